# Optimizing an MI355X kernel written in HIP

```python
import jax
import jax.numpy as jnp
from jax import lax
import numpy as np

D_MODEL = 2048
BATCH = 2
SEQ = 8192
DEPTH = 4

MIX_WIDTH = D_MODEL
RET_WIDTH = MIX_WIDTH // 2
RET_HEADS = 8
RET_HEAD_DIM = RET_WIDTH // RET_HEADS
RET_CHUNK = 128
RET_GN_EPS = 1e-5
ROPE_BASE = 10000.0
RWKV_WIDTH = MIX_WIDTH // 2
RWKV_HEAD_DIM = 64
RWKV_HEADS = RWKV_WIDTH // RWKV_HEAD_DIM
LORA_W = 64
LORA_A = 64
LORA_G = 128
RWKV_LN_EPS = 64e-5
D_FF = 4 * D_MODEL
NORM_EPS = 1e-6

RET_COLS = (RET_WIDTH, RET_WIDTH, RET_WIDTH, RET_WIDTH)
RWKV_COLS = (RWKV_WIDTH, RWKV_WIDTH, RWKV_WIDTH, LORA_W, LORA_A, LORA_G)
RWKV_SHIFT_WIDTH = sum(RWKV_COLS)
IN_WIDTH = sum(RET_COLS) + RWKV_SHIFT_WIDTH + 2 * D_MODEL

kernel_name = "retention_rwkv7_gated_hybrid"


def _split_cols(z, widths):
    offs = np.cumsum([0] + list(widths))
    return [z[..., int(offs[i]):int(offs[i + 1])] for i in range(len(widths))]


def rms_norm(x, g):
    xf = x.astype(jnp.float32)
    y = xf * lax.rsqrt(jnp.mean(xf * xf, axis=-1, keepdims=True) + NORM_EPS)
    return (y * g.astype(jnp.float32)).astype(x.dtype)


def head_norm(y, g, b, eps):
    H, d = y.shape[-2:]
    mean = jnp.mean(y, axis=-1, keepdims=True)
    var = jnp.mean(jnp.square(y - mean), axis=-1, keepdims=True)
    yn = (y - mean) * lax.rsqrt(var + eps)
    return yn * g.reshape(H, d).astype(jnp.float32) + b.reshape(H, d).astype(jnp.float32)


def rotary(t, positions):
    half = t.shape[-1] // 2
    inv_freq = ROPE_BASE ** (-jnp.arange(half, dtype=jnp.float32) / half)
    ang = positions.astype(jnp.float32)[..., None] * inv_freq
    cos = jnp.cos(ang)[:, :, None, :]
    sin = jnp.sin(ang)[:, :, None, :]
    t1, t2 = t[..., :half], t[..., half:]
    return jnp.concatenate([t1 * cos - t2 * sin, t2 * cos + t1 * sin], axis=-1)


def retention(q, k, v):
    B, S, H, d = q.shape
    C = RET_CHUNK
    N = S // C
    log_gamma = jnp.log1p(-(2.0 ** (-5.0 - jnp.arange(H, dtype=jnp.float32))))
    idx = jnp.arange(C, dtype=jnp.float32)
    diff = idx[:, None] - idx[None, :]
    inner_decay = jnp.where(diff[None] >= 0,
                            jnp.exp(jnp.maximum(diff, 0.0)[None] * log_gamma[:, None, None]), 0.0)
    query_decay = jnp.exp((idx + 1.0)[None, :] * log_gamma[:, None])[None, :, :, None]
    key_decay = jnp.exp((C - 1.0 - idx)[None, :] * log_gamma[:, None])[None, :, :, None]
    chunk_decay = jnp.exp(C * log_gamma)[None, :, None, None]

    def to_chunks(t):
        return t.reshape(B, N, C, H, d).transpose(1, 0, 3, 2, 4)

    def step(R, qkv):
        qn, kn, vn = qkv
        scores = jnp.einsum('bhcd,bhmd->bhcm', qn, kn) * inner_decay
        inner = jnp.einsum('bhcm,bhmd->bhcd', scores, vn)
        cross = jnp.einsum('bhcd,bhde->bhce', qn, R) * query_decay
        R_new = chunk_decay * R + jnp.einsum('bhcd,bhce->bhde', kn * key_decay, vn)
        return R_new, inner + cross

    R0 = jnp.zeros((B, H, d, d), jnp.float32)
    _, out = lax.scan(step, R0, (to_chunks(q), to_chunks(k), to_chunks(v)))
    return out.transpose(1, 0, 3, 2, 4).reshape(B, S, H, d)


def retention_branch(z, positions, gn_g, gn_b):
    B, S, _ = z.shape
    q, k, v, gr = _split_cols(z.astype(jnp.float32), RET_COLS)
    shp = (B, S, RET_HEADS, RET_HEAD_DIM)
    q = rotary(q.reshape(shp), positions)
    k = rotary(k.reshape(shp), positions) * (RET_HEAD_DIM ** -0.5)
    y = retention(q, k, v.reshape(shp))
    y = head_norm(y, gn_g, gn_b, RET_GN_EPS).reshape(B, S, RET_WIDTH)
    return jax.nn.silu(gr) * y


def rwkv7_scan(r, decay, k, v, kk, a):
    B, S, H, d = r.shape

    def step(state, inp):
        r_t, w_t, k_t, v_t, kk_t, a_t = inp
        sa = jnp.einsum('bhvk,bhk->bhv', state, -kk_t)
        state = (state * w_t[:, :, None, :]
                 + sa[..., None] * (kk_t * a_t)[:, :, None, :]
                 + v_t[..., None] * k_t[:, :, None, :])
        y = jnp.einsum('bhvk,bhk->bhv', state, r_t)
        return state, y

    seq_first = lambda t: jnp.moveaxis(t, 1, 0)
    s0 = jnp.zeros((B, H, d, d), jnp.float32)
    _, y = lax.scan(step, s0, tuple(seq_first(t) for t in (r, decay, k, v, kk, a)))
    return jnp.moveaxis(y, 0, 1)


def rwkv7_branch(z, mu, w0, w_up, a0, a_up, g_up, k_k, k_a, r_k, ln_g, ln_b):
    B, S, _ = z.shape
    f32 = jnp.float32
    z = z.astype(f32)
    z_prev = jnp.pad(z, ((0, 0), (1, 0), (0, 0)))[:, :-1]
    z = z + mu.astype(f32) * (z_prev - z)
    r, k, v, zw, za, zg = _split_cols(z, RWKV_COLS)
    w = -jax.nn.softplus(-(w0.astype(f32) + jnp.tanh(zw) @ w_up.astype(f32))) - 0.5
    decay = jnp.exp(-jnp.exp(w))
    a = jax.nn.sigmoid(a0.astype(f32) + za @ a_up.astype(f32))
    g = jax.nn.sigmoid(zg) @ g_up.astype(f32)
    heads = lambda t: t.reshape(B, S, RWKV_HEADS, RWKV_HEAD_DIM)
    kk = heads(k * k_k.astype(f32))
    kk = kk / jnp.maximum(jnp.sqrt(jnp.sum(kk * kk, axis=-1, keepdims=True)), 1e-12)
    k = k * (1.0 + (a - 1.0) * k_a.astype(f32))
    rh, kh, vh = heads(r), heads(k), heads(v)
    y = rwkv7_scan(rh, heads(decay), kh, vh, kk, heads(a))
    y = head_norm(y, ln_g, ln_b, RWKV_LN_EPS)
    bonus = jnp.sum(rh * kh * r_k.astype(f32).reshape(RWKV_HEADS, RWKV_HEAD_DIM), axis=-1, keepdims=True)
    y = y + bonus * vh
    return y.reshape(B, S, RWKV_WIDTH) * g


def setup_inputs(seed: int = 0) -> dict:
    key = jax.random.key(seed)
    ks = jax.random.split(key, 26)
    L, D = DEPTH, D_MODEL
    nrm = lambda k, shp, s: jax.random.normal(k, shp, jnp.float32) * s
    x = jax.random.normal(ks[0], (BATCH, SEQ, D), jnp.float32)
    offset = jax.random.randint(ks[1], (BATCH, 1), 0, 4096, dtype=jnp.int32)
    positions = offset + jnp.arange(SEQ, dtype=jnp.int32)[None, :]
    return {
        'x': x,
        'positions': positions,
        'norm1_g': 1.0 + nrm(ks[2], (L, D), 0.02),
        'w_in': nrm(ks[3], (L, D, IN_WIDTH), D ** -0.5),
        'ret_gn_g': 1.0 + nrm(ks[4], (L, RET_WIDTH), 0.02),
        'ret_gn_b': nrm(ks[5], (L, RET_WIDTH), 0.02),
        'rwkv_mu': jax.random.uniform(ks[6], (L, RWKV_SHIFT_WIDTH), jnp.float32),
        'rwkv_w0': jax.random.uniform(ks[7], (L, RWKV_WIDTH), jnp.float32, -6.0, 0.5),
        'rwkv_w_up': nrm(ks[8], (L, LORA_W, RWKV_WIDTH), 0.5 * LORA_W ** -0.5),
        'rwkv_a0': nrm(ks[9], (L, RWKV_WIDTH), 0.1),
        'rwkv_a_up': nrm(ks[10], (L, LORA_A, RWKV_WIDTH), LORA_A ** -0.5),
        'rwkv_g_up': nrm(ks[11], (L, LORA_G, RWKV_WIDTH), LORA_G ** -0.5),
        'rwkv_k_k': 0.85 + nrm(ks[12], (L, RWKV_WIDTH), 0.05),
        'rwkv_k_a': 1.0 + nrm(ks[13], (L, RWKV_WIDTH), 0.05),
        'rwkv_r_k': nrm(ks[14], (L, RWKV_WIDTH), 0.1),
        'rwkv_ln_g': 1.0 + nrm(ks[15], (L, RWKV_WIDTH), 0.02),
        'rwkv_ln_b': nrm(ks[16], (L, RWKV_WIDTH), 0.02),
        'w_branch_a': nrm(ks[17], (L, RET_WIDTH, D), RET_WIDTH ** -0.5),
        'w_branch_b': nrm(ks[18], (L, RWKV_WIDTH, D), RWKV_WIDTH ** -0.5),
        'w_out': nrm(ks[19], (L, D, D), D ** -0.5),
        'norm2_g': 1.0 + nrm(ks[20], (L, D), 0.02),
        'mlp_up': nrm(ks[21], (L, D, D_FF), D ** -0.5),
        'mlp_down': nrm(ks[22], (L, D_FF, D), D_FF ** -0.5),
        'final_g': 1.0 + nrm(ks[23], (D,), 0.02),
    }


def reference(x, positions, norm1_g, w_in, ret_gn_g, ret_gn_b, rwkv_mu, rwkv_w0, rwkv_w_up,
              rwkv_a0, rwkv_a_up, rwkv_g_up, rwkv_k_k, rwkv_k_a, rwkv_r_k, rwkv_ln_g, rwkv_ln_b,
              w_branch_a, w_branch_b, w_out, norm2_g, mlp_up, mlp_down, final_g):
    for l in range(DEPTH):
        h = rms_norm(x, norm1_g[l])
        z = h @ w_in[l]
        z_ret, z_rwkv, z_ga, z_gb = _split_cols(z, (sum(RET_COLS), RWKV_SHIFT_WIDTH, D_MODEL, D_MODEL))
        y_ret = retention_branch(z_ret, positions, ret_gn_g[l], ret_gn_b[l]).astype(x.dtype)
        y_rwkv = rwkv7_branch(z_rwkv, rwkv_mu[l], rwkv_w0[l], rwkv_w_up[l], rwkv_a0[l], rwkv_a_up[l],
                              rwkv_g_up[l], rwkv_k_k[l], rwkv_k_a[l], rwkv_r_k[l],
                              rwkv_ln_g[l], rwkv_ln_b[l]).astype(x.dtype)
        merged = (jax.nn.sigmoid(z_ga) * (y_ret @ w_branch_a[l])
                  + jax.nn.sigmoid(z_gb) * (y_rwkv @ w_branch_b[l]))
        x = x + merged @ w_out[l]
        h = rms_norm(x, norm2_g[l])
        x = x + jnp.square(jax.nn.relu(h @ mlp_up[l])) @ mlp_down[l]
    return rms_norm(x, final_g)
```

```cpp
#include <hip/hip_runtime.h>
#include <cstdio>
#include <cstdint>
namespace pg8 {
#define PG8_LAS __attribute__((address_space(3)))
typedef unsigned short bf16_t;
typedef short bf16x8 __attribute__((ext_vector_type(8)));
typedef float f32x4 __attribute__((ext_vector_type(4)));
typedef unsigned u32x4 __attribute__((ext_vector_type(4)));
constexpr int BM = 256, BK = 64, HALF = 128, HTB = HALF * BK * 2  , STAGE_BYTES = 8 * HTB, NXCD = 8, WGM = 8;

__host__ __device__ __forceinline__ int lds_byte(int r, int c) { const int st = (r >> 4) * 2 + (c >> 5), rr = r & 15, cc = c & 31, ob = rr * 64 + cc * 2; return st * 1024 + (ob ^ (((ob >> 9) & 1) << 5)); }
__host__ __device__ __forceinline__ void stage_rc(int b, int& R, int& C) { const int st = b / 1024, sb = b % 1024, swz = sb ^ (((sb >> 9) & 1) << 5); R = (st >> 1) * 16 + swz / 64; C = (st & 1) * 32 + (swz % 64) / 2; }
__host__ __device__ __forceinline__ int perm32(int rho) { const int n = rho >> 4, i = rho & 15; return 8 * (i >> 2) + 4 * n + (i & 3); }

struct Unit { int pm, pn; };
struct Gemm { const bf16_t* A; const bf16_t* Bt; int M, N, K; };

struct StaticOrder {
    int nM, nN, nwg, G, c;
    __host__ __device__ void init(int M, int N, int G_, int c_) { nM = M / BM; nN = N / BM; nwg = nM * nN; G = G_; c = c_; }
    __host__ __device__ bool next(int i, Unit& u) const {
        const long L = (long)i * G + c; if (L >= nwg) return false;
        int wgid = (int)L; { const int q = nwg / NXCD, r = nwg % NXCD, xcd = wgid % NXCD, off = wgid / NXCD; wgid = (xcd < r ? xcd * (q + 1) : r * (q + 1) + (xcd - r) * q) + off; }
        const int nig = WGM * nN, gid = wgid / nig, fm = gid * WGM, gsz = (nM - fm) < WGM ? (nM - fm) : WGM;
        u.pm = fm + ((wgid % nig) % gsz); u.pn = (wgid % nig) / gsz; return true;
    }
    __device__ __forceinline__ void a_ready(const Unit&) const {}
    __device__ __forceinline__ void done(const Unit&) const {}
};

__device__ __forceinline__ unsigned cvt_pk_bf16(float lo, float hi) { unsigned r; asm volatile("v_cvt_pk_bf16_f32 %0, %1, %2" : "=v"(r) : "v"(lo), "v"(hi)); return r; }
typedef float f32x2 __attribute__((ext_vector_type(2)));
__device__ __forceinline__ float bf_lo(unsigned w) { return __builtin_bit_cast(float, w << 16); }
__device__ __forceinline__ float bf_hi(unsigned w) { return __builtin_bit_cast(float, w & 0xffff0000u); }
__device__ __forceinline__ float sigmoidf_(float x) { return 1.0f / (1.0f + __expf(-x)); }
template <int MODE> struct EpiB {
    static constexpr bool PERM = true, AFTER_DRAIN = false;
    bf16_t* O; int ldc; const bf16_t* gate; int ldg;
    __device__ __forceinline__ void operator()(const f32x4 (&acc)[2][2][4][2], const Unit& u, int wr, int wc, int fr, int fq) const {
        const int row0 = u.pm * BM + wr * 64 + fr, col0 = u.pn * BM + wc * 32 + 8 * fq;
#pragma unroll
        for (int ai = 0; ai < 2; ++ai)
#pragma unroll
            for (int m = 0; m < 4; ++m) { const size_t row = (size_t)(row0 + ai * HALF + m * 16);
#pragma unroll
                for (int bj = 0; bj < 2; ++bj) { f32x4 v0 = acc[ai][bj][m][0], v1 = acc[ai][bj][m][1]; const int c = col0 + bj * HALF;
                    if (MODE == 1) {
#pragma unroll
                        for (int j = 0; j < 4; ++j) { const float a = fmaxf(v0[j], 0.f), b = fmaxf(v1[j], 0.f); v0[j] = a * a; v1[j] = b * b; } }
                    if (MODE >= 2) { const u32x4 g = *(const u32x4*)(gate + row * ldg + c);
                        v0[0] *= sigmoidf_(bf_lo(g.x)); v0[1] *= sigmoidf_(bf_hi(g.x)); v0[2] *= sigmoidf_(bf_lo(g.y)); v0[3] *= sigmoidf_(bf_hi(g.y));
                        v1[0] *= sigmoidf_(bf_lo(g.z)); v1[1] *= sigmoidf_(bf_hi(g.z)); v1[2] *= sigmoidf_(bf_lo(g.w)); v1[3] *= sigmoidf_(bf_hi(g.w)); }
                    if (MODE == 3) { const u32x4 o = *(const u32x4*)(O + row * ldc + c);
                        v0[0] += bf_lo(o.x); v0[1] += bf_hi(o.x); v0[2] += bf_lo(o.y); v0[3] += bf_hi(o.y);
                        v1[0] += bf_lo(o.z); v1[1] += bf_hi(o.z); v1[2] += bf_lo(o.w); v1[3] += bf_hi(o.w); }
                    u32x4 w; w.x = cvt_pk_bf16(v0[0], v0[1]); w.y = cvt_pk_bf16(v0[2], v0[3]); w.z = cvt_pk_bf16(v1[0], v1[1]); w.w = cvt_pk_bf16(v1[2], v1[3]);
                    *(u32x4*)(O + row * ldc + c) = w; } }
    }
};
struct EpiResF32 {
    static constexpr bool PERM = false, AFTER_DRAIN = false;
    float* X; int ldc;
    __device__ __forceinline__ void operator()(const f32x4 (&acc)[2][2][4][2], const Unit& u, int wr, int wc, int fr, int fq) const {
        const int row0 = u.pm * BM + wr * 64 + fr, col0 = u.pn * BM + wc * 32 + 4 * fq;
#pragma unroll
        for (int ai = 0; ai < 2; ++ai)
#pragma unroll
            for (int m = 0; m < 4; ++m) { float* rowp = X + (size_t)(row0 + ai * HALF + m * 16) * ldc + col0;
#pragma unroll
                for (int bj = 0; bj < 2; ++bj)
#pragma unroll
                    for (int n = 0; n < 2; ++n) { f32x4* p = (f32x4*)(rowp + bj * HALF + n * 16); *p = *p + acc[ai][bj][m][n]; } }
    }
};

template <class Epi, class Sched, bool ALIGN_EPI = false, bool SP2 = false>
__device__ __forceinline__ void gemm_phase(PG8_LAS unsigned char* lds, const Gemm g, const Sched& S, const Epi& E) {
    int tid_ = threadIdx.x; asm volatile("" : "+v"(tid_));
    const int tid = tid_, wid = __builtin_amdgcn_readfirstlane(tid >> 6), lane = tid & 63, wr = wid >> 2, wc = wid & 3, fr = lane & 15, fq = lane >> 4;
    const int K = g.K, nt = K / BK;
    unsigned voffA[2], voffB[2];
#pragma unroll
    for (int i = 0; i < 2; ++i) { int R, C; stage_rc(tid * 16 + i * 8192, R, C); const int Rb = Epi::PERM ? ((R & ~31) + perm32(R & 31)) : R;
        voffA[i] = (unsigned)(R * K + C) * 2u; voffB[i] = (unsigned)(Rb * K + C) * 2u; }
    const size_t kstep = (size_t)(BK * 2);
    const size_t hstep = (size_t)HALF * K * 2;
    const size_t tstep = 2 * hstep;
    const unsigned ldsw = (unsigned)wid * 1024u;
    const int aoff = lds_byte(wr * 64 + fr, fq * 8), boff = lds_byte(wc * 32 + fr, fq * 8);
#define PG8_SA(b, h) (((b) * 2 + (h)) * HTB)
#define PG8_SB(b, h) ((4 + (b) * 2 + (h)) * HTB)
#define PG8_STAGE(bufoff, gbase, voff) do { _Pragma("unroll") for (int _i = 0; _i < 2; ++_i) \
        __builtin_amdgcn_global_load_lds((const unsigned*)((const char*)(gbase) + (voff)[_i]), (PG8_LAS unsigned*)(lds + (bufoff) + ldsw + _i * 8192), 16, 0, 0); } while (0)
#define PG8_LDA(dst, b, h) do { _Pragma("unroll") for (int m = 0; m < 4; ++m) _Pragma("unroll") for (int k = 0; k < 2; ++k) dst[m][k] = *(const PG8_LAS bf16x8*)(lds + PG8_SA(b, h) + aoff + m * 2048 + k * 1024); } while (0)
#define PG8_LDB(dst, b, h) do { _Pragma("unroll") for (int n = 0; n < 2; ++n) _Pragma("unroll") for (int k = 0; k < 2; ++k) dst[n][k] = *(const PG8_LAS bf16x8*)(lds + PG8_SB(b, h) + boff + n * 2048 + k * 1024); } while (0)
#define PG8_MMA(ai, bj, At, Bt) do { __builtin_amdgcn_s_setprio(1); _Pragma("unroll") for (int m = 0; m < 4; ++m) _Pragma("unroll") for (int n = 0; n < 2; ++n) _Pragma("unroll") for (int k = 0; k < 2; ++k) \
        acc[ai][bj][m][n] = __builtin_amdgcn_mfma_f32_16x16x32_bf16(Bt[n][k], At[m][k], acc[ai][bj][m][n], 0, 0, 0); __builtin_amdgcn_s_setprio(0); } while (0)
#define PG8_WAIT_V(n) asm volatile("s_waitcnt vmcnt(" #n ")" ::: "memory")
#define PG8_WAIT_L(n) asm volatile("s_waitcnt lgkmcnt(" #n ")" ::: "memory")
#define PG8_BAR __builtin_amdgcn_s_barrier()
#define PG8_SCHED __builtin_amdgcn_sched_barrier(0)
    Unit cur, nxt; int ui = 0;
    if (!S.next(0, cur)) return;
    f32x4 acc[2][2][4][2];
#pragma unroll
    for (int a = 0; a < 2; ++a)
#pragma unroll
        for (int b = 0; b < 2; ++b)
#pragma unroll
            for (int m = 0; m < 4; ++m)
#pragma unroll
                for (int n = 0; n < 2; ++n) acc[a][b][m][n] = (f32x4){0.f, 0.f, 0.f, 0.f};
    bf16x8 At[4][2], B0[2][2], B1[2][2];
    const char* cA = (const char*)g.A + (size_t)cur.pm * tstep; const char* cB = (const char*)g.Bt + (size_t)cur.pn * tstep;
    S.a_ready(cur);
    if constexpr (SP2) {
        PG8_STAGE(PG8_SB(0, 0), cB, voffB); PG8_STAGE(PG8_SB(0, 1), cB + hstep, voffB); PG8_STAGE(PG8_SA(0, 0), cA, voffA); PG8_STAGE(PG8_SA(0, 1), cA + hstep, voffA);
        if (wr == 1) PG8_BAR;
        PG8_WAIT_V(2); PG8_BAR;
        PG8_STAGE(PG8_SB(1, 0), cB + kstep, voffB); PG8_STAGE(PG8_SA(1, 0), cA + kstep, voffA); PG8_STAGE(PG8_SB(1, 1), cB + hstep + kstep, voffB);
        PG8_WAIT_V(6); PG8_BAR;
    } else {
        PG8_STAGE(PG8_SB(0, 0), cB, voffB); PG8_STAGE(PG8_SA(0, 0), cA, voffA); PG8_STAGE(PG8_SB(0, 1), cB + hstep, voffB); PG8_STAGE(PG8_SA(0, 1), cA + hstep, voffA);
        if (wr == 1) PG8_BAR;
        PG8_WAIT_V(4); PG8_BAR;
        PG8_STAGE(PG8_SB(1, 0), cB + kstep, voffB); PG8_STAGE(PG8_SA(1, 0), cA + kstep, voffA); PG8_STAGE(PG8_SB(1, 1), cB + hstep + kstep, voffB);
        PG8_WAIT_V(6); PG8_BAR;
    }
    for (;;) {
        const bool has_next = S.next(ui + 1, nxt);
        const char* nA = has_next ? (const char*)g.A + (size_t)nxt.pm * tstep : cA; const char* nB = has_next ? (const char*)g.Bt + (size_t)nxt.pn * tstep : cB;
        for (int t = 0; t < nt; t += 2) {
            const bool last = (t == nt - 2);
            const char* a1 = cA + (size_t)(t + 1) * kstep;
            const char* a2 = last ? nA : cA + (size_t)(t + 2) * kstep; const char* b2 = last ? nB : cB + (size_t)(t + 2) * kstep;
            const char* a3 = a2 + kstep; const char* b3 = b2 + kstep;
            if (last && has_next) S.a_ready(nxt);
            if constexpr (SP2) {
            PG8_LDB(B0, 0, 0); PG8_LDB(B1, 0, 1); PG8_SCHED; PG8_LDA(At, 0, 0); PG8_STAGE(PG8_SA(1, 1), a1 + hstep, voffA);
            PG8_WAIT_V(8); PG8_WAIT_L(0); PG8_BAR; PG8_MMA(0, 0, At, B0); PG8_MMA(0, 1, At, B1); PG8_BAR; PG8_SCHED;
            PG8_LDA(At, 0, 1); PG8_STAGE(PG8_SB(0, 0), b2, voffB); PG8_STAGE(PG8_SB(0, 1), b2 + hstep, voffB); PG8_STAGE(PG8_SA(0, 0), a2, voffA);
            PG8_WAIT_V(8); PG8_WAIT_L(0); PG8_BAR; PG8_MMA(1, 0, At, B0); PG8_MMA(1, 1, At, B1); PG8_BAR; PG8_SCHED;
            PG8_LDB(B0, 1, 0); PG8_LDB(B1, 1, 1); PG8_SCHED; PG8_LDA(At, 1, 0); PG8_STAGE(PG8_SA(0, 1), a2 + hstep, voffA);
            PG8_WAIT_V(8); PG8_WAIT_L(0); PG8_BAR; PG8_MMA(0, 0, At, B0); PG8_MMA(0, 1, At, B1); PG8_BAR; PG8_SCHED;
            PG8_LDA(At, 1, 1); PG8_STAGE(PG8_SB(1, 0), b3, voffB); PG8_STAGE(PG8_SB(1, 1), b3 + hstep, voffB); PG8_STAGE(PG8_SA(1, 0), a3, voffA);
            PG8_WAIT_V(8); PG8_WAIT_L(0); PG8_BAR; PG8_MMA(1, 0, At, B0); PG8_MMA(1, 1, At, B1); PG8_BAR; PG8_SCHED;
            } else {
            PG8_LDB(B0, 0, 0); PG8_SCHED; PG8_LDA(At, 0, 0); PG8_STAGE(PG8_SA(1, 1), a1 + hstep, voffA);
            PG8_WAIT_L(8); PG8_BAR; PG8_WAIT_L(0); PG8_MMA(0, 0, At, B0); PG8_BAR; PG8_SCHED;
            PG8_LDB(B1, 0, 1); PG8_STAGE(PG8_SB(0, 0), b2, voffB);
            PG8_BAR; PG8_WAIT_L(0); PG8_MMA(0, 1, At, B1); PG8_BAR;
            PG8_LDA(At, 0, 1); PG8_STAGE(PG8_SA(0, 0), a2, voffA);
            PG8_BAR; PG8_WAIT_L(0); PG8_MMA(1, 0, At, B0); PG8_BAR; PG8_SCHED;
            PG8_STAGE(PG8_SB(0, 1), b2 + hstep, voffB);
            PG8_WAIT_V(6); PG8_BAR; PG8_MMA(1, 1, At, B1); PG8_BAR;
            PG8_LDB(B0, 1, 0); PG8_SCHED; PG8_LDA(At, 1, 0); PG8_STAGE(PG8_SA(0, 1), a2 + hstep, voffA);
            PG8_WAIT_L(8); PG8_BAR; PG8_WAIT_L(0); PG8_MMA(0, 0, At, B0); PG8_BAR; PG8_SCHED;
            PG8_LDB(B1, 1, 1); PG8_STAGE(PG8_SB(1, 0), b3, voffB);
            PG8_BAR; PG8_WAIT_L(0); PG8_MMA(0, 1, At, B1); PG8_BAR;
            PG8_LDA(At, 1, 1); PG8_STAGE(PG8_SA(1, 0), a3, voffA);
            PG8_BAR; PG8_WAIT_L(0); PG8_MMA(1, 0, At, B0); PG8_BAR; PG8_SCHED;
            PG8_STAGE(PG8_SB(1, 1), b3 + hstep, voffB);
            PG8_WAIT_V(6); PG8_BAR; PG8_MMA(1, 1, At, B1); PG8_BAR;
            }
        }
        if constexpr (ALIGN_EPI) { if (wr == 0) PG8_BAR; }
        if constexpr (!Epi::AFTER_DRAIN) { E(acc, cur, wr, wc, fr, fq); S.done(cur); }
        if (!has_next) break;
#pragma unroll
        for (int a = 0; a < 2; ++a)
#pragma unroll
            for (int b = 0; b < 2; ++b)
#pragma unroll
                for (int m = 0; m < 4; ++m)
#pragma unroll
                    for (int n = 0; n < 2; ++n) acc[a][b][m][n] = (f32x4){0.f, 0.f, 0.f, 0.f};
        cur = nxt; cA = nA; cB = nB; ++ui;
        if constexpr (ALIGN_EPI) { if (wr == 1) PG8_BAR; }
    }
    PG8_WAIT_V(0);
    if constexpr (!ALIGN_EPI) { if (wr == 0) PG8_BAR; }
    PG8_BAR;
    if constexpr (Epi::AFTER_DRAIN) { E.fused(acc, cur, wr, wc, fr, fq, lds, wid, lane); S.done(cur); }
#undef PG8_SA
#undef PG8_SB
#undef PG8_STAGE
#undef PG8_LDA
#undef PG8_LDB
#undef PG8_MMA
#undef PG8_WAIT_V
#undef PG8_WAIT_L
#undef PG8_BAR
#undef PG8_SCHED
}
}
constexpr int NWAVES = 8;
#ifndef MK_ONE_LAUNCH
#define MK_ONE_LAUNCH 1
#endif

constexpr int BATCH = 2, SEQ = 8192, D = 2048, DEPTH = 4, M = BATCH * SEQ;
constexpr int RETW = 1024, RH = 8, RD = 128, RWW = 1024, WH = 16, WD = 64;
constexpr int INW = 11520, DFF = 8192, RWSHIFT = 3328;
constexpr int ZC_Q = 0, ZC_K = 1024, ZC_V = 2048, ZC_GR = 3072, ZC_RW = 4096, ZC_GA = 7424, ZC_GB = 9472;
constexpr int RWC_R = 0, RWC_K = 1024, RWC_V = 2048, RWC_W = 3072, RWC_A = 3136, RWC_G = 3200;
constexpr float NORM_EPS = 1e-6f, RET_GN_EPS = 1e-5f, RWKV_LN_EPS = 64e-5f;

constexpr size_t MiB = 1u << 20;
constexpr size_t WS_CTL = 0, CTL_ZERO_BYTES = 1 * MiB;
constexpr size_t WS_ROPE = 1 * MiB;
constexpr size_t WS_WIN = 16 * MiB, WS_WA = 61 * MiB, WS_WB = 65 * MiB, WS_WO = 69 * MiB, WS_WUP = 77 * MiB, WS_WDN = 109 * MiB;
constexpr size_t WS_H = 144 * MiB;
constexpr size_t WS_Z = 208 * MiB;
constexpr size_t WS_UP = WS_Z;
constexpr size_t WS_QR = 568 * MiB, WS_KR = 600 * MiB;
constexpr size_t WS_YRET = 632 * MiB, WS_YRWKV = 664 * MiB;
constexpr size_t WS_MRG = 696 * MiB;
constexpr size_t WS_SR = 760 * MiB, WS_SW = 824 * MiB, WS_SK = 888 * MiB, WS_SV = 952 * MiB, WS_SNKK = 1016 * MiB, WS_SKKA = 1080 * MiB;
constexpr size_t WS_G = 1144 * MiB;
constexpr size_t WS_BONUS = 1208 * MiB;
constexpr size_t WS_YRAWR = 1216 * MiB, WS_YRAWW = 1280 * MiB;
constexpr size_t WS_END = 1344 * MiB;
constexpr int CW_BAR = 4096;

constexpr int PPL = 11;
enum { LP_CONV = 0, LP_G1, LP_PREP, LP_SCAN, LP_POST, LP_GA, LP_GB, LP_GO, LP_NORM2, LP_GUP, LP_GDN };
constexpr int PH_PRO = 0, PH_L0 = 1, PH_FIN = PH_L0 + DEPTH * PPL, NPH = PH_FIN + 1;

constexpr int RING_OFF = 0, RING_BYTES = 131072;
constexpr int LDSCTL_OFF = RING_BYTES, MISC_OFF = LDSCTL_OFF + 320;
constexpr int LDS_BYTES = 147456;
static_assert(MISC_OFF + 128 <= LDS_BYTES, "LDS map");

#define GAS __attribute__((address_space(1)))
#define LAS __attribute__((address_space(3)))
typedef unsigned short bf16;
typedef unsigned v4u __attribute__((ext_vector_type(4)));
typedef unsigned v2u __attribute__((ext_vector_type(2)));
typedef float f32x4 __attribute__((ext_vector_type(4)));
typedef float f32x2 __attribute__((ext_vector_type(2)));
typedef short bf16x8 __attribute__((ext_vector_type(8)));
typedef GAS unsigned gu32;
#define LDS_WAIT() asm volatile("s_waitcnt lgkmcnt(0)" ::: "memory")
#define VM_WAIT() asm volatile("s_waitcnt vmcnt(0)" ::: "memory")
__device__ __forceinline__ unsigned f2bf(float f) { unsigned u = __builtin_bit_cast(unsigned, f); return (u + 0x7fffu + ((u >> 16) & 1u)) >> 16; }
__device__ __forceinline__ unsigned pk2(float lo, float hi) { return f2bf(lo) | (f2bf(hi) << 16); }
__device__ __forceinline__ float bf2f(bf16 v) { return __builtin_bit_cast(float, (unsigned)v << 16); }
__device__ __forceinline__ float rdlane(float v, int l) { return __builtin_bit_cast(float, __builtin_amdgcn_readlane(__builtin_bit_cast(int, v), l)); }
__device__ __forceinline__ float sigm(float x) { return 1.0f / (1.0f + expf(-x)); }

__device__ const double ROPE_REV[64] = {
0.15915494309189535, 0.13782250260398285, 0.11934937021124886, 0.10335229661843406,
0.08949940160889101, 0.07750328875537406, 0.06711508300522726, 0.058119267441876246,
0.050329212104487035, 0.04358330210530733, 0.03774158471741977, 0.032682865872357,
0.0283021958306234, 0.024508691862069852, 0.02122365276477766, 0.018378926105679667,
0.015915494309189534, 0.013782250260398284, 0.011934937021124886, 0.010335229661843406,
0.008949940160889102, 0.0077503288755374055, 0.006711508300522725, 0.005811926744187624,
0.005032921210448704, 0.004358330210530733, 0.003774158471741977, 0.0032682865872356993,
0.00283021958306234, 0.002450869186206985, 0.0021223652764777662, 0.0018378926105679667,
0.0015915494309189536, 0.0013782250260398288, 0.0011934937021124885, 0.0010335229661843405,
0.0008949940160889102, 0.0007750328875537405, 0.0006711508300522726, 0.0005811926744187624,
0.0005032921210448703, 0.0004358330210530733, 0.00037741584717419774, 0.0003268286587235699,
0.00028302195830623395, 0.00024508691862069854, 0.0002122365276477766, 0.00018378926105679666,
0.00015915494309189535, 0.00013782250260398286, 0.00011934937021124886, 0.00010335229661843406,
8.949940160889102e-05, 7.750328875537406e-05, 6.711508300522725e-05, 5.811926744187624e-05,
5.0329212104487035e-05, 4.358330210530732e-05, 3.774158471741978e-05, 3.2682865872357e-05,
2.8302195830623396e-05, 2.4508691862069852e-05, 2.122365276477766e-05, 1.8378926105679668e-05 };

#define XB_TMO      128
#define XB_XCNT(j)  (256  + 64 * (j))
#define XB_XSUB(j)  (1280 + 64 * (j))
#define XB_XGEN(j)  (2304 + 64 * (j))
#define XB_TOP      3328
#define XB_TOPGEN   3392
#define XCD_BAR_WORDS 3456
#define XB_SPIN_CAP (1u << 18)

__device__ __forceinline__ unsigned xb_ld(unsigned* p)              { return __hip_atomic_load(p, __ATOMIC_RELAXED, __HIP_MEMORY_SCOPE_AGENT); }
__device__ __forceinline__ unsigned xb_add(unsigned* p, unsigned v) { return __hip_atomic_fetch_add(p, v, __ATOMIC_RELAXED, __HIP_MEMORY_SCOPE_AGENT); }
__device__ __forceinline__ unsigned xb_xcc_id() { return (unsigned)__builtin_amdgcn_s_getreg((3 << 11) | 20) & 0xFu; }
#define XB_SPIN(cond, bar) do { unsigned _sp = 0; while (cond) { __builtin_amdgcn_s_sleep(1); \
    if ((++_sp & 255u) == 0u) { if (xb_ld(&(bar)[XB_TMO])) break; if (_sp > XB_SPIN_CAP) { atomicAdd(&(bar)[XB_TMO], 1u); break; } } } } while (0)

struct XcdBarrier {
    unsigned* bar; unsigned x;
    volatile LAS unsigned* st;
};

__device__ __forceinline__ XcdBarrier xcd_barrier_post(unsigned* bar, volatile LAS unsigned* st) {
    XcdBarrier b; b.bar = bar; b.x = xb_xcc_id(); b.st = st;
    if (threadIdx.x == 0) (void)xb_add(&bar[XB_XCNT(b.x)], 1u);
    return b;
}
__device__ __forceinline__ void xcd_barrier_complete(unsigned* bar, unsigned x, unsigned& nloc, unsigned& nx) {
    const unsigned G = gridDim.x * gridDim.y * gridDim.z;
    unsigned sum, cnt, mine, sp = 0u;
    for (;;) {
        sum = 0u; cnt = 0u; mine = 0u;
#pragma unroll
        for (unsigned j = 0; j < 16; ++j) { const unsigned c = xb_ld(&bar[XB_XCNT(j)]); sum += c; cnt += (c > 0u) ? 1u : 0u; mine = (j == x) ? c : mine; }
        if (sum == G) break;
        __builtin_amdgcn_s_sleep(1);
        if ((++sp & 255u) == 0u) { if (xb_ld(&bar[XB_TMO])) break; if (sp > XB_SPIN_CAP) { atomicAdd(&bar[XB_TMO], 1u); break; } }
    }
    nloc = mine > 0u ? mine : 1u; nx = cnt > 0u ? cnt : 1u;
}

__device__ __forceinline__ void xcd_barrier(const XcdBarrier& b) {
    asm volatile("s_waitcnt vmcnt(0)" ::: "memory");
    __syncthreads();
    if (threadIdx.x == 0) {
        unsigned* bar = b.bar;
        __builtin_amdgcn_s_waitcnt(0);
        unsigned nloc = b.st[0], nx = b.st[1];
        if (nloc == 0u) { xcd_barrier_complete(bar, b.x, nloc, nx); b.st[0] = nloc; b.st[1] = nx; }
        const unsigned old = xb_add(&bar[XB_XSUB(b.x)], 1u);
        const unsigned gen = old / nloc;
        if (old + 1u == (gen + 1u) * nloc) {
            __builtin_amdgcn_fence(__ATOMIC_RELEASE, "agent");
            asm volatile("s_waitcnt vmcnt(0)" ::: "memory");
            const unsigned og = xb_add(&bar[XB_TOP], 1u);
            const unsigned tg = og / nx;
            if (og + 1u == (tg + 1u) * nx) xb_add(&bar[XB_TOPGEN], 1u);
            else XB_SPIN(xb_ld(&bar[XB_TOPGEN]) == tg, bar);
            __builtin_amdgcn_fence(__ATOMIC_ACQUIRE, "agent");
            xb_add(&bar[XB_XGEN(b.x)], 1u);
            asm volatile("s_waitcnt vmcnt(0)" ::: "memory");
        } else {
            XB_SPIN(xb_ld(&bar[XB_XGEN(b.x)]) == gen, bar);
            __builtin_amdgcn_fence(__ATOMIC_ACQUIRE, "agent");
            asm volatile("s_waitcnt vmcnt(0)" ::: "memory");
        }
    }
    __syncthreads();
}


struct Frame {
    LAS unsigned char* lds;
    volatile LAS unsigned* MISC;
    int tid, lane, wave;
    int vcu, G;
    float* out; unsigned char* ws;
};
struct Args { const float* in[24]; float* out; unsigned char* ws; int ph_lo, ph_hi, li, pad; };
#define WSP(T, off) ((T*)(F.ws + (off)))

__device__ __forceinline__ float wave_sum(float v) {
#pragma unroll
    for (int o = 1; o < 64; o <<= 1) v += __shfl_xor(v, o);
    return v;
}
__device__ __forceinline__ void transpose_item(const float* W, int K, int N, bf16* WT, LAS float* scr, int item, int lane) {
    const int nblk = N / 32, kb = item / nblk, nb = item % nblk, k0 = 64 * kb, n0 = 32 * nb;
#pragma unroll 8
    for (int i = 0; i < 32; ++i) { const int kk = 2 * i + (lane >> 5); scr[kk * 33 + (lane & 31)] = W[(size_t)(k0 + kk) * N + n0 + (lane & 31)]; }
    LDS_WAIT(); asm volatile("" ::: "memory");
    const int c = lane & 7;
#pragma unroll
    for (int j = 0; j < 4; ++j) { const int n = (lane >> 3) + 8 * j; const LAS float* s = scr + (8 * c) * 33 + n;
        v4u o; o.x = pk2(s[0 * 33], s[1 * 33]); o.y = pk2(s[2 * 33], s[3 * 33]); o.z = pk2(s[4 * 33], s[5 * 33]); o.w = pk2(s[6 * 33], s[7 * 33]);
        *(GAS v4u*)(WT + (size_t)(n0 + n) * K + k0 + 8 * c) = o; }
    LDS_WAIT(); asm volatile("" ::: "memory");
}
__device__ __forceinline__ void rms_row_to_bf16(const float* xrow, const float* g, bf16* orow, int lane) {
    const GAS f32x4* xr = (const GAS f32x4*)xrow + lane;
    f32x4 v[8]; float s = 0.f;
#pragma unroll
    for (int j = 0; j < 8; ++j) { v[j] = xr[64 * j]; s += (v[j].x * v[j].x + v[j].y * v[j].y) + (v[j].z * v[j].z + v[j].w * v[j].w); }
    const float rstd = 1.f / sqrtf(wave_sum(s) * (1.f / D) + NORM_EPS);
    const GAS f32x4* gr = (const GAS f32x4*)g + lane;
    GAS v2u* o8 = (GAS v2u*)orow + lane;
#pragma unroll
    for (int j = 0; j < 8; ++j) { const f32x4 gg = gr[64 * j]; v2u o; o.x = pk2(v[j].x * rstd * gg.x, v[j].y * rstd * gg.y); o.y = pk2(v[j].z * rstd * gg.z, v[j].w * rstd * gg.w); o8[64 * j] = o; }
}

__device__ __forceinline__ void ph_prologue(Frame& F, const Args& A) {
    const int* pos = (const int*)A.in[1]; float2* rope = WSP(float2, WS_ROPE);
    const size_t n4 = (size_t)M * D / 4;
    const GAS f32x4* src = (const GAS f32x4*)A.in[0]; GAS f32x4* dst = (GAS f32x4*)F.out;
    for (size_t i = (size_t)F.vcu * 512 + F.tid; i < n4; i += (size_t)F.G * 512) dst[i] = src[i];
    for (int i = F.vcu * 512 + F.tid; i < M * 64; i += F.G * 512) {
        const int m = i >> 6, j = i & 63;
        const double rev = (double)pos[m] * ROPE_REV[j];
        const float fr = (float)(rev - __builtin_rint(rev));
        rope[i] = make_float2(__builtin_amdgcn_cosf(fr), __builtin_amdgcn_sinf(fr));
    }
}
__device__ __forceinline__ void ph_convert(Frame& F, const Args& A, int l) {
    LAS float* scr = (LAS float*)(F.lds + RING_OFF + F.wave * 16384);
    const int gw = F.vcu * NWAVES + F.wave, NGW = F.G * NWAVES;
    constexpr int I_IN = (D / 64) * (INW / 32), I_A = (RETW / 64) * (D / 32), I_O = (D / 64) * (D / 32), I_UP = (D / 64) * (DFF / 32), I_DN = (DFF / 64) * (D / 32);
    constexpr int NITEMS = I_IN + 2 * I_A + I_O + I_UP + I_DN;
    for (int it = gw; it < NITEMS; it += NGW) {
        int r = it;
        if (r < I_IN) { transpose_item(A.in[3] + (size_t)l * D * INW, D, INW, WSP(bf16, WS_WIN), scr, r, F.lane); continue; } r -= I_IN;
        if (r < I_A) { transpose_item(A.in[17] + (size_t)l * RETW * D, RETW, D, WSP(bf16, WS_WA), scr, r, F.lane); continue; } r -= I_A;
        if (r < I_A) { transpose_item(A.in[18] + (size_t)l * RWW * D, RWW, D, WSP(bf16, WS_WB), scr, r, F.lane); continue; } r -= I_A;
        if (r < I_O) { transpose_item(A.in[19] + (size_t)l * D * D, D, D, WSP(bf16, WS_WO), scr, r, F.lane); continue; } r -= I_O;
        if (r < I_UP) { transpose_item(A.in[21] + (size_t)l * D * DFF, D, DFF, WSP(bf16, WS_WUP), scr, r, F.lane); continue; } r -= I_UP;
        transpose_item(A.in[22] + (size_t)l * DFF * D, DFF, D, WSP(bf16, WS_WDN), scr, r, F.lane);
    }
}
__device__ __forceinline__ void ph_norm(Frame& F, const float* g) {
    const int gw = F.vcu * NWAVES + F.wave, NGW = F.G * NWAVES;
    for (int m = gw; m < M; m += NGW) rms_row_to_bf16(F.out + (size_t)m * D, g, WSP(bf16, WS_H) + (size_t)m * D, F.lane);
}
__device__ __forceinline__ float zmix(const bf16* zr, const bf16* zp, bool has_prev, const float* mu, int c) {
    const float z = bf2f(zr[c]); const float p = has_prev ? bf2f(zp[c]) : 0.f; return z + mu[c] * (p - z);
}
__device__ __forceinline__ void ph_prep(Frame& F, const Args& A, int l) {
    const int gw = F.vcu * NWAVES + F.wave, NGW = F.G * NWAVES, lane = F.lane;
    LAS float* scr = (LAS float*)(F.lds + RING_OFF + F.wave * 2048);
    const float* mu = A.in[6] + (size_t)l * RWSHIFT; const float* w0 = A.in[7] + (size_t)l * RWW; const float* wup = A.in[8] + (size_t)l * 64 * RWW;
    const float* a0 = A.in[9] + (size_t)l * RWW; const float* aup = A.in[10] + (size_t)l * 64 * RWW; const float* gup = A.in[11] + (size_t)l * 128 * RWW;
    const float* kkw = A.in[12] + (size_t)l * RWW; const float* kaw = A.in[13] + (size_t)l * RWW; const float* rkw = A.in[14] + (size_t)l * RWW;
    for (int m = gw; m < M; m += NGW) {
        const bool has_prev = (m % SEQ) != 0;
        const bf16* zrow = WSP(bf16, WS_Z) + (size_t)m * INW;
        const float2 cs = WSP(float2, WS_ROPE)[(size_t)m * 64 + lane];
#pragma unroll
        for (int h = 0; h < RH; ++h) {
            const float q1 = bf2f(zrow[ZC_Q + h * RD + lane]), q2 = bf2f(zrow[ZC_Q + h * RD + 64 + lane]);
            const float k1 = bf2f(zrow[ZC_K + h * RD + lane]) * 0.08838834764831845f, k2 = bf2f(zrow[ZC_K + h * RD + 64 + lane]) * 0.08838834764831845f;
            bf16* qo = WSP(bf16, WS_QR) + (size_t)m * RETW + h * RD + lane; bf16* ko = WSP(bf16, WS_KR) + (size_t)m * RETW + h * RD + lane;
            qo[0] = (bf16)f2bf(q1 * cs.x - q2 * cs.y); qo[64] = (bf16)f2bf(q2 * cs.x + q1 * cs.y);
            ko[0] = (bf16)f2bf(k1 * cs.x - k2 * cs.y); ko[64] = (bf16)f2bf(k2 * cs.x + k1 * cs.y);
        }
        const bf16* zr = zrow + ZC_RW; const bf16* zp = zr - INW;
        scr[lane] = tanhf(zmix(zr, zp, has_prev, mu, RWC_W + lane));
        scr[64 + lane] = zmix(zr, zp, has_prev, mu, RWC_A + lane);
        scr[128 + lane] = sigm(zmix(zr, zp, has_prev, mu, RWC_G + lane));
        scr[192 + lane] = sigm(zmix(zr, zp, has_prev, mu, RWC_G + 64 + lane));
        LDS_WAIT(); asm volatile("" ::: "memory");
        for (int hh = 0; hh < WH; ++hh) {
            const int c = hh * WD + lane;
            float wl = w0[c], al = a0[c], gl = 0.f;
#pragma unroll 4
            for (int j = 0; j < 64; j += 4) {
                const f32x4 tw = *(const LAS f32x4*)(scr + j), ta = *(const LAS f32x4*)(scr + 64 + j);
                wl += tw.x * wup[(size_t)(j + 0) * RWW + c] + tw.y * wup[(size_t)(j + 1) * RWW + c] + tw.z * wup[(size_t)(j + 2) * RWW + c] + tw.w * wup[(size_t)(j + 3) * RWW + c];
                al += ta.x * aup[(size_t)(j + 0) * RWW + c] + ta.y * aup[(size_t)(j + 1) * RWW + c] + ta.z * aup[(size_t)(j + 2) * RWW + c] + ta.w * aup[(size_t)(j + 3) * RWW + c];
            }
#pragma unroll 4
            for (int j = 0; j < 128; j += 4) {
                const f32x4 tg = *(const LAS f32x4*)(scr + 128 + j);
                gl += tg.x * gup[(size_t)(j + 0) * RWW + c] + tg.y * gup[(size_t)(j + 1) * RWW + c] + tg.z * gup[(size_t)(j + 2) * RWW + c] + tg.w * gup[(size_t)(j + 3) * RWW + c];
            }
            const float yy = -wl;
            const float sp = (yy > 0.f) ? (yy + log1pf(expf(-yy))) : log1pf(expf(yy));
            const float wlog = -sp - 0.5f;
            const float decay = expf(-expf(wlog));
            const float a = sigm(al);
            const float r = zmix(zr, zp, has_prev, mu, RWC_R + c), k = zmix(zr, zp, has_prev, mu, RWC_K + c), v = zmix(zr, zp, has_prev, mu, RWC_V + c);
            const float kkr = k * kkw[c];
            const float nrm = fmaxf(sqrtf(wave_sum(kkr * kkr)), 1e-12f);
            const float kk = kkr / nrm;
            const float kp = k * (1.0f + (a - 1.0f) * kaw[c]);
            const float bonus = wave_sum(r * kp * rkw[c]);
            const size_t o = (size_t)m * RWW + c;
            WSP(float, WS_SR)[o] = r; WSP(float, WS_SW)[o] = decay; WSP(float, WS_SK)[o] = kp; WSP(float, WS_SV)[o] = v; WSP(float, WS_SNKK)[o] = -kk; WSP(float, WS_SKKA)[o] = kk * a; WSP(float, WS_G)[o] = gl;
            if (lane == 0) WSP(float, WS_BONUS)[(size_t)m * WH + hh] = bonus;
        }
        LDS_WAIT(); asm volatile("" ::: "memory");
    }
}
__device__ __forceinline__ void scan_rwkv_naive(Frame& F, int item) {
    const int lane = F.lane;
    float st[64];
#pragma unroll
    for (int j = 0; j < 64; ++j) st[j] = 0.f;
    const size_t base0 = (size_t)(item >> 4) * SEQ * RWW + (size_t)(item & 15) * WD + lane;
    for (int t = 0; t < SEQ; ++t) {
        const size_t o = base0 + (size_t)t * RWW;
        const float r = WSP(float, WS_SR)[o], w = WSP(float, WS_SW)[o], k = WSP(float, WS_SK)[o], v = WSP(float, WS_SV)[o], nk = WSP(float, WS_SNKK)[o], ka = WSP(float, WS_SKKA)[o];
        float sa = 0.f;
#pragma unroll
        for (int j = 0; j < 64; ++j) sa += st[j] * rdlane(nk, j);
        float y = 0.f;
#pragma unroll
        for (int j = 0; j < 64; ++j) { st[j] = st[j] * rdlane(w, j) + sa * rdlane(ka, j) + v * rdlane(k, j); y += st[j] * rdlane(r, j); }
        WSP(float, WS_YRAWW)[o] = y;
    }
}
__device__ __forceinline__ void scan_ret_naive(Frame& F, int item) {
    const int lane = F.lane, b = item >> 4, h = (item >> 1) & 7, half = item & 1;
    const float gam = 1.0f - exp2f((float)(-5 - h));
    float R[128];
#pragma unroll
    for (int j = 0; j < 128; ++j) R[j] = 0.f;
    for (int t = 0; t < SEQ; ++t) {
        const size_t m = (size_t)b * SEQ + t;
        const float q1 = bf2f(WSP(bf16, WS_QR)[m * RETW + h * RD + lane]), q2 = bf2f(WSP(bf16, WS_QR)[m * RETW + h * RD + 64 + lane]);
        const float k1 = bf2f(WSP(bf16, WS_KR)[m * RETW + h * RD + lane]), k2 = bf2f(WSP(bf16, WS_KR)[m * RETW + h * RD + 64 + lane]);
        const float v = bf2f(WSP(bf16, WS_Z)[m * INW + ZC_V + h * RD + half * 64 + lane]);
        float y = 0.f;
#pragma unroll
        for (int d = 0; d < 64; ++d) { R[d] = gam * R[d] + rdlane(k1, d) * v; y += rdlane(q1, d) * R[d]; }
#pragma unroll
        for (int d = 0; d < 64; ++d) { R[64 + d] = gam * R[64 + d] + rdlane(k2, d) * v; y += rdlane(q2, d) * R[64 + d]; }
        WSP(float, WS_YRAWR)[m * RETW + h * RD + half * 64 + lane] = y;
    }
}
__device__ __forceinline__ void ph_scan(Frame& F) {
    const int gw = F.vcu * NWAVES + F.wave, NGW = F.G * NWAVES;
    const int stride = NGW >= 64 ? NGW / 64 : 1;
    if (gw % stride == 0) {
        for (int item = gw / stride; item < 64; item += (NGW + stride - 1) / stride) {
            if (item < 32) scan_rwkv_naive(F, item); else scan_ret_naive(F, item - 32);
        }
    }
}
__device__ __forceinline__ void ph_post(Frame& F, const Args& A, int l) {
    const int gw = F.vcu * NWAVES + F.wave, NGW = F.G * NWAVES, lane = F.lane;
    const float* gng = A.in[4] + (size_t)l * RETW; const float* gnb = A.in[5] + (size_t)l * RETW;
    const float* lng = A.in[15] + (size_t)l * RWW; const float* lnb = A.in[16] + (size_t)l * RWW;
    for (int m = gw; m < M; m += NGW) {
        const bf16* zrow = WSP(bf16, WS_Z) + (size_t)m * INW;
#pragma unroll
        for (int h = 0; h < RH; ++h) {
            const int c = h * RD + lane;
            const float y1 = WSP(float, WS_YRAWR)[(size_t)m * RETW + c], y2 = WSP(float, WS_YRAWR)[(size_t)m * RETW + c + 64];
            const float mean = wave_sum(y1 + y2) * (1.f / RD);
            const float d1 = y1 - mean, d2 = y2 - mean;
            const float rstd = 1.f / sqrtf(wave_sum(d1 * d1 + d2 * d2) * (1.f / RD) + RET_GN_EPS);
            const float g1 = bf2f(zrow[ZC_GR + c]), g2 = bf2f(zrow[ZC_GR + c + 64]);
            const float o1 = (d1 * rstd * gng[c] + gnb[c]) * (g1 * sigm(g1)), o2 = (d2 * rstd * gng[c + 64] + gnb[c + 64]) * (g2 * sigm(g2));
            WSP(bf16, WS_YRET)[(size_t)m * RETW + c] = (bf16)f2bf(o1); WSP(bf16, WS_YRET)[(size_t)m * RETW + c + 64] = (bf16)f2bf(o2);
        }
#pragma unroll
        for (int hh = 0; hh < WH; ++hh) {
            const int c = hh * WD + lane; const size_t o = (size_t)m * RWW + c;
            const float y = WSP(float, WS_YRAWW)[o];
            const float mean = wave_sum(y) * (1.f / WD);
            const float d = y - mean;
            const float rstd = 1.f / sqrtf(wave_sum(d * d) * (1.f / WD) + RWKV_LN_EPS);
            float yn = d * rstd * lng[c] + lnb[c];
            yn += WSP(float, WS_BONUS)[(size_t)m * WH + hh] * WSP(float, WS_SV)[o];
            WSP(bf16, WS_YRWKV)[o] = (bf16)f2bf(yn * WSP(float, WS_G)[o]);
        }
    }
}
__device__ __forceinline__ void ph_final(Frame& F, const Args& A) {
    const int gw = F.vcu * NWAVES + F.wave, NGW = F.G * NWAVES, lane = F.lane;
    const GAS f32x4* gr = (const GAS f32x4*)A.in[23] + lane;
    for (int m = gw; m < M; m += NGW) {
        GAS f32x4* xr = (GAS f32x4*)(F.out + (size_t)m * D) + lane;
        f32x4 v[8]; float s = 0.f;
#pragma unroll
        for (int j = 0; j < 8; ++j) { v[j] = xr[64 * j]; s += (v[j].x * v[j].x + v[j].y * v[j].y) + (v[j].z * v[j].z + v[j].w * v[j].w); }
        const float rstd = 1.f / sqrtf(wave_sum(s) * (1.f / D) + NORM_EPS);
#pragma unroll
        for (int j = 0; j < 8; ++j) xr[64 * j] = v[j] * rstd * gr[64 * j];
    }
}

__global__ void __launch_bounds__(NWAVES * 64, 2) hybrid_fwd(Args args) {
    extern __shared__ __attribute__((aligned(16))) unsigned char lds[];
    Frame F;
    F.lds = (LAS unsigned char*)lds;
    F.MISC = (volatile LAS unsigned*)(F.lds + MISC_OFF);
    F.tid = threadIdx.x; F.lane = F.tid & 63; F.wave = __builtin_amdgcn_readfirstlane(F.tid >> 6);
    int bx = blockIdx.x; F.G = gridDim.x; { F.vcu = (F.G % 8 == 0) ? (bx % 8) * (F.G / 8) + bx / 8 : bx; }
    F.ws = args.ws; F.out = args.out;
    for (int u = F.tid; u < (LDS_BYTES - LDSCTL_OFF) / 4; u += NWAVES * 64) ((LAS unsigned*)(F.lds + LDSCTL_OFF))[u] = 0u;
    __syncthreads();
    XcdBarrier bar = xcd_barrier_post((unsigned*)(F.ws + WS_CTL) + CW_BAR, F.MISC + 8);

    const int lo = args.ph_lo, hi = args.ph_hi;
#define IN(k) (lo <= (k) && (k) < hi)
#define SEAM(k) do { if (IN(k) && IN((k) + 1)) xcd_barrier(bar); else __syncthreads(); } while (0)

    if (IN(PH_PRO)) { ph_prologue(F, args); }
    SEAM(PH_PRO);
    for (int l = 0; l < DEPTH; ++l) {
        const int p0 = PH_L0 + l * PPL;
        asm volatile("" : "+s"(F.ws), "+s"(F.out), "+s"(F.G), "+s"(F.vcu), "+s"(bx), "+s"(F.wave), "+v"(F.tid), "+v"(F.lane) :: "memory");
        if (IN(p0 + LP_CONV)) { ph_convert(F, args, l); ph_norm(F, args.in[2] + (size_t)l * D); }
        SEAM(p0 + LP_CONV);
        if (IN(p0 + LP_G1)) {
            pg8::Gemm g{WSP(bf16, WS_H), WSP(bf16, WS_WIN), M, INW, D}; pg8::StaticOrder S; S.init(M, INW, F.G, bx);
            pg8::EpiB<0> E{WSP(bf16, WS_Z), INW, nullptr, 0};
            pg8::gemm_phase<pg8::EpiB<0>, pg8::StaticOrder, true, true>(F.lds + RING_OFF, g, S, E);
        }
        SEAM(p0 + LP_G1);
        if (IN(p0 + LP_PREP)) { ph_prep(F, args, l); }
        SEAM(p0 + LP_PREP);
        if (IN(p0 + LP_SCAN)) { ph_scan(F); }
        SEAM(p0 + LP_SCAN);
        if (IN(p0 + LP_POST)) { ph_post(F, args, l); }
        SEAM(p0 + LP_POST);
        if (IN(p0 + LP_GA)) {
            pg8::Gemm g{WSP(bf16, WS_YRET), WSP(bf16, WS_WA), M, D, RETW}; pg8::StaticOrder S; S.init(M, D, F.G, bx);
            pg8::EpiB<2> E{WSP(bf16, WS_MRG), D, WSP(bf16, WS_Z) + ZC_GA, INW};
            pg8::gemm_phase<pg8::EpiB<2>, pg8::StaticOrder, true, true>(F.lds + RING_OFF, g, S, E);
        }
        SEAM(p0 + LP_GA);
        if (IN(p0 + LP_GB)) {
            pg8::Gemm g{WSP(bf16, WS_YRWKV), WSP(bf16, WS_WB), M, D, RWW}; pg8::StaticOrder S; S.init(M, D, F.G, bx);
            pg8::EpiB<3> E{WSP(bf16, WS_MRG), D, WSP(bf16, WS_Z) + ZC_GB, INW};
            pg8::gemm_phase<pg8::EpiB<3>, pg8::StaticOrder, true, true>(F.lds + RING_OFF, g, S, E);
        }
        SEAM(p0 + LP_GB);
        if (IN(p0 + LP_GO)) {
            pg8::Gemm g{WSP(bf16, WS_MRG), WSP(bf16, WS_WO), M, D, D}; pg8::StaticOrder S; S.init(M, D, F.G, bx);
            pg8::EpiResF32 E{F.out, D};
            pg8::gemm_phase<pg8::EpiResF32, pg8::StaticOrder, true, true>(F.lds + RING_OFF, g, S, E);
        }
        SEAM(p0 + LP_GO);
        if (IN(p0 + LP_NORM2)) { ph_norm(F, args.in[20] + (size_t)l * D); }
        SEAM(p0 + LP_NORM2);
        if (IN(p0 + LP_GUP)) {
            pg8::Gemm g{WSP(bf16, WS_H), WSP(bf16, WS_WUP), M, DFF, D}; pg8::StaticOrder S; S.init(M, DFF, F.G, bx);
            pg8::EpiB<1> E{WSP(bf16, WS_UP), DFF, nullptr, 0};
            pg8::gemm_phase<pg8::EpiB<1>, pg8::StaticOrder, true, true>(F.lds + RING_OFF, g, S, E);
        }
        SEAM(p0 + LP_GUP);
        if (IN(p0 + LP_GDN)) {
            pg8::Gemm g{WSP(bf16, WS_UP), WSP(bf16, WS_WDN), M, D, DFF}; pg8::StaticOrder S; S.init(M, D, F.G, bx);
            pg8::EpiResF32 E{F.out, D};
            pg8::gemm_phase<pg8::EpiResF32, pg8::StaticOrder, true, true>(F.lds + RING_OFF, g, S, E);
        }
        SEAM(p0 + LP_GDN);
    }
    if (IN(PH_FIN)) { ph_final(F, args); }
#undef IN
#undef SEAM
}

extern "C" void kernel_launch(void* const* d_in, const int* in_sizes, int n_in, void* d_out, int out_size, void* d_ws, size_t ws_size, hipStream_t stream) {
    static int grid = 0;
    if (grid == 0) {
        if (n_in != 24 || in_sizes[0] != M * D || out_size != M * D || ws_size < WS_END) { fprintf(stderr, "kernel_launch: built for 24 inputs, x and out of %d floats, >= %zu bytes of workspace; got n_in %d, in0 %d, out %d, ws %zu; nothing launched\n", M * D, (size_t)WS_END, n_in, n_in > 0 ? in_sizes[0] : -1, out_size, ws_size); grid = -1; return; }
        int dev = 0, cus = 0, per_cu = 0;
        if (hipGetDevice(&dev) != hipSuccess || hipDeviceGetAttribute(&cus, hipDeviceAttributeMultiprocessorCount, dev) != hipSuccess) { fprintf(stderr, "kernel_launch: hipGetDevice / hipDeviceGetAttribute failed; nothing launched\n"); grid = -1; return; }
        if (hipFuncSetAttribute((const void*)hybrid_fwd, hipFuncAttributeMaxDynamicSharedMemorySize, LDS_BYTES) != hipSuccess) { fprintf(stderr, "kernel_launch: hipFuncSetAttribute failed\n"); grid = -1; return; }
        if (hipOccupancyMaxActiveBlocksPerMultiprocessor(&per_cu, (const void*)hybrid_fwd, NWAVES * 64, LDS_BYTES) != hipSuccess || per_cu < 1)
            fprintf(stderr, "kernel_launch: note: the occupancy query reports %d workgroups per CU\n", per_cu);
        (void)hipGetLastError();
        grid = cus;
    }
    if (grid < 0) return;
    if (hipMemsetAsync((char*)d_ws + WS_CTL, 0, CTL_ZERO_BYTES, stream) != hipSuccess) { fprintf(stderr, "kernel_launch: hipMemsetAsync failed\n"); return; }
    Args a{};
    for (int i = 0; i < 24; ++i) a.in[i] = (const float*)d_in[i];
    a.out = (float*)d_out; a.ws = (unsigned char*)d_ws; a.li = 0; a.pad = 0;
#if MK_ONE_LAUNCH
    a.ph_lo = 0; a.ph_hi = NPH;
    hipLaunchKernelGGL(hybrid_fwd, dim3(grid), dim3(NWAVES * 64), LDS_BYTES, stream, a);
#else
    for (int p = 0; p < NPH; ++p) {
        a.ph_lo = p; a.ph_hi = p + 1;
        hipLaunchKernelGGL(hybrid_fwd, dim3(grid), dim3(NWAVES * 64), LDS_BYTES, stream, a);
    }
#endif
    const hipError_t le = hipPeekAtLastError();
    if (le != hipSuccess) fprintf(stderr, "kernel_launch: launch failed: %s\n", hipGetErrorName(le));
}
```

```cpp
#include <hip/hip_runtime.h>
#include <cstdio>
#include <cstdint>
namespace pg8 {
#define PG8_LAS __attribute__((address_space(3)))
typedef unsigned short bf16_t;
typedef short bf16x8 __attribute__((ext_vector_type(8)));
typedef float f32x4 __attribute__((ext_vector_type(4)));
typedef unsigned u32x4 __attribute__((ext_vector_type(4)));
constexpr int BM = 256, BK = 64, HALF = 128, HTB = HALF * BK * 2  , STAGE_BYTES = 8 * HTB, NXCD = 8, WGM = 8;

__host__ __device__ __forceinline__ int lds_byte(int r, int c) { const int st = (r >> 4) * 2 + (c >> 5), rr = r & 15, cc = c & 31, ob = rr * 64 + cc * 2; return st * 1024 + (ob ^ (((ob >> 9) & 1) << 5)); }
__host__ __device__ __forceinline__ void stage_rc(int b, int& R, int& C) { const int st = b / 1024, sb = b % 1024, swz = sb ^ (((sb >> 9) & 1) << 5); R = (st >> 1) * 16 + swz / 64; C = (st & 1) * 32 + (swz % 64) / 2; }
__host__ __device__ __forceinline__ int perm32(int rho) { const int n = rho >> 4, i = rho & 15; return 8 * (i >> 2) + 4 * n + (i & 3); }

struct Unit { int pm, pn; };
struct Gemm { const bf16_t* A; const bf16_t* Bt; int M, N, K; };

struct StaticOrder {
    int nM, nN, nwg, G, c;
    __host__ __device__ void init(int M, int N, int G_, int c_) { nM = M / BM; nN = N / BM; nwg = nM * nN; G = G_; c = c_; }
    __host__ __device__ bool next(int i, Unit& u) const {
        const long L = (long)i * G + c; if (L >= nwg) return false;
        int wgid = (int)L; { const int q = nwg / NXCD, r = nwg % NXCD, xcd = wgid % NXCD, off = wgid / NXCD; wgid = (xcd < r ? xcd * (q + 1) : r * (q + 1) + (xcd - r) * q) + off; }
        const int nig = WGM * nN, gid = wgid / nig, fm = gid * WGM, gsz = (nM - fm) < WGM ? (nM - fm) : WGM;
        u.pm = fm + ((wgid % nig) % gsz); u.pn = (wgid % nig) / gsz; return true;
    }
    __device__ __forceinline__ void a_ready(const Unit&) const {}
    __device__ __forceinline__ void done(const Unit&) const {}
};

__device__ __forceinline__ unsigned cvt_pk_bf16(float lo, float hi) { unsigned r; asm volatile("v_cvt_pk_bf16_f32 %0, %1, %2" : "=v"(r) : "v"(lo), "v"(hi)); return r; }
typedef float f32x2 __attribute__((ext_vector_type(2)));
__device__ __forceinline__ float bf_lo(unsigned w) { return __builtin_bit_cast(float, w << 16); }
__device__ __forceinline__ float bf_hi(unsigned w) { return __builtin_bit_cast(float, w & 0xffff0000u); }
__device__ __forceinline__ float sigmoidf_(float x) { return 1.0f / (1.0f + __expf(-x)); }
template <int MODE> struct EpiB {
    static constexpr bool PERM = true, AFTER_DRAIN = false;
    bf16_t* O; int ldc; const bf16_t* gate; int ldg;
    __device__ __forceinline__ void operator()(const f32x4 (&acc)[2][2][4][2], const Unit& u, int wr, int wc, int fr, int fq) const {
        const int row0 = u.pm * BM + wr * 64 + fr, col0 = u.pn * BM + wc * 32 + 8 * fq;
#pragma unroll
        for (int ai = 0; ai < 2; ++ai)
#pragma unroll
            for (int m = 0; m < 4; ++m) { const size_t row = (size_t)(row0 + ai * HALF + m * 16);
#pragma unroll
                for (int bj = 0; bj < 2; ++bj) { f32x4 v0 = acc[ai][bj][m][0], v1 = acc[ai][bj][m][1]; const int c = col0 + bj * HALF;
                    if (MODE == 1) {
#pragma unroll
                        for (int j = 0; j < 4; ++j) { const float a = fmaxf(v0[j], 0.f), b = fmaxf(v1[j], 0.f); v0[j] = a * a; v1[j] = b * b; } }
                    if (MODE >= 2) { const u32x4 g = *(const u32x4*)(gate + row * ldg + c);
                        v0[0] *= sigmoidf_(bf_lo(g.x)); v0[1] *= sigmoidf_(bf_hi(g.x)); v0[2] *= sigmoidf_(bf_lo(g.y)); v0[3] *= sigmoidf_(bf_hi(g.y));
                        v1[0] *= sigmoidf_(bf_lo(g.z)); v1[1] *= sigmoidf_(bf_hi(g.z)); v1[2] *= sigmoidf_(bf_lo(g.w)); v1[3] *= sigmoidf_(bf_hi(g.w)); }
                    if (MODE == 3) { const u32x4 o = *(const u32x4*)(O + row * ldc + c);
                        v0[0] += bf_lo(o.x); v0[1] += bf_hi(o.x); v0[2] += bf_lo(o.y); v0[3] += bf_hi(o.y);
                        v1[0] += bf_lo(o.z); v1[1] += bf_hi(o.z); v1[2] += bf_lo(o.w); v1[3] += bf_hi(o.w); }
                    u32x4 w; w.x = cvt_pk_bf16(v0[0], v0[1]); w.y = cvt_pk_bf16(v0[2], v0[3]); w.z = cvt_pk_bf16(v1[0], v1[1]); w.w = cvt_pk_bf16(v1[2], v1[3]);
                    *(u32x4*)(O + row * ldc + c) = w; } }
    }
};
struct EpiResF32 {
    static constexpr bool PERM = false, AFTER_DRAIN = false;
    float* X; int ldc;
    __device__ __forceinline__ void operator()(const f32x4 (&acc)[2][2][4][2], const Unit& u, int wr, int wc, int fr, int fq) const {
        const int row0 = u.pm * BM + wr * 64 + fr, col0 = u.pn * BM + wc * 32 + 4 * fq;
#pragma unroll
        for (int ai = 0; ai < 2; ++ai)
#pragma unroll
            for (int m = 0; m < 4; ++m) { float* rowp = X + (size_t)(row0 + ai * HALF + m * 16) * ldc + col0;
#pragma unroll
                for (int bj = 0; bj < 2; ++bj)
#pragma unroll
                    for (int n = 0; n < 2; ++n) { f32x4* p = (f32x4*)(rowp + bj * HALF + n * 16); *p = *p + acc[ai][bj][m][n]; } }
    }
};

template <class Epi, class Sched, bool ALIGN_EPI = false, bool SP2 = false>
__device__ __forceinline__ void gemm_phase(PG8_LAS unsigned char* lds, const Gemm g, const Sched& S, const Epi& E) {
    int tid_ = threadIdx.x; asm volatile("" : "+v"(tid_));
    const int tid = tid_, wid = __builtin_amdgcn_readfirstlane(tid >> 6), lane = tid & 63, wr = wid >> 2, wc = wid & 3, fr = lane & 15, fq = lane >> 4;
    const int K = g.K, nt = K / BK;
    unsigned voffA[2], voffB[2];
#pragma unroll
    for (int i = 0; i < 2; ++i) { int R, C; stage_rc(tid * 16 + i * 8192, R, C); const int Rb = Epi::PERM ? ((R & ~31) + perm32(R & 31)) : R;
        voffA[i] = (unsigned)(R * K + C) * 2u; voffB[i] = (unsigned)(Rb * K + C) * 2u; }
    const size_t kstep = (size_t)(BK * 2);
    const size_t hstep = (size_t)HALF * K * 2;
    const size_t tstep = 2 * hstep;
    const unsigned ldsw = (unsigned)wid * 1024u;
    const int aoff = lds_byte(wr * 64 + fr, fq * 8), boff = lds_byte(wc * 32 + fr, fq * 8);
#define PG8_SA(b, h) (((b) * 2 + (h)) * HTB)
#define PG8_SB(b, h) ((4 + (b) * 2 + (h)) * HTB)
#define PG8_STAGE(bufoff, gbase, voff) do { _Pragma("unroll") for (int _i = 0; _i < 2; ++_i) \
        __builtin_amdgcn_global_load_lds((const unsigned*)((const char*)(gbase) + (voff)[_i]), (PG8_LAS unsigned*)(lds + (bufoff) + ldsw + _i * 8192), 16, 0, 0); } while (0)
#define PG8_LDA(dst, b, h) do { _Pragma("unroll") for (int m = 0; m < 4; ++m) _Pragma("unroll") for (int k = 0; k < 2; ++k) dst[m][k] = *(const PG8_LAS bf16x8*)(lds + PG8_SA(b, h) + aoff + m * 2048 + k * 1024); } while (0)
#define PG8_LDB(dst, b, h) do { _Pragma("unroll") for (int n = 0; n < 2; ++n) _Pragma("unroll") for (int k = 0; k < 2; ++k) dst[n][k] = *(const PG8_LAS bf16x8*)(lds + PG8_SB(b, h) + boff + n * 2048 + k * 1024); } while (0)
#define PG8_MMA(ai, bj, At, Bt) do { __builtin_amdgcn_s_setprio(1); _Pragma("unroll") for (int m = 0; m < 4; ++m) _Pragma("unroll") for (int n = 0; n < 2; ++n) _Pragma("unroll") for (int k = 0; k < 2; ++k) \
        acc[ai][bj][m][n] = __builtin_amdgcn_mfma_f32_16x16x32_bf16(Bt[n][k], At[m][k], acc[ai][bj][m][n], 0, 0, 0); __builtin_amdgcn_s_setprio(0); } while (0)
#define PG8_WAIT_V(n) asm volatile("s_waitcnt vmcnt(" #n ")" ::: "memory")
#define PG8_WAIT_L(n) asm volatile("s_waitcnt lgkmcnt(" #n ")" ::: "memory")
#define PG8_BAR __builtin_amdgcn_s_barrier()
#define PG8_SCHED __builtin_amdgcn_sched_barrier(0)
    Unit cur, nxt; int ui = 0;
    if (!S.next(0, cur)) return;
    f32x4 acc[2][2][4][2];
#pragma unroll
    for (int a = 0; a < 2; ++a)
#pragma unroll
        for (int b = 0; b < 2; ++b)
#pragma unroll
            for (int m = 0; m < 4; ++m)
#pragma unroll
                for (int n = 0; n < 2; ++n) acc[a][b][m][n] = (f32x4){0.f, 0.f, 0.f, 0.f};
    bf16x8 At[4][2], B0[2][2], B1[2][2];
    const char* cA = (const char*)g.A + (size_t)cur.pm * tstep; const char* cB = (const char*)g.Bt + (size_t)cur.pn * tstep;
    S.a_ready(cur);
    if constexpr (SP2) {
        PG8_STAGE(PG8_SB(0, 0), cB, voffB); PG8_STAGE(PG8_SB(0, 1), cB + hstep, voffB); PG8_STAGE(PG8_SA(0, 0), cA, voffA); PG8_STAGE(PG8_SA(0, 1), cA + hstep, voffA);
        if (wr == 1) PG8_BAR;
        PG8_WAIT_V(2); PG8_BAR;
        PG8_STAGE(PG8_SB(1, 0), cB + kstep, voffB); PG8_STAGE(PG8_SA(1, 0), cA + kstep, voffA); PG8_STAGE(PG8_SB(1, 1), cB + hstep + kstep, voffB);
        PG8_WAIT_V(6); PG8_BAR;
    } else {
        PG8_STAGE(PG8_SB(0, 0), cB, voffB); PG8_STAGE(PG8_SA(0, 0), cA, voffA); PG8_STAGE(PG8_SB(0, 1), cB + hstep, voffB); PG8_STAGE(PG8_SA(0, 1), cA + hstep, voffA);
        if (wr == 1) PG8_BAR;
        PG8_WAIT_V(4); PG8_BAR;
        PG8_STAGE(PG8_SB(1, 0), cB + kstep, voffB); PG8_STAGE(PG8_SA(1, 0), cA + kstep, voffA); PG8_STAGE(PG8_SB(1, 1), cB + hstep + kstep, voffB);
        PG8_WAIT_V(6); PG8_BAR;
    }
    for (;;) {
        const bool has_next = S.next(ui + 1, nxt);
        const char* nA = has_next ? (const char*)g.A + (size_t)nxt.pm * tstep : cA; const char* nB = has_next ? (const char*)g.Bt + (size_t)nxt.pn * tstep : cB;
        for (int t = 0; t < nt; t += 2) {
            const bool last = (t == nt - 2);
            const char* a1 = cA + (size_t)(t + 1) * kstep;
            const char* a2 = last ? nA : cA + (size_t)(t + 2) * kstep; const char* b2 = last ? nB : cB + (size_t)(t + 2) * kstep;
            const char* a3 = a2 + kstep; const char* b3 = b2 + kstep;
            if (last && has_next) S.a_ready(nxt);
            if constexpr (SP2) {
            PG8_LDB(B0, 0, 0); PG8_LDB(B1, 0, 1); PG8_SCHED; PG8_LDA(At, 0, 0); PG8_STAGE(PG8_SA(1, 1), a1 + hstep, voffA);
            PG8_WAIT_V(8); PG8_WAIT_L(0); PG8_BAR; PG8_MMA(0, 0, At, B0); PG8_MMA(0, 1, At, B1); PG8_BAR; PG8_SCHED;
            PG8_LDA(At, 0, 1); PG8_STAGE(PG8_SB(0, 0), b2, voffB); PG8_STAGE(PG8_SB(0, 1), b2 + hstep, voffB); PG8_STAGE(PG8_SA(0, 0), a2, voffA);
            PG8_WAIT_V(8); PG8_WAIT_L(0); PG8_BAR; PG8_MMA(1, 0, At, B0); PG8_MMA(1, 1, At, B1); PG8_BAR; PG8_SCHED;
            PG8_LDB(B0, 1, 0); PG8_LDB(B1, 1, 1); PG8_SCHED; PG8_LDA(At, 1, 0); PG8_STAGE(PG8_SA(0, 1), a2 + hstep, voffA);
            PG8_WAIT_V(8); PG8_WAIT_L(0); PG8_BAR; PG8_MMA(0, 0, At, B0); PG8_MMA(0, 1, At, B1); PG8_BAR; PG8_SCHED;
            PG8_LDA(At, 1, 1); PG8_STAGE(PG8_SB(1, 0), b3, voffB); PG8_STAGE(PG8_SB(1, 1), b3 + hstep, voffB); PG8_STAGE(PG8_SA(1, 0), a3, voffA);
            PG8_WAIT_V(8); PG8_WAIT_L(0); PG8_BAR; PG8_MMA(1, 0, At, B0); PG8_MMA(1, 1, At, B1); PG8_BAR; PG8_SCHED;
            } else {
            PG8_LDB(B0, 0, 0); PG8_SCHED; PG8_LDA(At, 0, 0); PG8_STAGE(PG8_SA(1, 1), a1 + hstep, voffA);
            PG8_WAIT_L(8); PG8_BAR; PG8_WAIT_L(0); PG8_MMA(0, 0, At, B0); PG8_BAR; PG8_SCHED;
            PG8_LDB(B1, 0, 1); PG8_STAGE(PG8_SB(0, 0), b2, voffB);
            PG8_BAR; PG8_WAIT_L(0); PG8_MMA(0, 1, At, B1); PG8_BAR;
            PG8_LDA(At, 0, 1); PG8_STAGE(PG8_SA(0, 0), a2, voffA);
            PG8_BAR; PG8_WAIT_L(0); PG8_MMA(1, 0, At, B0); PG8_BAR; PG8_SCHED;
            PG8_STAGE(PG8_SB(0, 1), b2 + hstep, voffB);
            PG8_WAIT_V(6); PG8_BAR; PG8_MMA(1, 1, At, B1); PG8_BAR;
            PG8_LDB(B0, 1, 0); PG8_SCHED; PG8_LDA(At, 1, 0); PG8_STAGE(PG8_SA(0, 1), a2 + hstep, voffA);
            PG8_WAIT_L(8); PG8_BAR; PG8_WAIT_L(0); PG8_MMA(0, 0, At, B0); PG8_BAR; PG8_SCHED;
            PG8_LDB(B1, 1, 1); PG8_STAGE(PG8_SB(1, 0), b3, voffB);
            PG8_BAR; PG8_WAIT_L(0); PG8_MMA(0, 1, At, B1); PG8_BAR;
            PG8_LDA(At, 1, 1); PG8_STAGE(PG8_SA(1, 0), a3, voffA);
            PG8_BAR; PG8_WAIT_L(0); PG8_MMA(1, 0, At, B0); PG8_BAR; PG8_SCHED;
            PG8_STAGE(PG8_SB(1, 1), b3 + hstep, voffB);
            PG8_WAIT_V(6); PG8_BAR; PG8_MMA(1, 1, At, B1); PG8_BAR;
            }
        }
        if constexpr (ALIGN_EPI) { if (wr == 0) PG8_BAR; }
        if constexpr (!Epi::AFTER_DRAIN) { E(acc, cur, wr, wc, fr, fq); S.done(cur); }
        if (!has_next) break;
#pragma unroll
        for (int a = 0; a < 2; ++a)
#pragma unroll
            for (int b = 0; b < 2; ++b)
#pragma unroll
                for (int m = 0; m < 4; ++m)
#pragma unroll
                    for (int n = 0; n < 2; ++n) acc[a][b][m][n] = (f32x4){0.f, 0.f, 0.f, 0.f};
        cur = nxt; cA = nA; cB = nB; ++ui;
        if constexpr (ALIGN_EPI) { if (wr == 1) PG8_BAR; }
    }
    PG8_WAIT_V(0);
    if constexpr (!ALIGN_EPI) { if (wr == 0) PG8_BAR; }
    PG8_BAR;
    if constexpr (Epi::AFTER_DRAIN) { E.fused(acc, cur, wr, wc, fr, fq, lds, wid, lane); S.done(cur); }
#undef PG8_SA
#undef PG8_SB
#undef PG8_STAGE
#undef PG8_LDA
#undef PG8_LDB
#undef PG8_MMA
#undef PG8_WAIT_V
#undef PG8_WAIT_L
#undef PG8_BAR
#undef PG8_SCHED
}
}
constexpr int NWAVES = 8;
#ifndef MK_ONE_LAUNCH
#define MK_ONE_LAUNCH 1
#endif

constexpr int BATCH = 2, SEQ = 8192, D = 2048, DEPTH = 4, M = BATCH * SEQ;
constexpr int RETW = 1024, RH = 8, RD = 128, RWW = 1024, WH = 16, WD = 64;
constexpr int INW = 11520, DFF = 8192, RWSHIFT = 3328;
constexpr int ZC_Q = 0, ZC_K = 1024, ZC_V = 2048, ZC_GR = 3072, ZC_RW = 4096, ZC_GA = 7424, ZC_GB = 9472;
constexpr int RWC_R = 0, RWC_K = 1024, RWC_V = 2048, RWC_W = 3072, RWC_A = 3136, RWC_G = 3200;
constexpr float NORM_EPS = 1e-6f, RET_GN_EPS = 1e-5f, RWKV_LN_EPS = 64e-5f;

constexpr size_t MiB = 1u << 20;
constexpr size_t WS_CTL = 0, CTL_ZERO_BYTES = 1 * MiB;
constexpr size_t WS_ROPE = 1 * MiB;
constexpr size_t WS_WIN = 16 * MiB, WS_WA = 61 * MiB, WS_WB = 65 * MiB, WS_WO = 69 * MiB, WS_WUP = 77 * MiB, WS_WDN = 109 * MiB;
constexpr size_t WS_H = 144 * MiB;
constexpr size_t WS_Z = 208 * MiB;
constexpr size_t WS_UP = WS_Z;
constexpr size_t WS_QR = 568 * MiB, WS_KR = 600 * MiB;
constexpr size_t WS_YRET = 632 * MiB, WS_YRWKV = 664 * MiB;
constexpr size_t WS_MRG = 696 * MiB;
constexpr size_t WS_SR = 760 * MiB, WS_SW = 824 * MiB, WS_SK = 888 * MiB, WS_SV = 952 * MiB, WS_SNKK = 1016 * MiB, WS_SKKA = 1080 * MiB;
constexpr size_t WS_G = 1144 * MiB;
constexpr size_t WS_BONUS = 1208 * MiB;
constexpr size_t WS_YRAWR = 1216 * MiB, WS_YRAWW = 1280 * MiB;
constexpr size_t WS_END = 1344 * MiB;
constexpr int CW_BAR = 4096;

constexpr int PPL = 11;
enum { LP_CONV = 0, LP_G1, LP_PREP, LP_SCAN, LP_POST, LP_GA, LP_GB, LP_GO, LP_NORM2, LP_GUP, LP_GDN };
constexpr int PH_PRO = 0, PH_L0 = 1, PH_FIN = PH_L0 + DEPTH * PPL, NPH = PH_FIN + 1;

constexpr int RING_OFF = 0, RING_BYTES = 131072;
constexpr int LDSCTL_OFF = RING_BYTES, MISC_OFF = LDSCTL_OFF + 320;
constexpr int LDS_BYTES = 147456;
static_assert(MISC_OFF + 128 <= LDS_BYTES, "LDS map");

#define GAS __attribute__((address_space(1)))
#define LAS __attribute__((address_space(3)))
typedef unsigned short bf16;
typedef unsigned v4u __attribute__((ext_vector_type(4)));
typedef unsigned v2u __attribute__((ext_vector_type(2)));
typedef float f32x4 __attribute__((ext_vector_type(4)));
typedef float f32x2 __attribute__((ext_vector_type(2)));
typedef short bf16x8 __attribute__((ext_vector_type(8)));
typedef GAS unsigned gu32;
#define LDS_WAIT() asm volatile("s_waitcnt lgkmcnt(0)" ::: "memory")
#define VM_WAIT() asm volatile("s_waitcnt vmcnt(0)" ::: "memory")
__device__ __forceinline__ unsigned f2bf(float f) { unsigned u = __builtin_bit_cast(unsigned, f); return (u + 0x7fffu + ((u >> 16) & 1u)) >> 16; }
__device__ __forceinline__ unsigned pk2(float lo, float hi) { return f2bf(lo) | (f2bf(hi) << 16); }
__device__ __forceinline__ float bf2f(bf16 v) { return __builtin_bit_cast(float, (unsigned)v << 16); }
__device__ __forceinline__ float rdlane(float v, int l) { return __builtin_bit_cast(float, __builtin_amdgcn_readlane(__builtin_bit_cast(int, v), l)); }
__device__ __forceinline__ float sigm(float x) { return 1.0f / (1.0f + expf(-x)); }

__device__ const double ROPE_REV[64] = {
0.15915494309189535, 0.13782250260398285, 0.11934937021124886, 0.10335229661843406,
0.08949940160889101, 0.07750328875537406, 0.06711508300522726, 0.058119267441876246,
0.050329212104487035, 0.04358330210530733, 0.03774158471741977, 0.032682865872357,
0.0283021958306234, 0.024508691862069852, 0.02122365276477766, 0.018378926105679667,
0.015915494309189534, 0.013782250260398284, 0.011934937021124886, 0.010335229661843406,
0.008949940160889102, 0.0077503288755374055, 0.006711508300522725, 0.005811926744187624,
0.005032921210448704, 0.004358330210530733, 0.003774158471741977, 0.0032682865872356993,
0.00283021958306234, 0.002450869186206985, 0.0021223652764777662, 0.0018378926105679667,
0.0015915494309189536, 0.0013782250260398288, 0.0011934937021124885, 0.0010335229661843405,
0.0008949940160889102, 0.0007750328875537405, 0.0006711508300522726, 0.0005811926744187624,
0.0005032921210448703, 0.0004358330210530733, 0.00037741584717419774, 0.0003268286587235699,
0.00028302195830623395, 0.00024508691862069854, 0.0002122365276477766, 0.00018378926105679666,
0.00015915494309189535, 0.00013782250260398286, 0.00011934937021124886, 0.00010335229661843406,
8.949940160889102e-05, 7.750328875537406e-05, 6.711508300522725e-05, 5.811926744187624e-05,
5.0329212104487035e-05, 4.358330210530732e-05, 3.774158471741978e-05, 3.2682865872357e-05,
2.8302195830623396e-05, 2.4508691862069852e-05, 2.122365276477766e-05, 1.8378926105679668e-05 };

#define XB_TMO      128
#define XB_XCNT(j)  (256  + 64 * (j))
#define XB_XSUB(j)  (1280 + 64 * (j))
#define XB_XGEN(j)  (2304 + 64 * (j))
#define XB_TOP      3328
#define XB_TOPGEN   3392
#define XCD_BAR_WORDS 3456
#define XB_SPIN_CAP (1u << 18)

__device__ __forceinline__ unsigned xb_ld(unsigned* p)              { return __hip_atomic_load(p, __ATOMIC_RELAXED, __HIP_MEMORY_SCOPE_AGENT); }
__device__ __forceinline__ unsigned xb_add(unsigned* p, unsigned v) { return __hip_atomic_fetch_add(p, v, __ATOMIC_RELAXED, __HIP_MEMORY_SCOPE_AGENT); }
__device__ __forceinline__ unsigned xb_xcc_id() { return (unsigned)__builtin_amdgcn_s_getreg((3 << 11) | 20) & 0xFu; }
#define XB_SPIN(cond, bar) do { unsigned _sp = 0; while (cond) { __builtin_amdgcn_s_sleep(1); \
    if ((++_sp & 255u) == 0u) { if (xb_ld(&(bar)[XB_TMO])) break; if (_sp > XB_SPIN_CAP) { atomicAdd(&(bar)[XB_TMO], 1u); break; } } } } while (0)

struct XcdBarrier {
    unsigned* bar; unsigned x;
    volatile LAS unsigned* st;
};

__device__ __forceinline__ XcdBarrier xcd_barrier_post(unsigned* bar, volatile LAS unsigned* st) {
    XcdBarrier b; b.bar = bar; b.x = xb_xcc_id(); b.st = st;
    if (threadIdx.x == 0) (void)xb_add(&bar[XB_XCNT(b.x)], 1u);
    return b;
}
__device__ __forceinline__ void xcd_barrier_complete(unsigned* bar, unsigned x, unsigned& nloc, unsigned& nx) {
    const unsigned G = gridDim.x * gridDim.y * gridDim.z;
    unsigned sum, cnt, mine, sp = 0u;
    for (;;) {
        sum = 0u; cnt = 0u; mine = 0u;
#pragma unroll
        for (unsigned j = 0; j < 16; ++j) { const unsigned c = xb_ld(&bar[XB_XCNT(j)]); sum += c; cnt += (c > 0u) ? 1u : 0u; mine = (j == x) ? c : mine; }
        if (sum == G) break;
        __builtin_amdgcn_s_sleep(1);
        if ((++sp & 255u) == 0u) { if (xb_ld(&bar[XB_TMO])) break; if (sp > XB_SPIN_CAP) { atomicAdd(&bar[XB_TMO], 1u); break; } }
    }
    nloc = mine > 0u ? mine : 1u; nx = cnt > 0u ? cnt : 1u;
}

__device__ __forceinline__ void xcd_barrier(const XcdBarrier& b) {
    asm volatile("s_waitcnt vmcnt(0)" ::: "memory");
    __syncthreads();
    if (threadIdx.x == 0) {
        unsigned* bar = b.bar;
        __builtin_amdgcn_s_waitcnt(0);
        unsigned nloc = b.st[0], nx = b.st[1];
        if (nloc == 0u) { xcd_barrier_complete(bar, b.x, nloc, nx); b.st[0] = nloc; b.st[1] = nx; }
        const unsigned old = xb_add(&bar[XB_XSUB(b.x)], 1u);
        const unsigned gen = old / nloc;
        if (old + 1u == (gen + 1u) * nloc) {
            __builtin_amdgcn_fence(__ATOMIC_RELEASE, "agent");
            asm volatile("s_waitcnt vmcnt(0)" ::: "memory");
            const unsigned og = xb_add(&bar[XB_TOP], 1u);
            const unsigned tg = og / nx;
            if (og + 1u == (tg + 1u) * nx) xb_add(&bar[XB_TOPGEN], 1u);
            else XB_SPIN(xb_ld(&bar[XB_TOPGEN]) == tg, bar);
            __builtin_amdgcn_fence(__ATOMIC_ACQUIRE, "agent");
            xb_add(&bar[XB_XGEN(b.x)], 1u);
            asm volatile("s_waitcnt vmcnt(0)" ::: "memory");
        } else {
            XB_SPIN(xb_ld(&bar[XB_XGEN(b.x)]) == gen, bar);
            __builtin_amdgcn_fence(__ATOMIC_ACQUIRE, "agent");
            asm volatile("s_waitcnt vmcnt(0)" ::: "memory");
        }
    }
    __syncthreads();
}


struct Frame {
    LAS unsigned char* lds;
    volatile LAS unsigned* MISC;
    int tid, lane, wave;
    int vcu, G;
    float* out; unsigned char* ws;
};
struct Args { const float* in[24]; float* out; unsigned char* ws; int ph_lo, ph_hi, li, pad; };
#define WSP(T, off) ((T*)(F.ws + (off)))

__device__ __forceinline__ float wave_sum(float v) {
#pragma unroll
    for (int o = 1; o < 64; o <<= 1) v += __shfl_xor(v, o);
    return v;
}
__device__ __forceinline__ void transpose_item(const float* W, int K, int N, bf16* WT, LAS float* scr, int item, int lane) {
    const int nblk = N / 32, kb = item / nblk, nb = item % nblk, k0 = 64 * kb, n0 = 32 * nb;
#pragma unroll 8
    for (int i = 0; i < 32; ++i) { const int kk = 2 * i + (lane >> 5); scr[kk * 33 + (lane & 31)] = W[(size_t)(k0 + kk) * N + n0 + (lane & 31)]; }
    LDS_WAIT(); asm volatile("" ::: "memory");
    const int c = lane & 7;
#pragma unroll
    for (int j = 0; j < 4; ++j) { const int n = (lane >> 3) + 8 * j; const LAS float* s = scr + (8 * c) * 33 + n;
        v4u o; o.x = pk2(s[0 * 33], s[1 * 33]); o.y = pk2(s[2 * 33], s[3 * 33]); o.z = pk2(s[4 * 33], s[5 * 33]); o.w = pk2(s[6 * 33], s[7 * 33]);
        *(GAS v4u*)(WT + (size_t)(n0 + n) * K + k0 + 8 * c) = o; }
    LDS_WAIT(); asm volatile("" ::: "memory");
}
__device__ __forceinline__ void rms_row_to_bf16(const float* xrow, const float* g, bf16* orow, int lane) {
    const GAS f32x4* xr = (const GAS f32x4*)xrow + lane;
    f32x4 v[8]; float s = 0.f;
#pragma unroll
    for (int j = 0; j < 8; ++j) { v[j] = xr[64 * j]; s += (v[j].x * v[j].x + v[j].y * v[j].y) + (v[j].z * v[j].z + v[j].w * v[j].w); }
    const float rstd = 1.f / sqrtf(wave_sum(s) * (1.f / D) + NORM_EPS);
    const GAS f32x4* gr = (const GAS f32x4*)g + lane;
    GAS v2u* o8 = (GAS v2u*)orow + lane;
#pragma unroll
    for (int j = 0; j < 8; ++j) { const f32x4 gg = gr[64 * j]; v2u o; o.x = pk2(v[j].x * rstd * gg.x, v[j].y * rstd * gg.y); o.y = pk2(v[j].z * rstd * gg.z, v[j].w * rstd * gg.w); o8[64 * j] = o; }
}

__device__ __forceinline__ void ph_prologue(Frame& F, const Args& A) {
    const int* pos = (const int*)A.in[1]; float2* rope = WSP(float2, WS_ROPE);
    const size_t n4 = (size_t)M * D / 4;
    const GAS f32x4* src = (const GAS f32x4*)A.in[0]; GAS f32x4* dst = (GAS f32x4*)F.out;
    for (size_t i = (size_t)F.vcu * 512 + F.tid; i < n4; i += (size_t)F.G * 512) dst[i] = src[i];
    for (int i = F.vcu * 512 + F.tid; i < M * 64; i += F.G * 512) {
        const int m = i >> 6, j = i & 63;
        const double rev = (double)pos[m] * ROPE_REV[j];
        const float fr = (float)(rev - __builtin_rint(rev));
        rope[i] = make_float2(__builtin_amdgcn_cosf(fr), __builtin_amdgcn_sinf(fr));
    }
}
__device__ __forceinline__ void ph_convert(Frame& F, const Args& A, int l) {
    LAS float* scr = (LAS float*)(F.lds + RING_OFF + F.wave * 16384);
    const int gw = F.vcu * NWAVES + F.wave, NGW = F.G * NWAVES;
    constexpr int I_IN = (D / 64) * (INW / 32), I_A = (RETW / 64) * (D / 32), I_O = (D / 64) * (D / 32), I_UP = (D / 64) * (DFF / 32), I_DN = (DFF / 64) * (D / 32);
    constexpr int NITEMS = I_IN + 2 * I_A + I_O + I_UP + I_DN;
    for (int it = gw; it < NITEMS; it += NGW) {
        int r = it;
        if (r < I_IN) { transpose_item(A.in[3] + (size_t)l * D * INW, D, INW, WSP(bf16, WS_WIN), scr, r, F.lane); continue; } r -= I_IN;
        if (r < I_A) { transpose_item(A.in[17] + (size_t)l * RETW * D, RETW, D, WSP(bf16, WS_WA), scr, r, F.lane); continue; } r -= I_A;
        if (r < I_A) { transpose_item(A.in[18] + (size_t)l * RWW * D, RWW, D, WSP(bf16, WS_WB), scr, r, F.lane); continue; } r -= I_A;
        if (r < I_O) { transpose_item(A.in[19] + (size_t)l * D * D, D, D, WSP(bf16, WS_WO), scr, r, F.lane); continue; } r -= I_O;
        if (r < I_UP) { transpose_item(A.in[21] + (size_t)l * D * DFF, D, DFF, WSP(bf16, WS_WUP), scr, r, F.lane); continue; } r -= I_UP;
        transpose_item(A.in[22] + (size_t)l * DFF * D, DFF, D, WSP(bf16, WS_WDN), scr, r, F.lane);
    }
}
__device__ __forceinline__ void ph_norm(Frame& F, const float* g) {
    const int gw = F.vcu * NWAVES + F.wave, NGW = F.G * NWAVES;
    for (int m = gw; m < M; m += NGW) rms_row_to_bf16(F.out + (size_t)m * D, g, WSP(bf16, WS_H) + (size_t)m * D, F.lane);
}
__device__ __forceinline__ float zmix(const bf16* zr, const bf16* zp, bool has_prev, const float* mu, int c) {
    const float z = bf2f(zr[c]); const float p = has_prev ? bf2f(zp[c]) : 0.f; return z + mu[c] * (p - z);
}
__device__ __forceinline__ void ph_prep(Frame& F, const Args& A, int l) {
    const int gw = F.vcu * NWAVES + F.wave, NGW = F.G * NWAVES, lane = F.lane;
    LAS float* scr = (LAS float*)(F.lds + RING_OFF + F.wave * 2048);
    const float* mu = A.in[6] + (size_t)l * RWSHIFT; const float* w0 = A.in[7] + (size_t)l * RWW; const float* wup = A.in[8] + (size_t)l * 64 * RWW;
    const float* a0 = A.in[9] + (size_t)l * RWW; const float* aup = A.in[10] + (size_t)l * 64 * RWW; const float* gup = A.in[11] + (size_t)l * 128 * RWW;
    const float* kkw = A.in[12] + (size_t)l * RWW; const float* kaw = A.in[13] + (size_t)l * RWW; const float* rkw = A.in[14] + (size_t)l * RWW;
    for (int m = gw; m < M; m += NGW) {
        const bool has_prev = (m % SEQ) != 0;
        const bf16* zrow = WSP(bf16, WS_Z) + (size_t)m * INW;
        const float2 cs = WSP(float2, WS_ROPE)[(size_t)m * 64 + lane];
#pragma unroll
        for (int h = 0; h < RH; ++h) {
            const float q1 = bf2f(zrow[ZC_Q + h * RD + lane]), q2 = bf2f(zrow[ZC_Q + h * RD + 64 + lane]);
            const float k1 = bf2f(zrow[ZC_K + h * RD + lane]) * 0.08838834764831845f, k2 = bf2f(zrow[ZC_K + h * RD + 64 + lane]) * 0.08838834764831845f;
            bf16* qo = WSP(bf16, WS_QR) + (size_t)m * RETW + h * RD + lane; bf16* ko = WSP(bf16, WS_KR) + (size_t)m * RETW + h * RD + lane;
            qo[0] = (bf16)f2bf(q1 * cs.x - q2 * cs.y); qo[64] = (bf16)f2bf(q2 * cs.x + q1 * cs.y);
            ko[0] = (bf16)f2bf(k1 * cs.x - k2 * cs.y); ko[64] = (bf16)f2bf(k2 * cs.x + k1 * cs.y);
        }
        const bf16* zr = zrow + ZC_RW; const bf16* zp = zr - INW;
        scr[lane] = tanhf(zmix(zr, zp, has_prev, mu, RWC_W + lane));
        scr[64 + lane] = zmix(zr, zp, has_prev, mu, RWC_A + lane);
        scr[128 + lane] = sigm(zmix(zr, zp, has_prev, mu, RWC_G + lane));
        scr[192 + lane] = sigm(zmix(zr, zp, has_prev, mu, RWC_G + 64 + lane));
        LDS_WAIT(); asm volatile("" ::: "memory");
        for (int hh = 0; hh < WH; ++hh) {
            const int c = hh * WD + lane;
            float wl = w0[c], al = a0[c], gl = 0.f;
#pragma unroll 4
            for (int j = 0; j < 64; j += 4) {
                const f32x4 tw = *(const LAS f32x4*)(scr + j), ta = *(const LAS f32x4*)(scr + 64 + j);
                wl += tw.x * wup[(size_t)(j + 0) * RWW + c] + tw.y * wup[(size_t)(j + 1) * RWW + c] + tw.z * wup[(size_t)(j + 2) * RWW + c] + tw.w * wup[(size_t)(j + 3) * RWW + c];
                al += ta.x * aup[(size_t)(j + 0) * RWW + c] + ta.y * aup[(size_t)(j + 1) * RWW + c] + ta.z * aup[(size_t)(j + 2) * RWW + c] + ta.w * aup[(size_t)(j + 3) * RWW + c];
            }
#pragma unroll 4
            for (int j = 0; j < 128; j += 4) {
                const f32x4 tg = *(const LAS f32x4*)(scr + 128 + j);
                gl += tg.x * gup[(size_t)(j + 0) * RWW + c] + tg.y * gup[(size_t)(j + 1) * RWW + c] + tg.z * gup[(size_t)(j + 2) * RWW + c] + tg.w * gup[(size_t)(j + 3) * RWW + c];
            }
            const float yy = -wl;
            const float sp = (yy > 0.f) ? (yy + log1pf(expf(-yy))) : log1pf(expf(yy));
            const float wlog = -sp - 0.5f;
            const float decay = expf(-expf(wlog));
            const float a = sigm(al);
            const float r = zmix(zr, zp, has_prev, mu, RWC_R + c), k = zmix(zr, zp, has_prev, mu, RWC_K + c), v = zmix(zr, zp, has_prev, mu, RWC_V + c);
            const float kkr = k * kkw[c];
            const float nrm = fmaxf(sqrtf(wave_sum(kkr * kkr)), 1e-12f);
            const float kk = kkr / nrm;
            const float kp = k * (1.0f + (a - 1.0f) * kaw[c]);
            const float bonus = wave_sum(r * kp * rkw[c]);
            const size_t o = (size_t)m * RWW + c;
            WSP(float, WS_SR)[o] = r; WSP(float, WS_SW)[o] = decay; WSP(float, WS_SK)[o] = kp; WSP(float, WS_SV)[o] = v; WSP(float, WS_SNKK)[o] = -kk; WSP(float, WS_SKKA)[o] = kk * a; WSP(float, WS_G)[o] = gl;
            if (lane == 0) WSP(float, WS_BONUS)[(size_t)m * WH + hh] = bonus;
        }
        LDS_WAIT(); asm volatile("" ::: "memory");
    }
}
__device__ __forceinline__ void scan_rwkv_naive(Frame& F, int item) {
    const int lane = F.lane;
    float st[64];
#pragma unroll
    for (int j = 0; j < 64; ++j) st[j] = 0.f;
    const size_t base0 = (size_t)(item >> 4) * SEQ * RWW + (size_t)(item & 15) * WD + lane;
    for (int t = 0; t < SEQ; ++t) {
        const size_t o = base0 + (size_t)t * RWW;
        const float r = WSP(float, WS_SR)[o], w = WSP(float, WS_SW)[o], k = WSP(float, WS_SK)[o], v = WSP(float, WS_SV)[o], nk = WSP(float, WS_SNKK)[o], ka = WSP(float, WS_SKKA)[o];
        float sa = 0.f;
#pragma unroll
        for (int j = 0; j < 64; ++j) sa += st[j] * rdlane(nk, j);
        float y = 0.f;
#pragma unroll
        for (int j = 0; j < 64; ++j) { st[j] = st[j] * rdlane(w, j) + sa * rdlane(ka, j) + v * rdlane(k, j); y += st[j] * rdlane(r, j); }
        WSP(float, WS_YRAWW)[o] = y;
    }
}
__device__ __forceinline__ void scan_ret_naive(Frame& F, int item) {
    const int lane = F.lane, b = item >> 4, h = (item >> 1) & 7, half = item & 1;
    const float gam = 1.0f - exp2f((float)(-5 - h));
    float R[128];
#pragma unroll
    for (int j = 0; j < 128; ++j) R[j] = 0.f;
    for (int t = 0; t < SEQ; ++t) {
        const size_t m = (size_t)b * SEQ + t;
        const float q1 = bf2f(WSP(bf16, WS_QR)[m * RETW + h * RD + lane]), q2 = bf2f(WSP(bf16, WS_QR)[m * RETW + h * RD + 64 + lane]);
        const float k1 = bf2f(WSP(bf16, WS_KR)[m * RETW + h * RD + lane]), k2 = bf2f(WSP(bf16, WS_KR)[m * RETW + h * RD + 64 + lane]);
        const float v = bf2f(WSP(bf16, WS_Z)[m * INW + ZC_V + h * RD + half * 64 + lane]);
        float y = 0.f;
#pragma unroll
        for (int d = 0; d < 64; ++d) { R[d] = gam * R[d] + rdlane(k1, d) * v; y += rdlane(q1, d) * R[d]; }
#pragma unroll
        for (int d = 0; d < 64; ++d) { R[64 + d] = gam * R[64 + d] + rdlane(k2, d) * v; y += rdlane(q2, d) * R[64 + d]; }
        WSP(float, WS_YRAWR)[m * RETW + h * RD + half * 64 + lane] = y;
    }
}
constexpr int SCT = 32;
constexpr int SC_ARR = SCT * 64 * 4;
constexpr int SC_BUF = 5 * SC_ARR + SCT * 16 * 4;
static_assert(2 * SC_BUF <= RING_BYTES, "scan LDS");
template <int CTRL> __device__ __forceinline__ float dppf(float x) { return __builtin_bit_cast(float, __builtin_amdgcn_update_dpp(0, __builtin_bit_cast(int, x), CTRL, 0xF, 0xF, true)); }
__device__ __forceinline__ float sum16(float x) {
    x += dppf<0xB1>(x); x += dppf<0x4E>(x); x += dppf<0x141>(x); x += dppf<0x140>(x); return x;
}
__device__ __forceinline__ void scan_rwkv_fast(Frame& F, int w) {
    const int b = w >> 6, hh = (w >> 2) & 15, q = w & 3;
    const int lane = F.lane, wave = F.wave;
    LAS unsigned char* base = F.lds + RING_OFF;
    const size_t g0 = (size_t)b * SEQ * RWW + (size_t)hh * WD;
    constexpr int NBLK = SEQ / SCT;
    if (wave >= 4) {
        const int lt = F.tid - 256;
        const float* a0 = WSP(float, WS_SR) + g0; const float* a1 = WSP(float, WS_SW) + g0; const float* a2 = WSP(float, WS_SK) + g0;
        const float* a3 = WSP(float, WS_SNKK) + g0; const float* a4 = WSP(float, WS_SKKA) + g0; const float* av = WSP(float, WS_SV) + g0 + 16 * q;
        const int f0 = lt, f1 = lt + 256;
        const size_t o0 = (size_t)(f0 >> 4) * RWW + 4 * (f0 & 15), o1 = (size_t)(f1 >> 4) * RWW + 4 * (f1 & 15), ov = (size_t)(lt >> 2) * RWW + 4 * (lt & 3);
        f32x4 r0[5], r1[5], rv;
#define SC_LOAD(blk) do { const size_t tb = (size_t)(blk) * SCT * RWW; \
        r0[0] = *(const GAS f32x4*)(a0 + tb + o0); r1[0] = *(const GAS f32x4*)(a0 + tb + o1); r0[1] = *(const GAS f32x4*)(a1 + tb + o0); r1[1] = *(const GAS f32x4*)(a1 + tb + o1); \
        r0[2] = *(const GAS f32x4*)(a2 + tb + o0); r1[2] = *(const GAS f32x4*)(a2 + tb + o1); r0[3] = *(const GAS f32x4*)(a3 + tb + o0); r1[3] = *(const GAS f32x4*)(a3 + tb + o1); \
        r0[4] = *(const GAS f32x4*)(a4 + tb + o0); r1[4] = *(const GAS f32x4*)(a4 + tb + o1); if (lt < 128) rv = *(const GAS f32x4*)(av + tb + ov); } while (0)
#define SC_STORE(bi) do { LAS unsigned char* bb = base + (bi) * SC_BUF; \
        _Pragma("unroll") for (int a = 0; a < 5; ++a) { *(LAS f32x4*)(bb + a * SC_ARR + f0 * 16) = r0[a]; *(LAS f32x4*)(bb + a * SC_ARR + f1 * 16) = r1[a]; } \
        if (lt < 128) *(LAS f32x4*)(bb + 5 * SC_ARR + lt * 16) = rv; } while (0)
        SC_LOAD(0); SC_STORE(0);
        __syncthreads();
        for (int blk = 0; blk < NBLK; ++blk) {
            if (blk + 1 < NBLK) { SC_LOAD(blk + 1); SC_STORE((blk + 1) & 1); }
            __syncthreads();
        }
#undef SC_LOAD
#undef SC_STORE
    } else {
        const int l16 = lane & 15, rowl = 4 * wave + (lane >> 4);
        GAS float* Y = (GAS float*)(WSP(float, WS_YRAWW) + g0 + 16 * q + rowl);
        f32x4 st = (f32x4){0.f, 0.f, 0.f, 0.f};
        const int lo = l16 * 16, vo = 5 * SC_ARR + rowl * 4;
#define SC_LD(tt_, R4, W4, K4, N4, A4, V) do { R4 = *(const LAS f32x4*)(bb + 0 * SC_ARR + (tt_) * 256 + lo); W4 = *(const LAS f32x4*)(bb + 1 * SC_ARR + (tt_) * 256 + lo); \
        K4 = *(const LAS f32x4*)(bb + 2 * SC_ARR + (tt_) * 256 + lo); N4 = *(const LAS f32x4*)(bb + 3 * SC_ARR + (tt_) * 256 + lo); A4 = *(const LAS f32x4*)(bb + 4 * SC_ARR + (tt_) * 256 + lo); \
        V = *(const LAS float*)(bb + vo + (tt_) * 64); } while (0)
        __syncthreads();
        for (int blk = 0; blk < NBLK; ++blk) {
            const LAS unsigned char* bb = base + (blk & 1) * SC_BUF;
            GAS float* yb = Y + (size_t)blk * SCT * RWW;
            f32x4 r4, w4, k4, n4, a4; float v;
            SC_LD(0, r4, w4, k4, n4, a4, v);
#pragma unroll 8
            for (int tt = 0; tt < SCT; ++tt) {
                f32x4 r4n, w4n, k4n, n4n, a4n; float vn;
                const int tn = (tt + 1 < SCT) ? tt + 1 : tt;
                SC_LD(tn, r4n, w4n, k4n, n4n, a4n, vn);
                const float sap = (st.x * n4.x + st.y * n4.y) + (st.z * n4.z + st.w * n4.w);
                const f32x4 t0 = st * w4 + k4 * v;
                const float sa = sum16(sap);
                st = a4 * sa + t0;
                const float y = sum16((st.x * r4.x + st.y * r4.y) + (st.z * r4.z + st.w * r4.w));
                yb[(size_t)tt * RWW] = y;
                r4 = r4n; w4 = w4n; k4 = k4n; n4 = n4n; a4 = a4n; v = vn;
            }
            __syncthreads();
        }
#undef SC_LD
    }
}
constexpr int RT_STR = 288, RT_QS = 0, RT_KS = 128 * RT_STR, RT_VSTR = 80, RT_VS = 2 * 128 * RT_STR, RT_VPS = RT_VS + 128 * RT_VSTR, RT_RT = RT_VPS + 128 * RT_VSTR, RT_RTSZ = 32 * RT_STR;
static_assert(RT_RT + 2 * RT_RTSZ <= RING_BYTES, "retention LDS");
typedef short s4v __attribute__((ext_vector_type(4)));
__device__ __forceinline__ bf16x8 tr8(const LAS unsigned char* p0, const LAS unsigned char* p1) {
    const s4v a = __builtin_amdgcn_ds_read_tr16_b64_v4i16((LAS s4v*)p0), b = __builtin_amdgcn_ds_read_tr16_b64_v4i16((LAS s4v*)p1);
    return (bf16x8){a.x, a.y, a.z, a.w, b.x, b.y, b.z, b.w};
}
__device__ __forceinline__ void scan_ret_mfma(Frame& F, int w_) {
    const int b = w_ >> 5, h = (w_ >> 2) & 7, eq = w_ & 3;
    const int tid = F.tid, lane = F.lane, w = F.wave, l15 = lane & 15, g = lane >> 4, tq = l15 >> 2, tp = l15 & 3;
    LAS unsigned char* L = F.lds + RING_OFF;
    const float lg2 = log1pf(-exp2f((float)(-5 - h))) * 1.4426950408889634f;
    const float gC = __builtin_amdgcn_exp2f(lg2 * 128.f);
    for (int i = tid; i < RT_RTSZ / 4; i += NWAVES * 64) ((LAS unsigned*)(L + RT_RT))[i] = 0u;
    const GAS bf16* Qg = (const GAS bf16*)(WSP(bf16, WS_QR) + (size_t)b * SEQ * RETW + h * RD);
    const GAS bf16* Kg = (const GAS bf16*)(WSP(bf16, WS_KR) + (size_t)b * SEQ * RETW + h * RD);
    const GAS bf16* Vg = (const GAS bf16*)(WSP(bf16, WS_Z) + (size_t)b * SEQ * INW + ZC_V + h * RD + 32 * eq);
    GAS float* Yg = (GAS float*)(WSP(float, WS_YRAWR) + (size_t)b * SEQ * RETW + h * RD + 32 * eq);
    v4u rq[4], rk[4], rv;
#define RT_LOAD(n_) do { _Pragma("unroll") for (int i = 0; i < 4; ++i) { const int f = tid + 512 * i, c = f >> 4, pc = f & 15; \
        rq[i] = *(const GAS v4u*)(Qg + (size_t)((n_) * 128 + c) * RETW + 8 * pc); rk[i] = *(const GAS v4u*)(Kg + (size_t)((n_) * 128 + c) * RETW + 8 * pc); } \
        rv = *(const GAS v4u*)(Vg + (size_t)((n_) * 128 + (tid >> 2)) * INW + 8 * (tid & 3)); } while (0)
    f32x4 accR[2] = {(f32x4){0.f, 0.f, 0.f, 0.f}, (f32x4){0.f, 0.f, 0.f, 0.f}};
    RT_LOAD(0);
    for (int n = 0; n < SEQ / 128; ++n) {
#pragma unroll
        for (int i = 0; i < 4; ++i) { const int f = tid + 512 * i, c = f >> 4, pc = f & 15;
            *(LAS v4u*)(L + RT_QS + c * RT_STR + pc * 16) = rq[i]; *(LAS v4u*)(L + RT_KS + c * RT_STR + pc * 16) = rk[i]; }
        { const int c = tid >> 2, pc = tid & 3; *(LAS v4u*)(L + RT_VS + c * RT_VSTR + pc * 16) = rv;
          const float sc = __builtin_amdgcn_exp2f(lg2 * (float)(127 - c)); v4u o;
          o.x = pg8::cvt_pk_bf16(pg8::bf_lo(rv.x) * sc, pg8::bf_hi(rv.x) * sc); o.y = pg8::cvt_pk_bf16(pg8::bf_lo(rv.y) * sc, pg8::bf_hi(rv.y) * sc);
          o.z = pg8::cvt_pk_bf16(pg8::bf_lo(rv.z) * sc, pg8::bf_hi(rv.z) * sc); o.w = pg8::cvt_pk_bf16(pg8::bf_lo(rv.w) * sc, pg8::bf_hi(rv.w) * sc);
          *(LAS v4u*)(L + RT_VPS + c * RT_VSTR + pc * 16) = o; }
        __syncthreads();
        if (n + 1 < SEQ / 128) RT_LOAD(n + 1);
        bf16x8 qf[4];
#pragma unroll
        for (int ks = 0; ks < 4; ++ks) qf[ks] = *(const LAS bf16x8*)(L + RT_QS + (16 * w + l15) * RT_STR + (32 * ks + 8 * g) * 2);
        bf16x8 pf[4];
        const int cq = 16 * w + l15;
#pragma unroll
        for (int p = 0; p < 4; ++p) {
            f32x4 s0 = (f32x4){0.f, 0.f, 0.f, 0.f}, s1 = (f32x4){0.f, 0.f, 0.f, 0.f};
            if (2 * p <= w) {
#pragma unroll
                for (int ks = 0; ks < 4; ++ks) { const bf16x8 kf = *(const LAS bf16x8*)(L + RT_KS + (32 * p + l15) * RT_STR + (32 * ks + 8 * g) * 2);
                    s0 = __builtin_amdgcn_mfma_f32_16x16x32_bf16(kf, qf[ks], s0, 0, 0, 0); }
            }
            if (2 * p + 1 <= w) {
#pragma unroll
                for (int ks = 0; ks < 4; ++ks) { const bf16x8 kf = *(const LAS bf16x8*)(L + RT_KS + (32 * p + 16 + l15) * RT_STR + (32 * ks + 8 * g) * 2);
                    s1 = __builtin_amdgcn_mfma_f32_16x16x32_bf16(kf, qf[ks], s1, 0, 0, 0); }
            }
            float p0[4], p1[4];
#pragma unroll
            for (int i = 0; i < 4; ++i) { const int d0 = cq - (32 * p + 4 * g + i), d1 = d0 - 16;
                p0[i] = d0 >= 0 ? s0[i] * __builtin_amdgcn_exp2f(lg2 * (float)d0) : 0.f; p1[i] = d1 >= 0 ? s1[i] * __builtin_amdgcn_exp2f(lg2 * (float)d1) : 0.f; }
            v4u pk; pk.x = pg8::cvt_pk_bf16(p0[0], p0[1]); pk.y = pg8::cvt_pk_bf16(p0[2], p0[3]); pk.z = pg8::cvt_pk_bf16(p1[0], p1[1]); pk.w = pg8::cvt_pk_bf16(p1[2], p1[3]);
            pf[p] = __builtin_bit_cast(bf16x8, pk);
        }
        const LAS unsigned char* Rcur = L + RT_RT + (n & 1) * RT_RTSZ;
#pragma unroll
        for (int et = 0; et < 2; ++et) {
            f32x4 acc = (f32x4){0.f, 0.f, 0.f, 0.f};
#pragma unroll
            for (int ks = 0; ks < 4; ++ks) { const bf16x8 rf = *(const LAS bf16x8*)(Rcur + (16 * et + l15) * RT_STR + (32 * ks + 8 * g) * 2);
                acc = __builtin_amdgcn_mfma_f32_16x16x32_bf16(qf[ks], rf, acc, 0, 0, 0); }
#pragma unroll
            for (int i = 0; i < 4; ++i) acc[i] *= __builtin_amdgcn_exp2f(lg2 * (float)(16 * w + 4 * g + i + 1));
#pragma unroll
            for (int p = 0; p < 4; ++p) if (2 * p <= w) {
                const LAS unsigned char* vb = L + RT_VS + (32 * p + 4 * g + tq) * RT_VSTR + (16 * et + 4 * tp) * 2;
                const bf16x8 vf = tr8(vb, vb + 16 * RT_VSTR);
                acc = __builtin_amdgcn_mfma_f32_16x16x32_bf16(pf[p], vf, acc, 0, 0, 0); }
#pragma unroll
            for (int i = 0; i < 4; ++i) Yg[(size_t)(n * 128 + 16 * w + 4 * g + i) * RETW + 16 * et + l15] = acc[i];
        }
        LAS unsigned char* Rnxt = L + RT_RT + ((n + 1) & 1) * RT_RTSZ;
        accR[0] = accR[0] * gC; accR[1] = accR[1] * gC;
#pragma unroll
        for (int cs = 0; cs < 4; ++cs) {
            const LAS unsigned char* kb = L + RT_KS + (32 * cs + 8 * g + tq) * RT_STR + (16 * w + 4 * tp) * 2;
            const bf16x8 kt = tr8(kb, kb + 4 * RT_STR);
#pragma unroll
            for (int et = 0; et < 2; ++et) { const LAS unsigned char* vb = L + RT_VPS + (32 * cs + 8 * g + tq) * RT_VSTR + (16 * et + 4 * tp) * 2;
                const bf16x8 vt = tr8(vb, vb + 4 * RT_VSTR);
                accR[et] = __builtin_amdgcn_mfma_f32_16x16x32_bf16(kt, vt, accR[et], 0, 0, 0); }
        }
#pragma unroll
        for (int et = 0; et < 2; ++et) { v2u o; o.x = pg8::cvt_pk_bf16(accR[et][0], accR[et][1]); o.y = pg8::cvt_pk_bf16(accR[et][2], accR[et][3]);
            *(LAS v2u*)(Rnxt + (16 * et + l15) * RT_STR + (16 * w + 4 * g) * 2) = o; }
        __syncthreads();
    }
#undef RT_LOAD
}
__device__ __forceinline__ void ph_scan(Frame& F) {
    if (F.G >= 160) {
        if (F.vcu < 128) scan_rwkv_fast(F, F.vcu);
        else if (F.vcu < 192) scan_ret_mfma(F, F.vcu - 128);
    } else {
        const int gw = F.vcu * NWAVES + F.wave, NGW = F.G * NWAVES;
        const int stride = NGW >= 64 ? NGW / 64 : 1;
        if (gw % stride == 0) {
            for (int item = gw / stride; item < 64; item += (NGW + stride - 1) / stride) {
                if (item < 32) scan_rwkv_naive(F, item); else scan_ret_naive(F, item - 32);
            }
        }
    }
}
__device__ __forceinline__ void ph_post(Frame& F, const Args& A, int l) {
    const int gw = F.vcu * NWAVES + F.wave, NGW = F.G * NWAVES, lane = F.lane;
    const float* gng = A.in[4] + (size_t)l * RETW; const float* gnb = A.in[5] + (size_t)l * RETW;
    const float* lng = A.in[15] + (size_t)l * RWW; const float* lnb = A.in[16] + (size_t)l * RWW;
    for (int m = gw; m < M; m += NGW) {
        const bf16* zrow = WSP(bf16, WS_Z) + (size_t)m * INW;
#pragma unroll
        for (int h = 0; h < RH; ++h) {
            const int c = h * RD + lane;
            const float y1 = WSP(float, WS_YRAWR)[(size_t)m * RETW + c], y2 = WSP(float, WS_YRAWR)[(size_t)m * RETW + c + 64];
            const float mean = wave_sum(y1 + y2) * (1.f / RD);
            const float d1 = y1 - mean, d2 = y2 - mean;
            const float rstd = 1.f / sqrtf(wave_sum(d1 * d1 + d2 * d2) * (1.f / RD) + RET_GN_EPS);
            const float g1 = bf2f(zrow[ZC_GR + c]), g2 = bf2f(zrow[ZC_GR + c + 64]);
            const float o1 = (d1 * rstd * gng[c] + gnb[c]) * (g1 * sigm(g1)), o2 = (d2 * rstd * gng[c + 64] + gnb[c + 64]) * (g2 * sigm(g2));
            WSP(bf16, WS_YRET)[(size_t)m * RETW + c] = (bf16)f2bf(o1); WSP(bf16, WS_YRET)[(size_t)m * RETW + c + 64] = (bf16)f2bf(o2);
        }
#pragma unroll
        for (int hh = 0; hh < WH; ++hh) {
            const int c = hh * WD + lane; const size_t o = (size_t)m * RWW + c;
            const float y = WSP(float, WS_YRAWW)[o];
            const float mean = wave_sum(y) * (1.f / WD);
            const float d = y - mean;
            const float rstd = 1.f / sqrtf(wave_sum(d * d) * (1.f / WD) + RWKV_LN_EPS);
            float yn = d * rstd * lng[c] + lnb[c];
            yn += WSP(float, WS_BONUS)[(size_t)m * WH + hh] * WSP(float, WS_SV)[o];
            WSP(bf16, WS_YRWKV)[o] = (bf16)f2bf(yn * WSP(float, WS_G)[o]);
        }
    }
}
__device__ __forceinline__ void ph_final(Frame& F, const Args& A) {
    const int gw = F.vcu * NWAVES + F.wave, NGW = F.G * NWAVES, lane = F.lane;
    const GAS f32x4* gr = (const GAS f32x4*)A.in[23] + lane;
    for (int m = gw; m < M; m += NGW) {
        GAS f32x4* xr = (GAS f32x4*)(F.out + (size_t)m * D) + lane;
        f32x4 v[8]; float s = 0.f;
#pragma unroll
        for (int j = 0; j < 8; ++j) { v[j] = xr[64 * j]; s += (v[j].x * v[j].x + v[j].y * v[j].y) + (v[j].z * v[j].z + v[j].w * v[j].w); }
        const float rstd = 1.f / sqrtf(wave_sum(s) * (1.f / D) + NORM_EPS);
#pragma unroll
        for (int j = 0; j < 8; ++j) xr[64 * j] = v[j] * rstd * gr[64 * j];
    }
}

__global__ void __launch_bounds__(NWAVES * 64, 2) hybrid_fwd(Args args) {
    extern __shared__ __attribute__((aligned(16))) unsigned char lds[];
    Frame F;
    F.lds = (LAS unsigned char*)lds;
    F.MISC = (volatile LAS unsigned*)(F.lds + MISC_OFF);
    F.tid = threadIdx.x; F.lane = F.tid & 63; F.wave = __builtin_amdgcn_readfirstlane(F.tid >> 6);
    int bx = blockIdx.x; F.G = gridDim.x; { F.vcu = (F.G % 8 == 0) ? (bx % 8) * (F.G / 8) + bx / 8 : bx; }
    F.ws = args.ws; F.out = args.out;
    for (int u = F.tid; u < (LDS_BYTES - LDSCTL_OFF) / 4; u += NWAVES * 64) ((LAS unsigned*)(F.lds + LDSCTL_OFF))[u] = 0u;
    __syncthreads();
    XcdBarrier bar = xcd_barrier_post((unsigned*)(F.ws + WS_CTL) + CW_BAR, F.MISC + 8);

    const int lo = args.ph_lo, hi = args.ph_hi;
#define IN(k) (lo <= (k) && (k) < hi)
#define SEAM(k) do { if (IN(k) && IN((k) + 1)) xcd_barrier(bar); else __syncthreads(); } while (0)

    if (IN(PH_PRO)) { ph_prologue(F, args); }
    SEAM(PH_PRO);
    for (int l = 0; l < DEPTH; ++l) {
        const int p0 = PH_L0 + l * PPL;
        asm volatile("" : "+s"(F.ws), "+s"(F.out), "+s"(F.G), "+s"(F.vcu), "+s"(bx), "+s"(F.wave), "+v"(F.tid), "+v"(F.lane) :: "memory");
        if (IN(p0 + LP_CONV)) { ph_convert(F, args, l); ph_norm(F, args.in[2] + (size_t)l * D); }
        SEAM(p0 + LP_CONV);
        if (IN(p0 + LP_G1)) {
            pg8::Gemm g{WSP(bf16, WS_H), WSP(bf16, WS_WIN), M, INW, D}; pg8::StaticOrder S; S.init(M, INW, F.G, bx);
            pg8::EpiB<0> E{WSP(bf16, WS_Z), INW, nullptr, 0};
            pg8::gemm_phase<pg8::EpiB<0>, pg8::StaticOrder, true, true>(F.lds + RING_OFF, g, S, E);
        }
        SEAM(p0 + LP_G1);
        if (IN(p0 + LP_PREP)) { ph_prep(F, args, l); }
        SEAM(p0 + LP_PREP);
        if (IN(p0 + LP_SCAN)) { ph_scan(F); }
        SEAM(p0 + LP_SCAN);
        if (IN(p0 + LP_POST)) { ph_post(F, args, l); }
        SEAM(p0 + LP_POST);
        if (IN(p0 + LP_GA)) {
            pg8::Gemm g{WSP(bf16, WS_YRET), WSP(bf16, WS_WA), M, D, RETW}; pg8::StaticOrder S; S.init(M, D, F.G, bx);
            pg8::EpiB<2> E{WSP(bf16, WS_MRG), D, WSP(bf16, WS_Z) + ZC_GA, INW};
            pg8::gemm_phase<pg8::EpiB<2>, pg8::StaticOrder, true, true>(F.lds + RING_OFF, g, S, E);
        }
        SEAM(p0 + LP_GA);
        if (IN(p0 + LP_GB)) {
            pg8::Gemm g{WSP(bf16, WS_YRWKV), WSP(bf16, WS_WB), M, D, RWW}; pg8::StaticOrder S; S.init(M, D, F.G, bx);
            pg8::EpiB<3> E{WSP(bf16, WS_MRG), D, WSP(bf16, WS_Z) + ZC_GB, INW};
            pg8::gemm_phase<pg8::EpiB<3>, pg8::StaticOrder, true, true>(F.lds + RING_OFF, g, S, E);
        }
        SEAM(p0 + LP_GB);
        if (IN(p0 + LP_GO)) {
            pg8::Gemm g{WSP(bf16, WS_MRG), WSP(bf16, WS_WO), M, D, D}; pg8::StaticOrder S; S.init(M, D, F.G, bx);
            pg8::EpiResF32 E{F.out, D};
            pg8::gemm_phase<pg8::EpiResF32, pg8::StaticOrder, true, true>(F.lds + RING_OFF, g, S, E);
        }
        SEAM(p0 + LP_GO);
        if (IN(p0 + LP_NORM2)) { ph_norm(F, args.in[20] + (size_t)l * D); }
        SEAM(p0 + LP_NORM2);
        if (IN(p0 + LP_GUP)) {
            pg8::Gemm g{WSP(bf16, WS_H), WSP(bf16, WS_WUP), M, DFF, D}; pg8::StaticOrder S; S.init(M, DFF, F.G, bx);
            pg8::EpiB<1> E{WSP(bf16, WS_UP), DFF, nullptr, 0};
            pg8::gemm_phase<pg8::EpiB<1>, pg8::StaticOrder, true, true>(F.lds + RING_OFF, g, S, E);
        }
        SEAM(p0 + LP_GUP);
        if (IN(p0 + LP_GDN)) {
            pg8::Gemm g{WSP(bf16, WS_UP), WSP(bf16, WS_WDN), M, D, DFF}; pg8::StaticOrder S; S.init(M, D, F.G, bx);
            pg8::EpiResF32 E{F.out, D};
            pg8::gemm_phase<pg8::EpiResF32, pg8::StaticOrder, true, true>(F.lds + RING_OFF, g, S, E);
        }
        SEAM(p0 + LP_GDN);
    }
    if (IN(PH_FIN)) { ph_final(F, args); }
#undef IN
#undef SEAM
}

extern "C" void kernel_launch(void* const* d_in, const int* in_sizes, int n_in, void* d_out, int out_size, void* d_ws, size_t ws_size, hipStream_t stream) {
    static int grid = 0;
    if (grid == 0) {
        if (n_in != 24 || in_sizes[0] != M * D || out_size != M * D || ws_size < WS_END) { fprintf(stderr, "kernel_launch: built for 24 inputs, x and out of %d floats, >= %zu bytes of workspace; got n_in %d, in0 %d, out %d, ws %zu; nothing launched\n", M * D, (size_t)WS_END, n_in, n_in > 0 ? in_sizes[0] : -1, out_size, ws_size); grid = -1; return; }
        int dev = 0, cus = 0, per_cu = 0;
        if (hipGetDevice(&dev) != hipSuccess || hipDeviceGetAttribute(&cus, hipDeviceAttributeMultiprocessorCount, dev) != hipSuccess) { fprintf(stderr, "kernel_launch: hipGetDevice / hipDeviceGetAttribute failed; nothing launched\n"); grid = -1; return; }
        if (hipFuncSetAttribute((const void*)hybrid_fwd, hipFuncAttributeMaxDynamicSharedMemorySize, LDS_BYTES) != hipSuccess) { fprintf(stderr, "kernel_launch: hipFuncSetAttribute failed\n"); grid = -1; return; }
        if (hipOccupancyMaxActiveBlocksPerMultiprocessor(&per_cu, (const void*)hybrid_fwd, NWAVES * 64, LDS_BYTES) != hipSuccess || per_cu < 1)
            fprintf(stderr, "kernel_launch: note: the occupancy query reports %d workgroups per CU\n", per_cu);
        (void)hipGetLastError();
        grid = cus;
    }
    if (grid < 0) return;
    if (hipMemsetAsync((char*)d_ws + WS_CTL, 0, CTL_ZERO_BYTES, stream) != hipSuccess) { fprintf(stderr, "kernel_launch: hipMemsetAsync failed\n"); return; }
    Args a{};
    for (int i = 0; i < 24; ++i) a.in[i] = (const float*)d_in[i];
    a.out = (float*)d_out; a.ws = (unsigned char*)d_ws; a.li = 0; a.pad = 0;
#if MK_ONE_LAUNCH
    a.ph_lo = 0; a.ph_hi = NPH;
    hipLaunchKernelGGL(hybrid_fwd, dim3(grid), dim3(NWAVES * 64), LDS_BYTES, stream, a);
#else
    for (int p = 0; p < NPH; ++p) {
        a.ph_lo = p; a.ph_hi = p + 1;
        hipLaunchKernelGGL(hybrid_fwd, dim3(grid), dim3(NWAVES * 64), LDS_BYTES, stream, a);
    }
#endif
    const hipError_t le = hipPeekAtLastError();
    if (le != hipSuccess) fprintf(stderr, "kernel_launch: launch failed: %s\n", hipGetErrorName(le));
}
```

```cpp
#include <hip/hip_runtime.h>
#include <cstdio>
#include <cstdint>
namespace pg8 {
#define PG8_LAS __attribute__((address_space(3)))
typedef unsigned short bf16_t;
typedef short bf16x8 __attribute__((ext_vector_type(8)));
typedef float f32x4 __attribute__((ext_vector_type(4)));
typedef unsigned u32x4 __attribute__((ext_vector_type(4)));
constexpr int BM = 256, BK = 64, HALF = 128, HTB = HALF * BK * 2  , STAGE_BYTES = 8 * HTB, NXCD = 8, WGM = 8;

__host__ __device__ __forceinline__ int lds_byte(int r, int c) { const int st = (r >> 4) * 2 + (c >> 5), rr = r & 15, cc = c & 31, ob = rr * 64 + cc * 2; return st * 1024 + (ob ^ (((ob >> 9) & 1) << 5)); }
__host__ __device__ __forceinline__ void stage_rc(int b, int& R, int& C) { const int st = b / 1024, sb = b % 1024, swz = sb ^ (((sb >> 9) & 1) << 5); R = (st >> 1) * 16 + swz / 64; C = (st & 1) * 32 + (swz % 64) / 2; }
__host__ __device__ __forceinline__ int perm32(int rho) { const int n = rho >> 4, i = rho & 15; return 8 * (i >> 2) + 4 * n + (i & 3); }

struct Unit { int pm, pn; };
struct Gemm { const bf16_t* A; const bf16_t* Bt; int M, N, K; };

struct StaticOrder {
    int nM, nN, nwg, G, c;
    __host__ __device__ void init(int M, int N, int G_, int c_) { nM = M / BM; nN = N / BM; nwg = nM * nN; G = G_; c = c_; }
    __host__ __device__ bool next(int i, Unit& u) const {
        const long L = (long)i * G + c; if (L >= nwg) return false;
        int wgid = (int)L; { const int q = nwg / NXCD, r = nwg % NXCD, xcd = wgid % NXCD, off = wgid / NXCD; wgid = (xcd < r ? xcd * (q + 1) : r * (q + 1) + (xcd - r) * q) + off; }
        const int nig = WGM * nN, gid = wgid / nig, fm = gid * WGM, gsz = (nM - fm) < WGM ? (nM - fm) : WGM;
        u.pm = fm + ((wgid % nig) % gsz); u.pn = (wgid % nig) / gsz; return true;
    }
    __device__ __forceinline__ void a_ready(const Unit&) const {}
    __device__ __forceinline__ void done(const Unit&) const {}
};

__device__ __forceinline__ unsigned cvt_pk_bf16(float lo, float hi) { unsigned r; asm volatile("v_cvt_pk_bf16_f32 %0, %1, %2" : "=v"(r) : "v"(lo), "v"(hi)); return r; }
typedef float f32x2 __attribute__((ext_vector_type(2)));
__device__ __forceinline__ float bf_lo(unsigned w) { return __builtin_bit_cast(float, w << 16); }
__device__ __forceinline__ float bf_hi(unsigned w) { return __builtin_bit_cast(float, w & 0xffff0000u); }
__device__ __forceinline__ float sigmoidf_(float x) { return 1.0f / (1.0f + __expf(-x)); }
template <int MODE> struct EpiB {
    static constexpr bool PERM = true, AFTER_DRAIN = false;
    bf16_t* O; int ldc; const bf16_t* gate; int ldg;
    __device__ __forceinline__ void operator()(const f32x4 (&acc)[2][2][4][2], const Unit& u, int wr, int wc, int fr, int fq) const {
        const int row0 = u.pm * BM + wr * 64 + fr, col0 = u.pn * BM + wc * 32 + 8 * fq;
#pragma unroll
        for (int ai = 0; ai < 2; ++ai)
#pragma unroll
            for (int m = 0; m < 4; ++m) { const size_t row = (size_t)(row0 + ai * HALF + m * 16);
#pragma unroll
                for (int bj = 0; bj < 2; ++bj) { f32x4 v0 = acc[ai][bj][m][0], v1 = acc[ai][bj][m][1]; const int c = col0 + bj * HALF;
                    if (MODE == 1) {
#pragma unroll
                        for (int j = 0; j < 4; ++j) { const float a = fmaxf(v0[j], 0.f), b = fmaxf(v1[j], 0.f); v0[j] = a * a; v1[j] = b * b; } }
                    if (MODE >= 2) { const u32x4 g = *(const u32x4*)(gate + row * ldg + c);
                        v0[0] *= sigmoidf_(bf_lo(g.x)); v0[1] *= sigmoidf_(bf_hi(g.x)); v0[2] *= sigmoidf_(bf_lo(g.y)); v0[3] *= sigmoidf_(bf_hi(g.y));
                        v1[0] *= sigmoidf_(bf_lo(g.z)); v1[1] *= sigmoidf_(bf_hi(g.z)); v1[2] *= sigmoidf_(bf_lo(g.w)); v1[3] *= sigmoidf_(bf_hi(g.w)); }
                    if (MODE == 3) { const u32x4 o = *(const u32x4*)(O + row * ldc + c);
                        v0[0] += bf_lo(o.x); v0[1] += bf_hi(o.x); v0[2] += bf_lo(o.y); v0[3] += bf_hi(o.y);
                        v1[0] += bf_lo(o.z); v1[1] += bf_hi(o.z); v1[2] += bf_lo(o.w); v1[3] += bf_hi(o.w); }
                    u32x4 w; w.x = cvt_pk_bf16(v0[0], v0[1]); w.y = cvt_pk_bf16(v0[2], v0[3]); w.z = cvt_pk_bf16(v1[0], v1[1]); w.w = cvt_pk_bf16(v1[2], v1[3]);
                    *(u32x4*)(O + row * ldc + c) = w; } }
    }
};
struct EpiResF32 {
    static constexpr bool PERM = false, AFTER_DRAIN = false;
    float* X; int ldc;
    __device__ __forceinline__ void operator()(const f32x4 (&acc)[2][2][4][2], const Unit& u, int wr, int wc, int fr, int fq) const {
        const int row0 = u.pm * BM + wr * 64 + fr, col0 = u.pn * BM + wc * 32 + 4 * fq;
#pragma unroll
        for (int ai = 0; ai < 2; ++ai)
#pragma unroll
            for (int m = 0; m < 4; ++m) { float* rowp = X + (size_t)(row0 + ai * HALF + m * 16) * ldc + col0;
#pragma unroll
                for (int bj = 0; bj < 2; ++bj)
#pragma unroll
                    for (int n = 0; n < 2; ++n) { f32x4* p = (f32x4*)(rowp + bj * HALF + n * 16); *p = *p + acc[ai][bj][m][n]; } }
    }
};

template <class Epi, class Sched, bool ALIGN_EPI = false, bool SP2 = false>
__device__ __forceinline__ void gemm_phase(PG8_LAS unsigned char* lds, const Gemm g, const Sched& S, const Epi& E) {
    int tid_ = threadIdx.x; asm volatile("" : "+v"(tid_));
    const int tid = tid_, wid = __builtin_amdgcn_readfirstlane(tid >> 6), lane = tid & 63, wr = wid >> 2, wc = wid & 3, fr = lane & 15, fq = lane >> 4;
    const int K = g.K, nt = K / BK;
    unsigned voffA[2], voffB[2];
#pragma unroll
    for (int i = 0; i < 2; ++i) { int R, C; stage_rc(tid * 16 + i * 8192, R, C); const int Rb = Epi::PERM ? ((R & ~31) + perm32(R & 31)) : R;
        voffA[i] = (unsigned)(R * K + C) * 2u; voffB[i] = (unsigned)(Rb * K + C) * 2u; }
    const size_t kstep = (size_t)(BK * 2);
    const size_t hstep = (size_t)HALF * K * 2;
    const size_t tstep = 2 * hstep;
    const unsigned ldsw = (unsigned)wid * 1024u;
    const int aoff = lds_byte(wr * 64 + fr, fq * 8), boff = lds_byte(wc * 32 + fr, fq * 8);
#define PG8_SA(b, h) (((b) * 2 + (h)) * HTB)
#define PG8_SB(b, h) ((4 + (b) * 2 + (h)) * HTB)
#define PG8_STAGE(bufoff, gbase, voff) do { _Pragma("unroll") for (int _i = 0; _i < 2; ++_i) \
        __builtin_amdgcn_global_load_lds((const unsigned*)((const char*)(gbase) + (voff)[_i]), (PG8_LAS unsigned*)(lds + (bufoff) + ldsw + _i * 8192), 16, 0, 0); } while (0)
#define PG8_LDA(dst, b, h) do { _Pragma("unroll") for (int m = 0; m < 4; ++m) _Pragma("unroll") for (int k = 0; k < 2; ++k) dst[m][k] = *(const PG8_LAS bf16x8*)(lds + PG8_SA(b, h) + aoff + m * 2048 + k * 1024); } while (0)
#define PG8_LDB(dst, b, h) do { _Pragma("unroll") for (int n = 0; n < 2; ++n) _Pragma("unroll") for (int k = 0; k < 2; ++k) dst[n][k] = *(const PG8_LAS bf16x8*)(lds + PG8_SB(b, h) + boff + n * 2048 + k * 1024); } while (0)
#define PG8_MMA(ai, bj, At, Bt) do { __builtin_amdgcn_s_setprio(1); _Pragma("unroll") for (int m = 0; m < 4; ++m) _Pragma("unroll") for (int n = 0; n < 2; ++n) _Pragma("unroll") for (int k = 0; k < 2; ++k) \
        acc[ai][bj][m][n] = __builtin_amdgcn_mfma_f32_16x16x32_bf16(Bt[n][k], At[m][k], acc[ai][bj][m][n], 0, 0, 0); __builtin_amdgcn_s_setprio(0); } while (0)
#define PG8_WAIT_V(n) asm volatile("s_waitcnt vmcnt(" #n ")" ::: "memory")
#define PG8_WAIT_L(n) asm volatile("s_waitcnt lgkmcnt(" #n ")" ::: "memory")
#define PG8_BAR __builtin_amdgcn_s_barrier()
#define PG8_SCHED __builtin_amdgcn_sched_barrier(0)
    Unit cur, nxt; int ui = 0;
    if (!S.next(0, cur)) return;
    f32x4 acc[2][2][4][2];
#pragma unroll
    for (int a = 0; a < 2; ++a)
#pragma unroll
        for (int b = 0; b < 2; ++b)
#pragma unroll
            for (int m = 0; m < 4; ++m)
#pragma unroll
                for (int n = 0; n < 2; ++n) acc[a][b][m][n] = (f32x4){0.f, 0.f, 0.f, 0.f};
    bf16x8 At[4][2], B0[2][2], B1[2][2];
    const char* cA = (const char*)g.A + (size_t)cur.pm * tstep; const char* cB = (const char*)g.Bt + (size_t)cur.pn * tstep;
    S.a_ready(cur);
    if constexpr (SP2) {
        PG8_STAGE(PG8_SB(0, 0), cB, voffB); PG8_STAGE(PG8_SB(0, 1), cB + hstep, voffB); PG8_STAGE(PG8_SA(0, 0), cA, voffA); PG8_STAGE(PG8_SA(0, 1), cA + hstep, voffA);
        if (wr == 1) PG8_BAR;
        PG8_WAIT_V(2); PG8_BAR;
        PG8_STAGE(PG8_SB(1, 0), cB + kstep, voffB); PG8_STAGE(PG8_SA(1, 0), cA + kstep, voffA); PG8_STAGE(PG8_SB(1, 1), cB + hstep + kstep, voffB);
        PG8_WAIT_V(6); PG8_BAR;
    } else {
        PG8_STAGE(PG8_SB(0, 0), cB, voffB); PG8_STAGE(PG8_SA(0, 0), cA, voffA); PG8_STAGE(PG8_SB(0, 1), cB + hstep, voffB); PG8_STAGE(PG8_SA(0, 1), cA + hstep, voffA);
        if (wr == 1) PG8_BAR;
        PG8_WAIT_V(4); PG8_BAR;
        PG8_STAGE(PG8_SB(1, 0), cB + kstep, voffB); PG8_STAGE(PG8_SA(1, 0), cA + kstep, voffA); PG8_STAGE(PG8_SB(1, 1), cB + hstep + kstep, voffB);
        PG8_WAIT_V(6); PG8_BAR;
    }
    for (;;) {
        const bool has_next = S.next(ui + 1, nxt);
        const char* nA = has_next ? (const char*)g.A + (size_t)nxt.pm * tstep : cA; const char* nB = has_next ? (const char*)g.Bt + (size_t)nxt.pn * tstep : cB;
        for (int t = 0; t < nt; t += 2) {
            const bool last = (t == nt - 2);
            const char* a1 = cA + (size_t)(t + 1) * kstep;
            const char* a2 = last ? nA : cA + (size_t)(t + 2) * kstep; const char* b2 = last ? nB : cB + (size_t)(t + 2) * kstep;
            const char* a3 = a2 + kstep; const char* b3 = b2 + kstep;
            if (last && has_next) S.a_ready(nxt);
            if constexpr (SP2) {
            PG8_LDB(B0, 0, 0); PG8_LDB(B1, 0, 1); PG8_SCHED; PG8_LDA(At, 0, 0); PG8_STAGE(PG8_SA(1, 1), a1 + hstep, voffA);
            PG8_WAIT_V(8); PG8_WAIT_L(0); PG8_BAR; PG8_MMA(0, 0, At, B0); PG8_MMA(0, 1, At, B1); PG8_BAR; PG8_SCHED;
            PG8_LDA(At, 0, 1); PG8_STAGE(PG8_SB(0, 0), b2, voffB); PG8_STAGE(PG8_SB(0, 1), b2 + hstep, voffB); PG8_STAGE(PG8_SA(0, 0), a2, voffA);
            PG8_WAIT_V(8); PG8_WAIT_L(0); PG8_BAR; PG8_MMA(1, 0, At, B0); PG8_MMA(1, 1, At, B1); PG8_BAR; PG8_SCHED;
            PG8_LDB(B0, 1, 0); PG8_LDB(B1, 1, 1); PG8_SCHED; PG8_LDA(At, 1, 0); PG8_STAGE(PG8_SA(0, 1), a2 + hstep, voffA);
            PG8_WAIT_V(8); PG8_WAIT_L(0); PG8_BAR; PG8_MMA(0, 0, At, B0); PG8_MMA(0, 1, At, B1); PG8_BAR; PG8_SCHED;
            PG8_LDA(At, 1, 1); PG8_STAGE(PG8_SB(1, 0), b3, voffB); PG8_STAGE(PG8_SB(1, 1), b3 + hstep, voffB); PG8_STAGE(PG8_SA(1, 0), a3, voffA);
            PG8_WAIT_V(8); PG8_WAIT_L(0); PG8_BAR; PG8_MMA(1, 0, At, B0); PG8_MMA(1, 1, At, B1); PG8_BAR; PG8_SCHED;
            } else {
            PG8_LDB(B0, 0, 0); PG8_SCHED; PG8_LDA(At, 0, 0); PG8_STAGE(PG8_SA(1, 1), a1 + hstep, voffA);
            PG8_WAIT_L(8); PG8_BAR; PG8_WAIT_L(0); PG8_MMA(0, 0, At, B0); PG8_BAR; PG8_SCHED;
            PG8_LDB(B1, 0, 1); PG8_STAGE(PG8_SB(0, 0), b2, voffB);
            PG8_BAR; PG8_WAIT_L(0); PG8_MMA(0, 1, At, B1); PG8_BAR;
            PG8_LDA(At, 0, 1); PG8_STAGE(PG8_SA(0, 0), a2, voffA);
            PG8_BAR; PG8_WAIT_L(0); PG8_MMA(1, 0, At, B0); PG8_BAR; PG8_SCHED;
            PG8_STAGE(PG8_SB(0, 1), b2 + hstep, voffB);
            PG8_WAIT_V(6); PG8_BAR; PG8_MMA(1, 1, At, B1); PG8_BAR;
            PG8_LDB(B0, 1, 0); PG8_SCHED; PG8_LDA(At, 1, 0); PG8_STAGE(PG8_SA(0, 1), a2 + hstep, voffA);
            PG8_WAIT_L(8); PG8_BAR; PG8_WAIT_L(0); PG8_MMA(0, 0, At, B0); PG8_BAR; PG8_SCHED;
            PG8_LDB(B1, 1, 1); PG8_STAGE(PG8_SB(1, 0), b3, voffB);
            PG8_BAR; PG8_WAIT_L(0); PG8_MMA(0, 1, At, B1); PG8_BAR;
            PG8_LDA(At, 1, 1); PG8_STAGE(PG8_SA(1, 0), a3, voffA);
            PG8_BAR; PG8_WAIT_L(0); PG8_MMA(1, 0, At, B0); PG8_BAR; PG8_SCHED;
            PG8_STAGE(PG8_SB(1, 1), b3 + hstep, voffB);
            PG8_WAIT_V(6); PG8_BAR; PG8_MMA(1, 1, At, B1); PG8_BAR;
            }
        }
        if constexpr (ALIGN_EPI) { if (wr == 0) PG8_BAR; }
        if constexpr (!Epi::AFTER_DRAIN) { E(acc, cur, wr, wc, fr, fq); S.done(cur); }
        if (!has_next) break;
#pragma unroll
        for (int a = 0; a < 2; ++a)
#pragma unroll
            for (int b = 0; b < 2; ++b)
#pragma unroll
                for (int m = 0; m < 4; ++m)
#pragma unroll
                    for (int n = 0; n < 2; ++n) acc[a][b][m][n] = (f32x4){0.f, 0.f, 0.f, 0.f};
        cur = nxt; cA = nA; cB = nB; ++ui;
        if constexpr (ALIGN_EPI) { if (wr == 1) PG8_BAR; }
    }
    PG8_WAIT_V(0);
    if constexpr (!ALIGN_EPI) { if (wr == 0) PG8_BAR; }
    PG8_BAR;
    if constexpr (Epi::AFTER_DRAIN) { E.fused(acc, cur, wr, wc, fr, fq, lds, wid, lane); S.done(cur); }
#undef PG8_SA
#undef PG8_SB
#undef PG8_STAGE
#undef PG8_LDA
#undef PG8_LDB
#undef PG8_MMA
#undef PG8_WAIT_V
#undef PG8_WAIT_L
#undef PG8_BAR
#undef PG8_SCHED
}
}
constexpr int NWAVES = 8;
#ifndef MK_ONE_LAUNCH
#define MK_ONE_LAUNCH 1
#endif

#ifndef MK_REP
#define MK_REP 0
#endif

constexpr int BATCH = 2, SEQ = 8192, D = 2048, DEPTH = 4, M = BATCH * SEQ;
constexpr int RETW = 1024, RH = 8, RD = 128, RWW = 1024, WH = 16, WD = 64;
constexpr int INW = 11520, DFF = 8192, RWSHIFT = 3328;
constexpr int ZC_Q = 0, ZC_K = 1024, ZC_V = 2048, ZC_GR = 3072, ZC_RW = 4096, ZC_GA = 7424, ZC_GB = 9472;
constexpr int RWC_R = 0, RWC_K = 1024, RWC_V = 2048, RWC_W = 3072, RWC_A = 3136, RWC_G = 3200;
constexpr float NORM_EPS = 1e-6f, RET_GN_EPS = 1e-5f, RWKV_LN_EPS = 64e-5f;

constexpr size_t MiB = 1u << 20;
constexpr size_t WS_CTL = 0, CTL_ZERO_BYTES = 1 * MiB;
constexpr size_t WS_ROPE = 1 * MiB;
constexpr size_t WS_WIN = 16 * MiB, WS_WA = 61 * MiB, WS_WB = 65 * MiB, WS_WO = 69 * MiB, WS_WUP = 77 * MiB, WS_WDN = 109 * MiB;
constexpr size_t WS_LORA = 141 * MiB;
constexpr size_t WS_H = 144 * MiB;
constexpr size_t WS_Z = 208 * MiB;
constexpr size_t WS_UP = WS_Z;
constexpr size_t WS_QR = 568 * MiB, WS_KR = 600 * MiB;
constexpr size_t WS_YRET = 632 * MiB, WS_YRWKV = 664 * MiB;
constexpr size_t WS_MRG = 696 * MiB;
constexpr size_t WS_SR = 760 * MiB, WS_SW = 824 * MiB, WS_SK = 888 * MiB, WS_SV = 952 * MiB, WS_SNKK = 1016 * MiB, WS_SKKA = 1080 * MiB;
constexpr size_t WS_G = 1144 * MiB;
constexpr size_t WS_BONUS = 1208 * MiB;
constexpr size_t WS_YRAWR = 1216 * MiB, WS_YRAWW = 1280 * MiB;
constexpr size_t WS_END = 1344 * MiB;
constexpr int CW_BAR = 4096;

constexpr int PPL = 11;
enum { LP_CONV = 0, LP_G1, LP_PREP, LP_SCAN, LP_POST, LP_GA, LP_GB, LP_GO, LP_NORM2, LP_GUP, LP_GDN };
constexpr int PH_PRO = 0, PH_L0 = 1, PH_FIN = PH_L0 + DEPTH * PPL, NPH = PH_FIN + 1;

constexpr int RING_OFF = 0, RING_BYTES = 131072;
constexpr int LDSCTL_OFF = RING_BYTES, MISC_OFF = LDSCTL_OFF + 320;
constexpr int LDS_BYTES = 147456;
static_assert(MISC_OFF + 128 <= LDS_BYTES, "LDS map");

#define GAS __attribute__((address_space(1)))
#define LAS __attribute__((address_space(3)))
typedef unsigned short bf16;
typedef unsigned v4u __attribute__((ext_vector_type(4)));
typedef unsigned v2u __attribute__((ext_vector_type(2)));
typedef float f32x4 __attribute__((ext_vector_type(4)));
typedef float f32x2 __attribute__((ext_vector_type(2)));
typedef short bf16x8 __attribute__((ext_vector_type(8)));
typedef GAS unsigned gu32;
#define LDS_WAIT() asm volatile("s_waitcnt lgkmcnt(0)" ::: "memory")
#define VM_WAIT() asm volatile("s_waitcnt vmcnt(0)" ::: "memory")
__device__ __forceinline__ unsigned f2bf(float f) { unsigned u = __builtin_bit_cast(unsigned, f); return (u + 0x7fffu + ((u >> 16) & 1u)) >> 16; }
__device__ __forceinline__ unsigned pk2(float lo, float hi) { return f2bf(lo) | (f2bf(hi) << 16); }
__device__ __forceinline__ float bf2f(bf16 v) { return __builtin_bit_cast(float, (unsigned)v << 16); }
__device__ __forceinline__ float rdlane(float v, int l) { return __builtin_bit_cast(float, __builtin_amdgcn_readlane(__builtin_bit_cast(int, v), l)); }
__device__ __forceinline__ float sigm(float x) { return 1.0f / (1.0f + expf(-x)); }

__device__ const double ROPE_REV[64] = {
0.15915494309189535, 0.13782250260398285, 0.11934937021124886, 0.10335229661843406,
0.08949940160889101, 0.07750328875537406, 0.06711508300522726, 0.058119267441876246,
0.050329212104487035, 0.04358330210530733, 0.03774158471741977, 0.032682865872357,
0.0283021958306234, 0.024508691862069852, 0.02122365276477766, 0.018378926105679667,
0.015915494309189534, 0.013782250260398284, 0.011934937021124886, 0.010335229661843406,
0.008949940160889102, 0.0077503288755374055, 0.006711508300522725, 0.005811926744187624,
0.005032921210448704, 0.004358330210530733, 0.003774158471741977, 0.0032682865872356993,
0.00283021958306234, 0.002450869186206985, 0.0021223652764777662, 0.0018378926105679667,
0.0015915494309189536, 0.0013782250260398288, 0.0011934937021124885, 0.0010335229661843405,
0.0008949940160889102, 0.0007750328875537405, 0.0006711508300522726, 0.0005811926744187624,
0.0005032921210448703, 0.0004358330210530733, 0.00037741584717419774, 0.0003268286587235699,
0.00028302195830623395, 0.00024508691862069854, 0.0002122365276477766, 0.00018378926105679666,
0.00015915494309189535, 0.00013782250260398286, 0.00011934937021124886, 0.00010335229661843406,
8.949940160889102e-05, 7.750328875537406e-05, 6.711508300522725e-05, 5.811926744187624e-05,
5.0329212104487035e-05, 4.358330210530732e-05, 3.774158471741978e-05, 3.2682865872357e-05,
2.8302195830623396e-05, 2.4508691862069852e-05, 2.122365276477766e-05, 1.8378926105679668e-05 };

#define XB_TMO      128
#define XB_XCNT(j)  (256  + 64 * (j))
#define XB_XSUB(j)  (1280 + 64 * (j))
#define XB_XGEN(j)  (2304 + 64 * (j))
#define XB_TOP      3328
#define XB_TOPGEN   3392
#define XCD_BAR_WORDS 3456
#define XB_SPIN_CAP (1u << 18)

__device__ __forceinline__ unsigned xb_ld(unsigned* p)              { return __hip_atomic_load(p, __ATOMIC_RELAXED, __HIP_MEMORY_SCOPE_AGENT); }
__device__ __forceinline__ unsigned xb_add(unsigned* p, unsigned v) { return __hip_atomic_fetch_add(p, v, __ATOMIC_RELAXED, __HIP_MEMORY_SCOPE_AGENT); }
__device__ __forceinline__ unsigned xb_xcc_id() { return (unsigned)__builtin_amdgcn_s_getreg((3 << 11) | 20) & 0xFu; }
#define XB_SPIN(cond, bar) do { unsigned _sp = 0; while (cond) { __builtin_amdgcn_s_sleep(1); \
    if ((++_sp & 255u) == 0u) { if (xb_ld(&(bar)[XB_TMO])) break; if (_sp > XB_SPIN_CAP) { atomicAdd(&(bar)[XB_TMO], 1u); break; } } } } while (0)

struct XcdBarrier {
    unsigned* bar; unsigned x;
    volatile LAS unsigned* st;
};

__device__ __forceinline__ XcdBarrier xcd_barrier_post(unsigned* bar, volatile LAS unsigned* st) {
    XcdBarrier b; b.bar = bar; b.x = xb_xcc_id(); b.st = st;
    if (threadIdx.x == 0) (void)xb_add(&bar[XB_XCNT(b.x)], 1u);
    return b;
}
__device__ __forceinline__ void xcd_barrier_complete(unsigned* bar, unsigned x, unsigned& nloc, unsigned& nx) {
    const unsigned G = gridDim.x * gridDim.y * gridDim.z;
    unsigned sum, cnt, mine, sp = 0u;
    for (;;) {
        sum = 0u; cnt = 0u; mine = 0u;
#pragma unroll
        for (unsigned j = 0; j < 16; ++j) { const unsigned c = xb_ld(&bar[XB_XCNT(j)]); sum += c; cnt += (c > 0u) ? 1u : 0u; mine = (j == x) ? c : mine; }
        if (sum == G) break;
        __builtin_amdgcn_s_sleep(1);
        if ((++sp & 255u) == 0u) { if (xb_ld(&bar[XB_TMO])) break; if (sp > XB_SPIN_CAP) { atomicAdd(&bar[XB_TMO], 1u); break; } }
    }
    nloc = mine > 0u ? mine : 1u; nx = cnt > 0u ? cnt : 1u;
}

__device__ __forceinline__ void xcd_barrier(const XcdBarrier& b) {
    asm volatile("s_waitcnt vmcnt(0)" ::: "memory");
    __syncthreads();
    if (threadIdx.x == 0) {
        unsigned* bar = b.bar;
        __builtin_amdgcn_s_waitcnt(0);
        unsigned nloc = b.st[0], nx = b.st[1];
        if (nloc == 0u) { xcd_barrier_complete(bar, b.x, nloc, nx); b.st[0] = nloc; b.st[1] = nx; }
        const unsigned old = xb_add(&bar[XB_XSUB(b.x)], 1u);
        const unsigned gen = old / nloc;
        if (old + 1u == (gen + 1u) * nloc) {
            __builtin_amdgcn_fence(__ATOMIC_RELEASE, "agent");
            asm volatile("s_waitcnt vmcnt(0)" ::: "memory");
            const unsigned og = xb_add(&bar[XB_TOP], 1u);
            const unsigned tg = og / nx;
            if (og + 1u == (tg + 1u) * nx) xb_add(&bar[XB_TOPGEN], 1u);
            else XB_SPIN(xb_ld(&bar[XB_TOPGEN]) == tg, bar);
            __builtin_amdgcn_fence(__ATOMIC_ACQUIRE, "agent");
            xb_add(&bar[XB_XGEN(b.x)], 1u);
            asm volatile("s_waitcnt vmcnt(0)" ::: "memory");
        } else {
            XB_SPIN(xb_ld(&bar[XB_XGEN(b.x)]) == gen, bar);
            __builtin_amdgcn_fence(__ATOMIC_ACQUIRE, "agent");
            asm volatile("s_waitcnt vmcnt(0)" ::: "memory");
        }
    }
    __syncthreads();
}


struct Frame {
    LAS unsigned char* lds;
    volatile LAS unsigned* MISC;
    int tid, lane, wave;
    int vcu, G;
    float* out; unsigned char* ws;
};
struct Args { const float* in[24]; float* out; unsigned char* ws; int ph_lo, ph_hi, li, pad; };
#define WSP(T, off) ((T*)(F.ws + (off)))
#define CAS __attribute__((address_space(4)))
typedef const CAS Args* ArgP;

__device__ __forceinline__ float wave_sum(float v) {
#pragma unroll
    for (int o = 1; o < 64; o <<= 1) v += __shfl_xor(v, o);
    return v;
}
__device__ __forceinline__ void transpose_item(const float* W, int K, int N, bf16* WT, LAS float* scr, int item, int lane) {
    const int nblk = N / 32, kb = item / nblk, nb = item % nblk, k0 = 64 * kb, n0 = 32 * nb;
#pragma unroll 8
    for (int i = 0; i < 32; ++i) { const int kk = 2 * i + (lane >> 5); scr[kk * 33 + (lane & 31)] = W[(size_t)(k0 + kk) * N + n0 + (lane & 31)]; }
    LDS_WAIT(); asm volatile("" ::: "memory");
    const int c = lane & 7;
#pragma unroll
    for (int j = 0; j < 4; ++j) { const int n = (lane >> 3) + 8 * j; const LAS float* s = scr + (8 * c) * 33 + n;
        v4u o; o.x = pk2(s[0 * 33], s[1 * 33]); o.y = pk2(s[2 * 33], s[3 * 33]); o.z = pk2(s[4 * 33], s[5 * 33]); o.w = pk2(s[6 * 33], s[7 * 33]);
        *(GAS v4u*)(WT + (size_t)(n0 + n) * K + k0 + 8 * c) = o; }
    LDS_WAIT(); asm volatile("" ::: "memory");
}
__device__ __forceinline__ void rms_row_to_bf16(const float* xrow, const float* g, bf16* orow, int lane) {
    const GAS f32x4* xr = (const GAS f32x4*)xrow + lane;
    f32x4 v[8]; float s = 0.f;
#pragma unroll
    for (int j = 0; j < 8; ++j) { v[j] = xr[64 * j]; s += (v[j].x * v[j].x + v[j].y * v[j].y) + (v[j].z * v[j].z + v[j].w * v[j].w); }
    const float rstd = 1.f / sqrtf(wave_sum(s) * (1.f / D) + NORM_EPS);
    const GAS f32x4* gr = (const GAS f32x4*)g + lane;
    GAS v2u* o8 = (GAS v2u*)orow + lane;
#pragma unroll
    for (int j = 0; j < 8; ++j) { const f32x4 gg = gr[64 * j]; v2u o; o.x = pk2(v[j].x * rstd * gg.x, v[j].y * rstd * gg.y); o.y = pk2(v[j].z * rstd * gg.z, v[j].w * rstd * gg.w); o8[64 * j] = o; }
}

__device__ __forceinline__ void ph_prologue(Frame& F, ArgP A) {
    const int* pos = (const int*)A->in[1]; float2* rope = WSP(float2, WS_ROPE);
    const size_t n4 = (size_t)M * D / 4;
    const GAS f32x4* src = (const GAS f32x4*)A->in[0]; GAS f32x4* dst = (GAS f32x4*)F.out;
    for (size_t i = (size_t)F.vcu * 512 + F.tid; i < n4; i += (size_t)F.G * 512) dst[i] = src[i];
    for (int i = F.vcu * 512 + F.tid; i < M * 64; i += F.G * 512) {
        const int m = i >> 6, j = i & 63;
        const double rev = (double)pos[m] * ROPE_REV[j];
        const float fr = (float)(rev - __builtin_rint(rev));
        rope[i] = make_float2(__builtin_amdgcn_cosf(fr), __builtin_amdgcn_sinf(fr));
    }
}
__device__ __forceinline__ void ph_convert(Frame& F, ArgP A, int l) {
    LAS float* scr = (LAS float*)(F.lds + RING_OFF + F.wave * 16384);
    const int gw = F.vcu * NWAVES + F.wave, NGW = F.G * NWAVES;
    constexpr int I_IN = (D / 64) * (INW / 32), I_A = (RETW / 64) * (D / 32), I_O = (D / 64) * (D / 32), I_UP = (D / 64) * (DFF / 32), I_DN = (DFF / 64) * (D / 32);
    constexpr int NITEMS = I_IN + 2 * I_A + I_O + I_UP + I_DN + 32 + 32 + 64;
    for (int it = gw; it < NITEMS; it += NGW) {
        int r = it;
        if (r < I_IN) { transpose_item(A->in[3] + (size_t)l * D * INW, D, INW, WSP(bf16, WS_WIN), scr, r, F.lane); continue; } r -= I_IN;
        if (r < I_A) { transpose_item(A->in[17] + (size_t)l * RETW * D, RETW, D, WSP(bf16, WS_WA), scr, r, F.lane); continue; } r -= I_A;
        if (r < I_A) { transpose_item(A->in[18] + (size_t)l * RWW * D, RWW, D, WSP(bf16, WS_WB), scr, r, F.lane); continue; } r -= I_A;
        if (r < I_O) { transpose_item(A->in[19] + (size_t)l * D * D, D, D, WSP(bf16, WS_WO), scr, r, F.lane); continue; } r -= I_O;
        if (r < I_UP) { transpose_item(A->in[21] + (size_t)l * D * DFF, D, DFF, WSP(bf16, WS_WUP), scr, r, F.lane); continue; } r -= I_UP;
        if (r < I_DN) { transpose_item(A->in[22] + (size_t)l * DFF * D, DFF, D, WSP(bf16, WS_WDN), scr, r, F.lane); continue; } r -= I_DN;
        if (r < 32) { transpose_item(A->in[8] + (size_t)l * 64 * RWW, 64, RWW, WSP(bf16, WS_LORA), scr, r, F.lane); continue; } r -= 32;
        if (r < 32) { transpose_item(A->in[10] + (size_t)l * 64 * RWW, 64, RWW, WSP(bf16, WS_LORA) + 1024 * 64, scr, r, F.lane); continue; } r -= 32;
        transpose_item(A->in[11] + (size_t)l * 128 * RWW, 128, RWW, WSP(bf16, WS_LORA) + 2 * 1024 * 64, scr, r, F.lane);
    }
}
__device__ __forceinline__ void ph_norm(Frame& F, const float* g) {
    const int gw = F.vcu * NWAVES + F.wave, NGW = F.G * NWAVES;
    for (int m = gw; m < M; m += NGW) rms_row_to_bf16(F.out + (size_t)m * D, g, WSP(bf16, WS_H) + (size_t)m * D, F.lane);
}
__device__ __forceinline__ void unpack8(const v4u a, float (&o)[8]) {
    o[0] = pg8::bf_lo(a.x); o[1] = pg8::bf_hi(a.x); o[2] = pg8::bf_lo(a.y); o[3] = pg8::bf_hi(a.y); o[4] = pg8::bf_lo(a.z); o[5] = pg8::bf_hi(a.z); o[6] = pg8::bf_lo(a.w); o[7] = pg8::bf_hi(a.w);
}
__device__ __forceinline__ void mix8(const GAS bf16* zc, bool has_prev, const GAS float* mu, float (&o)[8]) {
    const v4u a = *(const GAS v4u*)zc; v4u p = (v4u){0u, 0u, 0u, 0u}; if (has_prev) p = *(const GAS v4u*)(zc - INW);
    const f32x4 m0 = *(const GAS f32x4*)mu, m1 = *(const GAS f32x4*)(mu + 4);
    float z[8], q[8]; unpack8(a, z); unpack8(p, q);
#pragma unroll
    for (int j = 0; j < 4; ++j) { o[j] = z[j] + m0[j] * (q[j] - z[j]); o[4 + j] = z[4 + j] + m1[j] * (q[4 + j] - z[4 + j]); }
}
__device__ __forceinline__ f32x4 mix4(const GAS bf16* zc, bool has_prev, const GAS float* mu) {
    const v2u a = *(const GAS v2u*)zc; v2u p = (v2u){0u, 0u}; if (has_prev) p = *(const GAS v2u*)(zc - INW);
    const f32x4 m = *(const GAS f32x4*)mu;
    const f32x4 z = (f32x4){pg8::bf_lo(a.x), pg8::bf_hi(a.x), pg8::bf_lo(a.y), pg8::bf_hi(a.y)}, q = (f32x4){pg8::bf_lo(p.x), pg8::bf_hi(p.x), pg8::bf_lo(p.y), pg8::bf_hi(p.y)};
    return z + m * (q - z);
}
__device__ __forceinline__ bf16x8 pack8(const float (&v)[8]) {
    v4u o; o.x = pg8::cvt_pk_bf16(v[0], v[1]); o.y = pg8::cvt_pk_bf16(v[2], v[3]); o.z = pg8::cvt_pk_bf16(v[4], v[5]); o.w = pg8::cvt_pk_bf16(v[6], v[7]);
    return __builtin_bit_cast(bf16x8, o);
}
__device__ __forceinline__ void ph_prep(Frame& F, ArgP A, int l) {
    const int gw = F.vcu * NWAVES + F.wave, NGW = F.G * NWAVES, lane = F.lane, l15 = lane & 15, g = lane >> 4;
    {
        const int h = lane >> 3, i0 = 8 * (lane & 7);
        for (int m = gw; m < M; m += NGW) {
            const GAS bf16* zrow = (const GAS bf16*)(WSP(bf16, WS_Z) + (size_t)m * INW);
            const GAS f32x4* rp = (const GAS f32x4*)(WSP(float2, WS_ROPE) + (size_t)m * 64 + i0);
            const f32x4 c01 = rp[0], c23 = rp[1], c45 = rp[2], c67 = rp[3];
            const float cs[8] = {c01.x, c01.z, c23.x, c23.z, c45.x, c45.z, c67.x, c67.z}, sn[8] = {c01.y, c01.w, c23.y, c23.w, c45.y, c45.w, c67.y, c67.w};
            float q1[8], q2[8], k1[8], k2[8], o1[8], o2[8];
            unpack8(*(const GAS v4u*)(zrow + ZC_Q + h * RD + i0), q1); unpack8(*(const GAS v4u*)(zrow + ZC_Q + h * RD + 64 + i0), q2);
            unpack8(*(const GAS v4u*)(zrow + ZC_K + h * RD + i0), k1); unpack8(*(const GAS v4u*)(zrow + ZC_K + h * RD + 64 + i0), k2);
#pragma unroll
            for (int j = 0; j < 8; ++j) { o1[j] = q1[j] * cs[j] - q2[j] * sn[j]; o2[j] = q2[j] * cs[j] + q1[j] * sn[j]; }
            GAS bf16* qo = (GAS bf16*)(WSP(bf16, WS_QR) + (size_t)m * RETW + h * RD + i0);
            *(GAS bf16x8*)qo = pack8(o1); *(GAS bf16x8*)(qo + 64) = pack8(o2);
#pragma unroll
            for (int j = 0; j < 8; ++j) { const float a = k1[j] * 0.08838834764831845f, b = k2[j] * 0.08838834764831845f; o1[j] = a * cs[j] - b * sn[j]; o2[j] = b * cs[j] + a * sn[j]; }
            GAS bf16* ko = (GAS bf16*)(WSP(bf16, WS_KR) + (size_t)m * RETW + h * RD + i0);
            *(GAS bf16x8*)ko = pack8(o1); *(GAS bf16x8*)(ko + 64) = pack8(o2);
        }
    }
    const GAS float* mu = (const GAS float*)(A->in[6] + (size_t)l * RWSHIFT);
    const GAS float* w0 = (const GAS float*)(A->in[7] + (size_t)l * RWW); const GAS float* a0 = (const GAS float*)(A->in[9] + (size_t)l * RWW);
    const GAS float* kkw = (const GAS float*)(A->in[12] + (size_t)l * RWW); const GAS float* kaw = (const GAS float*)(A->in[13] + (size_t)l * RWW); const GAS float* rkw = (const GAS float*)(A->in[14] + (size_t)l * RWW);
    const GAS bf16* WupT = (const GAS bf16*)WSP(bf16, WS_LORA); const GAS bf16* AupT = WupT + 1024 * 64; const GAS bf16* GupT = AupT + 1024 * 64;
    for (int task = gw; task < M / 16; task += NGW) {
        const int m = task * 16 + l15;
        const bool has_prev = (m % SEQ) != 0;
        const GAS bf16* zr = (const GAS bf16*)(WSP(bf16, WS_Z) + (size_t)m * INW + ZC_RW);
        bf16x8 fw[2], fa[2], fg[4];
#pragma unroll
        for (int ks = 0; ks < 2; ++ks) { float t[8];
            mix8(zr + RWC_W + 32 * ks + 8 * g, has_prev, mu + RWC_W + 32 * ks + 8 * g, t);
#pragma unroll
            for (int j = 0; j < 8; ++j) t[j] = tanhf(t[j]);
            fw[ks] = pack8(t);
            mix8(zr + RWC_A + 32 * ks + 8 * g, has_prev, mu + RWC_A + 32 * ks + 8 * g, t); fa[ks] = pack8(t); }
#pragma unroll
        for (int ks = 0; ks < 4; ++ks) { float t[8];
            mix8(zr + RWC_G + 32 * ks + 8 * g, has_prev, mu + RWC_G + 32 * ks + 8 * g, t);
#pragma unroll
            for (int j = 0; j < 8; ++j) t[j] = sigm(t[j]);
            fg[ks] = pack8(t); }
        for (int hh = 0; hh < WH; ++hh) {
            f32x4 kkr[4], av[4]; float ss = 0.f, bonus = 0.f;
#pragma unroll
            for (int nt = 0; nt < 4; ++nt) {
                const int cf = hh * WD + nt * 16 + l15;
                const int c0 = hh * WD + nt * 16 + 4 * g;
                f32x4 wl = *(const GAS f32x4*)(w0 + c0), al = *(const GAS f32x4*)(a0 + c0), gl = (f32x4){0.f, 0.f, 0.f, 0.f};
#pragma unroll
                for (int ks = 0; ks < 2; ++ks) {
                    wl = __builtin_amdgcn_mfma_f32_16x16x32_bf16(*(const GAS bf16x8*)(WupT + (size_t)cf * 64 + 32 * ks + 8 * g), fw[ks], wl, 0, 0, 0);
                    al = __builtin_amdgcn_mfma_f32_16x16x32_bf16(*(const GAS bf16x8*)(AupT + (size_t)cf * 64 + 32 * ks + 8 * g), fa[ks], al, 0, 0, 0); }
#pragma unroll
                for (int ks = 0; ks < 4; ++ks)
                    gl = __builtin_amdgcn_mfma_f32_16x16x32_bf16(*(const GAS bf16x8*)(GupT + (size_t)cf * 128 + 32 * ks + 8 * g), fg[ks], gl, 0, 0, 0);
                const f32x4 r = mix4(zr + RWC_R + c0, has_prev, mu + RWC_R + c0), k = mix4(zr + RWC_K + c0, has_prev, mu + RWC_K + c0), v = mix4(zr + RWC_V + c0, has_prev, mu + RWC_V + c0);
                const f32x4 kk4 = *(const GAS f32x4*)(kkw + c0), ka4 = *(const GAS f32x4*)(kaw + c0), rk4 = *(const GAS f32x4*)(rkw + c0);
                f32x4 decay, a, kp;
#pragma unroll
                for (int i = 0; i < 4; ++i) {
                    const float yy = -wl[i];
                    const float sp = (yy > 0.f) ? (yy + log1pf(expf(-yy))) : log1pf(expf(yy));
                    decay[i] = expf(-expf(-sp - 0.5f));
                    a[i] = sigm(al[i]);
                    kp[i] = k[i] * (1.0f + (a[i] - 1.0f) * ka4[i]);
                }
                kkr[nt] = k * kk4; av[nt] = a;
                ss += (kkr[nt].x * kkr[nt].x + kkr[nt].y * kkr[nt].y) + (kkr[nt].z * kkr[nt].z + kkr[nt].w * kkr[nt].w);
                const f32x4 rb = r * kp * rk4; bonus += (rb.x + rb.y) + (rb.z + rb.w);
                const size_t o = (size_t)m * RWW + c0;
                *(GAS f32x4*)(WSP(float, WS_SR) + o) = r; *(GAS f32x4*)(WSP(float, WS_SW) + o) = decay; *(GAS f32x4*)(WSP(float, WS_SK) + o) = kp;
                *(GAS f32x4*)(WSP(float, WS_SV) + o) = v; *(GAS f32x4*)(WSP(float, WS_G) + o) = gl;
            }
            ss += __shfl_xor(ss, 16); ss += __shfl_xor(ss, 32); bonus += __shfl_xor(bonus, 16); bonus += __shfl_xor(bonus, 32);
            const float inv = 1.0f / fmaxf(sqrtf(ss), 1e-12f);
#pragma unroll
            for (int nt = 0; nt < 4; ++nt) { const size_t o = (size_t)m * RWW + hh * WD + nt * 16 + 4 * g; const f32x4 kk = kkr[nt] * inv;
                *(GAS f32x4*)(WSP(float, WS_SNKK) + o) = -kk; *(GAS f32x4*)(WSP(float, WS_SKKA) + o) = kk * av[nt]; }
            if (g == 0) WSP(float, WS_BONUS)[(size_t)m * WH + hh] = bonus;
        }
    }
}
__device__ __forceinline__ void scan_rwkv_naive(Frame& F, int item) {
    const int lane = F.lane;
    float st[64];
#pragma unroll
    for (int j = 0; j < 64; ++j) st[j] = 0.f;
    const size_t base0 = (size_t)(item >> 4) * SEQ * RWW + (size_t)(item & 15) * WD + lane;
    for (int t = 0; t < SEQ; ++t) {
        const size_t o = base0 + (size_t)t * RWW;
        const float r = WSP(float, WS_SR)[o], w = WSP(float, WS_SW)[o], k = WSP(float, WS_SK)[o], v = WSP(float, WS_SV)[o], nk = WSP(float, WS_SNKK)[o], ka = WSP(float, WS_SKKA)[o];
        float sa = 0.f;
#pragma unroll
        for (int j = 0; j < 64; ++j) sa += st[j] * rdlane(nk, j);
        float y = 0.f;
#pragma unroll
        for (int j = 0; j < 64; ++j) { st[j] = st[j] * rdlane(w, j) + sa * rdlane(ka, j) + v * rdlane(k, j); y += st[j] * rdlane(r, j); }
        WSP(float, WS_YRAWW)[o] = y;
    }
}
__device__ __forceinline__ void scan_ret_naive(Frame& F, int item) {
    const int lane = F.lane, b = item >> 4, h = (item >> 1) & 7, half = item & 1;
    const float gam = 1.0f - exp2f((float)(-5 - h));
    float R[128];
#pragma unroll
    for (int j = 0; j < 128; ++j) R[j] = 0.f;
    for (int t = 0; t < SEQ; ++t) {
        const size_t m = (size_t)b * SEQ + t;
        const float q1 = bf2f(WSP(bf16, WS_QR)[m * RETW + h * RD + lane]), q2 = bf2f(WSP(bf16, WS_QR)[m * RETW + h * RD + 64 + lane]);
        const float k1 = bf2f(WSP(bf16, WS_KR)[m * RETW + h * RD + lane]), k2 = bf2f(WSP(bf16, WS_KR)[m * RETW + h * RD + 64 + lane]);
        const float v = bf2f(WSP(bf16, WS_Z)[m * INW + ZC_V + h * RD + half * 64 + lane]);
        float y = 0.f;
#pragma unroll
        for (int d = 0; d < 64; ++d) { R[d] = gam * R[d] + rdlane(k1, d) * v; y += rdlane(q1, d) * R[d]; }
#pragma unroll
        for (int d = 0; d < 64; ++d) { R[64 + d] = gam * R[64 + d] + rdlane(k2, d) * v; y += rdlane(q2, d) * R[64 + d]; }
        WSP(float, WS_YRAWR)[m * RETW + h * RD + half * 64 + lane] = y;
    }
}
constexpr int SCT = 32;
constexpr int SC_ARR = SCT * 64 * 4;
constexpr int SC_BUF = 5 * SC_ARR + SCT * 16 * 4;
static_assert(2 * SC_BUF <= RING_BYTES, "scan LDS");
template <int CTRL> __device__ __forceinline__ float dppf(float x) { return __builtin_bit_cast(float, __builtin_amdgcn_update_dpp(0, __builtin_bit_cast(int, x), CTRL, 0xF, 0xF, true)); }
__device__ __forceinline__ float sum16(float x) {
    x += dppf<0xB1>(x); x += dppf<0x4E>(x); x += dppf<0x141>(x); x += dppf<0x140>(x); return x;
}
__device__ __forceinline__ void scan_rwkv_fast(Frame& F, int w) {
    const int b = w >> 6, hh = (w >> 2) & 15, q = w & 3;
    const int lane = F.lane, wave = F.wave;
    LAS unsigned char* base = F.lds + RING_OFF;
    const size_t g0 = (size_t)b * SEQ * RWW + (size_t)hh * WD;
    constexpr int NBLK = SEQ / SCT;
#define SC_BAR() do { asm volatile("s_waitcnt lgkmcnt(0)" ::: "memory"); __builtin_amdgcn_s_barrier(); asm volatile("" ::: "memory"); } while (0)
    if (wave >= 4) {
        const int lt = F.tid - 256;
        const float* a0 = WSP(float, WS_SR) + g0; const float* a1 = WSP(float, WS_SW) + g0; const float* a2 = WSP(float, WS_SK) + g0;
        const float* a3 = WSP(float, WS_SNKK) + g0; const float* a4 = WSP(float, WS_SKKA) + g0; const float* av = WSP(float, WS_SV) + g0 + 16 * q;
        const int f0 = lt, f1 = lt + 256;
        const size_t o0 = (size_t)(f0 >> 4) * RWW + 4 * (f0 & 15), o1 = (size_t)(f1 >> 4) * RWW + 4 * (f1 & 15), ov = (size_t)(lt >> 2) * RWW + 4 * (lt & 3);
        f32x4 r0[5], r1[5], rv;
#define SC_LOAD(blk) do { const size_t tb = (size_t)(blk) * SCT * RWW; \
        r0[0] = *(const GAS f32x4*)(a0 + tb + o0); r1[0] = *(const GAS f32x4*)(a0 + tb + o1); r0[1] = *(const GAS f32x4*)(a1 + tb + o0); r1[1] = *(const GAS f32x4*)(a1 + tb + o1); \
        r0[2] = *(const GAS f32x4*)(a2 + tb + o0); r1[2] = *(const GAS f32x4*)(a2 + tb + o1); r0[3] = *(const GAS f32x4*)(a3 + tb + o0); r1[3] = *(const GAS f32x4*)(a3 + tb + o1); \
        r0[4] = *(const GAS f32x4*)(a4 + tb + o0); r1[4] = *(const GAS f32x4*)(a4 + tb + o1); if (lt < 128) rv = *(const GAS f32x4*)(av + tb + ov); } while (0)
#define SC_STORE(bi) do { LAS unsigned char* bb = base + (bi) * SC_BUF; \
        _Pragma("unroll") for (int a = 0; a < 5; ++a) { *(LAS f32x4*)(bb + a * SC_ARR + f0 * 16) = r0[a]; *(LAS f32x4*)(bb + a * SC_ARR + f1 * 16) = r1[a]; } \
        if (lt < 128) *(LAS f32x4*)(bb + 5 * SC_ARR + lt * 16) = rv; } while (0)
        SC_LOAD(0); SC_STORE(0);
        if (1 < NBLK) SC_LOAD(1);
        SC_BAR();
        for (int blk = 0; blk < NBLK; ++blk) {
            if (blk + 1 < NBLK) { SC_STORE((blk + 1) & 1); if (blk + 2 < NBLK) SC_LOAD(blk + 2); }
            SC_BAR();
        }
#undef SC_LOAD
#undef SC_STORE
    } else {
        const int l16 = lane & 15, rowl = 4 * wave + (lane >> 4);
        GAS float* Y = (GAS float*)(WSP(float, WS_YRAWW) + g0 + 16 * q + rowl);
        f32x4 st = (f32x4){0.f, 0.f, 0.f, 0.f};
        const int lo = l16 * 16, vo = 5 * SC_ARR + rowl * 4;
#define SC_LD(tt_, R4, W4, K4, N4, A4, V) do { R4 = *(const LAS f32x4*)(bb + 0 * SC_ARR + (tt_) * 256 + lo); W4 = *(const LAS f32x4*)(bb + 1 * SC_ARR + (tt_) * 256 + lo); \
        K4 = *(const LAS f32x4*)(bb + 2 * SC_ARR + (tt_) * 256 + lo); N4 = *(const LAS f32x4*)(bb + 3 * SC_ARR + (tt_) * 256 + lo); A4 = *(const LAS f32x4*)(bb + 4 * SC_ARR + (tt_) * 256 + lo); \
        V = *(const LAS float*)(bb + vo + (tt_) * 64); } while (0)
        SC_BAR();
        for (int blk = 0; blk < NBLK; ++blk) {
            const LAS unsigned char* bb = base + (blk & 1) * SC_BUF;
            GAS float* yb = Y + (size_t)blk * SCT * RWW;
            f32x4 r4, w4, k4, n4, a4; float v;
            SC_LD(0, r4, w4, k4, n4, a4, v);
#pragma unroll 8
            for (int tt = 0; tt < SCT; ++tt) {
                f32x4 r4n, w4n, k4n, n4n, a4n; float vn;
                const int tn = (tt + 1 < SCT) ? tt + 1 : tt;
                SC_LD(tn, r4n, w4n, k4n, n4n, a4n, vn);
                const float sap = (st.x * n4.x + st.y * n4.y) + (st.z * n4.z + st.w * n4.w);
                const f32x4 t0 = st * w4 + k4 * v;
                const float sa = sum16(sap);
                st = a4 * sa + t0;
                const float y = sum16((st.x * r4.x + st.y * r4.y) + (st.z * r4.z + st.w * r4.w));
                yb[(size_t)tt * RWW] = y;
                r4 = r4n; w4 = w4n; k4 = k4n; n4 = n4n; a4 = a4n; v = vn;
            }
            SC_BAR();
        }
#undef SC_LD
#undef SC_BAR
    }
}
constexpr int RT_STR = 288, RT_QS = 0, RT_KS = 128 * RT_STR, RT_VSTR = 80, RT_VS = 2 * 128 * RT_STR, RT_VPS = RT_VS + 128 * RT_VSTR, RT_RT = RT_VPS + 128 * RT_VSTR, RT_RTSZ = 32 * RT_STR;
static_assert(RT_RT + 2 * RT_RTSZ <= RING_BYTES, "retention LDS");
typedef short s4v __attribute__((ext_vector_type(4)));
__device__ __forceinline__ bf16x8 tr8(const LAS unsigned char* p0, const LAS unsigned char* p1) {
    const s4v a = __builtin_amdgcn_ds_read_tr16_b64_v4i16((LAS s4v*)p0), b = __builtin_amdgcn_ds_read_tr16_b64_v4i16((LAS s4v*)p1);
    return (bf16x8){a.x, a.y, a.z, a.w, b.x, b.y, b.z, b.w};
}
__device__ __forceinline__ void scan_ret_mfma(Frame& F, int w_) {
    const int b = w_ >> 5, h = (w_ >> 2) & 7, eq = w_ & 3;
    const int tid = F.tid, lane = F.lane, w = F.wave, l15 = lane & 15, g = lane >> 4, tq = l15 >> 2, tp = l15 & 3;
    LAS unsigned char* L = F.lds + RING_OFF;
    const float lg2 = log1pf(-exp2f((float)(-5 - h))) * 1.4426950408889634f;
    const float gC = __builtin_amdgcn_exp2f(lg2 * 128.f);
    for (int i = tid; i < RT_RTSZ / 4; i += NWAVES * 64) ((LAS unsigned*)(L + RT_RT))[i] = 0u;
    const GAS bf16* Qg = (const GAS bf16*)(WSP(bf16, WS_QR) + (size_t)b * SEQ * RETW + h * RD);
    const GAS bf16* Kg = (const GAS bf16*)(WSP(bf16, WS_KR) + (size_t)b * SEQ * RETW + h * RD);
    const GAS bf16* Vg = (const GAS bf16*)(WSP(bf16, WS_Z) + (size_t)b * SEQ * INW + ZC_V + h * RD + 32 * eq);
    GAS float* Yg = (GAS float*)(WSP(float, WS_YRAWR) + (size_t)b * SEQ * RETW + h * RD + 32 * eq);
    v4u rq[4], rk[4], rv;
#define RT_LOAD(n_) do { _Pragma("unroll") for (int i = 0; i < 4; ++i) { const int f = tid + 512 * i, c = f >> 4, pc = f & 15; \
        rq[i] = *(const GAS v4u*)(Qg + (size_t)((n_) * 128 + c) * RETW + 8 * pc); rk[i] = *(const GAS v4u*)(Kg + (size_t)((n_) * 128 + c) * RETW + 8 * pc); } \
        rv = *(const GAS v4u*)(Vg + (size_t)((n_) * 128 + (tid >> 2)) * INW + 8 * (tid & 3)); } while (0)
    f32x4 accR[2] = {(f32x4){0.f, 0.f, 0.f, 0.f}, (f32x4){0.f, 0.f, 0.f, 0.f}};
    RT_LOAD(0);
    for (int n = 0; n < SEQ / 128; ++n) {
#pragma unroll
        for (int i = 0; i < 4; ++i) { const int f = tid + 512 * i, c = f >> 4, pc = f & 15;
            *(LAS v4u*)(L + RT_QS + c * RT_STR + pc * 16) = rq[i]; *(LAS v4u*)(L + RT_KS + c * RT_STR + pc * 16) = rk[i]; }
        { const int c = tid >> 2, pc = tid & 3; *(LAS v4u*)(L + RT_VS + c * RT_VSTR + pc * 16) = rv;
          const float sc = __builtin_amdgcn_exp2f(lg2 * (float)(127 - c)); v4u o;
          o.x = pg8::cvt_pk_bf16(pg8::bf_lo(rv.x) * sc, pg8::bf_hi(rv.x) * sc); o.y = pg8::cvt_pk_bf16(pg8::bf_lo(rv.y) * sc, pg8::bf_hi(rv.y) * sc);
          o.z = pg8::cvt_pk_bf16(pg8::bf_lo(rv.z) * sc, pg8::bf_hi(rv.z) * sc); o.w = pg8::cvt_pk_bf16(pg8::bf_lo(rv.w) * sc, pg8::bf_hi(rv.w) * sc);
          *(LAS v4u*)(L + RT_VPS + c * RT_VSTR + pc * 16) = o; }
        __syncthreads();
        if (n + 1 < SEQ / 128) RT_LOAD(n + 1);
        bf16x8 qf[4];
#pragma unroll
        for (int ks = 0; ks < 4; ++ks) qf[ks] = *(const LAS bf16x8*)(L + RT_QS + (16 * w + l15) * RT_STR + (32 * ks + 8 * g) * 2);
        bf16x8 pf[4];
        const int cq = 16 * w + l15;
#pragma unroll
        for (int p = 0; p < 4; ++p) {
            f32x4 s0 = (f32x4){0.f, 0.f, 0.f, 0.f}, s1 = (f32x4){0.f, 0.f, 0.f, 0.f};
            if (2 * p <= w) {
#pragma unroll
                for (int ks = 0; ks < 4; ++ks) { const bf16x8 kf = *(const LAS bf16x8*)(L + RT_KS + (32 * p + l15) * RT_STR + (32 * ks + 8 * g) * 2);
                    s0 = __builtin_amdgcn_mfma_f32_16x16x32_bf16(kf, qf[ks], s0, 0, 0, 0); }
            }
            if (2 * p + 1 <= w) {
#pragma unroll
                for (int ks = 0; ks < 4; ++ks) { const bf16x8 kf = *(const LAS bf16x8*)(L + RT_KS + (32 * p + 16 + l15) * RT_STR + (32 * ks + 8 * g) * 2);
                    s1 = __builtin_amdgcn_mfma_f32_16x16x32_bf16(kf, qf[ks], s1, 0, 0, 0); }
            }
            float p0[4], p1[4];
#pragma unroll
            for (int i = 0; i < 4; ++i) { const int d0 = cq - (32 * p + 4 * g + i), d1 = d0 - 16;
                p0[i] = d0 >= 0 ? s0[i] * __builtin_amdgcn_exp2f(lg2 * (float)d0) : 0.f; p1[i] = d1 >= 0 ? s1[i] * __builtin_amdgcn_exp2f(lg2 * (float)d1) : 0.f; }
            v4u pk; pk.x = pg8::cvt_pk_bf16(p0[0], p0[1]); pk.y = pg8::cvt_pk_bf16(p0[2], p0[3]); pk.z = pg8::cvt_pk_bf16(p1[0], p1[1]); pk.w = pg8::cvt_pk_bf16(p1[2], p1[3]);
            pf[p] = __builtin_bit_cast(bf16x8, pk);
        }
        const LAS unsigned char* Rcur = L + RT_RT + (n & 1) * RT_RTSZ;
#pragma unroll
        for (int et = 0; et < 2; ++et) {
            f32x4 acc = (f32x4){0.f, 0.f, 0.f, 0.f};
#pragma unroll
            for (int ks = 0; ks < 4; ++ks) { const bf16x8 rf = *(const LAS bf16x8*)(Rcur + (16 * et + l15) * RT_STR + (32 * ks + 8 * g) * 2);
                acc = __builtin_amdgcn_mfma_f32_16x16x32_bf16(qf[ks], rf, acc, 0, 0, 0); }
#pragma unroll
            for (int i = 0; i < 4; ++i) acc[i] *= __builtin_amdgcn_exp2f(lg2 * (float)(16 * w + 4 * g + i + 1));
#pragma unroll
            for (int p = 0; p < 4; ++p) if (2 * p <= w) {
                const LAS unsigned char* vb = L + RT_VS + (32 * p + 4 * g + tq) * RT_VSTR + (16 * et + 4 * tp) * 2;
                const bf16x8 vf = tr8(vb, vb + 16 * RT_VSTR);
                acc = __builtin_amdgcn_mfma_f32_16x16x32_bf16(pf[p], vf, acc, 0, 0, 0); }
#pragma unroll
            for (int i = 0; i < 4; ++i) Yg[(size_t)(n * 128 + 16 * w + 4 * g + i) * RETW + 16 * et + l15] = acc[i];
        }
        LAS unsigned char* Rnxt = L + RT_RT + ((n + 1) & 1) * RT_RTSZ;
        accR[0] = accR[0] * gC; accR[1] = accR[1] * gC;
#pragma unroll
        for (int cs = 0; cs < 4; ++cs) {
            const LAS unsigned char* kb = L + RT_KS + (32 * cs + 8 * g + tq) * RT_STR + (16 * w + 4 * tp) * 2;
            const bf16x8 kt = tr8(kb, kb + 4 * RT_STR);
#pragma unroll
            for (int et = 0; et < 2; ++et) { const LAS unsigned char* vb = L + RT_VPS + (32 * cs + 8 * g + tq) * RT_VSTR + (16 * et + 4 * tp) * 2;
                const bf16x8 vt = tr8(vb, vb + 4 * RT_VSTR);
                accR[et] = __builtin_amdgcn_mfma_f32_16x16x32_bf16(kt, vt, accR[et], 0, 0, 0); }
        }
#pragma unroll
        for (int et = 0; et < 2; ++et) { v2u o; o.x = pg8::cvt_pk_bf16(accR[et][0], accR[et][1]); o.y = pg8::cvt_pk_bf16(accR[et][2], accR[et][3]);
            *(LAS v2u*)(Rnxt + (16 * et + l15) * RT_STR + (16 * w + 4 * g) * 2) = o; }
        __syncthreads();
    }
#undef RT_LOAD
}
__device__ __forceinline__ void ph_scan(Frame& F) {
    if (F.G >= 160) {
        if (F.vcu < 128) { scan_rwkv_fast(F, F.vcu); if (MK_REP & 32) { __syncthreads(); scan_rwkv_fast(F, F.vcu); } }
        else if (F.vcu < 192) { scan_ret_mfma(F, F.vcu - 128); if (MK_REP & 64) { __syncthreads(); scan_ret_mfma(F, F.vcu - 128); } }
    } else {
        const int gw = F.vcu * NWAVES + F.wave, NGW = F.G * NWAVES;
        const int stride = NGW >= 64 ? NGW / 64 : 1;
        if (gw % stride == 0) {
            for (int item = gw / stride; item < 64; item += (NGW + stride - 1) / stride) {
                if (item < 32) scan_rwkv_naive(F, item); else scan_ret_naive(F, item - 32);
            }
        }
    }
}
__device__ __forceinline__ void ph_post(Frame& F, ArgP A, int l) {
    const int gw = F.vcu * NWAVES + F.wave, NGW = F.G * NWAVES, lane = F.lane;
    const float* gng = A->in[4] + (size_t)l * RETW; const float* gnb = A->in[5] + (size_t)l * RETW;
    const float* lng = A->in[15] + (size_t)l * RWW; const float* lnb = A->in[16] + (size_t)l * RWW;
    for (int m = gw; m < M; m += NGW) {
        const bf16* zrow = WSP(bf16, WS_Z) + (size_t)m * INW;
#pragma unroll
        for (int h = 0; h < RH; ++h) {
            const int c = h * RD + lane;
            const float y1 = WSP(float, WS_YRAWR)[(size_t)m * RETW + c], y2 = WSP(float, WS_YRAWR)[(size_t)m * RETW + c + 64];
            const float mean = wave_sum(y1 + y2) * (1.f / RD);
            const float d1 = y1 - mean, d2 = y2 - mean;
            const float rstd = 1.f / sqrtf(wave_sum(d1 * d1 + d2 * d2) * (1.f / RD) + RET_GN_EPS);
            const float g1 = bf2f(zrow[ZC_GR + c]), g2 = bf2f(zrow[ZC_GR + c + 64]);
            const float o1 = (d1 * rstd * gng[c] + gnb[c]) * (g1 * sigm(g1)), o2 = (d2 * rstd * gng[c + 64] + gnb[c + 64]) * (g2 * sigm(g2));
            WSP(bf16, WS_YRET)[(size_t)m * RETW + c] = (bf16)f2bf(o1); WSP(bf16, WS_YRET)[(size_t)m * RETW + c + 64] = (bf16)f2bf(o2);
        }
#pragma unroll
        for (int hh = 0; hh < WH; ++hh) {
            const int c = hh * WD + lane; const size_t o = (size_t)m * RWW + c;
            const float y = WSP(float, WS_YRAWW)[o];
            const float mean = wave_sum(y) * (1.f / WD);
            const float d = y - mean;
            const float rstd = 1.f / sqrtf(wave_sum(d * d) * (1.f / WD) + RWKV_LN_EPS);
            float yn = d * rstd * lng[c] + lnb[c];
            yn += WSP(float, WS_BONUS)[(size_t)m * WH + hh] * WSP(float, WS_SV)[o];
            WSP(bf16, WS_YRWKV)[o] = (bf16)f2bf(yn * WSP(float, WS_G)[o]);
        }
    }
}
__device__ __forceinline__ void ph_final(Frame& F, ArgP A) {
    const int gw = F.vcu * NWAVES + F.wave, NGW = F.G * NWAVES, lane = F.lane;
    const GAS f32x4* gr = (const GAS f32x4*)A->in[23] + lane;
    for (int m = gw; m < M; m += NGW) {
        GAS f32x4* xr = (GAS f32x4*)(F.out + (size_t)m * D) + lane;
        f32x4 v[8]; float s = 0.f;
#pragma unroll
        for (int j = 0; j < 8; ++j) { v[j] = xr[64 * j]; s += (v[j].x * v[j].x + v[j].y * v[j].y) + (v[j].z * v[j].z + v[j].w * v[j].w); }
        const float rstd = 1.f / sqrtf(wave_sum(s) * (1.f / D) + NORM_EPS);
#pragma unroll
        for (int j = 0; j < 8; ++j) xr[64 * j] = v[j] * rstd * gr[64 * j];
    }
}

__global__ void __launch_bounds__(NWAVES * 64, 2) hybrid_fwd(Args args) {
    extern __shared__ __attribute__((aligned(16))) unsigned char lds[];
    Frame F;
    F.lds = (LAS unsigned char*)lds;
    F.MISC = (volatile LAS unsigned*)(F.lds + MISC_OFF);
    F.tid = threadIdx.x; F.lane = F.tid & 63; F.wave = __builtin_amdgcn_readfirstlane(F.tid >> 6);
    int bx = blockIdx.x; F.G = gridDim.x; { F.vcu = (F.G % 8 == 0) ? (bx % 8) * (F.G / 8) + bx / 8 : bx; }
    F.ws = args.ws; F.out = args.out;
    for (int u = F.tid; u < (LDS_BYTES - LDSCTL_OFF) / 4; u += NWAVES * 64) ((LAS unsigned*)(F.lds + LDSCTL_OFF))[u] = 0u;
    __syncthreads();
    if (F.tid == 0) { volatile LAS unsigned* U = (volatile LAS unsigned*)(F.lds + MISC_OFF) + 16; const unsigned long long pw = (unsigned long long)args.ws, po = (unsigned long long)args.out, pa = (unsigned long long)__builtin_amdgcn_kernarg_segment_ptr();
        U[0] = (unsigned)pw; U[1] = (unsigned)(pw >> 32); U[2] = (unsigned)po; U[3] = (unsigned)(po >> 32); U[4] = (unsigned)pa; U[5] = (unsigned)(pa >> 32); U[6] = (unsigned)F.G; U[7] = (unsigned)F.vcu; U[8] = (unsigned)bx; }
    __syncthreads();
    XcdBarrier bar = xcd_barrier_post((unsigned*)(F.ws + WS_CTL) + CW_BAR, F.MISC + 8);

    ArgP ap = (ArgP)__builtin_amdgcn_kernarg_segment_ptr();
    const int lo = args.ph_lo, hi = args.ph_hi;
#define REPX(bit, body) do { body; if (MK_REP & (bit)) { __syncthreads(); body; } } while (0)
#define IN(k) (lo <= (k) && (k) < hi)
#define SEAM(k) do { if (IN(k) && IN((k) + 1)) xcd_barrier(bar); else __syncthreads(); } while (0)

    if (IN(PH_PRO)) { ph_prologue(F, ap); }
    SEAM(PH_PRO);
    for (int l = 0; l < DEPTH; ++l) {
        const int p0 = PH_L0 + l * PPL;
        asm volatile("" : "+v"(F.tid), "+v"(F.lane) :: "memory");
        { unsigned ba = MISC_OFF + 64; asm volatile("" : "+v"(ba));
          const volatile LAS v4u* U = (const volatile LAS v4u*)(F.lds + ba);
          const v4u ua = U[0], ub = U[1]; const unsigned uc = *(const volatile LAS unsigned*)(U + 2);
          const unsigned u0 = __builtin_amdgcn_readfirstlane(ua.x), u1 = __builtin_amdgcn_readfirstlane(ua.y), u2 = __builtin_amdgcn_readfirstlane(ua.z), u3 = __builtin_amdgcn_readfirstlane(ua.w);
          const unsigned u4 = __builtin_amdgcn_readfirstlane(ub.x), u5 = __builtin_amdgcn_readfirstlane(ub.y), u6 = __builtin_amdgcn_readfirstlane(ub.z), u7 = __builtin_amdgcn_readfirstlane(ub.w), u8 = __builtin_amdgcn_readfirstlane(uc);
          F.ws = (unsigned char*)(((unsigned long long)u1 << 32) | u0); F.out = (float*)(((unsigned long long)u3 << 32) | u2); ap = (ArgP)(((unsigned long long)u5 << 32) | u4);
          F.G = (int)u6; F.vcu = (int)u7; bx = (int)u8; F.wave = __builtin_amdgcn_readfirstlane(F.tid >> 6); }
        if (IN(p0 + LP_CONV)) { REPX(1, ph_convert(F, ap, l)); REPX(2, ph_norm(F, ap->in[2] + (size_t)l * D)); }
        SEAM(p0 + LP_CONV);
        if (IN(p0 + LP_G1)) {
            pg8::Gemm g{WSP(bf16, WS_H), WSP(bf16, WS_WIN), M, INW, D}; pg8::StaticOrder S; S.init(M, INW, F.G, bx);
            pg8::EpiB<0> E{WSP(bf16, WS_Z), INW, nullptr, 0};
            pg8::gemm_phase<pg8::EpiB<0>, pg8::StaticOrder, true, true>(F.lds + RING_OFF, g, S, E);
        }
        SEAM(p0 + LP_G1);
        if (IN(p0 + LP_PREP)) { REPX(4, ph_prep(F, ap, l)); }
        SEAM(p0 + LP_PREP);
        if (IN(p0 + LP_SCAN)) { REPX(8, ph_scan(F)); }
        SEAM(p0 + LP_SCAN);
        if (IN(p0 + LP_POST)) { REPX(16, ph_post(F, ap, l)); }
        SEAM(p0 + LP_POST);
        if (IN(p0 + LP_GA)) {
            pg8::Gemm g{WSP(bf16, WS_YRET), WSP(bf16, WS_WA), M, D, RETW}; pg8::StaticOrder S; S.init(M, D, F.G, bx);
            pg8::EpiB<2> E{WSP(bf16, WS_MRG), D, WSP(bf16, WS_Z) + ZC_GA, INW};
            pg8::gemm_phase<pg8::EpiB<2>, pg8::StaticOrder, true, true>(F.lds + RING_OFF, g, S, E);
        }
        SEAM(p0 + LP_GA);
        if (IN(p0 + LP_GB)) {
            pg8::Gemm g{WSP(bf16, WS_YRWKV), WSP(bf16, WS_WB), M, D, RWW}; pg8::StaticOrder S; S.init(M, D, F.G, bx);
            pg8::EpiB<3> E{WSP(bf16, WS_MRG), D, WSP(bf16, WS_Z) + ZC_GB, INW};
            pg8::gemm_phase<pg8::EpiB<3>, pg8::StaticOrder, true, true>(F.lds + RING_OFF, g, S, E);
        }
        SEAM(p0 + LP_GB);
        if (IN(p0 + LP_GO)) {
            pg8::Gemm g{WSP(bf16, WS_MRG), WSP(bf16, WS_WO), M, D, D}; pg8::StaticOrder S; S.init(M, D, F.G, bx);
            pg8::EpiResF32 E{F.out, D};
            pg8::gemm_phase<pg8::EpiResF32, pg8::StaticOrder, true, true>(F.lds + RING_OFF, g, S, E);
        }
        SEAM(p0 + LP_GO);
        if (IN(p0 + LP_NORM2)) { REPX(2, ph_norm(F, ap->in[20] + (size_t)l * D)); }
        SEAM(p0 + LP_NORM2);
        if (IN(p0 + LP_GUP)) {
            pg8::Gemm g{WSP(bf16, WS_H), WSP(bf16, WS_WUP), M, DFF, D}; pg8::StaticOrder S; S.init(M, DFF, F.G, bx);
            pg8::EpiB<1> E{WSP(bf16, WS_UP), DFF, nullptr, 0};
            pg8::gemm_phase<pg8::EpiB<1>, pg8::StaticOrder, true, true>(F.lds + RING_OFF, g, S, E);
        }
        SEAM(p0 + LP_GUP);
        if (IN(p0 + LP_GDN)) {
            pg8::Gemm g{WSP(bf16, WS_UP), WSP(bf16, WS_WDN), M, D, DFF}; pg8::StaticOrder S; S.init(M, D, F.G, bx);
            pg8::EpiResF32 E{F.out, D};
            pg8::gemm_phase<pg8::EpiResF32, pg8::StaticOrder, true, true>(F.lds + RING_OFF, g, S, E);
        }
        SEAM(p0 + LP_GDN);
    }
    if (IN(PH_FIN)) { ph_final(F, ap); }
#undef IN
#undef SEAM
}

extern "C" void kernel_launch(void* const* d_in, const int* in_sizes, int n_in, void* d_out, int out_size, void* d_ws, size_t ws_size, hipStream_t stream) {
    static int grid = 0;
    if (grid == 0) {
        if (n_in != 24 || in_sizes[0] != M * D || out_size != M * D || ws_size < WS_END) { fprintf(stderr, "kernel_launch: built for 24 inputs, x and out of %d floats, >= %zu bytes of workspace; got n_in %d, in0 %d, out %d, ws %zu; nothing launched\n", M * D, (size_t)WS_END, n_in, n_in > 0 ? in_sizes[0] : -1, out_size, ws_size); grid = -1; return; }
        int dev = 0, cus = 0, per_cu = 0;
        if (hipGetDevice(&dev) != hipSuccess || hipDeviceGetAttribute(&cus, hipDeviceAttributeMultiprocessorCount, dev) != hipSuccess) { fprintf(stderr, "kernel_launch: hipGetDevice / hipDeviceGetAttribute failed; nothing launched\n"); grid = -1; return; }
        if (hipFuncSetAttribute((const void*)hybrid_fwd, hipFuncAttributeMaxDynamicSharedMemorySize, LDS_BYTES) != hipSuccess) { fprintf(stderr, "kernel_launch: hipFuncSetAttribute failed\n"); grid = -1; return; }
        if (hipOccupancyMaxActiveBlocksPerMultiprocessor(&per_cu, (const void*)hybrid_fwd, NWAVES * 64, LDS_BYTES) != hipSuccess || per_cu < 1)
            fprintf(stderr, "kernel_launch: note: the occupancy query reports %d workgroups per CU\n", per_cu);
        (void)hipGetLastError();
        grid = cus;
    }
    if (grid < 0) return;
    if (hipMemsetAsync((char*)d_ws + WS_CTL, 0, CTL_ZERO_BYTES, stream) != hipSuccess) { fprintf(stderr, "kernel_launch: hipMemsetAsync failed\n"); return; }
    Args a{};
    for (int i = 0; i < 24; ++i) a.in[i] = (const float*)d_in[i];
    a.out = (float*)d_out; a.ws = (unsigned char*)d_ws; a.li = 0; a.pad = 0;
#if MK_ONE_LAUNCH
    a.ph_lo = 0; a.ph_hi = NPH;
    hipLaunchKernelGGL(hybrid_fwd, dim3(grid), dim3(NWAVES * 64), LDS_BYTES, stream, a);
#else
    for (int p = 0; p < NPH; ++p) {
        a.ph_lo = p; a.ph_hi = p + 1;
        hipLaunchKernelGGL(hybrid_fwd, dim3(grid), dim3(NWAVES * 64), LDS_BYTES, stream, a);
    }
#endif
    const hipError_t le = hipPeekAtLastError();
    if (le != hipSuccess) fprintf(stderr, "kernel_launch: launch failed: %s\n", hipGetErrorName(le));
}
```

```cpp
#include <hip/hip_runtime.h>
#include <cstdio>
#include <cstdint>
#ifndef MK_GLOBAL_GROUPS
#define MK_GLOBAL_GROUPS 30
#endif
#ifndef MK_REP
#define MK_REP 0
#endif
namespace pg8 {
#define PG8_LAS __attribute__((address_space(3)))
typedef unsigned short bf16_t;
typedef short bf16x8 __attribute__((ext_vector_type(8)));
typedef float f32x4 __attribute__((ext_vector_type(4)));
typedef unsigned u32x4 __attribute__((ext_vector_type(4)));
constexpr int BM = 256, BK = 64, HALF = 128, HTB = HALF * BK * 2  , STAGE_BYTES = 8 * HTB, NXCD = 8, WGM = 8;

__host__ __device__ __forceinline__ int lds_byte(int r, int c) { const int st = (r >> 4) * 2 + (c >> 5), rr = r & 15, cc = c & 31, ob = rr * 64 + cc * 2; return st * 1024 + (ob ^ (((ob >> 9) & 1) << 5)); }
__host__ __device__ __forceinline__ void stage_rc(int b, int& R, int& C) { const int st = b / 1024, sb = b % 1024, swz = sb ^ (((sb >> 9) & 1) << 5); R = (st >> 1) * 16 + swz / 64; C = (st & 1) * 32 + (swz % 64) / 2; }
__host__ __device__ __forceinline__ int perm32(int rho) { const int n = rho >> 4, i = rho & 15; return 8 * (i >> 2) + 4 * n + (i & 3); }

struct Unit { int pm, pn; };
struct Gemm { const bf16_t* A; const bf16_t* Bt; int M, N, K; };

struct StaticOrder {
    int nM, nN, nwg, G, c;
    __host__ __device__ void init(int M, int N, int G_, int c_) { nM = M / BM; nN = N / BM; nwg = nM * nN; G = G_; c = c_; }
    __host__ __device__ bool next(int i, Unit& u) const {
        const long L = (long)i * G + c; if (L >= nwg) return false;
        int wgid = (int)L; { const int q = nwg / NXCD, r = nwg % NXCD, xcd = wgid % NXCD, off = wgid / NXCD; wgid = (xcd < r ? xcd * (q + 1) : r * (q + 1) + (xcd - r) * q) + off; }
        const int nig = WGM * nN, gid = wgid / nig, fm = gid * WGM, gsz = (nM - fm) < WGM ? (nM - fm) : WGM;
        u.pm = fm + ((wgid % nig) % gsz); u.pn = (wgid % nig) / gsz; return true;
    }
    __device__ __forceinline__ void a_ready(const Unit&) const {}
    __device__ __forceinline__ void done(const Unit&) const {}
};

__device__ __forceinline__ unsigned cvt_pk_bf16(float lo, float hi) { unsigned r; asm volatile("v_cvt_pk_bf16_f32 %0, %1, %2" : "=v"(r) : "v"(lo), "v"(hi)); return r; }
typedef float f32x2 __attribute__((ext_vector_type(2)));
__device__ __forceinline__ float bf_lo(unsigned w) { return __builtin_bit_cast(float, w << 16); }
__device__ __forceinline__ float bf_hi(unsigned w) { return __builtin_bit_cast(float, w & 0xffff0000u); }
__device__ __forceinline__ float sigmoidf_(float x) { return 1.0f / (1.0f + __expf(-x)); }
template <int MODE> struct EpiB {
    static constexpr bool PERM = true, AFTER_DRAIN = false;
    bf16_t* O; int ldc; const bf16_t* gate; int ldg; const float* ss;
    __device__ __forceinline__ void operator()(const f32x4 (&acc)[2][2][4][2], const Unit& u, int wr, int wc, int fr, int fq) const {
        const int row0 = u.pm * BM + wr * 64 + fr, col0 = u.pn * BM + wc * 32 + 8 * fq;
        float rs[2][4];
        for (int rep_ = 0; rep_ < ((MK_REP & 128) ? 2 : 1); ++rep_) { asm volatile("" ::: "memory");
        if (MODE <= 1) {
            typedef __attribute__((address_space(1))) const f32x4 gf4;
            f32x4 q[2][4][2];
#pragma unroll
            for (int ai = 0; ai < 2; ++ai)
#pragma unroll
                for (int m = 0; m < 4; ++m) { gf4* sp = (gf4*)(ss + (size_t)(row0 + ai * HALF + m * 16) * 32) + fq * 2; q[ai][m][0] = sp[0]; q[ai][m][1] = sp[1]; }
#pragma unroll
            for (int ai = 0; ai < 2; ++ai)
#pragma unroll
                for (int m = 0; m < 4; ++m) { const f32x4 a = q[ai][m][0] + q[ai][m][1]; rs[ai][m] = (a[0] + a[1]) + (a[2] + a[3]); }
#pragma unroll
            for (int ai = 0; ai < 2; ++ai)
#pragma unroll
                for (int m = 0; m < 4; ++m) rs[ai][m] += __shfl_xor(rs[ai][m], 16);
#pragma unroll
            for (int ai = 0; ai < 2; ++ai)
#pragma unroll
                for (int m = 0; m < 4; ++m) { rs[ai][m] += __shfl_xor(rs[ai][m], 32); rs[ai][m] = __builtin_amdgcn_rsqf(rs[ai][m] * (1.0f / 2048.0f) + 1e-6f); }
        }
        if (MK_REP & 128) asm volatile("" : "+v"(rs[0][0]), "+v"(rs[1][3]) :: "memory"); }
#pragma unroll
        for (int ai = 0; ai < 2; ++ai)
#pragma unroll
            for (int m = 0; m < 4; ++m) { const size_t row = (size_t)(row0 + ai * HALF + m * 16);
#pragma unroll
                for (int bj = 0; bj < 2; ++bj) { f32x4 v0 = acc[ai][bj][m][0], v1 = acc[ai][bj][m][1]; const int c = col0 + bj * HALF;
                    if (MODE <= 1) { v0 = v0 * rs[ai][m]; v1 = v1 * rs[ai][m]; }
                    if (MODE == 1) {
#pragma unroll
                        for (int j = 0; j < 4; ++j) { const float a = fmaxf(v0[j], 0.f), b = fmaxf(v1[j], 0.f); v0[j] = a * a; v1[j] = b * b; } }
                    if (MODE >= 2) { const u32x4 g = *(const u32x4*)(gate + row * ldg + c);
                        v0[0] *= sigmoidf_(bf_lo(g.x)); v0[1] *= sigmoidf_(bf_hi(g.x)); v0[2] *= sigmoidf_(bf_lo(g.y)); v0[3] *= sigmoidf_(bf_hi(g.y));
                        v1[0] *= sigmoidf_(bf_lo(g.z)); v1[1] *= sigmoidf_(bf_hi(g.z)); v1[2] *= sigmoidf_(bf_lo(g.w)); v1[3] *= sigmoidf_(bf_hi(g.w)); }
                    if (MODE == 3) { const u32x4 o = *(const u32x4*)(O + row * ldc + c);
                        v0[0] += bf_lo(o.x); v0[1] += bf_hi(o.x); v0[2] += bf_lo(o.y); v0[3] += bf_hi(o.y);
                        v1[0] += bf_lo(o.z); v1[1] += bf_hi(o.z); v1[2] += bf_lo(o.w); v1[3] += bf_hi(o.w); }
                    u32x4 w; w.x = cvt_pk_bf16(v0[0], v0[1]); w.y = cvt_pk_bf16(v0[2], v0[3]); w.z = cvt_pk_bf16(v1[0], v1[1]); w.w = cvt_pk_bf16(v1[2], v1[3]);
                    *(u32x4*)(O + row * ldc + c) = w; } }
    }
};
struct EpiResNorm {
    static constexpr bool PERM = true, AFTER_DRAIN = false;
    float* X; int ldc; bf16_t* XB; float* SS;
    __device__ __forceinline__ void operator()(const f32x4 (&acc)[2][2][4][2], const Unit& u, int wr, int wc, int fr, int fq) const {
        const int row0 = u.pm * BM + wr * 64 + fr, col0 = u.pn * BM + wc * 32 + 8 * fq;
#pragma unroll
        for (int ai = 0; ai < 2; ++ai)
#pragma unroll
            for (int m = 0; m < 4; ++m) { const size_t row = (size_t)(row0 + ai * HALF + m * 16);
                float s = 0.f;
#pragma unroll
                for (int bj = 0; bj < 2; ++bj) { const int c = col0 + bj * HALF; float* p = X + row * ldc + c;
                    const f32x4 x0 = *(const f32x4*)p + acc[ai][bj][m][0], x1 = *(const f32x4*)(p + 4) + acc[ai][bj][m][1];
                    *(f32x4*)p = x0; *(f32x4*)(p + 4) = x1;
                    u32x4 w; w.x = cvt_pk_bf16(x0[0], x0[1]); w.y = cvt_pk_bf16(x0[2], x0[3]); w.z = cvt_pk_bf16(x1[0], x1[1]); w.w = cvt_pk_bf16(x1[2], x1[3]);
                    *(u32x4*)(XB + row * ldc + c) = w;
                    s += ((x0[0] * x0[0] + x0[1] * x0[1]) + (x0[2] * x0[2] + x0[3] * x0[3])) + ((x1[0] * x1[0] + x1[1] * x1[1]) + (x1[2] * x1[2] + x1[3] * x1[3])); }
                s += __shfl_xor(s, 16); s += __shfl_xor(s, 32);
                if (fq == 0) SS[row * 32 + u.pn * 4 + wc] = s; }
    }
};

template <class Epi, class Sched, bool ALIGN_EPI = false, bool SP2 = false>
__device__ __forceinline__ void gemm_phase(PG8_LAS unsigned char* lds, const Gemm g, const Sched& S, const Epi& E) {
    int tid_ = threadIdx.x; asm volatile("" : "+v"(tid_));
    const int tid = tid_, wid = __builtin_amdgcn_readfirstlane(tid >> 6), lane = tid & 63, wr = wid >> 2, wc = wid & 3, fr = lane & 15, fq = lane >> 4;
    const int K = g.K, nt = K / BK;
    unsigned voffA[2], voffB[2];
#pragma unroll
    for (int i = 0; i < 2; ++i) { int R, C; stage_rc(tid * 16 + i * 8192, R, C); const int Rb = Epi::PERM ? ((R & ~31) + perm32(R & 31)) : R;
        voffA[i] = (unsigned)(R * K + C) * 2u; voffB[i] = (unsigned)(Rb * K + C) * 2u; }
    const size_t kstep = (size_t)(BK * 2);
    const size_t hstep = (size_t)HALF * K * 2;
    const size_t tstep = 2 * hstep;
    const unsigned ldsw = (unsigned)wid * 1024u;
    const int aoff = lds_byte(wr * 64 + fr, fq * 8), boff = lds_byte(wc * 32 + fr, fq * 8);
#define PG8_SA(b, h) (((b) * 2 + (h)) * HTB)
#define PG8_SB(b, h) ((4 + (b) * 2 + (h)) * HTB)
#define PG8_STAGE(bufoff, gbase, voff) do { _Pragma("unroll") for (int _i = 0; _i < 2; ++_i) \
        __builtin_amdgcn_global_load_lds((const unsigned*)((const char*)(gbase) + (voff)[_i]), (PG8_LAS unsigned*)(lds + (bufoff) + ldsw + _i * 8192), 16, 0, 0); } while (0)
#define PG8_LDA(dst, b, h) do { _Pragma("unroll") for (int m = 0; m < 4; ++m) _Pragma("unroll") for (int k = 0; k < 2; ++k) dst[m][k] = *(const PG8_LAS bf16x8*)(lds + PG8_SA(b, h) + aoff + m * 2048 + k * 1024); } while (0)
#define PG8_LDB(dst, b, h) do { _Pragma("unroll") for (int n = 0; n < 2; ++n) _Pragma("unroll") for (int k = 0; k < 2; ++k) dst[n][k] = *(const PG8_LAS bf16x8*)(lds + PG8_SB(b, h) + boff + n * 2048 + k * 1024); } while (0)
#define PG8_MMA(ai, bj, At, Bt) do { __builtin_amdgcn_s_setprio(1); _Pragma("unroll") for (int m = 0; m < 4; ++m) _Pragma("unroll") for (int n = 0; n < 2; ++n) _Pragma("unroll") for (int k = 0; k < 2; ++k) \
        acc[ai][bj][m][n] = __builtin_amdgcn_mfma_f32_16x16x32_bf16(Bt[n][k], At[m][k], acc[ai][bj][m][n], 0, 0, 0); __builtin_amdgcn_s_setprio(0); } while (0)
#define PG8_WAIT_V(n) asm volatile("s_waitcnt vmcnt(" #n ")" ::: "memory")
#define PG8_WAIT_L(n) asm volatile("s_waitcnt lgkmcnt(" #n ")" ::: "memory")
#define PG8_BAR __builtin_amdgcn_s_barrier()
#define PG8_SCHED __builtin_amdgcn_sched_barrier(0)
    Unit cur, nxt; int ui = 0;
    if (!S.next(0, cur)) return;
    f32x4 acc[2][2][4][2];
#pragma unroll
    for (int a = 0; a < 2; ++a)
#pragma unroll
        for (int b = 0; b < 2; ++b)
#pragma unroll
            for (int m = 0; m < 4; ++m)
#pragma unroll
                for (int n = 0; n < 2; ++n) acc[a][b][m][n] = (f32x4){0.f, 0.f, 0.f, 0.f};
    bf16x8 At[4][2], B0[2][2], B1[2][2];
    const char* cA = (const char*)g.A + (size_t)cur.pm * tstep; const char* cB = (const char*)g.Bt + (size_t)cur.pn * tstep;
    S.a_ready(cur);
    if constexpr (SP2) {
        PG8_STAGE(PG8_SB(0, 0), cB, voffB); PG8_STAGE(PG8_SB(0, 1), cB + hstep, voffB); PG8_STAGE(PG8_SA(0, 0), cA, voffA); PG8_STAGE(PG8_SA(0, 1), cA + hstep, voffA);
        if (wr == 1) PG8_BAR;
        PG8_WAIT_V(2); PG8_BAR;
        PG8_STAGE(PG8_SB(1, 0), cB + kstep, voffB); PG8_STAGE(PG8_SA(1, 0), cA + kstep, voffA); PG8_STAGE(PG8_SB(1, 1), cB + hstep + kstep, voffB);
        PG8_WAIT_V(6); PG8_BAR;
    } else {
        PG8_STAGE(PG8_SB(0, 0), cB, voffB); PG8_STAGE(PG8_SA(0, 0), cA, voffA); PG8_STAGE(PG8_SB(0, 1), cB + hstep, voffB); PG8_STAGE(PG8_SA(0, 1), cA + hstep, voffA);
        if (wr == 1) PG8_BAR;
        PG8_WAIT_V(4); PG8_BAR;
        PG8_STAGE(PG8_SB(1, 0), cB + kstep, voffB); PG8_STAGE(PG8_SA(1, 0), cA + kstep, voffA); PG8_STAGE(PG8_SB(1, 1), cB + hstep + kstep, voffB);
        PG8_WAIT_V(6); PG8_BAR;
    }
    for (;;) {
        const bool has_next = S.next(ui + 1, nxt);
        const char* nA = has_next ? (const char*)g.A + (size_t)nxt.pm * tstep : cA; const char* nB = has_next ? (const char*)g.Bt + (size_t)nxt.pn * tstep : cB;
        for (int t = 0; t < nt; t += 2) {
            const bool last = (t == nt - 2);
            const char* a1 = cA + (size_t)(t + 1) * kstep;
            const char* a2 = last ? nA : cA + (size_t)(t + 2) * kstep; const char* b2 = last ? nB : cB + (size_t)(t + 2) * kstep;
            const char* a3 = a2 + kstep; const char* b3 = b2 + kstep;
            if (last && has_next) S.a_ready(nxt);
            if constexpr (SP2) {
            PG8_LDB(B0, 0, 0); PG8_LDB(B1, 0, 1); PG8_SCHED; PG8_LDA(At, 0, 0); PG8_STAGE(PG8_SA(1, 1), a1 + hstep, voffA);
            PG8_WAIT_V(8); PG8_WAIT_L(0); PG8_BAR; PG8_MMA(0, 0, At, B0); PG8_MMA(0, 1, At, B1); PG8_BAR; PG8_SCHED;
            PG8_LDA(At, 0, 1); PG8_STAGE(PG8_SB(0, 0), b2, voffB); PG8_STAGE(PG8_SB(0, 1), b2 + hstep, voffB); PG8_STAGE(PG8_SA(0, 0), a2, voffA);
            PG8_WAIT_V(8); PG8_WAIT_L(0); PG8_BAR; PG8_MMA(1, 0, At, B0); PG8_MMA(1, 1, At, B1); PG8_BAR; PG8_SCHED;
            PG8_LDB(B0, 1, 0); PG8_LDB(B1, 1, 1); PG8_SCHED; PG8_LDA(At, 1, 0); PG8_STAGE(PG8_SA(0, 1), a2 + hstep, voffA);
            PG8_WAIT_V(8); PG8_WAIT_L(0); PG8_BAR; PG8_MMA(0, 0, At, B0); PG8_MMA(0, 1, At, B1); PG8_BAR; PG8_SCHED;
            PG8_LDA(At, 1, 1); PG8_STAGE(PG8_SB(1, 0), b3, voffB); PG8_STAGE(PG8_SB(1, 1), b3 + hstep, voffB); PG8_STAGE(PG8_SA(1, 0), a3, voffA);
            PG8_WAIT_V(8); PG8_WAIT_L(0); PG8_BAR; PG8_MMA(1, 0, At, B0); PG8_MMA(1, 1, At, B1); PG8_BAR; PG8_SCHED;
            } else {
            PG8_LDB(B0, 0, 0); PG8_SCHED; PG8_LDA(At, 0, 0); PG8_STAGE(PG8_SA(1, 1), a1 + hstep, voffA);
            PG8_WAIT_L(8); PG8_BAR; PG8_WAIT_L(0); PG8_MMA(0, 0, At, B0); PG8_BAR; PG8_SCHED;
            PG8_LDB(B1, 0, 1); PG8_STAGE(PG8_SB(0, 0), b2, voffB);
            PG8_BAR; PG8_WAIT_L(0); PG8_MMA(0, 1, At, B1); PG8_BAR;
            PG8_LDA(At, 0, 1); PG8_STAGE(PG8_SA(0, 0), a2, voffA);
            PG8_BAR; PG8_WAIT_L(0); PG8_MMA(1, 0, At, B0); PG8_BAR; PG8_SCHED;
            PG8_STAGE(PG8_SB(0, 1), b2 + hstep, voffB);
            PG8_WAIT_V(6); PG8_BAR; PG8_MMA(1, 1, At, B1); PG8_BAR;
            PG8_LDB(B0, 1, 0); PG8_SCHED; PG8_LDA(At, 1, 0); PG8_STAGE(PG8_SA(0, 1), a2 + hstep, voffA);
            PG8_WAIT_L(8); PG8_BAR; PG8_WAIT_L(0); PG8_MMA(0, 0, At, B0); PG8_BAR; PG8_SCHED;
            PG8_LDB(B1, 1, 1); PG8_STAGE(PG8_SB(1, 0), b3, voffB);
            PG8_BAR; PG8_WAIT_L(0); PG8_MMA(0, 1, At, B1); PG8_BAR;
            PG8_LDA(At, 1, 1); PG8_STAGE(PG8_SA(1, 0), a3, voffA);
            PG8_BAR; PG8_WAIT_L(0); PG8_MMA(1, 0, At, B0); PG8_BAR; PG8_SCHED;
            PG8_STAGE(PG8_SB(1, 1), b3 + hstep, voffB);
            PG8_WAIT_V(6); PG8_BAR; PG8_MMA(1, 1, At, B1); PG8_BAR;
            }
        }
        if constexpr (ALIGN_EPI) { if (wr == 0) PG8_BAR; }
        if constexpr (!Epi::AFTER_DRAIN) { E(acc, cur, wr, wc, fr, fq); S.done(cur); }
        if (!has_next) break;
#pragma unroll
        for (int a = 0; a < 2; ++a)
#pragma unroll
            for (int b = 0; b < 2; ++b)
#pragma unroll
                for (int m = 0; m < 4; ++m)
#pragma unroll
                    for (int n = 0; n < 2; ++n) acc[a][b][m][n] = (f32x4){0.f, 0.f, 0.f, 0.f};
        cur = nxt; cA = nA; cB = nB; ++ui;
        if constexpr (ALIGN_EPI) { if (wr == 1) PG8_BAR; }
    }
    PG8_WAIT_V(0);
    if constexpr (!ALIGN_EPI) { if (wr == 0) PG8_BAR; }
    PG8_BAR;
    if constexpr (Epi::AFTER_DRAIN) { E.fused(acc, cur, wr, wc, fr, fq, lds, wid, lane); S.done(cur); }
#undef PG8_SA
#undef PG8_SB
#undef PG8_STAGE
#undef PG8_LDA
#undef PG8_LDB
#undef PG8_MMA
#undef PG8_WAIT_V
#undef PG8_WAIT_L
#undef PG8_BAR
#undef PG8_SCHED
}
}
constexpr int NWAVES = 8;
#ifndef MK_ONE_LAUNCH
#define MK_ONE_LAUNCH 1
#endif

#ifndef MK_GLOBAL_GROUPS
#define MK_GLOBAL_GROUPS 30
#endif
#ifndef MK_REP
#define MK_REP 0
#endif

constexpr int BATCH = 2, SEQ = 8192, D = 2048, DEPTH = 4, M = BATCH * SEQ;
constexpr int RETW = 1024, RH = 8, RD = 128, RWW = 1024, WH = 16, WD = 64;
constexpr int INW = 11520, DFF = 8192, RWSHIFT = 3328;
constexpr int ZC_Q = 0, ZC_K = 1024, ZC_V = 2048, ZC_GR = 3072, ZC_RW = 4096, ZC_GA = 7424, ZC_GB = 9472;
constexpr int RWC_R = 0, RWC_K = 1024, RWC_V = 2048, RWC_W = 3072, RWC_A = 3136, RWC_G = 3200;
constexpr float NORM_EPS = 1e-6f, RET_GN_EPS = 1e-5f, RWKV_LN_EPS = 64e-5f;

constexpr size_t MiB = 1u << 20;
constexpr size_t WS_CTL = 0, CTL_ZERO_BYTES = 1 * MiB;
constexpr size_t WS_ROPE = 1 * MiB;
constexpr size_t WS_WSET = 16 * MiB, WSET_BYTES = 126 * MiB;
constexpr size_t WO_WIN = 0, WO_WA = 45 * MiB, WO_WB = 49 * MiB, WO_WO = 53 * MiB, WO_WUP = 61 * MiB, WO_WDN = 93 * MiB, WO_LORA = 125 * MiB;
constexpr size_t WS_H = 272 * MiB;
constexpr size_t WS_Z = 336 * MiB;
constexpr size_t WS_UP = WS_Z;
constexpr size_t WS_QR = 696 * MiB, WS_KR = 728 * MiB;
constexpr size_t WS_YRET = 760 * MiB, WS_YRWKV = 792 * MiB;
constexpr size_t WS_MRG = 824 * MiB;
constexpr size_t WS_SR = 888 * MiB, WS_SW = 952 * MiB, WS_SK = 1016 * MiB, WS_SV = 1080 * MiB, WS_SNKK = 1144 * MiB, WS_SKKA = 1208 * MiB;
constexpr size_t WS_G = 1272 * MiB;
constexpr size_t WS_BONUS = 1336 * MiB;
constexpr size_t WS_SS = 1337 * MiB;
constexpr size_t WS_YRAWR = WS_H, WS_YRAWW = WS_MRG;
constexpr size_t WS_END = 1341 * MiB;
constexpr int CW_BAR = 4096;

constexpr int PPL = 9;
enum { LP_G1 = 0, LP_PREP, LP_SCAN, LP_POST, LP_GA, LP_GB, LP_GO, LP_GUP, LP_GDN };
constexpr int PH_PRO = 0, PH_L0 = 1, PH_FIN = PH_L0 + DEPTH * PPL, NPH = PH_FIN + 1;

constexpr int RING_OFF = 0, RING_BYTES = 131072;
constexpr int LDSCTL_OFF = RING_BYTES, MISC_OFF = LDSCTL_OFF + 320;
constexpr int LDS_BYTES = 147456;
static_assert(MISC_OFF + 128 <= LDS_BYTES, "LDS map");

#define GAS __attribute__((address_space(1)))
#define LAS __attribute__((address_space(3)))
typedef unsigned short bf16;
typedef unsigned v4u __attribute__((ext_vector_type(4)));
typedef unsigned v2u __attribute__((ext_vector_type(2)));
typedef float f32x4 __attribute__((ext_vector_type(4)));
typedef float f32x2 __attribute__((ext_vector_type(2)));
typedef short bf16x8 __attribute__((ext_vector_type(8)));
typedef GAS unsigned gu32;
#define LDS_WAIT() asm volatile("s_waitcnt lgkmcnt(0)" ::: "memory")
#define VM_WAIT() asm volatile("s_waitcnt vmcnt(0)" ::: "memory")
__device__ __forceinline__ unsigned f2bf(float f) { unsigned u = __builtin_bit_cast(unsigned, f); return (u + 0x7fffu + ((u >> 16) & 1u)) >> 16; }
__device__ __forceinline__ unsigned pk2(float lo, float hi) { return f2bf(lo) | (f2bf(hi) << 16); }
__device__ __forceinline__ float bf2f(bf16 v) { return __builtin_bit_cast(float, (unsigned)v << 16); }
__device__ __forceinline__ float rdlane(float v, int l) { return __builtin_bit_cast(float, __builtin_amdgcn_readlane(__builtin_bit_cast(int, v), l)); }
__device__ __forceinline__ float sigm(float x) { return 1.0f / (1.0f + expf(-x)); }

__device__ const double ROPE_REV[64] = {
0.15915494309189535, 0.13782250260398285, 0.11934937021124886, 0.10335229661843406,
0.08949940160889101, 0.07750328875537406, 0.06711508300522726, 0.058119267441876246,
0.050329212104487035, 0.04358330210530733, 0.03774158471741977, 0.032682865872357,
0.0283021958306234, 0.024508691862069852, 0.02122365276477766, 0.018378926105679667,
0.015915494309189534, 0.013782250260398284, 0.011934937021124886, 0.010335229661843406,
0.008949940160889102, 0.0077503288755374055, 0.006711508300522725, 0.005811926744187624,
0.005032921210448704, 0.004358330210530733, 0.003774158471741977, 0.0032682865872356993,
0.00283021958306234, 0.002450869186206985, 0.0021223652764777662, 0.0018378926105679667,
0.0015915494309189536, 0.0013782250260398288, 0.0011934937021124885, 0.0010335229661843405,
0.0008949940160889102, 0.0007750328875537405, 0.0006711508300522726, 0.0005811926744187624,
0.0005032921210448703, 0.0004358330210530733, 0.00037741584717419774, 0.0003268286587235699,
0.00028302195830623395, 0.00024508691862069854, 0.0002122365276477766, 0.00018378926105679666,
0.00015915494309189535, 0.00013782250260398286, 0.00011934937021124886, 0.00010335229661843406,
8.949940160889102e-05, 7.750328875537406e-05, 6.711508300522725e-05, 5.811926744187624e-05,
5.0329212104487035e-05, 4.358330210530732e-05, 3.774158471741978e-05, 3.2682865872357e-05,
2.8302195830623396e-05, 2.4508691862069852e-05, 2.122365276477766e-05, 1.8378926105679668e-05 };

#define XB_TMO      128
#define XB_XCNT(j)  (256  + 64 * (j))
#define XB_XSUB(j)  (1280 + 64 * (j))
#define XB_XGEN(j)  (2304 + 64 * (j))
#define XB_TOP      3328
#define XB_TOPGEN   3392
#define XCD_BAR_WORDS 3456
#define XB_SPIN_CAP (1u << 18)

__device__ __forceinline__ unsigned xb_ld(unsigned* p)              { return __hip_atomic_load(p, __ATOMIC_RELAXED, __HIP_MEMORY_SCOPE_AGENT); }
__device__ __forceinline__ unsigned xb_add(unsigned* p, unsigned v) { return __hip_atomic_fetch_add(p, v, __ATOMIC_RELAXED, __HIP_MEMORY_SCOPE_AGENT); }
__device__ __forceinline__ unsigned xb_xcc_id() { return (unsigned)__builtin_amdgcn_s_getreg((3 << 11) | 20) & 0xFu; }
#define XB_SPIN(cond, bar) do { unsigned _sp = 0; while (cond) { __builtin_amdgcn_s_sleep(1); \
    if ((++_sp & 255u) == 0u) { if (xb_ld(&(bar)[XB_TMO])) break; if (_sp > XB_SPIN_CAP) { atomicAdd(&(bar)[XB_TMO], 1u); break; } } } } while (0)

struct XcdBarrier {
    unsigned* bar; unsigned x;
    volatile LAS unsigned* st;
};

__device__ __forceinline__ XcdBarrier xcd_barrier_post(unsigned* bar, volatile LAS unsigned* st) {
    XcdBarrier b; b.bar = bar; b.x = xb_xcc_id(); b.st = st;
    if (threadIdx.x == 0) (void)xb_add(&bar[XB_XCNT(b.x)], 1u);
    return b;
}
__device__ __forceinline__ void xcd_barrier_complete(unsigned* bar, unsigned x, unsigned& nloc, unsigned& nx) {
    const unsigned G = gridDim.x * gridDim.y * gridDim.z;
    unsigned sum, cnt, mine, sp = 0u;
    for (;;) {
        sum = 0u; cnt = 0u; mine = 0u;
#pragma unroll
        for (unsigned j = 0; j < 16; ++j) { const unsigned c = xb_ld(&bar[XB_XCNT(j)]); sum += c; cnt += (c > 0u) ? 1u : 0u; mine = (j == x) ? c : mine; }
        if (sum == G) break;
        __builtin_amdgcn_s_sleep(1);
        if ((++sp & 255u) == 0u) { if (xb_ld(&bar[XB_TMO])) break; if (sp > XB_SPIN_CAP) { atomicAdd(&bar[XB_TMO], 1u); break; } }
    }
    nloc = mine > 0u ? mine : 1u; nx = cnt > 0u ? cnt : 1u;
}

__device__ __forceinline__ void xcd_barrier(const XcdBarrier& b) {
    asm volatile("s_waitcnt vmcnt(0)" ::: "memory");
    __syncthreads();
    if (threadIdx.x == 0) {
        unsigned* bar = b.bar;
        __builtin_amdgcn_s_waitcnt(0);
        unsigned nloc = b.st[0], nx = b.st[1];
        if (nloc == 0u) { xcd_barrier_complete(bar, b.x, nloc, nx); b.st[0] = nloc; b.st[1] = nx; }
        const unsigned old = xb_add(&bar[XB_XSUB(b.x)], 1u);
        const unsigned gen = old / nloc;
        if (old + 1u == (gen + 1u) * nloc) {
            __builtin_amdgcn_fence(__ATOMIC_RELEASE, "agent");
            asm volatile("s_waitcnt vmcnt(0)" ::: "memory");
            const unsigned og = xb_add(&bar[XB_TOP], 1u);
            const unsigned tg = og / nx;
            if (og + 1u == (tg + 1u) * nx) xb_add(&bar[XB_TOPGEN], 1u);
            else XB_SPIN(xb_ld(&bar[XB_TOPGEN]) == tg, bar);
            __builtin_amdgcn_fence(__ATOMIC_ACQUIRE, "agent");
            xb_add(&bar[XB_XGEN(b.x)], 1u);
            asm volatile("s_waitcnt vmcnt(0)" ::: "memory");
        } else {
            XB_SPIN(xb_ld(&bar[XB_XGEN(b.x)]) == gen, bar);
            __builtin_amdgcn_fence(__ATOMIC_ACQUIRE, "agent");
            asm volatile("s_waitcnt vmcnt(0)" ::: "memory");
        }
    }
    __syncthreads();
}


struct Frame {
    LAS unsigned char* lds;
    volatile LAS unsigned* MISC;
    int tid, lane, wave;
    int vcu, G;
    float* out; unsigned char* ws;
};
struct Args { const float* in[24]; float* out; unsigned char* ws; int ph_lo, ph_hi, li, pad; };
#define WSP(T, off) ((T*)(F.ws + (off)))
#define WSPG(T, off) ((T*)(GAS T*)(unsigned long long)(F.ws + (off)))
#define WSW(l, off) ((bf16*)(F.ws + WS_WSET + (size_t)((l) & 1) * WSET_BYTES + (off)))
#define WSWG(l, off) ((bf16*)(GAS bf16*)(unsigned long long)(F.ws + WS_WSET + (size_t)((l) & 1) * WSET_BYTES + (off)))
#define OUTP ((float*)F.out)
#define OUTPG ((float*)(GAS float*)(unsigned long long)F.out)
#define INP(A, i) ((const float*)((const GAS float*)(A)->in[i]))
#define CAS __attribute__((address_space(4)))
typedef const CAS Args* ArgP;

__device__ __forceinline__ float fexp(float x) { return __builtin_amdgcn_exp2f(x * 1.4426950408889634f); }
__device__ __forceinline__ float fsig(float x) { return __builtin_amdgcn_rcpf(1.0f + fexp(-x)); }
__device__ __forceinline__ float ftanh(float x) { return 1.0f - 2.0f * __builtin_amdgcn_rcpf(1.0f + fexp(2.0f * x)); }
__device__ __forceinline__ float wave_sum(float v) {
#pragma unroll
    for (int o = 1; o < 64; o <<= 1) v += __shfl_xor(v, o);
    return v;
}
__device__ __forceinline__ void transpose_item(const float* W, int K, int N, bf16* WT, LAS float* scr, int item, int lane, const float* gk = nullptr) {
    const int nblk = N / 32, kb = item / nblk, nb = item % nblk, k0 = 64 * kb, n0 = 32 * nb;
#pragma unroll 8
    for (int i = 0; i < 32; ++i) { const int kk = 2 * i + (lane >> 5); scr[kk * 33 + (lane & 31)] = W[(size_t)(k0 + kk) * N + n0 + (lane & 31)]; }
    const int c = lane & 7;
    f32x4 g0 = (f32x4){1.f, 1.f, 1.f, 1.f}, g1 = g0;
    if (gk) { g0 = *(const GAS f32x4*)(gk + k0 + 8 * c); g1 = *(const GAS f32x4*)(gk + k0 + 8 * c + 4); }
    LDS_WAIT(); asm volatile("" ::: "memory");
#pragma unroll
    for (int j = 0; j < 4; ++j) { const int n = (lane >> 3) + 8 * j; const LAS float* s = scr + (8 * c) * 33 + n;
        v4u o; o.x = pk2(s[0 * 33] * g0.x, s[1 * 33] * g0.y); o.y = pk2(s[2 * 33] * g0.z, s[3 * 33] * g0.w); o.z = pk2(s[4 * 33] * g1.x, s[5 * 33] * g1.y); o.w = pk2(s[6 * 33] * g1.z, s[7 * 33] * g1.w);
        *(GAS v4u*)(WT + (size_t)(n0 + n) * K + k0 + 8 * c) = o; }
    LDS_WAIT(); asm volatile("" ::: "memory");
}
__device__ __forceinline__ void rms_row_to_bf16(const float* xrow, const float* g, bf16* orow, int lane) {
    const GAS f32x4* xr = (const GAS f32x4*)xrow + lane;
    f32x4 v[8]; float s = 0.f;
#pragma unroll
    for (int j = 0; j < 8; ++j) { v[j] = xr[64 * j]; s += (v[j].x * v[j].x + v[j].y * v[j].y) + (v[j].z * v[j].z + v[j].w * v[j].w); }
    const float rstd = 1.f / sqrtf(wave_sum(s) * (1.f / D) + NORM_EPS);
    const GAS f32x4* gr = (const GAS f32x4*)g + lane;
    GAS v2u* o8 = (GAS v2u*)orow + lane;
#pragma unroll
    for (int j = 0; j < 8; ++j) { const f32x4 gg = gr[64 * j]; v2u o; o.x = pk2(v[j].x * rstd * gg.x, v[j].y * rstd * gg.y); o.y = pk2(v[j].z * rstd * gg.z, v[j].w * rstd * gg.w); o8[64 * j] = o; }
}

#if (MK_GLOBAL_GROUPS & 1)
#pragma push_macro("WSP")
#pragma push_macro("WSW")
#pragma push_macro("OUTP")
#undef WSP
#undef WSW
#undef OUTP
#define WSP WSPG
#define WSW WSWG
#define OUTP OUTPG
#endif
__device__ __forceinline__ void ph_prologue(Frame& F, ArgP A) {
    const int* pos = (const int*)INP(A, 1); float2* rope = WSP(float2, WS_ROPE);
    {
        const int gw = F.vcu * NWAVES + F.wave, NGW = F.G * NWAVES, lane = F.lane;
        for (int m = gw; m < M; m += NGW) {
            const GAS f32x4* xr = (const GAS f32x4*)(INP(A, 0) + (size_t)m * D) + lane; GAS f32x4* orow = (GAS f32x4*)(OUTP + (size_t)m * D) + lane;
            GAS v2u* hb = (GAS v2u*)(WSP(bf16, WS_H) + (size_t)m * D) + lane; float s = 0.f;
#pragma unroll
            for (int j = 0; j < 8; ++j) { const f32x4 v = xr[64 * j]; orow[64 * j] = v; v2u o; o.x = pk2(v.x, v.y); o.y = pk2(v.z, v.w); hb[64 * j] = o; s += (v.x * v.x + v.y * v.y) + (v.z * v.z + v.w * v.w); }
            s = wave_sum(s);
            if (lane < 32) WSP(float, WS_SS)[(size_t)m * 32 + lane] = lane == 0 ? s : 0.f;
        }
    }
    for (int i = F.vcu * 512 + F.tid; i < M * 64; i += F.G * 512) {
        const int m = i >> 6, j = i & 63;
        const double rev = (double)pos[m] * ROPE_REV[j];
        const float fr = (float)(rev - __builtin_rint(rev));
        rope[i] = make_float2(__builtin_amdgcn_cosf(fr), __builtin_amdgcn_sinf(fr));
    }
}
#if (MK_GLOBAL_GROUPS & 1)
#pragma pop_macro("WSP")
#pragma pop_macro("WSW")
#pragma pop_macro("OUTP")
#endif
#if (MK_GLOBAL_GROUPS & 16)
#pragma push_macro("WSP")
#pragma push_macro("WSW")
#pragma push_macro("OUTP")
#undef WSP
#undef WSW
#undef OUTP
#define WSP WSPG
#define WSW WSWG
#define OUTP OUTPG
#endif
__device__ __forceinline__ void ph_convert(Frame& F, ArgP A, int l, int wg, int nwg) {
    LAS float* scr = (LAS float*)(F.lds + RING_OFF + F.wave * 16384);
    const int gw = wg * NWAVES + F.wave, NGW = nwg * NWAVES;
    constexpr int I_IN = (D / 64) * (INW / 32), I_A = (RETW / 64) * (D / 32), I_O = (D / 64) * (D / 32), I_UP = (D / 64) * (DFF / 32), I_DN = (DFF / 64) * (D / 32);
    constexpr int NITEMS = I_IN + 2 * I_A + I_O + I_UP + I_DN + 32 + 32 + 64;
    for (int it = gw; it < NITEMS; it += NGW) {
        int r = it;
        if (r < I_IN) { transpose_item(INP(A, 3) + (size_t)l * D * INW, D, INW, WSW(l, WO_WIN), scr, r, F.lane, INP(A, 2) + (size_t)l * D); continue; } r -= I_IN;
        if (r < I_A) { transpose_item(INP(A, 17) + (size_t)l * RETW * D, RETW, D, WSW(l, WO_WA), scr, r, F.lane); continue; } r -= I_A;
        if (r < I_A) { transpose_item(INP(A, 18) + (size_t)l * RWW * D, RWW, D, WSW(l, WO_WB), scr, r, F.lane); continue; } r -= I_A;
        if (r < I_O) { transpose_item(INP(A, 19) + (size_t)l * D * D, D, D, WSW(l, WO_WO), scr, r, F.lane); continue; } r -= I_O;
        if (r < I_UP) { transpose_item(INP(A, 21) + (size_t)l * D * DFF, D, DFF, WSW(l, WO_WUP), scr, r, F.lane, INP(A, 20) + (size_t)l * D); continue; } r -= I_UP;
        if (r < I_DN) { transpose_item(INP(A, 22) + (size_t)l * DFF * D, DFF, D, WSW(l, WO_WDN), scr, r, F.lane); continue; } r -= I_DN;
        if (r < 32) { transpose_item(INP(A, 8) + (size_t)l * 64 * RWW, 64, RWW, WSW(l, WO_LORA), scr, r, F.lane); continue; } r -= 32;
        if (r < 32) { transpose_item(INP(A, 10) + (size_t)l * 64 * RWW, 64, RWW, WSW(l, WO_LORA) + 1024 * 64, scr, r, F.lane); continue; } r -= 32;
        transpose_item(INP(A, 11) + (size_t)l * 128 * RWW, 128, RWW, WSW(l, WO_LORA) + 2 * 1024 * 64, scr, r, F.lane);
    }
}
__device__ __forceinline__ void ph_norm(Frame& F, const float* g) {
    const int gw = F.vcu * NWAVES + F.wave, NGW = F.G * NWAVES;
    for (int m = gw; m < M; m += NGW) rms_row_to_bf16(OUTP + (size_t)m * D, g, WSP(bf16, WS_H) + (size_t)m * D, F.lane);
}
#if (MK_GLOBAL_GROUPS & 16)
#pragma pop_macro("WSP")
#pragma pop_macro("WSW")
#pragma pop_macro("OUTP")
#endif
#if (MK_GLOBAL_GROUPS & 2)
#pragma push_macro("WSP")
#pragma push_macro("WSW")
#pragma push_macro("OUTP")
#undef WSP
#undef WSW
#undef OUTP
#define WSP WSPG
#define WSW WSWG
#define OUTP OUTPG
#endif
__device__ __forceinline__ void unpack8(const v4u a, float (&o)[8]) {
    o[0] = pg8::bf_lo(a.x); o[1] = pg8::bf_hi(a.x); o[2] = pg8::bf_lo(a.y); o[3] = pg8::bf_hi(a.y); o[4] = pg8::bf_lo(a.z); o[5] = pg8::bf_hi(a.z); o[6] = pg8::bf_lo(a.w); o[7] = pg8::bf_hi(a.w);
}
__device__ __forceinline__ void mix8(const GAS bf16* zc, bool has_prev, const GAS float* mu, float (&o)[8]) {
    const v4u a = *(const GAS v4u*)zc; v4u p = (v4u){0u, 0u, 0u, 0u}; if (has_prev) p = *(const GAS v4u*)(zc - INW);
    const f32x4 m0 = *(const GAS f32x4*)mu, m1 = *(const GAS f32x4*)(mu + 4);
    float z[8], q[8]; unpack8(a, z); unpack8(p, q);
#pragma unroll
    for (int j = 0; j < 4; ++j) { o[j] = z[j] + m0[j] * (q[j] - z[j]); o[4 + j] = z[4 + j] + m1[j] * (q[4 + j] - z[4 + j]); }
}
__device__ __forceinline__ f32x4 mix4(const GAS bf16* zc, bool has_prev, const GAS float* mu) {
    const v2u a = *(const GAS v2u*)zc; v2u p = (v2u){0u, 0u}; if (has_prev) p = *(const GAS v2u*)(zc - INW);
    const f32x4 m = *(const GAS f32x4*)mu;
    const f32x4 z = (f32x4){pg8::bf_lo(a.x), pg8::bf_hi(a.x), pg8::bf_lo(a.y), pg8::bf_hi(a.y)}, q = (f32x4){pg8::bf_lo(p.x), pg8::bf_hi(p.x), pg8::bf_lo(p.y), pg8::bf_hi(p.y)};
    return z + m * (q - z);
}
__device__ __forceinline__ bf16x8 pack8(const float (&v)[8]) {
    v4u o; o.x = pg8::cvt_pk_bf16(v[0], v[1]); o.y = pg8::cvt_pk_bf16(v[2], v[3]); o.z = pg8::cvt_pk_bf16(v[4], v[5]); o.w = pg8::cvt_pk_bf16(v[6], v[7]);
    return __builtin_bit_cast(bf16x8, o);
}
__device__ __forceinline__ void ph_prep(Frame& F, ArgP A, int l) {
    const int gw = F.vcu * NWAVES + F.wave, NGW = F.G * NWAVES, lane = F.lane, l15 = lane & 15, g = lane >> 4;
    {
        const int h = lane >> 3, i0 = 8 * (lane & 7);
        for (int m = gw; m < M; m += NGW) {
            const GAS bf16* zrow = (const GAS bf16*)(WSP(bf16, WS_Z) + (size_t)m * INW);
            const GAS f32x4* rp = (const GAS f32x4*)(WSP(float2, WS_ROPE) + (size_t)m * 64 + i0);
            const f32x4 c01 = rp[0], c23 = rp[1], c45 = rp[2], c67 = rp[3];
            const float cs[8] = {c01.x, c01.z, c23.x, c23.z, c45.x, c45.z, c67.x, c67.z}, sn[8] = {c01.y, c01.w, c23.y, c23.w, c45.y, c45.w, c67.y, c67.w};
            float q1[8], q2[8], k1[8], k2[8], o1[8], o2[8];
            unpack8(*(const GAS v4u*)(zrow + ZC_Q + h * RD + i0), q1); unpack8(*(const GAS v4u*)(zrow + ZC_Q + h * RD + 64 + i0), q2);
            unpack8(*(const GAS v4u*)(zrow + ZC_K + h * RD + i0), k1); unpack8(*(const GAS v4u*)(zrow + ZC_K + h * RD + 64 + i0), k2);
#pragma unroll
            for (int j = 0; j < 8; ++j) { o1[j] = q1[j] * cs[j] - q2[j] * sn[j]; o2[j] = q2[j] * cs[j] + q1[j] * sn[j]; }
            GAS bf16* qo = (GAS bf16*)(WSP(bf16, WS_QR) + (size_t)m * RETW + h * RD + i0);
            *(GAS bf16x8*)qo = pack8(o1); *(GAS bf16x8*)(qo + 64) = pack8(o2);
#pragma unroll
            for (int j = 0; j < 8; ++j) { const float a = k1[j] * 0.08838834764831845f, b = k2[j] * 0.08838834764831845f; o1[j] = a * cs[j] - b * sn[j]; o2[j] = b * cs[j] + a * sn[j]; }
            GAS bf16* ko = (GAS bf16*)(WSP(bf16, WS_KR) + (size_t)m * RETW + h * RD + i0);
            *(GAS bf16x8*)ko = pack8(o1); *(GAS bf16x8*)(ko + 64) = pack8(o2);
        }
    }
    const GAS float* mu = (const GAS float*)(INP(A, 6) + (size_t)l * RWSHIFT);
    const GAS float* w0 = (const GAS float*)(INP(A, 7) + (size_t)l * RWW); const GAS float* a0 = (const GAS float*)(INP(A, 9) + (size_t)l * RWW);
    const GAS float* kkw = (const GAS float*)(INP(A, 12) + (size_t)l * RWW); const GAS float* kaw = (const GAS float*)(INP(A, 13) + (size_t)l * RWW); const GAS float* rkw = (const GAS float*)(INP(A, 14) + (size_t)l * RWW);
    const GAS bf16* WupT = (const GAS bf16*)WSW(l, WO_LORA); const GAS bf16* AupT = WupT + 1024 * 64; const GAS bf16* GupT = AupT + 1024 * 64;
    for (int task = gw; task < M / 8; task += NGW) {
        const int m = (task >> 1) * 16 + l15, hh0 = (task & 1) * (WH / 2);
        const bool has_prev = (m % SEQ) != 0;
        const GAS bf16* zr = (const GAS bf16*)(WSP(bf16, WS_Z) + (size_t)m * INW + ZC_RW);
        bf16x8 fw[2], fa[2], fg[4];
#pragma unroll
        for (int ks = 0; ks < 2; ++ks) { float t[8];
            mix8(zr + RWC_W + 32 * ks + 8 * g, has_prev, mu + RWC_W + 32 * ks + 8 * g, t);
#pragma unroll
            for (int j = 0; j < 8; ++j) t[j] = ftanh(t[j]);
            fw[ks] = pack8(t);
            mix8(zr + RWC_A + 32 * ks + 8 * g, has_prev, mu + RWC_A + 32 * ks + 8 * g, t); fa[ks] = pack8(t); }
#pragma unroll
        for (int ks = 0; ks < 4; ++ks) { float t[8];
            mix8(zr + RWC_G + 32 * ks + 8 * g, has_prev, mu + RWC_G + 32 * ks + 8 * g, t);
#pragma unroll
            for (int j = 0; j < 8; ++j) t[j] = fsig(t[j]);
            fg[ks] = pack8(t); }
        for (int hh = hh0; hh < hh0 + WH / 2; ++hh) {
            f32x4 kkr[4], av[4]; float ss = 0.f, bonus = 0.f;
#pragma unroll
            for (int nt = 0; nt < 4; ++nt) {
                const int cf = hh * WD + nt * 16 + l15;
                const int c0 = hh * WD + nt * 16 + 4 * g;
                f32x4 wl = *(const GAS f32x4*)(w0 + c0), al = *(const GAS f32x4*)(a0 + c0), gl = (f32x4){0.f, 0.f, 0.f, 0.f};
#pragma unroll
                for (int ks = 0; ks < 2; ++ks) {
                    wl = __builtin_amdgcn_mfma_f32_16x16x32_bf16(*(const GAS bf16x8*)(WupT + (size_t)cf * 64 + 32 * ks + 8 * g), fw[ks], wl, 0, 0, 0);
                    al = __builtin_amdgcn_mfma_f32_16x16x32_bf16(*(const GAS bf16x8*)(AupT + (size_t)cf * 64 + 32 * ks + 8 * g), fa[ks], al, 0, 0, 0); }
#pragma unroll
                for (int ks = 0; ks < 4; ++ks)
                    gl = __builtin_amdgcn_mfma_f32_16x16x32_bf16(*(const GAS bf16x8*)(GupT + (size_t)cf * 128 + 32 * ks + 8 * g), fg[ks], gl, 0, 0, 0);
                const f32x4 r = mix4(zr + RWC_R + c0, has_prev, mu + RWC_R + c0), k = mix4(zr + RWC_K + c0, has_prev, mu + RWC_K + c0), v = mix4(zr + RWC_V + c0, has_prev, mu + RWC_V + c0);
                const f32x4 kk4 = *(const GAS f32x4*)(kkw + c0), ka4 = *(const GAS f32x4*)(kaw + c0), rk4 = *(const GAS f32x4*)(rkw + c0);
                f32x4 decay, a, kp;
#pragma unroll
                for (int i = 0; i < 4; ++i) {
                    decay[i] = fexp(-0.6065306597126334f * fsig(wl[i]));
                    a[i] = fsig(al[i]);
                    kp[i] = k[i] * (1.0f + (a[i] - 1.0f) * ka4[i]);
                }
                kkr[nt] = k * kk4; av[nt] = a;
                ss += (kkr[nt].x * kkr[nt].x + kkr[nt].y * kkr[nt].y) + (kkr[nt].z * kkr[nt].z + kkr[nt].w * kkr[nt].w);
                const f32x4 rb = r * kp * rk4; bonus += (rb.x + rb.y) + (rb.z + rb.w);
                const size_t o = (size_t)m * RWW + c0;
                *(GAS f32x4*)(WSP(float, WS_SR) + o) = r; *(GAS f32x4*)(WSP(float, WS_SW) + o) = decay; *(GAS f32x4*)(WSP(float, WS_SK) + o) = kp;
                *(GAS f32x4*)(WSP(float, WS_SV) + o) = v; *(GAS f32x4*)(WSP(float, WS_G) + o) = gl;
            }
            ss += __shfl_xor(ss, 16); ss += __shfl_xor(ss, 32); bonus += __shfl_xor(bonus, 16); bonus += __shfl_xor(bonus, 32);
            const float inv = 1.0f / fmaxf(sqrtf(ss), 1e-12f);
#pragma unroll
            for (int nt = 0; nt < 4; ++nt) { const size_t o = (size_t)m * RWW + hh * WD + nt * 16 + 4 * g; const f32x4 kk = kkr[nt] * inv;
                *(GAS f32x4*)(WSP(float, WS_SNKK) + o) = -kk; *(GAS f32x4*)(WSP(float, WS_SKKA) + o) = kk * av[nt]; }
            if (g == 0) WSP(float, WS_BONUS)[(size_t)m * WH + hh] = bonus;
        }
    }
}
#if (MK_GLOBAL_GROUPS & 2)
#pragma pop_macro("WSP")
#pragma pop_macro("WSW")
#pragma pop_macro("OUTP")
#endif
#if (MK_GLOBAL_GROUPS & 4)
#pragma push_macro("WSP")
#pragma push_macro("WSW")
#pragma push_macro("OUTP")
#undef WSP
#undef WSW
#undef OUTP
#define WSP WSPG
#define WSW WSWG
#define OUTP OUTPG
#endif
__device__ __forceinline__ void scan_rwkv_naive(Frame& F, int item) {
    const int lane = F.lane;
    float st[64];
#pragma unroll
    for (int j = 0; j < 64; ++j) st[j] = 0.f;
    const size_t base0 = (size_t)(item >> 4) * SEQ * RWW + (size_t)(item & 15) * WD + lane;
    for (int t = 0; t < SEQ; ++t) {
        const size_t o = base0 + (size_t)t * RWW;
        const float r = WSP(float, WS_SR)[o], w = WSP(float, WS_SW)[o], k = WSP(float, WS_SK)[o], v = WSP(float, WS_SV)[o], nk = WSP(float, WS_SNKK)[o], ka = WSP(float, WS_SKKA)[o];
        float sa = 0.f;
#pragma unroll
        for (int j = 0; j < 64; ++j) sa += st[j] * rdlane(nk, j);
        float y = 0.f;
#pragma unroll
        for (int j = 0; j < 64; ++j) { st[j] = st[j] * rdlane(w, j) + sa * rdlane(ka, j) + v * rdlane(k, j); y += st[j] * rdlane(r, j); }
        WSP(float, WS_YRAWW)[o] = y;
    }
}
__device__ __forceinline__ void scan_ret_naive(Frame& F, int item) {
    const int lane = F.lane, b = item >> 4, h = (item >> 1) & 7, half = item & 1;
    const float gam = 1.0f - exp2f((float)(-5 - h));
    float R[128];
#pragma unroll
    for (int j = 0; j < 128; ++j) R[j] = 0.f;
    for (int t = 0; t < SEQ; ++t) {
        const size_t m = (size_t)b * SEQ + t;
        const float q1 = bf2f(WSP(bf16, WS_QR)[m * RETW + h * RD + lane]), q2 = bf2f(WSP(bf16, WS_QR)[m * RETW + h * RD + 64 + lane]);
        const float k1 = bf2f(WSP(bf16, WS_KR)[m * RETW + h * RD + lane]), k2 = bf2f(WSP(bf16, WS_KR)[m * RETW + h * RD + 64 + lane]);
        const float v = bf2f(WSP(bf16, WS_Z)[m * INW + ZC_V + h * RD + half * 64 + lane]);
        float y = 0.f;
#pragma unroll
        for (int d = 0; d < 64; ++d) { R[d] = gam * R[d] + rdlane(k1, d) * v; y += rdlane(q1, d) * R[d]; }
#pragma unroll
        for (int d = 0; d < 64; ++d) { R[64 + d] = gam * R[64 + d] + rdlane(k2, d) * v; y += rdlane(q2, d) * R[64 + d]; }
        WSP(float, WS_YRAWR)[m * RETW + h * RD + half * 64 + lane] = y;
    }
}
constexpr int SCT = 32;
constexpr int SC_ARR = SCT * 64 * 4;
constexpr int SC_BUF = 5 * SC_ARR + SCT * 16 * 4;
static_assert(2 * SC_BUF <= RING_BYTES, "scan LDS");
template <int CTRL> __device__ __forceinline__ float dppf(float x) { return __builtin_bit_cast(float, __builtin_amdgcn_update_dpp(0, __builtin_bit_cast(int, x), CTRL, 0xF, 0xF, true)); }
__device__ __forceinline__ float sum16(float x) {
    x += dppf<0xB1>(x); x += dppf<0x4E>(x); x += dppf<0x141>(x); x += dppf<0x140>(x); return x;
}
__device__ __forceinline__ void scan_rwkv_fast(Frame& F, int w) {
    const int b = w >> 6, hh = (w >> 2) & 15, q = w & 3;
    const int lane = F.lane, wave = F.wave;
    LAS unsigned char* base = F.lds + RING_OFF;
    const size_t g0 = (size_t)b * SEQ * RWW + (size_t)hh * WD;
    constexpr int NBLK = SEQ / SCT;
#define SC_BAR() do { asm volatile("s_waitcnt lgkmcnt(0)" ::: "memory"); __builtin_amdgcn_s_barrier(); asm volatile("" ::: "memory"); } while (0)
    if (wave >= 4) {
        const int lt = F.tid - 256;
        const float* a0 = WSP(float, WS_SR) + g0; const float* a1 = WSP(float, WS_SW) + g0; const float* a2 = WSP(float, WS_SK) + g0;
        const float* a3 = WSP(float, WS_SNKK) + g0; const float* a4 = WSP(float, WS_SKKA) + g0; const float* av = WSP(float, WS_SV) + g0 + 16 * q;
        const int f0 = lt, f1 = lt + 256;
        const size_t o0 = (size_t)(f0 >> 4) * RWW + 4 * (f0 & 15), o1 = (size_t)(f1 >> 4) * RWW + 4 * (f1 & 15), ov = (size_t)(lt >> 2) * RWW + 4 * (lt & 3);
        f32x4 r0[5], r1[5], rv;
#define SC_LOAD(blk) do { const size_t tb = (size_t)(blk) * SCT * RWW; \
        r0[0] = *(const GAS f32x4*)(a0 + tb + o0); r1[0] = *(const GAS f32x4*)(a0 + tb + o1); r0[1] = *(const GAS f32x4*)(a1 + tb + o0); r1[1] = *(const GAS f32x4*)(a1 + tb + o1); \
        r0[2] = *(const GAS f32x4*)(a2 + tb + o0); r1[2] = *(const GAS f32x4*)(a2 + tb + o1); r0[3] = *(const GAS f32x4*)(a3 + tb + o0); r1[3] = *(const GAS f32x4*)(a3 + tb + o1); \
        r0[4] = *(const GAS f32x4*)(a4 + tb + o0); r1[4] = *(const GAS f32x4*)(a4 + tb + o1); if (lt < 128) rv = *(const GAS f32x4*)(av + tb + ov); } while (0)
#define SC_STORE(bi) do { LAS unsigned char* bb = base + (bi) * SC_BUF; \
        _Pragma("unroll") for (int a = 0; a < 5; ++a) { *(LAS f32x4*)(bb + a * SC_ARR + f0 * 16) = r0[a]; *(LAS f32x4*)(bb + a * SC_ARR + f1 * 16) = r1[a]; } \
        if (lt < 128) *(LAS f32x4*)(bb + 5 * SC_ARR + lt * 16) = rv; } while (0)
        SC_LOAD(0); SC_STORE(0);
        if (1 < NBLK) SC_LOAD(1);
        SC_BAR();
        for (int blk = 0; blk < NBLK; ++blk) {
            if (blk + 1 < NBLK) { SC_STORE((blk + 1) & 1); if (blk + 2 < NBLK) SC_LOAD(blk + 2); }
            SC_BAR();
        }
#undef SC_LOAD
#undef SC_STORE
    } else {
        const int l16 = lane & 15, rowl = 4 * wave + (lane >> 4);
        GAS float* Y = (GAS float*)(WSP(float, WS_YRAWW) + g0 + 16 * q + rowl);
        f32x4 st = (f32x4){0.f, 0.f, 0.f, 0.f};
        const int lo = l16 * 16, vo = 5 * SC_ARR + rowl * 4;
#define SC_LD(tt_, R4, W4, K4, N4, A4, V) do { R4 = *(const LAS f32x4*)(bb + 0 * SC_ARR + (tt_) * 256 + lo); W4 = *(const LAS f32x4*)(bb + 1 * SC_ARR + (tt_) * 256 + lo); \
        K4 = *(const LAS f32x4*)(bb + 2 * SC_ARR + (tt_) * 256 + lo); N4 = *(const LAS f32x4*)(bb + 3 * SC_ARR + (tt_) * 256 + lo); A4 = *(const LAS f32x4*)(bb + 4 * SC_ARR + (tt_) * 256 + lo); \
        V = *(const LAS float*)(bb + vo + (tt_) * 64); } while (0)
        SC_BAR();
        for (int blk = 0; blk < NBLK; ++blk) {
            const LAS unsigned char* bb = base + (blk & 1) * SC_BUF;
            GAS float* yb = Y + (size_t)blk * SCT * RWW;
            f32x4 r4[3], w4[3], k4[3], n4[3], a4[3]; float v[3];
            SC_LD(0, r4[0], w4[0], k4[0], n4[0], a4[0], v[0]);
            SC_LD(1, r4[1], w4[1], k4[1], n4[1], a4[1], v[1]);
#pragma unroll
            for (int tt = 0; tt < SCT; ++tt) {
                const int c = tt % 3, p = (tt + 2) % 3;
                if (tt + 2 < SCT) SC_LD(tt + 2, r4[p], w4[p], k4[p], n4[p], a4[p], v[p]);
                f32x2 sp2 = (f32x2){st.x, st.y} * (f32x2){n4[c].x, n4[c].y}; sp2 = (f32x2){st.z, st.w} * (f32x2){n4[c].z, n4[c].w} + sp2;
                const f32x4 t0 = st * w4[c] + k4[c] * v[c];
                const float sa = sum16(sp2.x + sp2.y);
                st = a4[c] * sa + t0;
                f32x2 yp2 = (f32x2){st.x, st.y} * (f32x2){r4[c].x, r4[c].y}; yp2 = (f32x2){st.z, st.w} * (f32x2){r4[c].z, r4[c].w} + yp2;
                const float y = sum16(yp2.x + yp2.y);
                yb[(size_t)tt * RWW] = y;
            }
            SC_BAR();
        }
#undef SC_LD
#undef SC_BAR
    }
}
constexpr int RT_STR = 288, RT_QS = 0, RT_KS = 128 * RT_STR, RT_VSTR = 80, RT_VS = 2 * 128 * RT_STR, RT_VPS = RT_VS + 128 * RT_VSTR, RT_RT = RT_VPS + 128 * RT_VSTR, RT_RTSZ = 32 * RT_STR;
static_assert(RT_RT + 2 * RT_RTSZ <= RING_BYTES, "retention LDS");
typedef short s4v __attribute__((ext_vector_type(4)));
__device__ __forceinline__ bf16x8 tr8(const LAS unsigned char* p0, const LAS unsigned char* p1) {
    const s4v a = __builtin_amdgcn_ds_read_tr16_b64_v4i16((LAS s4v*)p0), b = __builtin_amdgcn_ds_read_tr16_b64_v4i16((LAS s4v*)p1);
    return (bf16x8){a.x, a.y, a.z, a.w, b.x, b.y, b.z, b.w};
}
__device__ __forceinline__ void scan_ret_mfma(Frame& F, int w_) {
    const int b = w_ >> 5, h = (w_ >> 2) & 7, eq = w_ & 3;
    const int tid = F.tid, lane = F.lane, w = F.wave, l15 = lane & 15, g = lane >> 4, tq = l15 >> 2, tp = l15 & 3;
    LAS unsigned char* L = F.lds + RING_OFF;
    const float lg2 = log1pf(-exp2f((float)(-5 - h))) * 1.4426950408889634f;
    const float gC = __builtin_amdgcn_exp2f(lg2 * 128.f);
    for (int i = tid; i < RT_RTSZ / 4; i += NWAVES * 64) ((LAS unsigned*)(L + RT_RT))[i] = 0u;
    const GAS bf16* Qg = (const GAS bf16*)(WSP(bf16, WS_QR) + (size_t)b * SEQ * RETW + h * RD);
    const GAS bf16* Kg = (const GAS bf16*)(WSP(bf16, WS_KR) + (size_t)b * SEQ * RETW + h * RD);
    const GAS bf16* Vg = (const GAS bf16*)(WSP(bf16, WS_Z) + (size_t)b * SEQ * INW + ZC_V + h * RD + 32 * eq);
    GAS float* Yg = (GAS float*)(WSP(float, WS_YRAWR) + (size_t)b * SEQ * RETW + h * RD + 32 * eq);
    v4u rq[4], rk[4], rv;
#define RT_LOAD(n_) do { _Pragma("unroll") for (int i = 0; i < 4; ++i) { const int f = tid + 512 * i, c = f >> 4, pc = f & 15; \
        rq[i] = *(const GAS v4u*)(Qg + (size_t)((n_) * 128 + c) * RETW + 8 * pc); rk[i] = *(const GAS v4u*)(Kg + (size_t)((n_) * 128 + c) * RETW + 8 * pc); } \
        rv = *(const GAS v4u*)(Vg + (size_t)((n_) * 128 + (tid >> 2)) * INW + 8 * (tid & 3)); } while (0)
    f32x4 accR[2] = {(f32x4){0.f, 0.f, 0.f, 0.f}, (f32x4){0.f, 0.f, 0.f, 0.f}};
    RT_LOAD(0);
    for (int n = 0; n < SEQ / 128; ++n) {
#pragma unroll
        for (int i = 0; i < 4; ++i) { const int f = tid + 512 * i, c = f >> 4, pc = f & 15;
            *(LAS v4u*)(L + RT_QS + c * RT_STR + pc * 16) = rq[i]; *(LAS v4u*)(L + RT_KS + c * RT_STR + pc * 16) = rk[i]; }
        { const int c = tid >> 2, pc = tid & 3; *(LAS v4u*)(L + RT_VS + c * RT_VSTR + pc * 16) = rv;
          const float sc = __builtin_amdgcn_exp2f(lg2 * (float)(127 - c)); v4u o;
          o.x = pg8::cvt_pk_bf16(pg8::bf_lo(rv.x) * sc, pg8::bf_hi(rv.x) * sc); o.y = pg8::cvt_pk_bf16(pg8::bf_lo(rv.y) * sc, pg8::bf_hi(rv.y) * sc);
          o.z = pg8::cvt_pk_bf16(pg8::bf_lo(rv.z) * sc, pg8::bf_hi(rv.z) * sc); o.w = pg8::cvt_pk_bf16(pg8::bf_lo(rv.w) * sc, pg8::bf_hi(rv.w) * sc);
          *(LAS v4u*)(L + RT_VPS + c * RT_VSTR + pc * 16) = o; }
        __syncthreads();
        if (n + 1 < SEQ / 128) RT_LOAD(n + 1);
        bf16x8 qf[4];
#pragma unroll
        for (int ks = 0; ks < 4; ++ks) qf[ks] = *(const LAS bf16x8*)(L + RT_QS + (16 * w + l15) * RT_STR + (32 * ks + 8 * g) * 2);
        bf16x8 pf[4];
        const int cq = 16 * w + l15;
#pragma unroll
        for (int p = 0; p < 4; ++p) {
            f32x4 s0 = (f32x4){0.f, 0.f, 0.f, 0.f}, s1 = (f32x4){0.f, 0.f, 0.f, 0.f};
            if (2 * p <= w) {
#pragma unroll
                for (int ks = 0; ks < 4; ++ks) { const bf16x8 kf = *(const LAS bf16x8*)(L + RT_KS + (32 * p + l15) * RT_STR + (32 * ks + 8 * g) * 2);
                    s0 = __builtin_amdgcn_mfma_f32_16x16x32_bf16(kf, qf[ks], s0, 0, 0, 0); }
            }
            if (2 * p + 1 <= w) {
#pragma unroll
                for (int ks = 0; ks < 4; ++ks) { const bf16x8 kf = *(const LAS bf16x8*)(L + RT_KS + (32 * p + 16 + l15) * RT_STR + (32 * ks + 8 * g) * 2);
                    s1 = __builtin_amdgcn_mfma_f32_16x16x32_bf16(kf, qf[ks], s1, 0, 0, 0); }
            }
            float p0[4], p1[4];
#pragma unroll
            for (int i = 0; i < 4; ++i) { const int d0 = cq - (32 * p + 4 * g + i), d1 = d0 - 16;
                p0[i] = d0 >= 0 ? s0[i] * __builtin_amdgcn_exp2f(lg2 * (float)d0) : 0.f; p1[i] = d1 >= 0 ? s1[i] * __builtin_amdgcn_exp2f(lg2 * (float)d1) : 0.f; }
            v4u pk; pk.x = pg8::cvt_pk_bf16(p0[0], p0[1]); pk.y = pg8::cvt_pk_bf16(p0[2], p0[3]); pk.z = pg8::cvt_pk_bf16(p1[0], p1[1]); pk.w = pg8::cvt_pk_bf16(p1[2], p1[3]);
            pf[p] = __builtin_bit_cast(bf16x8, pk);
        }
        const LAS unsigned char* Rcur = L + RT_RT + (n & 1) * RT_RTSZ;
#pragma unroll
        for (int et = 0; et < 2; ++et) {
            f32x4 acc = (f32x4){0.f, 0.f, 0.f, 0.f};
#pragma unroll
            for (int ks = 0; ks < 4; ++ks) { const bf16x8 rf = *(const LAS bf16x8*)(Rcur + (16 * et + l15) * RT_STR + (32 * ks + 8 * g) * 2);
                acc = __builtin_amdgcn_mfma_f32_16x16x32_bf16(qf[ks], rf, acc, 0, 0, 0); }
#pragma unroll
            for (int i = 0; i < 4; ++i) acc[i] *= __builtin_amdgcn_exp2f(lg2 * (float)(16 * w + 4 * g + i + 1));
#pragma unroll
            for (int p = 0; p < 4; ++p) if (2 * p <= w) {
                const LAS unsigned char* vb = L + RT_VS + (32 * p + 4 * g + tq) * RT_VSTR + (16 * et + 4 * tp) * 2;
                const bf16x8 vf = tr8(vb, vb + 16 * RT_VSTR);
                acc = __builtin_amdgcn_mfma_f32_16x16x32_bf16(pf[p], vf, acc, 0, 0, 0); }
#pragma unroll
            for (int i = 0; i < 4; ++i) Yg[(size_t)(n * 128 + 16 * w + 4 * g + i) * RETW + 16 * et + l15] = acc[i];
        }
        LAS unsigned char* Rnxt = L + RT_RT + ((n + 1) & 1) * RT_RTSZ;
        accR[0] = accR[0] * gC; accR[1] = accR[1] * gC;
#pragma unroll
        for (int cs = 0; cs < 4; ++cs) {
            const LAS unsigned char* kb = L + RT_KS + (32 * cs + 8 * g + tq) * RT_STR + (16 * w + 4 * tp) * 2;
            const bf16x8 kt = tr8(kb, kb + 4 * RT_STR);
#pragma unroll
            for (int et = 0; et < 2; ++et) { const LAS unsigned char* vb = L + RT_VPS + (32 * cs + 8 * g + tq) * RT_VSTR + (16 * et + 4 * tp) * 2;
                const bf16x8 vt = tr8(vb, vb + 4 * RT_VSTR);
                accR[et] = __builtin_amdgcn_mfma_f32_16x16x32_bf16(kt, vt, accR[et], 0, 0, 0); }
        }
#pragma unroll
        for (int et = 0; et < 2; ++et) { v2u o; o.x = pg8::cvt_pk_bf16(accR[et][0], accR[et][1]); o.y = pg8::cvt_pk_bf16(accR[et][2], accR[et][3]);
            *(LAS v2u*)(Rnxt + (16 * et + l15) * RT_STR + (16 * w + 4 * g) * 2) = o; }
        __syncthreads();
    }
#undef RT_LOAD
}
__device__ __forceinline__ void ph_scan(Frame& F, ArgP A, int l) {
    if (F.G >= 256) {
        if (F.vcu >= 192) { if (l + 1 < DEPTH) ph_convert(F, A, l + 1, F.vcu - 192, F.G - 192); return; }
        if (F.vcu < 128) { scan_rwkv_fast(F, F.vcu); if (MK_REP & 32) { __syncthreads(); scan_rwkv_fast(F, F.vcu); } }
        else if (F.vcu < 192) { scan_ret_mfma(F, F.vcu - 128); if (MK_REP & 64) { __syncthreads(); scan_ret_mfma(F, F.vcu - 128); } }
    } else {
        if (l + 1 < DEPTH) ph_convert(F, A, l + 1, F.vcu, F.G);
        const int gw = F.vcu * NWAVES + F.wave, NGW = F.G * NWAVES;
        const int stride = NGW >= 64 ? NGW / 64 : 1;
        if (gw % stride == 0) {
            for (int item = gw / stride; item < 64; item += (NGW + stride - 1) / stride) {
                if (item < 32) scan_rwkv_naive(F, item); else scan_ret_naive(F, item - 32);
            }
        }
    }
}
#if (MK_GLOBAL_GROUPS & 4)
#pragma pop_macro("WSP")
#pragma pop_macro("WSW")
#pragma pop_macro("OUTP")
#endif
#if (MK_GLOBAL_GROUPS & 8)
#pragma push_macro("WSP")
#pragma push_macro("WSW")
#pragma push_macro("OUTP")
#undef WSP
#undef WSW
#undef OUTP
#define WSP WSPG
#define WSW WSWG
#define OUTP OUTPG
#endif
template <int CTRL> __device__ __forceinline__ float dppx(float x) { return __builtin_bit_cast(float, __builtin_amdgcn_update_dpp(0, __builtin_bit_cast(int, x), CTRL, 0xF, 0xF, true)); }
__device__ __forceinline__ void ph_post(Frame& F, ArgP A, int l) {
    const int gw = F.vcu * NWAVES + F.wave, NGW = F.G * NWAVES, lane = F.lane, c0 = lane * 16;
    f32x4 gg[4], gb[4], lg[4], lb[4];
#pragma unroll
    for (int j = 0; j < 4; ++j) { gg[j] = *(const GAS f32x4*)(INP(A, 4) + (size_t)l * RETW + c0 + 4 * j); gb[j] = *(const GAS f32x4*)(INP(A, 5) + (size_t)l * RETW + c0 + 4 * j);
        lg[j] = *(const GAS f32x4*)(INP(A, 15) + (size_t)l * RWW + c0 + 4 * j); lb[j] = *(const GAS f32x4*)(INP(A, 16) + (size_t)l * RWW + c0 + 4 * j); }
    for (int m = gw; m < M; m += NGW) {
        {
            f32x4 y[4]; float s = 0.f;
#pragma unroll
            for (int j = 0; j < 4; ++j) { y[j] = *(const GAS f32x4*)(WSP(float, WS_YRAWR) + (size_t)m * RETW + c0 + 4 * j); s += (y[j].x + y[j].y) + (y[j].z + y[j].w); }
            const GAS bf16* zg = (const GAS bf16*)(WSP(bf16, WS_Z) + (size_t)m * INW + ZC_GR + c0);
            float g[16]; { float t[8]; unpack8(*(const GAS v4u*)zg, t);
#pragma unroll
                for (int j = 0; j < 8; ++j) g[j] = t[j]; unpack8(*(const GAS v4u*)(zg + 8), t);
#pragma unroll
                for (int j = 0; j < 8; ++j) g[8 + j] = t[j]; }
            s += dppx<0xB1>(s); s += dppx<0x4E>(s); s += dppx<0x141>(s);
            const float mean = s * (1.f / RD); float q = 0.f;
#pragma unroll
            for (int j = 0; j < 4; ++j) { y[j] = y[j] - mean; q += (y[j].x * y[j].x + y[j].y * y[j].y) + (y[j].z * y[j].z + y[j].w * y[j].w); }
            q += dppx<0xB1>(q); q += dppx<0x4E>(q); q += dppx<0x141>(q);
            const float rstd = __builtin_amdgcn_rsqf(q * (1.f / RD) + RET_GN_EPS);
            float o[16];
#pragma unroll
            for (int j = 0; j < 4; ++j)
#pragma unroll
                for (int k = 0; k < 4; ++k) { const float gr = g[4 * j + k]; o[4 * j + k] = (y[j][k] * rstd * gg[j][k] + gb[j][k]) * (gr * fsig(gr)); }
            GAS bf16* yo = (GAS bf16*)(WSP(bf16, WS_YRET) + (size_t)m * RETW + c0);
            { float t[8];
#pragma unroll
              for (int j = 0; j < 8; ++j) t[j] = o[j]; *(GAS bf16x8*)yo = pack8(t);
#pragma unroll
              for (int j = 0; j < 8; ++j) t[j] = o[8 + j]; *(GAS bf16x8*)(yo + 8) = pack8(t); }
        }
        {
            const size_t ob = (size_t)m * RWW + c0;
            f32x4 y[4]; float s = 0.f;
#pragma unroll
            for (int j = 0; j < 4; ++j) { y[j] = *(const GAS f32x4*)(WSP(float, WS_YRAWW) + ob + 4 * j); s += (y[j].x + y[j].y) + (y[j].z + y[j].w); }
            f32x4 vv[4], gt[4];
#pragma unroll
            for (int j = 0; j < 4; ++j) { vv[j] = *(const GAS f32x4*)(WSP(float, WS_SV) + ob + 4 * j); gt[j] = *(const GAS f32x4*)(WSP(float, WS_G) + ob + 4 * j); }
            const float bonus = *(const GAS float*)(WSP(float, WS_BONUS) + (size_t)m * WH + (lane >> 2));
            s += dppx<0xB1>(s); s += dppx<0x4E>(s);
            const float mean = s * (1.f / WD); float q = 0.f;
#pragma unroll
            for (int j = 0; j < 4; ++j) { y[j] = y[j] - mean; q += (y[j].x * y[j].x + y[j].y * y[j].y) + (y[j].z * y[j].z + y[j].w * y[j].w); }
            q += dppx<0xB1>(q); q += dppx<0x4E>(q);
            const float rstd = __builtin_amdgcn_rsqf(q * (1.f / WD) + RWKV_LN_EPS);
            float o[16];
#pragma unroll
            for (int j = 0; j < 4; ++j)
#pragma unroll
                for (int k = 0; k < 4; ++k) o[4 * j + k] = (y[j][k] * rstd * lg[j][k] + lb[j][k] + bonus * vv[j][k]) * gt[j][k];
            GAS bf16* yo = (GAS bf16*)(WSP(bf16, WS_YRWKV) + ob);
            { float t[8];
#pragma unroll
              for (int j = 0; j < 8; ++j) t[j] = o[j]; *(GAS bf16x8*)yo = pack8(t);
#pragma unroll
              for (int j = 0; j < 8; ++j) t[j] = o[8 + j]; *(GAS bf16x8*)(yo + 8) = pack8(t); }
        }
    }
}
__device__ __forceinline__ void ph_final(Frame& F, ArgP A) {
    const int gw = F.vcu * NWAVES + F.wave, NGW = F.G * NWAVES, lane = F.lane;
    const GAS f32x4* gr = (const GAS f32x4*)INP(A, 23) + lane;
    for (int m = gw; m < M; m += NGW) {
        GAS f32x4* xr = (GAS f32x4*)(OUTP + (size_t)m * D) + lane;
        f32x4 v[8]; float s = 0.f;
#pragma unroll
        for (int j = 0; j < 8; ++j) { v[j] = xr[64 * j]; s += (v[j].x * v[j].x + v[j].y * v[j].y) + (v[j].z * v[j].z + v[j].w * v[j].w); }
        const float rstd = 1.f / sqrtf(wave_sum(s) * (1.f / D) + NORM_EPS);
#pragma unroll
        for (int j = 0; j < 8; ++j) xr[64 * j] = v[j] * rstd * gr[64 * j];
    }
}
#if (MK_GLOBAL_GROUPS & 8)
#pragma pop_macro("WSP")
#pragma pop_macro("WSW")
#pragma pop_macro("OUTP")
#endif

__global__ void __launch_bounds__(NWAVES * 64, 2) hybrid_fwd(Args args) {
    extern __shared__ __attribute__((aligned(16))) unsigned char lds[];
    Frame F;
    F.lds = (LAS unsigned char*)lds;
    F.MISC = (volatile LAS unsigned*)(F.lds + MISC_OFF);
    F.tid = threadIdx.x; F.lane = F.tid & 63; F.wave = __builtin_amdgcn_readfirstlane(F.tid >> 6);
    int bx = blockIdx.x; F.G = gridDim.x; { F.vcu = (F.G % 8 == 0) ? (bx % 8) * (F.G / 8) + bx / 8 : bx; }
    F.ws = args.ws; F.out = args.out;
    for (int u = F.tid; u < (LDS_BYTES - LDSCTL_OFF) / 4; u += NWAVES * 64) ((LAS unsigned*)(F.lds + LDSCTL_OFF))[u] = 0u;
    __syncthreads();
    if (F.tid == 0) { volatile LAS unsigned* U = (volatile LAS unsigned*)(F.lds + MISC_OFF) + 16; const unsigned long long pw = (unsigned long long)args.ws, po = (unsigned long long)args.out, pa = (unsigned long long)__builtin_amdgcn_kernarg_segment_ptr();
        U[0] = (unsigned)pw; U[1] = (unsigned)(pw >> 32); U[2] = (unsigned)po; U[3] = (unsigned)(po >> 32); U[4] = (unsigned)pa; U[5] = (unsigned)(pa >> 32); U[6] = (unsigned)F.G; U[7] = (unsigned)F.vcu; U[8] = (unsigned)bx; }
    __syncthreads();
    XcdBarrier bar = xcd_barrier_post((unsigned*)(F.ws + WS_CTL) + CW_BAR, F.MISC + 8);

    ArgP ap = (ArgP)__builtin_amdgcn_kernarg_segment_ptr();
    const int lo = args.ph_lo, hi = args.ph_hi;
#define REPX(bit, body) do { body; if (MK_REP & (bit)) { __syncthreads(); body; } } while (0)
#define IN(k) (lo <= (k) && (k) < hi)
#define SEAM(k) do { if (IN(k) && IN((k) + 1)) xcd_barrier(bar); else __syncthreads(); } while (0)

    if (IN(PH_PRO)) { ph_prologue(F, ap); ph_convert(F, ap, 0, F.vcu, F.G); }
    SEAM(PH_PRO);
    for (int l = 0; l < DEPTH; ++l) {
        const int p0 = PH_L0 + l * PPL;
        asm volatile("" : "+v"(F.tid), "+v"(F.lane) :: "memory");
        { unsigned ba = MISC_OFF + 64; asm volatile("" : "+v"(ba));
          const volatile LAS v4u* U = (const volatile LAS v4u*)(F.lds + ba);
          const v4u ua = U[0], ub = U[1]; const unsigned uc = *(const volatile LAS unsigned*)(U + 2);
          const unsigned u0 = __builtin_amdgcn_readfirstlane(ua.x), u1 = __builtin_amdgcn_readfirstlane(ua.y), u2 = __builtin_amdgcn_readfirstlane(ua.z), u3 = __builtin_amdgcn_readfirstlane(ua.w);
          const unsigned u4 = __builtin_amdgcn_readfirstlane(ub.x), u5 = __builtin_amdgcn_readfirstlane(ub.y), u6 = __builtin_amdgcn_readfirstlane(ub.z), u7 = __builtin_amdgcn_readfirstlane(ub.w), u8 = __builtin_amdgcn_readfirstlane(uc);
          F.ws = (unsigned char*)(((unsigned long long)u1 << 32) | u0); F.out = (float*)(((unsigned long long)u3 << 32) | u2); ap = (ArgP)(((unsigned long long)u5 << 32) | u4);
          F.G = (int)u6; F.vcu = (int)u7; bx = (int)u8; F.wave = __builtin_amdgcn_readfirstlane(F.tid >> 6); }
        if (IN(p0 + LP_G1)) {
            pg8::Gemm g{WSPG(bf16, WS_H), WSWG(l, WO_WIN), M, INW, D}; pg8::StaticOrder S; S.init(M, INW, F.G, bx);
            pg8::EpiB<0> E{WSPG(bf16, WS_Z), INW, nullptr, 0, WSPG(float, WS_SS)};
            pg8::gemm_phase<pg8::EpiB<0>, pg8::StaticOrder, true, true>(F.lds + RING_OFF, g, S, E);
        }
        SEAM(p0 + LP_G1);
        if (IN(p0 + LP_PREP)) { REPX(4, ph_prep(F, ap, l)); }
        SEAM(p0 + LP_PREP);
        if (IN(p0 + LP_SCAN)) { REPX(8, ph_scan(F, ap, l)); }
        SEAM(p0 + LP_SCAN);
        if (IN(p0 + LP_POST)) { REPX(16, ph_post(F, ap, l)); }
        SEAM(p0 + LP_POST);
        if (IN(p0 + LP_GA)) {
            pg8::Gemm g{WSPG(bf16, WS_YRET), WSWG(l, WO_WA), M, D, RETW}; pg8::StaticOrder S; S.init(M, D, F.G, bx);
            pg8::EpiB<2> E{WSPG(bf16, WS_MRG), D, WSPG(bf16, WS_Z) + ZC_GA, INW, nullptr};
            pg8::gemm_phase<pg8::EpiB<2>, pg8::StaticOrder, true, true>(F.lds + RING_OFF, g, S, E);
        }
        __syncthreads();
        if (IN(p0 + LP_GB)) {
            pg8::Gemm g{WSPG(bf16, WS_YRWKV), WSWG(l, WO_WB), M, D, RWW}; pg8::StaticOrder S; S.init(M, D, F.G, bx);
            pg8::EpiB<3> E{WSPG(bf16, WS_MRG), D, WSPG(bf16, WS_Z) + ZC_GB, INW, nullptr};
            pg8::gemm_phase<pg8::EpiB<3>, pg8::StaticOrder, true, true>(F.lds + RING_OFF, g, S, E);
        }
        SEAM(p0 + LP_GB);
        if (IN(p0 + LP_GO)) {
            pg8::Gemm g{WSPG(bf16, WS_MRG), WSWG(l, WO_WO), M, D, D}; pg8::StaticOrder S; S.init(M, D, F.G, bx);
            pg8::EpiResNorm E{OUTPG, D, WSPG(bf16, WS_H), WSPG(float, WS_SS)};
            pg8::gemm_phase<pg8::EpiResNorm, pg8::StaticOrder, true, true>(F.lds + RING_OFF, g, S, E);
        }
        SEAM(p0 + LP_GO);
        if (IN(p0 + LP_GUP)) {
            pg8::Gemm g{WSPG(bf16, WS_H), WSWG(l, WO_WUP), M, DFF, D}; pg8::StaticOrder S; S.init(M, DFF, F.G, bx);
            pg8::EpiB<1> E{WSPG(bf16, WS_UP), DFF, nullptr, 0, WSPG(float, WS_SS)};
            pg8::gemm_phase<pg8::EpiB<1>, pg8::StaticOrder, true, true>(F.lds + RING_OFF, g, S, E);
        }
        SEAM(p0 + LP_GUP);
        if (IN(p0 + LP_GDN)) {
            pg8::Gemm g{WSPG(bf16, WS_UP), WSWG(l, WO_WDN), M, D, DFF}; pg8::StaticOrder S; S.init(M, D, F.G, bx);
            pg8::EpiResNorm E{OUTPG, D, WSPG(bf16, WS_H), WSPG(float, WS_SS)};
            pg8::gemm_phase<pg8::EpiResNorm, pg8::StaticOrder, true, true>(F.lds + RING_OFF, g, S, E);
        }
        SEAM(p0 + LP_GDN);
    }
    if (IN(PH_FIN)) { ph_final(F, ap); }
#undef IN
#undef SEAM
}

extern "C" void kernel_launch(void* const* d_in, const int* in_sizes, int n_in, void* d_out, int out_size, void* d_ws, size_t ws_size, hipStream_t stream) {
    static int grid = 0;
    if (grid == 0) {
        if (n_in != 24 || in_sizes[0] != M * D || out_size != M * D || ws_size < WS_END) { fprintf(stderr, "kernel_launch: built for 24 inputs, x and out of %d floats, >= %zu bytes of workspace; got n_in %d, in0 %d, out %d, ws %zu; nothing launched\n", M * D, (size_t)WS_END, n_in, n_in > 0 ? in_sizes[0] : -1, out_size, ws_size); grid = -1; return; }
        int dev = 0, cus = 0, per_cu = 0;
        if (hipGetDevice(&dev) != hipSuccess || hipDeviceGetAttribute(&cus, hipDeviceAttributeMultiprocessorCount, dev) != hipSuccess) { fprintf(stderr, "kernel_launch: hipGetDevice / hipDeviceGetAttribute failed; nothing launched\n"); grid = -1; return; }
        if (hipFuncSetAttribute((const void*)hybrid_fwd, hipFuncAttributeMaxDynamicSharedMemorySize, LDS_BYTES) != hipSuccess) { fprintf(stderr, "kernel_launch: hipFuncSetAttribute failed\n"); grid = -1; return; }
        if (hipOccupancyMaxActiveBlocksPerMultiprocessor(&per_cu, (const void*)hybrid_fwd, NWAVES * 64, LDS_BYTES) != hipSuccess || per_cu < 1)
            fprintf(stderr, "kernel_launch: note: the occupancy query reports %d workgroups per CU\n", per_cu);
        (void)hipGetLastError();
        grid = cus;
    }
    if (grid < 0) return;
    if (hipMemsetAsync((char*)d_ws + WS_CTL, 0, CTL_ZERO_BYTES, stream) != hipSuccess) { fprintf(stderr, "kernel_launch: hipMemsetAsync failed\n"); return; }
    Args a{};
    for (int i = 0; i < 24; ++i) a.in[i] = (const float*)d_in[i];
    a.out = (float*)d_out; a.ws = (unsigned char*)d_ws; a.li = 0; a.pad = 0;
#if MK_ONE_LAUNCH
    a.ph_lo = 0; a.ph_hi = NPH;
    hipLaunchKernelGGL(hybrid_fwd, dim3(grid), dim3(NWAVES * 64), LDS_BYTES, stream, a);
#else
    for (int p = 0; p < NPH; ++p) {
        a.ph_lo = p; a.ph_hi = p + 1;
        hipLaunchKernelGGL(hybrid_fwd, dim3(grid), dim3(NWAVES * 64), LDS_BYTES, stream, a);
    }
#endif
    const hipError_t le = hipPeekAtLastError();
    if (le != hipSuccess) fprintf(stderr, "kernel_launch: launch failed: %s\n", hipGetErrorName(le));
}
```

```cpp
#include <hip/hip_runtime.h>
#include <cstdio>
#include <cstdint>
#ifndef MK_GLOBAL_GROUPS
#define MK_GLOBAL_GROUPS 30
#endif
#ifndef MK_REP
#define MK_REP 0
#endif
namespace pg8 {
#define PG8_LAS __attribute__((address_space(3)))
typedef unsigned short bf16_t;
typedef short bf16x8 __attribute__((ext_vector_type(8)));
typedef float f32x4 __attribute__((ext_vector_type(4)));
typedef unsigned u32x4 __attribute__((ext_vector_type(4)));
constexpr int BM = 256, BK = 64, HALF = 128, HTB = HALF * BK * 2  , STAGE_BYTES = 8 * HTB, NXCD = 8, WGM = 8;

__host__ __device__ __forceinline__ int lds_byte(int r, int c) { const int st = (r >> 4) * 2 + (c >> 5), rr = r & 15, cc = c & 31, ob = rr * 64 + cc * 2; return st * 1024 + (ob ^ (((ob >> 9) & 1) << 5)); }
__host__ __device__ __forceinline__ void stage_rc(int b, int& R, int& C) { const int st = b / 1024, sb = b % 1024, swz = sb ^ (((sb >> 9) & 1) << 5); R = (st >> 1) * 16 + swz / 64; C = (st & 1) * 32 + (swz % 64) / 2; }
__host__ __device__ __forceinline__ int perm32(int rho) { const int n = rho >> 4, i = rho & 15; return 8 * (i >> 2) + 4 * n + (i & 3); }

struct Unit { int pm, pn; };
struct Gemm { const bf16_t* A; const bf16_t* Bt; int M, N, K; };

struct StaticOrder {
    int nM, nN, nwg, G, c;
    __host__ __device__ void init(int M, int N, int G_, int c_) { nM = M / BM; nN = N / BM; nwg = nM * nN; G = G_; c = c_; }
    __host__ __device__ bool next(int i, Unit& u) const {
        const long L = (long)i * G + c; if (L >= nwg) return false;
        int wgid = (int)L; { const int q = nwg / NXCD, r = nwg % NXCD, xcd = wgid % NXCD, off = wgid / NXCD; wgid = (xcd < r ? xcd * (q + 1) : r * (q + 1) + (xcd - r) * q) + off; }
        const int nig = WGM * nN, gid = wgid / nig, fm = gid * WGM, gsz = (nM - fm) < WGM ? (nM - fm) : WGM;
        u.pm = fm + ((wgid % nig) % gsz); u.pn = (wgid % nig) / gsz; return true;
    }
    __device__ __forceinline__ void a_ready(const Unit&) const {}
    __device__ __forceinline__ void done(const Unit&) const {}
};

typedef float f32x2c __attribute__((ext_vector_type(2))); typedef __bf16 bf16x2c __attribute__((ext_vector_type(2)));
__device__ __forceinline__ unsigned cvt_pk_bf16(float lo, float hi) { const f32x2c v = {lo, hi}; return __builtin_bit_cast(unsigned, __builtin_convertvector(v, bf16x2c)); }
typedef float f32x2 __attribute__((ext_vector_type(2)));
__device__ __forceinline__ float bf_lo(unsigned w) { return __builtin_bit_cast(float, w << 16); }
__device__ __forceinline__ float bf_hi(unsigned w) { return __builtin_bit_cast(float, w & 0xffff0000u); }
__device__ __forceinline__ float sigmoidf_(float x) { return 1.0f / (1.0f + __expf(-x)); }
template <int MODE> struct EpiB {
    static constexpr bool PERM = true, AFTER_DRAIN = false;
    bf16_t* O; int ldc; const bf16_t* gate; int ldg; const float* ss;
    __device__ __forceinline__ void operator()(const f32x4 (&acc)[2][2][4][2], const Unit& u, int wr, int wc, int fr, int fq) const {
        const int row0 = u.pm * BM + wr * 64 + fr, col0 = u.pn * BM + wc * 32 + 8 * fq;
        float rs[2][4];
        for (int rep_ = 0; rep_ < ((MK_REP & 128) ? 2 : 1); ++rep_) { asm volatile("" ::: "memory");
        if (MODE <= 1) {
            typedef __attribute__((address_space(1))) const f32x4 gf4;
            f32x4 q[2][4][2];
#pragma unroll
            for (int ai = 0; ai < 2; ++ai)
#pragma unroll
                for (int m = 0; m < 4; ++m) { gf4* sp = (gf4*)(ss + (size_t)(row0 + ai * HALF + m * 16) * 32) + fq * 2; q[ai][m][0] = sp[0]; q[ai][m][1] = sp[1]; }
#pragma unroll
            for (int ai = 0; ai < 2; ++ai)
#pragma unroll
                for (int m = 0; m < 4; ++m) { const f32x4 a = q[ai][m][0] + q[ai][m][1]; rs[ai][m] = (a[0] + a[1]) + (a[2] + a[3]); }
#pragma unroll
            for (int ai = 0; ai < 2; ++ai)
#pragma unroll
                for (int m = 0; m < 4; ++m) rs[ai][m] += __shfl_xor(rs[ai][m], 16);
#pragma unroll
            for (int ai = 0; ai < 2; ++ai)
#pragma unroll
                for (int m = 0; m < 4; ++m) { rs[ai][m] += __shfl_xor(rs[ai][m], 32); rs[ai][m] = __builtin_amdgcn_rsqf(rs[ai][m] * (1.0f / 2048.0f) + 1e-6f); }
        }
        if (MK_REP & 128) asm volatile("" : "+v"(rs[0][0]), "+v"(rs[1][3]) :: "memory"); }
#pragma unroll
        for (int ai = 0; ai < 2; ++ai)
#pragma unroll
            for (int m = 0; m < 4; ++m) { const size_t row = (size_t)(row0 + ai * HALF + m * 16);
#pragma unroll
                for (int bj = 0; bj < 2; ++bj) { f32x4 v0 = acc[ai][bj][m][0], v1 = acc[ai][bj][m][1]; const int c = col0 + bj * HALF;
                    if (MODE <= 1) { v0 = v0 * rs[ai][m]; v1 = v1 * rs[ai][m]; }
                    if (MODE == 1) {
#pragma unroll
                        for (int j = 0; j < 4; ++j) { const float a = fmaxf(v0[j], 0.f), b = fmaxf(v1[j], 0.f); v0[j] = a * a; v1[j] = b * b; } }
                    if (MODE >= 2) { const u32x4 g = *(const u32x4*)(gate + row * ldg + c);
                        v0[0] *= sigmoidf_(bf_lo(g.x)); v0[1] *= sigmoidf_(bf_hi(g.x)); v0[2] *= sigmoidf_(bf_lo(g.y)); v0[3] *= sigmoidf_(bf_hi(g.y));
                        v1[0] *= sigmoidf_(bf_lo(g.z)); v1[1] *= sigmoidf_(bf_hi(g.z)); v1[2] *= sigmoidf_(bf_lo(g.w)); v1[3] *= sigmoidf_(bf_hi(g.w)); }
                    if (MODE == 3) { const u32x4 o = *(const u32x4*)(O + row * ldc + c);
                        v0[0] += bf_lo(o.x); v0[1] += bf_hi(o.x); v0[2] += bf_lo(o.y); v0[3] += bf_hi(o.y);
                        v1[0] += bf_lo(o.z); v1[1] += bf_hi(o.z); v1[2] += bf_lo(o.w); v1[3] += bf_hi(o.w); }
                    u32x4 w; w.x = cvt_pk_bf16(v0[0], v0[1]); w.y = cvt_pk_bf16(v0[2], v0[3]); w.z = cvt_pk_bf16(v1[0], v1[1]); w.w = cvt_pk_bf16(v1[2], v1[3]);
                    *(u32x4*)(O + row * ldc + c) = w; } }
    }
};
struct EpiResNorm {
    static constexpr bool PERM = true, AFTER_DRAIN = false;
    float* X; int ldc; bf16_t* XB; float* SS;
    __device__ __forceinline__ void operator()(const f32x4 (&acc)[2][2][4][2], const Unit& u, int wr, int wc, int fr, int fq) const {
        const int row0 = u.pm * BM + wr * 64 + fr, col0 = u.pn * BM + wc * 32 + 8 * fq;
#pragma unroll
        for (int ai = 0; ai < 2; ++ai)
#pragma unroll
            for (int m = 0; m < 4; ++m) { const size_t row = (size_t)(row0 + ai * HALF + m * 16);
                float s = 0.f;
#pragma unroll
                for (int bj = 0; bj < 2; ++bj) { const int c = col0 + bj * HALF; float* p = X + row * ldc + c;
                    const f32x4 x0 = *(const f32x4*)p + acc[ai][bj][m][0], x1 = *(const f32x4*)(p + 4) + acc[ai][bj][m][1];
                    *(f32x4*)p = x0; *(f32x4*)(p + 4) = x1;
                    u32x4 w; w.x = cvt_pk_bf16(x0[0], x0[1]); w.y = cvt_pk_bf16(x0[2], x0[3]); w.z = cvt_pk_bf16(x1[0], x1[1]); w.w = cvt_pk_bf16(x1[2], x1[3]);
                    *(u32x4*)(XB + row * ldc + c) = w;
                    s += ((x0[0] * x0[0] + x0[1] * x0[1]) + (x0[2] * x0[2] + x0[3] * x0[3])) + ((x1[0] * x1[0] + x1[1] * x1[1]) + (x1[2] * x1[2] + x1[3] * x1[3])); }
                s += __shfl_xor(s, 16); s += __shfl_xor(s, 32);
                if (fq == 0) SS[row * 32 + u.pn * 4 + wc] = s; }
    }
};

template <class Epi, class Sched, bool ALIGN_EPI = false, bool SP2 = false>
__device__ __forceinline__ void gemm_phase(PG8_LAS unsigned char* lds, const Gemm g, const Sched& S, const Epi& E) {
    int tid_ = threadIdx.x; asm volatile("" : "+v"(tid_));
    const int tid = tid_, wid = __builtin_amdgcn_readfirstlane(tid >> 6), lane = tid & 63, wr = wid >> 2, wc = wid & 3, fr = lane & 15, fq = lane >> 4;
    const int K = g.K, nt = K / BK;
    unsigned voffA[2], voffB[2];
#pragma unroll
    for (int i = 0; i < 2; ++i) { int R, C; stage_rc(tid * 16 + i * 8192, R, C); const int Rb = Epi::PERM ? ((R & ~31) + perm32(R & 31)) : R;
        voffA[i] = (unsigned)(R * K + C) * 2u; voffB[i] = (unsigned)(Rb * K + C) * 2u; }
    const size_t kstep = (size_t)(BK * 2);
    const size_t hstep = (size_t)HALF * K * 2;
    const size_t tstep = 2 * hstep;
    const unsigned ldsw = (unsigned)wid * 1024u;
    const int aoff = lds_byte(wr * 64 + fr, fq * 8), boff = lds_byte(wc * 32 + fr, fq * 8);
#define PG8_SA(b, h) (((b) * 2 + (h)) * HTB)
#define PG8_SB(b, h) ((4 + (b) * 2 + (h)) * HTB)
#define PG8_STAGE(bufoff, gbase, voff) do { _Pragma("unroll") for (int _i = 0; _i < 2; ++_i) \
        __builtin_amdgcn_global_load_lds((const unsigned*)((const char*)(gbase) + (voff)[_i]), (PG8_LAS unsigned*)(lds + (bufoff) + ldsw + _i * 8192), 16, 0, 0); } while (0)
#define PG8_LDA(dst, b, h) do { _Pragma("unroll") for (int m = 0; m < 4; ++m) _Pragma("unroll") for (int k = 0; k < 2; ++k) dst[m][k] = *(const PG8_LAS bf16x8*)(lds + PG8_SA(b, h) + aoff + m * 2048 + k * 1024); } while (0)
#define PG8_LDB(dst, b, h) do { _Pragma("unroll") for (int n = 0; n < 2; ++n) _Pragma("unroll") for (int k = 0; k < 2; ++k) dst[n][k] = *(const PG8_LAS bf16x8*)(lds + PG8_SB(b, h) + boff + n * 2048 + k * 1024); } while (0)
#define PG8_MMA(ai, bj, At, Bt) do { __builtin_amdgcn_s_setprio(1); _Pragma("unroll") for (int m = 0; m < 4; ++m) _Pragma("unroll") for (int n = 0; n < 2; ++n) _Pragma("unroll") for (int k = 0; k < 2; ++k) \
        acc[ai][bj][m][n] = __builtin_amdgcn_mfma_f32_16x16x32_bf16(Bt[n][k], At[m][k], acc[ai][bj][m][n], 0, 0, 0); __builtin_amdgcn_s_setprio(0); } while (0)
#define PG8_WAIT_V(n) asm volatile("s_waitcnt vmcnt(" #n ")" ::: "memory")
#define PG8_WAIT_L(n) asm volatile("s_waitcnt lgkmcnt(" #n ")" ::: "memory")
#define PG8_BAR __builtin_amdgcn_s_barrier()
#define PG8_SCHED __builtin_amdgcn_sched_barrier(0)
    Unit cur, nxt; int ui = 0;
    if (!S.next(0, cur)) return;
    f32x4 acc[2][2][4][2];
#pragma unroll
    for (int a = 0; a < 2; ++a)
#pragma unroll
        for (int b = 0; b < 2; ++b)
#pragma unroll
            for (int m = 0; m < 4; ++m)
#pragma unroll
                for (int n = 0; n < 2; ++n) acc[a][b][m][n] = (f32x4){0.f, 0.f, 0.f, 0.f};
    bf16x8 At[4][2], B0[2][2], B1[2][2];
    const char* cA = (const char*)g.A + (size_t)cur.pm * tstep; const char* cB = (const char*)g.Bt + (size_t)cur.pn * tstep;
    S.a_ready(cur);
    if constexpr (SP2) {
        PG8_STAGE(PG8_SB(0, 0), cB, voffB); PG8_STAGE(PG8_SB(0, 1), cB + hstep, voffB); PG8_STAGE(PG8_SA(0, 0), cA, voffA); PG8_STAGE(PG8_SA(0, 1), cA + hstep, voffA);
        if (wr == 1) PG8_BAR;
        PG8_WAIT_V(2); PG8_BAR;
        PG8_STAGE(PG8_SB(1, 0), cB + kstep, voffB); PG8_STAGE(PG8_SA(1, 0), cA + kstep, voffA); PG8_STAGE(PG8_SB(1, 1), cB + hstep + kstep, voffB);
        PG8_WAIT_V(6); PG8_BAR;
    } else {
        PG8_STAGE(PG8_SB(0, 0), cB, voffB); PG8_STAGE(PG8_SA(0, 0), cA, voffA); PG8_STAGE(PG8_SB(0, 1), cB + hstep, voffB); PG8_STAGE(PG8_SA(0, 1), cA + hstep, voffA);
        if (wr == 1) PG8_BAR;
        PG8_WAIT_V(4); PG8_BAR;
        PG8_STAGE(PG8_SB(1, 0), cB + kstep, voffB); PG8_STAGE(PG8_SA(1, 0), cA + kstep, voffA); PG8_STAGE(PG8_SB(1, 1), cB + hstep + kstep, voffB);
        PG8_WAIT_V(6); PG8_BAR;
    }
    for (;;) {
        const bool has_next = S.next(ui + 1, nxt);
        const char* nA = has_next ? (const char*)g.A + (size_t)nxt.pm * tstep : cA; const char* nB = has_next ? (const char*)g.Bt + (size_t)nxt.pn * tstep : cB;
        for (int t = 0; t < nt; t += 2) {
            const bool last = (t == nt - 2);
            const char* a1 = cA + (size_t)(t + 1) * kstep;
            const char* a2 = last ? nA : cA + (size_t)(t + 2) * kstep; const char* b2 = last ? nB : cB + (size_t)(t + 2) * kstep;
            const char* a3 = a2 + kstep; const char* b3 = b2 + kstep;
            if (last && has_next) S.a_ready(nxt);
            if constexpr (SP2) {
            PG8_LDB(B0, 0, 0); PG8_LDB(B1, 0, 1); PG8_SCHED; PG8_LDA(At, 0, 0); PG8_STAGE(PG8_SA(1, 1), a1 + hstep, voffA);
            PG8_WAIT_V(8); PG8_WAIT_L(0); PG8_BAR; PG8_MMA(0, 0, At, B0); PG8_MMA(0, 1, At, B1); PG8_BAR; PG8_SCHED;
            PG8_LDA(At, 0, 1); PG8_STAGE(PG8_SB(0, 0), b2, voffB); PG8_STAGE(PG8_SB(0, 1), b2 + hstep, voffB); PG8_STAGE(PG8_SA(0, 0), a2, voffA);
            PG8_WAIT_V(8); PG8_WAIT_L(0); PG8_BAR; PG8_MMA(1, 0, At, B0); PG8_MMA(1, 1, At, B1); PG8_BAR; PG8_SCHED;
            PG8_LDB(B0, 1, 0); PG8_LDB(B1, 1, 1); PG8_SCHED; PG8_LDA(At, 1, 0); PG8_STAGE(PG8_SA(0, 1), a2 + hstep, voffA);
            PG8_WAIT_V(8); PG8_WAIT_L(0); PG8_BAR; PG8_MMA(0, 0, At, B0); PG8_MMA(0, 1, At, B1); PG8_BAR; PG8_SCHED;
            PG8_LDA(At, 1, 1); PG8_STAGE(PG8_SB(1, 0), b3, voffB); PG8_STAGE(PG8_SB(1, 1), b3 + hstep, voffB); PG8_STAGE(PG8_SA(1, 0), a3, voffA);
            PG8_WAIT_V(8); PG8_WAIT_L(0); PG8_BAR; PG8_MMA(1, 0, At, B0); PG8_MMA(1, 1, At, B1); PG8_BAR; PG8_SCHED;
            } else {
            PG8_LDB(B0, 0, 0); PG8_SCHED; PG8_LDA(At, 0, 0); PG8_STAGE(PG8_SA(1, 1), a1 + hstep, voffA);
            PG8_WAIT_L(8); PG8_BAR; PG8_WAIT_L(0); PG8_MMA(0, 0, At, B0); PG8_BAR; PG8_SCHED;
            PG8_LDB(B1, 0, 1); PG8_STAGE(PG8_SB(0, 0), b2, voffB);
            PG8_BAR; PG8_WAIT_L(0); PG8_MMA(0, 1, At, B1); PG8_BAR;
            PG8_LDA(At, 0, 1); PG8_STAGE(PG8_SA(0, 0), a2, voffA);
            PG8_BAR; PG8_WAIT_L(0); PG8_MMA(1, 0, At, B0); PG8_BAR; PG8_SCHED;
            PG8_STAGE(PG8_SB(0, 1), b2 + hstep, voffB);
            PG8_WAIT_V(6); PG8_BAR; PG8_MMA(1, 1, At, B1); PG8_BAR;
            PG8_LDB(B0, 1, 0); PG8_SCHED; PG8_LDA(At, 1, 0); PG8_STAGE(PG8_SA(0, 1), a2 + hstep, voffA);
            PG8_WAIT_L(8); PG8_BAR; PG8_WAIT_L(0); PG8_MMA(0, 0, At, B0); PG8_BAR; PG8_SCHED;
            PG8_LDB(B1, 1, 1); PG8_STAGE(PG8_SB(1, 0), b3, voffB);
            PG8_BAR; PG8_WAIT_L(0); PG8_MMA(0, 1, At, B1); PG8_BAR;
            PG8_LDA(At, 1, 1); PG8_STAGE(PG8_SA(1, 0), a3, voffA);
            PG8_BAR; PG8_WAIT_L(0); PG8_MMA(1, 0, At, B0); PG8_BAR; PG8_SCHED;
            PG8_STAGE(PG8_SB(1, 1), b3 + hstep, voffB);
            PG8_WAIT_V(6); PG8_BAR; PG8_MMA(1, 1, At, B1); PG8_BAR;
            }
        }
        if constexpr (ALIGN_EPI) { if (wr == 0) PG8_BAR; }
        if constexpr (!Epi::AFTER_DRAIN) { E(acc, cur, wr, wc, fr, fq); S.done(cur); }
        if (!has_next) break;
#pragma unroll
        for (int a = 0; a < 2; ++a)
#pragma unroll
            for (int b = 0; b < 2; ++b)
#pragma unroll
                for (int m = 0; m < 4; ++m)
#pragma unroll
                    for (int n = 0; n < 2; ++n) acc[a][b][m][n] = (f32x4){0.f, 0.f, 0.f, 0.f};
        cur = nxt; cA = nA; cB = nB; ++ui;
        if constexpr (ALIGN_EPI) { if (wr == 1) PG8_BAR; }
    }
    PG8_WAIT_V(0);
    if constexpr (!ALIGN_EPI) { if (wr == 0) PG8_BAR; }
    PG8_BAR;
    if constexpr (Epi::AFTER_DRAIN) { E.fused(acc, cur, wr, wc, fr, fq, lds, wid, lane); S.done(cur); }
#undef PG8_SA
#undef PG8_SB
#undef PG8_STAGE
#undef PG8_LDA
#undef PG8_LDB
#undef PG8_MMA
#undef PG8_WAIT_V
#undef PG8_WAIT_L
#undef PG8_BAR
#undef PG8_SCHED
}
}
constexpr int NWAVES = 8;
#ifndef MK_ONE_LAUNCH
#define MK_ONE_LAUNCH 1
#endif

#ifndef MK_GLOBAL_GROUPS
#define MK_GLOBAL_GROUPS 30
#endif
#ifndef MK_CHUNKED
#define MK_CHUNKED 1
#endif
#ifndef MK_REP
#define MK_REP 0
#endif

constexpr int BATCH = 2, SEQ = 8192, D = 2048, DEPTH = 4, M = BATCH * SEQ;
constexpr int RETW = 1024, RH = 8, RD = 128, RWW = 1024, WH = 16, WD = 64;
constexpr int INW = 11520, DFF = 8192, RWSHIFT = 3328;
constexpr int ZC_Q = 0, ZC_K = 1024, ZC_V = 2048, ZC_GR = 3072, ZC_RW = 4096, ZC_GA = 7424, ZC_GB = 9472;
constexpr int RWC_R = 0, RWC_K = 1024, RWC_V = 2048, RWC_W = 3072, RWC_A = 3136, RWC_G = 3200;
constexpr float NORM_EPS = 1e-6f, RET_GN_EPS = 1e-5f, RWKV_LN_EPS = 64e-5f;

constexpr size_t MiB = 1u << 20;
constexpr size_t WS_CTL = 0, CTL_ZERO_BYTES = 1 * MiB;
constexpr size_t WS_ROPE = 1 * MiB;
constexpr size_t WS_WSET = 16 * MiB, WSET_BYTES = 126 * MiB;
constexpr size_t WO_WIN = 0, WO_WA = 45 * MiB, WO_WB = 49 * MiB, WO_WO = 53 * MiB, WO_WUP = 61 * MiB, WO_WDN = 93 * MiB, WO_LORA = 125 * MiB;
constexpr size_t WS_H = 272 * MiB;
constexpr size_t WS_Z = 336 * MiB;
constexpr size_t WS_UP = WS_Z;
constexpr size_t WS_QR = 696 * MiB, WS_KR = 728 * MiB;
constexpr size_t WS_YRET = 760 * MiB, WS_YRWKV = 792 * MiB;
constexpr size_t WS_MRG = 824 * MiB;
#if MK_CHUNKED
constexpr size_t WS_SR = 888 * MiB, WS_SV = 1208 * MiB;
#else
constexpr size_t WS_SR = 888 * MiB, WS_SW = 952 * MiB, WS_SK = 1016 * MiB, WS_SV = 1080 * MiB, WS_SNKK = 1144 * MiB, WS_SKKA = 1208 * MiB;
#endif
constexpr size_t WS_CU = WS_SR;
constexpr size_t WS_G = 1272 * MiB;
constexpr size_t WS_BONUS = 1336 * MiB;
constexpr size_t WS_SS = 1337 * MiB;
constexpr size_t WS_YRAWR = WS_H, WS_YRAWW = WS_MRG;
constexpr size_t WS_END = 1341 * MiB;
constexpr int CW_BAR = 4096;

constexpr int PPL = 9;
enum { LP_G1 = 0, LP_PREP, LP_SCAN, LP_POST, LP_GA, LP_GB, LP_GO, LP_GUP, LP_GDN };
constexpr int PH_PRO = 0, PH_L0 = 1, PH_FIN = PH_L0 + DEPTH * PPL, NPH = PH_FIN + 1;

constexpr int RING_OFF = 0, RING_BYTES = 131072;
constexpr int LDSCTL_OFF = RING_BYTES, MISC_OFF = LDSCTL_OFF + 320;
constexpr int LDS_BYTES = 147456;
static_assert(MISC_OFF + 128 <= LDS_BYTES, "LDS map");

#define GAS __attribute__((address_space(1)))
#define LAS __attribute__((address_space(3)))
typedef unsigned short bf16;
typedef unsigned v4u __attribute__((ext_vector_type(4)));
typedef unsigned v2u __attribute__((ext_vector_type(2)));
typedef float f32x4 __attribute__((ext_vector_type(4)));
typedef float f32x2 __attribute__((ext_vector_type(2)));
typedef short bf16x8 __attribute__((ext_vector_type(8)));
typedef GAS unsigned gu32;
#define LDS_WAIT() asm volatile("s_waitcnt lgkmcnt(0)" ::: "memory")
#define VM_WAIT() asm volatile("s_waitcnt vmcnt(0)" ::: "memory")
__device__ __forceinline__ unsigned f2bf(float f) { unsigned u = __builtin_bit_cast(unsigned, f); return (u + 0x7fffu + ((u >> 16) & 1u)) >> 16; }
__device__ __forceinline__ unsigned pk2(float lo, float hi) { return f2bf(lo) | (f2bf(hi) << 16); }
__device__ __forceinline__ float bf2f(bf16 v) { return __builtin_bit_cast(float, (unsigned)v << 16); }
__device__ __forceinline__ float rdlane(float v, int l) { return __builtin_bit_cast(float, __builtin_amdgcn_readlane(__builtin_bit_cast(int, v), l)); }
__device__ __forceinline__ float sigm(float x) { return 1.0f / (1.0f + expf(-x)); }

__device__ const double ROPE_REV[64] = {
0.15915494309189535, 0.13782250260398285, 0.11934937021124886, 0.10335229661843406,
0.08949940160889101, 0.07750328875537406, 0.06711508300522726, 0.058119267441876246,
0.050329212104487035, 0.04358330210530733, 0.03774158471741977, 0.032682865872357,
0.0283021958306234, 0.024508691862069852, 0.02122365276477766, 0.018378926105679667,
0.015915494309189534, 0.013782250260398284, 0.011934937021124886, 0.010335229661843406,
0.008949940160889102, 0.0077503288755374055, 0.006711508300522725, 0.005811926744187624,
0.005032921210448704, 0.004358330210530733, 0.003774158471741977, 0.0032682865872356993,
0.00283021958306234, 0.002450869186206985, 0.0021223652764777662, 0.0018378926105679667,
0.0015915494309189536, 0.0013782250260398288, 0.0011934937021124885, 0.0010335229661843405,
0.0008949940160889102, 0.0007750328875537405, 0.0006711508300522726, 0.0005811926744187624,
0.0005032921210448703, 0.0004358330210530733, 0.00037741584717419774, 0.0003268286587235699,
0.00028302195830623395, 0.00024508691862069854, 0.0002122365276477766, 0.00018378926105679666,
0.00015915494309189535, 0.00013782250260398286, 0.00011934937021124886, 0.00010335229661843406,
8.949940160889102e-05, 7.750328875537406e-05, 6.711508300522725e-05, 5.811926744187624e-05,
5.0329212104487035e-05, 4.358330210530732e-05, 3.774158471741978e-05, 3.2682865872357e-05,
2.8302195830623396e-05, 2.4508691862069852e-05, 2.122365276477766e-05, 1.8378926105679668e-05 };

#define XB_TMO      128
#define XB_XCNT(j)  (256  + 64 * (j))
#define XB_XSUB(j)  (1280 + 64 * (j))
#define XB_XGEN(j)  (2304 + 64 * (j))
#define XB_TOP      3328
#define XB_TOPGEN   3392
#define XCD_BAR_WORDS 3456
#define XB_SPIN_CAP (1u << 18)

__device__ __forceinline__ unsigned xb_ld(unsigned* p)              { return __hip_atomic_load(p, __ATOMIC_RELAXED, __HIP_MEMORY_SCOPE_AGENT); }
__device__ __forceinline__ unsigned xb_add(unsigned* p, unsigned v) { return __hip_atomic_fetch_add(p, v, __ATOMIC_RELAXED, __HIP_MEMORY_SCOPE_AGENT); }
__device__ __forceinline__ unsigned xb_xcc_id() { return (unsigned)__builtin_amdgcn_s_getreg((3 << 11) | 20) & 0xFu; }
#define XB_SPIN(cond, bar) do { unsigned _sp = 0; while (cond) { __builtin_amdgcn_s_sleep(1); \
    if ((++_sp & 255u) == 0u) { if (xb_ld(&(bar)[XB_TMO])) break; if (_sp > XB_SPIN_CAP) { atomicAdd(&(bar)[XB_TMO], 1u); break; } } } } while (0)

struct XcdBarrier {
    unsigned* bar; unsigned x;
    volatile LAS unsigned* st;
};

__device__ __forceinline__ XcdBarrier xcd_barrier_post(unsigned* bar, volatile LAS unsigned* st) {
    XcdBarrier b; b.bar = bar; b.x = xb_xcc_id(); b.st = st;
    if (threadIdx.x == 0) (void)xb_add(&bar[XB_XCNT(b.x)], 1u);
    return b;
}
__device__ __forceinline__ void xcd_barrier_complete(unsigned* bar, unsigned x, unsigned& nloc, unsigned& nx) {
    const unsigned G = gridDim.x * gridDim.y * gridDim.z;
    unsigned sum, cnt, mine, sp = 0u;
    for (;;) {
        sum = 0u; cnt = 0u; mine = 0u;
#pragma unroll
        for (unsigned j = 0; j < 16; ++j) { const unsigned c = xb_ld(&bar[XB_XCNT(j)]); sum += c; cnt += (c > 0u) ? 1u : 0u; mine = (j == x) ? c : mine; }
        if (sum == G) break;
        __builtin_amdgcn_s_sleep(1);
        if ((++sp & 255u) == 0u) { if (xb_ld(&bar[XB_TMO])) break; if (sp > XB_SPIN_CAP) { atomicAdd(&bar[XB_TMO], 1u); break; } }
    }
    nloc = mine > 0u ? mine : 1u; nx = cnt > 0u ? cnt : 1u;
}

__device__ __forceinline__ void xcd_barrier(const XcdBarrier& b) {
    asm volatile("s_waitcnt vmcnt(0)" ::: "memory");
    __syncthreads();
    if (threadIdx.x == 0) {
        unsigned* bar = b.bar;
        __builtin_amdgcn_s_waitcnt(0);
        unsigned nloc = b.st[0], nx = b.st[1];
        if (nloc == 0u) { xcd_barrier_complete(bar, b.x, nloc, nx); b.st[0] = nloc; b.st[1] = nx; }
        const unsigned old = xb_add(&bar[XB_XSUB(b.x)], 1u);
        const unsigned gen = old / nloc;
        if (old + 1u == (gen + 1u) * nloc) {
            __builtin_amdgcn_fence(__ATOMIC_RELEASE, "agent");
            asm volatile("s_waitcnt vmcnt(0)" ::: "memory");
            const unsigned og = xb_add(&bar[XB_TOP], 1u);
            const unsigned tg = og / nx;
            if (og + 1u == (tg + 1u) * nx) xb_add(&bar[XB_TOPGEN], 1u);
            else XB_SPIN(xb_ld(&bar[XB_TOPGEN]) == tg, bar);
            __builtin_amdgcn_fence(__ATOMIC_ACQUIRE, "agent");
            xb_add(&bar[XB_XGEN(b.x)], 1u);
            asm volatile("s_waitcnt vmcnt(0)" ::: "memory");
        } else {
            XB_SPIN(xb_ld(&bar[XB_XGEN(b.x)]) == gen, bar);
            __builtin_amdgcn_fence(__ATOMIC_ACQUIRE, "agent");
            asm volatile("s_waitcnt vmcnt(0)" ::: "memory");
        }
    }
    __syncthreads();
}


struct Frame {
    LAS unsigned char* lds;
    volatile LAS unsigned* MISC;
    int tid, lane, wave;
    int vcu, G;
    float* out; unsigned char* ws;
};
struct Args { const float* in[24]; float* out; unsigned char* ws; int ph_lo, ph_hi, li, pad; };
#define WSP(T, off) ((T*)(F.ws + (off)))
#define WSPG(T, off) ((T*)(GAS T*)(unsigned long long)(F.ws + (off)))
#define WSW(l, off) ((bf16*)(F.ws + WS_WSET + (size_t)((l) & 1) * WSET_BYTES + (off)))
#define WSWG(l, off) ((bf16*)(GAS bf16*)(unsigned long long)(F.ws + WS_WSET + (size_t)((l) & 1) * WSET_BYTES + (off)))
#define OUTP ((float*)F.out)
#define OUTPG ((float*)(GAS float*)(unsigned long long)F.out)
#define INP(A, i) ((const float*)((const GAS float*)(A)->in[i]))
#define RETID() do { int t_ = threadIdx.x; asm volatile("" : "+v"(t_)); F.tid = t_; F.lane = t_ & 63; } while (0)
#define CAS __attribute__((address_space(4)))
typedef const CAS Args* ArgP;

__device__ __forceinline__ float fexp(float x) { return __builtin_amdgcn_exp2f(x * 1.4426950408889634f); }
__device__ __forceinline__ float fsig(float x) { return __builtin_amdgcn_rcpf(1.0f + fexp(-x)); }
__device__ __forceinline__ float ftanh(float x) { return 1.0f - 2.0f * __builtin_amdgcn_rcpf(1.0f + fexp(2.0f * x)); }
__device__ __forceinline__ float wave_sum(float v) {
#pragma unroll
    for (int o = 1; o < 64; o <<= 1) v += __shfl_xor(v, o);
    return v;
}
__device__ __forceinline__ void transpose_item(const float* W, int K, int N, bf16* WT, LAS float* scr, int item, int lane, const float* gk = nullptr) {
    const int nblk = N / 32, kb = item / nblk, nb = item % nblk, k0 = 64 * kb, n0 = 32 * nb;
#pragma unroll 8
    for (int i = 0; i < 32; ++i) { const int kk = 2 * i + (lane >> 5); scr[kk * 33 + (lane & 31)] = W[(size_t)(k0 + kk) * N + n0 + (lane & 31)]; }
    const int c = lane & 7;
    f32x4 g0 = (f32x4){1.f, 1.f, 1.f, 1.f}, g1 = g0;
    if (gk) { g0 = *(const GAS f32x4*)(gk + k0 + 8 * c); g1 = *(const GAS f32x4*)(gk + k0 + 8 * c + 4); }
    LDS_WAIT(); asm volatile("" ::: "memory");
#pragma unroll
    for (int j = 0; j < 4; ++j) { const int n = (lane >> 3) + 8 * j; const LAS float* s = scr + (8 * c) * 33 + n;
        v4u o; o.x = pk2(s[0 * 33] * g0.x, s[1 * 33] * g0.y); o.y = pk2(s[2 * 33] * g0.z, s[3 * 33] * g0.w); o.z = pk2(s[4 * 33] * g1.x, s[5 * 33] * g1.y); o.w = pk2(s[6 * 33] * g1.z, s[7 * 33] * g1.w);
        *(GAS v4u*)(WT + (size_t)(n0 + n) * K + k0 + 8 * c) = o; }
    LDS_WAIT(); asm volatile("" ::: "memory");
}
__device__ __forceinline__ void rms_row_to_bf16(const float* xrow, const float* g, bf16* orow, int lane) {
    const GAS f32x4* xr = (const GAS f32x4*)xrow + lane;
    f32x4 v[8]; float s = 0.f;
#pragma unroll
    for (int j = 0; j < 8; ++j) { v[j] = xr[64 * j]; s += (v[j].x * v[j].x + v[j].y * v[j].y) + (v[j].z * v[j].z + v[j].w * v[j].w); }
    const float rstd = 1.f / sqrtf(wave_sum(s) * (1.f / D) + NORM_EPS);
    const GAS f32x4* gr = (const GAS f32x4*)g + lane;
    GAS v2u* o8 = (GAS v2u*)orow + lane;
#pragma unroll
    for (int j = 0; j < 8; ++j) { const f32x4 gg = gr[64 * j]; v2u o; o.x = pk2(v[j].x * rstd * gg.x, v[j].y * rstd * gg.y); o.y = pk2(v[j].z * rstd * gg.z, v[j].w * rstd * gg.w); o8[64 * j] = o; }
}

#if (MK_GLOBAL_GROUPS & 1)
#pragma push_macro("WSP")
#pragma push_macro("WSW")
#pragma push_macro("OUTP")
#undef WSP
#undef WSW
#undef OUTP
#define WSP WSPG
#define WSW WSWG
#define OUTP OUTPG
#endif
__device__ __forceinline__ void ph_prologue(Frame& F, ArgP A) {
    const int* pos = (const int*)INP(A, 1); float2* rope = WSP(float2, WS_ROPE);
    {
        const int gw = F.vcu * NWAVES + F.wave, NGW = F.G * NWAVES, lane = F.lane;
        for (int m = gw; m < M; m += NGW) {
            const GAS f32x4* xr = (const GAS f32x4*)(INP(A, 0) + (size_t)m * D) + lane; GAS f32x4* orow = (GAS f32x4*)(OUTP + (size_t)m * D) + lane;
            GAS v2u* hb = (GAS v2u*)(WSP(bf16, WS_H) + (size_t)m * D) + lane; float s = 0.f;
#pragma unroll
            for (int j = 0; j < 8; ++j) { const f32x4 v = xr[64 * j]; orow[64 * j] = v; v2u o; o.x = pk2(v.x, v.y); o.y = pk2(v.z, v.w); hb[64 * j] = o; s += (v.x * v.x + v.y * v.y) + (v.z * v.z + v.w * v.w); }
            s = wave_sum(s);
            if (lane < 32) WSP(float, WS_SS)[(size_t)m * 32 + lane] = lane == 0 ? s : 0.f;
        }
    }
    for (int i = F.vcu * 512 + F.tid; i < M * 64; i += F.G * 512) {
        const int m = i >> 6, j = i & 63;
        const double rev = (double)pos[m] * ROPE_REV[j];
        const float fr = (float)(rev - __builtin_rint(rev));
        rope[i] = make_float2(__builtin_amdgcn_cosf(fr), __builtin_amdgcn_sinf(fr));
    }
}
#if (MK_GLOBAL_GROUPS & 1)
#pragma pop_macro("WSP")
#pragma pop_macro("WSW")
#pragma pop_macro("OUTP")
#endif
#if (MK_GLOBAL_GROUPS & 16)
#pragma push_macro("WSP")
#pragma push_macro("WSW")
#pragma push_macro("OUTP")
#undef WSP
#undef WSW
#undef OUTP
#define WSP WSPG
#define WSW WSWG
#define OUTP OUTPG
#endif
__device__ __forceinline__ void ph_convert(Frame& F, ArgP A, int l, int wg, int nwg) {
    LAS float* scr = (LAS float*)(F.lds + RING_OFF + F.wave * 16384);
    const int gw = wg * NWAVES + F.wave, NGW = nwg * NWAVES;
    constexpr int I_IN = (D / 64) * (INW / 32), I_A = (RETW / 64) * (D / 32), I_O = (D / 64) * (D / 32), I_UP = (D / 64) * (DFF / 32), I_DN = (DFF / 64) * (D / 32);
    constexpr int NITEMS = I_IN + 2 * I_A + I_O + I_UP + I_DN + 32 + 32 + 64;
    for (int it = gw; it < NITEMS; it += NGW) {
        int r = it;
        if (r < I_IN) { transpose_item(INP(A, 3) + (size_t)l * D * INW, D, INW, WSW(l, WO_WIN), scr, r, F.lane, INP(A, 2) + (size_t)l * D); continue; } r -= I_IN;
        if (r < I_A) { transpose_item(INP(A, 17) + (size_t)l * RETW * D, RETW, D, WSW(l, WO_WA), scr, r, F.lane); continue; } r -= I_A;
        if (r < I_A) { transpose_item(INP(A, 18) + (size_t)l * RWW * D, RWW, D, WSW(l, WO_WB), scr, r, F.lane); continue; } r -= I_A;
        if (r < I_O) { transpose_item(INP(A, 19) + (size_t)l * D * D, D, D, WSW(l, WO_WO), scr, r, F.lane); continue; } r -= I_O;
        if (r < I_UP) { transpose_item(INP(A, 21) + (size_t)l * D * DFF, D, DFF, WSW(l, WO_WUP), scr, r, F.lane, INP(A, 20) + (size_t)l * D); continue; } r -= I_UP;
        if (r < I_DN) { transpose_item(INP(A, 22) + (size_t)l * DFF * D, DFF, D, WSW(l, WO_WDN), scr, r, F.lane); continue; } r -= I_DN;
        if (r < 32) { transpose_item(INP(A, 8) + (size_t)l * 64 * RWW, 64, RWW, WSW(l, WO_LORA), scr, r, F.lane); continue; } r -= 32;
        if (r < 32) { transpose_item(INP(A, 10) + (size_t)l * 64 * RWW, 64, RWW, WSW(l, WO_LORA) + 1024 * 64, scr, r, F.lane); continue; } r -= 32;
        transpose_item(INP(A, 11) + (size_t)l * 128 * RWW, 128, RWW, WSW(l, WO_LORA) + 2 * 1024 * 64, scr, r, F.lane);
    }
}
__device__ __forceinline__ void ph_norm(Frame& F, const float* g) {
    const int gw = F.vcu * NWAVES + F.wave, NGW = F.G * NWAVES;
    for (int m = gw; m < M; m += NGW) rms_row_to_bf16(OUTP + (size_t)m * D, g, WSP(bf16, WS_H) + (size_t)m * D, F.lane);
}
#if (MK_GLOBAL_GROUPS & 16)
#pragma pop_macro("WSP")
#pragma pop_macro("WSW")
#pragma pop_macro("OUTP")
#endif
#if (MK_GLOBAL_GROUPS & 2)
#pragma push_macro("WSP")
#pragma push_macro("WSW")
#pragma push_macro("OUTP")
#undef WSP
#undef WSW
#undef OUTP
#define WSP WSPG
#define WSW WSWG
#define OUTP OUTPG
#endif
__device__ __forceinline__ void unpack8(const v4u a, float (&o)[8]) {
    o[0] = pg8::bf_lo(a.x); o[1] = pg8::bf_hi(a.x); o[2] = pg8::bf_lo(a.y); o[3] = pg8::bf_hi(a.y); o[4] = pg8::bf_lo(a.z); o[5] = pg8::bf_hi(a.z); o[6] = pg8::bf_lo(a.w); o[7] = pg8::bf_hi(a.w);
}
__device__ __forceinline__ void mix8(const GAS bf16* zc, bool has_prev, const GAS float* mu, float (&o)[8]) {
    const v4u a = *(const GAS v4u*)zc; v4u p = (v4u){0u, 0u, 0u, 0u}; if (has_prev) p = *(const GAS v4u*)(zc - INW);
    const f32x4 m0 = *(const GAS f32x4*)mu, m1 = *(const GAS f32x4*)(mu + 4);
    float z[8], q[8]; unpack8(a, z); unpack8(p, q);
#pragma unroll
    for (int j = 0; j < 4; ++j) { o[j] = z[j] + m0[j] * (q[j] - z[j]); o[4 + j] = z[4 + j] + m1[j] * (q[4 + j] - z[4 + j]); }
}
__device__ __forceinline__ f32x4 mix4(const GAS bf16* zc, bool has_prev, const GAS float* mu) {
    const v2u a = *(const GAS v2u*)zc; v2u p = (v2u){0u, 0u}; if (has_prev) p = *(const GAS v2u*)(zc - INW);
    const f32x4 m = *(const GAS f32x4*)mu;
    const f32x4 z = (f32x4){pg8::bf_lo(a.x), pg8::bf_hi(a.x), pg8::bf_lo(a.y), pg8::bf_hi(a.y)}, q = (f32x4){pg8::bf_lo(p.x), pg8::bf_hi(p.x), pg8::bf_lo(p.y), pg8::bf_hi(p.y)};
    return z + m * (q - z);
}
__device__ __forceinline__ bf16x8 pack8(const float (&v)[8]) {
    v4u o; o.x = pg8::cvt_pk_bf16(v[0], v[1]); o.y = pg8::cvt_pk_bf16(v[2], v[3]); o.z = pg8::cvt_pk_bf16(v[4], v[5]); o.w = pg8::cvt_pk_bf16(v[6], v[7]);
    return __builtin_bit_cast(bf16x8, o);
}
constexpr int CU_BYTES = 20480, CU_M = 0, CU_N = 8192, CU_OM = 16384, CU_Y0 = 18432;
constexpr int CK = 16, NCHUNK = SEQ / CK;
constexpr int XL_STR = 144, XL_MAT = 16 * XL_STR;
typedef short s4v __attribute__((ext_vector_type(4)));
__device__ __forceinline__ s4v pk4(const f32x4 v) { v2u o; o.x = pg8::cvt_pk_bf16(v[0], v[1]); o.y = pg8::cvt_pk_bf16(v[2], v[3]); return __builtin_bit_cast(s4v, o); }
__device__ __forceinline__ bf16x8 pk8v(const f32x4 a, const f32x4 b) { v4u o; o.x = pg8::cvt_pk_bf16(a[0], a[1]); o.y = pg8::cvt_pk_bf16(a[2], a[3]); o.z = pg8::cvt_pk_bf16(b[0], b[1]); o.w = pg8::cvt_pk_bf16(b[2], b[3]); return __builtin_bit_cast(bf16x8, o); }
__device__ __forceinline__ f32x4 mma16(const s4v x, const s4v y, const f32x4 c) {
    const bf16x8 x8 = (bf16x8){x.x, x.y, x.z, x.w, 0, 0, 0, 0}, y8 = (bf16x8){y.x, y.y, y.z, y.w, 0, 0, 0, 0};
    return __builtin_amdgcn_mfma_f32_16x16x32_bf16(x8, y8, c, 0, 0, 0); }
__device__ __forceinline__ f32x4 mma32(const bf16x8 x, const bf16x8 y, const f32x4 c) { return __builtin_amdgcn_mfma_f32_16x16x32_bf16(x, y, c, 0, 0, 0); }
template <int N> __device__ __forceinline__ float dpp_shr0(float x) { return __builtin_bit_cast(float, __builtin_amdgcn_update_dpp(0, __builtin_bit_cast(int, x), 0x110 + N, 0xF, 0xF, true)); }
__device__ __forceinline__ float scan16(float x) { x += dpp_shr0<1>(x); x += dpp_shr0<2>(x); x += dpp_shr0<4>(x); x += dpp_shr0<8>(x); return x; }
__device__ __forceinline__ s4v trd(const LAS unsigned char* p) { return __builtin_amdgcn_ds_read_tr16_b64_v4i16((LAS s4v*)p); }
__device__ __forceinline__ void chunk_ops(const f32x4 (&r)[4], const f32x4 (&lw)[4], const f32x4 (&kp)[4], const f32x4 (&v)[4], const f32x4 (&a)[4], const f32x4 (&b)[4],
                                          LAS unsigned char* scr, GAS unsigned char* rec, int lane) {
    const int l15 = lane & 15, g = lane >> 4, tq = l15 >> 2, tp = l15 & 3;
    const f32x4 Z4 = (f32x4){0.f, 0.f, 0.f, 0.f};
    f32x4 Rt[4], pc[4]; bf16x8 Atf[2], Btf[2], Ktf[2], Rtf[2];
    {
        s4v Ah[4], Bq[4], Kq[4], Rq[4];
#pragma unroll
        for (int nt = 0; nt < 4; ++nt) {
            f32x4 cs, tot;
#pragma unroll
            for (int i = 0; i < 4; ++i) { cs[i] = scan16(lw[nt][i]); tot[i] = __shfl(cs[i], lane | 15); }
            f32x4 At, Bt, Kt, Bh, Kh;
#pragma unroll
            for (int i = 0; i < 4; ++i) { const float P = fexp(cs[i]), Pm1 = fexp(cs[i] - lw[nt][i]), iP = fexp(-cs[i]), PCP = fexp(tot[i] - cs[i]);
                pc[nt][i] = fexp(tot[i]); At[i] = a[nt][i] * Pm1; Bt[i] = b[nt][i] * iP; Kt[i] = kp[nt][i] * iP; Rt[nt][i] = r[nt][i] * P; Bh[i] = b[nt][i] * PCP; Kh[i] = kp[nt][i] * PCP; }
            Ah[nt] = pk4(At); Bq[nt] = pk4(Bt); Kq[nt] = pk4(Kt); Rq[nt] = pk4(Rt[nt]);
            LAS unsigned char* w = scr + l15 * XL_STR + (16 * nt + 4 * g) * 2;
            *(LAS s4v*)(w + 0 * XL_MAT) = Ah[nt]; *(LAS s4v*)(w + 1 * XL_MAT) = pk4(v[nt]); *(LAS s4v*)(w + 2 * XL_MAT) = pk4(Bh); *(LAS s4v*)(w + 3 * XL_MAT) = pk4(Kh);
        }
#pragma unroll
        for (int s = 0; s < 2; ++s) {
            Atf[s] = (bf16x8){Ah[2 * s].x, Ah[2 * s].y, Ah[2 * s].z, Ah[2 * s].w, Ah[2 * s + 1].x, Ah[2 * s + 1].y, Ah[2 * s + 1].z, Ah[2 * s + 1].w};
            Btf[s] = (bf16x8){Bq[2 * s].x, Bq[2 * s].y, Bq[2 * s].z, Bq[2 * s].w, Bq[2 * s + 1].x, Bq[2 * s + 1].y, Bq[2 * s + 1].z, Bq[2 * s + 1].w};
            Ktf[s] = (bf16x8){Kq[2 * s].x, Kq[2 * s].y, Kq[2 * s].z, Kq[2 * s].w, Kq[2 * s + 1].x, Kq[2 * s + 1].y, Kq[2 * s + 1].z, Kq[2 * s + 1].w};
            Rtf[s] = (bf16x8){Rq[2 * s].x, Rq[2 * s].y, Rq[2 * s].z, Rq[2 * s].w, Rq[2 * s + 1].x, Rq[2 * s + 1].y, Rq[2 * s + 1].z, Rq[2 * s + 1].w}; }
    }
    f32x4 LabR = Z4, LabT = Z4, LakT = Z4, LrbT = Z4, LrkT = Z4;
#pragma unroll
    for (int s = 0; s < 2; ++s) { LabR = mma32(Atf[s], Btf[s], LabR); LabT = mma32(Btf[s], Atf[s], LabT); LakT = mma32(Ktf[s], Atf[s], LakT); LrbT = mma32(Btf[s], Rtf[s], LrbT); LrkT = mma32(Ktf[s], Rtf[s], LrkT); }
    f32x4 IR;
#pragma unroll
    for (int i = 0; i < 4; ++i) { const int tt = 4 * g + i;
        IR[i] = (tt == l15) ? 1.f : 0.f;
        LabR[i] = (tt > l15) ? LabR[i] : 0.f; LabT[i] = (l15 > tt) ? LabT[i] : 0.f; LakT[i] = (l15 > tt) ? LakT[i] : 0.f;
        LrbT[i] = (l15 >= tt) ? LrbT[i] : 0.f; LrkT[i] = (l15 >= tt) ? LrkT[i] : 0.f; }
    const s4v L1R = pk4(LabR), L1T = pk4(LabT);
    const f32x4 L2R = mma16(L1T, L1R, Z4), L2T = mma16(L1R, L1T, Z4);
    const s4v L2Rp = pk4(L2R), L2Tp = pk4(L2T);
    const f32x4 L4R = mma16(L2Tp, L2Rp, Z4), L4T = mma16(L2Rp, L2Tp, Z4);
    const s4v L4Rp = pk4(L4R), L4Tp = pk4(L4T);
    const f32x4 L8R = mma16(L4Tp, L4Rp, Z4);
    const f32x4 T1T = mma16(pk4(IR + L2R), pk4(IR + LabT), Z4);
    const f32x4 T2T = mma16(pk4(IR + L4R), pk4(T1T), Z4);
    const s4v TmT = pk4(mma16(pk4(IR + L8R), pk4(T2T), Z4));
    const s4v LakTp = pk4(LakT), LrbTp = pk4(LrbT), LrkTp = pk4(LrkT);
    asm volatile("s_waitcnt lgkmcnt(0)" ::: "memory");
    const LAS unsigned char* tb = scr + (4 * g + tq) * XL_STR + (4 * tp) * 2;
    s4v tAt[4], tV[4], tBh[4], tKh[4];
#pragma unroll
    for (int t = 0; t < 4; ++t) { tAt[t] = trd(tb + 0 * XL_MAT + 32 * t); tV[t] = trd(tb + 1 * XL_MAT + 32 * t); tBh[t] = trd(tb + 2 * XL_MAT + 32 * t); tKh[t] = trd(tb + 3 * XL_MAT + 32 * t); }
    s4v Wp[4], U0p[4];
#pragma unroll
    for (int t = 0; t < 4; ++t) { Wp[t] = pk4(mma16(TmT, tAt[t], Z4));
        const f32x4 G = mma16(LakTp, tV[t], Z4);
        const f32x4 U0 = mma16(TmT, pk4(G), Z4); U0p[t] = pk4(U0);
        f32x4 Y0 = mma16(LrbTp, U0p[t], Z4); Y0 = mma16(LrkTp, tV[t], Y0);
        *(GAS s4v*)(rec + CU_Y0 + t * 512 + lane * 8) = pk4(Y0); }
    {
        f32x4 Om[4];
#pragma unroll
        for (int ct = 0; ct < 4; ++ct) Om[ct] = mma16(Wp[ct], LrbTp, Rt[ct]);
        *(GAS bf16x8*)(rec + CU_OM + 0 * 1024 + lane * 16) = pk8v(Om[0], Om[1]); *(GAS bf16x8*)(rec + CU_OM + 1 * 1024 + lane * 16) = pk8v(Om[2], Om[3]);
    }
#pragma unroll
    for (int tl = 0; tl < 4; ++tl) {
        f32x4 Mt[4];
#pragma unroll
        for (int kt = 0; kt < 4; ++kt) { Mt[kt] = mma16(Wp[kt], tBh[tl], Z4);
            if (kt == tl) {
#pragma unroll
                for (int i = 0; i < 4; ++i) Mt[kt][i] += (4 * g + i == l15) ? pc[kt][i] : 0.f; } }
        *(GAS bf16x8*)(rec + CU_M + (tl * 2 + 0) * 1024 + lane * 16) = pk8v(Mt[0], Mt[1]); *(GAS bf16x8*)(rec + CU_M + (tl * 2 + 1) * 1024 + lane * 16) = pk8v(Mt[2], Mt[3]);
    }
#pragma unroll
    for (int q = 0; q < 4; ++q)
#pragma unroll
        for (int tl = 0; tl < 4; ++tl) { f32x4 Nt = mma16(tBh[tl], U0p[q], Z4); Nt = mma16(tKh[tl], tV[q], Nt);
            *(GAS s4v*)(rec + CU_N + (q * 4 + tl) * 512 + lane * 8) = pk4(Nt); }
}
__device__ __forceinline__ void ph_prep(Frame& F, ArgP A, int l) {
    const int gw = F.vcu * NWAVES + F.wave, NGW = F.G * NWAVES, lane = F.lane, l15 = lane & 15, g = lane >> 4;
    {
        const int h = lane >> 3, i0 = 8 * (lane & 7);
        for (int m = gw; m < M; m += NGW) {
            const GAS bf16* zrow = (const GAS bf16*)(WSP(bf16, WS_Z) + (size_t)m * INW);
            const GAS f32x4* rp = (const GAS f32x4*)(WSP(float2, WS_ROPE) + (size_t)m * 64 + i0);
            const f32x4 c01 = rp[0], c23 = rp[1], c45 = rp[2], c67 = rp[3];
            const float cs[8] = {c01.x, c01.z, c23.x, c23.z, c45.x, c45.z, c67.x, c67.z}, sn[8] = {c01.y, c01.w, c23.y, c23.w, c45.y, c45.w, c67.y, c67.w};
            float q1[8], q2[8], k1[8], k2[8], o1[8], o2[8];
            unpack8(*(const GAS v4u*)(zrow + ZC_Q + h * RD + i0), q1); unpack8(*(const GAS v4u*)(zrow + ZC_Q + h * RD + 64 + i0), q2);
            unpack8(*(const GAS v4u*)(zrow + ZC_K + h * RD + i0), k1); unpack8(*(const GAS v4u*)(zrow + ZC_K + h * RD + 64 + i0), k2);
#pragma unroll
            for (int j = 0; j < 8; ++j) { o1[j] = q1[j] * cs[j] - q2[j] * sn[j]; o2[j] = q2[j] * cs[j] + q1[j] * sn[j]; }
            GAS bf16* qo = (GAS bf16*)(WSP(bf16, WS_QR) + (size_t)m * RETW + h * RD + i0);
            *(GAS bf16x8*)qo = pack8(o1); *(GAS bf16x8*)(qo + 64) = pack8(o2);
#pragma unroll
            for (int j = 0; j < 8; ++j) { const float a = k1[j] * 0.08838834764831845f, b = k2[j] * 0.08838834764831845f; o1[j] = a * cs[j] - b * sn[j]; o2[j] = b * cs[j] + a * sn[j]; }
            GAS bf16* ko = (GAS bf16*)(WSP(bf16, WS_KR) + (size_t)m * RETW + h * RD + i0);
            *(GAS bf16x8*)ko = pack8(o1); *(GAS bf16x8*)(ko + 64) = pack8(o2);
        }
    }
    const GAS float* mu = (const GAS float*)(INP(A, 6) + (size_t)l * RWSHIFT);
    const GAS float* w0 = (const GAS float*)(INP(A, 7) + (size_t)l * RWW); const GAS float* a0 = (const GAS float*)(INP(A, 9) + (size_t)l * RWW);
    const GAS float* kkw = (const GAS float*)(INP(A, 12) + (size_t)l * RWW); const GAS float* kaw = (const GAS float*)(INP(A, 13) + (size_t)l * RWW); const GAS float* rkw = (const GAS float*)(INP(A, 14) + (size_t)l * RWW);
    const GAS bf16* WupT = (const GAS bf16*)WSW(l, WO_LORA); const GAS bf16* AupT = WupT + 1024 * 64; const GAS bf16* GupT = AupT + 1024 * 64;
    for (int task = gw; task < M / 8; task += NGW) {
        const int m = (task >> 1) * 16 + l15, hh0 = (task & 1) * (WH / 2);
        const bool has_prev = (m % SEQ) != 0;
        const GAS bf16* zr = (const GAS bf16*)(WSP(bf16, WS_Z) + (size_t)m * INW + ZC_RW);
        bf16x8 fw[2], fa[2], fg[4];
#pragma unroll
        for (int ks = 0; ks < 2; ++ks) { float t[8];
            mix8(zr + RWC_W + 32 * ks + 8 * g, has_prev, mu + RWC_W + 32 * ks + 8 * g, t);
#pragma unroll
            for (int j = 0; j < 8; ++j) t[j] = ftanh(t[j]);
            fw[ks] = pack8(t);
            mix8(zr + RWC_A + 32 * ks + 8 * g, has_prev, mu + RWC_A + 32 * ks + 8 * g, t); fa[ks] = pack8(t); }
#pragma unroll
        for (int ks = 0; ks < 4; ++ks) { float t[8];
            mix8(zr + RWC_G + 32 * ks + 8 * g, has_prev, mu + RWC_G + 32 * ks + 8 * g, t);
#pragma unroll
            for (int j = 0; j < 8; ++j) t[j] = fsig(t[j]);
            fg[ks] = pack8(t); }
        for (int hh = hh0; hh < hh0 + WH / 2; ++hh) {
            f32x4 kkr[4], av[4], rr[4], lwv[4], kpv[4], vv[4]; float ss = 0.f, bonus = 0.f;
#pragma unroll
            for (int nt = 0; nt < 4; ++nt) {
                const int cf = hh * WD + nt * 16 + l15;
                const int c0 = hh * WD + nt * 16 + 4 * g;
                f32x4 wl = *(const GAS f32x4*)(w0 + c0), al = *(const GAS f32x4*)(a0 + c0), gl = (f32x4){0.f, 0.f, 0.f, 0.f};
#pragma unroll
                for (int ks = 0; ks < 2; ++ks) {
                    wl = __builtin_amdgcn_mfma_f32_16x16x32_bf16(*(const GAS bf16x8*)(WupT + (size_t)cf * 64 + 32 * ks + 8 * g), fw[ks], wl, 0, 0, 0);
                    al = __builtin_amdgcn_mfma_f32_16x16x32_bf16(*(const GAS bf16x8*)(AupT + (size_t)cf * 64 + 32 * ks + 8 * g), fa[ks], al, 0, 0, 0); }
#pragma unroll
                for (int ks = 0; ks < 4; ++ks)
                    gl = __builtin_amdgcn_mfma_f32_16x16x32_bf16(*(const GAS bf16x8*)(GupT + (size_t)cf * 128 + 32 * ks + 8 * g), fg[ks], gl, 0, 0, 0);
                const f32x4 r = mix4(zr + RWC_R + c0, has_prev, mu + RWC_R + c0), k = mix4(zr + RWC_K + c0, has_prev, mu + RWC_K + c0), v = mix4(zr + RWC_V + c0, has_prev, mu + RWC_V + c0);
                const f32x4 kk4 = *(const GAS f32x4*)(kkw + c0), ka4 = *(const GAS f32x4*)(kaw + c0), rk4 = *(const GAS f32x4*)(rkw + c0);
                f32x4 lwd, a, kp;
#pragma unroll
                for (int i = 0; i < 4; ++i) {
                    lwd[i] = -0.6065306597126334f * fsig(wl[i]);
                    a[i] = fsig(al[i]);
                    kp[i] = k[i] * (1.0f + (a[i] - 1.0f) * ka4[i]);
                }
                kkr[nt] = k * kk4; av[nt] = a; rr[nt] = r; lwv[nt] = lwd; kpv[nt] = kp; vv[nt] = v;
                ss += (kkr[nt].x * kkr[nt].x + kkr[nt].y * kkr[nt].y) + (kkr[nt].z * kkr[nt].z + kkr[nt].w * kkr[nt].w);
                const f32x4 rb = r * kp * rk4; bonus += (rb.x + rb.y) + (rb.z + rb.w);
                const size_t o = (size_t)m * RWW + c0;
#if MK_CHUNKED
                *(GAS f32x4*)(WSP(float, WS_SV) + o) = v; *(GAS f32x4*)(WSP(float, WS_G) + o) = gl;
#else
                f32x4 decay;
#pragma unroll
                for (int i = 0; i < 4; ++i) decay[i] = fexp(lwd[i]);
                *(GAS f32x4*)(WSP(float, WS_SR) + o) = r; *(GAS f32x4*)(WSP(float, WS_SW) + o) = decay; *(GAS f32x4*)(WSP(float, WS_SK) + o) = kp;
                *(GAS f32x4*)(WSP(float, WS_SV) + o) = v; *(GAS f32x4*)(WSP(float, WS_G) + o) = gl;
#endif
            }
            ss += __shfl_xor(ss, 16); ss += __shfl_xor(ss, 32); bonus += __shfl_xor(bonus, 16); bonus += __shfl_xor(bonus, 32);
            const float inv = 1.0f / fmaxf(sqrtf(ss), 1e-12f);
            if (g == 0) WSP(float, WS_BONUS)[(size_t)m * WH + hh] = bonus;
#if MK_CHUNKED
            f32x4 aa[4], bb[4];
#pragma unroll
            for (int nt = 0; nt < 4; ++nt) { const f32x4 kk = kkr[nt] * inv; aa[nt] = -kk; bb[nt] = kk * av[nt]; }
            const int tile = task >> 1;
            GAS unsigned char* rec = (GAS unsigned char*)WSP(unsigned char, WS_CU) + ((size_t)((tile / NCHUNK) * WH + hh) * NCHUNK + (tile % NCHUNK)) * CU_BYTES;
            chunk_ops(rr, lwv, kpv, vv, aa, bb, F.lds + RING_OFF + F.wave * 16384, rec, lane);
#else
#pragma unroll
            for (int nt = 0; nt < 4; ++nt) { const size_t o = (size_t)m * RWW + hh * WD + nt * 16 + 4 * g; const f32x4 kk = kkr[nt] * inv;
                *(GAS f32x4*)(WSP(float, WS_SNKK) + o) = -kk; *(GAS f32x4*)(WSP(float, WS_SKKA) + o) = kk * av[nt]; }
#endif
        }
    }
}
#if (MK_GLOBAL_GROUPS & 2)
#pragma pop_macro("WSP")
#pragma pop_macro("WSW")
#pragma pop_macro("OUTP")
#endif
#if (MK_GLOBAL_GROUPS & 4)
#pragma push_macro("WSP")
#pragma push_macro("WSW")
#pragma push_macro("OUTP")
#undef WSP
#undef WSW
#undef OUTP
#define WSP WSPG
#define WSW WSWG
#define OUTP OUTPG
#endif
#if !MK_CHUNKED
__device__ __forceinline__ void scan_rwkv_naive(Frame& F, int item) {
    const int lane = F.lane;
    float st[64];
#pragma unroll
    for (int j = 0; j < 64; ++j) st[j] = 0.f;
    const size_t base0 = (size_t)(item >> 4) * SEQ * RWW + (size_t)(item & 15) * WD + lane;
    for (int t = 0; t < SEQ; ++t) {
        const size_t o = base0 + (size_t)t * RWW;
        const float r = WSP(float, WS_SR)[o], w = WSP(float, WS_SW)[o], k = WSP(float, WS_SK)[o], v = WSP(float, WS_SV)[o], nk = WSP(float, WS_SNKK)[o], ka = WSP(float, WS_SKKA)[o];
        float sa = 0.f;
#pragma unroll
        for (int j = 0; j < 64; ++j) sa += st[j] * rdlane(nk, j);
        float y = 0.f;
#pragma unroll
        for (int j = 0; j < 64; ++j) { st[j] = st[j] * rdlane(w, j) + sa * rdlane(ka, j) + v * rdlane(k, j); y += st[j] * rdlane(r, j); }
        WSP(float, WS_YRAWW)[o] = y;
    }
}
#endif
__device__ __forceinline__ void scan_ret_naive(Frame& F, int item) {
    const int lane = F.lane, b = item >> 4, h = (item >> 1) & 7, half = item & 1;
    const float gam = 1.0f - exp2f((float)(-5 - h));
    float R[128];
#pragma unroll
    for (int j = 0; j < 128; ++j) R[j] = 0.f;
    for (int t = 0; t < SEQ; ++t) {
        const size_t m = (size_t)b * SEQ + t;
        const float q1 = bf2f(WSP(bf16, WS_QR)[m * RETW + h * RD + lane]), q2 = bf2f(WSP(bf16, WS_QR)[m * RETW + h * RD + 64 + lane]);
        const float k1 = bf2f(WSP(bf16, WS_KR)[m * RETW + h * RD + lane]), k2 = bf2f(WSP(bf16, WS_KR)[m * RETW + h * RD + 64 + lane]);
        const float v = bf2f(WSP(bf16, WS_Z)[m * INW + ZC_V + h * RD + half * 64 + lane]);
        float y = 0.f;
#pragma unroll
        for (int d = 0; d < 64; ++d) { R[d] = gam * R[d] + rdlane(k1, d) * v; y += rdlane(q1, d) * R[d]; }
#pragma unroll
        for (int d = 0; d < 64; ++d) { R[64 + d] = gam * R[64 + d] + rdlane(k2, d) * v; y += rdlane(q2, d) * R[64 + d]; }
        WSP(float, WS_YRAWR)[m * RETW + h * RD + half * 64 + lane] = y;
    }
}
#if !MK_CHUNKED
constexpr int SCT = 32;
constexpr int SC_ARR = SCT * 64 * 4;
constexpr int SC_BUF = 5 * SC_ARR + SCT * 16 * 4;
static_assert(2 * SC_BUF <= RING_BYTES, "scan LDS");
template <int CTRL> __device__ __forceinline__ float dppf(float x) { return __builtin_bit_cast(float, __builtin_amdgcn_update_dpp(0, __builtin_bit_cast(int, x), CTRL, 0xF, 0xF, true)); }
__device__ __forceinline__ float sum16(float x) {
    x += dppf<0xB1>(x); x += dppf<0x4E>(x); x += dppf<0x141>(x); x += dppf<0x140>(x); return x;
}
__device__ __forceinline__ void scan_rwkv_fast(Frame& F, int w) {
    const int b = w >> 6, hh = (w >> 2) & 15, q = w & 3;
    const int lane = F.lane, wave = F.wave;
    LAS unsigned char* base = F.lds + RING_OFF;
    const size_t g0 = (size_t)b * SEQ * RWW + (size_t)hh * WD;
    constexpr int NBLK = SEQ / SCT;
#define SC_BAR() do { asm volatile("s_waitcnt lgkmcnt(0)" ::: "memory"); __builtin_amdgcn_s_barrier(); asm volatile("" ::: "memory"); } while (0)
    if (wave >= 4) {
        const int lt = F.tid - 256;
        const float* a0 = WSP(float, WS_SR) + g0; const float* a1 = WSP(float, WS_SW) + g0; const float* a2 = WSP(float, WS_SK) + g0;
        const float* a3 = WSP(float, WS_SNKK) + g0; const float* a4 = WSP(float, WS_SKKA) + g0; const float* av = WSP(float, WS_SV) + g0 + 16 * q;
        const int f0 = lt, f1 = lt + 256;
        const size_t o0 = (size_t)(f0 >> 4) * RWW + 4 * (f0 & 15), o1 = (size_t)(f1 >> 4) * RWW + 4 * (f1 & 15), ov = (size_t)(lt >> 2) * RWW + 4 * (lt & 3);
        f32x4 r0[5], r1[5], rv;
#define SC_LOAD(blk) do { const size_t tb = (size_t)(blk) * SCT * RWW; \
        r0[0] = *(const GAS f32x4*)(a0 + tb + o0); r1[0] = *(const GAS f32x4*)(a0 + tb + o1); r0[1] = *(const GAS f32x4*)(a1 + tb + o0); r1[1] = *(const GAS f32x4*)(a1 + tb + o1); \
        r0[2] = *(const GAS f32x4*)(a2 + tb + o0); r1[2] = *(const GAS f32x4*)(a2 + tb + o1); r0[3] = *(const GAS f32x4*)(a3 + tb + o0); r1[3] = *(const GAS f32x4*)(a3 + tb + o1); \
        r0[4] = *(const GAS f32x4*)(a4 + tb + o0); r1[4] = *(const GAS f32x4*)(a4 + tb + o1); if (lt < 128) rv = *(const GAS f32x4*)(av + tb + ov); } while (0)
#define SC_STORE(bi) do { LAS unsigned char* bb = base + (bi) * SC_BUF; \
        _Pragma("unroll") for (int a = 0; a < 5; ++a) { *(LAS f32x4*)(bb + a * SC_ARR + f0 * 16) = r0[a]; *(LAS f32x4*)(bb + a * SC_ARR + f1 * 16) = r1[a]; } \
        if (lt < 128) *(LAS f32x4*)(bb + 5 * SC_ARR + lt * 16) = rv; } while (0)
        SC_LOAD(0); SC_STORE(0);
        if (1 < NBLK) SC_LOAD(1);
        SC_BAR();
        for (int blk = 0; blk < NBLK; ++blk) {
            if (blk + 1 < NBLK) { SC_STORE((blk + 1) & 1); if (blk + 2 < NBLK) SC_LOAD(blk + 2); }
            SC_BAR();
        }
#undef SC_LOAD
#undef SC_STORE
    } else {
        const int l16 = lane & 15, rowl = 4 * wave + (lane >> 4);
        GAS float* Y = (GAS float*)(WSP(float, WS_YRAWW) + g0 + 16 * q + rowl);
        f32x4 st = (f32x4){0.f, 0.f, 0.f, 0.f};
        const int lo = l16 * 16, vo = 5 * SC_ARR + rowl * 4;
#define SC_LD(tt_, R4, W4, K4, N4, A4, V) do { R4 = *(const LAS f32x4*)(bb + 0 * SC_ARR + (tt_) * 256 + lo); W4 = *(const LAS f32x4*)(bb + 1 * SC_ARR + (tt_) * 256 + lo); \
        K4 = *(const LAS f32x4*)(bb + 2 * SC_ARR + (tt_) * 256 + lo); N4 = *(const LAS f32x4*)(bb + 3 * SC_ARR + (tt_) * 256 + lo); A4 = *(const LAS f32x4*)(bb + 4 * SC_ARR + (tt_) * 256 + lo); \
        V = *(const LAS float*)(bb + vo + (tt_) * 64); } while (0)
        SC_BAR();
        for (int blk = 0; blk < NBLK; ++blk) {
            const LAS unsigned char* bb = base + (blk & 1) * SC_BUF;
            GAS float* yb = Y + (size_t)blk * SCT * RWW;
            f32x4 r4[3], w4[3], k4[3], n4[3], a4[3]; float v[3];
            SC_LD(0, r4[0], w4[0], k4[0], n4[0], a4[0], v[0]);
            SC_LD(1, r4[1], w4[1], k4[1], n4[1], a4[1], v[1]);
#pragma unroll
            for (int tt = 0; tt < SCT; ++tt) {
                const int c = tt % 3, p = (tt + 2) % 3;
                if (tt + 2 < SCT) SC_LD(tt + 2, r4[p], w4[p], k4[p], n4[p], a4[p], v[p]);
                f32x2 sp2 = (f32x2){st.x, st.y} * (f32x2){n4[c].x, n4[c].y}; sp2 = (f32x2){st.z, st.w} * (f32x2){n4[c].z, n4[c].w} + sp2;
                const f32x4 t0 = st * w4[c] + k4[c] * v[c];
                const float sa = sum16(sp2.x + sp2.y);
                st = a4[c] * sa + t0;
                f32x2 yp2 = (f32x2){st.x, st.y} * (f32x2){r4[c].x, r4[c].y}; yp2 = (f32x2){st.z, st.w} * (f32x2){r4[c].z, r4[c].w} + yp2;
                const float y = sum16(yp2.x + yp2.y);
                yb[(size_t)tt * RWW] = y;
            }
            SC_BAR();
        }
#undef SC_LD
#undef SC_BAR
    }
}
#endif
constexpr int CB_STEPS = 4, CB_STEP_BYTES = 8192 + 2048 + 2048 + 512, CB_BUF = CB_STEPS * CB_STEP_BYTES, CB_PIECES = CB_BUF / 16, CB_NBLK = NCHUNK / CB_STEPS;
static_assert(2 * CB_BUF <= RING_BYTES, "chunk scan LDS");
#ifndef MK_X2_DIRECT
#define MK_X2_DIRECT 0
#endif
__device__ __forceinline__ f32x4 unpk4(const v2u p) { return (f32x4){pg8::bf_lo(p.x), pg8::bf_hi(p.x), pg8::bf_lo(p.y), pg8::bf_hi(p.y)}; }
__device__ __forceinline__ void scan_rwkv_chunk(Frame& F, int w) {
    const int bh = w >> 2, q = w & 3, lane = F.lane, wave = F.wave;
#if MK_X2_DIRECT
    if (wave == 0) {
        const int l15 = lane & 15, g = lane >> 4;
        const f32x4 Z4 = (f32x4){0.f, 0.f, 0.f, 0.f};
        f32x4 acc[4] = {Z4, Z4, Z4, Z4};
        const GAS unsigned char* rec = (const GAS unsigned char*)WSP(unsigned char, WS_CU) + (size_t)bh * NCHUNK * CU_BYTES;
        GAS float* Y = (GAS float*)(WSP(float, WS_YRAWW) + (size_t)(bh >> 4) * SEQ * RWW + (size_t)(bh & 15) * WD + 16 * q + l15 + (size_t)(4 * g) * RWW);
        for (int n = 0; n < NCHUNK; ++n, rec += CU_BYTES) {
            const bf16x8 sf0 = pk8v(acc[0], acc[1]), sf1 = pk8v(acc[2], acc[3]);
            f32x4 ya = unpk4(*(const GAS v2u*)(rec + CU_Y0 + q * 512 + lane * 8));
            ya = mma32(*(const GAS bf16x8*)(rec + CU_OM + lane * 16), sf0, ya); ya = mma32(*(const GAS bf16x8*)(rec + CU_OM + 1024 + lane * 16), sf1, ya);
            GAS float* yp = Y + (size_t)(n * CK) * RWW;
#pragma unroll
            for (int i = 0; i < 4; ++i) yp[(size_t)i * RWW] = ya[i];
#pragma unroll
            for (int tl = 0; tl < 4; ++tl) { f32x4 na = unpk4(*(const GAS v2u*)(rec + CU_N + (q * 4 + tl) * 512 + lane * 8));
                na = mma32(*(const GAS bf16x8*)(rec + CU_M + (tl * 2 + 0) * 1024 + lane * 16), sf0, na); na = mma32(*(const GAS bf16x8*)(rec + CU_M + (tl * 2 + 1) * 1024 + lane * 16), sf1, na);
                acc[tl] = na; }
        }
    }
    return;
#endif
    LAS unsigned char* base = F.lds + RING_OFF;
    const GAS unsigned char* rec0 = (const GAS unsigned char*)WSP(unsigned char, WS_CU) + (size_t)bh * NCHUNK * CU_BYTES;
#define CB_BAR() do { asm volatile("s_waitcnt lgkmcnt(0)" ::: "memory"); __builtin_amdgcn_s_barrier(); asm volatile("" ::: "memory"); } while (0)
    if (wave >= 1) {
        const int lt = F.tid - 64;
        v4u rg[8];
#define CB_LOAD(blk) do { _Pragma("unroll") for (int j = 0; j < 8; ++j) { const int p = lt + 448 * j; if (p < CB_PIECES) { const int st = p / 800, off = p % 800; \
            const GAS unsigned char* rec = rec0 + (size_t)((blk) * CB_STEPS + st) * CU_BYTES; \
            const int src = off < 512 ? off * 16 : (off < 640 ? CU_N + q * 2048 + (off - 512) * 16 : (off < 768 ? CU_OM + (off - 640) * 16 : CU_Y0 + q * 512 + (off - 768) * 16)); \
            rg[j] = *(const GAS v4u*)(rec + src); } } } while (0)
#define CB_STORE(bi) do { _Pragma("unroll") for (int j = 0; j < 8; ++j) { const int p = lt + 448 * j; if (p < CB_PIECES) *(LAS v4u*)(base + (bi) * CB_BUF + p * 16) = rg[j]; } } while (0)
        CB_LOAD(0); CB_STORE(0);
        if (1 < CB_NBLK) CB_LOAD(1);
        CB_BAR();
        for (int blk = 0; blk < CB_NBLK; ++blk) {
            if (blk + 1 < CB_NBLK) { CB_STORE((blk + 1) & 1); if (blk + 2 < CB_NBLK) CB_LOAD(blk + 2); }
            CB_BAR();
        }
#undef CB_LOAD
#undef CB_STORE
    } else {
        const int l15 = lane & 15, g = lane >> 4;
        const f32x4 Z4 = (f32x4){0.f, 0.f, 0.f, 0.f};
        f32x4 acc[4] = {Z4, Z4, Z4, Z4};
        GAS float* Y = (GAS float*)(WSP(float, WS_YRAWW) + (size_t)(bh >> 4) * SEQ * RWW + (size_t)(bh & 15) * WD + 16 * q + l15 + (size_t)(4 * g) * RWW);
        CB_BAR();
        for (int blk = 0; blk < CB_NBLK; ++blk) {
            const LAS unsigned char* bb = base + (blk & 1) * CB_BUF;
#pragma unroll
            for (int st = 0; st < CB_STEPS; ++st) {
                const LAS unsigned char* sb = bb + st * CB_STEP_BYTES;
                const bf16x8 sf0 = pk8v(acc[0], acc[1]), sf1 = pk8v(acc[2], acc[3]);
                f32x4 ya = unpk4(*(const LAS v2u*)(sb + 12288 + lane * 8));
                ya = mma32(*(const LAS bf16x8*)(sb + 10240 + lane * 16), sf0, ya); ya = mma32(*(const LAS bf16x8*)(sb + 11264 + lane * 16), sf1, ya);
                GAS float* yp = Y + (size_t)((blk * CB_STEPS + st) * CK) * RWW;
#pragma unroll
                for (int i = 0; i < 4; ++i) yp[(size_t)i * RWW] = ya[i];
#pragma unroll
                for (int tl = 0; tl < 4; ++tl) { f32x4 na = unpk4(*(const LAS v2u*)(sb + 8192 + tl * 512 + lane * 8));
                    na = mma32(*(const LAS bf16x8*)(sb + (tl * 2 + 0) * 1024 + lane * 16), sf0, na); na = mma32(*(const LAS bf16x8*)(sb + (tl * 2 + 1) * 1024 + lane * 16), sf1, na);
                    acc[tl] = na; }
            }
            CB_BAR();
        }
    }
#undef CB_BAR
}
constexpr int RT_STR = 288, RT_QS = 0, RT_KS = 128 * RT_STR, RT_VSTR = 80, RT_VS = 2 * 128 * RT_STR, RT_VPS = RT_VS + 128 * RT_VSTR, RT_RT = RT_VPS + 128 * RT_VSTR, RT_RTSZ = 32 * RT_STR;
static_assert(RT_RT + 2 * RT_RTSZ <= RING_BYTES, "retention LDS");
__device__ __forceinline__ bf16x8 tr8(const LAS unsigned char* p0, const LAS unsigned char* p1) {
    const s4v a = __builtin_amdgcn_ds_read_tr16_b64_v4i16((LAS s4v*)p0), b = __builtin_amdgcn_ds_read_tr16_b64_v4i16((LAS s4v*)p1);
    return (bf16x8){a.x, a.y, a.z, a.w, b.x, b.y, b.z, b.w};
}
__device__ __forceinline__ void scan_ret_mfma(Frame& F, int w_) {
    const int b = w_ >> 5, h = (w_ >> 2) & 7, eq = w_ & 3;
    const int tid = F.tid, lane = F.lane, w = F.wave, l15 = lane & 15, g = lane >> 4, tq = l15 >> 2, tp = l15 & 3;
    LAS unsigned char* L = F.lds + RING_OFF;
    const float lg2 = log1pf(-exp2f((float)(-5 - h))) * 1.4426950408889634f;
    const float gC = __builtin_amdgcn_exp2f(lg2 * 128.f);
    for (int i = tid; i < RT_RTSZ / 4; i += NWAVES * 64) ((LAS unsigned*)(L + RT_RT))[i] = 0u;
    const GAS bf16* Qg = (const GAS bf16*)(WSP(bf16, WS_QR) + (size_t)b * SEQ * RETW + h * RD);
    const GAS bf16* Kg = (const GAS bf16*)(WSP(bf16, WS_KR) + (size_t)b * SEQ * RETW + h * RD);
    const GAS bf16* Vg = (const GAS bf16*)(WSP(bf16, WS_Z) + (size_t)b * SEQ * INW + ZC_V + h * RD + 32 * eq);
    GAS float* Yg = (GAS float*)(WSP(float, WS_YRAWR) + (size_t)b * SEQ * RETW + h * RD + 32 * eq);
    v4u rq[4], rk[4], rv;
#define RT_LOAD(n_) do { _Pragma("unroll") for (int i = 0; i < 4; ++i) { const int f = tid + 512 * i, c = f >> 4, pc = f & 15; \
        rq[i] = *(const GAS v4u*)(Qg + (size_t)((n_) * 128 + c) * RETW + 8 * pc); rk[i] = *(const GAS v4u*)(Kg + (size_t)((n_) * 128 + c) * RETW + 8 * pc); } \
        rv = *(const GAS v4u*)(Vg + (size_t)((n_) * 128 + (tid >> 2)) * INW + 8 * (tid & 3)); } while (0)
    f32x4 accR[2] = {(f32x4){0.f, 0.f, 0.f, 0.f}, (f32x4){0.f, 0.f, 0.f, 0.f}};
    RT_LOAD(0);
    for (int n = 0; n < SEQ / 128; ++n) {
#pragma unroll
        for (int i = 0; i < 4; ++i) { const int f = tid + 512 * i, c = f >> 4, pc = f & 15;
            *(LAS v4u*)(L + RT_QS + c * RT_STR + pc * 16) = rq[i]; *(LAS v4u*)(L + RT_KS + c * RT_STR + pc * 16) = rk[i]; }
        { const int c = tid >> 2, pc = tid & 3; *(LAS v4u*)(L + RT_VS + c * RT_VSTR + pc * 16) = rv;
          const float sc = __builtin_amdgcn_exp2f(lg2 * (float)(127 - c)); v4u o;
          o.x = pg8::cvt_pk_bf16(pg8::bf_lo(rv.x) * sc, pg8::bf_hi(rv.x) * sc); o.y = pg8::cvt_pk_bf16(pg8::bf_lo(rv.y) * sc, pg8::bf_hi(rv.y) * sc);
          o.z = pg8::cvt_pk_bf16(pg8::bf_lo(rv.z) * sc, pg8::bf_hi(rv.z) * sc); o.w = pg8::cvt_pk_bf16(pg8::bf_lo(rv.w) * sc, pg8::bf_hi(rv.w) * sc);
          *(LAS v4u*)(L + RT_VPS + c * RT_VSTR + pc * 16) = o; }
        __syncthreads();
        if (n + 1 < SEQ / 128) RT_LOAD(n + 1);
        bf16x8 qf[4];
#pragma unroll
        for (int ks = 0; ks < 4; ++ks) qf[ks] = *(const LAS bf16x8*)(L + RT_QS + (16 * w + l15) * RT_STR + (32 * ks + 8 * g) * 2);
        bf16x8 pf[4];
        const int cq = 16 * w + l15;
#pragma unroll
        for (int p = 0; p < 4; ++p) {
            f32x4 s0 = (f32x4){0.f, 0.f, 0.f, 0.f}, s1 = (f32x4){0.f, 0.f, 0.f, 0.f};
            if (2 * p <= w) {
#pragma unroll
                for (int ks = 0; ks < 4; ++ks) { const bf16x8 kf = *(const LAS bf16x8*)(L + RT_KS + (32 * p + l15) * RT_STR + (32 * ks + 8 * g) * 2);
                    s0 = __builtin_amdgcn_mfma_f32_16x16x32_bf16(kf, qf[ks], s0, 0, 0, 0); }
            }
            if (2 * p + 1 <= w) {
#pragma unroll
                for (int ks = 0; ks < 4; ++ks) { const bf16x8 kf = *(const LAS bf16x8*)(L + RT_KS + (32 * p + 16 + l15) * RT_STR + (32 * ks + 8 * g) * 2);
                    s1 = __builtin_amdgcn_mfma_f32_16x16x32_bf16(kf, qf[ks], s1, 0, 0, 0); }
            }
            float p0[4], p1[4];
#pragma unroll
            for (int i = 0; i < 4; ++i) { const int d0 = cq - (32 * p + 4 * g + i), d1 = d0 - 16;
                p0[i] = d0 >= 0 ? s0[i] * __builtin_amdgcn_exp2f(lg2 * (float)d0) : 0.f; p1[i] = d1 >= 0 ? s1[i] * __builtin_amdgcn_exp2f(lg2 * (float)d1) : 0.f; }
            v4u pk; pk.x = pg8::cvt_pk_bf16(p0[0], p0[1]); pk.y = pg8::cvt_pk_bf16(p0[2], p0[3]); pk.z = pg8::cvt_pk_bf16(p1[0], p1[1]); pk.w = pg8::cvt_pk_bf16(p1[2], p1[3]);
            pf[p] = __builtin_bit_cast(bf16x8, pk);
        }
        const LAS unsigned char* Rcur = L + RT_RT + (n & 1) * RT_RTSZ;
#pragma unroll
        for (int et = 0; et < 2; ++et) {
            f32x4 acc = (f32x4){0.f, 0.f, 0.f, 0.f};
#pragma unroll
            for (int ks = 0; ks < 4; ++ks) { const bf16x8 rf = *(const LAS bf16x8*)(Rcur + (16 * et + l15) * RT_STR + (32 * ks + 8 * g) * 2);
                acc = __builtin_amdgcn_mfma_f32_16x16x32_bf16(qf[ks], rf, acc, 0, 0, 0); }
#pragma unroll
            for (int i = 0; i < 4; ++i) acc[i] *= __builtin_amdgcn_exp2f(lg2 * (float)(16 * w + 4 * g + i + 1));
#pragma unroll
            for (int p = 0; p < 4; ++p) if (2 * p <= w) {
                const LAS unsigned char* vb = L + RT_VS + (32 * p + 4 * g + tq) * RT_VSTR + (16 * et + 4 * tp) * 2;
                const bf16x8 vf = tr8(vb, vb + 16 * RT_VSTR);
                acc = __builtin_amdgcn_mfma_f32_16x16x32_bf16(pf[p], vf, acc, 0, 0, 0); }
#pragma unroll
            for (int i = 0; i < 4; ++i) Yg[(size_t)(n * 128 + 16 * w + 4 * g + i) * RETW + 16 * et + l15] = acc[i];
        }
        LAS unsigned char* Rnxt = L + RT_RT + ((n + 1) & 1) * RT_RTSZ;
        accR[0] = accR[0] * gC; accR[1] = accR[1] * gC;
#pragma unroll
        for (int cs = 0; cs < 4; ++cs) {
            const LAS unsigned char* kb = L + RT_KS + (32 * cs + 8 * g + tq) * RT_STR + (16 * w + 4 * tp) * 2;
            const bf16x8 kt = tr8(kb, kb + 4 * RT_STR);
#pragma unroll
            for (int et = 0; et < 2; ++et) { const LAS unsigned char* vb = L + RT_VPS + (32 * cs + 8 * g + tq) * RT_VSTR + (16 * et + 4 * tp) * 2;
                const bf16x8 vt = tr8(vb, vb + 4 * RT_VSTR);
                accR[et] = __builtin_amdgcn_mfma_f32_16x16x32_bf16(kt, vt, accR[et], 0, 0, 0); }
        }
#pragma unroll
        for (int et = 0; et < 2; ++et) { v2u o; o.x = pg8::cvt_pk_bf16(accR[et][0], accR[et][1]); o.y = pg8::cvt_pk_bf16(accR[et][2], accR[et][3]);
            *(LAS v2u*)(Rnxt + (16 * et + l15) * RT_STR + (16 * w + 4 * g) * 2) = o; }
        __syncthreads();
    }
#undef RT_LOAD
}
__device__ __forceinline__ void ph_scan(Frame& F, ArgP A, int l) {
    if (F.G >= 256) {
        if (F.vcu >= 192) { if (l + 1 < DEPTH) ph_convert(F, A, l + 1, F.vcu - 192, F.G - 192); return; }
#if MK_CHUNKED
        if (F.vcu < 128) { scan_rwkv_chunk(F, F.vcu); if (MK_REP & 32) { __syncthreads(); scan_rwkv_chunk(F, F.vcu); } }
#else
        if (F.vcu < 128) { scan_rwkv_fast(F, F.vcu); if (MK_REP & 32) { __syncthreads(); scan_rwkv_fast(F, F.vcu); } }
#endif
        else if (F.vcu < 192) { scan_ret_mfma(F, F.vcu - 128); if (MK_REP & 64) { __syncthreads(); scan_ret_mfma(F, F.vcu - 128); } }
    } else {
        if (l + 1 < DEPTH) ph_convert(F, A, l + 1, F.vcu, F.G);
        const int gw = F.vcu * NWAVES + F.wave, NGW = F.G * NWAVES;
        const int stride = NGW >= 64 ? NGW / 64 : 1;
        if (gw % stride == 0) {
            for (int item = gw / stride; item < 64; item += (NGW + stride - 1) / stride) {
#if !MK_CHUNKED
                if (item < 32) scan_rwkv_naive(F, item); else
#endif
                scan_ret_naive(F, item < 32 ? item : item - 32);
            }
        }
    }
}
#if (MK_GLOBAL_GROUPS & 4)
#pragma pop_macro("WSP")
#pragma pop_macro("WSW")
#pragma pop_macro("OUTP")
#endif
#if (MK_GLOBAL_GROUPS & 8)
#pragma push_macro("WSP")
#pragma push_macro("WSW")
#pragma push_macro("OUTP")
#undef WSP
#undef WSW
#undef OUTP
#define WSP WSPG
#define WSW WSWG
#define OUTP OUTPG
#endif
template <int CTRL> __device__ __forceinline__ float dppx(float x) { return __builtin_bit_cast(float, __builtin_amdgcn_update_dpp(0, __builtin_bit_cast(int, x), CTRL, 0xF, 0xF, true)); }
__device__ __forceinline__ void ph_post(Frame& F, ArgP A, int l) {
    const int gw = F.vcu * NWAVES + F.wave, NGW = F.G * NWAVES, lane = F.lane, c0 = lane * 16;
    f32x4 gg[4], gb[4], lg[4], lb[4];
#pragma unroll
    for (int j = 0; j < 4; ++j) { gg[j] = *(const GAS f32x4*)(INP(A, 4) + (size_t)l * RETW + c0 + 4 * j); gb[j] = *(const GAS f32x4*)(INP(A, 5) + (size_t)l * RETW + c0 + 4 * j);
        lg[j] = *(const GAS f32x4*)(INP(A, 15) + (size_t)l * RWW + c0 + 4 * j); lb[j] = *(const GAS f32x4*)(INP(A, 16) + (size_t)l * RWW + c0 + 4 * j); }
    for (int m = gw; m < M; m += NGW) {
        {
            f32x4 y[4]; float s = 0.f;
#pragma unroll
            for (int j = 0; j < 4; ++j) { y[j] = *(const GAS f32x4*)(WSP(float, WS_YRAWR) + (size_t)m * RETW + c0 + 4 * j); s += (y[j].x + y[j].y) + (y[j].z + y[j].w); }
            const GAS bf16* zg = (const GAS bf16*)(WSP(bf16, WS_Z) + (size_t)m * INW + ZC_GR + c0);
            float g[16]; { float t[8]; unpack8(*(const GAS v4u*)zg, t);
#pragma unroll
                for (int j = 0; j < 8; ++j) g[j] = t[j]; unpack8(*(const GAS v4u*)(zg + 8), t);
#pragma unroll
                for (int j = 0; j < 8; ++j) g[8 + j] = t[j]; }
            s += dppx<0xB1>(s); s += dppx<0x4E>(s); s += dppx<0x141>(s);
            const float mean = s * (1.f / RD); float q = 0.f;
#pragma unroll
            for (int j = 0; j < 4; ++j) { y[j] = y[j] - mean; q += (y[j].x * y[j].x + y[j].y * y[j].y) + (y[j].z * y[j].z + y[j].w * y[j].w); }
            q += dppx<0xB1>(q); q += dppx<0x4E>(q); q += dppx<0x141>(q);
            const float rstd = __builtin_amdgcn_rsqf(q * (1.f / RD) + RET_GN_EPS);
            float o[16];
#pragma unroll
            for (int j = 0; j < 4; ++j)
#pragma unroll
                for (int k = 0; k < 4; ++k) { const float gr = g[4 * j + k]; o[4 * j + k] = (y[j][k] * rstd * gg[j][k] + gb[j][k]) * (gr * fsig(gr)); }
            GAS bf16* yo = (GAS bf16*)(WSP(bf16, WS_YRET) + (size_t)m * RETW + c0);
            { float t[8];
#pragma unroll
              for (int j = 0; j < 8; ++j) t[j] = o[j]; *(GAS bf16x8*)yo = pack8(t);
#pragma unroll
              for (int j = 0; j < 8; ++j) t[j] = o[8 + j]; *(GAS bf16x8*)(yo + 8) = pack8(t); }
        }
        {
            const size_t ob = (size_t)m * RWW + c0;
            f32x4 y[4]; float s = 0.f;
#pragma unroll
            for (int j = 0; j < 4; ++j) { y[j] = *(const GAS f32x4*)(WSP(float, WS_YRAWW) + ob + 4 * j); s += (y[j].x + y[j].y) + (y[j].z + y[j].w); }
            f32x4 vv[4], gt[4];
#pragma unroll
            for (int j = 0; j < 4; ++j) { vv[j] = *(const GAS f32x4*)(WSP(float, WS_SV) + ob + 4 * j); gt[j] = *(const GAS f32x4*)(WSP(float, WS_G) + ob + 4 * j); }
            const float bonus = *(const GAS float*)(WSP(float, WS_BONUS) + (size_t)m * WH + (lane >> 2));
            s += dppx<0xB1>(s); s += dppx<0x4E>(s);
            const float mean = s * (1.f / WD); float q = 0.f;
#pragma unroll
            for (int j = 0; j < 4; ++j) { y[j] = y[j] - mean; q += (y[j].x * y[j].x + y[j].y * y[j].y) + (y[j].z * y[j].z + y[j].w * y[j].w); }
            q += dppx<0xB1>(q); q += dppx<0x4E>(q);
            const float rstd = __builtin_amdgcn_rsqf(q * (1.f / WD) + RWKV_LN_EPS);
            float o[16];
#pragma unroll
            for (int j = 0; j < 4; ++j)
#pragma unroll
                for (int k = 0; k < 4; ++k) o[4 * j + k] = (y[j][k] * rstd * lg[j][k] + lb[j][k] + bonus * vv[j][k]) * gt[j][k];
            GAS bf16* yo = (GAS bf16*)(WSP(bf16, WS_YRWKV) + ob);
            { float t[8];
#pragma unroll
              for (int j = 0; j < 8; ++j) t[j] = o[j]; *(GAS bf16x8*)yo = pack8(t);
#pragma unroll
              for (int j = 0; j < 8; ++j) t[j] = o[8 + j]; *(GAS bf16x8*)(yo + 8) = pack8(t); }
        }
    }
}
__device__ __forceinline__ void ph_final(Frame& F, ArgP A) {
    const int gw = F.vcu * NWAVES + F.wave, NGW = F.G * NWAVES, lane = F.lane;
    const GAS f32x4* gr = (const GAS f32x4*)INP(A, 23) + lane;
    for (int m = gw; m < M; m += NGW) {
        GAS f32x4* xr = (GAS f32x4*)(OUTP + (size_t)m * D) + lane;
        f32x4 v[8]; float s = 0.f;
#pragma unroll
        for (int j = 0; j < 8; ++j) { v[j] = xr[64 * j]; s += (v[j].x * v[j].x + v[j].y * v[j].y) + (v[j].z * v[j].z + v[j].w * v[j].w); }
        const float rstd = 1.f / sqrtf(wave_sum(s) * (1.f / D) + NORM_EPS);
#pragma unroll
        for (int j = 0; j < 8; ++j) xr[64 * j] = v[j] * rstd * gr[64 * j];
    }
}
#if (MK_GLOBAL_GROUPS & 8)
#pragma pop_macro("WSP")
#pragma pop_macro("WSW")
#pragma pop_macro("OUTP")
#endif

__global__ void __launch_bounds__(NWAVES * 64, 2) hybrid_fwd(Args args) {
    extern __shared__ __attribute__((aligned(16))) unsigned char lds[];
    Frame F;
    F.lds = (LAS unsigned char*)lds;
    F.MISC = (volatile LAS unsigned*)(F.lds + MISC_OFF);
    F.tid = threadIdx.x; F.lane = F.tid & 63; F.wave = __builtin_amdgcn_readfirstlane(F.tid >> 6);
    int bx = blockIdx.x; F.G = gridDim.x; { F.vcu = (F.G % 8 == 0) ? (bx % 8) * (F.G / 8) + bx / 8 : bx; }
    F.ws = args.ws; F.out = args.out;
    for (int u = F.tid; u < (LDS_BYTES - LDSCTL_OFF) / 4; u += NWAVES * 64) ((LAS unsigned*)(F.lds + LDSCTL_OFF))[u] = 0u;
    __syncthreads();
    if (F.tid == 0) { volatile LAS unsigned* U = (volatile LAS unsigned*)(F.lds + MISC_OFF) + 16; const unsigned long long pw = (unsigned long long)args.ws, po = (unsigned long long)args.out, pa = (unsigned long long)__builtin_amdgcn_kernarg_segment_ptr();
        U[0] = (unsigned)pw; U[1] = (unsigned)(pw >> 32); U[2] = (unsigned)po; U[3] = (unsigned)(po >> 32); U[4] = (unsigned)pa; U[5] = (unsigned)(pa >> 32); U[6] = (unsigned)F.G; U[7] = (unsigned)F.vcu; U[8] = (unsigned)bx; }
    __syncthreads();
    XcdBarrier bar = xcd_barrier_post((unsigned*)(F.ws + WS_CTL) + CW_BAR, F.MISC + 8);

    ArgP ap = (ArgP)__builtin_amdgcn_kernarg_segment_ptr();
    const int lo = args.ph_lo, hi = args.ph_hi;
#define REPX(bit, body) do { body; if (MK_REP & (bit)) { __syncthreads(); body; } } while (0)
#define IN(k) (lo <= (k) && (k) < hi)
#define SEAM(k) do { if (IN(k) && IN((k) + 1)) xcd_barrier(bar); else __syncthreads(); } while (0)

    if (IN(PH_PRO)) { ph_prologue(F, ap); ph_convert(F, ap, 0, F.vcu, F.G); }
    SEAM(PH_PRO);
    for (int l = 0; l < DEPTH; ++l) {
        const int p0 = PH_L0 + l * PPL;
        RETID();
        { unsigned ba = MISC_OFF + 64; asm volatile("" : "+v"(ba));
          const volatile LAS v4u* U = (const volatile LAS v4u*)(F.lds + ba);
          const v4u ua = U[0], ub = U[1]; const unsigned uc = *(const volatile LAS unsigned*)(U + 2);
          const unsigned u0 = __builtin_amdgcn_readfirstlane(ua.x), u1 = __builtin_amdgcn_readfirstlane(ua.y), u2 = __builtin_amdgcn_readfirstlane(ua.z), u3 = __builtin_amdgcn_readfirstlane(ua.w);
          const unsigned u4 = __builtin_amdgcn_readfirstlane(ub.x), u5 = __builtin_amdgcn_readfirstlane(ub.y), u6 = __builtin_amdgcn_readfirstlane(ub.z), u7 = __builtin_amdgcn_readfirstlane(ub.w), u8 = __builtin_amdgcn_readfirstlane(uc);
          F.ws = (unsigned char*)(((unsigned long long)u1 << 32) | u0); F.out = (float*)(((unsigned long long)u3 << 32) | u2); ap = (ArgP)(((unsigned long long)u5 << 32) | u4);
          F.G = (int)u6; F.vcu = (int)u7; bx = (int)u8; F.wave = __builtin_amdgcn_readfirstlane(F.tid >> 6); }
        if (IN(p0 + LP_G1)) {
            pg8::Gemm g{WSPG(bf16, WS_H), WSWG(l, WO_WIN), M, INW, D}; pg8::StaticOrder S; S.init(M, INW, F.G, bx);
            pg8::EpiB<0> E{WSPG(bf16, WS_Z), INW, nullptr, 0, WSPG(float, WS_SS)};
            pg8::gemm_phase<pg8::EpiB<0>, pg8::StaticOrder, true, true>(F.lds + RING_OFF, g, S, E);
        }
        SEAM(p0 + LP_G1);
        if (IN(p0 + LP_PREP)) { RETID(); REPX(4, ph_prep(F, ap, l)); }
        SEAM(p0 + LP_PREP);
        if (IN(p0 + LP_SCAN)) { RETID(); REPX(8, ph_scan(F, ap, l)); }
        SEAM(p0 + LP_SCAN);
        if (IN(p0 + LP_POST)) { RETID(); REPX(16, ph_post(F, ap, l)); }
        SEAM(p0 + LP_POST);
        if (IN(p0 + LP_GA)) {
            pg8::Gemm g{WSPG(bf16, WS_YRET), WSWG(l, WO_WA), M, D, RETW}; pg8::StaticOrder S; S.init(M, D, F.G, bx);
            pg8::EpiB<2> E{WSPG(bf16, WS_MRG), D, WSPG(bf16, WS_Z) + ZC_GA, INW, nullptr};
            pg8::gemm_phase<pg8::EpiB<2>, pg8::StaticOrder, true, true>(F.lds + RING_OFF, g, S, E);
        }
        __syncthreads();
        if (IN(p0 + LP_GB)) {
            pg8::Gemm g{WSPG(bf16, WS_YRWKV), WSWG(l, WO_WB), M, D, RWW}; pg8::StaticOrder S; S.init(M, D, F.G, bx);
            pg8::EpiB<3> E{WSPG(bf16, WS_MRG), D, WSPG(bf16, WS_Z) + ZC_GB, INW, nullptr};
            pg8::gemm_phase<pg8::EpiB<3>, pg8::StaticOrder, true, true>(F.lds + RING_OFF, g, S, E);
        }
        SEAM(p0 + LP_GB);
        if (IN(p0 + LP_GO)) {
            pg8::Gemm g{WSPG(bf16, WS_MRG), WSWG(l, WO_WO), M, D, D}; pg8::StaticOrder S; S.init(M, D, F.G, bx);
            pg8::EpiResNorm E{OUTPG, D, WSPG(bf16, WS_H), WSPG(float, WS_SS)};
            pg8::gemm_phase<pg8::EpiResNorm, pg8::StaticOrder, true, true>(F.lds + RING_OFF, g, S, E);
        }
        SEAM(p0 + LP_GO);
        if (IN(p0 + LP_GUP)) {
            pg8::Gemm g{WSPG(bf16, WS_H), WSWG(l, WO_WUP), M, DFF, D}; pg8::StaticOrder S; S.init(M, DFF, F.G, bx);
            pg8::EpiB<1> E{WSPG(bf16, WS_UP), DFF, nullptr, 0, WSPG(float, WS_SS)};
            pg8::gemm_phase<pg8::EpiB<1>, pg8::StaticOrder, true, true>(F.lds + RING_OFF, g, S, E);
        }
        SEAM(p0 + LP_GUP);
        if (IN(p0 + LP_GDN)) {
            pg8::Gemm g{WSPG(bf16, WS_UP), WSWG(l, WO_WDN), M, D, DFF}; pg8::StaticOrder S; S.init(M, D, F.G, bx);
            pg8::EpiResNorm E{OUTPG, D, WSPG(bf16, WS_H), WSPG(float, WS_SS)};
            pg8::gemm_phase<pg8::EpiResNorm, pg8::StaticOrder, true, true>(F.lds + RING_OFF, g, S, E);
        }
        SEAM(p0 + LP_GDN);
    }
    if (IN(PH_FIN)) { RETID(); ph_final(F, ap); }
#undef IN
#undef SEAM
}

extern "C" void kernel_launch(void* const* d_in, const int* in_sizes, int n_in, void* d_out, int out_size, void* d_ws, size_t ws_size, hipStream_t stream) {
    static int grid = 0;
    if (grid == 0) {
        if (n_in != 24 || in_sizes[0] != M * D || out_size != M * D || ws_size < WS_END) { fprintf(stderr, "kernel_launch: built for 24 inputs, x and out of %d floats, >= %zu bytes of workspace; got n_in %d, in0 %d, out %d, ws %zu; nothing launched\n", M * D, (size_t)WS_END, n_in, n_in > 0 ? in_sizes[0] : -1, out_size, ws_size); grid = -1; return; }
        int dev = 0, cus = 0, per_cu = 0;
        if (hipGetDevice(&dev) != hipSuccess || hipDeviceGetAttribute(&cus, hipDeviceAttributeMultiprocessorCount, dev) != hipSuccess) { fprintf(stderr, "kernel_launch: hipGetDevice / hipDeviceGetAttribute failed; nothing launched\n"); grid = -1; return; }
        if (hipFuncSetAttribute((const void*)hybrid_fwd, hipFuncAttributeMaxDynamicSharedMemorySize, LDS_BYTES) != hipSuccess) { fprintf(stderr, "kernel_launch: hipFuncSetAttribute failed\n"); grid = -1; return; }
        if (hipOccupancyMaxActiveBlocksPerMultiprocessor(&per_cu, (const void*)hybrid_fwd, NWAVES * 64, LDS_BYTES) != hipSuccess || per_cu < 1)
            fprintf(stderr, "kernel_launch: note: the occupancy query reports %d workgroups per CU\n", per_cu);
        (void)hipGetLastError();
        grid = cus;
    }
    if (grid < 0) return;
    if (hipMemsetAsync((char*)d_ws + WS_CTL, 0, CTL_ZERO_BYTES, stream) != hipSuccess) { fprintf(stderr, "kernel_launch: hipMemsetAsync failed\n"); return; }
    Args a{};
    for (int i = 0; i < 24; ++i) a.in[i] = (const float*)d_in[i];
    a.out = (float*)d_out; a.ws = (unsigned char*)d_ws; a.li = 0; a.pad = 0;
#if MK_ONE_LAUNCH
    a.ph_lo = 0; a.ph_hi = NPH;
    hipLaunchKernelGGL(hybrid_fwd, dim3(grid), dim3(NWAVES * 64), LDS_BYTES, stream, a);
#else
    for (int p = 0; p < NPH; ++p) {
        a.ph_lo = p; a.ph_hi = p + 1;
        hipLaunchKernelGGL(hybrid_fwd, dim3(grid), dim3(NWAVES * 64), LDS_BYTES, stream, a);
    }
#endif
    const hipError_t le = hipPeekAtLastError();
    if (le != hipSuccess) fprintf(stderr, "kernel_launch: launch failed: %s\n", hipGetErrorName(le));
}
```

```cpp
#include <hip/hip_runtime.h>
#include <cstdio>
#include <cstdint>
#ifndef MK_GLOBAL_GROUPS
#define MK_GLOBAL_GROUPS 30
#endif
#ifndef MK_REP
#define MK_REP 0
#endif
namespace pg8 {
#define PG8_LAS __attribute__((address_space(3)))
typedef unsigned short bf16_t;
typedef short bf16x8 __attribute__((ext_vector_type(8)));
typedef float f32x4 __attribute__((ext_vector_type(4)));
typedef unsigned u32x4 __attribute__((ext_vector_type(4)));
constexpr int BM = 256, BK = 64, HALF = 128, HTB = HALF * BK * 2  , STAGE_BYTES = 8 * HTB, NXCD = 8, WGM = 8;

__host__ __device__ __forceinline__ int lds_byte(int r, int c) { const int st = (r >> 4) * 2 + (c >> 5), rr = r & 15, cc = c & 31, ob = rr * 64 + cc * 2; return st * 1024 + (ob ^ (((ob >> 9) & 1) << 5)); }
__host__ __device__ __forceinline__ void stage_rc(int b, int& R, int& C) { const int st = b / 1024, sb = b % 1024, swz = sb ^ (((sb >> 9) & 1) << 5); R = (st >> 1) * 16 + swz / 64; C = (st & 1) * 32 + (swz % 64) / 2; }
__host__ __device__ __forceinline__ int perm32(int rho) { const int n = rho >> 4, i = rho & 15; return 8 * (i >> 2) + 4 * n + (i & 3); }

struct Unit { int pm, pn; };
struct Gemm { const bf16_t* A; const bf16_t* Bt; int M, N, K; };

struct StaticOrder {
    int nM, nN, nwg, G, c;
    __host__ __device__ void init(int M, int N, int G_, int c_) { nM = M / BM; nN = N / BM; nwg = nM * nN; G = G_; c = c_; }
    __host__ __device__ bool next(int i, Unit& u) const {
        const long L = (long)i * G + c; if (L >= nwg) return false;
        int wgid = (int)L; { const int q = nwg / NXCD, r = nwg % NXCD, xcd = wgid % NXCD, off = wgid / NXCD; wgid = (xcd < r ? xcd * (q + 1) : r * (q + 1) + (xcd - r) * q) + off; }
        const int nig = WGM * nN, gid = wgid / nig, fm = gid * WGM, gsz = (nM - fm) < WGM ? (nM - fm) : WGM;
        u.pm = fm + ((wgid % nig) % gsz); u.pn = (wgid % nig) / gsz; return true;
    }
    __device__ __forceinline__ void a_ready(const Unit&) const {}
    __device__ __forceinline__ void done(const Unit&) const {}
};

typedef float f32x2c __attribute__((ext_vector_type(2))); typedef __bf16 bf16x2c __attribute__((ext_vector_type(2)));
__device__ __forceinline__ unsigned cvt_pk_bf16(float lo, float hi) { const f32x2c v = {lo, hi}; return __builtin_bit_cast(unsigned, __builtin_convertvector(v, bf16x2c)); }
typedef float f32x2 __attribute__((ext_vector_type(2)));
__device__ __forceinline__ float bf_lo(unsigned w) { return __builtin_bit_cast(float, w << 16); }
__device__ __forceinline__ float bf_hi(unsigned w) { return __builtin_bit_cast(float, w & 0xffff0000u); }
__device__ __forceinline__ float sigmoidf_(float x) { return 1.0f / (1.0f + __expf(-x)); }
template <int MODE> struct EpiB {
    static constexpr bool PERM = true, AFTER_DRAIN = false;
    bf16_t* O; int ldc; const bf16_t* gate; int ldg; const float* ss;
    __device__ __forceinline__ void operator()(const f32x4 (&acc)[2][2][4][2], const Unit& u, int wr, int wc, int fr, int fq) const {
        const int row0 = u.pm * BM + wr * 64 + fr, col0 = u.pn * BM + wc * 32 + 8 * fq;
        float rs[2][4];
        for (int rep_ = 0; rep_ < ((MK_REP & 128) ? 2 : 1); ++rep_) { asm volatile("" ::: "memory");
        if (MODE <= 1) {
            typedef __attribute__((address_space(1))) const f32x4 gf4;
            f32x4 q[2][4][2];
#pragma unroll
            for (int ai = 0; ai < 2; ++ai)
#pragma unroll
                for (int m = 0; m < 4; ++m) { gf4* sp = (gf4*)(ss + (size_t)(row0 + ai * HALF + m * 16) * 32) + fq * 2; q[ai][m][0] = sp[0]; q[ai][m][1] = sp[1]; }
#pragma unroll
            for (int ai = 0; ai < 2; ++ai)
#pragma unroll
                for (int m = 0; m < 4; ++m) { const f32x4 a = q[ai][m][0] + q[ai][m][1]; rs[ai][m] = (a[0] + a[1]) + (a[2] + a[3]); }
#pragma unroll
            for (int ai = 0; ai < 2; ++ai)
#pragma unroll
                for (int m = 0; m < 4; ++m) rs[ai][m] += __shfl_xor(rs[ai][m], 16);
#pragma unroll
            for (int ai = 0; ai < 2; ++ai)
#pragma unroll
                for (int m = 0; m < 4; ++m) { rs[ai][m] += __shfl_xor(rs[ai][m], 32); rs[ai][m] = __builtin_amdgcn_rsqf(rs[ai][m] * (1.0f / 2048.0f) + 1e-6f); }
        }
        if (MK_REP & 128) asm volatile("" : "+v"(rs[0][0]), "+v"(rs[1][3]) :: "memory"); }
#pragma unroll
        for (int ai = 0; ai < 2; ++ai)
#pragma unroll
            for (int m = 0; m < 4; ++m) { const size_t row = (size_t)(row0 + ai * HALF + m * 16);
#pragma unroll
                for (int bj = 0; bj < 2; ++bj) { f32x4 v0 = acc[ai][bj][m][0], v1 = acc[ai][bj][m][1]; const int c = col0 + bj * HALF;
                    if (MODE <= 1) { v0 = v0 * rs[ai][m]; v1 = v1 * rs[ai][m]; }
                    if (MODE == 1) {
#pragma unroll
                        for (int j = 0; j < 4; ++j) { const float a = fmaxf(v0[j], 0.f), b = fmaxf(v1[j], 0.f); v0[j] = a * a; v1[j] = b * b; } }
                    if (MODE >= 2) { const u32x4 g = *(const u32x4*)(gate + row * ldg + c);
                        v0[0] *= sigmoidf_(bf_lo(g.x)); v0[1] *= sigmoidf_(bf_hi(g.x)); v0[2] *= sigmoidf_(bf_lo(g.y)); v0[3] *= sigmoidf_(bf_hi(g.y));
                        v1[0] *= sigmoidf_(bf_lo(g.z)); v1[1] *= sigmoidf_(bf_hi(g.z)); v1[2] *= sigmoidf_(bf_lo(g.w)); v1[3] *= sigmoidf_(bf_hi(g.w)); }
                    if (MODE == 3) { const u32x4 o = *(const u32x4*)(O + row * ldc + c);
                        v0[0] += bf_lo(o.x); v0[1] += bf_hi(o.x); v0[2] += bf_lo(o.y); v0[3] += bf_hi(o.y);
                        v1[0] += bf_lo(o.z); v1[1] += bf_hi(o.z); v1[2] += bf_lo(o.w); v1[3] += bf_hi(o.w); }
                    u32x4 w; w.x = cvt_pk_bf16(v0[0], v0[1]); w.y = cvt_pk_bf16(v0[2], v0[3]); w.z = cvt_pk_bf16(v1[0], v1[1]); w.w = cvt_pk_bf16(v1[2], v1[3]);
                    *(u32x4*)(O + row * ldc + c) = w; } }
    }
};
struct EpiResNorm {
    static constexpr bool PERM = true, AFTER_DRAIN = false;
    float* X; int ldc; bf16_t* XB; float* SS;
    __device__ __forceinline__ void operator()(const f32x4 (&acc)[2][2][4][2], const Unit& u, int wr, int wc, int fr, int fq) const {
        const int row0 = u.pm * BM + wr * 64 + fr, col0 = u.pn * BM + wc * 32 + 8 * fq;
#pragma unroll
        for (int ai = 0; ai < 2; ++ai)
#pragma unroll
            for (int m = 0; m < 4; ++m) { const size_t row = (size_t)(row0 + ai * HALF + m * 16);
                float s = 0.f;
#pragma unroll
                for (int bj = 0; bj < 2; ++bj) { const int c = col0 + bj * HALF; float* p = X + row * ldc + c;
                    const f32x4 x0 = *(const f32x4*)p + acc[ai][bj][m][0], x1 = *(const f32x4*)(p + 4) + acc[ai][bj][m][1];
                    *(f32x4*)p = x0; *(f32x4*)(p + 4) = x1;
                    u32x4 w; w.x = cvt_pk_bf16(x0[0], x0[1]); w.y = cvt_pk_bf16(x0[2], x0[3]); w.z = cvt_pk_bf16(x1[0], x1[1]); w.w = cvt_pk_bf16(x1[2], x1[3]);
                    *(u32x4*)(XB + row * ldc + c) = w;
                    s += ((x0[0] * x0[0] + x0[1] * x0[1]) + (x0[2] * x0[2] + x0[3] * x0[3])) + ((x1[0] * x1[0] + x1[1] * x1[1]) + (x1[2] * x1[2] + x1[3] * x1[3])); }
                s += __shfl_xor(s, 16); s += __shfl_xor(s, 32);
                if (fq == 0) SS[row * 32 + u.pn * 4 + wc] = s; }
    }
};

template <class Epi, class Sched, bool ALIGN_EPI = false, bool SP2 = false>
__device__ __forceinline__ void gemm_phase(PG8_LAS unsigned char* lds, const Gemm g, const Sched& S, const Epi& E) {
    int tid_ = threadIdx.x; asm volatile("" : "+v"(tid_));
    const int tid = tid_, wid = __builtin_amdgcn_readfirstlane(tid >> 6), lane = tid & 63, wr = wid >> 2, wc = wid & 3, fr = lane & 15, fq = lane >> 4;
    const int K = g.K, nt = K / BK;
    unsigned voffA[2], voffB[2];
#pragma unroll
    for (int i = 0; i < 2; ++i) { int R, C; stage_rc(tid * 16 + i * 8192, R, C); const int Rb = Epi::PERM ? ((R & ~31) + perm32(R & 31)) : R;
        voffA[i] = (unsigned)(R * K + C) * 2u; voffB[i] = (unsigned)(Rb * K + C) * 2u; }
    const size_t kstep = (size_t)(BK * 2);
    const size_t hstep = (size_t)HALF * K * 2;
    const size_t tstep = 2 * hstep;
    const unsigned ldsw = (unsigned)wid * 1024u;
    const int aoff = lds_byte(wr * 64 + fr, fq * 8), boff = lds_byte(wc * 32 + fr, fq * 8);
#define PG8_SA(b, h) (((b) * 2 + (h)) * HTB)
#define PG8_SB(b, h) ((4 + (b) * 2 + (h)) * HTB)
#define PG8_STAGE(bufoff, gbase, voff) do { _Pragma("unroll") for (int _i = 0; _i < 2; ++_i) \
        __builtin_amdgcn_global_load_lds((const unsigned*)((const char*)(gbase) + (voff)[_i]), (PG8_LAS unsigned*)(lds + (bufoff) + ldsw + _i * 8192), 16, 0, 0); } while (0)
#define PG8_LDA(dst, b, h) do { _Pragma("unroll") for (int m = 0; m < 4; ++m) _Pragma("unroll") for (int k = 0; k < 2; ++k) dst[m][k] = *(const PG8_LAS bf16x8*)(lds + PG8_SA(b, h) + aoff + m * 2048 + k * 1024); } while (0)
#define PG8_LDB(dst, b, h) do { _Pragma("unroll") for (int n = 0; n < 2; ++n) _Pragma("unroll") for (int k = 0; k < 2; ++k) dst[n][k] = *(const PG8_LAS bf16x8*)(lds + PG8_SB(b, h) + boff + n * 2048 + k * 1024); } while (0)
#define PG8_MMA(ai, bj, At, Bt) do { __builtin_amdgcn_s_setprio(1); _Pragma("unroll") for (int m = 0; m < 4; ++m) _Pragma("unroll") for (int n = 0; n < 2; ++n) _Pragma("unroll") for (int k = 0; k < 2; ++k) \
        acc[ai][bj][m][n] = __builtin_amdgcn_mfma_f32_16x16x32_bf16(Bt[n][k], At[m][k], acc[ai][bj][m][n], 0, 0, 0); __builtin_amdgcn_s_setprio(0); } while (0)
#define PG8_WAIT_V(n) asm volatile("s_waitcnt vmcnt(" #n ")" ::: "memory")
#define PG8_WAIT_L(n) asm volatile("s_waitcnt lgkmcnt(" #n ")" ::: "memory")
#define PG8_BAR __builtin_amdgcn_s_barrier()
#define PG8_SCHED __builtin_amdgcn_sched_barrier(0)
    Unit cur, nxt; int ui = 0;
    if (!S.next(0, cur)) return;
    f32x4 acc[2][2][4][2];
#pragma unroll
    for (int a = 0; a < 2; ++a)
#pragma unroll
        for (int b = 0; b < 2; ++b)
#pragma unroll
            for (int m = 0; m < 4; ++m)
#pragma unroll
                for (int n = 0; n < 2; ++n) acc[a][b][m][n] = (f32x4){0.f, 0.f, 0.f, 0.f};
    bf16x8 At[4][2], B0[2][2], B1[2][2];
    const char* cA = (const char*)g.A + (size_t)cur.pm * tstep; const char* cB = (const char*)g.Bt + (size_t)cur.pn * tstep;
    S.a_ready(cur);
    if constexpr (SP2) {
        PG8_STAGE(PG8_SB(0, 0), cB, voffB); PG8_STAGE(PG8_SB(0, 1), cB + hstep, voffB); PG8_STAGE(PG8_SA(0, 0), cA, voffA); PG8_STAGE(PG8_SA(0, 1), cA + hstep, voffA);
        if (wr == 1) PG8_BAR;
        PG8_WAIT_V(2); PG8_BAR;
        PG8_STAGE(PG8_SB(1, 0), cB + kstep, voffB); PG8_STAGE(PG8_SA(1, 0), cA + kstep, voffA); PG8_STAGE(PG8_SB(1, 1), cB + hstep + kstep, voffB);
        PG8_WAIT_V(6); PG8_BAR;
    } else {
        PG8_STAGE(PG8_SB(0, 0), cB, voffB); PG8_STAGE(PG8_SA(0, 0), cA, voffA); PG8_STAGE(PG8_SB(0, 1), cB + hstep, voffB); PG8_STAGE(PG8_SA(0, 1), cA + hstep, voffA);
        if (wr == 1) PG8_BAR;
        PG8_WAIT_V(4); PG8_BAR;
        PG8_STAGE(PG8_SB(1, 0), cB + kstep, voffB); PG8_STAGE(PG8_SA(1, 0), cA + kstep, voffA); PG8_STAGE(PG8_SB(1, 1), cB + hstep + kstep, voffB);
        PG8_WAIT_V(6); PG8_BAR;
    }
    for (;;) {
        const bool has_next = S.next(ui + 1, nxt);
        const char* nA = has_next ? (const char*)g.A + (size_t)nxt.pm * tstep : cA; const char* nB = has_next ? (const char*)g.Bt + (size_t)nxt.pn * tstep : cB;
        for (int t = 0; t < nt; t += 2) {
            const bool last = (t == nt - 2);
            const char* a1 = cA + (size_t)(t + 1) * kstep;
            const char* a2 = last ? nA : cA + (size_t)(t + 2) * kstep; const char* b2 = last ? nB : cB + (size_t)(t + 2) * kstep;
            const char* a3 = a2 + kstep; const char* b3 = b2 + kstep;
            if (last && has_next) S.a_ready(nxt);
            if constexpr (SP2) {
            PG8_LDB(B0, 0, 0); PG8_LDB(B1, 0, 1); PG8_SCHED; PG8_LDA(At, 0, 0); PG8_STAGE(PG8_SA(1, 1), a1 + hstep, voffA);
            PG8_WAIT_V(8); PG8_WAIT_L(0); PG8_BAR; PG8_MMA(0, 0, At, B0); PG8_MMA(0, 1, At, B1); PG8_BAR; PG8_SCHED;
            PG8_LDA(At, 0, 1); PG8_STAGE(PG8_SB(0, 0), b2, voffB); PG8_STAGE(PG8_SB(0, 1), b2 + hstep, voffB); PG8_STAGE(PG8_SA(0, 0), a2, voffA);
            PG8_WAIT_V(8); PG8_WAIT_L(0); PG8_BAR; PG8_MMA(1, 0, At, B0); PG8_MMA(1, 1, At, B1); PG8_BAR; PG8_SCHED;
            PG8_LDB(B0, 1, 0); PG8_LDB(B1, 1, 1); PG8_SCHED; PG8_LDA(At, 1, 0); PG8_STAGE(PG8_SA(0, 1), a2 + hstep, voffA);
            PG8_WAIT_V(8); PG8_WAIT_L(0); PG8_BAR; PG8_MMA(0, 0, At, B0); PG8_MMA(0, 1, At, B1); PG8_BAR; PG8_SCHED;
            PG8_LDA(At, 1, 1); PG8_STAGE(PG8_SB(1, 0), b3, voffB); PG8_STAGE(PG8_SB(1, 1), b3 + hstep, voffB); PG8_STAGE(PG8_SA(1, 0), a3, voffA);
            PG8_WAIT_V(8); PG8_WAIT_L(0); PG8_BAR; PG8_MMA(1, 0, At, B0); PG8_MMA(1, 1, At, B1); PG8_BAR; PG8_SCHED;
            } else {
            PG8_LDB(B0, 0, 0); PG8_SCHED; PG8_LDA(At, 0, 0); PG8_STAGE(PG8_SA(1, 1), a1 + hstep, voffA);
            PG8_WAIT_L(8); PG8_BAR; PG8_WAIT_L(0); PG8_MMA(0, 0, At, B0); PG8_BAR; PG8_SCHED;
            PG8_LDB(B1, 0, 1); PG8_STAGE(PG8_SB(0, 0), b2, voffB);
            PG8_BAR; PG8_WAIT_L(0); PG8_MMA(0, 1, At, B1); PG8_BAR;
            PG8_LDA(At, 0, 1); PG8_STAGE(PG8_SA(0, 0), a2, voffA);
            PG8_BAR; PG8_WAIT_L(0); PG8_MMA(1, 0, At, B0); PG8_BAR; PG8_SCHED;
            PG8_STAGE(PG8_SB(0, 1), b2 + hstep, voffB);
            PG8_WAIT_V(6); PG8_BAR; PG8_MMA(1, 1, At, B1); PG8_BAR;
            PG8_LDB(B0, 1, 0); PG8_SCHED; PG8_LDA(At, 1, 0); PG8_STAGE(PG8_SA(0, 1), a2 + hstep, voffA);
            PG8_WAIT_L(8); PG8_BAR; PG8_WAIT_L(0); PG8_MMA(0, 0, At, B0); PG8_BAR; PG8_SCHED;
            PG8_LDB(B1, 1, 1); PG8_STAGE(PG8_SB(1, 0), b3, voffB);
            PG8_BAR; PG8_WAIT_L(0); PG8_MMA(0, 1, At, B1); PG8_BAR;
            PG8_LDA(At, 1, 1); PG8_STAGE(PG8_SA(1, 0), a3, voffA);
            PG8_BAR; PG8_WAIT_L(0); PG8_MMA(1, 0, At, B0); PG8_BAR; PG8_SCHED;
            PG8_STAGE(PG8_SB(1, 1), b3 + hstep, voffB);
            PG8_WAIT_V(6); PG8_BAR; PG8_MMA(1, 1, At, B1); PG8_BAR;
            }
        }
        if constexpr (ALIGN_EPI) { if (wr == 0) PG8_BAR; }
        if constexpr (!Epi::AFTER_DRAIN) { E(acc, cur, wr, wc, fr, fq); S.done(cur); }
        if (!has_next) break;
#pragma unroll
        for (int a = 0; a < 2; ++a)
#pragma unroll
            for (int b = 0; b < 2; ++b)
#pragma unroll
                for (int m = 0; m < 4; ++m)
#pragma unroll
                    for (int n = 0; n < 2; ++n) acc[a][b][m][n] = (f32x4){0.f, 0.f, 0.f, 0.f};
        cur = nxt; cA = nA; cB = nB; ++ui;
        if constexpr (ALIGN_EPI) { if (wr == 1) PG8_BAR; }
    }
    PG8_WAIT_V(0);
    if constexpr (!ALIGN_EPI) { if (wr == 0) PG8_BAR; }
    PG8_BAR;
    if constexpr (Epi::AFTER_DRAIN) { E.fused(acc, cur, wr, wc, fr, fq, lds, wid, lane); S.done(cur); }
#undef PG8_SA
#undef PG8_SB
#undef PG8_STAGE
#undef PG8_LDA
#undef PG8_LDB
#undef PG8_MMA
#undef PG8_WAIT_V
#undef PG8_WAIT_L
#undef PG8_BAR
#undef PG8_SCHED
}
}
constexpr int NWAVES = 8;
#ifndef MK_ONE_LAUNCH
#define MK_ONE_LAUNCH 1
#endif

#ifndef MK_GLOBAL_GROUPS
#define MK_GLOBAL_GROUPS 30
#endif
#ifndef MK_CHUNKED
#define MK_CHUNKED 1
#endif
#ifndef MK_REP
#define MK_REP 0
#endif

constexpr int BATCH = 2, SEQ = 8192, D = 2048, DEPTH = 4, M = BATCH * SEQ;
constexpr int RETW = 1024, RH = 8, RD = 128, RWW = 1024, WH = 16, WD = 64;
constexpr int INW = 11520, DFF = 8192, RWSHIFT = 3328;
constexpr int ZC_Q = 0, ZC_K = 1024, ZC_V = 2048, ZC_GR = 3072, ZC_RW = 4096, ZC_GA = 7424, ZC_GB = 9472;
constexpr int RWC_R = 0, RWC_K = 1024, RWC_V = 2048, RWC_W = 3072, RWC_A = 3136, RWC_G = 3200;
constexpr float NORM_EPS = 1e-6f, RET_GN_EPS = 1e-5f, RWKV_LN_EPS = 64e-5f;

constexpr size_t MiB = 1u << 20;
constexpr size_t WS_CTL = 0, CTL_ZERO_BYTES = 1 * MiB;
constexpr size_t WS_ROPE = 1 * MiB;
constexpr size_t WS_WSET = 16 * MiB, WSET_BYTES = 126 * MiB;
constexpr size_t WO_WIN = 0, WO_WA = 45 * MiB, WO_WB = 49 * MiB, WO_WO = 53 * MiB, WO_WUP = 61 * MiB, WO_WDN = 93 * MiB, WO_LORA = 125 * MiB;
constexpr size_t WS_H = 272 * MiB;
constexpr size_t WS_Z = 336 * MiB;
constexpr size_t WS_UP = WS_Z;
constexpr size_t WS_QR = 696 * MiB, WS_KR = 728 * MiB;
constexpr size_t WS_YRET = 760 * MiB, WS_YRWKV = 792 * MiB;
constexpr size_t WS_MRG = 824 * MiB;
#if MK_CHUNKED
constexpr size_t WS_SR = 888 * MiB, WS_SV = 1208 * MiB;
#else
constexpr size_t WS_SR = 888 * MiB, WS_SW = 952 * MiB, WS_SK = 1016 * MiB, WS_SV = 1080 * MiB, WS_SNKK = 1144 * MiB, WS_SKKA = 1208 * MiB;
#endif
constexpr size_t WS_CU = WS_SR;
constexpr size_t WS_G = 1272 * MiB;
constexpr size_t WS_BONUS = 1336 * MiB;
constexpr size_t WS_SS = 1337 * MiB;
constexpr size_t WS_YRAWR = WS_H, WS_YRAWW = WS_MRG;
constexpr size_t WS_END = 1341 * MiB;
constexpr int CW_BAR = 4096;

constexpr int PPL = 9;
enum { LP_G1 = 0, LP_PREP, LP_SCAN, LP_POST, LP_GA, LP_GB, LP_GO, LP_GUP, LP_GDN };
constexpr int PH_PRO = 0, PH_L0 = 1, PH_FIN = PH_L0 + DEPTH * PPL, NPH = PH_FIN + 1;

constexpr int RING_OFF = 0, RING_BYTES = 131072;
constexpr int LDSCTL_OFF = RING_BYTES, MISC_OFF = LDSCTL_OFF + 320;
constexpr int LDS_BYTES = 147456;
static_assert(MISC_OFF + 128 <= LDS_BYTES, "LDS map");

#define GAS __attribute__((address_space(1)))
#define LAS __attribute__((address_space(3)))
typedef unsigned short bf16;
typedef unsigned v4u __attribute__((ext_vector_type(4)));
typedef unsigned v2u __attribute__((ext_vector_type(2)));
typedef float f32x4 __attribute__((ext_vector_type(4)));
typedef float f32x2 __attribute__((ext_vector_type(2)));
typedef short bf16x8 __attribute__((ext_vector_type(8)));
typedef GAS unsigned gu32;
#define LDS_WAIT() asm volatile("s_waitcnt lgkmcnt(0)" ::: "memory")
#define VM_WAIT() asm volatile("s_waitcnt vmcnt(0)" ::: "memory")
__device__ __forceinline__ unsigned f2bf(float f) { unsigned u = __builtin_bit_cast(unsigned, f); return (u + 0x7fffu + ((u >> 16) & 1u)) >> 16; }
__device__ __forceinline__ unsigned pk2(float lo, float hi) { return f2bf(lo) | (f2bf(hi) << 16); }
__device__ __forceinline__ float bf2f(bf16 v) { return __builtin_bit_cast(float, (unsigned)v << 16); }
__device__ __forceinline__ float rdlane(float v, int l) { return __builtin_bit_cast(float, __builtin_amdgcn_readlane(__builtin_bit_cast(int, v), l)); }
__device__ __forceinline__ float sigm(float x) { return 1.0f / (1.0f + expf(-x)); }

__device__ const double ROPE_REV[64] = {
0.15915494309189535, 0.13782250260398285, 0.11934937021124886, 0.10335229661843406,
0.08949940160889101, 0.07750328875537406, 0.06711508300522726, 0.058119267441876246,
0.050329212104487035, 0.04358330210530733, 0.03774158471741977, 0.032682865872357,
0.0283021958306234, 0.024508691862069852, 0.02122365276477766, 0.018378926105679667,
0.015915494309189534, 0.013782250260398284, 0.011934937021124886, 0.010335229661843406,
0.008949940160889102, 0.0077503288755374055, 0.006711508300522725, 0.005811926744187624,
0.005032921210448704, 0.004358330210530733, 0.003774158471741977, 0.0032682865872356993,
0.00283021958306234, 0.002450869186206985, 0.0021223652764777662, 0.0018378926105679667,
0.0015915494309189536, 0.0013782250260398288, 0.0011934937021124885, 0.0010335229661843405,
0.0008949940160889102, 0.0007750328875537405, 0.0006711508300522726, 0.0005811926744187624,
0.0005032921210448703, 0.0004358330210530733, 0.00037741584717419774, 0.0003268286587235699,
0.00028302195830623395, 0.00024508691862069854, 0.0002122365276477766, 0.00018378926105679666,
0.00015915494309189535, 0.00013782250260398286, 0.00011934937021124886, 0.00010335229661843406,
8.949940160889102e-05, 7.750328875537406e-05, 6.711508300522725e-05, 5.811926744187624e-05,
5.0329212104487035e-05, 4.358330210530732e-05, 3.774158471741978e-05, 3.2682865872357e-05,
2.8302195830623396e-05, 2.4508691862069852e-05, 2.122365276477766e-05, 1.8378926105679668e-05 };

#define XB_TMO      128
#define XB_XCNT(j)  (256  + 64 * (j))
#define XB_XSUB(j)  (1280 + 64 * (j))
#define XB_XGEN(j)  (2304 + 64 * (j))
#define XB_TOP      3328
#define XB_TOPGEN   3392
#define XCD_BAR_WORDS 3456
#define XB_SPIN_CAP (1u << 18)

__device__ __forceinline__ unsigned xb_ld(unsigned* p)              { return __hip_atomic_load(p, __ATOMIC_RELAXED, __HIP_MEMORY_SCOPE_AGENT); }
__device__ __forceinline__ unsigned xb_add(unsigned* p, unsigned v) { return __hip_atomic_fetch_add(p, v, __ATOMIC_RELAXED, __HIP_MEMORY_SCOPE_AGENT); }
__device__ __forceinline__ unsigned xb_xcc_id() { return (unsigned)__builtin_amdgcn_s_getreg((3 << 11) | 20) & 0xFu; }
#define XB_SPIN(cond, bar) do { unsigned _sp = 0; while (cond) { __builtin_amdgcn_s_sleep(1); \
    if ((++_sp & 255u) == 0u) { if (xb_ld(&(bar)[XB_TMO])) break; if (_sp > XB_SPIN_CAP) { atomicAdd(&(bar)[XB_TMO], 1u); break; } } } } while (0)

struct XcdBarrier {
    unsigned* bar; unsigned x;
    volatile LAS unsigned* st;
};

__device__ __forceinline__ XcdBarrier xcd_barrier_post(unsigned* bar, volatile LAS unsigned* st) {
    XcdBarrier b; b.bar = bar; b.x = xb_xcc_id(); b.st = st;
    if (threadIdx.x == 0) (void)xb_add(&bar[XB_XCNT(b.x)], 1u);
    return b;
}
__device__ __forceinline__ void xcd_barrier_complete(unsigned* bar, unsigned x, unsigned& nloc, unsigned& nx) {
    const unsigned G = gridDim.x * gridDim.y * gridDim.z;
    unsigned sum, cnt, mine, sp = 0u;
    for (;;) {
        sum = 0u; cnt = 0u; mine = 0u;
#pragma unroll
        for (unsigned j = 0; j < 16; ++j) { const unsigned c = xb_ld(&bar[XB_XCNT(j)]); sum += c; cnt += (c > 0u) ? 1u : 0u; mine = (j == x) ? c : mine; }
        if (sum == G) break;
        __builtin_amdgcn_s_sleep(1);
        if ((++sp & 255u) == 0u) { if (xb_ld(&bar[XB_TMO])) break; if (sp > XB_SPIN_CAP) { atomicAdd(&bar[XB_TMO], 1u); break; } }
    }
    nloc = mine > 0u ? mine : 1u; nx = cnt > 0u ? cnt : 1u;
}

__device__ __forceinline__ void xcd_barrier(const XcdBarrier& b) {
    asm volatile("s_waitcnt vmcnt(0)" ::: "memory");
    __syncthreads();
    if (threadIdx.x == 0) {
        unsigned* bar = b.bar;
        __builtin_amdgcn_s_waitcnt(0);
        unsigned nloc = b.st[0], nx = b.st[1];
        if (nloc == 0u) { xcd_barrier_complete(bar, b.x, nloc, nx); b.st[0] = nloc; b.st[1] = nx; }
        const unsigned old = xb_add(&bar[XB_XSUB(b.x)], 1u);
        const unsigned gen = old / nloc;
        if (old + 1u == (gen + 1u) * nloc) {
            __builtin_amdgcn_fence(__ATOMIC_RELEASE, "agent");
            asm volatile("s_waitcnt vmcnt(0)" ::: "memory");
            const unsigned og = xb_add(&bar[XB_TOP], 1u);
            const unsigned tg = og / nx;
            if (og + 1u == (tg + 1u) * nx) xb_add(&bar[XB_TOPGEN], 1u);
            else XB_SPIN(xb_ld(&bar[XB_TOPGEN]) == tg, bar);
            __builtin_amdgcn_fence(__ATOMIC_ACQUIRE, "agent");
            xb_add(&bar[XB_XGEN(b.x)], 1u);
            asm volatile("s_waitcnt vmcnt(0)" ::: "memory");
        } else {
            XB_SPIN(xb_ld(&bar[XB_XGEN(b.x)]) == gen, bar);
            __builtin_amdgcn_fence(__ATOMIC_ACQUIRE, "agent");
            asm volatile("s_waitcnt vmcnt(0)" ::: "memory");
        }
    }
    __syncthreads();
}


struct Frame {
    LAS unsigned char* lds;
    volatile LAS unsigned* MISC;
    int tid, lane, wave;
    int vcu, G;
    float* out; unsigned char* ws;
};
struct Args { const float* in[24]; float* out; unsigned char* ws; int ph_lo, ph_hi, li, pad; };
#define WSP(T, off) ((T*)(F.ws + (off)))
#define WSPG(T, off) ((T*)(GAS T*)(unsigned long long)(F.ws + (off)))
#define WSW(l, off) ((bf16*)(F.ws + WS_WSET + (size_t)((l) & 1) * WSET_BYTES + (off)))
#define WSWG(l, off) ((bf16*)(GAS bf16*)(unsigned long long)(F.ws + WS_WSET + (size_t)((l) & 1) * WSET_BYTES + (off)))
#define OUTP ((float*)F.out)
#define OUTPG ((float*)(GAS float*)(unsigned long long)F.out)
#define INP(A, i) ((const float*)((const GAS float*)(A)->in[i]))
#define RETID() do { int t_ = threadIdx.x; asm volatile("" : "+v"(t_)); F.tid = t_; F.lane = t_ & 63; } while (0)
#define CAS __attribute__((address_space(4)))
typedef const CAS Args* ArgP;

__device__ __forceinline__ float fexp(float x) { return __builtin_amdgcn_exp2f(x * 1.4426950408889634f); }
__device__ __forceinline__ float fsig(float x) { return __builtin_amdgcn_rcpf(1.0f + fexp(-x)); }
__device__ __forceinline__ float ftanh(float x) { return 1.0f - 2.0f * __builtin_amdgcn_rcpf(1.0f + fexp(2.0f * x)); }
__device__ __forceinline__ float wave_sum(float v) {
#pragma unroll
    for (int o = 1; o < 64; o <<= 1) v += __shfl_xor(v, o);
    return v;
}
struct TItem { const float* W; bf16* WT; const float* gk; int K, N, item; };
__device__ __forceinline__ void titem_load(const TItem& t, int lane, f32x4 (&v)[8]) {
    const int nblk = t.N / 32, kb = t.item / nblk, nb = t.item % nblk, k0 = 64 * kb, n0 = 32 * nb, nq = lane & 7, kr = lane >> 3;
#pragma unroll
    for (int i = 0; i < 8; ++i) v[i] = *(const GAS f32x4*)(t.W + (size_t)(k0 + kr + 8 * i) * t.N + n0 + 4 * nq);
}
__device__ __forceinline__ void titem_finish(const TItem& t, int lane, const f32x4 (&v)[8], LAS float* scr) {
    const int nblk = t.N / 32, kb = t.item / nblk, nb = t.item % nblk, k0 = 64 * kb, n0 = 32 * nb, nq = lane & 7, kr = lane >> 3;
#pragma unroll
    for (int i = 0; i < 8; ++i)
#pragma unroll
        for (int e = 0; e < 4; ++e) scr[(kr + 8 * i) * 33 + 4 * nq + e] = v[i][e];
    const int c = lane & 7;
    f32x4 g0 = (f32x4){1.f, 1.f, 1.f, 1.f}, g1 = g0;
    if (t.gk) { g0 = *(const GAS f32x4*)(t.gk + k0 + 8 * c); g1 = *(const GAS f32x4*)(t.gk + k0 + 8 * c + 4); }
    LDS_WAIT(); asm volatile("" ::: "memory");
#pragma unroll
    for (int j = 0; j < 4; ++j) { const int n = (lane >> 3) + 8 * j; const LAS float* s = scr + (8 * c) * 33 + n;
        v4u o; o.x = pk2(s[0 * 33] * g0.x, s[1 * 33] * g0.y); o.y = pk2(s[2 * 33] * g0.z, s[3 * 33] * g0.w); o.z = pk2(s[4 * 33] * g1.x, s[5 * 33] * g1.y); o.w = pk2(s[6 * 33] * g1.z, s[7 * 33] * g1.w);
        *(GAS v4u*)(t.WT + (size_t)(n0 + n) * t.K + k0 + 8 * c) = o; }
    LDS_WAIT(); asm volatile("" ::: "memory");
}
__device__ __forceinline__ void rms_row_to_bf16(const float* xrow, const float* g, bf16* orow, int lane) {
    const GAS f32x4* xr = (const GAS f32x4*)xrow + lane;
    f32x4 v[8]; float s = 0.f;
#pragma unroll
    for (int j = 0; j < 8; ++j) { v[j] = xr[64 * j]; s += (v[j].x * v[j].x + v[j].y * v[j].y) + (v[j].z * v[j].z + v[j].w * v[j].w); }
    const float rstd = 1.f / sqrtf(wave_sum(s) * (1.f / D) + NORM_EPS);
    const GAS f32x4* gr = (const GAS f32x4*)g + lane;
    GAS v2u* o8 = (GAS v2u*)orow + lane;
#pragma unroll
    for (int j = 0; j < 8; ++j) { const f32x4 gg = gr[64 * j]; v2u o; o.x = pk2(v[j].x * rstd * gg.x, v[j].y * rstd * gg.y); o.y = pk2(v[j].z * rstd * gg.z, v[j].w * rstd * gg.w); o8[64 * j] = o; }
}

#if (MK_GLOBAL_GROUPS & 1)
#pragma push_macro("WSP")
#pragma push_macro("WSW")
#pragma push_macro("OUTP")
#undef WSP
#undef WSW
#undef OUTP
#define WSP WSPG
#define WSW WSWG
#define OUTP OUTPG
#endif
__device__ __forceinline__ void ph_prologue(Frame& F, ArgP A) {
    const int* pos = (const int*)INP(A, 1); float2* rope = WSP(float2, WS_ROPE);
    {
        const int gw = F.vcu * NWAVES + F.wave, NGW = F.G * NWAVES, lane = F.lane;
        for (int m = gw; m < M; m += NGW) {
            const GAS f32x4* xr = (const GAS f32x4*)(INP(A, 0) + (size_t)m * D) + lane; GAS f32x4* orow = (GAS f32x4*)(OUTP + (size_t)m * D) + lane;
            GAS v2u* hb = (GAS v2u*)(WSP(bf16, WS_H) + (size_t)m * D) + lane; float s = 0.f;
#pragma unroll
            for (int j = 0; j < 8; ++j) { const f32x4 v = xr[64 * j]; orow[64 * j] = v; v2u o; o.x = pk2(v.x, v.y); o.y = pk2(v.z, v.w); hb[64 * j] = o; s += (v.x * v.x + v.y * v.y) + (v.z * v.z + v.w * v.w); }
            s = wave_sum(s);
            if (lane < 32) WSP(float, WS_SS)[(size_t)m * 32 + lane] = lane == 0 ? s : 0.f;
        }
    }
    for (int i = F.vcu * 512 + F.tid; i < M * 64; i += F.G * 512) {
        const int m = i >> 6, j = i & 63;
        const double rev = (double)pos[m] * ROPE_REV[j];
        const float fr = (float)(rev - __builtin_rint(rev));
        rope[i] = make_float2(__builtin_amdgcn_cosf(fr), __builtin_amdgcn_sinf(fr));
    }
}
#if (MK_GLOBAL_GROUPS & 1)
#pragma pop_macro("WSP")
#pragma pop_macro("WSW")
#pragma pop_macro("OUTP")
#endif
#if (MK_GLOBAL_GROUPS & 16)
#pragma push_macro("WSP")
#pragma push_macro("WSW")
#pragma push_macro("OUTP")
#undef WSP
#undef WSW
#undef OUTP
#define WSP WSPG
#define WSW WSWG
#define OUTP OUTPG
#endif
__device__ __forceinline__ TItem conv_item(Frame& F, ArgP A, int l, int it) {
    constexpr int I_IN = (D / 64) * (INW / 32), I_A = (RETW / 64) * (D / 32), I_O = (D / 64) * (D / 32), I_UP = (D / 64) * (DFF / 32), I_DN = (DFF / 64) * (D / 32);
    int r = it; TItem t;
    if (r < I_IN) { t = TItem{INP(A, 3) + (size_t)l * D * INW, WSW(l, WO_WIN), INP(A, 2) + (size_t)l * D, D, INW, r}; return t; } r -= I_IN;
    if (r < I_A) { t = TItem{INP(A, 17) + (size_t)l * RETW * D, WSW(l, WO_WA), nullptr, RETW, D, r}; return t; } r -= I_A;
    if (r < I_A) { t = TItem{INP(A, 18) + (size_t)l * RWW * D, WSW(l, WO_WB), nullptr, RWW, D, r}; return t; } r -= I_A;
    if (r < I_O) { t = TItem{INP(A, 19) + (size_t)l * D * D, WSW(l, WO_WO), nullptr, D, D, r}; return t; } r -= I_O;
    if (r < I_UP) { t = TItem{INP(A, 21) + (size_t)l * D * DFF, WSW(l, WO_WUP), INP(A, 20) + (size_t)l * D, D, DFF, r}; return t; } r -= I_UP;
    if (r < I_DN) { t = TItem{INP(A, 22) + (size_t)l * DFF * D, WSW(l, WO_WDN), nullptr, DFF, D, r}; return t; } r -= I_DN;
    if (r < 32) { t = TItem{INP(A, 8) + (size_t)l * 64 * RWW, WSW(l, WO_LORA), nullptr, 64, RWW, r}; return t; } r -= 32;
    if (r < 32) { t = TItem{INP(A, 10) + (size_t)l * 64 * RWW, WSW(l, WO_LORA) + 1024 * 64, nullptr, 64, RWW, r}; return t; } r -= 32;
    t = TItem{INP(A, 11) + (size_t)l * 128 * RWW, WSW(l, WO_LORA) + 2 * 1024 * 64, nullptr, 128, RWW, r}; return t;
}
__device__ __forceinline__ void ph_convert(Frame& F, ArgP A, int l, int wg, int nwg) {
    LAS float* scr = (LAS float*)(F.lds + RING_OFF + F.wave * 16384);
    const int gw = wg * NWAVES + F.wave, NGW = nwg * NWAVES, lane = F.lane;
    constexpr int I_IN = (D / 64) * (INW / 32), I_A = (RETW / 64) * (D / 32), I_O = (D / 64) * (D / 32), I_UP = (D / 64) * (DFF / 32), I_DN = (DFF / 64) * (D / 32);
    constexpr int NITEMS = I_IN + 2 * I_A + I_O + I_UP + I_DN + 32 + 32 + 64;
    if (gw >= NITEMS) return;
    TItem cur = conv_item(F, A, l, gw); f32x4 va[8], vb[8];
    titem_load(cur, lane, va);
    for (int it = gw; it < NITEMS; it += 2 * NGW) {
        TItem nxt = cur; const bool h1 = it + NGW < NITEMS;
        if (h1) { nxt = conv_item(F, A, l, it + NGW); titem_load(nxt, lane, vb); }
        titem_finish(cur, lane, va, scr);
        if (!h1) break;
        const bool h2 = it + 2 * NGW < NITEMS;
        if (h2) { cur = conv_item(F, A, l, it + 2 * NGW); titem_load(cur, lane, va); }
        titem_finish(nxt, lane, vb, scr);
        if (!h2) break;
    }
}
__device__ __forceinline__ void ph_norm(Frame& F, const float* g) {
    const int gw = F.vcu * NWAVES + F.wave, NGW = F.G * NWAVES;
    for (int m = gw; m < M; m += NGW) rms_row_to_bf16(OUTP + (size_t)m * D, g, WSP(bf16, WS_H) + (size_t)m * D, F.lane);
}
#if (MK_GLOBAL_GROUPS & 16)
#pragma pop_macro("WSP")
#pragma pop_macro("WSW")
#pragma pop_macro("OUTP")
#endif
#if (MK_GLOBAL_GROUPS & 2)
#pragma push_macro("WSP")
#pragma push_macro("WSW")
#pragma push_macro("OUTP")
#undef WSP
#undef WSW
#undef OUTP
#define WSP WSPG
#define WSW WSWG
#define OUTP OUTPG
#endif
__device__ __forceinline__ void unpack8(const v4u a, float (&o)[8]) {
    o[0] = pg8::bf_lo(a.x); o[1] = pg8::bf_hi(a.x); o[2] = pg8::bf_lo(a.y); o[3] = pg8::bf_hi(a.y); o[4] = pg8::bf_lo(a.z); o[5] = pg8::bf_hi(a.z); o[6] = pg8::bf_lo(a.w); o[7] = pg8::bf_hi(a.w);
}
__device__ __forceinline__ void mix8(const GAS bf16* zc, bool has_prev, const GAS float* mu, float (&o)[8]) {
    const v4u a = *(const GAS v4u*)zc; v4u p = (v4u){0u, 0u, 0u, 0u}; if (has_prev) p = *(const GAS v4u*)(zc - INW);
    const f32x4 m0 = *(const GAS f32x4*)mu, m1 = *(const GAS f32x4*)(mu + 4);
    float z[8], q[8]; unpack8(a, z); unpack8(p, q);
#pragma unroll
    for (int j = 0; j < 4; ++j) { o[j] = z[j] + m0[j] * (q[j] - z[j]); o[4 + j] = z[4 + j] + m1[j] * (q[4 + j] - z[4 + j]); }
}
__device__ __forceinline__ f32x4 mix4(const GAS bf16* zc, bool has_prev, const GAS float* mu) {
    const v2u a = *(const GAS v2u*)zc; v2u p = (v2u){0u, 0u}; if (has_prev) p = *(const GAS v2u*)(zc - INW);
    const f32x4 m = *(const GAS f32x4*)mu;
    const f32x4 z = (f32x4){pg8::bf_lo(a.x), pg8::bf_hi(a.x), pg8::bf_lo(a.y), pg8::bf_hi(a.y)}, q = (f32x4){pg8::bf_lo(p.x), pg8::bf_hi(p.x), pg8::bf_lo(p.y), pg8::bf_hi(p.y)};
    return z + m * (q - z);
}
__device__ __forceinline__ bf16x8 pack8(const float (&v)[8]) {
    v4u o; o.x = pg8::cvt_pk_bf16(v[0], v[1]); o.y = pg8::cvt_pk_bf16(v[2], v[3]); o.z = pg8::cvt_pk_bf16(v[4], v[5]); o.w = pg8::cvt_pk_bf16(v[6], v[7]);
    return __builtin_bit_cast(bf16x8, o);
}
constexpr int CU_BYTES = 20480, CU_M = 0, CU_OM = 8192, CU_QB = 10240, CU_QSTR = 2560;
constexpr int CK = 16, NCHUNK = SEQ / CK;
constexpr int XL_STR = 144, XL_MAT = 16 * XL_STR;
typedef short s4v __attribute__((ext_vector_type(4)));
__device__ __forceinline__ s4v pk4(const f32x4 v) { v2u o; o.x = pg8::cvt_pk_bf16(v[0], v[1]); o.y = pg8::cvt_pk_bf16(v[2], v[3]); return __builtin_bit_cast(s4v, o); }
__device__ __forceinline__ bf16x8 pk8v(const f32x4 a, const f32x4 b) { v4u o; o.x = pg8::cvt_pk_bf16(a[0], a[1]); o.y = pg8::cvt_pk_bf16(a[2], a[3]); o.z = pg8::cvt_pk_bf16(b[0], b[1]); o.w = pg8::cvt_pk_bf16(b[2], b[3]); return __builtin_bit_cast(bf16x8, o); }
__device__ __forceinline__ f32x4 mma16(const s4v x, const s4v y, const f32x4 c) {
    const bf16x8 x8 = (bf16x8){x.x, x.y, x.z, x.w, 0, 0, 0, 0}, y8 = (bf16x8){y.x, y.y, y.z, y.w, 0, 0, 0, 0};
    return __builtin_amdgcn_mfma_f32_16x16x32_bf16(x8, y8, c, 0, 0, 0); }
__device__ __forceinline__ f32x4 mma32(const bf16x8 x, const bf16x8 y, const f32x4 c) { return __builtin_amdgcn_mfma_f32_16x16x32_bf16(x, y, c, 0, 0, 0); }
template <int N> __device__ __forceinline__ float dpp_shr0(float x) { return __builtin_bit_cast(float, __builtin_amdgcn_update_dpp(0, __builtin_bit_cast(int, x), 0x110 + N, 0xF, 0xF, true)); }
__device__ __forceinline__ float scan16(float x) { x += dpp_shr0<1>(x); x += dpp_shr0<2>(x); x += dpp_shr0<4>(x); x += dpp_shr0<8>(x); return x; }
__device__ __forceinline__ s4v trd(const LAS unsigned char* p) { return __builtin_amdgcn_ds_read_tr16_b64_v4i16((LAS s4v*)p); }
__device__ __forceinline__ void chunk_ops(const f32x4 (&r)[4], const f32x4 (&lw)[4], const f32x4 (&kp)[4], const f32x4 (&v)[4], const f32x4 (&a)[4], const f32x4 (&b)[4],
                                          LAS unsigned char* scr, GAS unsigned char* rec, int lane) {
    const int l15 = lane & 15, g = lane >> 4, tq = l15 >> 2, tp = l15 & 3;
    const f32x4 Z4 = (f32x4){0.f, 0.f, 0.f, 0.f};
    f32x4 Rt[4], pc[4]; bf16x8 Atf[2], Btf[2], Ktf[2], Rtf[2];
    {
        s4v Ah[4], Bq[4], Kq[4], Rq[4];
#pragma unroll
        for (int nt = 0; nt < 4; ++nt) {
            f32x4 cs, tot;
#pragma unroll
            for (int i = 0; i < 4; ++i) { cs[i] = scan16(lw[nt][i]); tot[i] = __shfl(cs[i], lane | 15); }
            f32x4 At, Bt, Kt, Bh, Kh;
#pragma unroll
            for (int i = 0; i < 4; ++i) { const float P = fexp(cs[i]), Pm1 = fexp(cs[i] - lw[nt][i]), iP = fexp(-cs[i]), PCP = fexp(tot[i] - cs[i]);
                pc[nt][i] = fexp(tot[i]); At[i] = a[nt][i] * Pm1; Bt[i] = b[nt][i] * iP; Kt[i] = kp[nt][i] * iP; Rt[nt][i] = r[nt][i] * P; Bh[i] = b[nt][i] * PCP; Kh[i] = kp[nt][i] * PCP; }
            Ah[nt] = pk4(At); Bq[nt] = pk4(Bt); Kq[nt] = pk4(Kt); Rq[nt] = pk4(Rt[nt]);
            LAS unsigned char* w = scr + l15 * XL_STR + (16 * nt + 4 * g) * 2;
            *(LAS s4v*)(w + 0 * XL_MAT) = Ah[nt]; *(LAS s4v*)(w + 1 * XL_MAT) = pk4(v[nt]); *(LAS s4v*)(w + 2 * XL_MAT) = pk4(Bh); *(LAS s4v*)(w + 3 * XL_MAT) = pk4(Kh);
        }
#pragma unroll
        for (int s = 0; s < 2; ++s) {
            Atf[s] = (bf16x8){Ah[2 * s].x, Ah[2 * s].y, Ah[2 * s].z, Ah[2 * s].w, Ah[2 * s + 1].x, Ah[2 * s + 1].y, Ah[2 * s + 1].z, Ah[2 * s + 1].w};
            Btf[s] = (bf16x8){Bq[2 * s].x, Bq[2 * s].y, Bq[2 * s].z, Bq[2 * s].w, Bq[2 * s + 1].x, Bq[2 * s + 1].y, Bq[2 * s + 1].z, Bq[2 * s + 1].w};
            Ktf[s] = (bf16x8){Kq[2 * s].x, Kq[2 * s].y, Kq[2 * s].z, Kq[2 * s].w, Kq[2 * s + 1].x, Kq[2 * s + 1].y, Kq[2 * s + 1].z, Kq[2 * s + 1].w};
            Rtf[s] = (bf16x8){Rq[2 * s].x, Rq[2 * s].y, Rq[2 * s].z, Rq[2 * s].w, Rq[2 * s + 1].x, Rq[2 * s + 1].y, Rq[2 * s + 1].z, Rq[2 * s + 1].w}; }
    }
    f32x4 LabR = Z4, LabT = Z4, LakT = Z4, LrbT = Z4, LrkT = Z4;
#pragma unroll
    for (int s = 0; s < 2; ++s) { LabR = mma32(Atf[s], Btf[s], LabR); LabT = mma32(Btf[s], Atf[s], LabT); LakT = mma32(Ktf[s], Atf[s], LakT); LrbT = mma32(Btf[s], Rtf[s], LrbT); LrkT = mma32(Ktf[s], Rtf[s], LrkT); }
    f32x4 IR;
#pragma unroll
    for (int i = 0; i < 4; ++i) { const int tt = 4 * g + i;
        IR[i] = (tt == l15) ? 1.f : 0.f;
        LabR[i] = (tt > l15) ? LabR[i] : 0.f; LabT[i] = (l15 > tt) ? LabT[i] : 0.f; LakT[i] = (l15 > tt) ? LakT[i] : 0.f;
        LrbT[i] = (l15 >= tt) ? LrbT[i] : 0.f; LrkT[i] = (l15 >= tt) ? LrkT[i] : 0.f; }
    const s4v L1R = pk4(LabR), L1T = pk4(LabT);
    const f32x4 L2R = mma16(L1T, L1R, Z4), L2T = mma16(L1R, L1T, Z4);
    const s4v L2Rp = pk4(L2R), L2Tp = pk4(L2T);
    const f32x4 L4R = mma16(L2Tp, L2Rp, Z4), L4T = mma16(L2Rp, L2Tp, Z4);
    const s4v L4Rp = pk4(L4R), L4Tp = pk4(L4T);
    const f32x4 L8R = mma16(L4Tp, L4Rp, Z4);
    const f32x4 T1T = mma16(pk4(IR + L2R), pk4(IR + LabT), Z4);
    const f32x4 T2T = mma16(pk4(IR + L4R), pk4(T1T), Z4);
    const s4v TmT = pk4(mma16(pk4(IR + L8R), pk4(T2T), Z4));
    const s4v LakTp = pk4(LakT), LrbTp = pk4(LrbT), LrkTp = pk4(LrkT);
    asm volatile("s_waitcnt lgkmcnt(0)" ::: "memory");
    const LAS unsigned char* tb = scr + (4 * g + tq) * XL_STR + (4 * tp) * 2;
    s4v tAt[4], tV[4], tBh[4], tKh[4];
#pragma unroll
    for (int t = 0; t < 4; ++t) { tAt[t] = trd(tb + 0 * XL_MAT + 32 * t); tV[t] = trd(tb + 1 * XL_MAT + 32 * t); tBh[t] = trd(tb + 2 * XL_MAT + 32 * t); tKh[t] = trd(tb + 3 * XL_MAT + 32 * t); }
    s4v Wp[4], U0p[4];
#pragma unroll
    for (int t = 0; t < 4; ++t) { Wp[t] = pk4(mma16(TmT, tAt[t], Z4));
        const f32x4 G = mma16(LakTp, tV[t], Z4);
        const f32x4 U0 = mma16(TmT, pk4(G), Z4); U0p[t] = pk4(U0);
        f32x4 Y0 = mma16(LrbTp, U0p[t], Z4); Y0 = mma16(LrkTp, tV[t], Y0);
        *(GAS s4v*)(rec + CU_QB + t * CU_QSTR + 2048 + lane * 8) = pk4(Y0); }
    {
        f32x4 Om[4];
#pragma unroll
        for (int ct = 0; ct < 4; ++ct) Om[ct] = mma16(Wp[ct], LrbTp, Rt[ct]);
        *(GAS bf16x8*)(rec + CU_OM + 0 * 1024 + lane * 16) = pk8v(Om[0], Om[1]); *(GAS bf16x8*)(rec + CU_OM + 1 * 1024 + lane * 16) = pk8v(Om[2], Om[3]);
    }
#pragma unroll
    for (int tl = 0; tl < 4; ++tl) {
        f32x4 Mt[4];
#pragma unroll
        for (int kt = 0; kt < 4; ++kt) { Mt[kt] = mma16(Wp[kt], tBh[tl], Z4);
            if (kt == tl) {
#pragma unroll
                for (int i = 0; i < 4; ++i) Mt[kt][i] += (4 * g + i == l15) ? pc[kt][i] : 0.f; } }
        *(GAS bf16x8*)(rec + CU_M + (tl * 2 + 0) * 1024 + lane * 16) = pk8v(Mt[0], Mt[1]); *(GAS bf16x8*)(rec + CU_M + (tl * 2 + 1) * 1024 + lane * 16) = pk8v(Mt[2], Mt[3]);
    }
#pragma unroll
    for (int q = 0; q < 4; ++q)
#pragma unroll
        for (int tl = 0; tl < 4; ++tl) { f32x4 Nt = mma16(tBh[tl], U0p[q], Z4); Nt = mma16(tKh[tl], tV[q], Nt);
            *(GAS s4v*)(rec + CU_QB + q * CU_QSTR + tl * 512 + lane * 8) = pk4(Nt); }
}
__device__ __forceinline__ void ph_prep(Frame& F, ArgP A, int l) {
    const int gw = F.vcu * NWAVES + F.wave, NGW = F.G * NWAVES, lane = F.lane, l15 = lane & 15, g = lane >> 4;
    {
        const int h = lane >> 3, i0 = 8 * (lane & 7);
        for (int m = gw; m < M; m += NGW) {
            const GAS bf16* zrow = (const GAS bf16*)(WSP(bf16, WS_Z) + (size_t)m * INW);
            const GAS f32x4* rp = (const GAS f32x4*)(WSP(float2, WS_ROPE) + (size_t)m * 64 + i0);
            const f32x4 c01 = rp[0], c23 = rp[1], c45 = rp[2], c67 = rp[3];
            const float cs[8] = {c01.x, c01.z, c23.x, c23.z, c45.x, c45.z, c67.x, c67.z}, sn[8] = {c01.y, c01.w, c23.y, c23.w, c45.y, c45.w, c67.y, c67.w};
            float q1[8], q2[8], k1[8], k2[8], o1[8], o2[8];
            unpack8(*(const GAS v4u*)(zrow + ZC_Q + h * RD + i0), q1); unpack8(*(const GAS v4u*)(zrow + ZC_Q + h * RD + 64 + i0), q2);
            unpack8(*(const GAS v4u*)(zrow + ZC_K + h * RD + i0), k1); unpack8(*(const GAS v4u*)(zrow + ZC_K + h * RD + 64 + i0), k2);
#pragma unroll
            for (int j = 0; j < 8; ++j) { o1[j] = q1[j] * cs[j] - q2[j] * sn[j]; o2[j] = q2[j] * cs[j] + q1[j] * sn[j]; }
            GAS bf16* qo = (GAS bf16*)(WSP(bf16, WS_QR) + (size_t)m * RETW + h * RD + i0);
            *(GAS bf16x8*)qo = pack8(o1); *(GAS bf16x8*)(qo + 64) = pack8(o2);
#pragma unroll
            for (int j = 0; j < 8; ++j) { const float a = k1[j] * 0.08838834764831845f, b = k2[j] * 0.08838834764831845f; o1[j] = a * cs[j] - b * sn[j]; o2[j] = b * cs[j] + a * sn[j]; }
            GAS bf16* ko = (GAS bf16*)(WSP(bf16, WS_KR) + (size_t)m * RETW + h * RD + i0);
            *(GAS bf16x8*)ko = pack8(o1); *(GAS bf16x8*)(ko + 64) = pack8(o2);
        }
    }
    const GAS float* mu = (const GAS float*)(INP(A, 6) + (size_t)l * RWSHIFT);
    const GAS float* w0 = (const GAS float*)(INP(A, 7) + (size_t)l * RWW); const GAS float* a0 = (const GAS float*)(INP(A, 9) + (size_t)l * RWW);
    const GAS float* kkw = (const GAS float*)(INP(A, 12) + (size_t)l * RWW); const GAS float* kaw = (const GAS float*)(INP(A, 13) + (size_t)l * RWW); const GAS float* rkw = (const GAS float*)(INP(A, 14) + (size_t)l * RWW);
    const GAS bf16* WupT = (const GAS bf16*)WSW(l, WO_LORA); const GAS bf16* AupT = WupT + 1024 * 64; const GAS bf16* GupT = AupT + 1024 * 64;
    for (int task = gw; task < M / 8; task += NGW) {
        const int m = (task >> 1) * 16 + l15, hh0 = (task & 1) * (WH / 2);
        const bool has_prev = (m % SEQ) != 0;
        const GAS bf16* zr = (const GAS bf16*)(WSP(bf16, WS_Z) + (size_t)m * INW + ZC_RW);
        bf16x8 fw[2], fa[2], fg[4];
#pragma unroll
        for (int ks = 0; ks < 2; ++ks) { float t[8];
            mix8(zr + RWC_W + 32 * ks + 8 * g, has_prev, mu + RWC_W + 32 * ks + 8 * g, t);
#pragma unroll
            for (int j = 0; j < 8; ++j) t[j] = ftanh(t[j]);
            fw[ks] = pack8(t);
            mix8(zr + RWC_A + 32 * ks + 8 * g, has_prev, mu + RWC_A + 32 * ks + 8 * g, t); fa[ks] = pack8(t); }
#pragma unroll
        for (int ks = 0; ks < 4; ++ks) { float t[8];
            mix8(zr + RWC_G + 32 * ks + 8 * g, has_prev, mu + RWC_G + 32 * ks + 8 * g, t);
#pragma unroll
            for (int j = 0; j < 8; ++j) t[j] = fsig(t[j]);
            fg[ks] = pack8(t); }
        for (int hh = hh0; hh < hh0 + WH / 2; ++hh) {
            f32x4 kkr[4], av[4], rr[4], lwv[4], kpv[4], vv[4]; float ss = 0.f, bonus = 0.f;
#pragma unroll
            for (int nt = 0; nt < 4; ++nt) {
                const int cf = hh * WD + nt * 16 + l15;
                const int c0 = hh * WD + nt * 16 + 4 * g;
                f32x4 wl = *(const GAS f32x4*)(w0 + c0), al = *(const GAS f32x4*)(a0 + c0), gl = (f32x4){0.f, 0.f, 0.f, 0.f};
#pragma unroll
                for (int ks = 0; ks < 2; ++ks) {
                    wl = __builtin_amdgcn_mfma_f32_16x16x32_bf16(*(const GAS bf16x8*)(WupT + (size_t)cf * 64 + 32 * ks + 8 * g), fw[ks], wl, 0, 0, 0);
                    al = __builtin_amdgcn_mfma_f32_16x16x32_bf16(*(const GAS bf16x8*)(AupT + (size_t)cf * 64 + 32 * ks + 8 * g), fa[ks], al, 0, 0, 0); }
#pragma unroll
                for (int ks = 0; ks < 4; ++ks)
                    gl = __builtin_amdgcn_mfma_f32_16x16x32_bf16(*(const GAS bf16x8*)(GupT + (size_t)cf * 128 + 32 * ks + 8 * g), fg[ks], gl, 0, 0, 0);
                const f32x4 r = mix4(zr + RWC_R + c0, has_prev, mu + RWC_R + c0), k = mix4(zr + RWC_K + c0, has_prev, mu + RWC_K + c0), v = mix4(zr + RWC_V + c0, has_prev, mu + RWC_V + c0);
                const f32x4 kk4 = *(const GAS f32x4*)(kkw + c0), ka4 = *(const GAS f32x4*)(kaw + c0), rk4 = *(const GAS f32x4*)(rkw + c0);
                f32x4 lwd, a, kp;
#pragma unroll
                for (int i = 0; i < 4; ++i) {
                    lwd[i] = -0.6065306597126334f * fsig(wl[i]);
                    a[i] = fsig(al[i]);
                    kp[i] = k[i] * (1.0f + (a[i] - 1.0f) * ka4[i]);
                }
                kkr[nt] = k * kk4; av[nt] = a; rr[nt] = r; lwv[nt] = lwd; kpv[nt] = kp; vv[nt] = v;
                ss += (kkr[nt].x * kkr[nt].x + kkr[nt].y * kkr[nt].y) + (kkr[nt].z * kkr[nt].z + kkr[nt].w * kkr[nt].w);
                const f32x4 rb = r * kp * rk4; bonus += (rb.x + rb.y) + (rb.z + rb.w);
                const size_t o = (size_t)m * RWW + c0;
#if MK_CHUNKED
                *(GAS f32x4*)(WSP(float, WS_SV) + o) = v; *(GAS f32x4*)(WSP(float, WS_G) + o) = gl;
#else
                f32x4 decay;
#pragma unroll
                for (int i = 0; i < 4; ++i) decay[i] = fexp(lwd[i]);
                *(GAS f32x4*)(WSP(float, WS_SR) + o) = r; *(GAS f32x4*)(WSP(float, WS_SW) + o) = decay; *(GAS f32x4*)(WSP(float, WS_SK) + o) = kp;
                *(GAS f32x4*)(WSP(float, WS_SV) + o) = v; *(GAS f32x4*)(WSP(float, WS_G) + o) = gl;
#endif
            }
            ss += __shfl_xor(ss, 16); ss += __shfl_xor(ss, 32); bonus += __shfl_xor(bonus, 16); bonus += __shfl_xor(bonus, 32);
            const float inv = 1.0f / fmaxf(sqrtf(ss), 1e-12f);
            if (g == 0) WSP(float, WS_BONUS)[(size_t)m * WH + hh] = bonus;
#if MK_CHUNKED
            f32x4 aa[4], bb[4];
#pragma unroll
            for (int nt = 0; nt < 4; ++nt) { const f32x4 kk = kkr[nt] * inv; aa[nt] = -kk; bb[nt] = kk * av[nt]; }
            const int tile = task >> 1;
            GAS unsigned char* rec = (GAS unsigned char*)WSP(unsigned char, WS_CU) + ((size_t)((tile / NCHUNK) * WH + hh) * NCHUNK + (tile % NCHUNK)) * CU_BYTES;
            chunk_ops(rr, lwv, kpv, vv, aa, bb, F.lds + RING_OFF + F.wave * 16384, rec, lane);
#else
#pragma unroll
            for (int nt = 0; nt < 4; ++nt) { const size_t o = (size_t)m * RWW + hh * WD + nt * 16 + 4 * g; const f32x4 kk = kkr[nt] * inv;
                *(GAS f32x4*)(WSP(float, WS_SNKK) + o) = -kk; *(GAS f32x4*)(WSP(float, WS_SKKA) + o) = kk * av[nt]; }
#endif
        }
    }
}
#if (MK_GLOBAL_GROUPS & 2)
#pragma pop_macro("WSP")
#pragma pop_macro("WSW")
#pragma pop_macro("OUTP")
#endif
#if (MK_GLOBAL_GROUPS & 4)
#pragma push_macro("WSP")
#pragma push_macro("WSW")
#pragma push_macro("OUTP")
#undef WSP
#undef WSW
#undef OUTP
#define WSP WSPG
#define WSW WSWG
#define OUTP OUTPG
#endif
#if !MK_CHUNKED
__device__ __forceinline__ void scan_rwkv_naive(Frame& F, int item) {
    const int lane = F.lane;
    float st[64];
#pragma unroll
    for (int j = 0; j < 64; ++j) st[j] = 0.f;
    const size_t base0 = (size_t)(item >> 4) * SEQ * RWW + (size_t)(item & 15) * WD + lane;
    for (int t = 0; t < SEQ; ++t) {
        const size_t o = base0 + (size_t)t * RWW;
        const float r = WSP(float, WS_SR)[o], w = WSP(float, WS_SW)[o], k = WSP(float, WS_SK)[o], v = WSP(float, WS_SV)[o], nk = WSP(float, WS_SNKK)[o], ka = WSP(float, WS_SKKA)[o];
        float sa = 0.f;
#pragma unroll
        for (int j = 0; j < 64; ++j) sa += st[j] * rdlane(nk, j);
        float y = 0.f;
#pragma unroll
        for (int j = 0; j < 64; ++j) { st[j] = st[j] * rdlane(w, j) + sa * rdlane(ka, j) + v * rdlane(k, j); y += st[j] * rdlane(r, j); }
        WSP(float, WS_YRAWW)[o] = y;
    }
}
#endif
__device__ __forceinline__ void scan_ret_naive(Frame& F, int item) {
    const int lane = F.lane, b = item >> 4, h = (item >> 1) & 7, half = item & 1;
    const float gam = 1.0f - exp2f((float)(-5 - h));
    float R[128];
#pragma unroll
    for (int j = 0; j < 128; ++j) R[j] = 0.f;
    for (int t = 0; t < SEQ; ++t) {
        const size_t m = (size_t)b * SEQ + t;
        const float q1 = bf2f(WSP(bf16, WS_QR)[m * RETW + h * RD + lane]), q2 = bf2f(WSP(bf16, WS_QR)[m * RETW + h * RD + 64 + lane]);
        const float k1 = bf2f(WSP(bf16, WS_KR)[m * RETW + h * RD + lane]), k2 = bf2f(WSP(bf16, WS_KR)[m * RETW + h * RD + 64 + lane]);
        const float v = bf2f(WSP(bf16, WS_Z)[m * INW + ZC_V + h * RD + half * 64 + lane]);
        float y = 0.f;
#pragma unroll
        for (int d = 0; d < 64; ++d) { R[d] = gam * R[d] + rdlane(k1, d) * v; y += rdlane(q1, d) * R[d]; }
#pragma unroll
        for (int d = 0; d < 64; ++d) { R[64 + d] = gam * R[64 + d] + rdlane(k2, d) * v; y += rdlane(q2, d) * R[64 + d]; }
        WSP(float, WS_YRAWR)[m * RETW + h * RD + half * 64 + lane] = y;
    }
}
#if !MK_CHUNKED
constexpr int SCT = 32;
constexpr int SC_ARR = SCT * 64 * 4;
constexpr int SC_BUF = 5 * SC_ARR + SCT * 16 * 4;
static_assert(2 * SC_BUF <= RING_BYTES, "scan LDS");
template <int CTRL> __device__ __forceinline__ float dppf(float x) { return __builtin_bit_cast(float, __builtin_amdgcn_update_dpp(0, __builtin_bit_cast(int, x), CTRL, 0xF, 0xF, true)); }
__device__ __forceinline__ float sum16(float x) {
    x += dppf<0xB1>(x); x += dppf<0x4E>(x); x += dppf<0x141>(x); x += dppf<0x140>(x); return x;
}
__device__ __forceinline__ void scan_rwkv_fast(Frame& F, int w) {
    const int b = w >> 6, hh = (w >> 2) & 15, q = w & 3;
    const int lane = F.lane, wave = F.wave;
    LAS unsigned char* base = F.lds + RING_OFF;
    const size_t g0 = (size_t)b * SEQ * RWW + (size_t)hh * WD;
    constexpr int NBLK = SEQ / SCT;
#define SC_BAR() do { asm volatile("s_waitcnt lgkmcnt(0)" ::: "memory"); __builtin_amdgcn_s_barrier(); asm volatile("" ::: "memory"); } while (0)
    if (wave >= 4) {
        const int lt = F.tid - 256;
        const float* a0 = WSP(float, WS_SR) + g0; const float* a1 = WSP(float, WS_SW) + g0; const float* a2 = WSP(float, WS_SK) + g0;
        const float* a3 = WSP(float, WS_SNKK) + g0; const float* a4 = WSP(float, WS_SKKA) + g0; const float* av = WSP(float, WS_SV) + g0 + 16 * q;
        const int f0 = lt, f1 = lt + 256;
        const size_t o0 = (size_t)(f0 >> 4) * RWW + 4 * (f0 & 15), o1 = (size_t)(f1 >> 4) * RWW + 4 * (f1 & 15), ov = (size_t)(lt >> 2) * RWW + 4 * (lt & 3);
        f32x4 r0[5], r1[5], rv;
#define SC_LOAD(blk) do { const size_t tb = (size_t)(blk) * SCT * RWW; \
        r0[0] = *(const GAS f32x4*)(a0 + tb + o0); r1[0] = *(const GAS f32x4*)(a0 + tb + o1); r0[1] = *(const GAS f32x4*)(a1 + tb + o0); r1[1] = *(const GAS f32x4*)(a1 + tb + o1); \
        r0[2] = *(const GAS f32x4*)(a2 + tb + o0); r1[2] = *(const GAS f32x4*)(a2 + tb + o1); r0[3] = *(const GAS f32x4*)(a3 + tb + o0); r1[3] = *(const GAS f32x4*)(a3 + tb + o1); \
        r0[4] = *(const GAS f32x4*)(a4 + tb + o0); r1[4] = *(const GAS f32x4*)(a4 + tb + o1); if (lt < 128) rv = *(const GAS f32x4*)(av + tb + ov); } while (0)
#define SC_STORE(bi) do { LAS unsigned char* bb = base + (bi) * SC_BUF; \
        _Pragma("unroll") for (int a = 0; a < 5; ++a) { *(LAS f32x4*)(bb + a * SC_ARR + f0 * 16) = r0[a]; *(LAS f32x4*)(bb + a * SC_ARR + f1 * 16) = r1[a]; } \
        if (lt < 128) *(LAS f32x4*)(bb + 5 * SC_ARR + lt * 16) = rv; } while (0)
        SC_LOAD(0); SC_STORE(0);
        if (1 < NBLK) SC_LOAD(1);
        SC_BAR();
        for (int blk = 0; blk < NBLK; ++blk) {
            if (blk + 1 < NBLK) { SC_STORE((blk + 1) & 1); if (blk + 2 < NBLK) SC_LOAD(blk + 2); }
            SC_BAR();
        }
#undef SC_LOAD
#undef SC_STORE
    } else {
        const int l16 = lane & 15, rowl = 4 * wave + (lane >> 4);
        GAS float* Y = (GAS float*)(WSP(float, WS_YRAWW) + g0 + 16 * q + rowl);
        f32x4 st = (f32x4){0.f, 0.f, 0.f, 0.f};
        const int lo = l16 * 16, vo = 5 * SC_ARR + rowl * 4;
#define SC_LD(tt_, R4, W4, K4, N4, A4, V) do { R4 = *(const LAS f32x4*)(bb + 0 * SC_ARR + (tt_) * 256 + lo); W4 = *(const LAS f32x4*)(bb + 1 * SC_ARR + (tt_) * 256 + lo); \
        K4 = *(const LAS f32x4*)(bb + 2 * SC_ARR + (tt_) * 256 + lo); N4 = *(const LAS f32x4*)(bb + 3 * SC_ARR + (tt_) * 256 + lo); A4 = *(const LAS f32x4*)(bb + 4 * SC_ARR + (tt_) * 256 + lo); \
        V = *(const LAS float*)(bb + vo + (tt_) * 64); } while (0)
        SC_BAR();
        for (int blk = 0; blk < NBLK; ++blk) {
            const LAS unsigned char* bb = base + (blk & 1) * SC_BUF;
            GAS float* yb = Y + (size_t)blk * SCT * RWW;
            f32x4 r4[3], w4[3], k4[3], n4[3], a4[3]; float v[3];
            SC_LD(0, r4[0], w4[0], k4[0], n4[0], a4[0], v[0]);
            SC_LD(1, r4[1], w4[1], k4[1], n4[1], a4[1], v[1]);
#pragma unroll
            for (int tt = 0; tt < SCT; ++tt) {
                const int c = tt % 3, p = (tt + 2) % 3;
                if (tt + 2 < SCT) SC_LD(tt + 2, r4[p], w4[p], k4[p], n4[p], a4[p], v[p]);
                f32x2 sp2 = (f32x2){st.x, st.y} * (f32x2){n4[c].x, n4[c].y}; sp2 = (f32x2){st.z, st.w} * (f32x2){n4[c].z, n4[c].w} + sp2;
                const f32x4 t0 = st * w4[c] + k4[c] * v[c];
                const float sa = sum16(sp2.x + sp2.y);
                st = a4[c] * sa + t0;
                f32x2 yp2 = (f32x2){st.x, st.y} * (f32x2){r4[c].x, r4[c].y}; yp2 = (f32x2){st.z, st.w} * (f32x2){r4[c].z, r4[c].w} + yp2;
                const float y = sum16(yp2.x + yp2.y);
                yb[(size_t)tt * RWW] = y;
            }
            SC_BAR();
        }
#undef SC_LD
#undef SC_BAR
    }
}
#endif
constexpr int CB_STEPS = 4, CB_STEP_BYTES = 8192 + 2048 + 2048 + 512, CB_BUF = CB_STEPS * CB_STEP_BYTES, CB_PIECES = CB_BUF / 16, CB_NBLK = NCHUNK / CB_STEPS;
static_assert(2 * CB_BUF <= RING_BYTES, "chunk scan LDS");
#ifndef MK_X2_DIRECT
#define MK_X2_DIRECT 0
#endif
__device__ __forceinline__ f32x4 unpk4(const v2u p) { return (f32x4){pg8::bf_lo(p.x), pg8::bf_hi(p.x), pg8::bf_lo(p.y), pg8::bf_hi(p.y)}; }
__device__ __forceinline__ void scan_rwkv_chunk(Frame& F, int w) {
    const int bh = w >> 2, q = w & 3, lane = F.lane, wave = F.wave;
#if MK_X2_DIRECT
    if (wave == 0) {
        const int l15 = lane & 15, g = lane >> 4;
        const f32x4 Z4 = (f32x4){0.f, 0.f, 0.f, 0.f};
        f32x4 acc[4] = {Z4, Z4, Z4, Z4};
        const GAS unsigned char* rec = (const GAS unsigned char*)WSP(unsigned char, WS_CU) + (size_t)bh * NCHUNK * CU_BYTES;
        GAS float* Y = (GAS float*)(WSP(float, WS_YRAWW) + (size_t)(bh >> 4) * SEQ * RWW + (size_t)(bh & 15) * WD + 16 * q + l15 + (size_t)(4 * g) * RWW);
        for (int n = 0; n < NCHUNK; ++n, rec += CU_BYTES) {
            const bf16x8 sf0 = pk8v(acc[0], acc[1]), sf1 = pk8v(acc[2], acc[3]);
            f32x4 ya = unpk4(*(const GAS v2u*)(rec + CU_QB + q * CU_QSTR + 2048 + lane * 8));
            ya = mma32(*(const GAS bf16x8*)(rec + CU_OM + lane * 16), sf0, ya); ya = mma32(*(const GAS bf16x8*)(rec + CU_OM + 1024 + lane * 16), sf1, ya);
            GAS float* yp = Y + (size_t)(n * CK) * RWW;
#pragma unroll
            for (int i = 0; i < 4; ++i) yp[(size_t)i * RWW] = ya[i];
#pragma unroll
            for (int tl = 0; tl < 4; ++tl) { f32x4 na = unpk4(*(const GAS v2u*)(rec + CU_QB + q * CU_QSTR + tl * 512 + lane * 8));
                na = mma32(*(const GAS bf16x8*)(rec + CU_M + (tl * 2 + 0) * 1024 + lane * 16), sf0, na); na = mma32(*(const GAS bf16x8*)(rec + CU_M + (tl * 2 + 1) * 1024 + lane * 16), sf1, na);
                acc[tl] = na; }
        }
    }
    return;
#endif
    LAS unsigned char* base = F.lds + RING_OFF;
    const GAS unsigned char* rec0 = (const GAS unsigned char*)WSP(unsigned char, WS_CU) + (size_t)bh * NCHUNK * CU_BYTES;
#define CB_BAR() do { asm volatile("s_waitcnt lgkmcnt(0)" ::: "memory"); __builtin_amdgcn_s_barrier(); asm volatile("" ::: "memory"); } while (0)
    if (wave >= 1) {
        const int lt = F.tid - 64;
        v4u ra[8], rb[8];
        int so[8];
#pragma unroll
        for (int j = 0; j < 8; ++j) { const int p = lt + 448 * j, st = p / 800, off = p % 800; so[j] = st * CU_BYTES + off * 16 + (off >= 640 ? q * CU_QSTR : 0); }
        const bool last_ok = (wave == 1);
#define CB_LOAD(rg, blk) do { const GAS unsigned char* bp = rec0 + (size_t)(blk) * CB_STEPS * CU_BYTES; \
            _Pragma("unroll") for (int j = 0; j < 7; ++j) rg[j] = *(const GAS v4u*)(bp + so[j]); if (last_ok) rg[7] = *(const GAS v4u*)(bp + so[7]); } while (0)
#define CB_STORE(rg, bi) do { LAS unsigned char* dp = base + (bi) * CB_BUF + lt * 16; \
            _Pragma("unroll") for (int j = 0; j < 7; ++j) *(LAS v4u*)(dp + j * 448 * 16) = rg[j]; if (last_ok) *(LAS v4u*)(dp + 7 * 448 * 16) = rg[7]; } while (0)
        static_assert(CB_NBLK % 2 == 0 && CB_NBLK >= 4, "block pairs");
        CB_LOAD(ra, 0); CB_STORE(ra, 0); CB_LOAD(rb, 1); CB_LOAD(ra, 2);
        CB_BAR();
        for (int blk = 0; blk < CB_NBLK; blk += 2) {
            CB_STORE(rb, 1); if (blk + 3 < CB_NBLK) CB_LOAD(rb, blk + 3);
            CB_BAR();
            if (blk + 2 < CB_NBLK) { CB_STORE(ra, 0); if (blk + 4 < CB_NBLK) CB_LOAD(ra, blk + 4); }
            CB_BAR();
        }
#undef CB_LOAD
#undef CB_STORE
    } else {
        const int l15 = lane & 15, g = lane >> 4;
        const f32x4 Z4 = (f32x4){0.f, 0.f, 0.f, 0.f};
        f32x4 acc[4] = {Z4, Z4, Z4, Z4};
        GAS float* Y = (GAS float*)(WSP(float, WS_YRAWW) + (size_t)(bh >> 4) * SEQ * RWW + (size_t)(bh & 15) * WD + 16 * q + l15 + (size_t)(4 * g) * RWW);
        CB_BAR();
        bf16x8 Mf[2][8], Of[2][2]; v2u Nt[2][4], Yt[2];
#define CB_FRAGS(sb_, k_) do { _Pragma("unroll") for (int j = 0; j < 8; ++j) Mf[k_][j] = *(const LAS bf16x8*)((sb_) + j * 1024 + lane * 16); \
        _Pragma("unroll") for (int j = 0; j < 4; ++j) Nt[k_][j] = *(const LAS v2u*)((sb_) + 10240 + j * 512 + lane * 8); \
        Of[k_][0] = *(const LAS bf16x8*)((sb_) + 8192 + lane * 16); Of[k_][1] = *(const LAS bf16x8*)((sb_) + 9216 + lane * 16); Yt[k_] = *(const LAS v2u*)((sb_) + 12288 + lane * 8); } while (0)
        for (int blk = 0; blk < CB_NBLK; ++blk) {
            const LAS unsigned char* bb = base + (blk & 1) * CB_BUF;
            CB_FRAGS(bb, 0);
#pragma unroll
            for (int st = 0; st < CB_STEPS; ++st) {
                const int c = st & 1;
                if (st + 1 < CB_STEPS) CB_FRAGS(bb + (st + 1) * CB_STEP_BYTES, (c ^ 1));
                const bf16x8 sf0 = pk8v(acc[0], acc[1]), sf1 = pk8v(acc[2], acc[3]);
                f32x4 ya = unpk4(Yt[c]);
                ya = mma32(Of[c][0], sf0, ya); ya = mma32(Of[c][1], sf1, ya);
                GAS float* yp = Y + (size_t)((blk * CB_STEPS + st) * CK) * RWW;
#pragma unroll
                for (int i = 0; i < 4; ++i) yp[(size_t)i * RWW] = ya[i];
                f32x4 na[4];
#pragma unroll
                for (int tl = 0; tl < 4; ++tl) na[tl] = mma32(Mf[c][tl * 2 + 0], sf0, unpk4(Nt[c][tl]));
#pragma unroll
                for (int tl = 0; tl < 4; ++tl) acc[tl] = mma32(Mf[c][tl * 2 + 1], sf1, na[tl]);
            }
            CB_BAR();
        }
#undef CB_FRAGS
    }
#undef CB_BAR
}
constexpr int RT_STR = 288, RT_QS = 0, RT_KS = 128 * RT_STR, RT_VSTR = 80, RT_VS = 2 * 128 * RT_STR, RT_VPS = RT_VS + 128 * RT_VSTR, RT_RT = RT_VPS + 128 * RT_VSTR, RT_RTSZ = 32 * RT_STR;
static_assert(RT_RT + 2 * RT_RTSZ <= RING_BYTES, "retention LDS");
__device__ __forceinline__ bf16x8 tr8(const LAS unsigned char* p0, const LAS unsigned char* p1) {
    const s4v a = __builtin_amdgcn_ds_read_tr16_b64_v4i16((LAS s4v*)p0), b = __builtin_amdgcn_ds_read_tr16_b64_v4i16((LAS s4v*)p1);
    return (bf16x8){a.x, a.y, a.z, a.w, b.x, b.y, b.z, b.w};
}
__device__ __forceinline__ void scan_ret_mfma(Frame& F, int w_) {
    const int b = w_ >> 5, h = (w_ >> 2) & 7, eq = w_ & 3;
    const int tid = F.tid, lane = F.lane, w = F.wave, l15 = lane & 15, g = lane >> 4, tq = l15 >> 2, tp = l15 & 3;
    LAS unsigned char* L = F.lds + RING_OFF;
    const float lg2 = log1pf(-exp2f((float)(-5 - h))) * 1.4426950408889634f;
    const float gC = __builtin_amdgcn_exp2f(lg2 * 128.f);
    for (int i = tid; i < RT_RTSZ / 4; i += NWAVES * 64) ((LAS unsigned*)(L + RT_RT))[i] = 0u;
    const GAS bf16* Qg = (const GAS bf16*)(WSP(bf16, WS_QR) + (size_t)b * SEQ * RETW + h * RD);
    const GAS bf16* Kg = (const GAS bf16*)(WSP(bf16, WS_KR) + (size_t)b * SEQ * RETW + h * RD);
    const GAS bf16* Vg = (const GAS bf16*)(WSP(bf16, WS_Z) + (size_t)b * SEQ * INW + ZC_V + h * RD + 32 * eq);
    GAS float* Yg = (GAS float*)(WSP(float, WS_YRAWR) + (size_t)b * SEQ * RETW + h * RD + 32 * eq);
    v4u rq[4], rk[4], rv;
#define RT_LOAD(n_) do { _Pragma("unroll") for (int i = 0; i < 4; ++i) { const int f = tid + 512 * i, c = f >> 4, pc = f & 15; \
        rq[i] = *(const GAS v4u*)(Qg + (size_t)((n_) * 128 + c) * RETW + 8 * pc); rk[i] = *(const GAS v4u*)(Kg + (size_t)((n_) * 128 + c) * RETW + 8 * pc); } \
        rv = *(const GAS v4u*)(Vg + (size_t)((n_) * 128 + (tid >> 2)) * INW + 8 * (tid & 3)); } while (0)
    f32x4 accR[2] = {(f32x4){0.f, 0.f, 0.f, 0.f}, (f32x4){0.f, 0.f, 0.f, 0.f}};
    RT_LOAD(0);
    for (int n = 0; n < SEQ / 128; ++n) {
#pragma unroll
        for (int i = 0; i < 4; ++i) { const int f = tid + 512 * i, c = f >> 4, pc = f & 15;
            *(LAS v4u*)(L + RT_QS + c * RT_STR + pc * 16) = rq[i]; *(LAS v4u*)(L + RT_KS + c * RT_STR + pc * 16) = rk[i]; }
        { const int c = tid >> 2, pc = tid & 3; *(LAS v4u*)(L + RT_VS + c * RT_VSTR + pc * 16) = rv;
          const float sc = __builtin_amdgcn_exp2f(lg2 * (float)(127 - c)); v4u o;
          o.x = pg8::cvt_pk_bf16(pg8::bf_lo(rv.x) * sc, pg8::bf_hi(rv.x) * sc); o.y = pg8::cvt_pk_bf16(pg8::bf_lo(rv.y) * sc, pg8::bf_hi(rv.y) * sc);
          o.z = pg8::cvt_pk_bf16(pg8::bf_lo(rv.z) * sc, pg8::bf_hi(rv.z) * sc); o.w = pg8::cvt_pk_bf16(pg8::bf_lo(rv.w) * sc, pg8::bf_hi(rv.w) * sc);
          *(LAS v4u*)(L + RT_VPS + c * RT_VSTR + pc * 16) = o; }
        __syncthreads();
        if (n + 1 < SEQ / 128) RT_LOAD(n + 1);
        bf16x8 qf[4];
#pragma unroll
        for (int ks = 0; ks < 4; ++ks) qf[ks] = *(const LAS bf16x8*)(L + RT_QS + (16 * w + l15) * RT_STR + (32 * ks + 8 * g) * 2);
        bf16x8 pf[4];
        const int cq = 16 * w + l15;
#pragma unroll
        for (int p = 0; p < 4; ++p) {
            f32x4 s0 = (f32x4){0.f, 0.f, 0.f, 0.f}, s1 = (f32x4){0.f, 0.f, 0.f, 0.f};
            if (2 * p <= w) {
#pragma unroll
                for (int ks = 0; ks < 4; ++ks) { const bf16x8 kf = *(const LAS bf16x8*)(L + RT_KS + (32 * p + l15) * RT_STR + (32 * ks + 8 * g) * 2);
                    s0 = __builtin_amdgcn_mfma_f32_16x16x32_bf16(kf, qf[ks], s0, 0, 0, 0); }
            }
            if (2 * p + 1 <= w) {
#pragma unroll
                for (int ks = 0; ks < 4; ++ks) { const bf16x8 kf = *(const LAS bf16x8*)(L + RT_KS + (32 * p + 16 + l15) * RT_STR + (32 * ks + 8 * g) * 2);
                    s1 = __builtin_amdgcn_mfma_f32_16x16x32_bf16(kf, qf[ks], s1, 0, 0, 0); }
            }
            float p0[4], p1[4];
#pragma unroll
            for (int i = 0; i < 4; ++i) { const int d0 = cq - (32 * p + 4 * g + i), d1 = d0 - 16;
                p0[i] = d0 >= 0 ? s0[i] * __builtin_amdgcn_exp2f(lg2 * (float)d0) : 0.f; p1[i] = d1 >= 0 ? s1[i] * __builtin_amdgcn_exp2f(lg2 * (float)d1) : 0.f; }
            v4u pk; pk.x = pg8::cvt_pk_bf16(p0[0], p0[1]); pk.y = pg8::cvt_pk_bf16(p0[2], p0[3]); pk.z = pg8::cvt_pk_bf16(p1[0], p1[1]); pk.w = pg8::cvt_pk_bf16(p1[2], p1[3]);
            pf[p] = __builtin_bit_cast(bf16x8, pk);
        }
        const LAS unsigned char* Rcur = L + RT_RT + (n & 1) * RT_RTSZ;
#pragma unroll
        for (int et = 0; et < 2; ++et) {
            f32x4 acc = (f32x4){0.f, 0.f, 0.f, 0.f};
#pragma unroll
            for (int ks = 0; ks < 4; ++ks) { const bf16x8 rf = *(const LAS bf16x8*)(Rcur + (16 * et + l15) * RT_STR + (32 * ks + 8 * g) * 2);
                acc = __builtin_amdgcn_mfma_f32_16x16x32_bf16(qf[ks], rf, acc, 0, 0, 0); }
#pragma unroll
            for (int i = 0; i < 4; ++i) acc[i] *= __builtin_amdgcn_exp2f(lg2 * (float)(16 * w + 4 * g + i + 1));
#pragma unroll
            for (int p = 0; p < 4; ++p) if (2 * p <= w) {
                const LAS unsigned char* vb = L + RT_VS + (32 * p + 4 * g + tq) * RT_VSTR + (16 * et + 4 * tp) * 2;
                const bf16x8 vf = tr8(vb, vb + 16 * RT_VSTR);
                acc = __builtin_amdgcn_mfma_f32_16x16x32_bf16(pf[p], vf, acc, 0, 0, 0); }
#pragma unroll
            for (int i = 0; i < 4; ++i) Yg[(size_t)(n * 128 + 16 * w + 4 * g + i) * RETW + 16 * et + l15] = acc[i];
        }
        LAS unsigned char* Rnxt = L + RT_RT + ((n + 1) & 1) * RT_RTSZ;
        accR[0] = accR[0] * gC; accR[1] = accR[1] * gC;
#pragma unroll
        for (int cs = 0; cs < 4; ++cs) {
            const LAS unsigned char* kb = L + RT_KS + (32 * cs + 8 * g + tq) * RT_STR + (16 * w + 4 * tp) * 2;
            const bf16x8 kt = tr8(kb, kb + 4 * RT_STR);
#pragma unroll
            for (int et = 0; et < 2; ++et) { const LAS unsigned char* vb = L + RT_VPS + (32 * cs + 8 * g + tq) * RT_VSTR + (16 * et + 4 * tp) * 2;
                const bf16x8 vt = tr8(vb, vb + 4 * RT_VSTR);
                accR[et] = __builtin_amdgcn_mfma_f32_16x16x32_bf16(kt, vt, accR[et], 0, 0, 0); }
        }
#pragma unroll
        for (int et = 0; et < 2; ++et) { v2u o; o.x = pg8::cvt_pk_bf16(accR[et][0], accR[et][1]); o.y = pg8::cvt_pk_bf16(accR[et][2], accR[et][3]);
            *(LAS v2u*)(Rnxt + (16 * et + l15) * RT_STR + (16 * w + 4 * g) * 2) = o; }
        __syncthreads();
    }
#undef RT_LOAD
}
__device__ __forceinline__ void ph_scan(Frame& F, ArgP A, int l) {
    if (F.G >= 256) {
        if (F.vcu >= 192) { if (l + 1 < DEPTH) { ph_convert(F, A, l + 1, F.vcu - 192, F.G - 192); if (MK_REP & 256) { __syncthreads(); ph_convert(F, A, l + 1, F.vcu - 192, F.G - 192); } } return; }
#if MK_CHUNKED
        if (F.vcu < 128) { scan_rwkv_chunk(F, F.vcu); if (MK_REP & 32) { __syncthreads(); scan_rwkv_chunk(F, F.vcu); } }
#else
        if (F.vcu < 128) { scan_rwkv_fast(F, F.vcu); if (MK_REP & 32) { __syncthreads(); scan_rwkv_fast(F, F.vcu); } }
#endif
        else if (F.vcu < 192) { scan_ret_mfma(F, F.vcu - 128); if (MK_REP & 64) { __syncthreads(); scan_ret_mfma(F, F.vcu - 128); } }
    } else {
        if (l + 1 < DEPTH) ph_convert(F, A, l + 1, F.vcu, F.G);
        const int gw = F.vcu * NWAVES + F.wave, NGW = F.G * NWAVES;
        const int stride = NGW >= 64 ? NGW / 64 : 1;
        if (gw % stride == 0) {
            for (int item = gw / stride; item < 64; item += (NGW + stride - 1) / stride) {
#if !MK_CHUNKED
                if (item < 32) scan_rwkv_naive(F, item); else
#endif
                scan_ret_naive(F, item < 32 ? item : item - 32);
            }
        }
    }
}
#if (MK_GLOBAL_GROUPS & 4)
#pragma pop_macro("WSP")
#pragma pop_macro("WSW")
#pragma pop_macro("OUTP")
#endif
#if (MK_GLOBAL_GROUPS & 8)
#pragma push_macro("WSP")
#pragma push_macro("WSW")
#pragma push_macro("OUTP")
#undef WSP
#undef WSW
#undef OUTP
#define WSP WSPG
#define WSW WSWG
#define OUTP OUTPG
#endif
template <int CTRL> __device__ __forceinline__ float dppx(float x) { return __builtin_bit_cast(float, __builtin_amdgcn_update_dpp(0, __builtin_bit_cast(int, x), CTRL, 0xF, 0xF, true)); }
__device__ __forceinline__ void ph_post(Frame& F, ArgP A, int l) {
    const int gw = F.vcu * NWAVES + F.wave, NGW = F.G * NWAVES, lane = F.lane, c0 = lane * 16;
    f32x4 gg[4], gb[4], lg[4], lb[4];
#pragma unroll
    for (int j = 0; j < 4; ++j) { gg[j] = *(const GAS f32x4*)(INP(A, 4) + (size_t)l * RETW + c0 + 4 * j); gb[j] = *(const GAS f32x4*)(INP(A, 5) + (size_t)l * RETW + c0 + 4 * j);
        lg[j] = *(const GAS f32x4*)(INP(A, 15) + (size_t)l * RWW + c0 + 4 * j); lb[j] = *(const GAS f32x4*)(INP(A, 16) + (size_t)l * RWW + c0 + 4 * j); }
    for (int m = gw; m < M; m += NGW) {
        {
            f32x4 y[4]; float s = 0.f;
#pragma unroll
            for (int j = 0; j < 4; ++j) { y[j] = *(const GAS f32x4*)(WSP(float, WS_YRAWR) + (size_t)m * RETW + c0 + 4 * j); s += (y[j].x + y[j].y) + (y[j].z + y[j].w); }
            const GAS bf16* zg = (const GAS bf16*)(WSP(bf16, WS_Z) + (size_t)m * INW + ZC_GR + c0);
            float g[16]; { float t[8]; unpack8(*(const GAS v4u*)zg, t);
#pragma unroll
                for (int j = 0; j < 8; ++j) g[j] = t[j]; unpack8(*(const GAS v4u*)(zg + 8), t);
#pragma unroll
                for (int j = 0; j < 8; ++j) g[8 + j] = t[j]; }
            s += dppx<0xB1>(s); s += dppx<0x4E>(s); s += dppx<0x141>(s);
            const float mean = s * (1.f / RD); float q = 0.f;
#pragma unroll
            for (int j = 0; j < 4; ++j) { y[j] = y[j] - mean; q += (y[j].x * y[j].x + y[j].y * y[j].y) + (y[j].z * y[j].z + y[j].w * y[j].w); }
            q += dppx<0xB1>(q); q += dppx<0x4E>(q); q += dppx<0x141>(q);
            const float rstd = __builtin_amdgcn_rsqf(q * (1.f / RD) + RET_GN_EPS);
            float o[16];
#pragma unroll
            for (int j = 0; j < 4; ++j)
#pragma unroll
                for (int k = 0; k < 4; ++k) { const float gr = g[4 * j + k]; o[4 * j + k] = (y[j][k] * rstd * gg[j][k] + gb[j][k]) * (gr * fsig(gr)); }
            GAS bf16* yo = (GAS bf16*)(WSP(bf16, WS_YRET) + (size_t)m * RETW + c0);
            { float t[8];
#pragma unroll
              for (int j = 0; j < 8; ++j) t[j] = o[j]; *(GAS bf16x8*)yo = pack8(t);
#pragma unroll
              for (int j = 0; j < 8; ++j) t[j] = o[8 + j]; *(GAS bf16x8*)(yo + 8) = pack8(t); }
        }
        {
            const size_t ob = (size_t)m * RWW + c0;
            f32x4 y[4]; float s = 0.f;
#pragma unroll
            for (int j = 0; j < 4; ++j) { y[j] = *(const GAS f32x4*)(WSP(float, WS_YRAWW) + ob + 4 * j); s += (y[j].x + y[j].y) + (y[j].z + y[j].w); }
            f32x4 vv[4], gt[4];
#pragma unroll
            for (int j = 0; j < 4; ++j) { vv[j] = *(const GAS f32x4*)(WSP(float, WS_SV) + ob + 4 * j); gt[j] = *(const GAS f32x4*)(WSP(float, WS_G) + ob + 4 * j); }
            const float bonus = *(const GAS float*)(WSP(float, WS_BONUS) + (size_t)m * WH + (lane >> 2));
            s += dppx<0xB1>(s); s += dppx<0x4E>(s);
            const float mean = s * (1.f / WD); float q = 0.f;
#pragma unroll
            for (int j = 0; j < 4; ++j) { y[j] = y[j] - mean; q += (y[j].x * y[j].x + y[j].y * y[j].y) + (y[j].z * y[j].z + y[j].w * y[j].w); }
            q += dppx<0xB1>(q); q += dppx<0x4E>(q);
            const float rstd = __builtin_amdgcn_rsqf(q * (1.f / WD) + RWKV_LN_EPS);
            float o[16];
#pragma unroll
            for (int j = 0; j < 4; ++j)
#pragma unroll
                for (int k = 0; k < 4; ++k) o[4 * j + k] = (y[j][k] * rstd * lg[j][k] + lb[j][k] + bonus * vv[j][k]) * gt[j][k];
            GAS bf16* yo = (GAS bf16*)(WSP(bf16, WS_YRWKV) + ob);
            { float t[8];
#pragma unroll
              for (int j = 0; j < 8; ++j) t[j] = o[j]; *(GAS bf16x8*)yo = pack8(t);
#pragma unroll
              for (int j = 0; j < 8; ++j) t[j] = o[8 + j]; *(GAS bf16x8*)(yo + 8) = pack8(t); }
        }
    }
}
__device__ __forceinline__ void ph_final(Frame& F, ArgP A) {
    const int gw = F.vcu * NWAVES + F.wave, NGW = F.G * NWAVES, lane = F.lane;
    const GAS f32x4* gr = (const GAS f32x4*)INP(A, 23) + lane;
    for (int m = gw; m < M; m += NGW) {
        GAS f32x4* xr = (GAS f32x4*)(OUTP + (size_t)m * D) + lane;
        f32x4 v[8]; float s = 0.f;
#pragma unroll
        for (int j = 0; j < 8; ++j) { v[j] = xr[64 * j]; s += (v[j].x * v[j].x + v[j].y * v[j].y) + (v[j].z * v[j].z + v[j].w * v[j].w); }
        const float rstd = 1.f / sqrtf(wave_sum(s) * (1.f / D) + NORM_EPS);
#pragma unroll
        for (int j = 0; j < 8; ++j) xr[64 * j] = v[j] * rstd * gr[64 * j];
    }
}
#if (MK_GLOBAL_GROUPS & 8)
#pragma pop_macro("WSP")
#pragma pop_macro("WSW")
#pragma pop_macro("OUTP")
#endif

__global__ void __launch_bounds__(NWAVES * 64, 2) hybrid_fwd(Args args) {
    extern __shared__ __attribute__((aligned(16))) unsigned char lds[];
    Frame F;
    F.lds = (LAS unsigned char*)lds;
    F.MISC = (volatile LAS unsigned*)(F.lds + MISC_OFF);
    F.tid = threadIdx.x; F.lane = F.tid & 63; F.wave = __builtin_amdgcn_readfirstlane(F.tid >> 6);
    int bx = blockIdx.x; F.G = gridDim.x; { F.vcu = (F.G % 8 == 0) ? (bx % 8) * (F.G / 8) + bx / 8 : bx; }
    F.ws = args.ws; F.out = args.out;
    for (int u = F.tid; u < (LDS_BYTES - LDSCTL_OFF) / 4; u += NWAVES * 64) ((LAS unsigned*)(F.lds + LDSCTL_OFF))[u] = 0u;
    __syncthreads();
    if (F.tid == 0) { volatile LAS unsigned* U = (volatile LAS unsigned*)(F.lds + MISC_OFF) + 16; const unsigned long long pw = (unsigned long long)args.ws, po = (unsigned long long)args.out, pa = (unsigned long long)__builtin_amdgcn_kernarg_segment_ptr();
        U[0] = (unsigned)pw; U[1] = (unsigned)(pw >> 32); U[2] = (unsigned)po; U[3] = (unsigned)(po >> 32); U[4] = (unsigned)pa; U[5] = (unsigned)(pa >> 32); U[6] = (unsigned)F.G; U[7] = (unsigned)F.vcu; U[8] = (unsigned)bx; }
    __syncthreads();
    XcdBarrier bar = xcd_barrier_post((unsigned*)(F.ws + WS_CTL) + CW_BAR, F.MISC + 8);

    ArgP ap = (ArgP)__builtin_amdgcn_kernarg_segment_ptr();
    const int lo = args.ph_lo, hi = args.ph_hi;
#define REPX(bit, body) do { body; if (MK_REP & (bit)) { __syncthreads(); body; } } while (0)
#define IN(k) (lo <= (k) && (k) < hi)
#define SEAM(k) do { if (IN(k) && IN((k) + 1)) xcd_barrier(bar); else __syncthreads(); } while (0)

    if (IN(PH_PRO)) { ph_prologue(F, ap); ph_convert(F, ap, 0, F.vcu, F.G); }
    SEAM(PH_PRO);
    for (int l = 0; l < DEPTH; ++l) {
        const int p0 = PH_L0 + l * PPL;
        RETID();
        { unsigned ba = MISC_OFF + 64; asm volatile("" : "+v"(ba));
          const volatile LAS v4u* U = (const volatile LAS v4u*)(F.lds + ba);
          const v4u ua = U[0], ub = U[1]; const unsigned uc = *(const volatile LAS unsigned*)(U + 2);
          const unsigned u0 = __builtin_amdgcn_readfirstlane(ua.x), u1 = __builtin_amdgcn_readfirstlane(ua.y), u2 = __builtin_amdgcn_readfirstlane(ua.z), u3 = __builtin_amdgcn_readfirstlane(ua.w);
          const unsigned u4 = __builtin_amdgcn_readfirstlane(ub.x), u5 = __builtin_amdgcn_readfirstlane(ub.y), u6 = __builtin_amdgcn_readfirstlane(ub.z), u7 = __builtin_amdgcn_readfirstlane(ub.w), u8 = __builtin_amdgcn_readfirstlane(uc);
          F.ws = (unsigned char*)(((unsigned long long)u1 << 32) | u0); F.out = (float*)(((unsigned long long)u3 << 32) | u2); ap = (ArgP)(((unsigned long long)u5 << 32) | u4);
          F.G = (int)u6; F.vcu = (int)u7; bx = (int)u8; F.wave = __builtin_amdgcn_readfirstlane(F.tid >> 6); }
        if (IN(p0 + LP_G1)) {
            pg8::Gemm g{WSPG(bf16, WS_H), WSWG(l, WO_WIN), M, INW, D}; pg8::StaticOrder S; S.init(M, INW, F.G, bx);
            pg8::EpiB<0> E{WSPG(bf16, WS_Z), INW, nullptr, 0, WSPG(float, WS_SS)};
            pg8::gemm_phase<pg8::EpiB<0>, pg8::StaticOrder, true, true>(F.lds + RING_OFF, g, S, E);
        }
        SEAM(p0 + LP_G1);
        if (IN(p0 + LP_PREP)) { RETID(); REPX(4, ph_prep(F, ap, l)); }
        SEAM(p0 + LP_PREP);
        if (IN(p0 + LP_SCAN)) { RETID(); REPX(8, ph_scan(F, ap, l)); }
        SEAM(p0 + LP_SCAN);
        if (IN(p0 + LP_POST)) { RETID(); REPX(16, ph_post(F, ap, l)); }
        SEAM(p0 + LP_POST);
        if (IN(p0 + LP_GA)) {
            pg8::Gemm g{WSPG(bf16, WS_YRET), WSWG(l, WO_WA), M, D, RETW}; pg8::StaticOrder S; S.init(M, D, F.G, bx);
            pg8::EpiB<2> E{WSPG(bf16, WS_MRG), D, WSPG(bf16, WS_Z) + ZC_GA, INW, nullptr};
            pg8::gemm_phase<pg8::EpiB<2>, pg8::StaticOrder, true, true>(F.lds + RING_OFF, g, S, E);
        }
        __syncthreads();
        if (IN(p0 + LP_GB)) {
            pg8::Gemm g{WSPG(bf16, WS_YRWKV), WSWG(l, WO_WB), M, D, RWW}; pg8::StaticOrder S; S.init(M, D, F.G, bx);
            pg8::EpiB<3> E{WSPG(bf16, WS_MRG), D, WSPG(bf16, WS_Z) + ZC_GB, INW, nullptr};
            pg8::gemm_phase<pg8::EpiB<3>, pg8::StaticOrder, true, true>(F.lds + RING_OFF, g, S, E);
        }
        SEAM(p0 + LP_GB);
        if (IN(p0 + LP_GO)) {
            pg8::Gemm g{WSPG(bf16, WS_MRG), WSWG(l, WO_WO), M, D, D}; pg8::StaticOrder S; S.init(M, D, F.G, bx);
            pg8::EpiResNorm E{OUTPG, D, WSPG(bf16, WS_H), WSPG(float, WS_SS)};
            pg8::gemm_phase<pg8::EpiResNorm, pg8::StaticOrder, true, true>(F.lds + RING_OFF, g, S, E);
        }
        SEAM(p0 + LP_GO);
        if (IN(p0 + LP_GUP)) {
            pg8::Gemm g{WSPG(bf16, WS_H), WSWG(l, WO_WUP), M, DFF, D}; pg8::StaticOrder S; S.init(M, DFF, F.G, bx);
            pg8::EpiB<1> E{WSPG(bf16, WS_UP), DFF, nullptr, 0, WSPG(float, WS_SS)};
            pg8::gemm_phase<pg8::EpiB<1>, pg8::StaticOrder, true, true>(F.lds + RING_OFF, g, S, E);
        }
        SEAM(p0 + LP_GUP);
        if (IN(p0 + LP_GDN)) {
            pg8::Gemm g{WSPG(bf16, WS_UP), WSWG(l, WO_WDN), M, D, DFF}; pg8::StaticOrder S; S.init(M, D, F.G, bx);
            pg8::EpiResNorm E{OUTPG, D, WSPG(bf16, WS_H), WSPG(float, WS_SS)};
            pg8::gemm_phase<pg8::EpiResNorm, pg8::StaticOrder, true, true>(F.lds + RING_OFF, g, S, E);
        }
        SEAM(p0 + LP_GDN);
    }
    if (IN(PH_FIN)) { RETID(); ph_final(F, ap); }
#undef IN
#undef SEAM
}

extern "C" void kernel_launch(void* const* d_in, const int* in_sizes, int n_in, void* d_out, int out_size, void* d_ws, size_t ws_size, hipStream_t stream) {
    static int grid = 0;
    if (grid == 0) {
        if (n_in != 24 || in_sizes[0] != M * D || out_size != M * D || ws_size < WS_END) { fprintf(stderr, "kernel_launch: built for 24 inputs, x and out of %d floats, >= %zu bytes of workspace; got n_in %d, in0 %d, out %d, ws %zu; nothing launched\n", M * D, (size_t)WS_END, n_in, n_in > 0 ? in_sizes[0] : -1, out_size, ws_size); grid = -1; return; }
        int dev = 0, cus = 0, per_cu = 0;
        if (hipGetDevice(&dev) != hipSuccess || hipDeviceGetAttribute(&cus, hipDeviceAttributeMultiprocessorCount, dev) != hipSuccess) { fprintf(stderr, "kernel_launch: hipGetDevice / hipDeviceGetAttribute failed; nothing launched\n"); grid = -1; return; }
        if (hipFuncSetAttribute((const void*)hybrid_fwd, hipFuncAttributeMaxDynamicSharedMemorySize, LDS_BYTES) != hipSuccess) { fprintf(stderr, "kernel_launch: hipFuncSetAttribute failed\n"); grid = -1; return; }
        if (hipOccupancyMaxActiveBlocksPerMultiprocessor(&per_cu, (const void*)hybrid_fwd, NWAVES * 64, LDS_BYTES) != hipSuccess || per_cu < 1)
            fprintf(stderr, "kernel_launch: note: the occupancy query reports %d workgroups per CU\n", per_cu);
        (void)hipGetLastError();
        grid = cus;
    }
    if (grid < 0) return;
    if (hipMemsetAsync((char*)d_ws + WS_CTL, 0, CTL_ZERO_BYTES, stream) != hipSuccess) { fprintf(stderr, "kernel_launch: hipMemsetAsync failed\n"); return; }
    Args a{};
    for (int i = 0; i < 24; ++i) a.in[i] = (const float*)d_in[i];
    a.out = (float*)d_out; a.ws = (unsigned char*)d_ws; a.li = 0; a.pad = 0;
#if MK_ONE_LAUNCH
    a.ph_lo = 0; a.ph_hi = NPH;
    hipLaunchKernelGGL(hybrid_fwd, dim3(grid), dim3(NWAVES * 64), LDS_BYTES, stream, a);
#else
    for (int p = 0; p < NPH; ++p) {
        a.ph_lo = p; a.ph_hi = p + 1;
        hipLaunchKernelGGL(hybrid_fwd, dim3(grid), dim3(NWAVES * 64), LDS_BYTES, stream, a);
    }
#endif
    const hipError_t le = hipPeekAtLastError();
    if (le != hipSuccess) fprintf(stderr, "kernel_launch: launch failed: %s\n", hipGetErrorName(le));
}
```

```cpp
#include <hip/hip_runtime.h>
#include <cstdio>
#include <cstdint>
#ifndef MK_GLOBAL_GROUPS
#define MK_GLOBAL_GROUPS 30
#endif
#ifndef MK_REP
#define MK_REP 0
#endif
namespace pg8 {
#define PG8_LAS __attribute__((address_space(3)))
typedef unsigned short bf16_t;
typedef short bf16x8 __attribute__((ext_vector_type(8)));
typedef float f32x4 __attribute__((ext_vector_type(4)));
typedef unsigned u32x4 __attribute__((ext_vector_type(4)));
constexpr int BM = 256, BK = 64, HALF = 128, HTB = HALF * BK * 2  , STAGE_BYTES = 8 * HTB, NXCD = 8, WGM = 8;

__host__ __device__ __forceinline__ int lds_byte(int r, int c) { const int st = (r >> 4) * 2 + (c >> 5), rr = r & 15, cc = c & 31, ob = rr * 64 + cc * 2; return st * 1024 + (ob ^ (((ob >> 9) & 1) << 5)); }
__host__ __device__ __forceinline__ void stage_rc(int b, int& R, int& C) { const int st = b / 1024, sb = b % 1024, swz = sb ^ (((sb >> 9) & 1) << 5); R = (st >> 1) * 16 + swz / 64; C = (st & 1) * 32 + (swz % 64) / 2; }
__host__ __device__ __forceinline__ int perm32(int rho) { const int n = rho >> 4, i = rho & 15; return 8 * (i >> 2) + 4 * n + (i & 3); }

struct Unit { int pm, pn; };
struct Gemm { const bf16_t* A; const bf16_t* Bt; int M, N, K; };

struct StaticOrder {
    int nM, nN, nwg, G, c;
    __host__ __device__ void init(int M, int N, int G_, int c_) { nM = M / BM; nN = N / BM; nwg = nM * nN; G = G_; c = c_; }
    __host__ __device__ bool next(int i, Unit& u) const {
        const long L = (long)i * G + c; if (L >= nwg) return false;
        int wgid = (int)L; { const int q = nwg / NXCD, r = nwg % NXCD, xcd = wgid % NXCD, off = wgid / NXCD; wgid = (xcd < r ? xcd * (q + 1) : r * (q + 1) + (xcd - r) * q) + off; }
        const int nig = WGM * nN, gid = wgid / nig, fm = gid * WGM, gsz = (nM - fm) < WGM ? (nM - fm) : WGM;
        u.pm = fm + ((wgid % nig) % gsz); u.pn = (wgid % nig) / gsz; return true;
    }
    __device__ __forceinline__ void a_ready(const Unit&) const {}
    __device__ __forceinline__ void done(const Unit&) const {}
};

typedef float f32x2c __attribute__((ext_vector_type(2))); typedef __bf16 bf16x2c __attribute__((ext_vector_type(2)));
__device__ __forceinline__ unsigned cvt_pk_bf16(float lo, float hi) { const f32x2c v = {lo, hi}; return __builtin_bit_cast(unsigned, __builtin_convertvector(v, bf16x2c)); }
typedef float f32x2 __attribute__((ext_vector_type(2)));
__device__ __forceinline__ float bf_lo(unsigned w) { return __builtin_bit_cast(float, w << 16); }
__device__ __forceinline__ float bf_hi(unsigned w) { return __builtin_bit_cast(float, w & 0xffff0000u); }
__device__ __forceinline__ float sigmoidf_(float x) { return 1.0f / (1.0f + __expf(-x)); }
template <int MODE> struct EpiB {
    static constexpr bool PERM = true, AFTER_DRAIN = false;
    bf16_t* O; int ldc; const bf16_t* gate; int ldg; const float* ss;
    __device__ __forceinline__ void operator()(const f32x4 (&acc)[2][2][4][2], const Unit& u, int wr, int wc, int fr, int fq) const {
        const int row0 = u.pm * BM + wr * 64 + fr, col0 = u.pn * BM + wc * 32 + 8 * fq;
        float rs[2][4];
        for (int rep_ = 0; rep_ < ((MK_REP & 128) ? 2 : 1); ++rep_) { asm volatile("" ::: "memory");
        if (MODE <= 1) {
            typedef __attribute__((address_space(1))) const f32x4 gf4;
            f32x4 q[2][4][2];
#pragma unroll
            for (int ai = 0; ai < 2; ++ai)
#pragma unroll
                for (int m = 0; m < 4; ++m) { gf4* sp = (gf4*)(ss + (size_t)(row0 + ai * HALF + m * 16) * 32) + fq * 2; q[ai][m][0] = sp[0]; q[ai][m][1] = sp[1]; }
#pragma unroll
            for (int ai = 0; ai < 2; ++ai)
#pragma unroll
                for (int m = 0; m < 4; ++m) { const f32x4 a = q[ai][m][0] + q[ai][m][1]; rs[ai][m] = (a[0] + a[1]) + (a[2] + a[3]); }
#pragma unroll
            for (int ai = 0; ai < 2; ++ai)
#pragma unroll
                for (int m = 0; m < 4; ++m) rs[ai][m] += __shfl_xor(rs[ai][m], 16);
#pragma unroll
            for (int ai = 0; ai < 2; ++ai)
#pragma unroll
                for (int m = 0; m < 4; ++m) { rs[ai][m] += __shfl_xor(rs[ai][m], 32); rs[ai][m] = __builtin_amdgcn_rsqf(rs[ai][m] * (1.0f / 2048.0f) + 1e-6f); }
        }
        if (MK_REP & 128) asm volatile("" : "+v"(rs[0][0]), "+v"(rs[1][3]) :: "memory"); }
#pragma unroll
        for (int ai = 0; ai < 2; ++ai)
#pragma unroll
            for (int m = 0; m < 4; ++m) { const size_t row = (size_t)(row0 + ai * HALF + m * 16);
#pragma unroll
                for (int bj = 0; bj < 2; ++bj) { f32x4 v0 = acc[ai][bj][m][0], v1 = acc[ai][bj][m][1]; const int c = col0 + bj * HALF;
                    if (MODE <= 1) { v0 = v0 * rs[ai][m]; v1 = v1 * rs[ai][m]; }
                    if (MODE == 1) {
#pragma unroll
                        for (int j = 0; j < 4; ++j) { const float a = fmaxf(v0[j], 0.f), b = fmaxf(v1[j], 0.f); v0[j] = a * a; v1[j] = b * b; } }
                    if (MODE >= 2) { const u32x4 g = *(const u32x4*)(gate + row * ldg + c);
                        v0[0] *= sigmoidf_(bf_lo(g.x)); v0[1] *= sigmoidf_(bf_hi(g.x)); v0[2] *= sigmoidf_(bf_lo(g.y)); v0[3] *= sigmoidf_(bf_hi(g.y));
                        v1[0] *= sigmoidf_(bf_lo(g.z)); v1[1] *= sigmoidf_(bf_hi(g.z)); v1[2] *= sigmoidf_(bf_lo(g.w)); v1[3] *= sigmoidf_(bf_hi(g.w)); }
                    if (MODE == 3) { const u32x4 o = *(const u32x4*)(O + row * ldc + c);
                        v0[0] += bf_lo(o.x); v0[1] += bf_hi(o.x); v0[2] += bf_lo(o.y); v0[3] += bf_hi(o.y);
                        v1[0] += bf_lo(o.z); v1[1] += bf_hi(o.z); v1[2] += bf_lo(o.w); v1[3] += bf_hi(o.w); }
                    u32x4 w; w.x = cvt_pk_bf16(v0[0], v0[1]); w.y = cvt_pk_bf16(v0[2], v0[3]); w.z = cvt_pk_bf16(v1[0], v1[1]); w.w = cvt_pk_bf16(v1[2], v1[3]);
                    *(u32x4*)(O + row * ldc + c) = w; } }
    }
};
struct EpiResNorm {
    static constexpr bool PERM = true, AFTER_DRAIN = false;
    float* X; int ldc; bf16_t* XB; float* SS;
    __device__ __forceinline__ void operator()(const f32x4 (&acc)[2][2][4][2], const Unit& u, int wr, int wc, int fr, int fq) const {
        const int row0 = u.pm * BM + wr * 64 + fr, col0 = u.pn * BM + wc * 32 + 8 * fq;
#pragma unroll
        for (int ai = 0; ai < 2; ++ai)
#pragma unroll
            for (int m = 0; m < 4; ++m) { const size_t row = (size_t)(row0 + ai * HALF + m * 16);
                float s = 0.f;
#pragma unroll
                for (int bj = 0; bj < 2; ++bj) { const int c = col0 + bj * HALF; float* p = X + row * ldc + c;
                    const f32x4 x0 = *(const f32x4*)p + acc[ai][bj][m][0], x1 = *(const f32x4*)(p + 4) + acc[ai][bj][m][1];
                    *(f32x4*)p = x0; *(f32x4*)(p + 4) = x1;
                    u32x4 w; w.x = cvt_pk_bf16(x0[0], x0[1]); w.y = cvt_pk_bf16(x0[2], x0[3]); w.z = cvt_pk_bf16(x1[0], x1[1]); w.w = cvt_pk_bf16(x1[2], x1[3]);
                    *(u32x4*)(XB + row * ldc + c) = w;
                    s += ((x0[0] * x0[0] + x0[1] * x0[1]) + (x0[2] * x0[2] + x0[3] * x0[3])) + ((x1[0] * x1[0] + x1[1] * x1[1]) + (x1[2] * x1[2] + x1[3] * x1[3])); }
                s += __shfl_xor(s, 16); s += __shfl_xor(s, 32);
                if (fq == 0) SS[row * 32 + u.pn * 4 + wc] = s; }
    }
};

template <class Epi, class Sched, bool ALIGN_EPI = false, bool SP2 = false>
__device__ __forceinline__ void gemm_phase(PG8_LAS unsigned char* lds, const Gemm g, const Sched& S, const Epi& E) {
    int tid_ = threadIdx.x; asm volatile("" : "+v"(tid_));
    const int tid = tid_, wid = __builtin_amdgcn_readfirstlane(tid >> 6), lane = tid & 63, wr = wid >> 2, wc = wid & 3, fr = lane & 15, fq = lane >> 4;
    const int K = g.K, nt = K / BK;
    unsigned voffA[2], voffB[2];
#pragma unroll
    for (int i = 0; i < 2; ++i) { int R, C; stage_rc(tid * 16 + i * 8192, R, C); const int Rb = Epi::PERM ? ((R & ~31) + perm32(R & 31)) : R;
        voffA[i] = (unsigned)(R * K + C) * 2u; voffB[i] = (unsigned)(Rb * K + C) * 2u; }
    const size_t kstep = (size_t)(BK * 2);
    const size_t hstep = (size_t)HALF * K * 2;
    const size_t tstep = 2 * hstep;
    const unsigned ldsw = (unsigned)wid * 1024u;
    const int aoff = lds_byte(wr * 64 + fr, fq * 8), boff = lds_byte(wc * 32 + fr, fq * 8);
#define PG8_SA(b, h) (((b) * 2 + (h)) * HTB)
#define PG8_SB(b, h) ((4 + (b) * 2 + (h)) * HTB)
#define PG8_STAGE(bufoff, gbase, voff) do { _Pragma("unroll") for (int _i = 0; _i < 2; ++_i) \
        __builtin_amdgcn_global_load_lds((const unsigned*)((const char*)(gbase) + (voff)[_i]), (PG8_LAS unsigned*)(lds + (bufoff) + ldsw + _i * 8192), 16, 0, 0); } while (0)
#define PG8_LDA(dst, b, h) do { _Pragma("unroll") for (int m = 0; m < 4; ++m) _Pragma("unroll") for (int k = 0; k < 2; ++k) dst[m][k] = *(const PG8_LAS bf16x8*)(lds + PG8_SA(b, h) + aoff + m * 2048 + k * 1024); } while (0)
#define PG8_LDB(dst, b, h) do { _Pragma("unroll") for (int n = 0; n < 2; ++n) _Pragma("unroll") for (int k = 0; k < 2; ++k) dst[n][k] = *(const PG8_LAS bf16x8*)(lds + PG8_SB(b, h) + boff + n * 2048 + k * 1024); } while (0)
#define PG8_MMA(ai, bj, At, Bt) do { __builtin_amdgcn_s_setprio(1); _Pragma("unroll") for (int m = 0; m < 4; ++m) _Pragma("unroll") for (int n = 0; n < 2; ++n) _Pragma("unroll") for (int k = 0; k < 2; ++k) \
        acc[ai][bj][m][n] = __builtin_amdgcn_mfma_f32_16x16x32_bf16(Bt[n][k], At[m][k], acc[ai][bj][m][n], 0, 0, 0); __builtin_amdgcn_s_setprio(0); } while (0)
#define PG8_WAIT_V(n) asm volatile("s_waitcnt vmcnt(" #n ")" ::: "memory")
#define PG8_WAIT_L(n) asm volatile("s_waitcnt lgkmcnt(" #n ")" ::: "memory")
#define PG8_BAR __builtin_amdgcn_s_barrier()
#define PG8_SCHED __builtin_amdgcn_sched_barrier(0)
    Unit cur, nxt; int ui = 0;
    if (!S.next(0, cur)) return;
    f32x4 acc[2][2][4][2];
#pragma unroll
    for (int a = 0; a < 2; ++a)
#pragma unroll
        for (int b = 0; b < 2; ++b)
#pragma unroll
            for (int m = 0; m < 4; ++m)
#pragma unroll
                for (int n = 0; n < 2; ++n) acc[a][b][m][n] = (f32x4){0.f, 0.f, 0.f, 0.f};
    bf16x8 At[4][2], B0[2][2], B1[2][2];
    const char* cA = (const char*)g.A + (size_t)cur.pm * tstep; const char* cB = (const char*)g.Bt + (size_t)cur.pn * tstep;
    S.a_ready(cur);
    if constexpr (SP2) {
        PG8_STAGE(PG8_SB(0, 0), cB, voffB); PG8_STAGE(PG8_SB(0, 1), cB + hstep, voffB); PG8_STAGE(PG8_SA(0, 0), cA, voffA); PG8_STAGE(PG8_SA(0, 1), cA + hstep, voffA);
        if (wr == 1) PG8_BAR;
        PG8_WAIT_V(2); PG8_BAR;
        PG8_STAGE(PG8_SB(1, 0), cB + kstep, voffB); PG8_STAGE(PG8_SA(1, 0), cA + kstep, voffA); PG8_STAGE(PG8_SB(1, 1), cB + hstep + kstep, voffB);
        PG8_WAIT_V(6); PG8_BAR;
    } else {
        PG8_STAGE(PG8_SB(0, 0), cB, voffB); PG8_STAGE(PG8_SA(0, 0), cA, voffA); PG8_STAGE(PG8_SB(0, 1), cB + hstep, voffB); PG8_STAGE(PG8_SA(0, 1), cA + hstep, voffA);
        if (wr == 1) PG8_BAR;
        PG8_WAIT_V(4); PG8_BAR;
        PG8_STAGE(PG8_SB(1, 0), cB + kstep, voffB); PG8_STAGE(PG8_SA(1, 0), cA + kstep, voffA); PG8_STAGE(PG8_SB(1, 1), cB + hstep + kstep, voffB);
        PG8_WAIT_V(6); PG8_BAR;
    }
    for (;;) {
        const bool has_next = S.next(ui + 1, nxt);
        const char* nA = has_next ? (const char*)g.A + (size_t)nxt.pm * tstep : cA; const char* nB = has_next ? (const char*)g.Bt + (size_t)nxt.pn * tstep : cB;
        for (int t = 0; t < nt; t += 2) {
            const bool last = (t == nt - 2);
            const char* a1 = cA + (size_t)(t + 1) * kstep;
            const char* a2 = last ? nA : cA + (size_t)(t + 2) * kstep; const char* b2 = last ? nB : cB + (size_t)(t + 2) * kstep;
            const char* a3 = a2 + kstep; const char* b3 = b2 + kstep;
            if (last && has_next) S.a_ready(nxt);
            if constexpr (SP2) {
            PG8_LDB(B0, 0, 0); PG8_LDB(B1, 0, 1); PG8_SCHED; PG8_LDA(At, 0, 0); PG8_STAGE(PG8_SA(1, 1), a1 + hstep, voffA);
            PG8_WAIT_V(8); PG8_WAIT_L(0); PG8_BAR; PG8_MMA(0, 0, At, B0); PG8_MMA(0, 1, At, B1); PG8_BAR; PG8_SCHED;
            PG8_LDA(At, 0, 1); PG8_STAGE(PG8_SB(0, 0), b2, voffB); PG8_STAGE(PG8_SB(0, 1), b2 + hstep, voffB); PG8_STAGE(PG8_SA(0, 0), a2, voffA);
            PG8_WAIT_V(8); PG8_WAIT_L(0); PG8_BAR; PG8_MMA(1, 0, At, B0); PG8_MMA(1, 1, At, B1); PG8_BAR; PG8_SCHED;
            PG8_LDB(B0, 1, 0); PG8_LDB(B1, 1, 1); PG8_SCHED; PG8_LDA(At, 1, 0); PG8_STAGE(PG8_SA(0, 1), a2 + hstep, voffA);
            PG8_WAIT_V(8); PG8_WAIT_L(0); PG8_BAR; PG8_MMA(0, 0, At, B0); PG8_MMA(0, 1, At, B1); PG8_BAR; PG8_SCHED;
            PG8_LDA(At, 1, 1); PG8_STAGE(PG8_SB(1, 0), b3, voffB); PG8_STAGE(PG8_SB(1, 1), b3 + hstep, voffB); PG8_STAGE(PG8_SA(1, 0), a3, voffA);
            PG8_WAIT_V(8); PG8_WAIT_L(0); PG8_BAR; PG8_MMA(1, 0, At, B0); PG8_MMA(1, 1, At, B1); PG8_BAR; PG8_SCHED;
            } else {
            PG8_LDB(B0, 0, 0); PG8_SCHED; PG8_LDA(At, 0, 0); PG8_STAGE(PG8_SA(1, 1), a1 + hstep, voffA);
            PG8_WAIT_L(8); PG8_BAR; PG8_WAIT_L(0); PG8_MMA(0, 0, At, B0); PG8_BAR; PG8_SCHED;
            PG8_LDB(B1, 0, 1); PG8_STAGE(PG8_SB(0, 0), b2, voffB);
            PG8_BAR; PG8_WAIT_L(0); PG8_MMA(0, 1, At, B1); PG8_BAR;
            PG8_LDA(At, 0, 1); PG8_STAGE(PG8_SA(0, 0), a2, voffA);
            PG8_BAR; PG8_WAIT_L(0); PG8_MMA(1, 0, At, B0); PG8_BAR; PG8_SCHED;
            PG8_STAGE(PG8_SB(0, 1), b2 + hstep, voffB);
            PG8_WAIT_V(6); PG8_BAR; PG8_MMA(1, 1, At, B1); PG8_BAR;
            PG8_LDB(B0, 1, 0); PG8_SCHED; PG8_LDA(At, 1, 0); PG8_STAGE(PG8_SA(0, 1), a2 + hstep, voffA);
            PG8_WAIT_L(8); PG8_BAR; PG8_WAIT_L(0); PG8_MMA(0, 0, At, B0); PG8_BAR; PG8_SCHED;
            PG8_LDB(B1, 1, 1); PG8_STAGE(PG8_SB(1, 0), b3, voffB);
            PG8_BAR; PG8_WAIT_L(0); PG8_MMA(0, 1, At, B1); PG8_BAR;
            PG8_LDA(At, 1, 1); PG8_STAGE(PG8_SA(1, 0), a3, voffA);
            PG8_BAR; PG8_WAIT_L(0); PG8_MMA(1, 0, At, B0); PG8_BAR; PG8_SCHED;
            PG8_STAGE(PG8_SB(1, 1), b3 + hstep, voffB);
            PG8_WAIT_V(6); PG8_BAR; PG8_MMA(1, 1, At, B1); PG8_BAR;
            }
        }
        if constexpr (ALIGN_EPI) { if (wr == 0) PG8_BAR; }
        if constexpr (!Epi::AFTER_DRAIN) { E(acc, cur, wr, wc, fr, fq); S.done(cur); }
        if (!has_next) break;
#pragma unroll
        for (int a = 0; a < 2; ++a)
#pragma unroll
            for (int b = 0; b < 2; ++b)
#pragma unroll
                for (int m = 0; m < 4; ++m)
#pragma unroll
                    for (int n = 0; n < 2; ++n) acc[a][b][m][n] = (f32x4){0.f, 0.f, 0.f, 0.f};
        cur = nxt; cA = nA; cB = nB; ++ui;
        if constexpr (ALIGN_EPI) { if (wr == 1) PG8_BAR; }
    }
    PG8_WAIT_V(0);
    if constexpr (!ALIGN_EPI) { if (wr == 0) PG8_BAR; }
    PG8_BAR;
    if constexpr (Epi::AFTER_DRAIN) { E.fused(acc, cur, wr, wc, fr, fq, lds, wid, lane); S.done(cur); }
#undef PG8_SA
#undef PG8_SB
#undef PG8_STAGE
#undef PG8_LDA
#undef PG8_LDB
#undef PG8_MMA
#undef PG8_WAIT_V
#undef PG8_WAIT_L
#undef PG8_BAR
#undef PG8_SCHED
}
}
constexpr int NWAVES = 8;
#ifndef MK_ONE_LAUNCH
#define MK_ONE_LAUNCH 1
#endif

#ifndef MK_GLOBAL_GROUPS
#define MK_GLOBAL_GROUPS 30
#endif
#ifndef MK_CHUNKED
#define MK_CHUNKED 1
#endif
#ifndef MK_REP
#define MK_REP 0
#endif

constexpr int BATCH = 2, SEQ = 8192, D = 2048, DEPTH = 4, M = BATCH * SEQ;
constexpr int RETW = 1024, RH = 8, RD = 128, RWW = 1024, WH = 16, WD = 64;
constexpr int INW = 11520, DFF = 8192, RWSHIFT = 3328;
constexpr int ZC_Q = 0, ZC_K = 1024, ZC_V = 2048, ZC_GR = 3072, ZC_RW = 4096, ZC_GA = 7424, ZC_GB = 9472;
constexpr int RWC_R = 0, RWC_K = 1024, RWC_V = 2048, RWC_W = 3072, RWC_A = 3136, RWC_G = 3200;
constexpr float NORM_EPS = 1e-6f, RET_GN_EPS = 1e-5f, RWKV_LN_EPS = 64e-5f;

constexpr size_t MiB = 1u << 20;
constexpr size_t WS_CTL = 0, CTL_ZERO_BYTES = 1 * MiB;
constexpr size_t WS_ROPE = 1 * MiB;
constexpr size_t WS_WSET = 16 * MiB, WSET_BYTES = 126 * MiB;
constexpr size_t WO_WIN = 0, WO_WA = 45 * MiB, WO_WB = 49 * MiB, WO_WO = 53 * MiB, WO_WUP = 61 * MiB, WO_WDN = 93 * MiB, WO_LORA = 125 * MiB;
constexpr size_t WS_H = 272 * MiB;
constexpr size_t WS_Z = 336 * MiB;
constexpr size_t WS_UP = WS_Z;
constexpr size_t WS_QR = 696 * MiB, WS_KR = 728 * MiB;
constexpr size_t WS_YRET = 760 * MiB, WS_YRWKV = 792 * MiB;
constexpr size_t WS_MRG = 824 * MiB;
#if MK_CHUNKED
constexpr size_t WS_SR = 888 * MiB, WS_SV = 1208 * MiB;
#else
constexpr size_t WS_SR = 888 * MiB, WS_SW = 952 * MiB, WS_SK = 1016 * MiB, WS_SV = 1080 * MiB, WS_SNKK = 1144 * MiB, WS_SKKA = 1208 * MiB;
#endif
constexpr size_t WS_CU = WS_SR;
constexpr size_t WS_G = 1272 * MiB;
constexpr size_t WS_BONUS = 1336 * MiB;
constexpr size_t WS_SS = 1337 * MiB;
constexpr size_t WS_YRAWR = WS_H, WS_YRAWW = WS_MRG;
constexpr size_t WS_END = 1341 * MiB;
constexpr int CW_BAR = 4096;

constexpr int PPL = 9;
enum { LP_G1 = 0, LP_PREP, LP_SCAN, LP_POST, LP_GA, LP_GB, LP_GO, LP_GUP, LP_GDN };
constexpr int PH_PRO = 0, PH_L0 = 1, PH_FIN = PH_L0 + DEPTH * PPL, NPH = PH_FIN + 1;

constexpr int RING_OFF = 0, RING_BYTES = 131072;
constexpr int LDSCTL_OFF = RING_BYTES, MISC_OFF = LDSCTL_OFF + 320;
constexpr int LDS_BYTES = 147456;
static_assert(MISC_OFF + 128 <= LDS_BYTES, "LDS map");

#define GAS __attribute__((address_space(1)))
#define LAS __attribute__((address_space(3)))
typedef unsigned short bf16;
typedef unsigned v4u __attribute__((ext_vector_type(4)));
typedef unsigned v2u __attribute__((ext_vector_type(2)));
typedef float f32x4 __attribute__((ext_vector_type(4)));
typedef float f32x2 __attribute__((ext_vector_type(2)));
typedef short bf16x8 __attribute__((ext_vector_type(8)));
typedef GAS unsigned gu32;
#define LDS_WAIT() asm volatile("s_waitcnt lgkmcnt(0)" ::: "memory")
#define VM_WAIT() asm volatile("s_waitcnt vmcnt(0)" ::: "memory")
__device__ __forceinline__ unsigned f2bf(float f) { unsigned u = __builtin_bit_cast(unsigned, f); return (u + 0x7fffu + ((u >> 16) & 1u)) >> 16; }
__device__ __forceinline__ unsigned pk2(float lo, float hi) { return f2bf(lo) | (f2bf(hi) << 16); }
__device__ __forceinline__ float bf2f(bf16 v) { return __builtin_bit_cast(float, (unsigned)v << 16); }
__device__ __forceinline__ float rdlane(float v, int l) { return __builtin_bit_cast(float, __builtin_amdgcn_readlane(__builtin_bit_cast(int, v), l)); }
__device__ __forceinline__ float sigm(float x) { return 1.0f / (1.0f + expf(-x)); }

__device__ const double ROPE_REV[64] = {
0.15915494309189535, 0.13782250260398285, 0.11934937021124886, 0.10335229661843406,
0.08949940160889101, 0.07750328875537406, 0.06711508300522726, 0.058119267441876246,
0.050329212104487035, 0.04358330210530733, 0.03774158471741977, 0.032682865872357,
0.0283021958306234, 0.024508691862069852, 0.02122365276477766, 0.018378926105679667,
0.015915494309189534, 0.013782250260398284, 0.011934937021124886, 0.010335229661843406,
0.008949940160889102, 0.0077503288755374055, 0.006711508300522725, 0.005811926744187624,
0.005032921210448704, 0.004358330210530733, 0.003774158471741977, 0.0032682865872356993,
0.00283021958306234, 0.002450869186206985, 0.0021223652764777662, 0.0018378926105679667,
0.0015915494309189536, 0.0013782250260398288, 0.0011934937021124885, 0.0010335229661843405,
0.0008949940160889102, 0.0007750328875537405, 0.0006711508300522726, 0.0005811926744187624,
0.0005032921210448703, 0.0004358330210530733, 0.00037741584717419774, 0.0003268286587235699,
0.00028302195830623395, 0.00024508691862069854, 0.0002122365276477766, 0.00018378926105679666,
0.00015915494309189535, 0.00013782250260398286, 0.00011934937021124886, 0.00010335229661843406,
8.949940160889102e-05, 7.750328875537406e-05, 6.711508300522725e-05, 5.811926744187624e-05,
5.0329212104487035e-05, 4.358330210530732e-05, 3.774158471741978e-05, 3.2682865872357e-05,
2.8302195830623396e-05, 2.4508691862069852e-05, 2.122365276477766e-05, 1.8378926105679668e-05 };

#define XB_TMO      128
#define XB_XCNT(j)  (256  + 64 * (j))
#define XB_XSUB(j)  (1280 + 64 * (j))
#define XB_XGEN(j)  (2304 + 64 * (j))
#define XB_TOP      3328
#define XB_TOPGEN   3392
#define XCD_BAR_WORDS 3456
#define XB_SPIN_CAP (1u << 18)

__device__ __forceinline__ unsigned xb_ld(unsigned* p)              { return __hip_atomic_load(p, __ATOMIC_RELAXED, __HIP_MEMORY_SCOPE_AGENT); }
__device__ __forceinline__ unsigned xb_add(unsigned* p, unsigned v) { return __hip_atomic_fetch_add(p, v, __ATOMIC_RELAXED, __HIP_MEMORY_SCOPE_AGENT); }
__device__ __forceinline__ unsigned xb_xcc_id() { return (unsigned)__builtin_amdgcn_s_getreg((3 << 11) | 20) & 0xFu; }
#define XB_SPIN(cond, bar) do { unsigned _sp = 0; while (cond) { __builtin_amdgcn_s_sleep(1); \
    if ((++_sp & 255u) == 0u) { if (xb_ld(&(bar)[XB_TMO])) break; if (_sp > XB_SPIN_CAP) { atomicAdd(&(bar)[XB_TMO], 1u); break; } } } } while (0)

struct XcdBarrier {
    unsigned* bar; unsigned x;
    volatile LAS unsigned* st;
};

__device__ __forceinline__ XcdBarrier xcd_barrier_post(unsigned* bar, volatile LAS unsigned* st) {
    XcdBarrier b; b.bar = bar; b.x = xb_xcc_id(); b.st = st;
    if (threadIdx.x == 0) (void)xb_add(&bar[XB_XCNT(b.x)], 1u);
    return b;
}
__device__ __forceinline__ void xcd_barrier_complete(unsigned* bar, unsigned x, unsigned& nloc, unsigned& nx) {
    const unsigned G = gridDim.x * gridDim.y * gridDim.z;
    unsigned sum, cnt, mine, sp = 0u;
    for (;;) {
        sum = 0u; cnt = 0u; mine = 0u;
#pragma unroll
        for (unsigned j = 0; j < 16; ++j) { const unsigned c = xb_ld(&bar[XB_XCNT(j)]); sum += c; cnt += (c > 0u) ? 1u : 0u; mine = (j == x) ? c : mine; }
        if (sum == G) break;
        __builtin_amdgcn_s_sleep(1);
        if ((++sp & 255u) == 0u) { if (xb_ld(&bar[XB_TMO])) break; if (sp > XB_SPIN_CAP) { atomicAdd(&bar[XB_TMO], 1u); break; } }
    }
    nloc = mine > 0u ? mine : 1u; nx = cnt > 0u ? cnt : 1u;
}

__device__ __forceinline__ void xcd_barrier(const XcdBarrier& b) {
    asm volatile("s_waitcnt vmcnt(0)" ::: "memory");
    __syncthreads();
    if (threadIdx.x == 0) {
        unsigned* bar = b.bar;
        __builtin_amdgcn_s_waitcnt(0);
        unsigned nloc = b.st[0], nx = b.st[1];
        if (nloc == 0u) { xcd_barrier_complete(bar, b.x, nloc, nx); b.st[0] = nloc; b.st[1] = nx; }
        const unsigned old = xb_add(&bar[XB_XSUB(b.x)], 1u);
        const unsigned gen = old / nloc;
        if (old + 1u == (gen + 1u) * nloc) {
            __builtin_amdgcn_fence(__ATOMIC_RELEASE, "agent");
            asm volatile("s_waitcnt vmcnt(0)" ::: "memory");
            const unsigned og = xb_add(&bar[XB_TOP], 1u);
            const unsigned tg = og / nx;
            if (og + 1u == (tg + 1u) * nx) xb_add(&bar[XB_TOPGEN], 1u);
            else XB_SPIN(xb_ld(&bar[XB_TOPGEN]) == tg, bar);
            __builtin_amdgcn_fence(__ATOMIC_ACQUIRE, "agent");
            xb_add(&bar[XB_XGEN(b.x)], 1u);
            asm volatile("s_waitcnt vmcnt(0)" ::: "memory");
        } else {
            XB_SPIN(xb_ld(&bar[XB_XGEN(b.x)]) == gen, bar);
            __builtin_amdgcn_fence(__ATOMIC_ACQUIRE, "agent");
            asm volatile("s_waitcnt vmcnt(0)" ::: "memory");
        }
    }
    __syncthreads();
}


struct Frame {
    LAS unsigned char* lds;
    volatile LAS unsigned* MISC;
    int tid, lane, wave;
    int vcu, G;
    float* out; unsigned char* ws;
};
struct Args { const float* in[24]; float* out; unsigned char* ws; int ph_lo, ph_hi, li, pad; };
#define WSP(T, off) ((T*)(F.ws + (off)))
#define WSPG(T, off) ((T*)(GAS T*)(unsigned long long)(F.ws + (off)))
#define WSW(l, off) ((bf16*)(F.ws + WS_WSET + (size_t)((l) & 1) * WSET_BYTES + (off)))
#define WSWG(l, off) ((bf16*)(GAS bf16*)(unsigned long long)(F.ws + WS_WSET + (size_t)((l) & 1) * WSET_BYTES + (off)))
#define OUTP ((float*)F.out)
#define OUTPG ((float*)(GAS float*)(unsigned long long)F.out)
#define INP(A, i) ((const float*)((const GAS float*)(A)->in[i]))
#define RETID() do { int t_ = threadIdx.x; asm volatile("" : "+v"(t_)); F.tid = t_; F.lane = t_ & 63; } while (0)
#define CAS __attribute__((address_space(4)))
typedef const CAS Args* ArgP;

__device__ __forceinline__ float fexp(float x) { return __builtin_amdgcn_exp2f(x * 1.4426950408889634f); }
__device__ __forceinline__ float fsig(float x) { return __builtin_amdgcn_rcpf(1.0f + fexp(-x)); }
__device__ __forceinline__ float ftanh(float x) { return 1.0f - 2.0f * __builtin_amdgcn_rcpf(1.0f + fexp(2.0f * x)); }
__device__ __forceinline__ float wave_sum(float v) {
#pragma unroll
    for (int o = 1; o < 64; o <<= 1) v += __shfl_xor(v, o);
    return v;
}
struct TItem { const float* W; bf16* WT; const float* gk; int K, N, item; };
__device__ __forceinline__ void titem_load(const TItem& t, int lane, f32x4 (&v)[8]) {
    const int nblk = t.N / 32, kb = t.item / nblk, nb = t.item % nblk, k0 = 64 * kb, n0 = 32 * nb, nq = lane & 7, kr = lane >> 3;
#pragma unroll
    for (int i = 0; i < 8; ++i) v[i] = *(const GAS f32x4*)(t.W + (size_t)(k0 + kr + 8 * i) * t.N + n0 + 4 * nq);
}
__device__ __forceinline__ void titem_finish(const TItem& t, int lane, const f32x4 (&v)[8], LAS float* scr) {
    const int nblk = t.N / 32, kb = t.item / nblk, nb = t.item % nblk, k0 = 64 * kb, n0 = 32 * nb, nq = lane & 7, kr = lane >> 3;
#pragma unroll
    for (int i = 0; i < 8; ++i)
#pragma unroll
        for (int e = 0; e < 4; ++e) scr[(kr + 8 * i) * 33 + 4 * nq + e] = v[i][e];
    const int c = lane & 7;
    f32x4 g0 = (f32x4){1.f, 1.f, 1.f, 1.f}, g1 = g0;
    if (t.gk) { g0 = *(const GAS f32x4*)(t.gk + k0 + 8 * c); g1 = *(const GAS f32x4*)(t.gk + k0 + 8 * c + 4); }
    LDS_WAIT(); asm volatile("" ::: "memory");
#pragma unroll
    for (int j = 0; j < 4; ++j) { const int n = (lane >> 3) + 8 * j; const LAS float* s = scr + (8 * c) * 33 + n;
        v4u o; o.x = pk2(s[0 * 33] * g0.x, s[1 * 33] * g0.y); o.y = pk2(s[2 * 33] * g0.z, s[3 * 33] * g0.w); o.z = pk2(s[4 * 33] * g1.x, s[5 * 33] * g1.y); o.w = pk2(s[6 * 33] * g1.z, s[7 * 33] * g1.w);
        *(GAS v4u*)(t.WT + (size_t)(n0 + n) * t.K + k0 + 8 * c) = o; }
    LDS_WAIT(); asm volatile("" ::: "memory");
}
__device__ __forceinline__ void rms_row_to_bf16(const float* xrow, const float* g, bf16* orow, int lane) {
    const GAS f32x4* xr = (const GAS f32x4*)xrow + lane;
    f32x4 v[8]; float s = 0.f;
#pragma unroll
    for (int j = 0; j < 8; ++j) { v[j] = xr[64 * j]; s += (v[j].x * v[j].x + v[j].y * v[j].y) + (v[j].z * v[j].z + v[j].w * v[j].w); }
    const float rstd = 1.f / sqrtf(wave_sum(s) * (1.f / D) + NORM_EPS);
    const GAS f32x4* gr = (const GAS f32x4*)g + lane;
    GAS v2u* o8 = (GAS v2u*)orow + lane;
#pragma unroll
    for (int j = 0; j < 8; ++j) { const f32x4 gg = gr[64 * j]; v2u o; o.x = pk2(v[j].x * rstd * gg.x, v[j].y * rstd * gg.y); o.y = pk2(v[j].z * rstd * gg.z, v[j].w * rstd * gg.w); o8[64 * j] = o; }
}

#if (MK_GLOBAL_GROUPS & 1)
#pragma push_macro("WSP")
#pragma push_macro("WSW")
#pragma push_macro("OUTP")
#undef WSP
#undef WSW
#undef OUTP
#define WSP WSPG
#define WSW WSWG
#define OUTP OUTPG
#endif
__device__ __forceinline__ void ph_prologue(Frame& F, ArgP A) {
    const int* pos = (const int*)INP(A, 1); float2* rope = WSP(float2, WS_ROPE);
    {
        const int gw = F.vcu * NWAVES + F.wave, NGW = F.G * NWAVES, lane = F.lane;
        for (int m = gw; m < M; m += NGW) {
            const GAS f32x4* xr = (const GAS f32x4*)(INP(A, 0) + (size_t)m * D) + lane; GAS f32x4* orow = (GAS f32x4*)(OUTP + (size_t)m * D) + lane;
            GAS v2u* hb = (GAS v2u*)(WSP(bf16, WS_H) + (size_t)m * D) + lane; float s = 0.f;
#pragma unroll
            for (int j = 0; j < 8; ++j) { const f32x4 v = xr[64 * j]; orow[64 * j] = v; v2u o; o.x = pk2(v.x, v.y); o.y = pk2(v.z, v.w); hb[64 * j] = o; s += (v.x * v.x + v.y * v.y) + (v.z * v.z + v.w * v.w); }
            s = wave_sum(s);
            if (lane < 32) WSP(float, WS_SS)[(size_t)m * 32 + lane] = lane == 0 ? s : 0.f;
        }
    }
    for (int i = F.vcu * 512 + F.tid; i < M * 64; i += F.G * 512) {
        const int m = i >> 6, j = i & 63;
        const double rev = (double)pos[m] * ROPE_REV[j];
        const float fr = (float)(rev - __builtin_rint(rev));
        rope[i] = make_float2(__builtin_amdgcn_cosf(fr), __builtin_amdgcn_sinf(fr));
    }
}
#if (MK_GLOBAL_GROUPS & 1)
#pragma pop_macro("WSP")
#pragma pop_macro("WSW")
#pragma pop_macro("OUTP")
#endif
#if (MK_GLOBAL_GROUPS & 16)
#pragma push_macro("WSP")
#pragma push_macro("WSW")
#pragma push_macro("OUTP")
#undef WSP
#undef WSW
#undef OUTP
#define WSP WSPG
#define WSW WSWG
#define OUTP OUTPG
#endif
__device__ __forceinline__ TItem conv_item(Frame& F, ArgP A, int l, int it) {
    constexpr int I_IN = (D / 64) * (INW / 32), I_A = (RETW / 64) * (D / 32), I_O = (D / 64) * (D / 32), I_UP = (D / 64) * (DFF / 32), I_DN = (DFF / 64) * (D / 32);
    int r = it; TItem t;
    if (r < I_IN) { t = TItem{INP(A, 3) + (size_t)l * D * INW, WSW(l, WO_WIN), INP(A, 2) + (size_t)l * D, D, INW, r}; return t; } r -= I_IN;
    if (r < I_A) { t = TItem{INP(A, 17) + (size_t)l * RETW * D, WSW(l, WO_WA), nullptr, RETW, D, r}; return t; } r -= I_A;
    if (r < I_A) { t = TItem{INP(A, 18) + (size_t)l * RWW * D, WSW(l, WO_WB), nullptr, RWW, D, r}; return t; } r -= I_A;
    if (r < I_O) { t = TItem{INP(A, 19) + (size_t)l * D * D, WSW(l, WO_WO), nullptr, D, D, r}; return t; } r -= I_O;
    if (r < I_UP) { t = TItem{INP(A, 21) + (size_t)l * D * DFF, WSW(l, WO_WUP), INP(A, 20) + (size_t)l * D, D, DFF, r}; return t; } r -= I_UP;
    if (r < I_DN) { t = TItem{INP(A, 22) + (size_t)l * DFF * D, WSW(l, WO_WDN), nullptr, DFF, D, r}; return t; } r -= I_DN;
    if (r < 32) { t = TItem{INP(A, 8) + (size_t)l * 64 * RWW, WSW(l, WO_LORA), nullptr, 64, RWW, r}; return t; } r -= 32;
    if (r < 32) { t = TItem{INP(A, 10) + (size_t)l * 64 * RWW, WSW(l, WO_LORA) + 1024 * 64, nullptr, 64, RWW, r}; return t; } r -= 32;
    t = TItem{INP(A, 11) + (size_t)l * 128 * RWW, WSW(l, WO_LORA) + 2 * 1024 * 64, nullptr, 128, RWW, r}; return t;
}
__device__ __forceinline__ void ph_convert(Frame& F, ArgP A, int l, int wg, int nwg) {
    LAS float* scr = (LAS float*)(F.lds + RING_OFF + F.wave * 16384);
    const int gw = wg * NWAVES + F.wave, NGW = nwg * NWAVES, lane = F.lane;
    constexpr int I_IN = (D / 64) * (INW / 32), I_A = (RETW / 64) * (D / 32), I_O = (D / 64) * (D / 32), I_UP = (D / 64) * (DFF / 32), I_DN = (DFF / 64) * (D / 32);
    constexpr int NITEMS = I_IN + 2 * I_A + I_O + I_UP + I_DN + 32 + 32 + 64;
    if (gw >= NITEMS) return;
    TItem cur = conv_item(F, A, l, gw); f32x4 va[8], vb[8];
    titem_load(cur, lane, va);
    for (int it = gw; it < NITEMS; it += 2 * NGW) {
        TItem nxt = cur; const bool h1 = it + NGW < NITEMS;
        if (h1) { nxt = conv_item(F, A, l, it + NGW); titem_load(nxt, lane, vb); }
        titem_finish(cur, lane, va, scr);
        if (!h1) break;
        const bool h2 = it + 2 * NGW < NITEMS;
        if (h2) { cur = conv_item(F, A, l, it + 2 * NGW); titem_load(cur, lane, va); }
        titem_finish(nxt, lane, vb, scr);
        if (!h2) break;
    }
}
__device__ __forceinline__ void ph_norm(Frame& F, const float* g) {
    const int gw = F.vcu * NWAVES + F.wave, NGW = F.G * NWAVES;
    for (int m = gw; m < M; m += NGW) rms_row_to_bf16(OUTP + (size_t)m * D, g, WSP(bf16, WS_H) + (size_t)m * D, F.lane);
}
#if (MK_GLOBAL_GROUPS & 16)
#pragma pop_macro("WSP")
#pragma pop_macro("WSW")
#pragma pop_macro("OUTP")
#endif
#if (MK_GLOBAL_GROUPS & 2)
#pragma push_macro("WSP")
#pragma push_macro("WSW")
#pragma push_macro("OUTP")
#undef WSP
#undef WSW
#undef OUTP
#define WSP WSPG
#define WSW WSWG
#define OUTP OUTPG
#endif
__device__ __forceinline__ f32x4 unpk4(const v2u p) { return (f32x4){pg8::bf_lo(p.x), pg8::bf_hi(p.x), pg8::bf_lo(p.y), pg8::bf_hi(p.y)}; }
__device__ __forceinline__ void unpack8(const v4u a, float (&o)[8]) {
    o[0] = pg8::bf_lo(a.x); o[1] = pg8::bf_hi(a.x); o[2] = pg8::bf_lo(a.y); o[3] = pg8::bf_hi(a.y); o[4] = pg8::bf_lo(a.z); o[5] = pg8::bf_hi(a.z); o[6] = pg8::bf_lo(a.w); o[7] = pg8::bf_hi(a.w);
}
__device__ __forceinline__ void mix8(const GAS bf16* zc, bool has_prev, const GAS float* mu, float (&o)[8]) {
    const v4u a = *(const GAS v4u*)zc; v4u p = (v4u){0u, 0u, 0u, 0u}; if (has_prev) p = *(const GAS v4u*)(zc - INW);
    const f32x4 m0 = *(const GAS f32x4*)mu, m1 = *(const GAS f32x4*)(mu + 4);
    float z[8], q[8]; unpack8(a, z); unpack8(p, q);
#pragma unroll
    for (int j = 0; j < 4; ++j) { o[j] = z[j] + m0[j] * (q[j] - z[j]); o[4 + j] = z[4 + j] + m1[j] * (q[4 + j] - z[4 + j]); }
}
__device__ __forceinline__ f32x4 mix4(const GAS bf16* zc, bool has_prev, const GAS float* mu) {
    const v2u a = *(const GAS v2u*)zc; v2u p = (v2u){0u, 0u}; if (has_prev) p = *(const GAS v2u*)(zc - INW);
    const f32x4 m = *(const GAS f32x4*)mu;
    const f32x4 z = (f32x4){pg8::bf_lo(a.x), pg8::bf_hi(a.x), pg8::bf_lo(a.y), pg8::bf_hi(a.y)}, q = (f32x4){pg8::bf_lo(p.x), pg8::bf_hi(p.x), pg8::bf_lo(p.y), pg8::bf_hi(p.y)};
    return z + m * (q - z);
}
__device__ __forceinline__ bf16x8 pack8(const float (&v)[8]) {
    v4u o; o.x = pg8::cvt_pk_bf16(v[0], v[1]); o.y = pg8::cvt_pk_bf16(v[2], v[3]); o.z = pg8::cvt_pk_bf16(v[4], v[5]); o.w = pg8::cvt_pk_bf16(v[6], v[7]);
    return __builtin_bit_cast(bf16x8, o);
}
constexpr int CU_BYTES = 20480, CU_M = 0, CU_OM = 8192, CU_QB = 10240, CU_QSTR = 2560;
constexpr int CK = 16, NCHUNK = SEQ / CK;
constexpr int XL_STR = 144, XL_MAT = 16 * XL_STR;
typedef short s4v __attribute__((ext_vector_type(4)));
__device__ __forceinline__ s4v pk4(const f32x4 v) { v2u o; o.x = pg8::cvt_pk_bf16(v[0], v[1]); o.y = pg8::cvt_pk_bf16(v[2], v[3]); return __builtin_bit_cast(s4v, o); }
__device__ __forceinline__ bf16x8 pk8v(const f32x4 a, const f32x4 b) { v4u o; o.x = pg8::cvt_pk_bf16(a[0], a[1]); o.y = pg8::cvt_pk_bf16(a[2], a[3]); o.z = pg8::cvt_pk_bf16(b[0], b[1]); o.w = pg8::cvt_pk_bf16(b[2], b[3]); return __builtin_bit_cast(bf16x8, o); }
__device__ __forceinline__ f32x4 mma16(const s4v x, const s4v y, const f32x4 c) {
    const bf16x8 x8 = (bf16x8){x.x, x.y, x.z, x.w, 0, 0, 0, 0}, y8 = (bf16x8){y.x, y.y, y.z, y.w, 0, 0, 0, 0};
    return __builtin_amdgcn_mfma_f32_16x16x32_bf16(x8, y8, c, 0, 0, 0); }
__device__ __forceinline__ f32x4 mma32(const bf16x8 x, const bf16x8 y, const f32x4 c) { return __builtin_amdgcn_mfma_f32_16x16x32_bf16(x, y, c, 0, 0, 0); }
template <int N> __device__ __forceinline__ float dpp_shr0(float x) { return __builtin_bit_cast(float, __builtin_amdgcn_update_dpp(0, __builtin_bit_cast(int, x), 0x110 + N, 0xF, 0xF, true)); }
__device__ __forceinline__ float scan16(float x) { x += dpp_shr0<1>(x); x += dpp_shr0<2>(x); x += dpp_shr0<4>(x); x += dpp_shr0<8>(x); return x; }
__device__ __forceinline__ s4v trd(const LAS unsigned char* p) { return __builtin_amdgcn_ds_read_tr16_b64_v4i16((LAS s4v*)p); }
__device__ __forceinline__ void chunk_ops(const f32x4 (&r)[4], const f32x4 (&lw)[4], const f32x4 (&kp)[4], const f32x4 (&v)[4], const f32x4 (&a)[4], const f32x4 (&b)[4],
                                          LAS unsigned char* scr, GAS unsigned char* rec, int lane) {
    const int l15 = lane & 15, g = lane >> 4, tq = l15 >> 2, tp = l15 & 3;
    const f32x4 Z4 = (f32x4){0.f, 0.f, 0.f, 0.f};
    f32x4 Rt[4], pc[4]; bf16x8 Atf[2], Btf[2], Ktf[2], Rtf[2];
    {
        s4v Ah[4], Bq[4], Kq[4], Rq[4];
#pragma unroll
        for (int nt = 0; nt < 4; ++nt) {
            f32x4 cs, tot;
#pragma unroll
            for (int i = 0; i < 4; ++i) { cs[i] = scan16(lw[nt][i]); tot[i] = __shfl(cs[i], lane | 15); }
            f32x4 At, Bt, Kt, Bh, Kh;
#pragma unroll
            for (int i = 0; i < 4; ++i) { const float P = fexp(cs[i]), Pm1 = fexp(cs[i] - lw[nt][i]), iP = fexp(-cs[i]), PCP = fexp(tot[i] - cs[i]);
                pc[nt][i] = fexp(tot[i]); At[i] = a[nt][i] * Pm1; Bt[i] = b[nt][i] * iP; Kt[i] = kp[nt][i] * iP; Rt[nt][i] = r[nt][i] * P; Bh[i] = b[nt][i] * PCP; Kh[i] = kp[nt][i] * PCP; }
            Ah[nt] = pk4(At); Bq[nt] = pk4(Bt); Kq[nt] = pk4(Kt); Rq[nt] = pk4(Rt[nt]);
            LAS unsigned char* w = scr + l15 * XL_STR + (16 * nt + 4 * g) * 2;
            *(LAS s4v*)(w + 0 * XL_MAT) = Ah[nt]; *(LAS s4v*)(w + 1 * XL_MAT) = pk4(v[nt]); *(LAS s4v*)(w + 2 * XL_MAT) = pk4(Bh); *(LAS s4v*)(w + 3 * XL_MAT) = pk4(Kh);
        }
#pragma unroll
        for (int s = 0; s < 2; ++s) {
            Atf[s] = (bf16x8){Ah[2 * s].x, Ah[2 * s].y, Ah[2 * s].z, Ah[2 * s].w, Ah[2 * s + 1].x, Ah[2 * s + 1].y, Ah[2 * s + 1].z, Ah[2 * s + 1].w};
            Btf[s] = (bf16x8){Bq[2 * s].x, Bq[2 * s].y, Bq[2 * s].z, Bq[2 * s].w, Bq[2 * s + 1].x, Bq[2 * s + 1].y, Bq[2 * s + 1].z, Bq[2 * s + 1].w};
            Ktf[s] = (bf16x8){Kq[2 * s].x, Kq[2 * s].y, Kq[2 * s].z, Kq[2 * s].w, Kq[2 * s + 1].x, Kq[2 * s + 1].y, Kq[2 * s + 1].z, Kq[2 * s + 1].w};
            Rtf[s] = (bf16x8){Rq[2 * s].x, Rq[2 * s].y, Rq[2 * s].z, Rq[2 * s].w, Rq[2 * s + 1].x, Rq[2 * s + 1].y, Rq[2 * s + 1].z, Rq[2 * s + 1].w}; }
    }
    f32x4 LabR = Z4, LabT = Z4, LakT = Z4, LrbT = Z4, LrkT = Z4;
#pragma unroll
    for (int s = 0; s < 2; ++s) { LabR = mma32(Atf[s], Btf[s], LabR); LabT = mma32(Btf[s], Atf[s], LabT); LakT = mma32(Ktf[s], Atf[s], LakT); LrbT = mma32(Btf[s], Rtf[s], LrbT); LrkT = mma32(Ktf[s], Rtf[s], LrkT); }
    f32x4 IR;
#pragma unroll
    for (int i = 0; i < 4; ++i) { const int tt = 4 * g + i;
        IR[i] = (tt == l15) ? 1.f : 0.f;
        LabR[i] = (tt > l15) ? LabR[i] : 0.f; LabT[i] = (l15 > tt) ? LabT[i] : 0.f; LakT[i] = (l15 > tt) ? LakT[i] : 0.f;
        LrbT[i] = (l15 >= tt) ? LrbT[i] : 0.f; LrkT[i] = (l15 >= tt) ? LrkT[i] : 0.f; }
    const s4v L1R = pk4(LabR), L1T = pk4(LabT);
    const f32x4 L2R = mma16(L1T, L1R, Z4), L2T = mma16(L1R, L1T, Z4);
    const s4v L2Rp = pk4(L2R), L2Tp = pk4(L2T);
    const f32x4 L4R = mma16(L2Tp, L2Rp, Z4), L4T = mma16(L2Rp, L2Tp, Z4);
    const s4v L4Rp = pk4(L4R), L4Tp = pk4(L4T);
    const f32x4 L8R = mma16(L4Tp, L4Rp, Z4);
    const f32x4 T1T = mma16(pk4(IR + L2R), pk4(IR + LabT), Z4);
    const f32x4 T2T = mma16(pk4(IR + L4R), pk4(T1T), Z4);
    const s4v TmT = pk4(mma16(pk4(IR + L8R), pk4(T2T), Z4));
    const s4v LakTp = pk4(LakT), LrbTp = pk4(LrbT), LrkTp = pk4(LrkT);
    asm volatile("s_waitcnt lgkmcnt(0)" ::: "memory");
    const LAS unsigned char* tb = scr + (4 * g + tq) * XL_STR + (4 * tp) * 2;
    s4v tAt[4], tV[4], tBh[4], tKh[4];
#pragma unroll
    for (int t = 0; t < 4; ++t) { tAt[t] = trd(tb + 0 * XL_MAT + 32 * t); tV[t] = trd(tb + 1 * XL_MAT + 32 * t); tBh[t] = trd(tb + 2 * XL_MAT + 32 * t); tKh[t] = trd(tb + 3 * XL_MAT + 32 * t); }
    s4v Wp[4], U0p[4];
#pragma unroll
    for (int t = 0; t < 4; ++t) { Wp[t] = pk4(mma16(TmT, tAt[t], Z4));
        const f32x4 G = mma16(LakTp, tV[t], Z4);
        const f32x4 U0 = mma16(TmT, pk4(G), Z4); U0p[t] = pk4(U0);
        f32x4 Y0 = mma16(LrbTp, U0p[t], Z4); Y0 = mma16(LrkTp, tV[t], Y0);
        *(GAS s4v*)(rec + CU_QB + t * CU_QSTR + 2048 + lane * 8) = pk4(Y0); }
    {
        f32x4 Om[4];
#pragma unroll
        for (int ct = 0; ct < 4; ++ct) Om[ct] = mma16(Wp[ct], LrbTp, Rt[ct]);
        *(GAS bf16x8*)(rec + CU_OM + 0 * 1024 + lane * 16) = pk8v(Om[0], Om[1]); *(GAS bf16x8*)(rec + CU_OM + 1 * 1024 + lane * 16) = pk8v(Om[2], Om[3]);
    }
#pragma unroll
    for (int tl = 0; tl < 4; ++tl) {
        f32x4 Mt[4];
#pragma unroll
        for (int kt = 0; kt < 4; ++kt) { Mt[kt] = mma16(Wp[kt], tBh[tl], Z4);
            if (kt == tl) {
#pragma unroll
                for (int i = 0; i < 4; ++i) Mt[kt][i] += (4 * g + i == l15) ? pc[kt][i] : 0.f; } }
        *(GAS bf16x8*)(rec + CU_M + (tl * 2 + 0) * 1024 + lane * 16) = pk8v(Mt[0], Mt[1]); *(GAS bf16x8*)(rec + CU_M + (tl * 2 + 1) * 1024 + lane * 16) = pk8v(Mt[2], Mt[3]);
    }
#pragma unroll
    for (int q = 0; q < 4; ++q)
#pragma unroll
        for (int tl = 0; tl < 4; ++tl) { f32x4 Nt = mma16(tBh[tl], U0p[q], Z4); Nt = mma16(tKh[tl], tV[q], Nt);
            *(GAS s4v*)(rec + CU_QB + q * CU_QSTR + tl * 512 + lane * 8) = pk4(Nt); }
}
__device__ __forceinline__ void ph_prep(Frame& F, ArgP A, int l) {
    const int gw = F.vcu * NWAVES + F.wave, NGW = F.G * NWAVES, lane = F.lane, l15 = lane & 15, g = lane >> 4;
    {
        const int h = lane >> 3, i0 = 8 * (lane & 7);
        int nrr_ = (MK_REP & 1024) ? 2 : 1; asm volatile("" : "+s"(nrr_));
#pragma unroll 1
        for (int rr_ = 0; rr_ < nrr_; ++rr_)
        for (int m = gw; m < M; m += NGW) {
            const GAS bf16* zrow = (const GAS bf16*)(WSP(bf16, WS_Z) + (size_t)m * INW);
            const GAS f32x4* rp = (const GAS f32x4*)(WSP(float2, WS_ROPE) + (size_t)m * 64 + i0);
            const f32x4 c01 = rp[0], c23 = rp[1], c45 = rp[2], c67 = rp[3];
            const float cs[8] = {c01.x, c01.z, c23.x, c23.z, c45.x, c45.z, c67.x, c67.z}, sn[8] = {c01.y, c01.w, c23.y, c23.w, c45.y, c45.w, c67.y, c67.w};
            float q1[8], q2[8], k1[8], k2[8], o1[8], o2[8];
            unpack8(*(const GAS v4u*)(zrow + ZC_Q + h * RD + i0), q1); unpack8(*(const GAS v4u*)(zrow + ZC_Q + h * RD + 64 + i0), q2);
            unpack8(*(const GAS v4u*)(zrow + ZC_K + h * RD + i0), k1); unpack8(*(const GAS v4u*)(zrow + ZC_K + h * RD + 64 + i0), k2);
#pragma unroll
            for (int j = 0; j < 8; ++j) { o1[j] = q1[j] * cs[j] - q2[j] * sn[j]; o2[j] = q2[j] * cs[j] + q1[j] * sn[j]; }
            GAS bf16* qo = (GAS bf16*)(WSP(bf16, WS_QR) + (size_t)m * RETW + h * RD + i0);
            *(GAS bf16x8*)qo = pack8(o1); *(GAS bf16x8*)(qo + 64) = pack8(o2);
#pragma unroll
            for (int j = 0; j < 8; ++j) { const float a = k1[j] * 0.08838834764831845f, b = k2[j] * 0.08838834764831845f; o1[j] = a * cs[j] - b * sn[j]; o2[j] = b * cs[j] + a * sn[j]; }
            GAS bf16* ko = (GAS bf16*)(WSP(bf16, WS_KR) + (size_t)m * RETW + h * RD + i0);
            *(GAS bf16x8*)ko = pack8(o1); *(GAS bf16x8*)(ko + 64) = pack8(o2);
        }
    }
    const GAS float* mu = (const GAS float*)(INP(A, 6) + (size_t)l * RWSHIFT);
    const GAS float* w0 = (const GAS float*)(INP(A, 7) + (size_t)l * RWW); const GAS float* a0 = (const GAS float*)(INP(A, 9) + (size_t)l * RWW);
    const GAS float* kkw = (const GAS float*)(INP(A, 12) + (size_t)l * RWW); const GAS float* kaw = (const GAS float*)(INP(A, 13) + (size_t)l * RWW); const GAS float* rkw = (const GAS float*)(INP(A, 14) + (size_t)l * RWW);
    const GAS bf16* WupT = (const GAS bf16*)WSW(l, WO_LORA); const GAS bf16* AupT = WupT + 1024 * 64; const GAS bf16* GupT = AupT + 1024 * 64;
    constexpr int PP_OFF = 8 * 10240;
    LAS float* PP = (LAS float*)(F.lds + RING_OFF + PP_OFF);
    __syncthreads();
    for (int i = F.tid; i < 2048; i += NWAVES * 64) { const int arr = i >> 8, off = (i & 255) * 4;
        const GAS float* src = arr < 3 ? mu + arr * 1024 : (arr == 3 ? w0 : (arr == 4 ? a0 : (arr == 5 ? kkw : (arr == 6 ? kaw : rkw))));
        *(LAS f32x4*)(PP + arr * 1024 + off) = *(const GAS f32x4*)(src + off); }
    __syncthreads();
    int nrw_ = (MK_REP & 2048) ? 2 : 1; asm volatile("" : "+s"(nrw_));
#pragma unroll 1
    for (int rw_ = 0; rw_ < nrw_; ++rw_)
    for (int task = gw; task < M / 8; task += NGW) {
        const int m = (task >> 1) * 16 + l15, hh0 = (task & 1) * (WH / 2);
        const bool has_prev = (m % SEQ) != 0;
        const GAS bf16* zr = (const GAS bf16*)(WSP(bf16, WS_Z) + (size_t)m * INW + ZC_RW);
        bf16x8 fw[2], fa[2], fg[4];
#pragma unroll
        for (int ks = 0; ks < 2; ++ks) { float t[8];
            mix8(zr + RWC_W + 32 * ks + 8 * g, has_prev, mu + RWC_W + 32 * ks + 8 * g, t);
#pragma unroll
            for (int j = 0; j < 8; ++j) t[j] = ftanh(t[j]);
            fw[ks] = pack8(t);
            mix8(zr + RWC_A + 32 * ks + 8 * g, has_prev, mu + RWC_A + 32 * ks + 8 * g, t); fa[ks] = pack8(t); }
#pragma unroll
        for (int ks = 0; ks < 4; ++ks) { float t[8];
            mix8(zr + RWC_G + 32 * ks + 8 * g, has_prev, mu + RWC_G + 32 * ks + 8 * g, t);
#pragma unroll
            for (int j = 0; j < 8; ++j) t[j] = fsig(t[j]);
            fg[ks] = pack8(t); }
        const GAS bf16* zq = has_prev ? zr - INW : zr;
        for (int hh = hh0; hh < hh0 + WH / 2; ++hh) {
            f32x4 kkr[4], av[4], rr[4], lwv[4], kpv[4], vv[4]; float ss = 0.f, bonus = 0.f;
            const int cb = hh * WD + 4 * g;
            {
                v2u zc[3][4], zp[3][4];
#pragma unroll
                for (int a3 = 0; a3 < 3; ++a3)
#pragma unroll
                    for (int nt = 0; nt < 4; ++nt) { zc[a3][nt] = *(const GAS v2u*)(zr + a3 * 1024 + cb + 16 * nt); zp[a3][nt] = *(const GAS v2u*)(zq + a3 * 1024 + cb + 16 * nt); }
#pragma unroll
                for (int nt = 0; nt < 4; ++nt) {
#pragma unroll
                    for (int a3 = 0; a3 < 3; ++a3) { const f32x4 z = unpk4(zc[a3][nt]); f32x4 p = unpk4(zp[a3][nt]); if (!has_prev) p = (f32x4){0.f, 0.f, 0.f, 0.f};
                        const f32x4 mx = z + *(const LAS f32x4*)(PP + a3 * 1024 + cb + 16 * nt) * (p - z);
                        if (a3 == 0) rr[nt] = mx; else if (a3 == 1) kpv[nt] = mx; else vv[nt] = mx; }
                }
            }
            bf16x8 wf[2][2], af[2][2], gf[2][4];
#define PREP_WFRAGS(nt_, k_) do { const int cf_ = hh * WD + (nt_) * 16 + l15; \
            _Pragma("unroll") for (int ks = 0; ks < 2; ++ks) { wf[k_][ks] = *(const GAS bf16x8*)(WupT + (size_t)cf_ * 64 + 32 * ks + 8 * g); af[k_][ks] = *(const GAS bf16x8*)(AupT + (size_t)cf_ * 64 + 32 * ks + 8 * g); } \
            _Pragma("unroll") for (int ks = 0; ks < 4; ++ks) gf[k_][ks] = *(const GAS bf16x8*)(GupT + (size_t)cf_ * 128 + 32 * ks + 8 * g); } while (0)
            PREP_WFRAGS(0, 0);
#pragma unroll
            for (int nt = 0; nt < 4; ++nt) {
                const int c0 = cb + 16 * nt, cs_ = nt & 1;
                if (nt + 1 < 4) PREP_WFRAGS(nt + 1, (cs_ ^ 1));
                f32x4 wl = *(const LAS f32x4*)(PP + 3 * 1024 + c0), al = *(const LAS f32x4*)(PP + 4 * 1024 + c0), gl = (f32x4){0.f, 0.f, 0.f, 0.f};
#pragma unroll
                for (int ks = 0; ks < 2; ++ks) { wl = __builtin_amdgcn_mfma_f32_16x16x32_bf16(wf[cs_][ks], fw[ks], wl, 0, 0, 0); al = __builtin_amdgcn_mfma_f32_16x16x32_bf16(af[cs_][ks], fa[ks], al, 0, 0, 0); }
#pragma unroll
                for (int ks = 0; ks < 4; ++ks) gl = __builtin_amdgcn_mfma_f32_16x16x32_bf16(gf[cs_][ks], fg[ks], gl, 0, 0, 0);
                const f32x4 r = rr[nt], k = kpv[nt], v = vv[nt];
                const f32x4 kk4 = *(const LAS f32x4*)(PP + 5 * 1024 + c0), ka4 = *(const LAS f32x4*)(PP + 6 * 1024 + c0), rk4 = *(const LAS f32x4*)(PP + 7 * 1024 + c0);
                f32x4 lwd, a, kp;
#pragma unroll
                for (int i = 0; i < 4; ++i) {
                    lwd[i] = -0.6065306597126334f * fsig(wl[i]);
                    a[i] = fsig(al[i]);
                    kp[i] = k[i] * (1.0f + (a[i] - 1.0f) * ka4[i]);
                }
                kkr[nt] = k * kk4; av[nt] = a; lwv[nt] = lwd; kpv[nt] = kp;
                ss += (kkr[nt].x * kkr[nt].x + kkr[nt].y * kkr[nt].y) + (kkr[nt].z * kkr[nt].z + kkr[nt].w * kkr[nt].w);
                const f32x4 rb = r * kp * rk4; bonus += (rb.x + rb.y) + (rb.z + rb.w);
                const size_t o = (size_t)m * RWW + c0;
#if MK_CHUNKED
                *(GAS f32x4*)(WSP(float, WS_SV) + o) = v; *(GAS f32x4*)(WSP(float, WS_G) + o) = gl;
#else
                f32x4 decay;
#pragma unroll
                for (int i = 0; i < 4; ++i) decay[i] = fexp(lwd[i]);
                *(GAS f32x4*)(WSP(float, WS_SR) + o) = r; *(GAS f32x4*)(WSP(float, WS_SW) + o) = decay; *(GAS f32x4*)(WSP(float, WS_SK) + o) = kp;
                *(GAS f32x4*)(WSP(float, WS_SV) + o) = v; *(GAS f32x4*)(WSP(float, WS_G) + o) = gl;
#endif
            }
#undef PREP_WFRAGS
            ss += __shfl_xor(ss, 16); ss += __shfl_xor(ss, 32); bonus += __shfl_xor(bonus, 16); bonus += __shfl_xor(bonus, 32);
            const float inv = 1.0f / fmaxf(sqrtf(ss), 1e-12f);
            if (g == 0) WSP(float, WS_BONUS)[(size_t)m * WH + hh] = bonus;
#if MK_CHUNKED
            f32x4 aa[4], bb[4];
#pragma unroll
            for (int nt = 0; nt < 4; ++nt) { const f32x4 kk = kkr[nt] * inv; aa[nt] = -kk; bb[nt] = kk * av[nt]; }
            const int tile = task >> 1;
            GAS unsigned char* rec = (GAS unsigned char*)WSP(unsigned char, WS_CU) + ((size_t)((tile / NCHUNK) * WH + hh) * NCHUNK + (tile % NCHUNK)) * CU_BYTES;
            chunk_ops(rr, lwv, kpv, vv, aa, bb, F.lds + RING_OFF + F.wave * 10240, rec, lane);
#else
#pragma unroll
            for (int nt = 0; nt < 4; ++nt) { const size_t o = (size_t)m * RWW + hh * WD + nt * 16 + 4 * g; const f32x4 kk = kkr[nt] * inv;
                *(GAS f32x4*)(WSP(float, WS_SNKK) + o) = -kk; *(GAS f32x4*)(WSP(float, WS_SKKA) + o) = kk * av[nt]; }
#endif
        }
    }
}
#if (MK_GLOBAL_GROUPS & 2)
#pragma pop_macro("WSP")
#pragma pop_macro("WSW")
#pragma pop_macro("OUTP")
#endif
#if (MK_GLOBAL_GROUPS & 4)
#pragma push_macro("WSP")
#pragma push_macro("WSW")
#pragma push_macro("OUTP")
#undef WSP
#undef WSW
#undef OUTP
#define WSP WSPG
#define WSW WSWG
#define OUTP OUTPG
#endif
#if !MK_CHUNKED
__device__ __forceinline__ void scan_rwkv_naive(Frame& F, int item) {
    const int lane = F.lane;
    float st[64];
#pragma unroll
    for (int j = 0; j < 64; ++j) st[j] = 0.f;
    const size_t base0 = (size_t)(item >> 4) * SEQ * RWW + (size_t)(item & 15) * WD + lane;
    for (int t = 0; t < SEQ; ++t) {
        const size_t o = base0 + (size_t)t * RWW;
        const float r = WSP(float, WS_SR)[o], w = WSP(float, WS_SW)[o], k = WSP(float, WS_SK)[o], v = WSP(float, WS_SV)[o], nk = WSP(float, WS_SNKK)[o], ka = WSP(float, WS_SKKA)[o];
        float sa = 0.f;
#pragma unroll
        for (int j = 0; j < 64; ++j) sa += st[j] * rdlane(nk, j);
        float y = 0.f;
#pragma unroll
        for (int j = 0; j < 64; ++j) { st[j] = st[j] * rdlane(w, j) + sa * rdlane(ka, j) + v * rdlane(k, j); y += st[j] * rdlane(r, j); }
        WSP(float, WS_YRAWW)[o] = y;
    }
}
#endif
__device__ __forceinline__ void scan_ret_naive(Frame& F, int item) {
    const int lane = F.lane, b = item >> 4, h = (item >> 1) & 7, half = item & 1;
    const float gam = 1.0f - exp2f((float)(-5 - h));
    float R[128];
#pragma unroll
    for (int j = 0; j < 128; ++j) R[j] = 0.f;
    for (int t = 0; t < SEQ; ++t) {
        const size_t m = (size_t)b * SEQ + t;
        const float q1 = bf2f(WSP(bf16, WS_QR)[m * RETW + h * RD + lane]), q2 = bf2f(WSP(bf16, WS_QR)[m * RETW + h * RD + 64 + lane]);
        const float k1 = bf2f(WSP(bf16, WS_KR)[m * RETW + h * RD + lane]), k2 = bf2f(WSP(bf16, WS_KR)[m * RETW + h * RD + 64 + lane]);
        const float v = bf2f(WSP(bf16, WS_Z)[m * INW + ZC_V + h * RD + half * 64 + lane]);
        float y = 0.f;
#pragma unroll
        for (int d = 0; d < 64; ++d) { R[d] = gam * R[d] + rdlane(k1, d) * v; y += rdlane(q1, d) * R[d]; }
#pragma unroll
        for (int d = 0; d < 64; ++d) { R[64 + d] = gam * R[64 + d] + rdlane(k2, d) * v; y += rdlane(q2, d) * R[64 + d]; }
        WSP(float, WS_YRAWR)[m * RETW + h * RD + half * 64 + lane] = y;
    }
}
#if !MK_CHUNKED
constexpr int SCT = 32;
constexpr int SC_ARR = SCT * 64 * 4;
constexpr int SC_BUF = 5 * SC_ARR + SCT * 16 * 4;
static_assert(2 * SC_BUF <= RING_BYTES, "scan LDS");
template <int CTRL> __device__ __forceinline__ float dppf(float x) { return __builtin_bit_cast(float, __builtin_amdgcn_update_dpp(0, __builtin_bit_cast(int, x), CTRL, 0xF, 0xF, true)); }
__device__ __forceinline__ float sum16(float x) {
    x += dppf<0xB1>(x); x += dppf<0x4E>(x); x += dppf<0x141>(x); x += dppf<0x140>(x); return x;
}
__device__ __forceinline__ void scan_rwkv_fast(Frame& F, int w) {
    const int b = w >> 6, hh = (w >> 2) & 15, q = w & 3;
    const int lane = F.lane, wave = F.wave;
    LAS unsigned char* base = F.lds + RING_OFF;
    const size_t g0 = (size_t)b * SEQ * RWW + (size_t)hh * WD;
    constexpr int NBLK = SEQ / SCT;
#define SC_BAR() do { asm volatile("s_waitcnt lgkmcnt(0)" ::: "memory"); __builtin_amdgcn_s_barrier(); asm volatile("" ::: "memory"); } while (0)
    if (wave >= 4) {
        const int lt = F.tid - 256;
        const float* a0 = WSP(float, WS_SR) + g0; const float* a1 = WSP(float, WS_SW) + g0; const float* a2 = WSP(float, WS_SK) + g0;
        const float* a3 = WSP(float, WS_SNKK) + g0; const float* a4 = WSP(float, WS_SKKA) + g0; const float* av = WSP(float, WS_SV) + g0 + 16 * q;
        const int f0 = lt, f1 = lt + 256;
        const size_t o0 = (size_t)(f0 >> 4) * RWW + 4 * (f0 & 15), o1 = (size_t)(f1 >> 4) * RWW + 4 * (f1 & 15), ov = (size_t)(lt >> 2) * RWW + 4 * (lt & 3);
        f32x4 r0[5], r1[5], rv;
#define SC_LOAD(blk) do { const size_t tb = (size_t)(blk) * SCT * RWW; \
        r0[0] = *(const GAS f32x4*)(a0 + tb + o0); r1[0] = *(const GAS f32x4*)(a0 + tb + o1); r0[1] = *(const GAS f32x4*)(a1 + tb + o0); r1[1] = *(const GAS f32x4*)(a1 + tb + o1); \
        r0[2] = *(const GAS f32x4*)(a2 + tb + o0); r1[2] = *(const GAS f32x4*)(a2 + tb + o1); r0[3] = *(const GAS f32x4*)(a3 + tb + o0); r1[3] = *(const GAS f32x4*)(a3 + tb + o1); \
        r0[4] = *(const GAS f32x4*)(a4 + tb + o0); r1[4] = *(const GAS f32x4*)(a4 + tb + o1); if (lt < 128) rv = *(const GAS f32x4*)(av + tb + ov); } while (0)
#define SC_STORE(bi) do { LAS unsigned char* bb = base + (bi) * SC_BUF; \
        _Pragma("unroll") for (int a = 0; a < 5; ++a) { *(LAS f32x4*)(bb + a * SC_ARR + f0 * 16) = r0[a]; *(LAS f32x4*)(bb + a * SC_ARR + f1 * 16) = r1[a]; } \
        if (lt < 128) *(LAS f32x4*)(bb + 5 * SC_ARR + lt * 16) = rv; } while (0)
        SC_LOAD(0); SC_STORE(0);
        if (1 < NBLK) SC_LOAD(1);
        SC_BAR();
        for (int blk = 0; blk < NBLK; ++blk) {
            if (blk + 1 < NBLK) { SC_STORE((blk + 1) & 1); if (blk + 2 < NBLK) SC_LOAD(blk + 2); }
            SC_BAR();
        }
#undef SC_LOAD
#undef SC_STORE
    } else {
        const int l16 = lane & 15, rowl = 4 * wave + (lane >> 4);
        GAS float* Y = (GAS float*)(WSP(float, WS_YRAWW) + g0 + 16 * q + rowl);
        f32x4 st = (f32x4){0.f, 0.f, 0.f, 0.f};
        const int lo = l16 * 16, vo = 5 * SC_ARR + rowl * 4;
#define SC_LD(tt_, R4, W4, K4, N4, A4, V) do { R4 = *(const LAS f32x4*)(bb + 0 * SC_ARR + (tt_) * 256 + lo); W4 = *(const LAS f32x4*)(bb + 1 * SC_ARR + (tt_) * 256 + lo); \
        K4 = *(const LAS f32x4*)(bb + 2 * SC_ARR + (tt_) * 256 + lo); N4 = *(const LAS f32x4*)(bb + 3 * SC_ARR + (tt_) * 256 + lo); A4 = *(const LAS f32x4*)(bb + 4 * SC_ARR + (tt_) * 256 + lo); \
        V = *(const LAS float*)(bb + vo + (tt_) * 64); } while (0)
        SC_BAR();
        for (int blk = 0; blk < NBLK; ++blk) {
            const LAS unsigned char* bb = base + (blk & 1) * SC_BUF;
            GAS float* yb = Y + (size_t)blk * SCT * RWW;
            f32x4 r4[3], w4[3], k4[3], n4[3], a4[3]; float v[3];
            SC_LD(0, r4[0], w4[0], k4[0], n4[0], a4[0], v[0]);
            SC_LD(1, r4[1], w4[1], k4[1], n4[1], a4[1], v[1]);
#pragma unroll
            for (int tt = 0; tt < SCT; ++tt) {
                const int c = tt % 3, p = (tt + 2) % 3;
                if (tt + 2 < SCT) SC_LD(tt + 2, r4[p], w4[p], k4[p], n4[p], a4[p], v[p]);
                f32x2 sp2 = (f32x2){st.x, st.y} * (f32x2){n4[c].x, n4[c].y}; sp2 = (f32x2){st.z, st.w} * (f32x2){n4[c].z, n4[c].w} + sp2;
                const f32x4 t0 = st * w4[c] + k4[c] * v[c];
                const float sa = sum16(sp2.x + sp2.y);
                st = a4[c] * sa + t0;
                f32x2 yp2 = (f32x2){st.x, st.y} * (f32x2){r4[c].x, r4[c].y}; yp2 = (f32x2){st.z, st.w} * (f32x2){r4[c].z, r4[c].w} + yp2;
                const float y = sum16(yp2.x + yp2.y);
                yb[(size_t)tt * RWW] = y;
            }
            SC_BAR();
        }
#undef SC_LD
#undef SC_BAR
    }
}
#endif
constexpr int CB_STEPS = 4, CB_STEP_BYTES = 8192 + 2048 + 2048 + 512, CB_BUF = CB_STEPS * CB_STEP_BYTES, CB_PIECES = CB_BUF / 16, CB_NBLK = NCHUNK / CB_STEPS;
static_assert(2 * CB_BUF <= RING_BYTES, "chunk scan LDS");
#ifndef MK_X2_DIRECT
#define MK_X2_DIRECT 0
#endif
__device__ __forceinline__ void scan_rwkv_chunk(Frame& F, int w) {
    const int bh = w >> 2, q = w & 3, lane = F.lane, wave = F.wave;
#if MK_X2_DIRECT
    if (wave == 0) {
        const int l15 = lane & 15, g = lane >> 4;
        const f32x4 Z4 = (f32x4){0.f, 0.f, 0.f, 0.f};
        f32x4 acc[4] = {Z4, Z4, Z4, Z4};
        const GAS unsigned char* rec = (const GAS unsigned char*)WSP(unsigned char, WS_CU) + (size_t)bh * NCHUNK * CU_BYTES;
        GAS float* Y = (GAS float*)(WSP(float, WS_YRAWW) + (size_t)(bh >> 4) * SEQ * RWW + (size_t)(bh & 15) * WD + 16 * q + l15 + (size_t)(4 * g) * RWW);
        for (int n = 0; n < NCHUNK; ++n, rec += CU_BYTES) {
            const bf16x8 sf0 = pk8v(acc[0], acc[1]), sf1 = pk8v(acc[2], acc[3]);
            f32x4 ya = unpk4(*(const GAS v2u*)(rec + CU_QB + q * CU_QSTR + 2048 + lane * 8));
            ya = mma32(*(const GAS bf16x8*)(rec + CU_OM + lane * 16), sf0, ya); ya = mma32(*(const GAS bf16x8*)(rec + CU_OM + 1024 + lane * 16), sf1, ya);
            GAS float* yp = Y + (size_t)(n * CK) * RWW;
#pragma unroll
            for (int i = 0; i < 4; ++i) yp[(size_t)i * RWW] = ya[i];
#pragma unroll
            for (int tl = 0; tl < 4; ++tl) { f32x4 na = unpk4(*(const GAS v2u*)(rec + CU_QB + q * CU_QSTR + tl * 512 + lane * 8));
                na = mma32(*(const GAS bf16x8*)(rec + CU_M + (tl * 2 + 0) * 1024 + lane * 16), sf0, na); na = mma32(*(const GAS bf16x8*)(rec + CU_M + (tl * 2 + 1) * 1024 + lane * 16), sf1, na);
                acc[tl] = na; }
        }
    }
    return;
#endif
    LAS unsigned char* base = F.lds + RING_OFF;
    const GAS unsigned char* rec0 = (const GAS unsigned char*)WSP(unsigned char, WS_CU) + (size_t)bh * NCHUNK * CU_BYTES;
#define CB_BAR() do { asm volatile("s_waitcnt lgkmcnt(0)" ::: "memory"); __builtin_amdgcn_s_barrier(); asm volatile("" ::: "memory"); } while (0)
    if (wave >= 1) {
        const int lt = F.tid - 64;
        v4u ra[8], rb[8];
        int so[8];
#pragma unroll
        for (int j = 0; j < 8; ++j) { const int p = lt + 448 * j, st = p / 800, off = p % 800; so[j] = st * CU_BYTES + off * 16 + (off >= 640 ? q * CU_QSTR : 0); }
        const bool last_ok = (wave == 1);
#define CB_LOAD(rg, blk) do { const GAS unsigned char* bp = rec0 + (size_t)(blk) * CB_STEPS * CU_BYTES; \
            _Pragma("unroll") for (int j = 0; j < 7; ++j) rg[j] = *(const GAS v4u*)(bp + so[j]); if (last_ok) rg[7] = *(const GAS v4u*)(bp + so[7]); } while (0)
#define CB_STORE(rg, bi) do { LAS unsigned char* dp = base + (bi) * CB_BUF + lt * 16; \
            _Pragma("unroll") for (int j = 0; j < 7; ++j) *(LAS v4u*)(dp + j * 448 * 16) = rg[j]; if (last_ok) *(LAS v4u*)(dp + 7 * 448 * 16) = rg[7]; } while (0)
        static_assert(CB_NBLK % 2 == 0 && CB_NBLK >= 4, "block pairs");
        CB_LOAD(ra, 0); CB_STORE(ra, 0); CB_LOAD(rb, 1); CB_LOAD(ra, 2);
        CB_BAR();
        for (int blk = 0; blk < CB_NBLK; blk += 2) {
            CB_STORE(rb, 1); if (blk + 3 < CB_NBLK) CB_LOAD(rb, blk + 3);
            CB_BAR();
            if (blk + 2 < CB_NBLK) { CB_STORE(ra, 0); if (blk + 4 < CB_NBLK) CB_LOAD(ra, blk + 4); }
            CB_BAR();
        }
#undef CB_LOAD
#undef CB_STORE
    } else {
        const int l15 = lane & 15, g = lane >> 4;
        const f32x4 Z4 = (f32x4){0.f, 0.f, 0.f, 0.f};
        f32x4 acc[4] = {Z4, Z4, Z4, Z4};
        GAS float* Y = (GAS float*)(WSP(float, WS_YRAWW) + (size_t)(bh >> 4) * SEQ * RWW + (size_t)(bh & 15) * WD + 16 * q + l15 + (size_t)(4 * g) * RWW);
        CB_BAR();
        bf16x8 Mf[2][8], Of[2][2]; v2u Nt[2][4], Yt[2];
#define CB_FRAGS(sb_, k_) do { _Pragma("unroll") for (int j = 0; j < 8; ++j) Mf[k_][j] = *(const LAS bf16x8*)((sb_) + j * 1024 + lane * 16); \
        _Pragma("unroll") for (int j = 0; j < 4; ++j) Nt[k_][j] = *(const LAS v2u*)((sb_) + 10240 + j * 512 + lane * 8); \
        Of[k_][0] = *(const LAS bf16x8*)((sb_) + 8192 + lane * 16); Of[k_][1] = *(const LAS bf16x8*)((sb_) + 9216 + lane * 16); Yt[k_] = *(const LAS v2u*)((sb_) + 12288 + lane * 8); } while (0)
        for (int blk = 0; blk < CB_NBLK; ++blk) {
            const LAS unsigned char* bb = base + (blk & 1) * CB_BUF;
            CB_FRAGS(bb, 0);
#pragma unroll
            for (int st = 0; st < CB_STEPS; ++st) {
                const int c = st & 1;
                if (st + 1 < CB_STEPS) CB_FRAGS(bb + (st + 1) * CB_STEP_BYTES, (c ^ 1));
                const bf16x8 sf0 = pk8v(acc[0], acc[1]), sf1 = pk8v(acc[2], acc[3]);
                f32x4 ya = unpk4(Yt[c]);
                ya = mma32(Of[c][0], sf0, ya); ya = mma32(Of[c][1], sf1, ya);
                GAS float* yp = Y + (size_t)((blk * CB_STEPS + st) * CK) * RWW;
#pragma unroll
                for (int i = 0; i < 4; ++i) yp[(size_t)i * RWW] = ya[i];
                f32x4 na[4];
#pragma unroll
                for (int tl = 0; tl < 4; ++tl) na[tl] = mma32(Mf[c][tl * 2 + 0], sf0, unpk4(Nt[c][tl]));
#pragma unroll
                for (int tl = 0; tl < 4; ++tl) acc[tl] = mma32(Mf[c][tl * 2 + 1], sf1, na[tl]);
            }
            CB_BAR();
        }
#undef CB_FRAGS
    }
#undef CB_BAR
}
constexpr int RT_STR = 288, RT_QS = 0, RT_KS = 128 * RT_STR, RT_VSTR = 80, RT_VS = 2 * 128 * RT_STR, RT_VPS = RT_VS + 128 * RT_VSTR, RT_RT = RT_VPS + 128 * RT_VSTR, RT_RTSZ = 32 * RT_STR;
static_assert(RT_RT + 2 * RT_RTSZ <= RING_BYTES, "retention LDS");
__device__ __forceinline__ bf16x8 tr8(const LAS unsigned char* p0, const LAS unsigned char* p1) {
    const s4v a = __builtin_amdgcn_ds_read_tr16_b64_v4i16((LAS s4v*)p0), b = __builtin_amdgcn_ds_read_tr16_b64_v4i16((LAS s4v*)p1);
    return (bf16x8){a.x, a.y, a.z, a.w, b.x, b.y, b.z, b.w};
}
__device__ __forceinline__ void scan_ret_mfma(Frame& F, int w_) {
    const int b = w_ >> 5, h = (w_ >> 2) & 7, eq = w_ & 3;
    const int tid = F.tid, lane = F.lane, w = F.wave, l15 = lane & 15, g = lane >> 4, tq = l15 >> 2, tp = l15 & 3;
    LAS unsigned char* L = F.lds + RING_OFF;
    const float lg2 = log1pf(-exp2f((float)(-5 - h))) * 1.4426950408889634f;
    const float gC = __builtin_amdgcn_exp2f(lg2 * 128.f);
    for (int i = tid; i < RT_RTSZ / 4; i += NWAVES * 64) ((LAS unsigned*)(L + RT_RT))[i] = 0u;
    const GAS bf16* Qg = (const GAS bf16*)(WSP(bf16, WS_QR) + (size_t)b * SEQ * RETW + h * RD);
    const GAS bf16* Kg = (const GAS bf16*)(WSP(bf16, WS_KR) + (size_t)b * SEQ * RETW + h * RD);
    const GAS bf16* Vg = (const GAS bf16*)(WSP(bf16, WS_Z) + (size_t)b * SEQ * INW + ZC_V + h * RD + 32 * eq);
    GAS float* Yg = (GAS float*)(WSP(float, WS_YRAWR) + (size_t)b * SEQ * RETW + h * RD + 32 * eq);
    v4u rq[4], rk[4], rv;
#define RT_LOAD(n_) do { _Pragma("unroll") for (int i = 0; i < 4; ++i) { const int f = tid + 512 * i, c = f >> 4, pc = f & 15; \
        rq[i] = *(const GAS v4u*)(Qg + (size_t)((n_) * 128 + c) * RETW + 8 * pc); rk[i] = *(const GAS v4u*)(Kg + (size_t)((n_) * 128 + c) * RETW + 8 * pc); } \
        rv = *(const GAS v4u*)(Vg + (size_t)((n_) * 128 + (tid >> 2)) * INW + 8 * (tid & 3)); } while (0)
    f32x4 accR[2] = {(f32x4){0.f, 0.f, 0.f, 0.f}, (f32x4){0.f, 0.f, 0.f, 0.f}};
    RT_LOAD(0);
    for (int n = 0; n < SEQ / 128; ++n) {
#pragma unroll
        for (int i = 0; i < 4; ++i) { const int f = tid + 512 * i, c = f >> 4, pc = f & 15;
            *(LAS v4u*)(L + RT_QS + c * RT_STR + pc * 16) = rq[i]; *(LAS v4u*)(L + RT_KS + c * RT_STR + pc * 16) = rk[i]; }
        { const int c = tid >> 2, pc = tid & 3; *(LAS v4u*)(L + RT_VS + c * RT_VSTR + pc * 16) = rv;
          const float sc = __builtin_amdgcn_exp2f(lg2 * (float)(127 - c)); v4u o;
          o.x = pg8::cvt_pk_bf16(pg8::bf_lo(rv.x) * sc, pg8::bf_hi(rv.x) * sc); o.y = pg8::cvt_pk_bf16(pg8::bf_lo(rv.y) * sc, pg8::bf_hi(rv.y) * sc);
          o.z = pg8::cvt_pk_bf16(pg8::bf_lo(rv.z) * sc, pg8::bf_hi(rv.z) * sc); o.w = pg8::cvt_pk_bf16(pg8::bf_lo(rv.w) * sc, pg8::bf_hi(rv.w) * sc);
          *(LAS v4u*)(L + RT_VPS + c * RT_VSTR + pc * 16) = o; }
        __syncthreads();
        if (n + 1 < SEQ / 128) RT_LOAD(n + 1);
        bf16x8 qf[4];
#pragma unroll
        for (int ks = 0; ks < 4; ++ks) qf[ks] = *(const LAS bf16x8*)(L + RT_QS + (16 * w + l15) * RT_STR + (32 * ks + 8 * g) * 2);
        bf16x8 pf[4];
        const int cq = 16 * w + l15;
#pragma unroll
        for (int p = 0; p < 4; ++p) {
            f32x4 s0 = (f32x4){0.f, 0.f, 0.f, 0.f}, s1 = (f32x4){0.f, 0.f, 0.f, 0.f};
            if (2 * p <= w) {
#pragma unroll
                for (int ks = 0; ks < 4; ++ks) { const bf16x8 kf = *(const LAS bf16x8*)(L + RT_KS + (32 * p + l15) * RT_STR + (32 * ks + 8 * g) * 2);
                    s0 = __builtin_amdgcn_mfma_f32_16x16x32_bf16(kf, qf[ks], s0, 0, 0, 0); }
            }
            if (2 * p + 1 <= w) {
#pragma unroll
                for (int ks = 0; ks < 4; ++ks) { const bf16x8 kf = *(const LAS bf16x8*)(L + RT_KS + (32 * p + 16 + l15) * RT_STR + (32 * ks + 8 * g) * 2);
                    s1 = __builtin_amdgcn_mfma_f32_16x16x32_bf16(kf, qf[ks], s1, 0, 0, 0); }
            }
            float p0[4], p1[4];
#pragma unroll
            for (int i = 0; i < 4; ++i) { const int d0 = cq - (32 * p + 4 * g + i), d1 = d0 - 16;
                p0[i] = d0 >= 0 ? s0[i] * __builtin_amdgcn_exp2f(lg2 * (float)d0) : 0.f; p1[i] = d1 >= 0 ? s1[i] * __builtin_amdgcn_exp2f(lg2 * (float)d1) : 0.f; }
            v4u pk; pk.x = pg8::cvt_pk_bf16(p0[0], p0[1]); pk.y = pg8::cvt_pk_bf16(p0[2], p0[3]); pk.z = pg8::cvt_pk_bf16(p1[0], p1[1]); pk.w = pg8::cvt_pk_bf16(p1[2], p1[3]);
            pf[p] = __builtin_bit_cast(bf16x8, pk);
        }
        const LAS unsigned char* Rcur = L + RT_RT + (n & 1) * RT_RTSZ;
#pragma unroll
        for (int et = 0; et < 2; ++et) {
            f32x4 acc = (f32x4){0.f, 0.f, 0.f, 0.f};
#pragma unroll
            for (int ks = 0; ks < 4; ++ks) { const bf16x8 rf = *(const LAS bf16x8*)(Rcur + (16 * et + l15) * RT_STR + (32 * ks + 8 * g) * 2);
                acc = __builtin_amdgcn_mfma_f32_16x16x32_bf16(qf[ks], rf, acc, 0, 0, 0); }
#pragma unroll
            for (int i = 0; i < 4; ++i) acc[i] *= __builtin_amdgcn_exp2f(lg2 * (float)(16 * w + 4 * g + i + 1));
#pragma unroll
            for (int p = 0; p < 4; ++p) if (2 * p <= w) {
                const LAS unsigned char* vb = L + RT_VS + (32 * p + 4 * g + tq) * RT_VSTR + (16 * et + 4 * tp) * 2;
                const bf16x8 vf = tr8(vb, vb + 16 * RT_VSTR);
                acc = __builtin_amdgcn_mfma_f32_16x16x32_bf16(pf[p], vf, acc, 0, 0, 0); }
#pragma unroll
            for (int i = 0; i < 4; ++i) Yg[(size_t)(n * 128 + 16 * w + 4 * g + i) * RETW + 16 * et + l15] = acc[i];
        }
        LAS unsigned char* Rnxt = L + RT_RT + ((n + 1) & 1) * RT_RTSZ;
        accR[0] = accR[0] * gC; accR[1] = accR[1] * gC;
#pragma unroll
        for (int cs = 0; cs < 4; ++cs) {
            const LAS unsigned char* kb = L + RT_KS + (32 * cs + 8 * g + tq) * RT_STR + (16 * w + 4 * tp) * 2;
            const bf16x8 kt = tr8(kb, kb + 4 * RT_STR);
#pragma unroll
            for (int et = 0; et < 2; ++et) { const LAS unsigned char* vb = L + RT_VPS + (32 * cs + 8 * g + tq) * RT_VSTR + (16 * et + 4 * tp) * 2;
                const bf16x8 vt = tr8(vb, vb + 4 * RT_VSTR);
                accR[et] = __builtin_amdgcn_mfma_f32_16x16x32_bf16(kt, vt, accR[et], 0, 0, 0); }
        }
#pragma unroll
        for (int et = 0; et < 2; ++et) { v2u o; o.x = pg8::cvt_pk_bf16(accR[et][0], accR[et][1]); o.y = pg8::cvt_pk_bf16(accR[et][2], accR[et][3]);
            *(LAS v2u*)(Rnxt + (16 * et + l15) * RT_STR + (16 * w + 4 * g) * 2) = o; }
        __syncthreads();
    }
#undef RT_LOAD
}
__device__ __forceinline__ void ph_scan(Frame& F, ArgP A, int l) {
    if (F.G >= 256) {
        if (F.vcu >= 192) { if (l + 1 < DEPTH) { ph_convert(F, A, l + 1, F.vcu - 192, F.G - 192); if (MK_REP & 256) { __syncthreads(); ph_convert(F, A, l + 1, F.vcu - 192, F.G - 192); } } return; }
#if MK_CHUNKED
        if (F.vcu < 128) { scan_rwkv_chunk(F, F.vcu); if (MK_REP & 32) { __syncthreads(); scan_rwkv_chunk(F, F.vcu); } }
#else
        if (F.vcu < 128) { scan_rwkv_fast(F, F.vcu); if (MK_REP & 32) { __syncthreads(); scan_rwkv_fast(F, F.vcu); } }
#endif
        else if (F.vcu < 192) { scan_ret_mfma(F, F.vcu - 128); if (MK_REP & 64) { __syncthreads(); scan_ret_mfma(F, F.vcu - 128); } }
    } else {
        if (l + 1 < DEPTH) ph_convert(F, A, l + 1, F.vcu, F.G);
        const int gw = F.vcu * NWAVES + F.wave, NGW = F.G * NWAVES;
        const int stride = NGW >= 64 ? NGW / 64 : 1;
        if (gw % stride == 0) {
            for (int item = gw / stride; item < 64; item += (NGW + stride - 1) / stride) {
#if !MK_CHUNKED
                if (item < 32) scan_rwkv_naive(F, item); else
#endif
                scan_ret_naive(F, item < 32 ? item : item - 32);
            }
        }
    }
}
#if (MK_GLOBAL_GROUPS & 4)
#pragma pop_macro("WSP")
#pragma pop_macro("WSW")
#pragma pop_macro("OUTP")
#endif
#if (MK_GLOBAL_GROUPS & 8)
#pragma push_macro("WSP")
#pragma push_macro("WSW")
#pragma push_macro("OUTP")
#undef WSP
#undef WSW
#undef OUTP
#define WSP WSPG
#define WSW WSWG
#define OUTP OUTPG
#endif
template <int CTRL> __device__ __forceinline__ float dppx(float x) { return __builtin_bit_cast(float, __builtin_amdgcn_update_dpp(0, __builtin_bit_cast(int, x), CTRL, 0xF, 0xF, true)); }
__device__ __forceinline__ void ph_post(Frame& F, ArgP A, int l) {
    const int gw = F.vcu * NWAVES + F.wave, NGW = F.G * NWAVES, lane = F.lane, c0 = lane * 16;
    f32x4 gg[4], gb[4], lg[4], lb[4];
#pragma unroll
    for (int j = 0; j < 4; ++j) { gg[j] = *(const GAS f32x4*)(INP(A, 4) + (size_t)l * RETW + c0 + 4 * j); gb[j] = *(const GAS f32x4*)(INP(A, 5) + (size_t)l * RETW + c0 + 4 * j);
        lg[j] = *(const GAS f32x4*)(INP(A, 15) + (size_t)l * RWW + c0 + 4 * j); lb[j] = *(const GAS f32x4*)(INP(A, 16) + (size_t)l * RWW + c0 + 4 * j); }
    for (int m = gw; m < M; m += NGW) {
        {
            f32x4 y[4]; float s = 0.f;
#pragma unroll
            for (int j = 0; j < 4; ++j) { y[j] = *(const GAS f32x4*)(WSP(float, WS_YRAWR) + (size_t)m * RETW + c0 + 4 * j); s += (y[j].x + y[j].y) + (y[j].z + y[j].w); }
            const GAS bf16* zg = (const GAS bf16*)(WSP(bf16, WS_Z) + (size_t)m * INW + ZC_GR + c0);
            float g[16]; { float t[8]; unpack8(*(const GAS v4u*)zg, t);
#pragma unroll
                for (int j = 0; j < 8; ++j) g[j] = t[j]; unpack8(*(const GAS v4u*)(zg + 8), t);
#pragma unroll
                for (int j = 0; j < 8; ++j) g[8 + j] = t[j]; }
            s += dppx<0xB1>(s); s += dppx<0x4E>(s); s += dppx<0x141>(s);
            const float mean = s * (1.f / RD); float q = 0.f;
#pragma unroll
            for (int j = 0; j < 4; ++j) { y[j] = y[j] - mean; q += (y[j].x * y[j].x + y[j].y * y[j].y) + (y[j].z * y[j].z + y[j].w * y[j].w); }
            q += dppx<0xB1>(q); q += dppx<0x4E>(q); q += dppx<0x141>(q);
            const float rstd = __builtin_amdgcn_rsqf(q * (1.f / RD) + RET_GN_EPS);
            float o[16];
#pragma unroll
            for (int j = 0; j < 4; ++j)
#pragma unroll
                for (int k = 0; k < 4; ++k) { const float gr = g[4 * j + k]; o[4 * j + k] = (y[j][k] * rstd * gg[j][k] + gb[j][k]) * (gr * fsig(gr)); }
            GAS bf16* yo = (GAS bf16*)(WSP(bf16, WS_YRET) + (size_t)m * RETW + c0);
            { float t[8];
#pragma unroll
              for (int j = 0; j < 8; ++j) t[j] = o[j]; *(GAS bf16x8*)yo = pack8(t);
#pragma unroll
              for (int j = 0; j < 8; ++j) t[j] = o[8 + j]; *(GAS bf16x8*)(yo + 8) = pack8(t); }
        }
        {
            const size_t ob = (size_t)m * RWW + c0;
            f32x4 y[4]; float s = 0.f;
#pragma unroll
            for (int j = 0; j < 4; ++j) { y[j] = *(const GAS f32x4*)(WSP(float, WS_YRAWW) + ob + 4 * j); s += (y[j].x + y[j].y) + (y[j].z + y[j].w); }
            f32x4 vv[4], gt[4];
#pragma unroll
            for (int j = 0; j < 4; ++j) { vv[j] = *(const GAS f32x4*)(WSP(float, WS_SV) + ob + 4 * j); gt[j] = *(const GAS f32x4*)(WSP(float, WS_G) + ob + 4 * j); }
            const float bonus = *(const GAS float*)(WSP(float, WS_BONUS) + (size_t)m * WH + (lane >> 2));
            s += dppx<0xB1>(s); s += dppx<0x4E>(s);
            const float mean = s * (1.f / WD); float q = 0.f;
#pragma unroll
            for (int j = 0; j < 4; ++j) { y[j] = y[j] - mean; q += (y[j].x * y[j].x + y[j].y * y[j].y) + (y[j].z * y[j].z + y[j].w * y[j].w); }
            q += dppx<0xB1>(q); q += dppx<0x4E>(q);
            const float rstd = __builtin_amdgcn_rsqf(q * (1.f / WD) + RWKV_LN_EPS);
            float o[16];
#pragma unroll
            for (int j = 0; j < 4; ++j)
#pragma unroll
                for (int k = 0; k < 4; ++k) o[4 * j + k] = (y[j][k] * rstd * lg[j][k] + lb[j][k] + bonus * vv[j][k]) * gt[j][k];
            GAS bf16* yo = (GAS bf16*)(WSP(bf16, WS_YRWKV) + ob);
            { float t[8];
#pragma unroll
              for (int j = 0; j < 8; ++j) t[j] = o[j]; *(GAS bf16x8*)yo = pack8(t);
#pragma unroll
              for (int j = 0; j < 8; ++j) t[j] = o[8 + j]; *(GAS bf16x8*)(yo + 8) = pack8(t); }
        }
    }
}
__device__ __forceinline__ void ph_final(Frame& F, ArgP A) {
    const int gw = F.vcu * NWAVES + F.wave, NGW = F.G * NWAVES, lane = F.lane;
    const GAS f32x4* gr = (const GAS f32x4*)INP(A, 23) + lane;
    for (int m = gw; m < M; m += NGW) {
        GAS f32x4* xr = (GAS f32x4*)(OUTP + (size_t)m * D) + lane;
        f32x4 v[8]; float s = 0.f;
#pragma unroll
        for (int j = 0; j < 8; ++j) { v[j] = xr[64 * j]; s += (v[j].x * v[j].x + v[j].y * v[j].y) + (v[j].z * v[j].z + v[j].w * v[j].w); }
        const float rstd = 1.f / sqrtf(wave_sum(s) * (1.f / D) + NORM_EPS);
#pragma unroll
        for (int j = 0; j < 8; ++j) xr[64 * j] = v[j] * rstd * gr[64 * j];
    }
}
#if (MK_GLOBAL_GROUPS & 8)
#pragma pop_macro("WSP")
#pragma pop_macro("WSW")
#pragma pop_macro("OUTP")
#endif

__global__ void __launch_bounds__(NWAVES * 64, 2) hybrid_fwd(Args args) {
    extern __shared__ __attribute__((aligned(16))) unsigned char lds[];
    Frame F;
    F.lds = (LAS unsigned char*)lds;
    F.MISC = (volatile LAS unsigned*)(F.lds + MISC_OFF);
    F.tid = threadIdx.x; F.lane = F.tid & 63; F.wave = __builtin_amdgcn_readfirstlane(F.tid >> 6);
    int bx = blockIdx.x; F.G = gridDim.x; { F.vcu = (F.G % 8 == 0) ? (bx % 8) * (F.G / 8) + bx / 8 : bx; }
    F.ws = args.ws; F.out = args.out;
    for (int u = F.tid; u < (LDS_BYTES - LDSCTL_OFF) / 4; u += NWAVES * 64) ((LAS unsigned*)(F.lds + LDSCTL_OFF))[u] = 0u;
    __syncthreads();
    if (F.tid == 0) { volatile LAS unsigned* U = (volatile LAS unsigned*)(F.lds + MISC_OFF) + 16; const unsigned long long pw = (unsigned long long)args.ws, po = (unsigned long long)args.out, pa = (unsigned long long)__builtin_amdgcn_kernarg_segment_ptr();
        U[0] = (unsigned)pw; U[1] = (unsigned)(pw >> 32); U[2] = (unsigned)po; U[3] = (unsigned)(po >> 32); U[4] = (unsigned)pa; U[5] = (unsigned)(pa >> 32); U[6] = (unsigned)F.G; U[7] = (unsigned)F.vcu; U[8] = (unsigned)bx; }
    __syncthreads();
    XcdBarrier bar = xcd_barrier_post((unsigned*)(F.ws + WS_CTL) + CW_BAR, F.MISC + 8);

    ArgP ap = (ArgP)__builtin_amdgcn_kernarg_segment_ptr();
    const int lo = args.ph_lo, hi = args.ph_hi;
#define REPX(bit, body) do { body; if (MK_REP & (bit)) { __syncthreads(); body; } } while (0)
#define IN(k) (lo <= (k) && (k) < hi)
#define SEAM(k) do { if (IN(k) && IN((k) + 1)) xcd_barrier(bar); else __syncthreads(); } while (0)

    if (IN(PH_PRO)) { ph_prologue(F, ap); ph_convert(F, ap, 0, F.vcu, F.G); }
    SEAM(PH_PRO);
    for (int l = 0; l < DEPTH; ++l) {
        const int p0 = PH_L0 + l * PPL;
        RETID();
        { unsigned ba = MISC_OFF + 64; asm volatile("" : "+v"(ba));
          const volatile LAS v4u* U = (const volatile LAS v4u*)(F.lds + ba);
          const v4u ua = U[0], ub = U[1]; const unsigned uc = *(const volatile LAS unsigned*)(U + 2);
          const unsigned u0 = __builtin_amdgcn_readfirstlane(ua.x), u1 = __builtin_amdgcn_readfirstlane(ua.y), u2 = __builtin_amdgcn_readfirstlane(ua.z), u3 = __builtin_amdgcn_readfirstlane(ua.w);
          const unsigned u4 = __builtin_amdgcn_readfirstlane(ub.x), u5 = __builtin_amdgcn_readfirstlane(ub.y), u6 = __builtin_amdgcn_readfirstlane(ub.z), u7 = __builtin_amdgcn_readfirstlane(ub.w), u8 = __builtin_amdgcn_readfirstlane(uc);
          F.ws = (unsigned char*)(((unsigned long long)u1 << 32) | u0); F.out = (float*)(((unsigned long long)u3 << 32) | u2); ap = (ArgP)(((unsigned long long)u5 << 32) | u4);
          F.G = (int)u6; F.vcu = (int)u7; bx = (int)u8; F.wave = __builtin_amdgcn_readfirstlane(F.tid >> 6); }
        if (IN(p0 + LP_G1)) {
            pg8::Gemm g{WSPG(bf16, WS_H), WSWG(l, WO_WIN), M, INW, D}; pg8::StaticOrder S; S.init(M, INW, F.G, bx);
            pg8::EpiB<0> E{WSPG(bf16, WS_Z), INW, nullptr, 0, WSPG(float, WS_SS)};
            pg8::gemm_phase<pg8::EpiB<0>, pg8::StaticOrder, true, true>(F.lds + RING_OFF, g, S, E);
            if (MK_REP & 512) { __syncthreads(); pg8::gemm_phase<pg8::EpiB<0>, pg8::StaticOrder, true, true>(F.lds + RING_OFF, g, S, E); }
        }
        SEAM(p0 + LP_G1);
        if (IN(p0 + LP_PREP)) { int nrep_ = (MK_REP & 4) ? 2 : 1; asm volatile("" : "+s"(nrep_));
#pragma unroll 1
            for (int rep_ = 0; rep_ < nrep_; ++rep_) { RETID(); ph_prep(F, ap, l); __syncthreads(); } }
        SEAM(p0 + LP_PREP);
        if (IN(p0 + LP_SCAN)) { RETID(); REPX(8, ph_scan(F, ap, l)); }
        SEAM(p0 + LP_SCAN);
        if (IN(p0 + LP_POST)) { RETID(); REPX(16, ph_post(F, ap, l)); }
        SEAM(p0 + LP_POST);
        if (IN(p0 + LP_GA)) {
            pg8::Gemm g{WSPG(bf16, WS_YRET), WSWG(l, WO_WA), M, D, RETW}; pg8::StaticOrder S; S.init(M, D, F.G, bx);
            pg8::EpiB<2> E{WSPG(bf16, WS_MRG), D, WSPG(bf16, WS_Z) + ZC_GA, INW, nullptr};
            pg8::gemm_phase<pg8::EpiB<2>, pg8::StaticOrder, true, true>(F.lds + RING_OFF, g, S, E);
        }
        __syncthreads();
        if (IN(p0 + LP_GB)) {
            pg8::Gemm g{WSPG(bf16, WS_YRWKV), WSWG(l, WO_WB), M, D, RWW}; pg8::StaticOrder S; S.init(M, D, F.G, bx);
            pg8::EpiB<3> E{WSPG(bf16, WS_MRG), D, WSPG(bf16, WS_Z) + ZC_GB, INW, nullptr};
            pg8::gemm_phase<pg8::EpiB<3>, pg8::StaticOrder, true, true>(F.lds + RING_OFF, g, S, E);
        }
        SEAM(p0 + LP_GB);
        if (IN(p0 + LP_GO)) {
            pg8::Gemm g{WSPG(bf16, WS_MRG), WSWG(l, WO_WO), M, D, D}; pg8::StaticOrder S; S.init(M, D, F.G, bx);
            pg8::EpiResNorm E{OUTPG, D, WSPG(bf16, WS_H), WSPG(float, WS_SS)};
            pg8::gemm_phase<pg8::EpiResNorm, pg8::StaticOrder, true, true>(F.lds + RING_OFF, g, S, E);
        }
        SEAM(p0 + LP_GO);
        if (IN(p0 + LP_GUP)) {
            pg8::Gemm g{WSPG(bf16, WS_H), WSWG(l, WO_WUP), M, DFF, D}; pg8::StaticOrder S; S.init(M, DFF, F.G, bx);
            pg8::EpiB<1> E{WSPG(bf16, WS_UP), DFF, nullptr, 0, WSPG(float, WS_SS)};
            pg8::gemm_phase<pg8::EpiB<1>, pg8::StaticOrder, true, true>(F.lds + RING_OFF, g, S, E);
        }
        SEAM(p0 + LP_GUP);
        if (IN(p0 + LP_GDN)) {
            pg8::Gemm g{WSPG(bf16, WS_UP), WSWG(l, WO_WDN), M, D, DFF}; pg8::StaticOrder S; S.init(M, D, F.G, bx);
            pg8::EpiResNorm E{OUTPG, D, WSPG(bf16, WS_H), WSPG(float, WS_SS)};
            pg8::gemm_phase<pg8::EpiResNorm, pg8::StaticOrder, true, true>(F.lds + RING_OFF, g, S, E);
        }
        SEAM(p0 + LP_GDN);
    }
    if (IN(PH_FIN)) { RETID(); ph_final(F, ap); }
#undef IN
#undef SEAM
}

extern "C" void kernel_launch(void* const* d_in, const int* in_sizes, int n_in, void* d_out, int out_size, void* d_ws, size_t ws_size, hipStream_t stream) {
    static int grid = 0;
    if (grid == 0) {
        if (n_in != 24 || in_sizes[0] != M * D || out_size != M * D || ws_size < WS_END) { fprintf(stderr, "kernel_launch: built for 24 inputs, x and out of %d floats, >= %zu bytes of workspace; got n_in %d, in0 %d, out %d, ws %zu; nothing launched\n", M * D, (size_t)WS_END, n_in, n_in > 0 ? in_sizes[0] : -1, out_size, ws_size); grid = -1; return; }
        int dev = 0, cus = 0, per_cu = 0;
        if (hipGetDevice(&dev) != hipSuccess || hipDeviceGetAttribute(&cus, hipDeviceAttributeMultiprocessorCount, dev) != hipSuccess) { fprintf(stderr, "kernel_launch: hipGetDevice / hipDeviceGetAttribute failed; nothing launched\n"); grid = -1; return; }
        if (hipFuncSetAttribute((const void*)hybrid_fwd, hipFuncAttributeMaxDynamicSharedMemorySize, LDS_BYTES) != hipSuccess) { fprintf(stderr, "kernel_launch: hipFuncSetAttribute failed\n"); grid = -1; return; }
        if (hipOccupancyMaxActiveBlocksPerMultiprocessor(&per_cu, (const void*)hybrid_fwd, NWAVES * 64, LDS_BYTES) != hipSuccess || per_cu < 1)
            fprintf(stderr, "kernel_launch: note: the occupancy query reports %d workgroups per CU\n", per_cu);
        (void)hipGetLastError();
        grid = cus;
    }
    if (grid < 0) return;
    if (hipMemsetAsync((char*)d_ws + WS_CTL, 0, CTL_ZERO_BYTES, stream) != hipSuccess) { fprintf(stderr, "kernel_launch: hipMemsetAsync failed\n"); return; }
    Args a{};
    for (int i = 0; i < 24; ++i) a.in[i] = (const float*)d_in[i];
    a.out = (float*)d_out; a.ws = (unsigned char*)d_ws; a.li = 0; a.pad = 0;
#if MK_ONE_LAUNCH
    a.ph_lo = 0; a.ph_hi = NPH;
    hipLaunchKernelGGL(hybrid_fwd, dim3(grid), dim3(NWAVES * 64), LDS_BYTES, stream, a);
#else
    for (int p = 0; p < NPH; ++p) {
        a.ph_lo = p; a.ph_hi = p + 1;
        hipLaunchKernelGGL(hybrid_fwd, dim3(grid), dim3(NWAVES * 64), LDS_BYTES, stream, a);
    }
#endif
    const hipError_t le = hipPeekAtLastError();
    if (le != hipSuccess) fprintf(stderr, "kernel_launch: launch failed: %s\n", hipGetErrorName(le));
}
```

```cpp
#include <hip/hip_runtime.h>
#include <cstdio>
#include <cstdint>
#ifndef MK_GLOBAL_GROUPS
#define MK_GLOBAL_GROUPS 30
#endif
#ifndef MK_REP
#define MK_REP 0
#endif
namespace pg8 {
#define PG8_LAS __attribute__((address_space(3)))
typedef unsigned short bf16_t;
typedef short bf16x8 __attribute__((ext_vector_type(8)));
typedef float f32x4 __attribute__((ext_vector_type(4)));
typedef unsigned u32x4 __attribute__((ext_vector_type(4)));
constexpr int BM = 256, BK = 64, HALF = 128, HTB = HALF * BK * 2  , STAGE_BYTES = 8 * HTB, NXCD = 8, WGM = 8;

__host__ __device__ __forceinline__ int lds_byte(int r, int c) { const int st = (r >> 4) * 2 + (c >> 5), rr = r & 15, cc = c & 31, ob = rr * 64 + cc * 2; return st * 1024 + (ob ^ (((ob >> 9) & 1) << 5)); }
__host__ __device__ __forceinline__ void stage_rc(int b, int& R, int& C) { const int st = b / 1024, sb = b % 1024, swz = sb ^ (((sb >> 9) & 1) << 5); R = (st >> 1) * 16 + swz / 64; C = (st & 1) * 32 + (swz % 64) / 2; }
__host__ __device__ __forceinline__ int perm32(int rho) { const int n = rho >> 4, i = rho & 15; return 8 * (i >> 2) + 4 * n + (i & 3); }

struct Unit { int pm, pn; };
struct Gemm { const bf16_t* A; const bf16_t* Bt; int M, N, K; };

struct StaticOrder {
    int nM, nN, nwg, G, c;
    __host__ __device__ void init(int M, int N, int G_, int c_) { nM = M / BM; nN = N / BM; nwg = nM * nN; G = G_; c = c_; }
    __host__ __device__ bool next(int i, Unit& u) const {
        const long L = (long)i * G + c; if (L >= nwg) return false;
        int wgid = (int)L; { const int q = nwg / NXCD, r = nwg % NXCD, xcd = wgid % NXCD, off = wgid / NXCD; wgid = (xcd < r ? xcd * (q + 1) : r * (q + 1) + (xcd - r) * q) + off; }
        const int nig = WGM * nN, gid = wgid / nig, fm = gid * WGM, gsz = (nM - fm) < WGM ? (nM - fm) : WGM;
        u.pm = fm + ((wgid % nig) % gsz); u.pn = (wgid % nig) / gsz; return true;
    }
    __device__ __forceinline__ void a_ready(const Unit&) const {}
    __device__ __forceinline__ void done(const Unit&) const {}
};

typedef float f32x2c __attribute__((ext_vector_type(2))); typedef __bf16 bf16x2c __attribute__((ext_vector_type(2)));
__device__ __forceinline__ unsigned cvt_pk_bf16(float lo, float hi) { const f32x2c v = {lo, hi}; return __builtin_bit_cast(unsigned, __builtin_convertvector(v, bf16x2c)); }
typedef float f32x2 __attribute__((ext_vector_type(2)));
__device__ __forceinline__ float bf_lo(unsigned w) { return __builtin_bit_cast(float, w << 16); }
__device__ __forceinline__ float bf_hi(unsigned w) { return __builtin_bit_cast(float, w & 0xffff0000u); }
__device__ __forceinline__ float sigmoidf_(float x) { return 1.0f / (1.0f + __expf(-x)); }
template <int MODE> struct EpiB {
    static constexpr bool PERM = true, AFTER_DRAIN = false;
    bf16_t* O; int ldc; const bf16_t* gate; int ldg; const float* ss;
    __device__ __forceinline__ void operator()(const f32x4 (&acc)[2][2][4][2], const Unit& u, int wr, int wc, int fr, int fq) const {
        const int row0 = u.pm * BM + wr * 64 + fr, col0 = u.pn * BM + wc * 32 + 8 * fq;
        float rs[2][4];
        for (int rep_ = 0; rep_ < ((MK_REP & 128) ? 2 : 1); ++rep_) { asm volatile("" ::: "memory");
        if (MODE <= 1) {
            typedef __attribute__((address_space(1))) const f32x4 gf4;
            f32x4 q[2][4][2];
#pragma unroll
            for (int ai = 0; ai < 2; ++ai)
#pragma unroll
                for (int m = 0; m < 4; ++m) { gf4* sp = (gf4*)(ss + (size_t)(row0 + ai * HALF + m * 16) * 32) + fq * 2; q[ai][m][0] = sp[0]; q[ai][m][1] = sp[1]; }
#pragma unroll
            for (int ai = 0; ai < 2; ++ai)
#pragma unroll
                for (int m = 0; m < 4; ++m) { const f32x4 a = q[ai][m][0] + q[ai][m][1]; rs[ai][m] = (a[0] + a[1]) + (a[2] + a[3]); }
#pragma unroll
            for (int ai = 0; ai < 2; ++ai)
#pragma unroll
                for (int m = 0; m < 4; ++m) rs[ai][m] += __shfl_xor(rs[ai][m], 16);
#pragma unroll
            for (int ai = 0; ai < 2; ++ai)
#pragma unroll
                for (int m = 0; m < 4; ++m) { rs[ai][m] += __shfl_xor(rs[ai][m], 32); rs[ai][m] = __builtin_amdgcn_rsqf(rs[ai][m] * (1.0f / 2048.0f) + 1e-6f); }
        }
        if (MK_REP & 128) asm volatile("" : "+v"(rs[0][0]), "+v"(rs[1][3]) :: "memory"); }
#pragma unroll
        for (int ai = 0; ai < 2; ++ai)
#pragma unroll
            for (int m = 0; m < 4; ++m) { const size_t row = (size_t)(row0 + ai * HALF + m * 16);
#pragma unroll
                for (int bj = 0; bj < 2; ++bj) { f32x4 v0 = acc[ai][bj][m][0], v1 = acc[ai][bj][m][1]; const int c = col0 + bj * HALF;
                    if (MODE <= 1) { v0 = v0 * rs[ai][m]; v1 = v1 * rs[ai][m]; }
                    if (MODE == 1) {
#pragma unroll
                        for (int j = 0; j < 4; ++j) { const float a = fmaxf(v0[j], 0.f), b = fmaxf(v1[j], 0.f); v0[j] = a * a; v1[j] = b * b; } }
                    if (MODE >= 2) { const u32x4 g = *(const u32x4*)(gate + row * ldg + c);
                        v0[0] *= sigmoidf_(bf_lo(g.x)); v0[1] *= sigmoidf_(bf_hi(g.x)); v0[2] *= sigmoidf_(bf_lo(g.y)); v0[3] *= sigmoidf_(bf_hi(g.y));
                        v1[0] *= sigmoidf_(bf_lo(g.z)); v1[1] *= sigmoidf_(bf_hi(g.z)); v1[2] *= sigmoidf_(bf_lo(g.w)); v1[3] *= sigmoidf_(bf_hi(g.w)); }
                    if (MODE == 3) { const u32x4 o = *(const u32x4*)(O + row * ldc + c);
                        v0[0] += bf_lo(o.x); v0[1] += bf_hi(o.x); v0[2] += bf_lo(o.y); v0[3] += bf_hi(o.y);
                        v1[0] += bf_lo(o.z); v1[1] += bf_hi(o.z); v1[2] += bf_lo(o.w); v1[3] += bf_hi(o.w); }
                    u32x4 w; w.x = cvt_pk_bf16(v0[0], v0[1]); w.y = cvt_pk_bf16(v0[2], v0[3]); w.z = cvt_pk_bf16(v1[0], v1[1]); w.w = cvt_pk_bf16(v1[2], v1[3]);
                    *(u32x4*)(O + row * ldc + c) = w; } }
    }
};
struct EpiResNorm {
    static constexpr bool PERM = true, AFTER_DRAIN = false;
    float* X; int ldc; bf16_t* XB; float* SS; const float* Xin;
    __device__ __forceinline__ void operator()(const f32x4 (&acc)[2][2][4][2], const Unit& u, int wr, int wc, int fr, int fq) const {
        const int row0 = u.pm * BM + wr * 64 + fr, col0 = u.pn * BM + wc * 32 + 8 * fq;
#pragma unroll
        for (int ai = 0; ai < 2; ++ai)
#pragma unroll
            for (int m = 0; m < 4; ++m) { const size_t row = (size_t)(row0 + ai * HALF + m * 16);
                float s = 0.f;
#pragma unroll
                for (int bj = 0; bj < 2; ++bj) { const int c = col0 + bj * HALF; float* p = X + row * ldc + c; const float* pi = Xin + row * ldc + c;
                    const f32x4 x0 = *(const f32x4*)pi + acc[ai][bj][m][0], x1 = *(const f32x4*)(pi + 4) + acc[ai][bj][m][1];
                    *(f32x4*)p = x0; *(f32x4*)(p + 4) = x1;
                    u32x4 w; w.x = cvt_pk_bf16(x0[0], x0[1]); w.y = cvt_pk_bf16(x0[2], x0[3]); w.z = cvt_pk_bf16(x1[0], x1[1]); w.w = cvt_pk_bf16(x1[2], x1[3]);
                    *(u32x4*)(XB + row * ldc + c) = w;
                    s += ((x0[0] * x0[0] + x0[1] * x0[1]) + (x0[2] * x0[2] + x0[3] * x0[3])) + ((x1[0] * x1[0] + x1[1] * x1[1]) + (x1[2] * x1[2] + x1[3] * x1[3])); }
                s += __shfl_xor(s, 16); s += __shfl_xor(s, 32);
                if (fq == 0) SS[row * 32 + u.pn * 4 + wc] = s; }
    }
};

template <class Epi, class Sched, bool ALIGN_EPI = false, bool SP2 = false>
__device__ __forceinline__ void gemm_phase(PG8_LAS unsigned char* lds, const Gemm g, const Sched& S, const Epi& E) {
    int tid_ = threadIdx.x; asm volatile("" : "+v"(tid_));
    const int tid = tid_, wid = __builtin_amdgcn_readfirstlane(tid >> 6), lane = tid & 63, wr = wid >> 2, wc = wid & 3, fr = lane & 15, fq = lane >> 4;
    const int K = g.K, nt = K / BK;
    unsigned voffA[2], voffB[2];
#pragma unroll
    for (int i = 0; i < 2; ++i) { int R, C; stage_rc(tid * 16 + i * 8192, R, C); const int Rb = Epi::PERM ? ((R & ~31) + perm32(R & 31)) : R;
        voffA[i] = (unsigned)(R * K + C) * 2u; voffB[i] = (unsigned)(Rb * K + C) * 2u; }
    const size_t kstep = (size_t)(BK * 2);
    const size_t hstep = (size_t)HALF * K * 2;
    const size_t tstep = 2 * hstep;
    const unsigned ldsw = (unsigned)wid * 1024u;
    const int aoff = lds_byte(wr * 64 + fr, fq * 8), boff = lds_byte(wc * 32 + fr, fq * 8);
#define PG8_SA(b, h) (((b) * 2 + (h)) * HTB)
#define PG8_SB(b, h) ((4 + (b) * 2 + (h)) * HTB)
#define PG8_STAGE(bufoff, gbase, voff) do { _Pragma("unroll") for (int _i = 0; _i < 2; ++_i) \
        __builtin_amdgcn_global_load_lds((const unsigned*)((const char*)(gbase) + (voff)[_i]), (PG8_LAS unsigned*)(lds + (bufoff) + ldsw + _i * 8192), 16, 0, 0); } while (0)
#define PG8_LDA(dst, b, h) do { _Pragma("unroll") for (int m = 0; m < 4; ++m) _Pragma("unroll") for (int k = 0; k < 2; ++k) dst[m][k] = *(const PG8_LAS bf16x8*)(lds + PG8_SA(b, h) + aoff + m * 2048 + k * 1024); } while (0)
#define PG8_LDB(dst, b, h) do { _Pragma("unroll") for (int n = 0; n < 2; ++n) _Pragma("unroll") for (int k = 0; k < 2; ++k) dst[n][k] = *(const PG8_LAS bf16x8*)(lds + PG8_SB(b, h) + boff + n * 2048 + k * 1024); } while (0)
#define PG8_MMA(ai, bj, At, Bt) do { __builtin_amdgcn_s_setprio(1); _Pragma("unroll") for (int m = 0; m < 4; ++m) _Pragma("unroll") for (int n = 0; n < 2; ++n) _Pragma("unroll") for (int k = 0; k < 2; ++k) \
        acc[ai][bj][m][n] = __builtin_amdgcn_mfma_f32_16x16x32_bf16(Bt[n][k], At[m][k], acc[ai][bj][m][n], 0, 0, 0); __builtin_amdgcn_s_setprio(0); } while (0)
#define PG8_WAIT_V(n) asm volatile("s_waitcnt vmcnt(" #n ")" ::: "memory")
#define PG8_WAIT_L(n) asm volatile("s_waitcnt lgkmcnt(" #n ")" ::: "memory")
#define PG8_BAR __builtin_amdgcn_s_barrier()
#define PG8_SCHED __builtin_amdgcn_sched_barrier(0)
    Unit cur, nxt; int ui = 0;
    if (!S.next(0, cur)) return;
    f32x4 acc[2][2][4][2];
#pragma unroll
    for (int a = 0; a < 2; ++a)
#pragma unroll
        for (int b = 0; b < 2; ++b)
#pragma unroll
            for (int m = 0; m < 4; ++m)
#pragma unroll
                for (int n = 0; n < 2; ++n) acc[a][b][m][n] = (f32x4){0.f, 0.f, 0.f, 0.f};
    bf16x8 At[4][2], B0[2][2], B1[2][2];
    const char* cA = (const char*)g.A + (size_t)cur.pm * tstep; const char* cB = (const char*)g.Bt + (size_t)cur.pn * tstep;
    S.a_ready(cur);
    if constexpr (SP2) {
        PG8_STAGE(PG8_SB(0, 0), cB, voffB); PG8_STAGE(PG8_SB(0, 1), cB + hstep, voffB); PG8_STAGE(PG8_SA(0, 0), cA, voffA); PG8_STAGE(PG8_SA(0, 1), cA + hstep, voffA);
        if (wr == 1) PG8_BAR;
        PG8_WAIT_V(2); PG8_BAR;
        PG8_STAGE(PG8_SB(1, 0), cB + kstep, voffB); PG8_STAGE(PG8_SA(1, 0), cA + kstep, voffA); PG8_STAGE(PG8_SB(1, 1), cB + hstep + kstep, voffB);
        PG8_WAIT_V(6); PG8_BAR;
    } else {
        PG8_STAGE(PG8_SB(0, 0), cB, voffB); PG8_STAGE(PG8_SA(0, 0), cA, voffA); PG8_STAGE(PG8_SB(0, 1), cB + hstep, voffB); PG8_STAGE(PG8_SA(0, 1), cA + hstep, voffA);
        if (wr == 1) PG8_BAR;
        PG8_WAIT_V(4); PG8_BAR;
        PG8_STAGE(PG8_SB(1, 0), cB + kstep, voffB); PG8_STAGE(PG8_SA(1, 0), cA + kstep, voffA); PG8_STAGE(PG8_SB(1, 1), cB + hstep + kstep, voffB);
        PG8_WAIT_V(6); PG8_BAR;
    }
    for (;;) {
        const bool has_next = S.next(ui + 1, nxt);
        const char* nA = has_next ? (const char*)g.A + (size_t)nxt.pm * tstep : cA; const char* nB = has_next ? (const char*)g.Bt + (size_t)nxt.pn * tstep : cB;
        for (int t = 0; t < nt; t += 2) {
            const bool last = (t == nt - 2);
            const char* a1 = cA + (size_t)(t + 1) * kstep;
            const char* a2 = last ? nA : cA + (size_t)(t + 2) * kstep; const char* b2 = last ? nB : cB + (size_t)(t + 2) * kstep;
            const char* a3 = a2 + kstep; const char* b3 = b2 + kstep;
            if (last && has_next) S.a_ready(nxt);
            if constexpr (SP2) {
            PG8_LDB(B0, 0, 0); PG8_LDB(B1, 0, 1); PG8_SCHED; PG8_LDA(At, 0, 0); PG8_STAGE(PG8_SA(1, 1), a1 + hstep, voffA);
            PG8_WAIT_V(8); PG8_WAIT_L(0); PG8_BAR; PG8_MMA(0, 0, At, B0); PG8_MMA(0, 1, At, B1); PG8_BAR; PG8_SCHED;
            PG8_LDA(At, 0, 1); PG8_STAGE(PG8_SB(0, 0), b2, voffB); PG8_STAGE(PG8_SB(0, 1), b2 + hstep, voffB); PG8_STAGE(PG8_SA(0, 0), a2, voffA);
            PG8_WAIT_V(8); PG8_WAIT_L(0); PG8_BAR; PG8_MMA(1, 0, At, B0); PG8_MMA(1, 1, At, B1); PG8_BAR; PG8_SCHED;
            PG8_LDB(B0, 1, 0); PG8_LDB(B1, 1, 1); PG8_SCHED; PG8_LDA(At, 1, 0); PG8_STAGE(PG8_SA(0, 1), a2 + hstep, voffA);
            PG8_WAIT_V(8); PG8_WAIT_L(0); PG8_BAR; PG8_MMA(0, 0, At, B0); PG8_MMA(0, 1, At, B1); PG8_BAR; PG8_SCHED;
            PG8_LDA(At, 1, 1); PG8_STAGE(PG8_SB(1, 0), b3, voffB); PG8_STAGE(PG8_SB(1, 1), b3 + hstep, voffB); PG8_STAGE(PG8_SA(1, 0), a3, voffA);
            PG8_WAIT_V(8); PG8_WAIT_L(0); PG8_BAR; PG8_MMA(1, 0, At, B0); PG8_MMA(1, 1, At, B1); PG8_BAR; PG8_SCHED;
            } else {
            PG8_LDB(B0, 0, 0); PG8_SCHED; PG8_LDA(At, 0, 0); PG8_STAGE(PG8_SA(1, 1), a1 + hstep, voffA);
            PG8_WAIT_L(8); PG8_BAR; PG8_WAIT_L(0); PG8_MMA(0, 0, At, B0); PG8_BAR; PG8_SCHED;
            PG8_LDB(B1, 0, 1); PG8_STAGE(PG8_SB(0, 0), b2, voffB);
            PG8_BAR; PG8_WAIT_L(0); PG8_MMA(0, 1, At, B1); PG8_BAR;
            PG8_LDA(At, 0, 1); PG8_STAGE(PG8_SA(0, 0), a2, voffA);
            PG8_BAR; PG8_WAIT_L(0); PG8_MMA(1, 0, At, B0); PG8_BAR; PG8_SCHED;
            PG8_STAGE(PG8_SB(0, 1), b2 + hstep, voffB);
            PG8_WAIT_V(6); PG8_BAR; PG8_MMA(1, 1, At, B1); PG8_BAR;
            PG8_LDB(B0, 1, 0); PG8_SCHED; PG8_LDA(At, 1, 0); PG8_STAGE(PG8_SA(0, 1), a2 + hstep, voffA);
            PG8_WAIT_L(8); PG8_BAR; PG8_WAIT_L(0); PG8_MMA(0, 0, At, B0); PG8_BAR; PG8_SCHED;
            PG8_LDB(B1, 1, 1); PG8_STAGE(PG8_SB(1, 0), b3, voffB);
            PG8_BAR; PG8_WAIT_L(0); PG8_MMA(0, 1, At, B1); PG8_BAR;
            PG8_LDA(At, 1, 1); PG8_STAGE(PG8_SA(1, 0), a3, voffA);
            PG8_BAR; PG8_WAIT_L(0); PG8_MMA(1, 0, At, B0); PG8_BAR; PG8_SCHED;
            PG8_STAGE(PG8_SB(1, 1), b3 + hstep, voffB);
            PG8_WAIT_V(6); PG8_BAR; PG8_MMA(1, 1, At, B1); PG8_BAR;
            }
        }
        if constexpr (ALIGN_EPI) { if (wr == 0) PG8_BAR; }
        if constexpr (!Epi::AFTER_DRAIN) { E(acc, cur, wr, wc, fr, fq); S.done(cur); }
        if (!has_next) break;
#pragma unroll
        for (int a = 0; a < 2; ++a)
#pragma unroll
            for (int b = 0; b < 2; ++b)
#pragma unroll
                for (int m = 0; m < 4; ++m)
#pragma unroll
                    for (int n = 0; n < 2; ++n) acc[a][b][m][n] = (f32x4){0.f, 0.f, 0.f, 0.f};
        cur = nxt; cA = nA; cB = nB; ++ui;
        if constexpr (ALIGN_EPI) { if (wr == 1) PG8_BAR; }
    }
    PG8_WAIT_V(0);
    if constexpr (!ALIGN_EPI) { if (wr == 0) PG8_BAR; }
    PG8_BAR;
    if constexpr (Epi::AFTER_DRAIN) { E.fused(acc, cur, wr, wc, fr, fq, lds, wid, lane); S.done(cur); }
#undef PG8_SA
#undef PG8_SB
#undef PG8_STAGE
#undef PG8_LDA
#undef PG8_LDB
#undef PG8_MMA
#undef PG8_WAIT_V
#undef PG8_WAIT_L
#undef PG8_BAR
#undef PG8_SCHED
}
}
constexpr int NWAVES = 8;
#ifndef MK_ONE_LAUNCH
#define MK_ONE_LAUNCH 1
#endif

#ifndef MK_GLOBAL_GROUPS
#define MK_GLOBAL_GROUPS 30
#endif
#ifndef MK_CHUNKED
#define MK_CHUNKED 1
#endif
#ifndef MK_SP2
#define MK_SP2 true
#endif
#ifndef MK_ALIGN
#define MK_ALIGN true
#endif
#ifndef MK_CONV_IN_G1
#define MK_CONV_IN_G1 0
#endif
#ifndef MK_REP
#define MK_REP 0
#endif

constexpr int BATCH = 2, SEQ = 8192, D = 2048, DEPTH = 4, M = BATCH * SEQ;
constexpr int RETW = 1024, RH = 8, RD = 128, RWW = 1024, WH = 16, WD = 64;
constexpr int INW = 11520, DFF = 8192, RWSHIFT = 3328;
constexpr int ZC_Q = 0, ZC_K = 1024, ZC_V = 2048, ZC_GR = 3072, ZC_RW = 4096, ZC_GA = 7424, ZC_GB = 9472;
constexpr int RWC_R = 0, RWC_K = 1024, RWC_V = 2048, RWC_W = 3072, RWC_A = 3136, RWC_G = 3200;
constexpr float NORM_EPS = 1e-6f, RET_GN_EPS = 1e-5f, RWKV_LN_EPS = 64e-5f;

constexpr size_t MiB = 1u << 20;
constexpr size_t WS_CTL = 0, CTL_ZERO_BYTES = 1 * MiB;
constexpr size_t WS_ROPE = 1 * MiB;
constexpr size_t WS_WSET = 16 * MiB, WSET_BYTES = 126 * MiB;
constexpr size_t WO_WIN = 0, WO_WA = 45 * MiB, WO_WB = 49 * MiB, WO_WO = 53 * MiB, WO_WUP = 61 * MiB, WO_WDN = 93 * MiB, WO_LORA = 125 * MiB;
constexpr size_t WS_H = 272 * MiB;
constexpr size_t WS_Z = 336 * MiB;
constexpr size_t WS_UP = WS_Z;
constexpr size_t WS_QR = 696 * MiB, WS_KR = 728 * MiB;
constexpr size_t WS_YRET = 760 * MiB, WS_YRWKV = 792 * MiB;
constexpr size_t WS_MRG = 824 * MiB;
#if MK_CHUNKED
constexpr size_t WS_SR = 888 * MiB, WS_SV = 1208 * MiB;
#else
constexpr size_t WS_SR = 888 * MiB, WS_SW = 952 * MiB, WS_SK = 1016 * MiB, WS_SV = 1080 * MiB, WS_SNKK = 1144 * MiB, WS_SKKA = 1208 * MiB;
#endif
constexpr size_t WS_CU = WS_SR;
constexpr size_t WS_G = 1272 * MiB;
constexpr size_t WS_BONUS = 1336 * MiB;
constexpr size_t WS_SS = 1337 * MiB;
constexpr size_t WS_YRAWR = WS_H, WS_YRAWW = WS_MRG;
constexpr size_t WS_END = 1341 * MiB;
constexpr int CW_BAR = 4096;

constexpr int PPL = 9;
enum { LP_G1 = 0, LP_PREP, LP_SCAN, LP_POST, LP_GA, LP_GB, LP_GO, LP_GUP, LP_GDN };
constexpr int PH_PRO = 0, PH_L0 = 1, PH_FIN = PH_L0 + DEPTH * PPL, NPH = PH_FIN + 1;

constexpr int RING_OFF = 0, RING_BYTES = 131072;
constexpr int LDSCTL_OFF = RING_BYTES, MISC_OFF = LDSCTL_OFF + 320;
constexpr int LDS_BYTES = 147456;
static_assert(MISC_OFF + 128 <= LDS_BYTES, "LDS map");

#define GAS __attribute__((address_space(1)))
#define LAS __attribute__((address_space(3)))
typedef unsigned short bf16;
typedef unsigned v4u __attribute__((ext_vector_type(4)));
typedef unsigned v2u __attribute__((ext_vector_type(2)));
typedef float f32x4 __attribute__((ext_vector_type(4)));
typedef float f32x2 __attribute__((ext_vector_type(2)));
typedef short bf16x8 __attribute__((ext_vector_type(8)));
typedef GAS unsigned gu32;
#define LDS_WAIT() asm volatile("s_waitcnt lgkmcnt(0)" ::: "memory")
#define VM_WAIT() asm volatile("s_waitcnt vmcnt(0)" ::: "memory")
__device__ __forceinline__ unsigned f2bf(float f) { unsigned u = __builtin_bit_cast(unsigned, f); return (u + 0x7fffu + ((u >> 16) & 1u)) >> 16; }
__device__ __forceinline__ unsigned pk2(float lo, float hi) { return f2bf(lo) | (f2bf(hi) << 16); }
__device__ __forceinline__ float bf2f(bf16 v) { return __builtin_bit_cast(float, (unsigned)v << 16); }
__device__ __forceinline__ float rdlane(float v, int l) { return __builtin_bit_cast(float, __builtin_amdgcn_readlane(__builtin_bit_cast(int, v), l)); }
__device__ __forceinline__ float sigm(float x) { return 1.0f / (1.0f + expf(-x)); }

__device__ const double ROPE_REV[64] = {
0.15915494309189535, 0.13782250260398285, 0.11934937021124886, 0.10335229661843406,
0.08949940160889101, 0.07750328875537406, 0.06711508300522726, 0.058119267441876246,
0.050329212104487035, 0.04358330210530733, 0.03774158471741977, 0.032682865872357,
0.0283021958306234, 0.024508691862069852, 0.02122365276477766, 0.018378926105679667,
0.015915494309189534, 0.013782250260398284, 0.011934937021124886, 0.010335229661843406,
0.008949940160889102, 0.0077503288755374055, 0.006711508300522725, 0.005811926744187624,
0.005032921210448704, 0.004358330210530733, 0.003774158471741977, 0.0032682865872356993,
0.00283021958306234, 0.002450869186206985, 0.0021223652764777662, 0.0018378926105679667,
0.0015915494309189536, 0.0013782250260398288, 0.0011934937021124885, 0.0010335229661843405,
0.0008949940160889102, 0.0007750328875537405, 0.0006711508300522726, 0.0005811926744187624,
0.0005032921210448703, 0.0004358330210530733, 0.00037741584717419774, 0.0003268286587235699,
0.00028302195830623395, 0.00024508691862069854, 0.0002122365276477766, 0.00018378926105679666,
0.00015915494309189535, 0.00013782250260398286, 0.00011934937021124886, 0.00010335229661843406,
8.949940160889102e-05, 7.750328875537406e-05, 6.711508300522725e-05, 5.811926744187624e-05,
5.0329212104487035e-05, 4.358330210530732e-05, 3.774158471741978e-05, 3.2682865872357e-05,
2.8302195830623396e-05, 2.4508691862069852e-05, 2.122365276477766e-05, 1.8378926105679668e-05 };

#define XB_TMO      128
#define XB_XCNT(j)  (256  + 64 * (j))
#define XB_XSUB(j)  (1280 + 64 * (j))
#define XB_XGEN(j)  (2304 + 64 * (j))
#define XB_TOP      3328
#define XB_TOPGEN   3392
#define XCD_BAR_WORDS 3456
#define XB_SPIN_CAP (1u << 18)

__device__ __forceinline__ unsigned xb_ld(unsigned* p)              { return __hip_atomic_load(p, __ATOMIC_RELAXED, __HIP_MEMORY_SCOPE_AGENT); }
__device__ __forceinline__ unsigned xb_add(unsigned* p, unsigned v) { return __hip_atomic_fetch_add(p, v, __ATOMIC_RELAXED, __HIP_MEMORY_SCOPE_AGENT); }
__device__ __forceinline__ unsigned xb_xcc_id() { return (unsigned)__builtin_amdgcn_s_getreg((3 << 11) | 20) & 0xFu; }
#define XB_SPIN(cond, bar) do { unsigned _sp = 0; while (cond) { __builtin_amdgcn_s_sleep(1); \
    if ((++_sp & 255u) == 0u) { if (xb_ld(&(bar)[XB_TMO])) break; if (_sp > XB_SPIN_CAP) { atomicAdd(&(bar)[XB_TMO], 1u); break; } } } } while (0)

struct XcdBarrier {
    unsigned* bar; unsigned x;
    volatile LAS unsigned* st;
};

__device__ __forceinline__ XcdBarrier xcd_barrier_post(unsigned* bar, volatile LAS unsigned* st) {
    XcdBarrier b; b.bar = bar; b.x = xb_xcc_id(); b.st = st;
    if (threadIdx.x == 0) (void)xb_add(&bar[XB_XCNT(b.x)], 1u);
    return b;
}
__device__ __forceinline__ void xcd_barrier_complete(unsigned* bar, unsigned x, unsigned& nloc, unsigned& nx) {
    const unsigned G = gridDim.x * gridDim.y * gridDim.z;
    unsigned sum, cnt, mine, sp = 0u;
    for (;;) {
        sum = 0u; cnt = 0u; mine = 0u;
#pragma unroll
        for (unsigned j = 0; j < 16; ++j) { const unsigned c = xb_ld(&bar[XB_XCNT(j)]); sum += c; cnt += (c > 0u) ? 1u : 0u; mine = (j == x) ? c : mine; }
        if (sum == G) break;
        __builtin_amdgcn_s_sleep(1);
        if ((++sp & 255u) == 0u) { if (xb_ld(&bar[XB_TMO])) break; if (sp > XB_SPIN_CAP) { atomicAdd(&bar[XB_TMO], 1u); break; } }
    }
    nloc = mine > 0u ? mine : 1u; nx = cnt > 0u ? cnt : 1u;
}

__device__ __forceinline__ void xcd_barrier(const XcdBarrier& b) {
    asm volatile("s_waitcnt vmcnt(0)" ::: "memory");
    __syncthreads();
    if (threadIdx.x == 0) {
        unsigned* bar = b.bar;
        __builtin_amdgcn_s_waitcnt(0);
        unsigned nloc = b.st[0], nx = b.st[1];
        if (nloc == 0u) { xcd_barrier_complete(bar, b.x, nloc, nx); b.st[0] = nloc; b.st[1] = nx; }
        const unsigned old = xb_add(&bar[XB_XSUB(b.x)], 1u);
        const unsigned gen = old / nloc;
        if (old + 1u == (gen + 1u) * nloc) {
            __builtin_amdgcn_fence(__ATOMIC_RELEASE, "agent");
            asm volatile("s_waitcnt vmcnt(0)" ::: "memory");
            const unsigned og = xb_add(&bar[XB_TOP], 1u);
            const unsigned tg = og / nx;
            if (og + 1u == (tg + 1u) * nx) xb_add(&bar[XB_TOPGEN], 1u);
            else XB_SPIN(xb_ld(&bar[XB_TOPGEN]) == tg, bar);
            __builtin_amdgcn_fence(__ATOMIC_ACQUIRE, "agent");
            xb_add(&bar[XB_XGEN(b.x)], 1u);
            asm volatile("s_waitcnt vmcnt(0)" ::: "memory");
        } else {
            XB_SPIN(xb_ld(&bar[XB_XGEN(b.x)]) == gen, bar);
            __builtin_amdgcn_fence(__ATOMIC_ACQUIRE, "agent");
            asm volatile("s_waitcnt vmcnt(0)" ::: "memory");
        }
    }
    __syncthreads();
}


struct Frame {
    LAS unsigned char* lds;
    volatile LAS unsigned* MISC;
    int tid, lane, wave;
    int vcu, G;
    float* out; unsigned char* ws;
};
struct Args { const float* in[24]; float* out; unsigned char* ws; int ph_lo, ph_hi, li, pad; };
#define WSP(T, off) ((T*)(F.ws + (off)))
#define WSPG(T, off) ((T*)(GAS T*)(unsigned long long)(F.ws + (off)))
#define WSW(l, off) ((bf16*)(F.ws + WS_WSET + (size_t)((l) & 1) * WSET_BYTES + (off)))
#define WSWG(l, off) ((bf16*)(GAS bf16*)(unsigned long long)(F.ws + WS_WSET + (size_t)((l) & 1) * WSET_BYTES + (off)))
#define OUTP ((float*)F.out)
#define OUTPG ((float*)(GAS float*)(unsigned long long)F.out)
#define INP(A, i) ((const float*)((const GAS float*)(A)->in[i]))
#define RETID() do { int t_ = threadIdx.x; asm volatile("" : "+v"(t_)); F.tid = t_; F.lane = t_ & 63; } while (0)
#define CAS __attribute__((address_space(4)))
typedef const CAS Args* ArgP;

__device__ __forceinline__ float fexp(float x) { return __builtin_amdgcn_exp2f(x * 1.4426950408889634f); }
__device__ __forceinline__ float fsig(float x) { return __builtin_amdgcn_rcpf(1.0f + fexp(-x)); }
__device__ __forceinline__ float ftanh(float x) { return 1.0f - 2.0f * __builtin_amdgcn_rcpf(1.0f + fexp(2.0f * x)); }
__device__ __forceinline__ float wave_sum(float v) {
#pragma unroll
    for (int o = 1; o < 64; o <<= 1) v += __shfl_xor(v, o);
    return v;
}
struct TItem { const float* W; bf16* WT; const float* gk; int K, N, item; };
__device__ __forceinline__ void titem_load(const TItem& t, int lane, f32x4 (&v)[8]) {
    const int nblk = t.N / 32, kb = t.item / nblk, nb = t.item % nblk, k0 = 64 * kb, n0 = 32 * nb, nq = lane & 7, kr = lane >> 3;
#pragma unroll
    for (int i = 0; i < 8; ++i) v[i] = *(const GAS f32x4*)(t.W + (size_t)(k0 + kr + 8 * i) * t.N + n0 + 4 * nq);
}
__device__ __forceinline__ void titem_finish(const TItem& t, int lane, const f32x4 (&v)[8], LAS float* scr) {
    const int nblk = t.N / 32, kb = t.item / nblk, nb = t.item % nblk, k0 = 64 * kb, n0 = 32 * nb, nq = lane & 7, kr = lane >> 3;
#pragma unroll
    for (int i = 0; i < 8; ++i)
#pragma unroll
        for (int e = 0; e < 4; ++e) scr[(kr + 8 * i) * 33 + 4 * nq + e] = v[i][e];
    const int c = lane & 7;
    f32x4 g0 = (f32x4){1.f, 1.f, 1.f, 1.f}, g1 = g0;
    if (t.gk) { g0 = *(const GAS f32x4*)(t.gk + k0 + 8 * c); g1 = *(const GAS f32x4*)(t.gk + k0 + 8 * c + 4); }
    LDS_WAIT(); asm volatile("" ::: "memory");
#pragma unroll
    for (int j = 0; j < 4; ++j) { const int n = (lane >> 3) + 8 * j; const LAS float* s = scr + (8 * c) * 33 + n;
        v4u o; o.x = pk2(s[0 * 33] * g0.x, s[1 * 33] * g0.y); o.y = pk2(s[2 * 33] * g0.z, s[3 * 33] * g0.w); o.z = pk2(s[4 * 33] * g1.x, s[5 * 33] * g1.y); o.w = pk2(s[6 * 33] * g1.z, s[7 * 33] * g1.w);
        *(GAS v4u*)(t.WT + (size_t)(n0 + n) * t.K + k0 + 8 * c) = o; }
    LDS_WAIT(); asm volatile("" ::: "memory");
}
__device__ __forceinline__ void rms_row_to_bf16(const float* xrow, const float* g, bf16* orow, int lane) {
    const GAS f32x4* xr = (const GAS f32x4*)xrow + lane;
    f32x4 v[8]; float s = 0.f;
#pragma unroll
    for (int j = 0; j < 8; ++j) { v[j] = xr[64 * j]; s += (v[j].x * v[j].x + v[j].y * v[j].y) + (v[j].z * v[j].z + v[j].w * v[j].w); }
    const float rstd = 1.f / sqrtf(wave_sum(s) * (1.f / D) + NORM_EPS);
    const GAS f32x4* gr = (const GAS f32x4*)g + lane;
    GAS v2u* o8 = (GAS v2u*)orow + lane;
#pragma unroll
    for (int j = 0; j < 8; ++j) { const f32x4 gg = gr[64 * j]; v2u o; o.x = pk2(v[j].x * rstd * gg.x, v[j].y * rstd * gg.y); o.y = pk2(v[j].z * rstd * gg.z, v[j].w * rstd * gg.w); o8[64 * j] = o; }
}

#if (MK_GLOBAL_GROUPS & 1)
#pragma push_macro("WSP")
#pragma push_macro("WSW")
#pragma push_macro("OUTP")
#undef WSP
#undef WSW
#undef OUTP
#define WSP WSPG
#define WSW WSWG
#define OUTP OUTPG
#endif
__device__ __forceinline__ void ph_prologue(Frame& F, ArgP A) {
    const int* pos = (const int*)INP(A, 1); float2* rope = WSP(float2, WS_ROPE);
    {
        const int gw = F.vcu * NWAVES + F.wave, NGW = F.G * NWAVES, lane = F.lane;
        for (int m = gw; m < M; m += NGW) {
            const GAS f32x4* xr = (const GAS f32x4*)(INP(A, 0) + (size_t)m * D) + lane;
            GAS v2u* hb = (GAS v2u*)(WSP(bf16, WS_H) + (size_t)m * D) + lane; float s = 0.f;
#pragma unroll
            for (int j = 0; j < 8; ++j) { const f32x4 v = xr[64 * j]; v2u o; o.x = pk2(v.x, v.y); o.y = pk2(v.z, v.w); hb[64 * j] = o; s += (v.x * v.x + v.y * v.y) + (v.z * v.z + v.w * v.w); }
            s = wave_sum(s);
            if (lane < 32) WSP(float, WS_SS)[(size_t)m * 32 + lane] = lane == 0 ? s : 0.f;
        }
    }
    for (int i = F.vcu * 512 + F.tid; i < M * 64; i += F.G * 512) {
        const int m = i >> 6, j = i & 63;
        const double rev = (double)pos[m] * ROPE_REV[j];
        const float fr = (float)(rev - __builtin_rint(rev));
        rope[i] = make_float2(__builtin_amdgcn_cosf(fr), __builtin_amdgcn_sinf(fr));
    }
}
#if (MK_GLOBAL_GROUPS & 1)
#pragma pop_macro("WSP")
#pragma pop_macro("WSW")
#pragma pop_macro("OUTP")
#endif
#if (MK_GLOBAL_GROUPS & 16)
#pragma push_macro("WSP")
#pragma push_macro("WSW")
#pragma push_macro("OUTP")
#undef WSP
#undef WSW
#undef OUTP
#define WSP WSPG
#define WSW WSWG
#define OUTP OUTPG
#endif
__device__ __forceinline__ TItem conv_item(Frame& F, ArgP A, int l, int it) {
    constexpr int I_IN = (D / 64) * (INW / 32), I_A = (RETW / 64) * (D / 32), I_O = (D / 64) * (D / 32), I_UP = (D / 64) * (DFF / 32), I_DN = (DFF / 64) * (D / 32);
    int r = it; TItem t;
    if (r < I_IN) { t = TItem{INP(A, 3) + (size_t)l * D * INW, WSW(l, WO_WIN), INP(A, 2) + (size_t)l * D, D, INW, r}; return t; } r -= I_IN;
    if (r < I_A) { t = TItem{INP(A, 17) + (size_t)l * RETW * D, WSW(l, WO_WA), nullptr, RETW, D, r}; return t; } r -= I_A;
    if (r < I_A) { t = TItem{INP(A, 18) + (size_t)l * RWW * D, WSW(l, WO_WB), nullptr, RWW, D, r}; return t; } r -= I_A;
    if (r < I_O) { t = TItem{INP(A, 19) + (size_t)l * D * D, WSW(l, WO_WO), nullptr, D, D, r}; return t; } r -= I_O;
    if (r < I_UP) { t = TItem{INP(A, 21) + (size_t)l * D * DFF, WSW(l, WO_WUP), INP(A, 20) + (size_t)l * D, D, DFF, r}; return t; } r -= I_UP;
    if (r < I_DN) { t = TItem{INP(A, 22) + (size_t)l * DFF * D, WSW(l, WO_WDN), nullptr, DFF, D, r}; return t; } r -= I_DN;
    if (r < 32) { t = TItem{INP(A, 8) + (size_t)l * 64 * RWW, WSW(l, WO_LORA), nullptr, 64, RWW, r}; return t; } r -= 32;
    if (r < 32) { t = TItem{INP(A, 10) + (size_t)l * 64 * RWW, WSW(l, WO_LORA) + 1024 * 64, nullptr, 64, RWW, r}; return t; } r -= 32;
    t = TItem{INP(A, 11) + (size_t)l * 128 * RWW, WSW(l, WO_LORA) + 2 * 1024 * 64, nullptr, 128, RWW, r}; return t;
}
__device__ __forceinline__ void ph_convert(Frame& F, ArgP A, int l, int wg, int nwg) {
    LAS float* scr = (LAS float*)(F.lds + RING_OFF + F.wave * 16384);
    const int gw = wg * NWAVES + F.wave, NGW = nwg * NWAVES, lane = F.lane;
    constexpr int I_IN = (D / 64) * (INW / 32), I_A = (RETW / 64) * (D / 32), I_O = (D / 64) * (D / 32), I_UP = (D / 64) * (DFF / 32), I_DN = (DFF / 64) * (D / 32);
    constexpr int NITEMS = I_IN + 2 * I_A + I_O + I_UP + I_DN + 32 + 32 + 64;
    if (gw >= NITEMS) return;
    TItem cur = conv_item(F, A, l, gw); f32x4 va[8], vb[8];
    titem_load(cur, lane, va);
    for (int it = gw; it < NITEMS; it += 2 * NGW) {
        TItem nxt = cur; const bool h1 = it + NGW < NITEMS;
        if (h1) { nxt = conv_item(F, A, l, it + NGW); titem_load(nxt, lane, vb); }
        titem_finish(cur, lane, va, scr);
        if (!h1) break;
        const bool h2 = it + 2 * NGW < NITEMS;
        if (h2) { cur = conv_item(F, A, l, it + 2 * NGW); titem_load(cur, lane, va); }
        titem_finish(nxt, lane, vb, scr);
        if (!h2) break;
    }
}
__device__ __forceinline__ void ph_norm(Frame& F, const float* g) {
    const int gw = F.vcu * NWAVES + F.wave, NGW = F.G * NWAVES;
    for (int m = gw; m < M; m += NGW) rms_row_to_bf16(OUTP + (size_t)m * D, g, WSP(bf16, WS_H) + (size_t)m * D, F.lane);
}
#if (MK_GLOBAL_GROUPS & 16)
#pragma pop_macro("WSP")
#pragma pop_macro("WSW")
#pragma pop_macro("OUTP")
#endif
#if (MK_GLOBAL_GROUPS & 2)
#pragma push_macro("WSP")
#pragma push_macro("WSW")
#pragma push_macro("OUTP")
#undef WSP
#undef WSW
#undef OUTP
#define WSP WSPG
#define WSW WSWG
#define OUTP OUTPG
#endif
__device__ __forceinline__ f32x4 unpk4(const v2u p) { return (f32x4){pg8::bf_lo(p.x), pg8::bf_hi(p.x), pg8::bf_lo(p.y), pg8::bf_hi(p.y)}; }
__device__ __forceinline__ void unpack8(const v4u a, float (&o)[8]) {
    o[0] = pg8::bf_lo(a.x); o[1] = pg8::bf_hi(a.x); o[2] = pg8::bf_lo(a.y); o[3] = pg8::bf_hi(a.y); o[4] = pg8::bf_lo(a.z); o[5] = pg8::bf_hi(a.z); o[6] = pg8::bf_lo(a.w); o[7] = pg8::bf_hi(a.w);
}
__device__ __forceinline__ void mix8(const GAS bf16* zc, bool has_prev, const GAS float* mu, float (&o)[8]) {
    const v4u a = *(const GAS v4u*)zc; v4u p = (v4u){0u, 0u, 0u, 0u}; if (has_prev) p = *(const GAS v4u*)(zc - INW);
    const f32x4 m0 = *(const GAS f32x4*)mu, m1 = *(const GAS f32x4*)(mu + 4);
    float z[8], q[8]; unpack8(a, z); unpack8(p, q);
#pragma unroll
    for (int j = 0; j < 4; ++j) { o[j] = z[j] + m0[j] * (q[j] - z[j]); o[4 + j] = z[4 + j] + m1[j] * (q[4 + j] - z[4 + j]); }
}
__device__ __forceinline__ f32x4 mix4(const GAS bf16* zc, bool has_prev, const GAS float* mu) {
    const v2u a = *(const GAS v2u*)zc; v2u p = (v2u){0u, 0u}; if (has_prev) p = *(const GAS v2u*)(zc - INW);
    const f32x4 m = *(const GAS f32x4*)mu;
    const f32x4 z = (f32x4){pg8::bf_lo(a.x), pg8::bf_hi(a.x), pg8::bf_lo(a.y), pg8::bf_hi(a.y)}, q = (f32x4){pg8::bf_lo(p.x), pg8::bf_hi(p.x), pg8::bf_lo(p.y), pg8::bf_hi(p.y)};
    return z + m * (q - z);
}
__device__ __forceinline__ bf16x8 pack8(const float (&v)[8]) {
    v4u o; o.x = pg8::cvt_pk_bf16(v[0], v[1]); o.y = pg8::cvt_pk_bf16(v[2], v[3]); o.z = pg8::cvt_pk_bf16(v[4], v[5]); o.w = pg8::cvt_pk_bf16(v[6], v[7]);
    return __builtin_bit_cast(bf16x8, o);
}
constexpr int CU_BYTES = 20480, CU_M = 0, CU_OM = 8192, CU_QB = 10240, CU_QSTR = 2560;
constexpr int CK = 16, NCHUNK = SEQ / CK;
constexpr int XL_STR = 144, XL_MAT = 16 * XL_STR;
typedef short s4v __attribute__((ext_vector_type(4)));
__device__ __forceinline__ s4v pk4(const f32x4 v) { v2u o; o.x = pg8::cvt_pk_bf16(v[0], v[1]); o.y = pg8::cvt_pk_bf16(v[2], v[3]); return __builtin_bit_cast(s4v, o); }
__device__ __forceinline__ bf16x8 pk8v(const f32x4 a, const f32x4 b) { v4u o; o.x = pg8::cvt_pk_bf16(a[0], a[1]); o.y = pg8::cvt_pk_bf16(a[2], a[3]); o.z = pg8::cvt_pk_bf16(b[0], b[1]); o.w = pg8::cvt_pk_bf16(b[2], b[3]); return __builtin_bit_cast(bf16x8, o); }
__device__ __forceinline__ f32x4 mma16(const s4v x, const s4v y, const f32x4 c) {
    const bf16x8 x8 = (bf16x8){x.x, x.y, x.z, x.w, 0, 0, 0, 0}, y8 = (bf16x8){y.x, y.y, y.z, y.w, 0, 0, 0, 0};
    return __builtin_amdgcn_mfma_f32_16x16x32_bf16(x8, y8, c, 0, 0, 0); }
__device__ __forceinline__ f32x4 mma32(const bf16x8 x, const bf16x8 y, const f32x4 c) { return __builtin_amdgcn_mfma_f32_16x16x32_bf16(x, y, c, 0, 0, 0); }
template <int N> __device__ __forceinline__ float dpp_shr0(float x) { return __builtin_bit_cast(float, __builtin_amdgcn_update_dpp(0, __builtin_bit_cast(int, x), 0x110 + N, 0xF, 0xF, true)); }
__device__ __forceinline__ float scan16(float x) { x += dpp_shr0<1>(x); x += dpp_shr0<2>(x); x += dpp_shr0<4>(x); x += dpp_shr0<8>(x); return x; }
__device__ __forceinline__ s4v trd(const LAS unsigned char* p) { return __builtin_amdgcn_ds_read_tr16_b64_v4i16((LAS s4v*)p); }
__device__ __forceinline__ void chunk_ops(const f32x4 (&r)[4], const f32x4 (&lw)[4], const f32x4 (&kp)[4], const f32x4 (&v)[4], const f32x4 (&a)[4], const f32x4 (&b)[4],
                                          LAS unsigned char* scr, GAS unsigned char* rec, int lane) {
    const int l15 = lane & 15, g = lane >> 4, tq = l15 >> 2, tp = l15 & 3;
    const f32x4 Z4 = (f32x4){0.f, 0.f, 0.f, 0.f};
    f32x4 Rt[4], pc[4]; bf16x8 Atf[2], Btf[2], Ktf[2], Rtf[2];
    {
        s4v Ah[4], Bq[4], Kq[4], Rq[4];
#pragma unroll
        for (int nt = 0; nt < 4; ++nt) {
            f32x4 cs, tot;
#pragma unroll
            for (int i = 0; i < 4; ++i) { cs[i] = scan16(lw[nt][i]); tot[i] = __shfl(cs[i], lane | 15); }
            f32x4 At, Bt, Kt, Bh, Kh;
#pragma unroll
            for (int i = 0; i < 4; ++i) { const float P = fexp(cs[i]), Pm1 = fexp(cs[i] - lw[nt][i]), iP = fexp(-cs[i]), PCP = fexp(tot[i] - cs[i]);
                pc[nt][i] = fexp(tot[i]); At[i] = a[nt][i] * Pm1; Bt[i] = b[nt][i] * iP; Kt[i] = kp[nt][i] * iP; Rt[nt][i] = r[nt][i] * P; Bh[i] = b[nt][i] * PCP; Kh[i] = kp[nt][i] * PCP; }
            Ah[nt] = pk4(At); Bq[nt] = pk4(Bt); Kq[nt] = pk4(Kt); Rq[nt] = pk4(Rt[nt]);
            LAS unsigned char* w = scr + l15 * XL_STR + (16 * nt + 4 * g) * 2;
            *(LAS s4v*)(w + 0 * XL_MAT) = Ah[nt]; *(LAS s4v*)(w + 1 * XL_MAT) = pk4(v[nt]); *(LAS s4v*)(w + 2 * XL_MAT) = pk4(Bh); *(LAS s4v*)(w + 3 * XL_MAT) = pk4(Kh);
        }
#pragma unroll
        for (int s = 0; s < 2; ++s) {
            Atf[s] = (bf16x8){Ah[2 * s].x, Ah[2 * s].y, Ah[2 * s].z, Ah[2 * s].w, Ah[2 * s + 1].x, Ah[2 * s + 1].y, Ah[2 * s + 1].z, Ah[2 * s + 1].w};
            Btf[s] = (bf16x8){Bq[2 * s].x, Bq[2 * s].y, Bq[2 * s].z, Bq[2 * s].w, Bq[2 * s + 1].x, Bq[2 * s + 1].y, Bq[2 * s + 1].z, Bq[2 * s + 1].w};
            Ktf[s] = (bf16x8){Kq[2 * s].x, Kq[2 * s].y, Kq[2 * s].z, Kq[2 * s].w, Kq[2 * s + 1].x, Kq[2 * s + 1].y, Kq[2 * s + 1].z, Kq[2 * s + 1].w};
            Rtf[s] = (bf16x8){Rq[2 * s].x, Rq[2 * s].y, Rq[2 * s].z, Rq[2 * s].w, Rq[2 * s + 1].x, Rq[2 * s + 1].y, Rq[2 * s + 1].z, Rq[2 * s + 1].w}; }
    }
    f32x4 LabR = Z4, LabT = Z4, LakT = Z4, LrbT = Z4, LrkT = Z4;
#pragma unroll
    for (int s = 0; s < 2; ++s) { LabR = mma32(Atf[s], Btf[s], LabR); LabT = mma32(Btf[s], Atf[s], LabT); LakT = mma32(Ktf[s], Atf[s], LakT); LrbT = mma32(Btf[s], Rtf[s], LrbT); LrkT = mma32(Ktf[s], Rtf[s], LrkT); }
    f32x4 IR;
#pragma unroll
    for (int i = 0; i < 4; ++i) { const int tt = 4 * g + i;
        IR[i] = (tt == l15) ? 1.f : 0.f;
        LabR[i] = (tt > l15) ? LabR[i] : 0.f; LabT[i] = (l15 > tt) ? LabT[i] : 0.f; LakT[i] = (l15 > tt) ? LakT[i] : 0.f;
        LrbT[i] = (l15 >= tt) ? LrbT[i] : 0.f; LrkT[i] = (l15 >= tt) ? LrkT[i] : 0.f; }
    const s4v L1R = pk4(LabR), L1T = pk4(LabT);
    const f32x4 L2R = mma16(L1T, L1R, Z4), L2T = mma16(L1R, L1T, Z4);
    const s4v L2Rp = pk4(L2R), L2Tp = pk4(L2T);
    const f32x4 L4R = mma16(L2Tp, L2Rp, Z4), L4T = mma16(L2Rp, L2Tp, Z4);
    const s4v L4Rp = pk4(L4R), L4Tp = pk4(L4T);
    const f32x4 L8R = mma16(L4Tp, L4Rp, Z4);
    const f32x4 T1T = mma16(pk4(IR + L2R), pk4(IR + LabT), Z4);
    const f32x4 T2T = mma16(pk4(IR + L4R), pk4(T1T), Z4);
    const s4v TmT = pk4(mma16(pk4(IR + L8R), pk4(T2T), Z4));
    const s4v LakTp = pk4(LakT), LrbTp = pk4(LrbT), LrkTp = pk4(LrkT);
    asm volatile("s_waitcnt lgkmcnt(0)" ::: "memory");
    const LAS unsigned char* tb = scr + (4 * g + tq) * XL_STR + (4 * tp) * 2;
    s4v tAt[4], tV[4], tBh[4], tKh[4];
#pragma unroll
    for (int t = 0; t < 4; ++t) { tAt[t] = trd(tb + 0 * XL_MAT + 32 * t); tV[t] = trd(tb + 1 * XL_MAT + 32 * t); tBh[t] = trd(tb + 2 * XL_MAT + 32 * t); tKh[t] = trd(tb + 3 * XL_MAT + 32 * t); }
    s4v Wp[4], U0p[4];
#pragma unroll
    for (int t = 0; t < 4; ++t) { Wp[t] = pk4(mma16(TmT, tAt[t], Z4));
        const f32x4 G = mma16(LakTp, tV[t], Z4);
        const f32x4 U0 = mma16(TmT, pk4(G), Z4); U0p[t] = pk4(U0);
        f32x4 Y0 = mma16(LrbTp, U0p[t], Z4); Y0 = mma16(LrkTp, tV[t], Y0);
        *(GAS s4v*)(rec + CU_QB + t * CU_QSTR + 2048 + lane * 8) = pk4(Y0); }
    {
        f32x4 Om[4];
#pragma unroll
        for (int ct = 0; ct < 4; ++ct) Om[ct] = mma16(Wp[ct], LrbTp, Rt[ct]);
        *(GAS bf16x8*)(rec + CU_OM + 0 * 1024 + lane * 16) = pk8v(Om[0], Om[1]); *(GAS bf16x8*)(rec + CU_OM + 1 * 1024 + lane * 16) = pk8v(Om[2], Om[3]);
    }
#pragma unroll
    for (int tl = 0; tl < 4; ++tl) {
        f32x4 Mt[4];
#pragma unroll
        for (int kt = 0; kt < 4; ++kt) { Mt[kt] = mma16(Wp[kt], tBh[tl], Z4);
            if (kt == tl) {
#pragma unroll
                for (int i = 0; i < 4; ++i) Mt[kt][i] += (4 * g + i == l15) ? pc[kt][i] : 0.f; } }
        *(GAS bf16x8*)(rec + CU_M + (tl * 2 + 0) * 1024 + lane * 16) = pk8v(Mt[0], Mt[1]); *(GAS bf16x8*)(rec + CU_M + (tl * 2 + 1) * 1024 + lane * 16) = pk8v(Mt[2], Mt[3]);
    }
#pragma unroll
    for (int q = 0; q < 4; ++q)
#pragma unroll
        for (int tl = 0; tl < 4; ++tl) { f32x4 Nt = mma16(tBh[tl], U0p[q], Z4); Nt = mma16(tKh[tl], tV[q], Nt);
            *(GAS s4v*)(rec + CU_QB + q * CU_QSTR + tl * 512 + lane * 8) = pk4(Nt); }
}
__device__ __forceinline__ void ph_prep(Frame& F, ArgP A, int l) {
    const int gw = F.vcu * NWAVES + F.wave, NGW = F.G * NWAVES, lane = F.lane, l15 = lane & 15, g = lane >> 4;
    {
        const int h = lane >> 3, i0 = 8 * (lane & 7);
        int nrr_ = (MK_REP & 1024) ? 2 : 1; asm volatile("" : "+s"(nrr_));
#pragma unroll 1
        for (int rr_ = 0; rr_ < nrr_; ++rr_)
        for (int m = gw; m < M; m += NGW) {
            const GAS bf16* zrow = (const GAS bf16*)(WSP(bf16, WS_Z) + (size_t)m * INW);
            const GAS f32x4* rp = (const GAS f32x4*)(WSP(float2, WS_ROPE) + (size_t)m * 64 + i0);
            const f32x4 c01 = rp[0], c23 = rp[1], c45 = rp[2], c67 = rp[3];
            const float cs[8] = {c01.x, c01.z, c23.x, c23.z, c45.x, c45.z, c67.x, c67.z}, sn[8] = {c01.y, c01.w, c23.y, c23.w, c45.y, c45.w, c67.y, c67.w};
            float q1[8], q2[8], k1[8], k2[8], o1[8], o2[8];
            unpack8(*(const GAS v4u*)(zrow + ZC_Q + h * RD + i0), q1); unpack8(*(const GAS v4u*)(zrow + ZC_Q + h * RD + 64 + i0), q2);
            unpack8(*(const GAS v4u*)(zrow + ZC_K + h * RD + i0), k1); unpack8(*(const GAS v4u*)(zrow + ZC_K + h * RD + 64 + i0), k2);
#pragma unroll
            for (int j = 0; j < 8; ++j) { o1[j] = q1[j] * cs[j] - q2[j] * sn[j]; o2[j] = q2[j] * cs[j] + q1[j] * sn[j]; }
            GAS bf16* qo = (GAS bf16*)(WSP(bf16, WS_QR) + (size_t)m * RETW + h * RD + i0);
            *(GAS bf16x8*)qo = pack8(o1); *(GAS bf16x8*)(qo + 64) = pack8(o2);
#pragma unroll
            for (int j = 0; j < 8; ++j) { const float a = k1[j] * 0.08838834764831845f, b = k2[j] * 0.08838834764831845f; o1[j] = a * cs[j] - b * sn[j]; o2[j] = b * cs[j] + a * sn[j]; }
            GAS bf16* ko = (GAS bf16*)(WSP(bf16, WS_KR) + (size_t)m * RETW + h * RD + i0);
            *(GAS bf16x8*)ko = pack8(o1); *(GAS bf16x8*)(ko + 64) = pack8(o2);
        }
    }
    const GAS float* mu = (const GAS float*)(INP(A, 6) + (size_t)l * RWSHIFT);
    const GAS float* w0 = (const GAS float*)(INP(A, 7) + (size_t)l * RWW); const GAS float* a0 = (const GAS float*)(INP(A, 9) + (size_t)l * RWW);
    const GAS float* kkw = (const GAS float*)(INP(A, 12) + (size_t)l * RWW); const GAS float* kaw = (const GAS float*)(INP(A, 13) + (size_t)l * RWW); const GAS float* rkw = (const GAS float*)(INP(A, 14) + (size_t)l * RWW);
    const GAS bf16* WupT = (const GAS bf16*)WSW(l, WO_LORA); const GAS bf16* AupT = WupT + 1024 * 64; const GAS bf16* GupT = AupT + 1024 * 64;
    constexpr int PP_OFF = 8 * 10240;
    LAS float* PP = (LAS float*)(F.lds + RING_OFF + PP_OFF);
    __syncthreads();
    for (int i = F.tid; i < 2048; i += NWAVES * 64) { const int arr = i >> 8, off = (i & 255) * 4;
        const GAS float* src = arr < 3 ? mu + arr * 1024 : (arr == 3 ? w0 : (arr == 4 ? a0 : (arr == 5 ? kkw : (arr == 6 ? kaw : rkw))));
        *(LAS f32x4*)(PP + arr * 1024 + off) = *(const GAS f32x4*)(src + off); }
    __syncthreads();
    int nrw_ = (MK_REP & 2048) ? 2 : 1; asm volatile("" : "+s"(nrw_));
#pragma unroll 1
    for (int rw_ = 0; rw_ < nrw_; ++rw_)
    for (int task = gw; task < M / 8; task += NGW) {
        const int m = (task >> 1) * 16 + l15, hh0 = (task & 1) * (WH / 2);
        const bool has_prev = (m % SEQ) != 0;
        const GAS bf16* zr = (const GAS bf16*)(WSP(bf16, WS_Z) + (size_t)m * INW + ZC_RW);
        bf16x8 fw[2], fa[2], fg[4];
#pragma unroll
        for (int ks = 0; ks < 2; ++ks) { float t[8];
            mix8(zr + RWC_W + 32 * ks + 8 * g, has_prev, mu + RWC_W + 32 * ks + 8 * g, t);
#pragma unroll
            for (int j = 0; j < 8; ++j) t[j] = ftanh(t[j]);
            fw[ks] = pack8(t);
            mix8(zr + RWC_A + 32 * ks + 8 * g, has_prev, mu + RWC_A + 32 * ks + 8 * g, t); fa[ks] = pack8(t); }
#pragma unroll
        for (int ks = 0; ks < 4; ++ks) { float t[8];
            mix8(zr + RWC_G + 32 * ks + 8 * g, has_prev, mu + RWC_G + 32 * ks + 8 * g, t);
#pragma unroll
            for (int j = 0; j < 8; ++j) t[j] = fsig(t[j]);
            fg[ks] = pack8(t); }
        const GAS bf16* zq = has_prev ? zr - INW : zr;
        for (int hh = hh0; hh < hh0 + WH / 2; ++hh) {
            f32x4 kkr[4], av[4], rr[4], lwv[4], kpv[4], vv[4]; float ss = 0.f, bonus = 0.f;
            const int cb = hh * WD + 4 * g;
            {
                v2u zc[3][4], zp[3][4];
#pragma unroll
                for (int a3 = 0; a3 < 3; ++a3)
#pragma unroll
                    for (int nt = 0; nt < 4; ++nt) { zc[a3][nt] = *(const GAS v2u*)(zr + a3 * 1024 + cb + 16 * nt); zp[a3][nt] = *(const GAS v2u*)(zq + a3 * 1024 + cb + 16 * nt); }
#pragma unroll
                for (int nt = 0; nt < 4; ++nt) {
#pragma unroll
                    for (int a3 = 0; a3 < 3; ++a3) { const f32x4 z = unpk4(zc[a3][nt]); f32x4 p = unpk4(zp[a3][nt]); if (!has_prev) p = (f32x4){0.f, 0.f, 0.f, 0.f};
                        const f32x4 mx = z + *(const LAS f32x4*)(PP + a3 * 1024 + cb + 16 * nt) * (p - z);
                        if (a3 == 0) rr[nt] = mx; else if (a3 == 1) kpv[nt] = mx; else vv[nt] = mx; }
                }
            }
            bf16x8 wf[2][2], af[2][2], gf[2][4];
#define PREP_WFRAGS(nt_, k_) do { const int cf_ = hh * WD + (nt_) * 16 + l15; \
            _Pragma("unroll") for (int ks = 0; ks < 2; ++ks) { wf[k_][ks] = *(const GAS bf16x8*)(WupT + (size_t)cf_ * 64 + 32 * ks + 8 * g); af[k_][ks] = *(const GAS bf16x8*)(AupT + (size_t)cf_ * 64 + 32 * ks + 8 * g); } \
            _Pragma("unroll") for (int ks = 0; ks < 4; ++ks) gf[k_][ks] = *(const GAS bf16x8*)(GupT + (size_t)cf_ * 128 + 32 * ks + 8 * g); } while (0)
            PREP_WFRAGS(0, 0);
#pragma unroll
            for (int nt = 0; nt < 4; ++nt) {
                const int c0 = cb + 16 * nt, cs_ = nt & 1;
                if (nt + 1 < 4) PREP_WFRAGS(nt + 1, (cs_ ^ 1));
                f32x4 wl = *(const LAS f32x4*)(PP + 3 * 1024 + c0), al = *(const LAS f32x4*)(PP + 4 * 1024 + c0), gl = (f32x4){0.f, 0.f, 0.f, 0.f};
#pragma unroll
                for (int ks = 0; ks < 2; ++ks) { wl = __builtin_amdgcn_mfma_f32_16x16x32_bf16(wf[cs_][ks], fw[ks], wl, 0, 0, 0); al = __builtin_amdgcn_mfma_f32_16x16x32_bf16(af[cs_][ks], fa[ks], al, 0, 0, 0); }
#pragma unroll
                for (int ks = 0; ks < 4; ++ks) gl = __builtin_amdgcn_mfma_f32_16x16x32_bf16(gf[cs_][ks], fg[ks], gl, 0, 0, 0);
                const f32x4 r = rr[nt], k = kpv[nt], v = vv[nt];
                const f32x4 kk4 = *(const LAS f32x4*)(PP + 5 * 1024 + c0), ka4 = *(const LAS f32x4*)(PP + 6 * 1024 + c0), rk4 = *(const LAS f32x4*)(PP + 7 * 1024 + c0);
                f32x4 lwd, a, kp;
#pragma unroll
                for (int i = 0; i < 4; ++i) {
                    lwd[i] = -0.6065306597126334f * fsig(wl[i]);
                    a[i] = fsig(al[i]);
                    kp[i] = k[i] * (1.0f + (a[i] - 1.0f) * ka4[i]);
                }
                kkr[nt] = k * kk4; av[nt] = a; lwv[nt] = lwd; kpv[nt] = kp;
                ss += (kkr[nt].x * kkr[nt].x + kkr[nt].y * kkr[nt].y) + (kkr[nt].z * kkr[nt].z + kkr[nt].w * kkr[nt].w);
                const f32x4 rb = r * kp * rk4; bonus += (rb.x + rb.y) + (rb.z + rb.w);
                const size_t o = (size_t)m * RWW + c0;
#if MK_CHUNKED
                *(GAS s4v*)(WSP(bf16, WS_SV) + o) = pk4(v); *(GAS s4v*)(WSP(bf16, WS_G) + o) = pk4(gl);
#else
                f32x4 decay;
#pragma unroll
                for (int i = 0; i < 4; ++i) decay[i] = fexp(lwd[i]);
                *(GAS f32x4*)(WSP(float, WS_SR) + o) = r; *(GAS f32x4*)(WSP(float, WS_SW) + o) = decay; *(GAS f32x4*)(WSP(float, WS_SK) + o) = kp;
                *(GAS f32x4*)(WSP(float, WS_SV) + o) = v; *(GAS f32x4*)(WSP(float, WS_G) + o) = gl;
#endif
            }
#undef PREP_WFRAGS
            ss += __shfl_xor(ss, 16); ss += __shfl_xor(ss, 32); bonus += __shfl_xor(bonus, 16); bonus += __shfl_xor(bonus, 32);
            const float inv = 1.0f / fmaxf(sqrtf(ss), 1e-12f);
            if (g == 0) WSP(float, WS_BONUS)[(size_t)m * WH + hh] = bonus;
#if MK_CHUNKED
            f32x4 aa[4], bb[4];
#pragma unroll
            for (int nt = 0; nt < 4; ++nt) { const f32x4 kk = kkr[nt] * inv; aa[nt] = -kk; bb[nt] = kk * av[nt]; }
            const int tile = task >> 1;
            GAS unsigned char* rec = (GAS unsigned char*)WSP(unsigned char, WS_CU) + ((size_t)((tile / NCHUNK) * WH + hh) * NCHUNK + (tile % NCHUNK)) * CU_BYTES;
            chunk_ops(rr, lwv, kpv, vv, aa, bb, F.lds + RING_OFF + F.wave * 10240, rec, lane);
#else
#pragma unroll
            for (int nt = 0; nt < 4; ++nt) { const size_t o = (size_t)m * RWW + hh * WD + nt * 16 + 4 * g; const f32x4 kk = kkr[nt] * inv;
                *(GAS f32x4*)(WSP(float, WS_SNKK) + o) = -kk; *(GAS f32x4*)(WSP(float, WS_SKKA) + o) = kk * av[nt]; }
#endif
        }
    }
}
#if (MK_GLOBAL_GROUPS & 2)
#pragma pop_macro("WSP")
#pragma pop_macro("WSW")
#pragma pop_macro("OUTP")
#endif
#if (MK_GLOBAL_GROUPS & 4)
#pragma push_macro("WSP")
#pragma push_macro("WSW")
#pragma push_macro("OUTP")
#undef WSP
#undef WSW
#undef OUTP
#define WSP WSPG
#define WSW WSWG
#define OUTP OUTPG
#endif
#if !MK_CHUNKED
__device__ __forceinline__ void scan_rwkv_naive(Frame& F, int item) {
    const int lane = F.lane;
    float st[64];
#pragma unroll
    for (int j = 0; j < 64; ++j) st[j] = 0.f;
    const size_t base0 = (size_t)(item >> 4) * SEQ * RWW + (size_t)(item & 15) * WD + lane;
    for (int t = 0; t < SEQ; ++t) {
        const size_t o = base0 + (size_t)t * RWW;
        const float r = WSP(float, WS_SR)[o], w = WSP(float, WS_SW)[o], k = WSP(float, WS_SK)[o], v = WSP(float, WS_SV)[o], nk = WSP(float, WS_SNKK)[o], ka = WSP(float, WS_SKKA)[o];
        float sa = 0.f;
#pragma unroll
        for (int j = 0; j < 64; ++j) sa += st[j] * rdlane(nk, j);
        float y = 0.f;
#pragma unroll
        for (int j = 0; j < 64; ++j) { st[j] = st[j] * rdlane(w, j) + sa * rdlane(ka, j) + v * rdlane(k, j); y += st[j] * rdlane(r, j); }
        WSP(float, WS_YRAWW)[o] = y;
    }
}
#endif
__device__ __forceinline__ void scan_ret_naive(Frame& F, int item) {
    const int lane = F.lane, b = item >> 4, h = (item >> 1) & 7, half = item & 1;
    const float gam = 1.0f - exp2f((float)(-5 - h));
    float R[128];
#pragma unroll
    for (int j = 0; j < 128; ++j) R[j] = 0.f;
    for (int t = 0; t < SEQ; ++t) {
        const size_t m = (size_t)b * SEQ + t;
        const float q1 = bf2f(WSP(bf16, WS_QR)[m * RETW + h * RD + lane]), q2 = bf2f(WSP(bf16, WS_QR)[m * RETW + h * RD + 64 + lane]);
        const float k1 = bf2f(WSP(bf16, WS_KR)[m * RETW + h * RD + lane]), k2 = bf2f(WSP(bf16, WS_KR)[m * RETW + h * RD + 64 + lane]);
        const float v = bf2f(WSP(bf16, WS_Z)[m * INW + ZC_V + h * RD + half * 64 + lane]);
        float y = 0.f;
#pragma unroll
        for (int d = 0; d < 64; ++d) { R[d] = gam * R[d] + rdlane(k1, d) * v; y += rdlane(q1, d) * R[d]; }
#pragma unroll
        for (int d = 0; d < 64; ++d) { R[64 + d] = gam * R[64 + d] + rdlane(k2, d) * v; y += rdlane(q2, d) * R[64 + d]; }
        WSP(float, WS_YRAWR)[m * RETW + h * RD + half * 64 + lane] = y;
    }
}
#if !MK_CHUNKED
constexpr int SCT = 32;
constexpr int SC_ARR = SCT * 64 * 4;
constexpr int SC_BUF = 5 * SC_ARR + SCT * 16 * 4;
static_assert(2 * SC_BUF <= RING_BYTES, "scan LDS");
template <int CTRL> __device__ __forceinline__ float dppf(float x) { return __builtin_bit_cast(float, __builtin_amdgcn_update_dpp(0, __builtin_bit_cast(int, x), CTRL, 0xF, 0xF, true)); }
__device__ __forceinline__ float sum16(float x) {
    x += dppf<0xB1>(x); x += dppf<0x4E>(x); x += dppf<0x141>(x); x += dppf<0x140>(x); return x;
}
__device__ __forceinline__ void scan_rwkv_fast(Frame& F, int w) {
    const int b = w >> 6, hh = (w >> 2) & 15, q = w & 3;
    const int lane = F.lane, wave = F.wave;
    LAS unsigned char* base = F.lds + RING_OFF;
    const size_t g0 = (size_t)b * SEQ * RWW + (size_t)hh * WD;
    constexpr int NBLK = SEQ / SCT;
#define SC_BAR() do { asm volatile("s_waitcnt lgkmcnt(0)" ::: "memory"); __builtin_amdgcn_s_barrier(); asm volatile("" ::: "memory"); } while (0)
    if (wave >= 4) {
        const int lt = F.tid - 256;
        const float* a0 = WSP(float, WS_SR) + g0; const float* a1 = WSP(float, WS_SW) + g0; const float* a2 = WSP(float, WS_SK) + g0;
        const float* a3 = WSP(float, WS_SNKK) + g0; const float* a4 = WSP(float, WS_SKKA) + g0; const float* av = WSP(float, WS_SV) + g0 + 16 * q;
        const int f0 = lt, f1 = lt + 256;
        const size_t o0 = (size_t)(f0 >> 4) * RWW + 4 * (f0 & 15), o1 = (size_t)(f1 >> 4) * RWW + 4 * (f1 & 15), ov = (size_t)(lt >> 2) * RWW + 4 * (lt & 3);
        f32x4 r0[5], r1[5], rv;
#define SC_LOAD(blk) do { const size_t tb = (size_t)(blk) * SCT * RWW; \
        r0[0] = *(const GAS f32x4*)(a0 + tb + o0); r1[0] = *(const GAS f32x4*)(a0 + tb + o1); r0[1] = *(const GAS f32x4*)(a1 + tb + o0); r1[1] = *(const GAS f32x4*)(a1 + tb + o1); \
        r0[2] = *(const GAS f32x4*)(a2 + tb + o0); r1[2] = *(const GAS f32x4*)(a2 + tb + o1); r0[3] = *(const GAS f32x4*)(a3 + tb + o0); r1[3] = *(const GAS f32x4*)(a3 + tb + o1); \
        r0[4] = *(const GAS f32x4*)(a4 + tb + o0); r1[4] = *(const GAS f32x4*)(a4 + tb + o1); if (lt < 128) rv = *(const GAS f32x4*)(av + tb + ov); } while (0)
#define SC_STORE(bi) do { LAS unsigned char* bb = base + (bi) * SC_BUF; \
        _Pragma("unroll") for (int a = 0; a < 5; ++a) { *(LAS f32x4*)(bb + a * SC_ARR + f0 * 16) = r0[a]; *(LAS f32x4*)(bb + a * SC_ARR + f1 * 16) = r1[a]; } \
        if (lt < 128) *(LAS f32x4*)(bb + 5 * SC_ARR + lt * 16) = rv; } while (0)
        SC_LOAD(0); SC_STORE(0);
        if (1 < NBLK) SC_LOAD(1);
        SC_BAR();
        for (int blk = 0; blk < NBLK; ++blk) {
            if (blk + 1 < NBLK) { SC_STORE((blk + 1) & 1); if (blk + 2 < NBLK) SC_LOAD(blk + 2); }
            SC_BAR();
        }
#undef SC_LOAD
#undef SC_STORE
    } else {
        const int l16 = lane & 15, rowl = 4 * wave + (lane >> 4);
        GAS float* Y = (GAS float*)(WSP(float, WS_YRAWW) + g0 + 16 * q + rowl);
        f32x4 st = (f32x4){0.f, 0.f, 0.f, 0.f};
        const int lo = l16 * 16, vo = 5 * SC_ARR + rowl * 4;
#define SC_LD(tt_, R4, W4, K4, N4, A4, V) do { R4 = *(const LAS f32x4*)(bb + 0 * SC_ARR + (tt_) * 256 + lo); W4 = *(const LAS f32x4*)(bb + 1 * SC_ARR + (tt_) * 256 + lo); \
        K4 = *(const LAS f32x4*)(bb + 2 * SC_ARR + (tt_) * 256 + lo); N4 = *(const LAS f32x4*)(bb + 3 * SC_ARR + (tt_) * 256 + lo); A4 = *(const LAS f32x4*)(bb + 4 * SC_ARR + (tt_) * 256 + lo); \
        V = *(const LAS float*)(bb + vo + (tt_) * 64); } while (0)
        SC_BAR();
        for (int blk = 0; blk < NBLK; ++blk) {
            const LAS unsigned char* bb = base + (blk & 1) * SC_BUF;
            GAS float* yb = Y + (size_t)blk * SCT * RWW;
            f32x4 r4[3], w4[3], k4[3], n4[3], a4[3]; float v[3];
            SC_LD(0, r4[0], w4[0], k4[0], n4[0], a4[0], v[0]);
            SC_LD(1, r4[1], w4[1], k4[1], n4[1], a4[1], v[1]);
#pragma unroll
            for (int tt = 0; tt < SCT; ++tt) {
                const int c = tt % 3, p = (tt + 2) % 3;
                if (tt + 2 < SCT) SC_LD(tt + 2, r4[p], w4[p], k4[p], n4[p], a4[p], v[p]);
                f32x2 sp2 = (f32x2){st.x, st.y} * (f32x2){n4[c].x, n4[c].y}; sp2 = (f32x2){st.z, st.w} * (f32x2){n4[c].z, n4[c].w} + sp2;
                const f32x4 t0 = st * w4[c] + k4[c] * v[c];
                const float sa = sum16(sp2.x + sp2.y);
                st = a4[c] * sa + t0;
                f32x2 yp2 = (f32x2){st.x, st.y} * (f32x2){r4[c].x, r4[c].y}; yp2 = (f32x2){st.z, st.w} * (f32x2){r4[c].z, r4[c].w} + yp2;
                const float y = sum16(yp2.x + yp2.y);
                yb[(size_t)tt * RWW] = y;
            }
            SC_BAR();
        }
#undef SC_LD
#undef SC_BAR
    }
}
#endif
constexpr int CB_STEPS = 4, CB_STEP_BYTES = 8192 + 2048 + 2048 + 512, CB_BUF = CB_STEPS * CB_STEP_BYTES, CB_PIECES = CB_BUF / 16, CB_NBLK = NCHUNK / CB_STEPS;
static_assert(2 * CB_BUF <= RING_BYTES, "chunk scan LDS");
#ifndef MK_X2_DIRECT
#define MK_X2_DIRECT 0
#endif
__device__ __forceinline__ void scan_rwkv_chunk(Frame& F, int w) {
    const int bh = w >> 2, q = w & 3, lane = F.lane, wave = F.wave;
#if MK_X2_DIRECT
    if (wave == 0) {
        const int l15 = lane & 15, g = lane >> 4;
        const f32x4 Z4 = (f32x4){0.f, 0.f, 0.f, 0.f};
        f32x4 acc[4] = {Z4, Z4, Z4, Z4};
        const GAS unsigned char* rec = (const GAS unsigned char*)WSP(unsigned char, WS_CU) + (size_t)bh * NCHUNK * CU_BYTES;
        GAS float* Y = (GAS float*)(WSP(float, WS_YRAWW) + (size_t)(bh >> 4) * SEQ * RWW + (size_t)(bh & 15) * WD + 16 * q + l15 + (size_t)(4 * g) * RWW);
        for (int n = 0; n < NCHUNK; ++n, rec += CU_BYTES) {
            const bf16x8 sf0 = pk8v(acc[0], acc[1]), sf1 = pk8v(acc[2], acc[3]);
            f32x4 ya = unpk4(*(const GAS v2u*)(rec + CU_QB + q * CU_QSTR + 2048 + lane * 8));
            ya = mma32(*(const GAS bf16x8*)(rec + CU_OM + lane * 16), sf0, ya); ya = mma32(*(const GAS bf16x8*)(rec + CU_OM + 1024 + lane * 16), sf1, ya);
            GAS float* yp = Y + (size_t)(n * CK) * RWW;
#pragma unroll
            for (int i = 0; i < 4; ++i) yp[(size_t)i * RWW] = ya[i];
#pragma unroll
            for (int tl = 0; tl < 4; ++tl) { f32x4 na = unpk4(*(const GAS v2u*)(rec + CU_QB + q * CU_QSTR + tl * 512 + lane * 8));
                na = mma32(*(const GAS bf16x8*)(rec + CU_M + (tl * 2 + 0) * 1024 + lane * 16), sf0, na); na = mma32(*(const GAS bf16x8*)(rec + CU_M + (tl * 2 + 1) * 1024 + lane * 16), sf1, na);
                acc[tl] = na; }
        }
    }
    return;
#endif
    LAS unsigned char* base = F.lds + RING_OFF;
    const GAS unsigned char* rec0 = (const GAS unsigned char*)WSP(unsigned char, WS_CU) + (size_t)bh * NCHUNK * CU_BYTES;
#define CB_BAR() do { asm volatile("s_waitcnt lgkmcnt(0)" ::: "memory"); __builtin_amdgcn_s_barrier(); asm volatile("" ::: "memory"); } while (0)
    if (wave >= 1) {
        const int lt = F.tid - 64;
        v4u ra[8], rb[8], rc[8], rd[8];
        int so[8];
#pragma unroll
        for (int j = 0; j < 8; ++j) { const int p = lt + 448 * j, st = p / 800, off = p % 800; so[j] = st * CU_BYTES + off * 16 + (off >= 640 ? q * CU_QSTR : 0); }
        const bool last_ok = (wave == 1);
#define CB_LOAD(rg, blk) do { const GAS unsigned char* bp = rec0 + (size_t)(blk) * CB_STEPS * CU_BYTES; \
            _Pragma("unroll") for (int j = 0; j < 7; ++j) rg[j] = *(const GAS v4u*)(bp + so[j]); if (last_ok) rg[7] = *(const GAS v4u*)(bp + so[7]); } while (0)
#define CB_STORE(rg, bi) do { LAS unsigned char* dp = base + (bi) * CB_BUF + lt * 16; \
            _Pragma("unroll") for (int j = 0; j < 7; ++j) *(LAS v4u*)(dp + j * 448 * 16) = rg[j]; if (last_ok) *(LAS v4u*)(dp + 7 * 448 * 16) = rg[7]; } while (0)
        static_assert(CB_NBLK % 4 == 0 && CB_NBLK >= 8, "block quads");
        CB_LOAD(ra, 0); CB_STORE(ra, 0); CB_LOAD(rb, 1); CB_LOAD(rc, 2); CB_LOAD(rd, 3);
        CB_BAR();
        for (int blk = 0; blk < CB_NBLK; blk += 4) {
            CB_STORE(rb, 1); if (blk + 4 < CB_NBLK) CB_LOAD(ra, blk + 4);
            CB_BAR();
            CB_STORE(rc, 0); if (blk + 5 < CB_NBLK) CB_LOAD(rb, blk + 5);
            CB_BAR();
            CB_STORE(rd, 1); if (blk + 6 < CB_NBLK) CB_LOAD(rc, blk + 6);
            CB_BAR();
            if (blk + 4 < CB_NBLK) { CB_STORE(ra, 0); if (blk + 7 < CB_NBLK) CB_LOAD(rd, blk + 7); }
            CB_BAR();
        }
#undef CB_LOAD
#undef CB_STORE
    } else {
        const int l15 = lane & 15, g = lane >> 4;
        const f32x4 Z4 = (f32x4){0.f, 0.f, 0.f, 0.f};
        f32x4 acc[4] = {Z4, Z4, Z4, Z4};
        GAS float* Y = (GAS float*)(WSP(float, WS_YRAWW) + (size_t)(bh >> 4) * SEQ * RWW + (size_t)(bh & 15) * WD + 16 * q + l15 + (size_t)(4 * g) * RWW);
        CB_BAR();
        bf16x8 Mf[2][8], Of[2][2]; v2u Nt[2][4], Yt[2];
#define CB_FRAGS(sb_, k_) do { _Pragma("unroll") for (int j = 0; j < 8; ++j) Mf[k_][j] = *(const LAS bf16x8*)((sb_) + j * 1024 + lane * 16); \
        _Pragma("unroll") for (int j = 0; j < 4; ++j) Nt[k_][j] = *(const LAS v2u*)((sb_) + 10240 + j * 512 + lane * 8); \
        Of[k_][0] = *(const LAS bf16x8*)((sb_) + 8192 + lane * 16); Of[k_][1] = *(const LAS bf16x8*)((sb_) + 9216 + lane * 16); Yt[k_] = *(const LAS v2u*)((sb_) + 12288 + lane * 8); } while (0)
        for (int blk = 0; blk < CB_NBLK; ++blk) {
            const LAS unsigned char* bb = base + (blk & 1) * CB_BUF;
            CB_FRAGS(bb, 0);
#pragma unroll
            for (int st = 0; st < CB_STEPS; ++st) {
                const int c = st & 1;
                if (st + 1 < CB_STEPS) CB_FRAGS(bb + (st + 1) * CB_STEP_BYTES, (c ^ 1));
                const bf16x8 sf0 = pk8v(acc[0], acc[1]), sf1 = pk8v(acc[2], acc[3]);
                f32x4 ya = unpk4(Yt[c]);
                ya = mma32(Of[c][0], sf0, ya); ya = mma32(Of[c][1], sf1, ya);
                GAS float* yp = Y + (size_t)((blk * CB_STEPS + st) * CK) * RWW;
#pragma unroll
                for (int i = 0; i < 4; ++i) yp[(size_t)i * RWW] = ya[i];
                f32x4 na[4];
#pragma unroll
                for (int tl = 0; tl < 4; ++tl) na[tl] = mma32(Mf[c][tl * 2 + 0], sf0, unpk4(Nt[c][tl]));
#pragma unroll
                for (int tl = 0; tl < 4; ++tl) acc[tl] = mma32(Mf[c][tl * 2 + 1], sf1, na[tl]);
            }
            CB_BAR();
        }
#undef CB_FRAGS
    }
#undef CB_BAR
}
constexpr int RT_STR = 288, RT_QS = 0, RT_KS = 128 * RT_STR, RT_VSTR = 80, RT_VS = 2 * 128 * RT_STR, RT_VPS = RT_VS + 128 * RT_VSTR, RT_RT = RT_VPS + 128 * RT_VSTR, RT_RTSZ = 32 * RT_STR;
static_assert(RT_RT + 2 * RT_RTSZ <= RING_BYTES, "retention LDS");
__device__ __forceinline__ bf16x8 tr8(const LAS unsigned char* p0, const LAS unsigned char* p1) {
    const s4v a = __builtin_amdgcn_ds_read_tr16_b64_v4i16((LAS s4v*)p0), b = __builtin_amdgcn_ds_read_tr16_b64_v4i16((LAS s4v*)p1);
    return (bf16x8){a.x, a.y, a.z, a.w, b.x, b.y, b.z, b.w};
}
__device__ __forceinline__ void scan_ret_mfma(Frame& F, int w_) {
    const int b = w_ >> 5, h = (w_ >> 2) & 7, eq = w_ & 3;
    const int tid = F.tid, lane = F.lane, w = F.wave, l15 = lane & 15, g = lane >> 4, tq = l15 >> 2, tp = l15 & 3;
    LAS unsigned char* L = F.lds + RING_OFF;
    const float lg2 = log1pf(-exp2f((float)(-5 - h))) * 1.4426950408889634f;
    const float gC = __builtin_amdgcn_exp2f(lg2 * 128.f);
    for (int i = tid; i < RT_RTSZ / 4; i += NWAVES * 64) ((LAS unsigned*)(L + RT_RT))[i] = 0u;
    const GAS bf16* Qg = (const GAS bf16*)(WSP(bf16, WS_QR) + (size_t)b * SEQ * RETW + h * RD);
    const GAS bf16* Kg = (const GAS bf16*)(WSP(bf16, WS_KR) + (size_t)b * SEQ * RETW + h * RD);
    const GAS bf16* Vg = (const GAS bf16*)(WSP(bf16, WS_Z) + (size_t)b * SEQ * INW + ZC_V + h * RD + 32 * eq);
    GAS float* Yg = (GAS float*)(WSP(float, WS_YRAWR) + (size_t)b * SEQ * RETW + h * RD + 32 * eq);
    v4u rq[4], rk[4], rv;
#define RT_LOAD(n_) do { _Pragma("unroll") for (int i = 0; i < 4; ++i) { const int f = tid + 512 * i, c = f >> 4, pc = f & 15; \
        rq[i] = *(const GAS v4u*)(Qg + (size_t)((n_) * 128 + c) * RETW + 8 * pc); rk[i] = *(const GAS v4u*)(Kg + (size_t)((n_) * 128 + c) * RETW + 8 * pc); } \
        rv = *(const GAS v4u*)(Vg + (size_t)((n_) * 128 + (tid >> 2)) * INW + 8 * (tid & 3)); } while (0)
    f32x4 accR[2] = {(f32x4){0.f, 0.f, 0.f, 0.f}, (f32x4){0.f, 0.f, 0.f, 0.f}};
    RT_LOAD(0);
    for (int n = 0; n < SEQ / 128; ++n) {
#pragma unroll
        for (int i = 0; i < 4; ++i) { const int f = tid + 512 * i, c = f >> 4, pc = f & 15;
            *(LAS v4u*)(L + RT_QS + c * RT_STR + pc * 16) = rq[i]; *(LAS v4u*)(L + RT_KS + c * RT_STR + pc * 16) = rk[i]; }
        { const int c = tid >> 2, pc = tid & 3; *(LAS v4u*)(L + RT_VS + c * RT_VSTR + pc * 16) = rv;
          const float sc = __builtin_amdgcn_exp2f(lg2 * (float)(127 - c)); v4u o;
          o.x = pg8::cvt_pk_bf16(pg8::bf_lo(rv.x) * sc, pg8::bf_hi(rv.x) * sc); o.y = pg8::cvt_pk_bf16(pg8::bf_lo(rv.y) * sc, pg8::bf_hi(rv.y) * sc);
          o.z = pg8::cvt_pk_bf16(pg8::bf_lo(rv.z) * sc, pg8::bf_hi(rv.z) * sc); o.w = pg8::cvt_pk_bf16(pg8::bf_lo(rv.w) * sc, pg8::bf_hi(rv.w) * sc);
          *(LAS v4u*)(L + RT_VPS + c * RT_VSTR + pc * 16) = o; }
        __syncthreads();
        if (n + 1 < SEQ / 128) RT_LOAD(n + 1);
        bf16x8 qf[4];
#pragma unroll
        for (int ks = 0; ks < 4; ++ks) qf[ks] = *(const LAS bf16x8*)(L + RT_QS + (16 * w + l15) * RT_STR + (32 * ks + 8 * g) * 2);
        bf16x8 pf[4];
        const int cq = 16 * w + l15;
#pragma unroll
        for (int p = 0; p < 4; ++p) {
            f32x4 s0 = (f32x4){0.f, 0.f, 0.f, 0.f}, s1 = (f32x4){0.f, 0.f, 0.f, 0.f};
            if (2 * p <= w) {
#pragma unroll
                for (int ks = 0; ks < 4; ++ks) { const bf16x8 kf = *(const LAS bf16x8*)(L + RT_KS + (32 * p + l15) * RT_STR + (32 * ks + 8 * g) * 2);
                    s0 = __builtin_amdgcn_mfma_f32_16x16x32_bf16(kf, qf[ks], s0, 0, 0, 0); }
            }
            if (2 * p + 1 <= w) {
#pragma unroll
                for (int ks = 0; ks < 4; ++ks) { const bf16x8 kf = *(const LAS bf16x8*)(L + RT_KS + (32 * p + 16 + l15) * RT_STR + (32 * ks + 8 * g) * 2);
                    s1 = __builtin_amdgcn_mfma_f32_16x16x32_bf16(kf, qf[ks], s1, 0, 0, 0); }
            }
            float p0[4], p1[4];
#pragma unroll
            for (int i = 0; i < 4; ++i) { const int d0 = cq - (32 * p + 4 * g + i), d1 = d0 - 16;
                p0[i] = d0 >= 0 ? s0[i] * __builtin_amdgcn_exp2f(lg2 * (float)d0) : 0.f; p1[i] = d1 >= 0 ? s1[i] * __builtin_amdgcn_exp2f(lg2 * (float)d1) : 0.f; }
            v4u pk; pk.x = pg8::cvt_pk_bf16(p0[0], p0[1]); pk.y = pg8::cvt_pk_bf16(p0[2], p0[3]); pk.z = pg8::cvt_pk_bf16(p1[0], p1[1]); pk.w = pg8::cvt_pk_bf16(p1[2], p1[3]);
            pf[p] = __builtin_bit_cast(bf16x8, pk);
        }
        const LAS unsigned char* Rcur = L + RT_RT + (n & 1) * RT_RTSZ;
#pragma unroll
        for (int et = 0; et < 2; ++et) {
            f32x4 acc = (f32x4){0.f, 0.f, 0.f, 0.f};
#pragma unroll
            for (int ks = 0; ks < 4; ++ks) { const bf16x8 rf = *(const LAS bf16x8*)(Rcur + (16 * et + l15) * RT_STR + (32 * ks + 8 * g) * 2);
                acc = __builtin_amdgcn_mfma_f32_16x16x32_bf16(qf[ks], rf, acc, 0, 0, 0); }
#pragma unroll
            for (int i = 0; i < 4; ++i) acc[i] *= __builtin_amdgcn_exp2f(lg2 * (float)(16 * w + 4 * g + i + 1));
#pragma unroll
            for (int p = 0; p < 4; ++p) if (2 * p <= w) {
                const LAS unsigned char* vb = L + RT_VS + (32 * p + 4 * g + tq) * RT_VSTR + (16 * et + 4 * tp) * 2;
                const bf16x8 vf = tr8(vb, vb + 16 * RT_VSTR);
                acc = __builtin_amdgcn_mfma_f32_16x16x32_bf16(pf[p], vf, acc, 0, 0, 0); }
#pragma unroll
            for (int i = 0; i < 4; ++i) Yg[(size_t)(n * 128 + 16 * w + 4 * g + i) * RETW + 16 * et + l15] = acc[i];
        }
        LAS unsigned char* Rnxt = L + RT_RT + ((n + 1) & 1) * RT_RTSZ;
        accR[0] = accR[0] * gC; accR[1] = accR[1] * gC;
#pragma unroll
        for (int cs = 0; cs < 4; ++cs) {
            const LAS unsigned char* kb = L + RT_KS + (32 * cs + 8 * g + tq) * RT_STR + (16 * w + 4 * tp) * 2;
            const bf16x8 kt = tr8(kb, kb + 4 * RT_STR);
#pragma unroll
            for (int et = 0; et < 2; ++et) { const LAS unsigned char* vb = L + RT_VPS + (32 * cs + 8 * g + tq) * RT_VSTR + (16 * et + 4 * tp) * 2;
                const bf16x8 vt = tr8(vb, vb + 4 * RT_VSTR);
                accR[et] = __builtin_amdgcn_mfma_f32_16x16x32_bf16(kt, vt, accR[et], 0, 0, 0); }
        }
#pragma unroll
        for (int et = 0; et < 2; ++et) { v2u o; o.x = pg8::cvt_pk_bf16(accR[et][0], accR[et][1]); o.y = pg8::cvt_pk_bf16(accR[et][2], accR[et][3]);
            *(LAS v2u*)(Rnxt + (16 * et + l15) * RT_STR + (16 * w + 4 * g) * 2) = o; }
        __syncthreads();
    }
#undef RT_LOAD
}
__device__ __forceinline__ void ph_scan(Frame& F, ArgP A, int l) {
#if MK_CHUNKED
    if (F.G == 256) {
        const int it = F.vcu, r = it & 3, idx = it >> 2;
        if (r == 0 || r == 2) { const int w = idx * 2 + (r >> 1); scan_rwkv_chunk(F, w); }
        else if (r == 1) { scan_ret_mfma(F, idx); }
        else if (l + 1 < DEPTH) { ph_convert(F, A, l + 1, idx, 64); }
        __syncthreads();
    }
#else
    if (F.G >= 256) {
        if (F.vcu >= 192) { if (l + 1 < DEPTH) ph_convert(F, A, l + 1, F.vcu - 192, F.G - 192); return; }
        if (F.vcu < 128) { scan_rwkv_fast(F, F.vcu); if (MK_REP & 32) { __syncthreads(); scan_rwkv_fast(F, F.vcu); } }
        else if (F.vcu < 192) { scan_ret_mfma(F, F.vcu - 128); if (MK_REP & 64) { __syncthreads(); scan_ret_mfma(F, F.vcu - 128); } }
    } else {
        if (l + 1 < DEPTH) ph_convert(F, A, l + 1, F.vcu, F.G);
        const int gw = F.vcu * NWAVES + F.wave, NGW = F.G * NWAVES;
        const int stride = NGW >= 64 ? NGW / 64 : 1;
        if (gw % stride == 0) {
            for (int item = gw / stride; item < 64; item += (NGW + stride - 1) / stride) {
                if (item < 32) scan_rwkv_naive(F, item); else scan_ret_naive(F, item - 32);
            }
        }
    }
#endif
}
#if (MK_GLOBAL_GROUPS & 4)
#pragma pop_macro("WSP")
#pragma pop_macro("WSW")
#pragma pop_macro("OUTP")
#endif
#if (MK_GLOBAL_GROUPS & 8)
#pragma push_macro("WSP")
#pragma push_macro("WSW")
#pragma push_macro("OUTP")
#undef WSP
#undef WSW
#undef OUTP
#define WSP WSPG
#define WSW WSWG
#define OUTP OUTPG
#endif
template <int CTRL> __device__ __forceinline__ float dppx(float x) { return __builtin_bit_cast(float, __builtin_amdgcn_update_dpp(0, __builtin_bit_cast(int, x), CTRL, 0xF, 0xF, true)); }
__device__ __forceinline__ void ph_post(Frame& F, ArgP A, int l) {
    const int gw = F.vcu * NWAVES + F.wave, NGW = F.G * NWAVES, lane = F.lane, c0 = lane * 16;
    f32x4 gg[4], gb[4], lg[4], lb[4];
#pragma unroll
    for (int j = 0; j < 4; ++j) { gg[j] = *(const GAS f32x4*)(INP(A, 4) + (size_t)l * RETW + c0 + 4 * j); gb[j] = *(const GAS f32x4*)(INP(A, 5) + (size_t)l * RETW + c0 + 4 * j);
        lg[j] = *(const GAS f32x4*)(INP(A, 15) + (size_t)l * RWW + c0 + 4 * j); lb[j] = *(const GAS f32x4*)(INP(A, 16) + (size_t)l * RWW + c0 + 4 * j); }
    for (int m = gw; m < M; m += NGW) {
        {
            f32x4 y[4]; float s = 0.f;
#pragma unroll
            for (int j = 0; j < 4; ++j) { y[j] = *(const GAS f32x4*)(WSP(float, WS_YRAWR) + (size_t)m * RETW + c0 + 4 * j); s += (y[j].x + y[j].y) + (y[j].z + y[j].w); }
            const GAS bf16* zg = (const GAS bf16*)(WSP(bf16, WS_Z) + (size_t)m * INW + ZC_GR + c0);
            float g[16]; { float t[8]; unpack8(*(const GAS v4u*)zg, t);
#pragma unroll
                for (int j = 0; j < 8; ++j) g[j] = t[j]; unpack8(*(const GAS v4u*)(zg + 8), t);
#pragma unroll
                for (int j = 0; j < 8; ++j) g[8 + j] = t[j]; }
            s += dppx<0xB1>(s); s += dppx<0x4E>(s); s += dppx<0x141>(s);
            const float mean = s * (1.f / RD); float q = 0.f;
#pragma unroll
            for (int j = 0; j < 4; ++j) { y[j] = y[j] - mean; q += (y[j].x * y[j].x + y[j].y * y[j].y) + (y[j].z * y[j].z + y[j].w * y[j].w); }
            q += dppx<0xB1>(q); q += dppx<0x4E>(q); q += dppx<0x141>(q);
            const float rstd = __builtin_amdgcn_rsqf(q * (1.f / RD) + RET_GN_EPS);
            float o[16];
#pragma unroll
            for (int j = 0; j < 4; ++j)
#pragma unroll
                for (int k = 0; k < 4; ++k) { const float gr = g[4 * j + k]; o[4 * j + k] = (y[j][k] * rstd * gg[j][k] + gb[j][k]) * (gr * fsig(gr)); }
            GAS bf16* yo = (GAS bf16*)(WSP(bf16, WS_YRET) + (size_t)m * RETW + c0);
            { float t[8];
#pragma unroll
              for (int j = 0; j < 8; ++j) t[j] = o[j]; *(GAS bf16x8*)yo = pack8(t);
#pragma unroll
              for (int j = 0; j < 8; ++j) t[j] = o[8 + j]; *(GAS bf16x8*)(yo + 8) = pack8(t); }
        }
        {
            const size_t ob = (size_t)m * RWW + c0;
            f32x4 y[4]; float s = 0.f;
#pragma unroll
            for (int j = 0; j < 4; ++j) { y[j] = *(const GAS f32x4*)(WSP(float, WS_YRAWW) + ob + 4 * j); s += (y[j].x + y[j].y) + (y[j].z + y[j].w); }
            f32x4 vv[4], gt[4];
#pragma unroll
#if MK_CHUNKED
            for (int j = 0; j < 4; ++j) { vv[j] = unpk4(*(const GAS v2u*)(WSP(bf16, WS_SV) + ob + 4 * j)); gt[j] = unpk4(*(const GAS v2u*)(WSP(bf16, WS_G) + ob + 4 * j)); }
#else
            for (int j = 0; j < 4; ++j) { vv[j] = *(const GAS f32x4*)(WSP(float, WS_SV) + ob + 4 * j); gt[j] = *(const GAS f32x4*)(WSP(float, WS_G) + ob + 4 * j); }
#endif
            const float bonus = *(const GAS float*)(WSP(float, WS_BONUS) + (size_t)m * WH + (lane >> 2));
            s += dppx<0xB1>(s); s += dppx<0x4E>(s);
            const float mean = s * (1.f / WD); float q = 0.f;
#pragma unroll
            for (int j = 0; j < 4; ++j) { y[j] = y[j] - mean; q += (y[j].x * y[j].x + y[j].y * y[j].y) + (y[j].z * y[j].z + y[j].w * y[j].w); }
            q += dppx<0xB1>(q); q += dppx<0x4E>(q);
            const float rstd = __builtin_amdgcn_rsqf(q * (1.f / WD) + RWKV_LN_EPS);
            float o[16];
#pragma unroll
            for (int j = 0; j < 4; ++j)
#pragma unroll
                for (int k = 0; k < 4; ++k) o[4 * j + k] = (y[j][k] * rstd * lg[j][k] + lb[j][k] + bonus * vv[j][k]) * gt[j][k];
            GAS bf16* yo = (GAS bf16*)(WSP(bf16, WS_YRWKV) + ob);
            { float t[8];
#pragma unroll
              for (int j = 0; j < 8; ++j) t[j] = o[j]; *(GAS bf16x8*)yo = pack8(t);
#pragma unroll
              for (int j = 0; j < 8; ++j) t[j] = o[8 + j]; *(GAS bf16x8*)(yo + 8) = pack8(t); }
        }
    }
}
__device__ __forceinline__ void ph_final(Frame& F, ArgP A) {
    const int gw = F.vcu * NWAVES + F.wave, NGW = F.G * NWAVES, lane = F.lane;
    const GAS f32x4* gr = (const GAS f32x4*)INP(A, 23) + lane;
    for (int m = gw; m < M; m += NGW) {
        GAS f32x4* xr = (GAS f32x4*)(OUTP + (size_t)m * D) + lane;
        f32x4 v[8]; float s = 0.f;
#pragma unroll
        for (int j = 0; j < 8; ++j) { v[j] = xr[64 * j]; s += (v[j].x * v[j].x + v[j].y * v[j].y) + (v[j].z * v[j].z + v[j].w * v[j].w); }
        const float rstd = 1.f / sqrtf(wave_sum(s) * (1.f / D) + NORM_EPS);
#pragma unroll
        for (int j = 0; j < 8; ++j) xr[64 * j] = v[j] * rstd * gr[64 * j];
    }
}
#if (MK_GLOBAL_GROUPS & 8)
#pragma pop_macro("WSP")
#pragma pop_macro("WSW")
#pragma pop_macro("OUTP")
#endif

__global__ void __launch_bounds__(NWAVES * 64, 2) hybrid_fwd(Args args) {
    extern __shared__ __attribute__((aligned(16))) unsigned char lds[];
    Frame F;
    F.lds = (LAS unsigned char*)lds;
    F.MISC = (volatile LAS unsigned*)(F.lds + MISC_OFF);
    F.tid = threadIdx.x; F.lane = F.tid & 63; F.wave = __builtin_amdgcn_readfirstlane(F.tid >> 6);
    int bx = blockIdx.x; F.G = gridDim.x; { F.vcu = (F.G % 8 == 0) ? (bx % 8) * (F.G / 8) + bx / 8 : bx; }
    F.ws = args.ws; F.out = args.out;
    for (int u = F.tid; u < (LDS_BYTES - LDSCTL_OFF) / 4; u += NWAVES * 64) ((LAS unsigned*)(F.lds + LDSCTL_OFF))[u] = 0u;
    __syncthreads();
    if (F.tid == 0) { volatile LAS unsigned* U = (volatile LAS unsigned*)(F.lds + MISC_OFF) + 16; const unsigned long long pw = (unsigned long long)args.ws, po = (unsigned long long)args.out, pa = (unsigned long long)__builtin_amdgcn_kernarg_segment_ptr();
        U[0] = (unsigned)pw; U[1] = (unsigned)(pw >> 32); U[2] = (unsigned)po; U[3] = (unsigned)(po >> 32); U[4] = (unsigned)pa; U[5] = (unsigned)(pa >> 32); U[6] = (unsigned)F.G; U[7] = (unsigned)F.vcu; U[8] = (unsigned)bx; }
    __syncthreads();
    XcdBarrier bar = xcd_barrier_post((unsigned*)(F.ws + WS_CTL) + CW_BAR, F.MISC + 8);

    ArgP ap = (ArgP)__builtin_amdgcn_kernarg_segment_ptr();
    const int lo = args.ph_lo, hi = args.ph_hi;
#define REPX(bit, body) do { body; if (MK_REP & (bit)) { __syncthreads(); body; } } while (0)
#define IN(k) (lo <= (k) && (k) < hi)
#define SEAM(k) do { if (IN(k) && IN((k) + 1)) xcd_barrier(bar); else __syncthreads(); } while (0)

    if (IN(PH_PRO)) { int np_ = (MK_REP & 8192) ? 2 : 1; asm volatile("" : "+s"(np_));
#pragma unroll 1
        for (int rp_ = 0; rp_ < np_; ++rp_) { ph_prologue(F, ap); ph_convert(F, ap, 0, F.vcu, F.G); __syncthreads(); } }
    SEAM(PH_PRO);
    for (int l = 0; l < DEPTH; ++l) {
        const int p0 = PH_L0 + l * PPL;
        RETID();
        { unsigned ba = MISC_OFF + 64; asm volatile("" : "+v"(ba));
          const volatile LAS v4u* U = (const volatile LAS v4u*)(F.lds + ba);
          const v4u ua = U[0], ub = U[1]; const unsigned uc = *(const volatile LAS unsigned*)(U + 2);
          const unsigned u0 = __builtin_amdgcn_readfirstlane(ua.x), u1 = __builtin_amdgcn_readfirstlane(ua.y), u2 = __builtin_amdgcn_readfirstlane(ua.z), u3 = __builtin_amdgcn_readfirstlane(ua.w);
          const unsigned u4 = __builtin_amdgcn_readfirstlane(ub.x), u5 = __builtin_amdgcn_readfirstlane(ub.y), u6 = __builtin_amdgcn_readfirstlane(ub.z), u7 = __builtin_amdgcn_readfirstlane(ub.w), u8 = __builtin_amdgcn_readfirstlane(uc);
          F.ws = (unsigned char*)(((unsigned long long)u1 << 32) | u0); F.out = (float*)(((unsigned long long)u3 << 32) | u2); ap = (ArgP)(((unsigned long long)u5 << 32) | u4);
          F.G = (int)u6; F.vcu = (int)u7; bx = (int)u8; F.wave = __builtin_amdgcn_readfirstlane(F.tid >> 6); }
        if (IN(p0 + LP_G1)) {
            pg8::Gemm g{WSPG(bf16, WS_H), WSWG(l, WO_WIN), M, INW, D}; pg8::StaticOrder S; S.init(M, INW, F.G, bx);
            pg8::EpiB<0> E{WSPG(bf16, WS_Z), INW, nullptr, 0, WSPG(float, WS_SS)};
            pg8::gemm_phase<pg8::EpiB<0>, pg8::StaticOrder, MK_ALIGN, MK_SP2>(F.lds + RING_OFF, g, S, E);
            if (MK_REP & 512) { __syncthreads(); pg8::gemm_phase<pg8::EpiB<0>, pg8::StaticOrder, MK_ALIGN, MK_SP2>(F.lds + RING_OFF, g, S, E); }
            if (MK_CONV_IN_G1 && F.G == 256 && l + 1 < DEPTH && bx >= 64) { RETID(); ph_convert(F, ap, l + 1, bx - 64, 192); }
        }
        SEAM(p0 + LP_G1);
        if (IN(p0 + LP_PREP)) { int nrep_ = (MK_REP & 4) ? 2 : 1; asm volatile("" : "+s"(nrep_));
#pragma unroll 1
            for (int rep_ = 0; rep_ < nrep_; ++rep_) { RETID(); ph_prep(F, ap, l); __syncthreads(); } }
        SEAM(p0 + LP_PREP);
        if (IN(p0 + LP_SCAN)) { RETID(); REPX(8, ph_scan(F, ap, l)); }
        SEAM(p0 + LP_SCAN);
        if (IN(p0 + LP_POST)) { RETID(); REPX(16, ph_post(F, ap, l)); }
        SEAM(p0 + LP_POST);
        if (IN(p0 + LP_GA)) {
            pg8::Gemm g{WSPG(bf16, WS_YRET), WSWG(l, WO_WA), M, D, RETW}; pg8::StaticOrder S; S.init(M, D, F.G, bx);
            pg8::EpiB<2> E{WSPG(bf16, WS_MRG), D, WSPG(bf16, WS_Z) + ZC_GA, INW, nullptr};
            pg8::gemm_phase<pg8::EpiB<2>, pg8::StaticOrder, MK_ALIGN, MK_SP2>(F.lds + RING_OFF, g, S, E);
        }
        __syncthreads();
        if (IN(p0 + LP_GB)) {
            pg8::Gemm g{WSPG(bf16, WS_YRWKV), WSWG(l, WO_WB), M, D, RWW}; pg8::StaticOrder S; S.init(M, D, F.G, bx);
            pg8::EpiB<3> E{WSPG(bf16, WS_MRG), D, WSPG(bf16, WS_Z) + ZC_GB, INW, nullptr};
            pg8::gemm_phase<pg8::EpiB<3>, pg8::StaticOrder, MK_ALIGN, MK_SP2>(F.lds + RING_OFF, g, S, E);
        }
        SEAM(p0 + LP_GB);
        if (IN(p0 + LP_GO)) {
            pg8::Gemm g{WSPG(bf16, WS_MRG), WSWG(l, WO_WO), M, D, D}; pg8::StaticOrder S; S.init(M, D, F.G, bx);
            pg8::EpiResNorm E{OUTPG, D, WSPG(bf16, WS_H), WSPG(float, WS_SS), l == 0 ? (const float*)(GAS const float*)(unsigned long long)INP(ap, 0) : (const float*)OUTPG};
            pg8::gemm_phase<pg8::EpiResNorm, pg8::StaticOrder, MK_ALIGN, MK_SP2>(F.lds + RING_OFF, g, S, E);
        }
        SEAM(p0 + LP_GO);
        if (IN(p0 + LP_GUP)) {
            pg8::Gemm g{WSPG(bf16, WS_H), WSWG(l, WO_WUP), M, DFF, D}; pg8::StaticOrder S; S.init(M, DFF, F.G, bx);
            pg8::EpiB<1> E{WSPG(bf16, WS_UP), DFF, nullptr, 0, WSPG(float, WS_SS)};
            pg8::gemm_phase<pg8::EpiB<1>, pg8::StaticOrder, MK_ALIGN, MK_SP2>(F.lds + RING_OFF, g, S, E);
        }
        SEAM(p0 + LP_GUP);
        if (IN(p0 + LP_GDN)) {
            pg8::Gemm g{WSPG(bf16, WS_UP), WSWG(l, WO_WDN), M, D, DFF}; pg8::StaticOrder S; S.init(M, D, F.G, bx);
            pg8::EpiResNorm E{OUTPG, D, WSPG(bf16, WS_H), WSPG(float, WS_SS), OUTPG};
            pg8::gemm_phase<pg8::EpiResNorm, pg8::StaticOrder, MK_ALIGN, MK_SP2>(F.lds + RING_OFF, g, S, E);
        }
        SEAM(p0 + LP_GDN);
    }
    if (IN(PH_FIN)) { RETID(); ph_final(F, ap); }
#undef IN
#undef SEAM
}

extern "C" void kernel_launch(void* const* d_in, const int* in_sizes, int n_in, void* d_out, int out_size, void* d_ws, size_t ws_size, hipStream_t stream) {
    static int grid = 0;
    if (grid == 0) {
        if (n_in != 24 || in_sizes[0] != M * D || out_size != M * D || ws_size < WS_END) { fprintf(stderr, "kernel_launch: built for 24 inputs, x and out of %d floats, >= %zu bytes of workspace; got n_in %d, in0 %d, out %d, ws %zu; nothing launched\n", M * D, (size_t)WS_END, n_in, n_in > 0 ? in_sizes[0] : -1, out_size, ws_size); grid = -1; return; }
        int dev = 0, cus = 0, per_cu = 0;
        if (hipGetDevice(&dev) != hipSuccess || hipDeviceGetAttribute(&cus, hipDeviceAttributeMultiprocessorCount, dev) != hipSuccess) { fprintf(stderr, "kernel_launch: hipGetDevice / hipDeviceGetAttribute failed; nothing launched\n"); grid = -1; return; }
        if (hipFuncSetAttribute((const void*)hybrid_fwd, hipFuncAttributeMaxDynamicSharedMemorySize, LDS_BYTES) != hipSuccess) { fprintf(stderr, "kernel_launch: hipFuncSetAttribute failed\n"); grid = -1; return; }
        if (hipOccupancyMaxActiveBlocksPerMultiprocessor(&per_cu, (const void*)hybrid_fwd, NWAVES * 64, LDS_BYTES) != hipSuccess || per_cu < 1)
            fprintf(stderr, "kernel_launch: note: the occupancy query reports %d workgroups per CU\n", per_cu);
        (void)hipGetLastError();
        if (cus < 256) { fprintf(stderr, "kernel_launch: built for a 256-CU device (MI355X); this one reports %d CUs; nothing launched\n", cus); grid = -1; return; }
        grid = 256;
    }
    if (grid < 0) return;
    if (hipMemsetAsync((char*)d_ws + WS_CTL, 0, CTL_ZERO_BYTES, stream) != hipSuccess) { fprintf(stderr, "kernel_launch: hipMemsetAsync failed\n"); return; }
    Args a{};
    for (int i = 0; i < 24; ++i) a.in[i] = (const float*)d_in[i];
    a.out = (float*)d_out; a.ws = (unsigned char*)d_ws; a.li = 0; a.pad = 0;
#if MK_ONE_LAUNCH
    a.ph_lo = 0; a.ph_hi = NPH;
    hipLaunchKernelGGL(hybrid_fwd, dim3(grid), dim3(NWAVES * 64), LDS_BYTES, stream, a);
#else
    for (int p = 0; p < NPH; ++p) {
        a.ph_lo = p; a.ph_hi = p + 1;
        hipLaunchKernelGGL(hybrid_fwd, dim3(grid), dim3(NWAVES * 64), LDS_BYTES, stream, a);
    }
#endif
    const hipError_t le = hipPeekAtLastError();
    if (le != hipSuccess) fprintf(stderr, "kernel_launch: launch failed: %s\n", hipGetErrorName(le));
}
```

```cpp
#include <hip/hip_runtime.h>
#include <cstdio>
#include <cstdint>
#ifndef MK_GLOBAL_GROUPS
#define MK_GLOBAL_GROUPS 30
#endif
#ifndef MK_REP
#define MK_REP 0
#endif
namespace pg8 {
#define PG8_LAS __attribute__((address_space(3)))
typedef unsigned short bf16_t;
typedef short bf16x8 __attribute__((ext_vector_type(8)));
typedef float f32x4 __attribute__((ext_vector_type(4)));
typedef unsigned u32x4 __attribute__((ext_vector_type(4)));
constexpr int BM = 256, BK = 64, HALF = 128, HTB = HALF * BK * 2  , STAGE_BYTES = 8 * HTB, NXCD = 8, WGM = 8;

__host__ __device__ __forceinline__ int lds_byte(int r, int c) { const int st = (r >> 4) * 2 + (c >> 5), rr = r & 15, cc = c & 31, ob = rr * 64 + cc * 2; return st * 1024 + (ob ^ (((ob >> 9) & 1) << 5)); }
__host__ __device__ __forceinline__ void stage_rc(int b, int& R, int& C) { const int st = b / 1024, sb = b % 1024, swz = sb ^ (((sb >> 9) & 1) << 5); R = (st >> 1) * 16 + swz / 64; C = (st & 1) * 32 + (swz % 64) / 2; }
__host__ __device__ __forceinline__ int perm32(int rho) { const int n = rho >> 4, i = rho & 15; return 8 * (i >> 2) + 4 * n + (i & 3); }

struct Unit { int pm, pn; };
struct Gemm { const bf16_t* A; const bf16_t* Bt; int M, N, K; };

struct StaticOrder {
    int nM, nN, nwg, G, c;
    __host__ __device__ void init(int M, int N, int G_, int c_) { nM = M / BM; nN = N / BM; nwg = nM * nN; G = G_; c = c_; }
    __host__ __device__ bool next(int i, Unit& u) const {
        const long L = (long)i * G + c; if (L >= nwg) return false;
        int wgid = (int)L; { const int q = nwg / NXCD, r = nwg % NXCD, xcd = wgid % NXCD, off = wgid / NXCD; wgid = (xcd < r ? xcd * (q + 1) : r * (q + 1) + (xcd - r) * q) + off; }
        const int nig = WGM * nN, gid = wgid / nig, fm = gid * WGM, gsz = (nM - fm) < WGM ? (nM - fm) : WGM;
        u.pm = fm + ((wgid % nig) % gsz); u.pn = (wgid % nig) / gsz; return true;
    }
    __device__ __forceinline__ void a_ready(const Unit&) const {}
    __device__ __forceinline__ void done(const Unit&) const {}
};

typedef float f32x2c __attribute__((ext_vector_type(2))); typedef __bf16 bf16x2c __attribute__((ext_vector_type(2)));
__device__ __forceinline__ unsigned cvt_pk_bf16(float lo, float hi) { const f32x2c v = {lo, hi}; return __builtin_bit_cast(unsigned, __builtin_convertvector(v, bf16x2c)); }
typedef float f32x2 __attribute__((ext_vector_type(2)));
__device__ __forceinline__ float bf_lo(unsigned w) { return __builtin_bit_cast(float, w << 16); }
__device__ __forceinline__ float bf_hi(unsigned w) { return __builtin_bit_cast(float, w & 0xffff0000u); }
__device__ __forceinline__ float sigmoidf_(float x) { return 1.0f / (1.0f + __expf(-x)); }
template <int MODE> struct EpiB {
    static constexpr bool PERM = true, AFTER_DRAIN = false;
    bf16_t* O; int ldc; const bf16_t* gate; int ldg; const float* ss;
    __device__ __forceinline__ void operator()(const f32x4 (&acc)[2][2][4][2], const Unit& u, int wr, int wc, int fr, int fq) const {
        const int row0 = u.pm * BM + wr * 64 + fr, col0 = u.pn * BM + wc * 32 + 8 * fq;
        float rs[2][4];
        for (int rep_ = 0; rep_ < ((MK_REP & 128) ? 2 : 1); ++rep_) { asm volatile("" ::: "memory");
        if (MODE <= 1) {
            typedef __attribute__((address_space(1))) const f32x4 gf4;
            f32x4 q[2][4][2];
#pragma unroll
            for (int ai = 0; ai < 2; ++ai)
#pragma unroll
                for (int m = 0; m < 4; ++m) { gf4* sp = (gf4*)(ss + (size_t)(row0 + ai * HALF + m * 16) * 32) + fq * 2; q[ai][m][0] = sp[0]; q[ai][m][1] = sp[1]; }
#pragma unroll
            for (int ai = 0; ai < 2; ++ai)
#pragma unroll
                for (int m = 0; m < 4; ++m) { const f32x4 a = q[ai][m][0] + q[ai][m][1]; rs[ai][m] = (a[0] + a[1]) + (a[2] + a[3]); }
#pragma unroll
            for (int ai = 0; ai < 2; ++ai)
#pragma unroll
                for (int m = 0; m < 4; ++m) rs[ai][m] += __shfl_xor(rs[ai][m], 16);
#pragma unroll
            for (int ai = 0; ai < 2; ++ai)
#pragma unroll
                for (int m = 0; m < 4; ++m) { rs[ai][m] += __shfl_xor(rs[ai][m], 32); rs[ai][m] = __builtin_amdgcn_rsqf(rs[ai][m] * (1.0f / 2048.0f) + 1e-6f); }
        }
        if (MK_REP & 128) asm volatile("" : "+v"(rs[0][0]), "+v"(rs[1][3]) :: "memory"); }
#pragma unroll
        for (int ai = 0; ai < 2; ++ai)
#pragma unroll
            for (int m = 0; m < 4; ++m) { const size_t row = (size_t)(row0 + ai * HALF + m * 16);
#pragma unroll
                for (int bj = 0; bj < 2; ++bj) { f32x4 v0 = acc[ai][bj][m][0], v1 = acc[ai][bj][m][1]; const int c = col0 + bj * HALF;
                    if (MODE <= 1) { v0 = v0 * rs[ai][m]; v1 = v1 * rs[ai][m]; }
                    if (MODE == 1) {
#pragma unroll
                        for (int j = 0; j < 4; ++j) { const float a = fmaxf(v0[j], 0.f), b = fmaxf(v1[j], 0.f); v0[j] = a * a; v1[j] = b * b; } }
                    if (MODE >= 2) { const u32x4 g = *(const u32x4*)(gate + row * ldg + c);
                        v0[0] *= sigmoidf_(bf_lo(g.x)); v0[1] *= sigmoidf_(bf_hi(g.x)); v0[2] *= sigmoidf_(bf_lo(g.y)); v0[3] *= sigmoidf_(bf_hi(g.y));
                        v1[0] *= sigmoidf_(bf_lo(g.z)); v1[1] *= sigmoidf_(bf_hi(g.z)); v1[2] *= sigmoidf_(bf_lo(g.w)); v1[3] *= sigmoidf_(bf_hi(g.w)); }
                    if (MODE == 3) { const u32x4 o = *(const u32x4*)(O + row * ldc + c);
                        v0[0] += bf_lo(o.x); v0[1] += bf_hi(o.x); v0[2] += bf_lo(o.y); v0[3] += bf_hi(o.y);
                        v1[0] += bf_lo(o.z); v1[1] += bf_hi(o.z); v1[2] += bf_lo(o.w); v1[3] += bf_hi(o.w); }
                    u32x4 w; w.x = cvt_pk_bf16(v0[0], v0[1]); w.y = cvt_pk_bf16(v0[2], v0[3]); w.z = cvt_pk_bf16(v1[0], v1[1]); w.w = cvt_pk_bf16(v1[2], v1[3]);
                    *(u32x4*)(O + row * ldc + c) = w; } }
    }
};
struct EpiResNorm {
    static constexpr bool PERM = true, AFTER_DRAIN = false;
    float* X; int ldc; bf16_t* XB; float* SS; const float* Xin;
    __device__ __forceinline__ void operator()(const f32x4 (&acc)[2][2][4][2], const Unit& u, int wr, int wc, int fr, int fq) const {
        const int row0 = u.pm * BM + wr * 64 + fr, col0 = u.pn * BM + wc * 32 + 8 * fq;
#pragma unroll
        for (int ai = 0; ai < 2; ++ai)
#pragma unroll
            for (int m = 0; m < 4; ++m) { const size_t row = (size_t)(row0 + ai * HALF + m * 16);
                float s = 0.f;
#pragma unroll
                for (int bj = 0; bj < 2; ++bj) { const int c = col0 + bj * HALF; float* p = X + row * ldc + c; const float* pi = Xin + row * ldc + c;
                    const f32x4 x0 = *(const f32x4*)pi + acc[ai][bj][m][0], x1 = *(const f32x4*)(pi + 4) + acc[ai][bj][m][1];
                    *(f32x4*)p = x0; *(f32x4*)(p + 4) = x1;
                    u32x4 w; w.x = cvt_pk_bf16(x0[0], x0[1]); w.y = cvt_pk_bf16(x0[2], x0[3]); w.z = cvt_pk_bf16(x1[0], x1[1]); w.w = cvt_pk_bf16(x1[2], x1[3]);
                    *(u32x4*)(XB + row * ldc + c) = w;
                    s += ((x0[0] * x0[0] + x0[1] * x0[1]) + (x0[2] * x0[2] + x0[3] * x0[3])) + ((x1[0] * x1[0] + x1[1] * x1[1]) + (x1[2] * x1[2] + x1[3] * x1[3])); }
                s += __shfl_xor(s, 16); s += __shfl_xor(s, 32);
                if (fq == 0) SS[row * 32 + u.pn * 4 + wc] = s; }
    }
};

template <class Epi, class Sched, bool ALIGN_EPI = false, bool SP2 = false>
__device__ __forceinline__ void gemm_phase(PG8_LAS unsigned char* lds, const Gemm g, const Sched& S, const Epi& E) {
    int tid_ = threadIdx.x; asm volatile("" : "+v"(tid_));
    const int tid = tid_, wid = __builtin_amdgcn_readfirstlane(tid >> 6), lane = tid & 63, wr = wid >> 2, wc = wid & 3, fr = lane & 15, fq = lane >> 4;
    const int K = g.K, nt = K / BK;
    unsigned voffA[2], voffB[2];
#pragma unroll
    for (int i = 0; i < 2; ++i) { int R, C; stage_rc(tid * 16 + i * 8192, R, C); const int Rb = Epi::PERM ? ((R & ~31) + perm32(R & 31)) : R;
        voffA[i] = (unsigned)(R * K + C) * 2u; voffB[i] = (unsigned)(Rb * K + C) * 2u; }
    const size_t kstep = (size_t)(BK * 2);
    const size_t hstep = (size_t)HALF * K * 2;
    const size_t tstep = 2 * hstep;
    const unsigned ldsw = (unsigned)wid * 1024u;
    const int aoff = lds_byte(wr * 64 + fr, fq * 8), boff = lds_byte(wc * 32 + fr, fq * 8);
#define PG8_SA(b, h) (((b) * 2 + (h)) * HTB)
#define PG8_SB(b, h) ((4 + (b) * 2 + (h)) * HTB)
#define PG8_STAGE(bufoff, gbase, voff) do { _Pragma("unroll") for (int _i = 0; _i < 2; ++_i) \
        __builtin_amdgcn_global_load_lds((const unsigned*)((const char*)(gbase) + (voff)[_i]), (PG8_LAS unsigned*)(lds + (bufoff) + ldsw + _i * 8192), 16, 0, 0); } while (0)
#define PG8_LDA(dst, b, h) do { _Pragma("unroll") for (int m = 0; m < 4; ++m) _Pragma("unroll") for (int k = 0; k < 2; ++k) dst[m][k] = *(const PG8_LAS bf16x8*)(lds + PG8_SA(b, h) + aoff + m * 2048 + k * 1024); } while (0)
#define PG8_LDB(dst, b, h) do { _Pragma("unroll") for (int n = 0; n < 2; ++n) _Pragma("unroll") for (int k = 0; k < 2; ++k) dst[n][k] = *(const PG8_LAS bf16x8*)(lds + PG8_SB(b, h) + boff + n * 2048 + k * 1024); } while (0)
#define PG8_MMA(ai, bj, At, Bt) do { __builtin_amdgcn_s_setprio(1); _Pragma("unroll") for (int m = 0; m < 4; ++m) _Pragma("unroll") for (int n = 0; n < 2; ++n) _Pragma("unroll") for (int k = 0; k < 2; ++k) \
        acc[ai][bj][m][n] = __builtin_amdgcn_mfma_f32_16x16x32_bf16(Bt[n][k], At[m][k], acc[ai][bj][m][n], 0, 0, 0); __builtin_amdgcn_s_setprio(0); } while (0)
#define PG8_WAIT_V(n) asm volatile("s_waitcnt vmcnt(" #n ")" ::: "memory")
#define PG8_WAIT_L(n) asm volatile("s_waitcnt lgkmcnt(" #n ")" ::: "memory")
#define PG8_BAR __builtin_amdgcn_s_barrier()
#define PG8_SCHED __builtin_amdgcn_sched_barrier(0)
    Unit cur, nxt; int ui = 0;
    if (!S.next(0, cur)) return;
    f32x4 acc[2][2][4][2];
#pragma unroll
    for (int a = 0; a < 2; ++a)
#pragma unroll
        for (int b = 0; b < 2; ++b)
#pragma unroll
            for (int m = 0; m < 4; ++m)
#pragma unroll
                for (int n = 0; n < 2; ++n) acc[a][b][m][n] = (f32x4){0.f, 0.f, 0.f, 0.f};
    bf16x8 At[4][2], B0[2][2], B1[2][2];
    const char* cA = (const char*)g.A + (size_t)cur.pm * tstep; const char* cB = (const char*)g.Bt + (size_t)cur.pn * tstep;
    S.a_ready(cur);
    if constexpr (SP2) {
        PG8_STAGE(PG8_SB(0, 0), cB, voffB); PG8_STAGE(PG8_SB(0, 1), cB + hstep, voffB); PG8_STAGE(PG8_SA(0, 0), cA, voffA); PG8_STAGE(PG8_SA(0, 1), cA + hstep, voffA);
        if (wr == 1) PG8_BAR;
        PG8_WAIT_V(2); PG8_BAR;
        PG8_STAGE(PG8_SB(1, 0), cB + kstep, voffB); PG8_STAGE(PG8_SA(1, 0), cA + kstep, voffA); PG8_STAGE(PG8_SB(1, 1), cB + hstep + kstep, voffB);
        PG8_WAIT_V(6); PG8_BAR;
    } else {
        PG8_STAGE(PG8_SB(0, 0), cB, voffB); PG8_STAGE(PG8_SA(0, 0), cA, voffA); PG8_STAGE(PG8_SB(0, 1), cB + hstep, voffB); PG8_STAGE(PG8_SA(0, 1), cA + hstep, voffA);
        if (wr == 1) PG8_BAR;
        PG8_WAIT_V(4); PG8_BAR;
        PG8_STAGE(PG8_SB(1, 0), cB + kstep, voffB); PG8_STAGE(PG8_SA(1, 0), cA + kstep, voffA); PG8_STAGE(PG8_SB(1, 1), cB + hstep + kstep, voffB);
        PG8_WAIT_V(6); PG8_BAR;
    }
    for (;;) {
        const bool has_next = S.next(ui + 1, nxt);
        const char* nA = has_next ? (const char*)g.A + (size_t)nxt.pm * tstep : cA; const char* nB = has_next ? (const char*)g.Bt + (size_t)nxt.pn * tstep : cB;
        for (int t = 0; t < nt; t += 2) {
            const bool last = (t == nt - 2);
            const char* a1 = cA + (size_t)(t + 1) * kstep;
            const char* a2 = last ? nA : cA + (size_t)(t + 2) * kstep; const char* b2 = last ? nB : cB + (size_t)(t + 2) * kstep;
            const char* a3 = a2 + kstep; const char* b3 = b2 + kstep;
            if (last && has_next) S.a_ready(nxt);
            if constexpr (SP2) {
            PG8_LDB(B0, 0, 0); PG8_LDB(B1, 0, 1); PG8_SCHED; PG8_LDA(At, 0, 0); PG8_STAGE(PG8_SA(1, 1), a1 + hstep, voffA);
            PG8_WAIT_V(8); PG8_WAIT_L(0); PG8_BAR; PG8_MMA(0, 0, At, B0); PG8_MMA(0, 1, At, B1); PG8_BAR; PG8_SCHED;
            PG8_LDA(At, 0, 1); PG8_STAGE(PG8_SB(0, 0), b2, voffB); PG8_STAGE(PG8_SB(0, 1), b2 + hstep, voffB); PG8_STAGE(PG8_SA(0, 0), a2, voffA);
            PG8_WAIT_V(8); PG8_WAIT_L(0); PG8_BAR; PG8_MMA(1, 0, At, B0); PG8_MMA(1, 1, At, B1); PG8_BAR; PG8_SCHED;
            PG8_LDB(B0, 1, 0); PG8_LDB(B1, 1, 1); PG8_SCHED; PG8_LDA(At, 1, 0); PG8_STAGE(PG8_SA(0, 1), a2 + hstep, voffA);
            PG8_WAIT_V(8); PG8_WAIT_L(0); PG8_BAR; PG8_MMA(0, 0, At, B0); PG8_MMA(0, 1, At, B1); PG8_BAR; PG8_SCHED;
            PG8_LDA(At, 1, 1); PG8_STAGE(PG8_SB(1, 0), b3, voffB); PG8_STAGE(PG8_SB(1, 1), b3 + hstep, voffB); PG8_STAGE(PG8_SA(1, 0), a3, voffA);
            PG8_WAIT_V(8); PG8_WAIT_L(0); PG8_BAR; PG8_MMA(1, 0, At, B0); PG8_MMA(1, 1, At, B1); PG8_BAR; PG8_SCHED;
            } else {
            PG8_LDB(B0, 0, 0); PG8_SCHED; PG8_LDA(At, 0, 0); PG8_STAGE(PG8_SA(1, 1), a1 + hstep, voffA);
            PG8_WAIT_L(8); PG8_BAR; PG8_WAIT_L(0); PG8_MMA(0, 0, At, B0); PG8_BAR; PG8_SCHED;
            PG8_LDB(B1, 0, 1); PG8_STAGE(PG8_SB(0, 0), b2, voffB);
            PG8_BAR; PG8_WAIT_L(0); PG8_MMA(0, 1, At, B1); PG8_BAR;
            PG8_LDA(At, 0, 1); PG8_STAGE(PG8_SA(0, 0), a2, voffA);
            PG8_BAR; PG8_WAIT_L(0); PG8_MMA(1, 0, At, B0); PG8_BAR; PG8_SCHED;
            PG8_STAGE(PG8_SB(0, 1), b2 + hstep, voffB);
            PG8_WAIT_V(6); PG8_BAR; PG8_MMA(1, 1, At, B1); PG8_BAR;
            PG8_LDB(B0, 1, 0); PG8_SCHED; PG8_LDA(At, 1, 0); PG8_STAGE(PG8_SA(0, 1), a2 + hstep, voffA);
            PG8_WAIT_L(8); PG8_BAR; PG8_WAIT_L(0); PG8_MMA(0, 0, At, B0); PG8_BAR; PG8_SCHED;
            PG8_LDB(B1, 1, 1); PG8_STAGE(PG8_SB(1, 0), b3, voffB);
            PG8_BAR; PG8_WAIT_L(0); PG8_MMA(0, 1, At, B1); PG8_BAR;
            PG8_LDA(At, 1, 1); PG8_STAGE(PG8_SA(1, 0), a3, voffA);
            PG8_BAR; PG8_WAIT_L(0); PG8_MMA(1, 0, At, B0); PG8_BAR; PG8_SCHED;
            PG8_STAGE(PG8_SB(1, 1), b3 + hstep, voffB);
            PG8_WAIT_V(6); PG8_BAR; PG8_MMA(1, 1, At, B1); PG8_BAR;
            }
        }
        if constexpr (ALIGN_EPI) { if (wr == 0) PG8_BAR; }
        if constexpr (!Epi::AFTER_DRAIN) { E(acc, cur, wr, wc, fr, fq); S.done(cur); }
        if (!has_next) break;
#pragma unroll
        for (int a = 0; a < 2; ++a)
#pragma unroll
            for (int b = 0; b < 2; ++b)
#pragma unroll
                for (int m = 0; m < 4; ++m)
#pragma unroll
                    for (int n = 0; n < 2; ++n) acc[a][b][m][n] = (f32x4){0.f, 0.f, 0.f, 0.f};
        cur = nxt; cA = nA; cB = nB; ++ui;
        if constexpr (ALIGN_EPI) { if (wr == 1) PG8_BAR; }
    }
    PG8_WAIT_V(0);
    if constexpr (!ALIGN_EPI) { if (wr == 0) PG8_BAR; }
    PG8_BAR;
    if constexpr (Epi::AFTER_DRAIN) { E.fused(acc, cur, wr, wc, fr, fq, lds, wid, lane); S.done(cur); }
#undef PG8_SA
#undef PG8_SB
#undef PG8_STAGE
#undef PG8_LDA
#undef PG8_LDB
#undef PG8_MMA
#undef PG8_WAIT_V
#undef PG8_WAIT_L
#undef PG8_BAR
#undef PG8_SCHED
}
}
constexpr int NWAVES = 8;
#ifndef MK_ONE_LAUNCH
#define MK_ONE_LAUNCH 1
#endif

#ifndef MK_GLOBAL_GROUPS
#define MK_GLOBAL_GROUPS 30
#endif
#ifndef MK_CHUNKED
#define MK_CHUNKED 1
#endif
#ifndef MK_SP2
#define MK_SP2 true
#endif
#ifndef MK_ALIGN
#define MK_ALIGN true
#endif
#ifndef MK_CONV_IN_G1
#define MK_CONV_IN_G1 0
#endif
#ifndef MK_X2_NT
#define MK_X2_NT 0
#endif
#ifndef MK_REP
#define MK_REP 0
#endif

constexpr int BATCH = 2, SEQ = 8192, D = 2048, DEPTH = 4, M = BATCH * SEQ;
constexpr int RETW = 1024, RH = 8, RD = 128, RWW = 1024, WH = 16, WD = 64;
constexpr int INW = 11520, DFF = 8192, RWSHIFT = 3328;
constexpr int ZC_Q = 0, ZC_K = 1024, ZC_V = 2048, ZC_GR = 3072, ZC_RW = 4096, ZC_GA = 7424, ZC_GB = 9472;
constexpr int RWC_R = 0, RWC_K = 1024, RWC_V = 2048, RWC_W = 3072, RWC_A = 3136, RWC_G = 3200;
constexpr float NORM_EPS = 1e-6f, RET_GN_EPS = 1e-5f, RWKV_LN_EPS = 64e-5f;

constexpr size_t MiB = 1u << 20;
constexpr size_t WS_CTL = 0, CTL_ZERO_BYTES = 1 * MiB;
constexpr size_t WS_ROPE = 1 * MiB;
constexpr size_t WS_WSET = 16 * MiB, WSET_BYTES = 126 * MiB;
constexpr size_t WO_WIN = 0, WO_WA = 45 * MiB, WO_WB = 49 * MiB, WO_WO = 53 * MiB, WO_WUP = 61 * MiB, WO_WDN = 93 * MiB, WO_LORA = 125 * MiB;
constexpr size_t WS_H = 272 * MiB;
constexpr size_t WS_Z = 336 * MiB;
constexpr size_t WS_UP = WS_Z;
constexpr size_t WS_QR = 696 * MiB, WS_KR = 728 * MiB;
constexpr size_t WS_YRET = 760 * MiB, WS_YRWKV = 792 * MiB;
constexpr size_t WS_MRG = 824 * MiB;
#if MK_CHUNKED
constexpr size_t WS_SR = 888 * MiB, WS_SV = 1208 * MiB;
#else
constexpr size_t WS_SR = 888 * MiB, WS_SW = 952 * MiB, WS_SK = 1016 * MiB, WS_SV = 1080 * MiB, WS_SNKK = 1144 * MiB, WS_SKKA = 1208 * MiB;
#endif
constexpr size_t WS_CU = WS_SR;
constexpr size_t WS_G = 1272 * MiB;
constexpr size_t WS_BONUS = 1336 * MiB;
constexpr size_t WS_SS = 1337 * MiB;
constexpr size_t WS_YRAWR = WS_H, WS_YRAWW = WS_MRG;
constexpr size_t WS_END = 1341 * MiB;
constexpr int CW_BAR = 4096;

constexpr int PPL = 9;
enum { LP_G1 = 0, LP_PREP, LP_SCAN, LP_POST, LP_GA, LP_GB, LP_GO, LP_GUP, LP_GDN };
constexpr int PH_PRO = 0, PH_L0 = 1, PH_FIN = PH_L0 + DEPTH * PPL, NPH = PH_FIN + 1;

constexpr int RING_OFF = 0, RING_BYTES = 131072;
constexpr int LDSCTL_OFF = RING_BYTES, MISC_OFF = LDSCTL_OFF + 320;
constexpr int LDS_BYTES = 147456;
static_assert(MISC_OFF + 128 <= LDS_BYTES, "LDS map");

#define GAS __attribute__((address_space(1)))
#define LAS __attribute__((address_space(3)))
typedef unsigned short bf16;
typedef unsigned v4u __attribute__((ext_vector_type(4)));
typedef unsigned v2u __attribute__((ext_vector_type(2)));
typedef float f32x4 __attribute__((ext_vector_type(4)));
typedef float f32x2 __attribute__((ext_vector_type(2)));
typedef short bf16x8 __attribute__((ext_vector_type(8)));
typedef GAS unsigned gu32;
#define LDS_WAIT() asm volatile("s_waitcnt lgkmcnt(0)" ::: "memory")
#define VM_WAIT() asm volatile("s_waitcnt vmcnt(0)" ::: "memory")
__device__ __forceinline__ unsigned f2bf(float f) { unsigned u = __builtin_bit_cast(unsigned, f); return (u + 0x7fffu + ((u >> 16) & 1u)) >> 16; }
__device__ __forceinline__ unsigned pk2(float lo, float hi) { return f2bf(lo) | (f2bf(hi) << 16); }
__device__ __forceinline__ float bf2f(bf16 v) { return __builtin_bit_cast(float, (unsigned)v << 16); }
__device__ __forceinline__ float rdlane(float v, int l) { return __builtin_bit_cast(float, __builtin_amdgcn_readlane(__builtin_bit_cast(int, v), l)); }
__device__ __forceinline__ float sigm(float x) { return 1.0f / (1.0f + expf(-x)); }

__device__ const double ROPE_REV[64] = {
0.15915494309189535, 0.13782250260398285, 0.11934937021124886, 0.10335229661843406,
0.08949940160889101, 0.07750328875537406, 0.06711508300522726, 0.058119267441876246,
0.050329212104487035, 0.04358330210530733, 0.03774158471741977, 0.032682865872357,
0.0283021958306234, 0.024508691862069852, 0.02122365276477766, 0.018378926105679667,
0.015915494309189534, 0.013782250260398284, 0.011934937021124886, 0.010335229661843406,
0.008949940160889102, 0.0077503288755374055, 0.006711508300522725, 0.005811926744187624,
0.005032921210448704, 0.004358330210530733, 0.003774158471741977, 0.0032682865872356993,
0.00283021958306234, 0.002450869186206985, 0.0021223652764777662, 0.0018378926105679667,
0.0015915494309189536, 0.0013782250260398288, 0.0011934937021124885, 0.0010335229661843405,
0.0008949940160889102, 0.0007750328875537405, 0.0006711508300522726, 0.0005811926744187624,
0.0005032921210448703, 0.0004358330210530733, 0.00037741584717419774, 0.0003268286587235699,
0.00028302195830623395, 0.00024508691862069854, 0.0002122365276477766, 0.00018378926105679666,
0.00015915494309189535, 0.00013782250260398286, 0.00011934937021124886, 0.00010335229661843406,
8.949940160889102e-05, 7.750328875537406e-05, 6.711508300522725e-05, 5.811926744187624e-05,
5.0329212104487035e-05, 4.358330210530732e-05, 3.774158471741978e-05, 3.2682865872357e-05,
2.8302195830623396e-05, 2.4508691862069852e-05, 2.122365276477766e-05, 1.8378926105679668e-05 };

#define XB_TMO      128
#define XB_XCNT(j)  (256  + 64 * (j))
#define XB_XSUB(j)  (1280 + 64 * (j))
#define XB_XGEN(j)  (2304 + 64 * (j))
#define XB_TOP      3328
#define XB_TOPGEN   3392
#define XCD_BAR_WORDS 3456
#define XB_SPIN_CAP (1u << 18)

__device__ __forceinline__ unsigned xb_ld(unsigned* p)              { return __hip_atomic_load(p, __ATOMIC_RELAXED, __HIP_MEMORY_SCOPE_AGENT); }
__device__ __forceinline__ unsigned xb_add(unsigned* p, unsigned v) { return __hip_atomic_fetch_add(p, v, __ATOMIC_RELAXED, __HIP_MEMORY_SCOPE_AGENT); }
__device__ __forceinline__ unsigned xb_xcc_id() { return (unsigned)__builtin_amdgcn_s_getreg((3 << 11) | 20) & 0xFu; }
#define XB_SPIN(cond, bar) do { unsigned _sp = 0; while (cond) { __builtin_amdgcn_s_sleep(1); \
    if ((++_sp & 255u) == 0u) { if (xb_ld(&(bar)[XB_TMO])) break; if (_sp > XB_SPIN_CAP) { atomicAdd(&(bar)[XB_TMO], 1u); break; } } } } while (0)

struct XcdBarrier {
    unsigned* bar; unsigned x;
    volatile LAS unsigned* st;
};

__device__ __forceinline__ XcdBarrier xcd_barrier_post(unsigned* bar, volatile LAS unsigned* st) {
    XcdBarrier b; b.bar = bar; b.x = xb_xcc_id(); b.st = st;
    if (threadIdx.x == 0) (void)xb_add(&bar[XB_XCNT(b.x)], 1u);
    return b;
}
__device__ __forceinline__ void xcd_barrier_complete(unsigned* bar, unsigned x, unsigned& nloc, unsigned& nx) {
    const unsigned G = gridDim.x * gridDim.y * gridDim.z;
    unsigned sum, cnt, mine, sp = 0u;
    for (;;) {
        sum = 0u; cnt = 0u; mine = 0u;
#pragma unroll
        for (unsigned j = 0; j < 16; ++j) { const unsigned c = xb_ld(&bar[XB_XCNT(j)]); sum += c; cnt += (c > 0u) ? 1u : 0u; mine = (j == x) ? c : mine; }
        if (sum == G) break;
        __builtin_amdgcn_s_sleep(1);
        if ((++sp & 255u) == 0u) { if (xb_ld(&bar[XB_TMO])) break; if (sp > XB_SPIN_CAP) { atomicAdd(&bar[XB_TMO], 1u); break; } }
    }
    nloc = mine > 0u ? mine : 1u; nx = cnt > 0u ? cnt : 1u;
}

__device__ __forceinline__ void xcd_barrier(const XcdBarrier& b) {
    asm volatile("s_waitcnt vmcnt(0)" ::: "memory");
    __syncthreads();
    if (threadIdx.x == 0) {
        unsigned* bar = b.bar;
        __builtin_amdgcn_s_waitcnt(0);
        unsigned nloc = b.st[0], nx = b.st[1];
        if (nloc == 0u) { xcd_barrier_complete(bar, b.x, nloc, nx); b.st[0] = nloc; b.st[1] = nx; }
        const unsigned old = xb_add(&bar[XB_XSUB(b.x)], 1u);
        const unsigned gen = old / nloc;
        if (old + 1u == (gen + 1u) * nloc) {
            __builtin_amdgcn_fence(__ATOMIC_RELEASE, "agent");
            asm volatile("s_waitcnt vmcnt(0)" ::: "memory");
            const unsigned og = xb_add(&bar[XB_TOP], 1u);
            const unsigned tg = og / nx;
            if (og + 1u == (tg + 1u) * nx) xb_add(&bar[XB_TOPGEN], 1u);
            else XB_SPIN(xb_ld(&bar[XB_TOPGEN]) == tg, bar);
            __builtin_amdgcn_fence(__ATOMIC_ACQUIRE, "agent");
            xb_add(&bar[XB_XGEN(b.x)], 1u);
            asm volatile("s_waitcnt vmcnt(0)" ::: "memory");
        } else {
            XB_SPIN(xb_ld(&bar[XB_XGEN(b.x)]) == gen, bar);
            __builtin_amdgcn_fence(__ATOMIC_ACQUIRE, "agent");
            asm volatile("s_waitcnt vmcnt(0)" ::: "memory");
        }
    }
    __syncthreads();
}


struct Frame {
    LAS unsigned char* lds;
    volatile LAS unsigned* MISC;
    int tid, lane, wave;
    int vcu, G;
    float* out; unsigned char* ws;
};
struct Args { const float* in[24]; float* out; unsigned char* ws; int ph_lo, ph_hi, li, pad; };
#define WSP(T, off) ((T*)(F.ws + (off)))
#define WSPG(T, off) ((T*)(GAS T*)(unsigned long long)(F.ws + (off)))
#define WSW(l, off) ((bf16*)(F.ws + WS_WSET + (size_t)((l) & 1) * WSET_BYTES + (off)))
#define WSWG(l, off) ((bf16*)(GAS bf16*)(unsigned long long)(F.ws + WS_WSET + (size_t)((l) & 1) * WSET_BYTES + (off)))
#define OUTP ((float*)F.out)
#define OUTPG ((float*)(GAS float*)(unsigned long long)F.out)
#define INP(A, i) ((const float*)((const GAS float*)(A)->in[i]))
#define RETID() do { int t_ = threadIdx.x; asm volatile("" : "+v"(t_)); F.tid = t_; F.lane = t_ & 63; } while (0)
#define CAS __attribute__((address_space(4)))
typedef const CAS Args* ArgP;

__device__ __forceinline__ float fexp(float x) { return __builtin_amdgcn_exp2f(x * 1.4426950408889634f); }
__device__ __forceinline__ float fsig(float x) { return __builtin_amdgcn_rcpf(1.0f + fexp(-x)); }
__device__ __forceinline__ float ftanh(float x) { return 1.0f - 2.0f * __builtin_amdgcn_rcpf(1.0f + fexp(2.0f * x)); }
__device__ __forceinline__ float wave_sum(float v) {
#pragma unroll
    for (int o = 1; o < 64; o <<= 1) v += __shfl_xor(v, o);
    return v;
}
struct TItem { const float* W; bf16* WT; const float* gk; int K, N, item; };
__device__ __forceinline__ void titem_load(const TItem& t, int lane, f32x4 (&v)[8]) {
    const int nblk = t.N / 32, kb = t.item / nblk, nb = t.item % nblk, k0 = 64 * kb, n0 = 32 * nb, nq = lane & 7, kr = lane >> 3;
#pragma unroll
    for (int i = 0; i < 8; ++i) v[i] = *(const GAS f32x4*)(t.W + (size_t)(k0 + kr + 8 * i) * t.N + n0 + 4 * nq);
}
__device__ __forceinline__ void titem_finish(const TItem& t, int lane, const f32x4 (&v)[8], LAS float* scr) {
    const int nblk = t.N / 32, kb = t.item / nblk, nb = t.item % nblk, k0 = 64 * kb, n0 = 32 * nb, nq = lane & 7, kr = lane >> 3;
#pragma unroll
    for (int i = 0; i < 8; ++i)
#pragma unroll
        for (int e = 0; e < 4; ++e) scr[(kr + 8 * i) * 33 + 4 * nq + e] = v[i][e];
    const int c = lane & 7;
    f32x4 g0 = (f32x4){1.f, 1.f, 1.f, 1.f}, g1 = g0;
    if (t.gk) { g0 = *(const GAS f32x4*)(t.gk + k0 + 8 * c); g1 = *(const GAS f32x4*)(t.gk + k0 + 8 * c + 4); }
    LDS_WAIT(); asm volatile("" ::: "memory");
#pragma unroll
    for (int j = 0; j < 4; ++j) { const int n = (lane >> 3) + 8 * j; const LAS float* s = scr + (8 * c) * 33 + n;
        v4u o; o.x = pk2(s[0 * 33] * g0.x, s[1 * 33] * g0.y); o.y = pk2(s[2 * 33] * g0.z, s[3 * 33] * g0.w); o.z = pk2(s[4 * 33] * g1.x, s[5 * 33] * g1.y); o.w = pk2(s[6 * 33] * g1.z, s[7 * 33] * g1.w);
        *(GAS v4u*)(t.WT + (size_t)(n0 + n) * t.K + k0 + 8 * c) = o; }
    LDS_WAIT(); asm volatile("" ::: "memory");
}
__device__ __forceinline__ void rms_row_to_bf16(const float* xrow, const float* g, bf16* orow, int lane) {
    const GAS f32x4* xr = (const GAS f32x4*)xrow + lane;
    f32x4 v[8]; float s = 0.f;
#pragma unroll
    for (int j = 0; j < 8; ++j) { v[j] = xr[64 * j]; s += (v[j].x * v[j].x + v[j].y * v[j].y) + (v[j].z * v[j].z + v[j].w * v[j].w); }
    const float rstd = 1.f / sqrtf(wave_sum(s) * (1.f / D) + NORM_EPS);
    const GAS f32x4* gr = (const GAS f32x4*)g + lane;
    GAS v2u* o8 = (GAS v2u*)orow + lane;
#pragma unroll
    for (int j = 0; j < 8; ++j) { const f32x4 gg = gr[64 * j]; v2u o; o.x = pk2(v[j].x * rstd * gg.x, v[j].y * rstd * gg.y); o.y = pk2(v[j].z * rstd * gg.z, v[j].w * rstd * gg.w); o8[64 * j] = o; }
}

#if (MK_GLOBAL_GROUPS & 1)
#pragma push_macro("WSP")
#pragma push_macro("WSW")
#pragma push_macro("OUTP")
#undef WSP
#undef WSW
#undef OUTP
#define WSP WSPG
#define WSW WSWG
#define OUTP OUTPG
#endif
__device__ __forceinline__ void ph_prologue(Frame& F, ArgP A) {
    const int* pos = (const int*)INP(A, 1); float2* rope = WSP(float2, WS_ROPE);
    {
        const int gw = F.vcu * NWAVES + F.wave, NGW = F.G * NWAVES, lane = F.lane;
        for (int m = gw; m < M; m += NGW) {
            const GAS f32x4* xr = (const GAS f32x4*)(INP(A, 0) + (size_t)m * D) + lane;
            GAS v2u* hb = (GAS v2u*)(WSP(bf16, WS_H) + (size_t)m * D) + lane; float s = 0.f;
#pragma unroll
            for (int j = 0; j < 8; ++j) { const f32x4 v = xr[64 * j]; v2u o; o.x = pk2(v.x, v.y); o.y = pk2(v.z, v.w); hb[64 * j] = o; s += (v.x * v.x + v.y * v.y) + (v.z * v.z + v.w * v.w); }
            s = wave_sum(s);
            if (lane < 32) WSP(float, WS_SS)[(size_t)m * 32 + lane] = lane == 0 ? s : 0.f;
        }
    }
    for (int i = F.vcu * 512 + F.tid; i < M * 64; i += F.G * 512) {
        const int m = i >> 6, j = i & 63;
        const double rev = (double)pos[m] * ROPE_REV[j];
        const float fr = (float)(rev - __builtin_rint(rev));
        rope[i] = make_float2(__builtin_amdgcn_cosf(fr), __builtin_amdgcn_sinf(fr));
    }
}
#if (MK_GLOBAL_GROUPS & 1)
#pragma pop_macro("WSP")
#pragma pop_macro("WSW")
#pragma pop_macro("OUTP")
#endif
#if (MK_GLOBAL_GROUPS & 16)
#pragma push_macro("WSP")
#pragma push_macro("WSW")
#pragma push_macro("OUTP")
#undef WSP
#undef WSW
#undef OUTP
#define WSP WSPG
#define WSW WSWG
#define OUTP OUTPG
#endif
__device__ __forceinline__ TItem conv_item(Frame& F, ArgP A, int l, int it) {
    constexpr int I_IN = (D / 64) * (INW / 32), I_A = (RETW / 64) * (D / 32), I_O = (D / 64) * (D / 32), I_UP = (D / 64) * (DFF / 32), I_DN = (DFF / 64) * (D / 32);
    int r = it; TItem t;
    if (r < I_IN) { t = TItem{INP(A, 3) + (size_t)l * D * INW, WSW(l, WO_WIN), INP(A, 2) + (size_t)l * D, D, INW, r}; return t; } r -= I_IN;
    if (r < I_A) { t = TItem{INP(A, 17) + (size_t)l * RETW * D, WSW(l, WO_WA), nullptr, RETW, D, r}; return t; } r -= I_A;
    if (r < I_A) { t = TItem{INP(A, 18) + (size_t)l * RWW * D, WSW(l, WO_WB), nullptr, RWW, D, r}; return t; } r -= I_A;
    if (r < I_O) { t = TItem{INP(A, 19) + (size_t)l * D * D, WSW(l, WO_WO), nullptr, D, D, r}; return t; } r -= I_O;
    if (r < I_UP) { t = TItem{INP(A, 21) + (size_t)l * D * DFF, WSW(l, WO_WUP), INP(A, 20) + (size_t)l * D, D, DFF, r}; return t; } r -= I_UP;
    if (r < I_DN) { t = TItem{INP(A, 22) + (size_t)l * DFF * D, WSW(l, WO_WDN), nullptr, DFF, D, r}; return t; } r -= I_DN;
    if (r < 32) { t = TItem{INP(A, 8) + (size_t)l * 64 * RWW, WSW(l, WO_LORA), nullptr, 64, RWW, r}; return t; } r -= 32;
    if (r < 32) { t = TItem{INP(A, 10) + (size_t)l * 64 * RWW, WSW(l, WO_LORA) + 1024 * 64, nullptr, 64, RWW, r}; return t; } r -= 32;
    t = TItem{INP(A, 11) + (size_t)l * 128 * RWW, WSW(l, WO_LORA) + 2 * 1024 * 64, nullptr, 128, RWW, r}; return t;
}
__device__ __forceinline__ void ph_convert(Frame& F, ArgP A, int l, int wg, int nwg) {
    LAS float* scr = (LAS float*)(F.lds + RING_OFF + F.wave * 16384);
    const int gw = wg * NWAVES + F.wave, NGW = nwg * NWAVES, lane = F.lane;
    constexpr int I_IN = (D / 64) * (INW / 32), I_A = (RETW / 64) * (D / 32), I_O = (D / 64) * (D / 32), I_UP = (D / 64) * (DFF / 32), I_DN = (DFF / 64) * (D / 32);
    constexpr int NITEMS = I_IN + 2 * I_A + I_O + I_UP + I_DN + 32 + 32 + 64;
    if (gw >= NITEMS) return;
    TItem cur = conv_item(F, A, l, gw); f32x4 va[8], vb[8];
    titem_load(cur, lane, va);
    for (int it = gw; it < NITEMS; it += 2 * NGW) {
        TItem nxt = cur; const bool h1 = it + NGW < NITEMS;
        if (h1) { nxt = conv_item(F, A, l, it + NGW); titem_load(nxt, lane, vb); }
        titem_finish(cur, lane, va, scr);
        if (!h1) break;
        const bool h2 = it + 2 * NGW < NITEMS;
        if (h2) { cur = conv_item(F, A, l, it + 2 * NGW); titem_load(cur, lane, va); }
        titem_finish(nxt, lane, vb, scr);
        if (!h2) break;
    }
}
__device__ __forceinline__ void ph_norm(Frame& F, const float* g) {
    const int gw = F.vcu * NWAVES + F.wave, NGW = F.G * NWAVES;
    for (int m = gw; m < M; m += NGW) rms_row_to_bf16(OUTP + (size_t)m * D, g, WSP(bf16, WS_H) + (size_t)m * D, F.lane);
}
#if (MK_GLOBAL_GROUPS & 16)
#pragma pop_macro("WSP")
#pragma pop_macro("WSW")
#pragma pop_macro("OUTP")
#endif
#if (MK_GLOBAL_GROUPS & 2)
#pragma push_macro("WSP")
#pragma push_macro("WSW")
#pragma push_macro("OUTP")
#undef WSP
#undef WSW
#undef OUTP
#define WSP WSPG
#define WSW WSWG
#define OUTP OUTPG
#endif
__device__ __forceinline__ f32x4 unpk4(const v2u p) { return (f32x4){pg8::bf_lo(p.x), pg8::bf_hi(p.x), pg8::bf_lo(p.y), pg8::bf_hi(p.y)}; }
__device__ __forceinline__ void unpack8(const v4u a, float (&o)[8]) {
    o[0] = pg8::bf_lo(a.x); o[1] = pg8::bf_hi(a.x); o[2] = pg8::bf_lo(a.y); o[3] = pg8::bf_hi(a.y); o[4] = pg8::bf_lo(a.z); o[5] = pg8::bf_hi(a.z); o[6] = pg8::bf_lo(a.w); o[7] = pg8::bf_hi(a.w);
}
__device__ __forceinline__ void mix8(const GAS bf16* zc, bool has_prev, const GAS float* mu, float (&o)[8]) {
    const v4u a = *(const GAS v4u*)zc; v4u p = (v4u){0u, 0u, 0u, 0u}; if (has_prev) p = *(const GAS v4u*)(zc - INW);
    const f32x4 m0 = *(const GAS f32x4*)mu, m1 = *(const GAS f32x4*)(mu + 4);
    float z[8], q[8]; unpack8(a, z); unpack8(p, q);
#pragma unroll
    for (int j = 0; j < 4; ++j) { o[j] = z[j] + m0[j] * (q[j] - z[j]); o[4 + j] = z[4 + j] + m1[j] * (q[4 + j] - z[4 + j]); }
}
__device__ __forceinline__ f32x4 mix4(const GAS bf16* zc, bool has_prev, const GAS float* mu) {
    const v2u a = *(const GAS v2u*)zc; v2u p = (v2u){0u, 0u}; if (has_prev) p = *(const GAS v2u*)(zc - INW);
    const f32x4 m = *(const GAS f32x4*)mu;
    const f32x4 z = (f32x4){pg8::bf_lo(a.x), pg8::bf_hi(a.x), pg8::bf_lo(a.y), pg8::bf_hi(a.y)}, q = (f32x4){pg8::bf_lo(p.x), pg8::bf_hi(p.x), pg8::bf_lo(p.y), pg8::bf_hi(p.y)};
    return z + m * (q - z);
}
__device__ __forceinline__ bf16x8 pack8(const float (&v)[8]) {
    v4u o; o.x = pg8::cvt_pk_bf16(v[0], v[1]); o.y = pg8::cvt_pk_bf16(v[2], v[3]); o.z = pg8::cvt_pk_bf16(v[4], v[5]); o.w = pg8::cvt_pk_bf16(v[6], v[7]);
    return __builtin_bit_cast(bf16x8, o);
}
constexpr int CU_BYTES = 20480, CU_M = 0, CU_OM = 8192, CU_QB = 10240, CU_QSTR = 2560;
constexpr int CK = 16, NCHUNK = SEQ / CK;
constexpr int XL_STR = 144, XL_MAT = 16 * XL_STR;
typedef short s4v __attribute__((ext_vector_type(4)));
__device__ __forceinline__ s4v pk4(const f32x4 v) { v2u o; o.x = pg8::cvt_pk_bf16(v[0], v[1]); o.y = pg8::cvt_pk_bf16(v[2], v[3]); return __builtin_bit_cast(s4v, o); }
__device__ __forceinline__ bf16x8 pk8v(const f32x4 a, const f32x4 b) { v4u o; o.x = pg8::cvt_pk_bf16(a[0], a[1]); o.y = pg8::cvt_pk_bf16(a[2], a[3]); o.z = pg8::cvt_pk_bf16(b[0], b[1]); o.w = pg8::cvt_pk_bf16(b[2], b[3]); return __builtin_bit_cast(bf16x8, o); }
__device__ __forceinline__ f32x4 mma16(const s4v x, const s4v y, const f32x4 c) {
    const bf16x8 x8 = (bf16x8){x.x, x.y, x.z, x.w, 0, 0, 0, 0}, y8 = (bf16x8){y.x, y.y, y.z, y.w, 0, 0, 0, 0};
    return __builtin_amdgcn_mfma_f32_16x16x32_bf16(x8, y8, c, 0, 0, 0); }
__device__ __forceinline__ f32x4 mma32(const bf16x8 x, const bf16x8 y, const f32x4 c) { return __builtin_amdgcn_mfma_f32_16x16x32_bf16(x, y, c, 0, 0, 0); }
template <int N> __device__ __forceinline__ float dpp_shr0(float x) { return __builtin_bit_cast(float, __builtin_amdgcn_update_dpp(0, __builtin_bit_cast(int, x), 0x110 + N, 0xF, 0xF, true)); }
__device__ __forceinline__ float scan16(float x) { x += dpp_shr0<1>(x); x += dpp_shr0<2>(x); x += dpp_shr0<4>(x); x += dpp_shr0<8>(x); return x; }
__device__ __forceinline__ s4v trd(const LAS unsigned char* p) { return __builtin_amdgcn_ds_read_tr16_b64_v4i16((LAS s4v*)p); }
__device__ __forceinline__ void chunk_ops(const f32x4 (&r)[4], const f32x4 (&lw)[4], const f32x4 (&kp)[4], const f32x4 (&v)[4], const f32x4 (&a)[4], const f32x4 (&b)[4],
                                          LAS unsigned char* scr, GAS unsigned char* rec, int lane) {
    const int l15 = lane & 15, g = lane >> 4, tq = l15 >> 2, tp = l15 & 3;
    const f32x4 Z4 = (f32x4){0.f, 0.f, 0.f, 0.f};
    f32x4 Rt[4], pc[4]; bf16x8 Atf[2], Btf[2], Ktf[2], Rtf[2];
    {
        s4v Ah[4], Bq[4], Kq[4], Rq[4];
#pragma unroll
        for (int nt = 0; nt < 4; ++nt) {
            f32x4 cs, tot;
#pragma unroll
            for (int i = 0; i < 4; ++i) { cs[i] = scan16(lw[nt][i]); tot[i] = __shfl(cs[i], lane | 15); }
            f32x4 At, Bt, Kt, Bh, Kh;
#pragma unroll
            for (int i = 0; i < 4; ++i) { const float P = fexp(cs[i]), Pm1 = fexp(cs[i] - lw[nt][i]), iP = fexp(-cs[i]), PCP = fexp(tot[i] - cs[i]);
                pc[nt][i] = fexp(tot[i]); At[i] = a[nt][i] * Pm1; Bt[i] = b[nt][i] * iP; Kt[i] = kp[nt][i] * iP; Rt[nt][i] = r[nt][i] * P; Bh[i] = b[nt][i] * PCP; Kh[i] = kp[nt][i] * PCP; }
            Ah[nt] = pk4(At); Bq[nt] = pk4(Bt); Kq[nt] = pk4(Kt); Rq[nt] = pk4(Rt[nt]);
            LAS unsigned char* w = scr + l15 * XL_STR + (16 * nt + 4 * g) * 2;
            *(LAS s4v*)(w + 0 * XL_MAT) = Ah[nt]; *(LAS s4v*)(w + 1 * XL_MAT) = pk4(v[nt]); *(LAS s4v*)(w + 2 * XL_MAT) = pk4(Bh); *(LAS s4v*)(w + 3 * XL_MAT) = pk4(Kh);
        }
#pragma unroll
        for (int s = 0; s < 2; ++s) {
            Atf[s] = (bf16x8){Ah[2 * s].x, Ah[2 * s].y, Ah[2 * s].z, Ah[2 * s].w, Ah[2 * s + 1].x, Ah[2 * s + 1].y, Ah[2 * s + 1].z, Ah[2 * s + 1].w};
            Btf[s] = (bf16x8){Bq[2 * s].x, Bq[2 * s].y, Bq[2 * s].z, Bq[2 * s].w, Bq[2 * s + 1].x, Bq[2 * s + 1].y, Bq[2 * s + 1].z, Bq[2 * s + 1].w};
            Ktf[s] = (bf16x8){Kq[2 * s].x, Kq[2 * s].y, Kq[2 * s].z, Kq[2 * s].w, Kq[2 * s + 1].x, Kq[2 * s + 1].y, Kq[2 * s + 1].z, Kq[2 * s + 1].w};
            Rtf[s] = (bf16x8){Rq[2 * s].x, Rq[2 * s].y, Rq[2 * s].z, Rq[2 * s].w, Rq[2 * s + 1].x, Rq[2 * s + 1].y, Rq[2 * s + 1].z, Rq[2 * s + 1].w}; }
    }
    f32x4 LabR = Z4, LabT = Z4, LakT = Z4, LrbT = Z4, LrkT = Z4;
#pragma unroll
    for (int s = 0; s < 2; ++s) { LabR = mma32(Atf[s], Btf[s], LabR); LabT = mma32(Btf[s], Atf[s], LabT); LakT = mma32(Ktf[s], Atf[s], LakT); LrbT = mma32(Btf[s], Rtf[s], LrbT); LrkT = mma32(Ktf[s], Rtf[s], LrkT); }
    f32x4 IR;
#pragma unroll
    for (int i = 0; i < 4; ++i) { const int tt = 4 * g + i;
        IR[i] = (tt == l15) ? 1.f : 0.f;
        LabR[i] = (tt > l15) ? LabR[i] : 0.f; LabT[i] = (l15 > tt) ? LabT[i] : 0.f; LakT[i] = (l15 > tt) ? LakT[i] : 0.f;
        LrbT[i] = (l15 >= tt) ? LrbT[i] : 0.f; LrkT[i] = (l15 >= tt) ? LrkT[i] : 0.f; }
    const s4v L1R = pk4(LabR), L1T = pk4(LabT);
    const f32x4 L2R = mma16(L1T, L1R, Z4), L2T = mma16(L1R, L1T, Z4);
    const s4v L2Rp = pk4(L2R), L2Tp = pk4(L2T);
    const f32x4 L4R = mma16(L2Tp, L2Rp, Z4), L4T = mma16(L2Rp, L2Tp, Z4);
    const s4v L4Rp = pk4(L4R), L4Tp = pk4(L4T);
    const f32x4 L8R = mma16(L4Tp, L4Rp, Z4);
    const f32x4 T1T = mma16(pk4(IR + L2R), pk4(IR + LabT), Z4);
    const f32x4 T2T = mma16(pk4(IR + L4R), pk4(T1T), Z4);
    const s4v TmT = pk4(mma16(pk4(IR + L8R), pk4(T2T), Z4));
    const s4v LakTp = pk4(LakT), LrbTp = pk4(LrbT), LrkTp = pk4(LrkT);
    asm volatile("s_waitcnt lgkmcnt(0)" ::: "memory");
    const LAS unsigned char* tb = scr + (4 * g + tq) * XL_STR + (4 * tp) * 2;
    s4v tAt[4], tV[4], tBh[4], tKh[4];
#pragma unroll
    for (int t = 0; t < 4; ++t) { tAt[t] = trd(tb + 0 * XL_MAT + 32 * t); tV[t] = trd(tb + 1 * XL_MAT + 32 * t); tBh[t] = trd(tb + 2 * XL_MAT + 32 * t); tKh[t] = trd(tb + 3 * XL_MAT + 32 * t); }
    s4v Wp[4], U0p[4];
#pragma unroll
    for (int t = 0; t < 4; ++t) { Wp[t] = pk4(mma16(TmT, tAt[t], Z4));
        const f32x4 G = mma16(LakTp, tV[t], Z4);
        const f32x4 U0 = mma16(TmT, pk4(G), Z4); U0p[t] = pk4(U0);
        f32x4 Y0 = mma16(LrbTp, U0p[t], Z4); Y0 = mma16(LrkTp, tV[t], Y0);
        *(GAS s4v*)(rec + CU_QB + t * CU_QSTR + 2048 + lane * 8) = pk4(Y0); }
    {
        f32x4 Om[4];
#pragma unroll
        for (int ct = 0; ct < 4; ++ct) Om[ct] = mma16(Wp[ct], LrbTp, Rt[ct]);
        *(GAS bf16x8*)(rec + CU_OM + 0 * 1024 + lane * 16) = pk8v(Om[0], Om[1]); *(GAS bf16x8*)(rec + CU_OM + 1 * 1024 + lane * 16) = pk8v(Om[2], Om[3]);
    }
#pragma unroll
    for (int tl = 0; tl < 4; ++tl) {
        f32x4 Mt[4];
#pragma unroll
        for (int kt = 0; kt < 4; ++kt) { Mt[kt] = mma16(Wp[kt], tBh[tl], Z4);
            if (kt == tl) {
#pragma unroll
                for (int i = 0; i < 4; ++i) Mt[kt][i] += (4 * g + i == l15) ? pc[kt][i] : 0.f; } }
        *(GAS bf16x8*)(rec + CU_M + (tl * 2 + 0) * 1024 + lane * 16) = pk8v(Mt[0], Mt[1]); *(GAS bf16x8*)(rec + CU_M + (tl * 2 + 1) * 1024 + lane * 16) = pk8v(Mt[2], Mt[3]);
    }
#pragma unroll
    for (int q = 0; q < 4; ++q)
#pragma unroll
        for (int tl = 0; tl < 4; ++tl) { f32x4 Nt = mma16(tBh[tl], U0p[q], Z4); Nt = mma16(tKh[tl], tV[q], Nt);
            *(GAS s4v*)(rec + CU_QB + q * CU_QSTR + tl * 512 + lane * 8) = pk4(Nt); }
}
__device__ __forceinline__ void ph_prep(Frame& F, ArgP A, int l) {
    const int gw = F.vcu * NWAVES + F.wave, NGW = F.G * NWAVES, lane = F.lane, l15 = lane & 15, g = lane >> 4;
    {
        const int h = lane >> 3, i0 = 8 * (lane & 7);
        int nrr_ = (MK_REP & 1024) ? 2 : 1; asm volatile("" : "+s"(nrr_));
#pragma unroll 1
        for (int rr_ = 0; rr_ < nrr_; ++rr_)
        for (int m = gw; m < M; m += NGW) {
            const GAS bf16* zrow = (const GAS bf16*)(WSP(bf16, WS_Z) + (size_t)m * INW);
            const GAS f32x4* rp = (const GAS f32x4*)(WSP(float2, WS_ROPE) + (size_t)m * 64 + i0);
            const f32x4 c01 = rp[0], c23 = rp[1], c45 = rp[2], c67 = rp[3];
            const float cs[8] = {c01.x, c01.z, c23.x, c23.z, c45.x, c45.z, c67.x, c67.z}, sn[8] = {c01.y, c01.w, c23.y, c23.w, c45.y, c45.w, c67.y, c67.w};
            float q1[8], q2[8], k1[8], k2[8], o1[8], o2[8];
            unpack8(*(const GAS v4u*)(zrow + ZC_Q + h * RD + i0), q1); unpack8(*(const GAS v4u*)(zrow + ZC_Q + h * RD + 64 + i0), q2);
            unpack8(*(const GAS v4u*)(zrow + ZC_K + h * RD + i0), k1); unpack8(*(const GAS v4u*)(zrow + ZC_K + h * RD + 64 + i0), k2);
#pragma unroll
            for (int j = 0; j < 8; ++j) { o1[j] = q1[j] * cs[j] - q2[j] * sn[j]; o2[j] = q2[j] * cs[j] + q1[j] * sn[j]; }
            GAS bf16* qo = (GAS bf16*)(WSP(bf16, WS_QR) + (size_t)m * RETW + h * RD + i0);
            *(GAS bf16x8*)qo = pack8(o1); *(GAS bf16x8*)(qo + 64) = pack8(o2);
#pragma unroll
            for (int j = 0; j < 8; ++j) { const float a = k1[j] * 0.08838834764831845f, b = k2[j] * 0.08838834764831845f; o1[j] = a * cs[j] - b * sn[j]; o2[j] = b * cs[j] + a * sn[j]; }
            GAS bf16* ko = (GAS bf16*)(WSP(bf16, WS_KR) + (size_t)m * RETW + h * RD + i0);
            *(GAS bf16x8*)ko = pack8(o1); *(GAS bf16x8*)(ko + 64) = pack8(o2);
        }
    }
    const GAS float* mu = (const GAS float*)(INP(A, 6) + (size_t)l * RWSHIFT);
    const GAS float* w0 = (const GAS float*)(INP(A, 7) + (size_t)l * RWW); const GAS float* a0 = (const GAS float*)(INP(A, 9) + (size_t)l * RWW);
    const GAS float* kkw = (const GAS float*)(INP(A, 12) + (size_t)l * RWW); const GAS float* kaw = (const GAS float*)(INP(A, 13) + (size_t)l * RWW); const GAS float* rkw = (const GAS float*)(INP(A, 14) + (size_t)l * RWW);
    const GAS bf16* WupT = (const GAS bf16*)WSW(l, WO_LORA); const GAS bf16* AupT = WupT + 1024 * 64; const GAS bf16* GupT = AupT + 1024 * 64;
    constexpr int PP_OFF = 8 * 10240;
    LAS float* PP = (LAS float*)(F.lds + RING_OFF + PP_OFF);
    __syncthreads();
    for (int i = F.tid; i < 2048; i += NWAVES * 64) { const int arr = i >> 8, off = (i & 255) * 4;
        const GAS float* src = arr < 3 ? mu + arr * 1024 : (arr == 3 ? w0 : (arr == 4 ? a0 : (arr == 5 ? kkw : (arr == 6 ? kaw : rkw))));
        *(LAS f32x4*)(PP + arr * 1024 + off) = *(const GAS f32x4*)(src + off); }
    __syncthreads();
    int nrw_ = (MK_REP & 2048) ? 2 : 1; asm volatile("" : "+s"(nrw_));
#pragma unroll 1
    for (int rw_ = 0; rw_ < nrw_; ++rw_)
    for (int task = gw; task < M / 8; task += NGW) {
        const int m = (task >> 1) * 16 + l15, hh0 = (task & 1) * (WH / 2);
        const bool has_prev = (m % SEQ) != 0;
        const GAS bf16* zr = (const GAS bf16*)(WSP(bf16, WS_Z) + (size_t)m * INW + ZC_RW);
        bf16x8 fw[2], fa[2], fg[4];
#pragma unroll
        for (int ks = 0; ks < 2; ++ks) { float t[8];
            mix8(zr + RWC_W + 32 * ks + 8 * g, has_prev, mu + RWC_W + 32 * ks + 8 * g, t);
#pragma unroll
            for (int j = 0; j < 8; ++j) t[j] = ftanh(t[j]);
            fw[ks] = pack8(t);
            mix8(zr + RWC_A + 32 * ks + 8 * g, has_prev, mu + RWC_A + 32 * ks + 8 * g, t); fa[ks] = pack8(t); }
#pragma unroll
        for (int ks = 0; ks < 4; ++ks) { float t[8];
            mix8(zr + RWC_G + 32 * ks + 8 * g, has_prev, mu + RWC_G + 32 * ks + 8 * g, t);
#pragma unroll
            for (int j = 0; j < 8; ++j) t[j] = fsig(t[j]);
            fg[ks] = pack8(t); }
        const GAS bf16* zq = has_prev ? zr - INW : zr;
        for (int hh = hh0; hh < hh0 + WH / 2; ++hh) {
            f32x4 kkr[4], av[4], rr[4], lwv[4], kpv[4], vv[4]; float ss = 0.f, bonus = 0.f;
            const int cb = hh * WD + 4 * g;
            {
                v2u zc[3][4], zp[3][4];
#pragma unroll
                for (int a3 = 0; a3 < 3; ++a3)
#pragma unroll
                    for (int nt = 0; nt < 4; ++nt) { zc[a3][nt] = *(const GAS v2u*)(zr + a3 * 1024 + cb + 16 * nt); zp[a3][nt] = *(const GAS v2u*)(zq + a3 * 1024 + cb + 16 * nt); }
#pragma unroll
                for (int nt = 0; nt < 4; ++nt) {
#pragma unroll
                    for (int a3 = 0; a3 < 3; ++a3) { const f32x4 z = unpk4(zc[a3][nt]); f32x4 p = unpk4(zp[a3][nt]); if (!has_prev) p = (f32x4){0.f, 0.f, 0.f, 0.f};
                        const f32x4 mx = z + *(const LAS f32x4*)(PP + a3 * 1024 + cb + 16 * nt) * (p - z);
                        if (a3 == 0) rr[nt] = mx; else if (a3 == 1) kpv[nt] = mx; else vv[nt] = mx; }
                }
            }
            bf16x8 wf[2][2], af[2][2], gf[2][4];
#define PREP_WFRAGS(nt_, k_) do { const int cf_ = hh * WD + (nt_) * 16 + l15; \
            _Pragma("unroll") for (int ks = 0; ks < 2; ++ks) { wf[k_][ks] = *(const GAS bf16x8*)(WupT + (size_t)cf_ * 64 + 32 * ks + 8 * g); af[k_][ks] = *(const GAS bf16x8*)(AupT + (size_t)cf_ * 64 + 32 * ks + 8 * g); } \
            _Pragma("unroll") for (int ks = 0; ks < 4; ++ks) gf[k_][ks] = *(const GAS bf16x8*)(GupT + (size_t)cf_ * 128 + 32 * ks + 8 * g); } while (0)
            PREP_WFRAGS(0, 0);
#pragma unroll
            for (int nt = 0; nt < 4; ++nt) {
                const int c0 = cb + 16 * nt, cs_ = nt & 1;
                if (nt + 1 < 4) PREP_WFRAGS(nt + 1, (cs_ ^ 1));
                f32x4 wl = *(const LAS f32x4*)(PP + 3 * 1024 + c0), al = *(const LAS f32x4*)(PP + 4 * 1024 + c0), gl = (f32x4){0.f, 0.f, 0.f, 0.f};
#pragma unroll
                for (int ks = 0; ks < 2; ++ks) { wl = __builtin_amdgcn_mfma_f32_16x16x32_bf16(wf[cs_][ks], fw[ks], wl, 0, 0, 0); al = __builtin_amdgcn_mfma_f32_16x16x32_bf16(af[cs_][ks], fa[ks], al, 0, 0, 0); }
#pragma unroll
                for (int ks = 0; ks < 4; ++ks) gl = __builtin_amdgcn_mfma_f32_16x16x32_bf16(gf[cs_][ks], fg[ks], gl, 0, 0, 0);
                const f32x4 r = rr[nt], k = kpv[nt], v = vv[nt];
                const f32x4 kk4 = *(const LAS f32x4*)(PP + 5 * 1024 + c0), ka4 = *(const LAS f32x4*)(PP + 6 * 1024 + c0), rk4 = *(const LAS f32x4*)(PP + 7 * 1024 + c0);
                f32x4 lwd, a, kp;
#pragma unroll
                for (int i = 0; i < 4; ++i) {
                    lwd[i] = -0.6065306597126334f * fsig(wl[i]);
                    a[i] = fsig(al[i]);
                    kp[i] = k[i] * (1.0f + (a[i] - 1.0f) * ka4[i]);
                }
                kkr[nt] = k * kk4; av[nt] = a; lwv[nt] = lwd; kpv[nt] = kp;
                ss += (kkr[nt].x * kkr[nt].x + kkr[nt].y * kkr[nt].y) + (kkr[nt].z * kkr[nt].z + kkr[nt].w * kkr[nt].w);
                const f32x4 rb = r * kp * rk4; bonus += (rb.x + rb.y) + (rb.z + rb.w);
                const size_t o = (size_t)m * RWW + c0;
#if MK_CHUNKED
                *(GAS s4v*)(WSP(bf16, WS_SV) + o) = pk4(v); *(GAS s4v*)(WSP(bf16, WS_G) + o) = pk4(gl);
#else
                f32x4 decay;
#pragma unroll
                for (int i = 0; i < 4; ++i) decay[i] = fexp(lwd[i]);
                *(GAS f32x4*)(WSP(float, WS_SR) + o) = r; *(GAS f32x4*)(WSP(float, WS_SW) + o) = decay; *(GAS f32x4*)(WSP(float, WS_SK) + o) = kp;
                *(GAS f32x4*)(WSP(float, WS_SV) + o) = v; *(GAS f32x4*)(WSP(float, WS_G) + o) = gl;
#endif
            }
#undef PREP_WFRAGS
            ss += __shfl_xor(ss, 16); ss += __shfl_xor(ss, 32); bonus += __shfl_xor(bonus, 16); bonus += __shfl_xor(bonus, 32);
            const float inv = 1.0f / fmaxf(sqrtf(ss), 1e-12f);
            if (g == 0) WSP(float, WS_BONUS)[(size_t)m * WH + hh] = bonus;
#if MK_CHUNKED
            f32x4 aa[4], bb[4];
#pragma unroll
            for (int nt = 0; nt < 4; ++nt) { const f32x4 kk = kkr[nt] * inv; aa[nt] = -kk; bb[nt] = kk * av[nt]; }
            const int tile = task >> 1;
            GAS unsigned char* rec = (GAS unsigned char*)WSP(unsigned char, WS_CU) + ((size_t)((tile / NCHUNK) * WH + hh) * NCHUNK + (tile % NCHUNK)) * CU_BYTES;
            chunk_ops(rr, lwv, kpv, vv, aa, bb, F.lds + RING_OFF + F.wave * 10240, rec, lane);
#else
#pragma unroll
            for (int nt = 0; nt < 4; ++nt) { const size_t o = (size_t)m * RWW + hh * WD + nt * 16 + 4 * g; const f32x4 kk = kkr[nt] * inv;
                *(GAS f32x4*)(WSP(float, WS_SNKK) + o) = -kk; *(GAS f32x4*)(WSP(float, WS_SKKA) + o) = kk * av[nt]; }
#endif
        }
    }
}
#if (MK_GLOBAL_GROUPS & 2)
#pragma pop_macro("WSP")
#pragma pop_macro("WSW")
#pragma pop_macro("OUTP")
#endif
#if (MK_GLOBAL_GROUPS & 4)
#pragma push_macro("WSP")
#pragma push_macro("WSW")
#pragma push_macro("OUTP")
#undef WSP
#undef WSW
#undef OUTP
#define WSP WSPG
#define WSW WSWG
#define OUTP OUTPG
#endif
#if !MK_CHUNKED
__device__ __forceinline__ void scan_rwkv_naive(Frame& F, int item) {
    const int lane = F.lane;
    float st[64];
#pragma unroll
    for (int j = 0; j < 64; ++j) st[j] = 0.f;
    const size_t base0 = (size_t)(item >> 4) * SEQ * RWW + (size_t)(item & 15) * WD + lane;
    for (int t = 0; t < SEQ; ++t) {
        const size_t o = base0 + (size_t)t * RWW;
        const float r = WSP(float, WS_SR)[o], w = WSP(float, WS_SW)[o], k = WSP(float, WS_SK)[o], v = WSP(float, WS_SV)[o], nk = WSP(float, WS_SNKK)[o], ka = WSP(float, WS_SKKA)[o];
        float sa = 0.f;
#pragma unroll
        for (int j = 0; j < 64; ++j) sa += st[j] * rdlane(nk, j);
        float y = 0.f;
#pragma unroll
        for (int j = 0; j < 64; ++j) { st[j] = st[j] * rdlane(w, j) + sa * rdlane(ka, j) + v * rdlane(k, j); y += st[j] * rdlane(r, j); }
        WSP(float, WS_YRAWW)[o] = y;
    }
}
#endif
__device__ __forceinline__ void scan_ret_naive(Frame& F, int item) {
    const int lane = F.lane, b = item >> 4, h = (item >> 1) & 7, half = item & 1;
    const float gam = 1.0f - exp2f((float)(-5 - h));
    float R[128];
#pragma unroll
    for (int j = 0; j < 128; ++j) R[j] = 0.f;
    for (int t = 0; t < SEQ; ++t) {
        const size_t m = (size_t)b * SEQ + t;
        const float q1 = bf2f(WSP(bf16, WS_QR)[m * RETW + h * RD + lane]), q2 = bf2f(WSP(bf16, WS_QR)[m * RETW + h * RD + 64 + lane]);
        const float k1 = bf2f(WSP(bf16, WS_KR)[m * RETW + h * RD + lane]), k2 = bf2f(WSP(bf16, WS_KR)[m * RETW + h * RD + 64 + lane]);
        const float v = bf2f(WSP(bf16, WS_Z)[m * INW + ZC_V + h * RD + half * 64 + lane]);
        float y = 0.f;
#pragma unroll
        for (int d = 0; d < 64; ++d) { R[d] = gam * R[d] + rdlane(k1, d) * v; y += rdlane(q1, d) * R[d]; }
#pragma unroll
        for (int d = 0; d < 64; ++d) { R[64 + d] = gam * R[64 + d] + rdlane(k2, d) * v; y += rdlane(q2, d) * R[64 + d]; }
        WSP(float, WS_YRAWR)[m * RETW + h * RD + half * 64 + lane] = y;
    }
}
#if !MK_CHUNKED
constexpr int SCT = 32;
constexpr int SC_ARR = SCT * 64 * 4;
constexpr int SC_BUF = 5 * SC_ARR + SCT * 16 * 4;
static_assert(2 * SC_BUF <= RING_BYTES, "scan LDS");
template <int CTRL> __device__ __forceinline__ float dppf(float x) { return __builtin_bit_cast(float, __builtin_amdgcn_update_dpp(0, __builtin_bit_cast(int, x), CTRL, 0xF, 0xF, true)); }
__device__ __forceinline__ float sum16(float x) {
    x += dppf<0xB1>(x); x += dppf<0x4E>(x); x += dppf<0x141>(x); x += dppf<0x140>(x); return x;
}
__device__ __forceinline__ void scan_rwkv_fast(Frame& F, int w) {
    const int b = w >> 6, hh = (w >> 2) & 15, q = w & 3;
    const int lane = F.lane, wave = F.wave;
    LAS unsigned char* base = F.lds + RING_OFF;
    const size_t g0 = (size_t)b * SEQ * RWW + (size_t)hh * WD;
    constexpr int NBLK = SEQ / SCT;
#define SC_BAR() do { asm volatile("s_waitcnt lgkmcnt(0)" ::: "memory"); __builtin_amdgcn_s_barrier(); asm volatile("" ::: "memory"); } while (0)
    if (wave >= 4) {
        const int lt = F.tid - 256;
        const float* a0 = WSP(float, WS_SR) + g0; const float* a1 = WSP(float, WS_SW) + g0; const float* a2 = WSP(float, WS_SK) + g0;
        const float* a3 = WSP(float, WS_SNKK) + g0; const float* a4 = WSP(float, WS_SKKA) + g0; const float* av = WSP(float, WS_SV) + g0 + 16 * q;
        const int f0 = lt, f1 = lt + 256;
        const size_t o0 = (size_t)(f0 >> 4) * RWW + 4 * (f0 & 15), o1 = (size_t)(f1 >> 4) * RWW + 4 * (f1 & 15), ov = (size_t)(lt >> 2) * RWW + 4 * (lt & 3);
        f32x4 r0[5], r1[5], rv;
#define SC_LOAD(blk) do { const size_t tb = (size_t)(blk) * SCT * RWW; \
        r0[0] = *(const GAS f32x4*)(a0 + tb + o0); r1[0] = *(const GAS f32x4*)(a0 + tb + o1); r0[1] = *(const GAS f32x4*)(a1 + tb + o0); r1[1] = *(const GAS f32x4*)(a1 + tb + o1); \
        r0[2] = *(const GAS f32x4*)(a2 + tb + o0); r1[2] = *(const GAS f32x4*)(a2 + tb + o1); r0[3] = *(const GAS f32x4*)(a3 + tb + o0); r1[3] = *(const GAS f32x4*)(a3 + tb + o1); \
        r0[4] = *(const GAS f32x4*)(a4 + tb + o0); r1[4] = *(const GAS f32x4*)(a4 + tb + o1); if (lt < 128) rv = *(const GAS f32x4*)(av + tb + ov); } while (0)
#define SC_STORE(bi) do { LAS unsigned char* bb = base + (bi) * SC_BUF; \
        _Pragma("unroll") for (int a = 0; a < 5; ++a) { *(LAS f32x4*)(bb + a * SC_ARR + f0 * 16) = r0[a]; *(LAS f32x4*)(bb + a * SC_ARR + f1 * 16) = r1[a]; } \
        if (lt < 128) *(LAS f32x4*)(bb + 5 * SC_ARR + lt * 16) = rv; } while (0)
        SC_LOAD(0); SC_STORE(0);
        if (1 < NBLK) SC_LOAD(1);
        SC_BAR();
        for (int blk = 0; blk < NBLK; ++blk) {
            if (blk + 1 < NBLK) { SC_STORE((blk + 1) & 1); if (blk + 2 < NBLK) SC_LOAD(blk + 2); }
            SC_BAR();
        }
#undef SC_LOAD
#undef SC_STORE
    } else {
        const int l16 = lane & 15, rowl = 4 * wave + (lane >> 4);
        GAS float* Y = (GAS float*)(WSP(float, WS_YRAWW) + g0 + 16 * q + rowl);
        f32x4 st = (f32x4){0.f, 0.f, 0.f, 0.f};
        const int lo = l16 * 16, vo = 5 * SC_ARR + rowl * 4;
#define SC_LD(tt_, R4, W4, K4, N4, A4, V) do { R4 = *(const LAS f32x4*)(bb + 0 * SC_ARR + (tt_) * 256 + lo); W4 = *(const LAS f32x4*)(bb + 1 * SC_ARR + (tt_) * 256 + lo); \
        K4 = *(const LAS f32x4*)(bb + 2 * SC_ARR + (tt_) * 256 + lo); N4 = *(const LAS f32x4*)(bb + 3 * SC_ARR + (tt_) * 256 + lo); A4 = *(const LAS f32x4*)(bb + 4 * SC_ARR + (tt_) * 256 + lo); \
        V = *(const LAS float*)(bb + vo + (tt_) * 64); } while (0)
        SC_BAR();
        for (int blk = 0; blk < NBLK; ++blk) {
            const LAS unsigned char* bb = base + (blk & 1) * SC_BUF;
            GAS float* yb = Y + (size_t)blk * SCT * RWW;
            f32x4 r4[3], w4[3], k4[3], n4[3], a4[3]; float v[3];
            SC_LD(0, r4[0], w4[0], k4[0], n4[0], a4[0], v[0]);
            SC_LD(1, r4[1], w4[1], k4[1], n4[1], a4[1], v[1]);
#pragma unroll
            for (int tt = 0; tt < SCT; ++tt) {
                const int c = tt % 3, p = (tt + 2) % 3;
                if (tt + 2 < SCT) SC_LD(tt + 2, r4[p], w4[p], k4[p], n4[p], a4[p], v[p]);
                f32x2 sp2 = (f32x2){st.x, st.y} * (f32x2){n4[c].x, n4[c].y}; sp2 = (f32x2){st.z, st.w} * (f32x2){n4[c].z, n4[c].w} + sp2;
                const f32x4 t0 = st * w4[c] + k4[c] * v[c];
                const float sa = sum16(sp2.x + sp2.y);
                st = a4[c] * sa + t0;
                f32x2 yp2 = (f32x2){st.x, st.y} * (f32x2){r4[c].x, r4[c].y}; yp2 = (f32x2){st.z, st.w} * (f32x2){r4[c].z, r4[c].w} + yp2;
                const float y = sum16(yp2.x + yp2.y);
                yb[(size_t)tt * RWW] = y;
            }
            SC_BAR();
        }
#undef SC_LD
#undef SC_BAR
    }
}
#endif
constexpr int CB_STEPS = 4, CB_STEP_BYTES = 8192 + 2048 + 2048 + 512, CB_BUF = CB_STEPS * CB_STEP_BYTES, CB_PIECES = CB_BUF / 16, CB_NBLK = NCHUNK / CB_STEPS;
static_assert(2 * CB_BUF <= RING_BYTES, "chunk scan LDS");
#ifndef MK_X2_DIRECT
#define MK_X2_DIRECT 0
#endif
__device__ __forceinline__ void scan_rwkv_chunk(Frame& F, int w) {
    const int bh = w >> 2, q = w & 3, lane = F.lane, wave = F.wave;
#if MK_X2_DIRECT
    if (wave == 0) {
        const int l15 = lane & 15, g = lane >> 4;
        const f32x4 Z4 = (f32x4){0.f, 0.f, 0.f, 0.f};
        f32x4 acc[4] = {Z4, Z4, Z4, Z4};
        const GAS unsigned char* rec = (const GAS unsigned char*)WSP(unsigned char, WS_CU) + (size_t)bh * NCHUNK * CU_BYTES;
        GAS float* Y = (GAS float*)(WSP(float, WS_YRAWW) + (size_t)(bh >> 4) * SEQ * RWW + (size_t)(bh & 15) * WD + 16 * q + l15 + (size_t)(4 * g) * RWW);
        for (int n = 0; n < NCHUNK; ++n, rec += CU_BYTES) {
            const bf16x8 sf0 = pk8v(acc[0], acc[1]), sf1 = pk8v(acc[2], acc[3]);
            f32x4 ya = unpk4(*(const GAS v2u*)(rec + CU_QB + q * CU_QSTR + 2048 + lane * 8));
            ya = mma32(*(const GAS bf16x8*)(rec + CU_OM + lane * 16), sf0, ya); ya = mma32(*(const GAS bf16x8*)(rec + CU_OM + 1024 + lane * 16), sf1, ya);
            GAS float* yp = Y + (size_t)(n * CK) * RWW;
#pragma unroll
            for (int i = 0; i < 4; ++i) yp[(size_t)i * RWW] = ya[i];
#pragma unroll
            for (int tl = 0; tl < 4; ++tl) { f32x4 na = unpk4(*(const GAS v2u*)(rec + CU_QB + q * CU_QSTR + tl * 512 + lane * 8));
                na = mma32(*(const GAS bf16x8*)(rec + CU_M + (tl * 2 + 0) * 1024 + lane * 16), sf0, na); na = mma32(*(const GAS bf16x8*)(rec + CU_M + (tl * 2 + 1) * 1024 + lane * 16), sf1, na);
                acc[tl] = na; }
        }
    }
    return;
#endif
    LAS unsigned char* base = F.lds + RING_OFF;
    const GAS unsigned char* rec0 = (const GAS unsigned char*)WSP(unsigned char, WS_CU) + (size_t)bh * NCHUNK * CU_BYTES;
#define CB_BAR() do { asm volatile("s_waitcnt lgkmcnt(0)" ::: "memory"); __builtin_amdgcn_s_barrier(); asm volatile("" ::: "memory"); } while (0)
    if (wave >= 1) {
        const int lt = F.tid - 64;
#if MK_X2_NT
#define CB_LD(p_) __builtin_nontemporal_load((const GAS v4u*)(p_))
#else
#define CB_LD(p_) (*(const GAS v4u*)(p_))
#endif
        v4u ra[8], rb[8], rc[8], rd[8];
        const int ltc = lt < 400 ? lt : 399;
        int so[8];
#pragma unroll
        for (int j = 0; j < 8; ++j) { const int p = ltc + 400 * j, st = p / 800, off = p % 800; so[j] = st * CU_BYTES + off * 16 + (off >= 640 ? q * CU_QSTR : 0); }
#define CB_LOAD(rg, blk) do { const int bc_ = (blk) < CB_NBLK ? (blk) : CB_NBLK - 1; const GAS unsigned char* bp = rec0 + (size_t)bc_ * CB_STEPS * CU_BYTES; \
            _Pragma("unroll") for (int j = 0; j < 8; ++j) rg[j] = CB_LD(bp + so[j]); } while (0)
#define CB_STORE(rg, bi) do { LAS unsigned char* dp = base + (bi) * CB_BUF + ltc * 16; \
            _Pragma("unroll") for (int j = 0; j < 8; ++j) *(LAS v4u*)(dp + j * 400 * 16) = rg[j]; } while (0)
        static_assert(CB_NBLK % 4 == 0 && CB_NBLK >= 8, "block quads");
        CB_LOAD(ra, 0); CB_STORE(ra, 0); CB_LOAD(rb, 1); CB_LOAD(rc, 2); CB_LOAD(rd, 3);
        CB_BAR();
        for (int blk = 0; blk < CB_NBLK; blk += 4) {
            CB_STORE(rb, 1); CB_LOAD(ra, blk + 4); CB_BAR();
            CB_STORE(rc, 0); CB_LOAD(rb, blk + 5); CB_BAR();
            CB_STORE(rd, 1); CB_LOAD(rc, blk + 6); CB_BAR();
            CB_STORE(ra, 0); CB_LOAD(rd, blk + 7); CB_BAR();
        }
#undef CB_LOAD
#undef CB_STORE
    } else {
        const int l15 = lane & 15, g = lane >> 4;
        const f32x4 Z4 = (f32x4){0.f, 0.f, 0.f, 0.f};
        f32x4 acc[4] = {Z4, Z4, Z4, Z4};
        GAS float* Y = (GAS float*)(WSP(float, WS_YRAWW) + (size_t)(bh >> 4) * SEQ * RWW + (size_t)(bh & 15) * WD + 16 * q + l15 + (size_t)(4 * g) * RWW);
        CB_BAR();
        bf16x8 Mf[2][8], Of[2][2]; v2u Nt[2][4], Yt[2];
#define CB_FRAGS(sb_, k_) do { _Pragma("unroll") for (int j = 0; j < 8; ++j) Mf[k_][j] = *(const LAS bf16x8*)((sb_) + j * 1024 + lane * 16); \
        _Pragma("unroll") for (int j = 0; j < 4; ++j) Nt[k_][j] = *(const LAS v2u*)((sb_) + 10240 + j * 512 + lane * 8); \
        Of[k_][0] = *(const LAS bf16x8*)((sb_) + 8192 + lane * 16); Of[k_][1] = *(const LAS bf16x8*)((sb_) + 9216 + lane * 16); Yt[k_] = *(const LAS v2u*)((sb_) + 12288 + lane * 8); } while (0)
        for (int blk = 0; blk < CB_NBLK; ++blk) {
            const LAS unsigned char* bb = base + (blk & 1) * CB_BUF;
            CB_FRAGS(bb, 0);
#pragma unroll
            for (int st = 0; st < CB_STEPS; ++st) {
                const int c = st & 1;
                if (st + 1 < CB_STEPS) CB_FRAGS(bb + (st + 1) * CB_STEP_BYTES, (c ^ 1));
                const bf16x8 sf0 = pk8v(acc[0], acc[1]), sf1 = pk8v(acc[2], acc[3]);
                f32x4 ya = unpk4(Yt[c]);
                ya = mma32(Of[c][0], sf0, ya); ya = mma32(Of[c][1], sf1, ya);
                GAS float* yp = Y + (size_t)((blk * CB_STEPS + st) * CK) * RWW;
#pragma unroll
                for (int i = 0; i < 4; ++i) yp[(size_t)i * RWW] = ya[i];
                f32x4 na[4];
#pragma unroll
                for (int tl = 0; tl < 4; ++tl) na[tl] = mma32(Mf[c][tl * 2 + 0], sf0, unpk4(Nt[c][tl]));
#pragma unroll
                for (int tl = 0; tl < 4; ++tl) acc[tl] = mma32(Mf[c][tl * 2 + 1], sf1, na[tl]);
            }
            CB_BAR();
        }
#undef CB_FRAGS
    }
#undef CB_BAR
}
constexpr int RT_STR = 288, RT_QS = 0, RT_KS = 128 * RT_STR, RT_VSTR = 80, RT_VS = 2 * 128 * RT_STR, RT_VPS = RT_VS + 128 * RT_VSTR, RT_RT = RT_VPS + 128 * RT_VSTR, RT_RTSZ = 32 * RT_STR;
static_assert(RT_RT + 2 * RT_RTSZ <= RING_BYTES, "retention LDS");
__device__ __forceinline__ bf16x8 tr8(const LAS unsigned char* p0, const LAS unsigned char* p1) {
    const s4v a = __builtin_amdgcn_ds_read_tr16_b64_v4i16((LAS s4v*)p0), b = __builtin_amdgcn_ds_read_tr16_b64_v4i16((LAS s4v*)p1);
    return (bf16x8){a.x, a.y, a.z, a.w, b.x, b.y, b.z, b.w};
}
__device__ __forceinline__ void scan_ret_mfma(Frame& F, int w_) {
    const int b = w_ >> 5, h = (w_ >> 2) & 7, eq = w_ & 3;
    const int tid = F.tid, lane = F.lane, w = F.wave, l15 = lane & 15, g = lane >> 4, tq = l15 >> 2, tp = l15 & 3;
    LAS unsigned char* L = F.lds + RING_OFF;
    const float lg2 = log1pf(-exp2f((float)(-5 - h))) * 1.4426950408889634f;
    const float gC = __builtin_amdgcn_exp2f(lg2 * 128.f);
    for (int i = tid; i < RT_RTSZ / 4; i += NWAVES * 64) ((LAS unsigned*)(L + RT_RT))[i] = 0u;
    const GAS bf16* Qg = (const GAS bf16*)(WSP(bf16, WS_QR) + (size_t)b * SEQ * RETW + h * RD);
    const GAS bf16* Kg = (const GAS bf16*)(WSP(bf16, WS_KR) + (size_t)b * SEQ * RETW + h * RD);
    const GAS bf16* Vg = (const GAS bf16*)(WSP(bf16, WS_Z) + (size_t)b * SEQ * INW + ZC_V + h * RD + 32 * eq);
    GAS float* Yg = (GAS float*)(WSP(float, WS_YRAWR) + (size_t)b * SEQ * RETW + h * RD + 32 * eq);
    v4u rq[4], rk[4], rv;
#define RT_BAR() do { asm volatile("s_waitcnt lgkmcnt(0)" ::: "memory"); __builtin_amdgcn_s_barrier(); asm volatile("" ::: "memory"); } while (0)
#define RT_LOAD(n_) do { _Pragma("unroll") for (int i = 0; i < 4; ++i) { const int f = tid + 512 * i, c = f >> 4, pc = f & 15; \
        rq[i] = *(const GAS v4u*)(Qg + (size_t)((n_) * 128 + c) * RETW + 8 * pc); rk[i] = *(const GAS v4u*)(Kg + (size_t)((n_) * 128 + c) * RETW + 8 * pc); } \
        rv = *(const GAS v4u*)(Vg + (size_t)((n_) * 128 + (tid >> 2)) * INW + 8 * (tid & 3)); } while (0)
    f32x4 accR[2] = {(f32x4){0.f, 0.f, 0.f, 0.f}, (f32x4){0.f, 0.f, 0.f, 0.f}};
    RT_LOAD(0);
    for (int n = 0; n < SEQ / 128; ++n) {
#pragma unroll
        for (int i = 0; i < 4; ++i) { const int f = tid + 512 * i, c = f >> 4, pc = f & 15;
            *(LAS v4u*)(L + RT_QS + c * RT_STR + pc * 16) = rq[i]; *(LAS v4u*)(L + RT_KS + c * RT_STR + pc * 16) = rk[i]; }
        { const int c = tid >> 2, pc = tid & 3; *(LAS v4u*)(L + RT_VS + c * RT_VSTR + pc * 16) = rv;
          const float sc = __builtin_amdgcn_exp2f(lg2 * (float)(127 - c)); v4u o;
          o.x = pg8::cvt_pk_bf16(pg8::bf_lo(rv.x) * sc, pg8::bf_hi(rv.x) * sc); o.y = pg8::cvt_pk_bf16(pg8::bf_lo(rv.y) * sc, pg8::bf_hi(rv.y) * sc);
          o.z = pg8::cvt_pk_bf16(pg8::bf_lo(rv.z) * sc, pg8::bf_hi(rv.z) * sc); o.w = pg8::cvt_pk_bf16(pg8::bf_lo(rv.w) * sc, pg8::bf_hi(rv.w) * sc);
          *(LAS v4u*)(L + RT_VPS + c * RT_VSTR + pc * 16) = o; }
        RT_BAR();
        if (n + 1 < SEQ / 128) RT_LOAD(n + 1);
        bf16x8 qf[4];
#pragma unroll
        for (int ks = 0; ks < 4; ++ks) qf[ks] = *(const LAS bf16x8*)(L + RT_QS + (16 * w + l15) * RT_STR + (32 * ks + 8 * g) * 2);
        bf16x8 pf[4];
        const int cq = 16 * w + l15;
#pragma unroll
        for (int p = 0; p < 4; ++p) {
            f32x4 s0 = (f32x4){0.f, 0.f, 0.f, 0.f}, s1 = (f32x4){0.f, 0.f, 0.f, 0.f};
            if (2 * p <= w) {
#pragma unroll
                for (int ks = 0; ks < 4; ++ks) { const bf16x8 kf = *(const LAS bf16x8*)(L + RT_KS + (32 * p + l15) * RT_STR + (32 * ks + 8 * g) * 2);
                    s0 = __builtin_amdgcn_mfma_f32_16x16x32_bf16(kf, qf[ks], s0, 0, 0, 0); }
            }
            if (2 * p + 1 <= w) {
#pragma unroll
                for (int ks = 0; ks < 4; ++ks) { const bf16x8 kf = *(const LAS bf16x8*)(L + RT_KS + (32 * p + 16 + l15) * RT_STR + (32 * ks + 8 * g) * 2);
                    s1 = __builtin_amdgcn_mfma_f32_16x16x32_bf16(kf, qf[ks], s1, 0, 0, 0); }
            }
            float p0[4], p1[4];
#pragma unroll
            for (int i = 0; i < 4; ++i) { const int d0 = cq - (32 * p + 4 * g + i), d1 = d0 - 16;
                p0[i] = d0 >= 0 ? s0[i] * __builtin_amdgcn_exp2f(lg2 * (float)d0) : 0.f; p1[i] = d1 >= 0 ? s1[i] * __builtin_amdgcn_exp2f(lg2 * (float)d1) : 0.f; }
            v4u pk; pk.x = pg8::cvt_pk_bf16(p0[0], p0[1]); pk.y = pg8::cvt_pk_bf16(p0[2], p0[3]); pk.z = pg8::cvt_pk_bf16(p1[0], p1[1]); pk.w = pg8::cvt_pk_bf16(p1[2], p1[3]);
            pf[p] = __builtin_bit_cast(bf16x8, pk);
        }
        const LAS unsigned char* Rcur = L + RT_RT + (n & 1) * RT_RTSZ;
#pragma unroll
        for (int et = 0; et < 2; ++et) {
            f32x4 acc = (f32x4){0.f, 0.f, 0.f, 0.f};
#pragma unroll
            for (int ks = 0; ks < 4; ++ks) { const bf16x8 rf = *(const LAS bf16x8*)(Rcur + (16 * et + l15) * RT_STR + (32 * ks + 8 * g) * 2);
                acc = __builtin_amdgcn_mfma_f32_16x16x32_bf16(qf[ks], rf, acc, 0, 0, 0); }
#pragma unroll
            for (int i = 0; i < 4; ++i) acc[i] *= __builtin_amdgcn_exp2f(lg2 * (float)(16 * w + 4 * g + i + 1));
#pragma unroll
            for (int p = 0; p < 4; ++p) if (2 * p <= w) {
                const LAS unsigned char* vb = L + RT_VS + (32 * p + 4 * g + tq) * RT_VSTR + (16 * et + 4 * tp) * 2;
                const bf16x8 vf = tr8(vb, vb + 16 * RT_VSTR);
                acc = __builtin_amdgcn_mfma_f32_16x16x32_bf16(pf[p], vf, acc, 0, 0, 0); }
#pragma unroll
            for (int i = 0; i < 4; ++i) Yg[(size_t)(n * 128 + 16 * w + 4 * g + i) * RETW + 16 * et + l15] = acc[i];
        }
        LAS unsigned char* Rnxt = L + RT_RT + ((n + 1) & 1) * RT_RTSZ;
        accR[0] = accR[0] * gC; accR[1] = accR[1] * gC;
#pragma unroll
        for (int cs = 0; cs < 4; ++cs) {
            const LAS unsigned char* kb = L + RT_KS + (32 * cs + 8 * g + tq) * RT_STR + (16 * w + 4 * tp) * 2;
            const bf16x8 kt = tr8(kb, kb + 4 * RT_STR);
#pragma unroll
            for (int et = 0; et < 2; ++et) { const LAS unsigned char* vb = L + RT_VPS + (32 * cs + 8 * g + tq) * RT_VSTR + (16 * et + 4 * tp) * 2;
                const bf16x8 vt = tr8(vb, vb + 4 * RT_VSTR);
                accR[et] = __builtin_amdgcn_mfma_f32_16x16x32_bf16(kt, vt, accR[et], 0, 0, 0); }
        }
#pragma unroll
        for (int et = 0; et < 2; ++et) { v2u o; o.x = pg8::cvt_pk_bf16(accR[et][0], accR[et][1]); o.y = pg8::cvt_pk_bf16(accR[et][2], accR[et][3]);
            *(LAS v2u*)(Rnxt + (16 * et + l15) * RT_STR + (16 * w + 4 * g) * 2) = o; }
        RT_BAR();
    }
#undef RT_LOAD
#undef RT_BAR
}
__device__ __forceinline__ void ph_scan(Frame& F, ArgP A, int l) {
#if MK_CHUNKED
    if (F.G == 256) {
        const int it = F.vcu, r = it & 3, idx = it >> 2;
        if (r == 0 || r == 2) { const int w = idx * 2 + (r >> 1); int n_ = (MK_REP & 32) ? 2 : 1; asm volatile("" : "+s"(n_));
#pragma unroll 1
            for (int k_ = 0; k_ < n_; ++k_) { scan_rwkv_chunk(F, w); __syncthreads(); } }
        else if (r == 1) { int n_ = (MK_REP & 64) ? 2 : 1; asm volatile("" : "+s"(n_));
#pragma unroll 1
            for (int k_ = 0; k_ < n_; ++k_) { scan_ret_mfma(F, idx); __syncthreads(); } }
        else if (l + 1 < DEPTH) { ph_convert(F, A, l + 1, idx, 64); }
        __syncthreads();
    }
#else
    if (F.G >= 256) {
        if (F.vcu >= 192) { if (l + 1 < DEPTH) ph_convert(F, A, l + 1, F.vcu - 192, F.G - 192); return; }
        if (F.vcu < 128) { scan_rwkv_fast(F, F.vcu); if (MK_REP & 32) { __syncthreads(); scan_rwkv_fast(F, F.vcu); } }
        else if (F.vcu < 192) { scan_ret_mfma(F, F.vcu - 128); if (MK_REP & 64) { __syncthreads(); scan_ret_mfma(F, F.vcu - 128); } }
    } else {
        if (l + 1 < DEPTH) ph_convert(F, A, l + 1, F.vcu, F.G);
        const int gw = F.vcu * NWAVES + F.wave, NGW = F.G * NWAVES;
        const int stride = NGW >= 64 ? NGW / 64 : 1;
        if (gw % stride == 0) {
            for (int item = gw / stride; item < 64; item += (NGW + stride - 1) / stride) {
                if (item < 32) scan_rwkv_naive(F, item); else scan_ret_naive(F, item - 32);
            }
        }
    }
#endif
}
#if (MK_GLOBAL_GROUPS & 4)
#pragma pop_macro("WSP")
#pragma pop_macro("WSW")
#pragma pop_macro("OUTP")
#endif
#if (MK_GLOBAL_GROUPS & 8)
#pragma push_macro("WSP")
#pragma push_macro("WSW")
#pragma push_macro("OUTP")
#undef WSP
#undef WSW
#undef OUTP
#define WSP WSPG
#define WSW WSWG
#define OUTP OUTPG
#endif
template <int CTRL> __device__ __forceinline__ float dppx(float x) { return __builtin_bit_cast(float, __builtin_amdgcn_update_dpp(0, __builtin_bit_cast(int, x), CTRL, 0xF, 0xF, true)); }
__device__ __forceinline__ void ph_post(Frame& F, ArgP A, int l) {
    const int gw = F.vcu * NWAVES + F.wave, NGW = F.G * NWAVES, lane = F.lane, c0 = lane * 16;
    f32x4 gg[4], gb[4], lg[4], lb[4];
#pragma unroll
    for (int j = 0; j < 4; ++j) { gg[j] = *(const GAS f32x4*)(INP(A, 4) + (size_t)l * RETW + c0 + 4 * j); gb[j] = *(const GAS f32x4*)(INP(A, 5) + (size_t)l * RETW + c0 + 4 * j);
        lg[j] = *(const GAS f32x4*)(INP(A, 15) + (size_t)l * RWW + c0 + 4 * j); lb[j] = *(const GAS f32x4*)(INP(A, 16) + (size_t)l * RWW + c0 + 4 * j); }
    for (int m = gw; m < M; m += NGW) {
        {
            f32x4 y[4]; float s = 0.f;
#pragma unroll
            for (int j = 0; j < 4; ++j) { y[j] = *(const GAS f32x4*)(WSP(float, WS_YRAWR) + (size_t)m * RETW + c0 + 4 * j); s += (y[j].x + y[j].y) + (y[j].z + y[j].w); }
            const GAS bf16* zg = (const GAS bf16*)(WSP(bf16, WS_Z) + (size_t)m * INW + ZC_GR + c0);
            float g[16]; { float t[8]; unpack8(*(const GAS v4u*)zg, t);
#pragma unroll
                for (int j = 0; j < 8; ++j) g[j] = t[j]; unpack8(*(const GAS v4u*)(zg + 8), t);
#pragma unroll
                for (int j = 0; j < 8; ++j) g[8 + j] = t[j]; }
            s += dppx<0xB1>(s); s += dppx<0x4E>(s); s += dppx<0x141>(s);
            const float mean = s * (1.f / RD); float q = 0.f;
#pragma unroll
            for (int j = 0; j < 4; ++j) { y[j] = y[j] - mean; q += (y[j].x * y[j].x + y[j].y * y[j].y) + (y[j].z * y[j].z + y[j].w * y[j].w); }
            q += dppx<0xB1>(q); q += dppx<0x4E>(q); q += dppx<0x141>(q);
            const float rstd = __builtin_amdgcn_rsqf(q * (1.f / RD) + RET_GN_EPS);
            float o[16];
#pragma unroll
            for (int j = 0; j < 4; ++j)
#pragma unroll
                for (int k = 0; k < 4; ++k) { const float gr = g[4 * j + k]; o[4 * j + k] = (y[j][k] * rstd * gg[j][k] + gb[j][k]) * (gr * fsig(gr)); }
            GAS bf16* yo = (GAS bf16*)(WSP(bf16, WS_YRET) + (size_t)m * RETW + c0);
            { float t[8];
#pragma unroll
              for (int j = 0; j < 8; ++j) t[j] = o[j]; *(GAS bf16x8*)yo = pack8(t);
#pragma unroll
              for (int j = 0; j < 8; ++j) t[j] = o[8 + j]; *(GAS bf16x8*)(yo + 8) = pack8(t); }
        }
        {
            const size_t ob = (size_t)m * RWW + c0;
            f32x4 y[4]; float s = 0.f;
#pragma unroll
            for (int j = 0; j < 4; ++j) { y[j] = *(const GAS f32x4*)(WSP(float, WS_YRAWW) + ob + 4 * j); s += (y[j].x + y[j].y) + (y[j].z + y[j].w); }
            f32x4 vv[4], gt[4];
#pragma unroll
#if MK_CHUNKED
            for (int j = 0; j < 4; ++j) { vv[j] = unpk4(*(const GAS v2u*)(WSP(bf16, WS_SV) + ob + 4 * j)); gt[j] = unpk4(*(const GAS v2u*)(WSP(bf16, WS_G) + ob + 4 * j)); }
#else
            for (int j = 0; j < 4; ++j) { vv[j] = *(const GAS f32x4*)(WSP(float, WS_SV) + ob + 4 * j); gt[j] = *(const GAS f32x4*)(WSP(float, WS_G) + ob + 4 * j); }
#endif
            const float bonus = *(const GAS float*)(WSP(float, WS_BONUS) + (size_t)m * WH + (lane >> 2));
            s += dppx<0xB1>(s); s += dppx<0x4E>(s);
            const float mean = s * (1.f / WD); float q = 0.f;
#pragma unroll
            for (int j = 0; j < 4; ++j) { y[j] = y[j] - mean; q += (y[j].x * y[j].x + y[j].y * y[j].y) + (y[j].z * y[j].z + y[j].w * y[j].w); }
            q += dppx<0xB1>(q); q += dppx<0x4E>(q);
            const float rstd = __builtin_amdgcn_rsqf(q * (1.f / WD) + RWKV_LN_EPS);
            float o[16];
#pragma unroll
            for (int j = 0; j < 4; ++j)
#pragma unroll
                for (int k = 0; k < 4; ++k) o[4 * j + k] = (y[j][k] * rstd * lg[j][k] + lb[j][k] + bonus * vv[j][k]) * gt[j][k];
            GAS bf16* yo = (GAS bf16*)(WSP(bf16, WS_YRWKV) + ob);
            { float t[8];
#pragma unroll
              for (int j = 0; j < 8; ++j) t[j] = o[j]; *(GAS bf16x8*)yo = pack8(t);
#pragma unroll
              for (int j = 0; j < 8; ++j) t[j] = o[8 + j]; *(GAS bf16x8*)(yo + 8) = pack8(t); }
        }
    }
}
__device__ __forceinline__ void ph_final(Frame& F, ArgP A) {
    const int gw = F.vcu * NWAVES + F.wave, NGW = F.G * NWAVES, lane = F.lane;
    const GAS f32x4* gr = (const GAS f32x4*)INP(A, 23) + lane;
    for (int m = gw; m < M; m += NGW) {
        GAS f32x4* xr = (GAS f32x4*)(OUTP + (size_t)m * D) + lane;
        f32x4 v[8]; float s = 0.f;
#pragma unroll
        for (int j = 0; j < 8; ++j) { v[j] = xr[64 * j]; s += (v[j].x * v[j].x + v[j].y * v[j].y) + (v[j].z * v[j].z + v[j].w * v[j].w); }
        const float rstd = 1.f / sqrtf(wave_sum(s) * (1.f / D) + NORM_EPS);
#pragma unroll
        for (int j = 0; j < 8; ++j) xr[64 * j] = v[j] * rstd * gr[64 * j];
    }
}
#if (MK_GLOBAL_GROUPS & 8)
#pragma pop_macro("WSP")
#pragma pop_macro("WSW")
#pragma pop_macro("OUTP")
#endif

__global__ void __launch_bounds__(NWAVES * 64, 2) hybrid_fwd(Args args) {
    extern __shared__ __attribute__((aligned(16))) unsigned char lds[];
    Frame F;
    F.lds = (LAS unsigned char*)lds;
    F.MISC = (volatile LAS unsigned*)(F.lds + MISC_OFF);
    F.tid = threadIdx.x; F.lane = F.tid & 63; F.wave = __builtin_amdgcn_readfirstlane(F.tid >> 6);
    int bx = blockIdx.x; F.G = gridDim.x; { F.vcu = (F.G % 8 == 0) ? (bx % 8) * (F.G / 8) + bx / 8 : bx; }
    F.ws = args.ws; F.out = args.out;
    for (int u = F.tid; u < (LDS_BYTES - LDSCTL_OFF) / 4; u += NWAVES * 64) ((LAS unsigned*)(F.lds + LDSCTL_OFF))[u] = 0u;
    __syncthreads();
    if (F.tid == 0) { volatile LAS unsigned* U = (volatile LAS unsigned*)(F.lds + MISC_OFF) + 16; const unsigned long long pw = (unsigned long long)args.ws, po = (unsigned long long)args.out, pa = (unsigned long long)__builtin_amdgcn_kernarg_segment_ptr();
        U[0] = (unsigned)pw; U[1] = (unsigned)(pw >> 32); U[2] = (unsigned)po; U[3] = (unsigned)(po >> 32); U[4] = (unsigned)pa; U[5] = (unsigned)(pa >> 32); U[6] = (unsigned)F.G; U[7] = (unsigned)F.vcu; U[8] = (unsigned)bx; }
    __syncthreads();
    XcdBarrier bar = xcd_barrier_post((unsigned*)(F.ws + WS_CTL) + CW_BAR, F.MISC + 8);

    ArgP ap = (ArgP)__builtin_amdgcn_kernarg_segment_ptr();
    const int lo = args.ph_lo, hi = args.ph_hi;
#define REPX(bit, body) do { body; if (MK_REP & (bit)) { __syncthreads(); body; } } while (0)
#define IN(k) (lo <= (k) && (k) < hi)
#define SEAM(k) do { if (IN(k) && IN((k) + 1)) xcd_barrier(bar); else __syncthreads(); } while (0)

    if (IN(PH_PRO)) { int np_ = (MK_REP & 8192) ? 2 : 1; asm volatile("" : "+s"(np_));
#pragma unroll 1
        for (int rp_ = 0; rp_ < np_; ++rp_) { ph_prologue(F, ap); ph_convert(F, ap, 0, F.vcu, F.G); __syncthreads(); } }
    SEAM(PH_PRO);
    for (int l = 0; l < DEPTH; ++l) {
        const int p0 = PH_L0 + l * PPL;
        RETID();
        { unsigned ba = MISC_OFF + 64; asm volatile("" : "+v"(ba));
          const volatile LAS v4u* U = (const volatile LAS v4u*)(F.lds + ba);
          const v4u ua = U[0], ub = U[1]; const unsigned uc = *(const volatile LAS unsigned*)(U + 2);
          const unsigned u0 = __builtin_amdgcn_readfirstlane(ua.x), u1 = __builtin_amdgcn_readfirstlane(ua.y), u2 = __builtin_amdgcn_readfirstlane(ua.z), u3 = __builtin_amdgcn_readfirstlane(ua.w);
          const unsigned u4 = __builtin_amdgcn_readfirstlane(ub.x), u5 = __builtin_amdgcn_readfirstlane(ub.y), u6 = __builtin_amdgcn_readfirstlane(ub.z), u7 = __builtin_amdgcn_readfirstlane(ub.w), u8 = __builtin_amdgcn_readfirstlane(uc);
          F.ws = (unsigned char*)(((unsigned long long)u1 << 32) | u0); F.out = (float*)(((unsigned long long)u3 << 32) | u2); ap = (ArgP)(((unsigned long long)u5 << 32) | u4);
          F.G = (int)u6; F.vcu = (int)u7; bx = (int)u8; F.wave = __builtin_amdgcn_readfirstlane(F.tid >> 6); }
        if (IN(p0 + LP_G1)) {
            pg8::Gemm g{WSPG(bf16, WS_H), WSWG(l, WO_WIN), M, INW, D}; pg8::StaticOrder S; S.init(M, INW, F.G, bx);
            pg8::EpiB<0> E{WSPG(bf16, WS_Z), INW, nullptr, 0, WSPG(float, WS_SS)};
            pg8::gemm_phase<pg8::EpiB<0>, pg8::StaticOrder, MK_ALIGN, MK_SP2>(F.lds + RING_OFF, g, S, E);
            if (MK_REP & 512) { __syncthreads(); pg8::gemm_phase<pg8::EpiB<0>, pg8::StaticOrder, MK_ALIGN, MK_SP2>(F.lds + RING_OFF, g, S, E); }
            if (MK_CONV_IN_G1 && F.G == 256 && l + 1 < DEPTH && bx >= 64) { RETID(); ph_convert(F, ap, l + 1, bx - 64, 192); }
        }
        SEAM(p0 + LP_G1);
        if (IN(p0 + LP_PREP)) { int nrep_ = (MK_REP & 4) ? 2 : 1; asm volatile("" : "+s"(nrep_));
#pragma unroll 1
            for (int rep_ = 0; rep_ < nrep_; ++rep_) { RETID(); ph_prep(F, ap, l); __syncthreads(); } }
        SEAM(p0 + LP_PREP);
        if (IN(p0 + LP_SCAN)) { RETID(); REPX(8, ph_scan(F, ap, l)); }
        SEAM(p0 + LP_SCAN);
        if (IN(p0 + LP_POST)) { RETID(); REPX(16, ph_post(F, ap, l)); }
        SEAM(p0 + LP_POST);
        if (IN(p0 + LP_GA)) {
            pg8::Gemm g{WSPG(bf16, WS_YRET), WSWG(l, WO_WA), M, D, RETW}; pg8::StaticOrder S; S.init(M, D, F.G, bx);
            pg8::EpiB<2> E{WSPG(bf16, WS_MRG), D, WSPG(bf16, WS_Z) + ZC_GA, INW, nullptr};
            pg8::gemm_phase<pg8::EpiB<2>, pg8::StaticOrder, MK_ALIGN, MK_SP2>(F.lds + RING_OFF, g, S, E);
        }
        __syncthreads();
        if (IN(p0 + LP_GB)) {
            pg8::Gemm g{WSPG(bf16, WS_YRWKV), WSWG(l, WO_WB), M, D, RWW}; pg8::StaticOrder S; S.init(M, D, F.G, bx);
            pg8::EpiB<3> E{WSPG(bf16, WS_MRG), D, WSPG(bf16, WS_Z) + ZC_GB, INW, nullptr};
            pg8::gemm_phase<pg8::EpiB<3>, pg8::StaticOrder, MK_ALIGN, MK_SP2>(F.lds + RING_OFF, g, S, E);
        }
        SEAM(p0 + LP_GB);
        if (IN(p0 + LP_GO)) {
            pg8::Gemm g{WSPG(bf16, WS_MRG), WSWG(l, WO_WO), M, D, D}; pg8::StaticOrder S; S.init(M, D, F.G, bx);
            pg8::EpiResNorm E{OUTPG, D, WSPG(bf16, WS_H), WSPG(float, WS_SS), l == 0 ? (const float*)(GAS const float*)(unsigned long long)INP(ap, 0) : (const float*)OUTPG};
            pg8::gemm_phase<pg8::EpiResNorm, pg8::StaticOrder, MK_ALIGN, MK_SP2>(F.lds + RING_OFF, g, S, E);
        }
        SEAM(p0 + LP_GO);
        if (IN(p0 + LP_GUP)) {
            pg8::Gemm g{WSPG(bf16, WS_H), WSWG(l, WO_WUP), M, DFF, D}; pg8::StaticOrder S; S.init(M, DFF, F.G, bx);
            pg8::EpiB<1> E{WSPG(bf16, WS_UP), DFF, nullptr, 0, WSPG(float, WS_SS)};
            pg8::gemm_phase<pg8::EpiB<1>, pg8::StaticOrder, MK_ALIGN, MK_SP2>(F.lds + RING_OFF, g, S, E);
        }
        SEAM(p0 + LP_GUP);
        if (IN(p0 + LP_GDN)) {
            pg8::Gemm g{WSPG(bf16, WS_UP), WSWG(l, WO_WDN), M, D, DFF}; pg8::StaticOrder S; S.init(M, D, F.G, bx);
            pg8::EpiResNorm E{OUTPG, D, WSPG(bf16, WS_H), WSPG(float, WS_SS), OUTPG};
            pg8::gemm_phase<pg8::EpiResNorm, pg8::StaticOrder, MK_ALIGN, MK_SP2>(F.lds + RING_OFF, g, S, E);
        }
        SEAM(p0 + LP_GDN);
    }
    if (IN(PH_FIN)) { RETID(); ph_final(F, ap); }
#undef IN
#undef SEAM
}

extern "C" void kernel_launch(void* const* d_in, const int* in_sizes, int n_in, void* d_out, int out_size, void* d_ws, size_t ws_size, hipStream_t stream) {
    static int grid = 0;
    if (grid == 0) {
        if (n_in != 24 || in_sizes[0] != M * D || out_size != M * D || ws_size < WS_END) { fprintf(stderr, "kernel_launch: built for 24 inputs, x and out of %d floats, >= %zu bytes of workspace; got n_in %d, in0 %d, out %d, ws %zu; nothing launched\n", M * D, (size_t)WS_END, n_in, n_in > 0 ? in_sizes[0] : -1, out_size, ws_size); grid = -1; return; }
        int dev = 0, cus = 0, per_cu = 0;
        if (hipGetDevice(&dev) != hipSuccess || hipDeviceGetAttribute(&cus, hipDeviceAttributeMultiprocessorCount, dev) != hipSuccess) { fprintf(stderr, "kernel_launch: hipGetDevice / hipDeviceGetAttribute failed; nothing launched\n"); grid = -1; return; }
        if (hipFuncSetAttribute((const void*)hybrid_fwd, hipFuncAttributeMaxDynamicSharedMemorySize, LDS_BYTES) != hipSuccess) { fprintf(stderr, "kernel_launch: hipFuncSetAttribute failed\n"); grid = -1; return; }
        if (hipOccupancyMaxActiveBlocksPerMultiprocessor(&per_cu, (const void*)hybrid_fwd, NWAVES * 64, LDS_BYTES) != hipSuccess || per_cu < 1)
            fprintf(stderr, "kernel_launch: note: the occupancy query reports %d workgroups per CU\n", per_cu);
        (void)hipGetLastError();
        if (cus < 256) { fprintf(stderr, "kernel_launch: built for a 256-CU device (MI355X); this one reports %d CUs; nothing launched\n", cus); grid = -1; return; }
        grid = 256;
    }
    if (grid < 0) return;
    if (hipMemsetAsync((char*)d_ws + WS_CTL, 0, CTL_ZERO_BYTES, stream) != hipSuccess) { fprintf(stderr, "kernel_launch: hipMemsetAsync failed\n"); return; }
    Args a{};
    for (int i = 0; i < 24; ++i) a.in[i] = (const float*)d_in[i];
    a.out = (float*)d_out; a.ws = (unsigned char*)d_ws; a.li = 0; a.pad = 0;
#if MK_ONE_LAUNCH
    a.ph_lo = 0; a.ph_hi = NPH;
    hipLaunchKernelGGL(hybrid_fwd, dim3(grid), dim3(NWAVES * 64), LDS_BYTES, stream, a);
#else
    for (int p = 0; p < NPH; ++p) {
        a.ph_lo = p; a.ph_hi = p + 1;
        hipLaunchKernelGGL(hybrid_fwd, dim3(grid), dim3(NWAVES * 64), LDS_BYTES, stream, a);
    }
#endif
    const hipError_t le = hipPeekAtLastError();
    if (le != hipSuccess) fprintf(stderr, "kernel_launch: launch failed: %s\n", hipGetErrorName(le));
}
```

```cpp
#include <hip/hip_runtime.h>
#include <cstdio>
#include <cstdint>
#ifndef MK_GLOBAL_GROUPS
#define MK_GLOBAL_GROUPS 30
#endif
#ifndef MK_REP
#define MK_REP 0
#endif
namespace pg8 {
#define PG8_LAS __attribute__((address_space(3)))
typedef unsigned short bf16_t;
typedef short bf16x8 __attribute__((ext_vector_type(8)));
typedef float f32x4 __attribute__((ext_vector_type(4)));
typedef unsigned u32x4 __attribute__((ext_vector_type(4)));
constexpr int BM = 256, BK = 64, HALF = 128, HTB = HALF * BK * 2  , STAGE_BYTES = 8 * HTB, NXCD = 8, WGM = 8;

__host__ __device__ __forceinline__ int lds_byte(int r, int c) { const int st = (r >> 4) * 2 + (c >> 5), rr = r & 15, cc = c & 31, ob = rr * 64 + cc * 2; return st * 1024 + (ob ^ (((ob >> 9) & 1) << 5)); }
__host__ __device__ __forceinline__ void stage_rc(int b, int& R, int& C) { const int st = b / 1024, sb = b % 1024, swz = sb ^ (((sb >> 9) & 1) << 5); R = (st >> 1) * 16 + swz / 64; C = (st & 1) * 32 + (swz % 64) / 2; }
__host__ __device__ __forceinline__ int perm32(int rho) { const int n = rho >> 4, i = rho & 15; return 8 * (i >> 2) + 4 * n + (i & 3); }

struct Unit { int pm, pn; };
struct Gemm { const bf16_t* A; const bf16_t* Bt; int M, N, K; };

struct StaticOrder {
    int nM, nN, nwg, G, c;
    __host__ __device__ void init(int M, int N, int G_, int c_) { nM = M / BM; nN = N / BM; nwg = nM * nN; G = G_; c = c_; }
    __host__ __device__ bool next(int i, Unit& u) const {
        const long L = (long)i * G + c; if (L >= nwg) return false;
        int wgid = (int)L; { const int q = nwg / NXCD, r = nwg % NXCD, xcd = wgid % NXCD, off = wgid / NXCD; wgid = (xcd < r ? xcd * (q + 1) : r * (q + 1) + (xcd - r) * q) + off; }
        const int nig = WGM * nN, gid = wgid / nig, fm = gid * WGM, gsz = (nM - fm) < WGM ? (nM - fm) : WGM;
        u.pm = fm + ((wgid % nig) % gsz); u.pn = (wgid % nig) / gsz; return true;
    }
    __device__ __forceinline__ void a_ready(const Unit&) const {}
    __device__ __forceinline__ void done(const Unit&) const {}
};

typedef float f32x2c __attribute__((ext_vector_type(2))); typedef __bf16 bf16x2c __attribute__((ext_vector_type(2)));
__device__ __forceinline__ unsigned cvt_pk_bf16(float lo, float hi) { const f32x2c v = {lo, hi}; return __builtin_bit_cast(unsigned, __builtin_convertvector(v, bf16x2c)); }
typedef float f32x2 __attribute__((ext_vector_type(2)));
__device__ __forceinline__ float bf_lo(unsigned w) { return __builtin_bit_cast(float, w << 16); }
__device__ __forceinline__ float bf_hi(unsigned w) { return __builtin_bit_cast(float, w & 0xffff0000u); }
__device__ __forceinline__ float sigmoidf_(float x) { return 1.0f / (1.0f + __expf(-x)); }
template <int MODE> struct EpiB {
    static constexpr bool PERM = true, AFTER_DRAIN = false;
    bf16_t* O; int ldc; const bf16_t* gate; int ldg; const float* ss;
    __device__ __forceinline__ void operator()(const f32x4 (&acc)[2][2][4][2], const Unit& u, int wr, int wc, int fr, int fq) const {
        const int row0 = u.pm * BM + wr * 64 + fr, col0 = u.pn * BM + wc * 32 + 8 * fq;
        float rs[2][4];
        for (int rep_ = 0; rep_ < ((MK_REP & 128) ? 2 : 1); ++rep_) { asm volatile("" ::: "memory");
        if (MODE <= 1) {
            typedef __attribute__((address_space(1))) const f32x4 gf4;
            f32x4 q[2][4][2];
#pragma unroll
            for (int ai = 0; ai < 2; ++ai)
#pragma unroll
                for (int m = 0; m < 4; ++m) { gf4* sp = (gf4*)(ss + (size_t)(row0 + ai * HALF + m * 16) * 32) + fq * 2; q[ai][m][0] = sp[0]; q[ai][m][1] = sp[1]; }
#pragma unroll
            for (int ai = 0; ai < 2; ++ai)
#pragma unroll
                for (int m = 0; m < 4; ++m) { const f32x4 a = q[ai][m][0] + q[ai][m][1]; rs[ai][m] = (a[0] + a[1]) + (a[2] + a[3]); }
#pragma unroll
            for (int ai = 0; ai < 2; ++ai)
#pragma unroll
                for (int m = 0; m < 4; ++m) rs[ai][m] += __shfl_xor(rs[ai][m], 16);
#pragma unroll
            for (int ai = 0; ai < 2; ++ai)
#pragma unroll
                for (int m = 0; m < 4; ++m) { rs[ai][m] += __shfl_xor(rs[ai][m], 32); rs[ai][m] = __builtin_amdgcn_rsqf(rs[ai][m] * (1.0f / 2048.0f) + 1e-6f); }
        }
        if (MK_REP & 128) asm volatile("" : "+v"(rs[0][0]), "+v"(rs[1][3]) :: "memory"); }
        int ne_ = ((MK_REP & 16384) && MODE == 1) ? 2 : 1; asm volatile("" : "+s"(ne_));
#pragma unroll 1
        for (int re_ = 0; re_ < ne_; ++re_)
#pragma unroll
        for (int ai = 0; ai < 2; ++ai)
#pragma unroll
            for (int m = 0; m < 4; ++m) { const size_t row = (size_t)(row0 + ai * HALF + m * 16);
#pragma unroll
                for (int bj = 0; bj < 2; ++bj) { f32x4 v0 = acc[ai][bj][m][0], v1 = acc[ai][bj][m][1]; const int c = col0 + bj * HALF;
                    if (MODE <= 1) { v0 = v0 * rs[ai][m]; v1 = v1 * rs[ai][m]; }
                    if (MODE == 1) {
#pragma unroll
                        for (int j = 0; j < 4; ++j) { const float a = fmaxf(v0[j], 0.f), b = fmaxf(v1[j], 0.f); v0[j] = a * a; v1[j] = b * b; } }
                    if (MODE >= 2) { const u32x4 g = *(const u32x4*)(gate + row * ldg + c);
                        v0[0] *= sigmoidf_(bf_lo(g.x)); v0[1] *= sigmoidf_(bf_hi(g.x)); v0[2] *= sigmoidf_(bf_lo(g.y)); v0[3] *= sigmoidf_(bf_hi(g.y));
                        v1[0] *= sigmoidf_(bf_lo(g.z)); v1[1] *= sigmoidf_(bf_hi(g.z)); v1[2] *= sigmoidf_(bf_lo(g.w)); v1[3] *= sigmoidf_(bf_hi(g.w)); }
                    if (MODE == 3) { const u32x4 o = *(const u32x4*)(O + row * ldc + c);
                        v0[0] += bf_lo(o.x); v0[1] += bf_hi(o.x); v0[2] += bf_lo(o.y); v0[3] += bf_hi(o.y);
                        v1[0] += bf_lo(o.z); v1[1] += bf_hi(o.z); v1[2] += bf_lo(o.w); v1[3] += bf_hi(o.w); }
                    u32x4 w; w.x = cvt_pk_bf16(v0[0], v0[1]); w.y = cvt_pk_bf16(v0[2], v0[3]); w.z = cvt_pk_bf16(v1[0], v1[1]); w.w = cvt_pk_bf16(v1[2], v1[3]);
                    *(u32x4*)(O + row * ldc + c) = w; } }
    }
};
struct EpiResNorm {
    static constexpr bool PERM = true, AFTER_DRAIN = false;
    float* X; int ldc; bf16_t* XB; float* SS; const float* Xin;
    __device__ __forceinline__ void operator()(const f32x4 (&acc)[2][2][4][2], const Unit& u, int wr, int wc, int fr, int fq) const {
        const int row0 = u.pm * BM + wr * 64 + fr, col0 = u.pn * BM + wc * 32 + 8 * fq;
#pragma unroll
        for (int ai = 0; ai < 2; ++ai)
#pragma unroll
            for (int m = 0; m < 4; ++m) { const size_t row = (size_t)(row0 + ai * HALF + m * 16);
                float s = 0.f;
#pragma unroll
                for (int bj = 0; bj < 2; ++bj) { const int c = col0 + bj * HALF; float* p = X + row * ldc + c; const float* pi = Xin + row * ldc + c;
                    const f32x4 x0 = *(const f32x4*)pi + acc[ai][bj][m][0], x1 = *(const f32x4*)(pi + 4) + acc[ai][bj][m][1];
                    *(f32x4*)p = x0; *(f32x4*)(p + 4) = x1;
                    u32x4 w; w.x = cvt_pk_bf16(x0[0], x0[1]); w.y = cvt_pk_bf16(x0[2], x0[3]); w.z = cvt_pk_bf16(x1[0], x1[1]); w.w = cvt_pk_bf16(x1[2], x1[3]);
                    *(u32x4*)(XB + row * ldc + c) = w;
                    s += ((x0[0] * x0[0] + x0[1] * x0[1]) + (x0[2] * x0[2] + x0[3] * x0[3])) + ((x1[0] * x1[0] + x1[1] * x1[1]) + (x1[2] * x1[2] + x1[3] * x1[3])); }
                s += __shfl_xor(s, 16); s += __shfl_xor(s, 32);
                if (fq == 0) SS[row * 32 + u.pn * 4 + wc] = s; }
    }
};

template <class Epi, class Sched, bool ALIGN_EPI = false, bool SP2 = false>
__device__ __forceinline__ void gemm_phase(PG8_LAS unsigned char* lds, const Gemm g, const Sched& S, const Epi& E) {
    int tid_ = threadIdx.x; asm volatile("" : "+v"(tid_));
    const int tid = tid_, wid = __builtin_amdgcn_readfirstlane(tid >> 6), lane = tid & 63, wr = wid >> 2, wc = wid & 3, fr = lane & 15, fq = lane >> 4;
    const int K = g.K, nt = K / BK;
    unsigned voffA[2], voffB[2];
#pragma unroll
    for (int i = 0; i < 2; ++i) { int R, C; stage_rc(tid * 16 + i * 8192, R, C); const int Rb = Epi::PERM ? ((R & ~31) + perm32(R & 31)) : R;
        voffA[i] = (unsigned)(R * K + C) * 2u; voffB[i] = (unsigned)(Rb * K + C) * 2u; }
    const size_t kstep = (size_t)(BK * 2);
    const size_t hstep = (size_t)HALF * K * 2;
    const size_t tstep = 2 * hstep;
    const unsigned ldsw = (unsigned)wid * 1024u;
    const int aoff = lds_byte(wr * 64 + fr, fq * 8), boff = lds_byte(wc * 32 + fr, fq * 8);
#define PG8_SA(b, h) (((b) * 2 + (h)) * HTB)
#define PG8_SB(b, h) ((4 + (b) * 2 + (h)) * HTB)
#define PG8_STAGE(bufoff, gbase, voff) do { _Pragma("unroll") for (int _i = 0; _i < 2; ++_i) \
        __builtin_amdgcn_global_load_lds((const unsigned*)((const char*)(gbase) + (voff)[_i]), (PG8_LAS unsigned*)(lds + (bufoff) + ldsw + _i * 8192), 16, 0, 0); } while (0)
#define PG8_LDA(dst, b, h) do { _Pragma("unroll") for (int m = 0; m < 4; ++m) _Pragma("unroll") for (int k = 0; k < 2; ++k) dst[m][k] = *(const PG8_LAS bf16x8*)(lds + PG8_SA(b, h) + aoff + m * 2048 + k * 1024); } while (0)
#define PG8_LDB(dst, b, h) do { _Pragma("unroll") for (int n = 0; n < 2; ++n) _Pragma("unroll") for (int k = 0; k < 2; ++k) dst[n][k] = *(const PG8_LAS bf16x8*)(lds + PG8_SB(b, h) + boff + n * 2048 + k * 1024); } while (0)
#define PG8_MMA(ai, bj, At, Bt) do { __builtin_amdgcn_s_setprio(1); _Pragma("unroll") for (int m = 0; m < 4; ++m) _Pragma("unroll") for (int n = 0; n < 2; ++n) _Pragma("unroll") for (int k = 0; k < 2; ++k) \
        acc[ai][bj][m][n] = __builtin_amdgcn_mfma_f32_16x16x32_bf16(Bt[n][k], At[m][k], acc[ai][bj][m][n], 0, 0, 0); __builtin_amdgcn_s_setprio(0); } while (0)
#define PG8_WAIT_V(n) asm volatile("s_waitcnt vmcnt(" #n ")" ::: "memory")
#define PG8_WAIT_L(n) asm volatile("s_waitcnt lgkmcnt(" #n ")" ::: "memory")
#define PG8_BAR __builtin_amdgcn_s_barrier()
#define PG8_SCHED __builtin_amdgcn_sched_barrier(0)
    Unit cur, nxt; int ui = 0;
    if (!S.next(0, cur)) return;
    f32x4 acc[2][2][4][2];
#pragma unroll
    for (int a = 0; a < 2; ++a)
#pragma unroll
        for (int b = 0; b < 2; ++b)
#pragma unroll
            for (int m = 0; m < 4; ++m)
#pragma unroll
                for (int n = 0; n < 2; ++n) acc[a][b][m][n] = (f32x4){0.f, 0.f, 0.f, 0.f};
    bf16x8 At[4][2], B0[2][2], B1[2][2];
    const char* cA = (const char*)g.A + (size_t)cur.pm * tstep; const char* cB = (const char*)g.Bt + (size_t)cur.pn * tstep;
    S.a_ready(cur);
    if constexpr (SP2) {
        PG8_STAGE(PG8_SB(0, 0), cB, voffB); PG8_STAGE(PG8_SB(0, 1), cB + hstep, voffB); PG8_STAGE(PG8_SA(0, 0), cA, voffA); PG8_STAGE(PG8_SA(0, 1), cA + hstep, voffA);
        if (wr == 1) PG8_BAR;
        PG8_WAIT_V(2); PG8_BAR;
        PG8_STAGE(PG8_SB(1, 0), cB + kstep, voffB); PG8_STAGE(PG8_SA(1, 0), cA + kstep, voffA); PG8_STAGE(PG8_SB(1, 1), cB + hstep + kstep, voffB);
        PG8_WAIT_V(6); PG8_BAR;
    } else {
        PG8_STAGE(PG8_SB(0, 0), cB, voffB); PG8_STAGE(PG8_SA(0, 0), cA, voffA); PG8_STAGE(PG8_SB(0, 1), cB + hstep, voffB); PG8_STAGE(PG8_SA(0, 1), cA + hstep, voffA);
        if (wr == 1) PG8_BAR;
        PG8_WAIT_V(4); PG8_BAR;
        PG8_STAGE(PG8_SB(1, 0), cB + kstep, voffB); PG8_STAGE(PG8_SA(1, 0), cA + kstep, voffA); PG8_STAGE(PG8_SB(1, 1), cB + hstep + kstep, voffB);
        PG8_WAIT_V(6); PG8_BAR;
    }
    for (;;) {
        const bool has_next = S.next(ui + 1, nxt);
        const char* nA = has_next ? (const char*)g.A + (size_t)nxt.pm * tstep : cA; const char* nB = has_next ? (const char*)g.Bt + (size_t)nxt.pn * tstep : cB;
        for (int t = 0; t < nt; t += 2) {
            const bool last = (t == nt - 2);
            const char* a1 = cA + (size_t)(t + 1) * kstep;
            const char* a2 = last ? nA : cA + (size_t)(t + 2) * kstep; const char* b2 = last ? nB : cB + (size_t)(t + 2) * kstep;
            const char* a3 = a2 + kstep; const char* b3 = b2 + kstep;
            if (last && has_next) S.a_ready(nxt);
            if constexpr (SP2) {
            PG8_LDB(B0, 0, 0); PG8_LDB(B1, 0, 1); PG8_SCHED; PG8_LDA(At, 0, 0); PG8_STAGE(PG8_SA(1, 1), a1 + hstep, voffA);
            PG8_WAIT_V(8); PG8_WAIT_L(0); PG8_BAR; PG8_MMA(0, 0, At, B0); PG8_MMA(0, 1, At, B1); PG8_BAR; PG8_SCHED;
            PG8_LDA(At, 0, 1); PG8_STAGE(PG8_SB(0, 0), b2, voffB); PG8_STAGE(PG8_SB(0, 1), b2 + hstep, voffB); PG8_STAGE(PG8_SA(0, 0), a2, voffA);
            PG8_WAIT_V(8); PG8_WAIT_L(0); PG8_BAR; PG8_MMA(1, 0, At, B0); PG8_MMA(1, 1, At, B1); PG8_BAR; PG8_SCHED;
            PG8_LDB(B0, 1, 0); PG8_LDB(B1, 1, 1); PG8_SCHED; PG8_LDA(At, 1, 0); PG8_STAGE(PG8_SA(0, 1), a2 + hstep, voffA);
            PG8_WAIT_V(8); PG8_WAIT_L(0); PG8_BAR; PG8_MMA(0, 0, At, B0); PG8_MMA(0, 1, At, B1); PG8_BAR; PG8_SCHED;
            PG8_LDA(At, 1, 1); PG8_STAGE(PG8_SB(1, 0), b3, voffB); PG8_STAGE(PG8_SB(1, 1), b3 + hstep, voffB); PG8_STAGE(PG8_SA(1, 0), a3, voffA);
            PG8_WAIT_V(8); PG8_WAIT_L(0); PG8_BAR; PG8_MMA(1, 0, At, B0); PG8_MMA(1, 1, At, B1); PG8_BAR; PG8_SCHED;
            } else {
            PG8_LDB(B0, 0, 0); PG8_SCHED; PG8_LDA(At, 0, 0); PG8_STAGE(PG8_SA(1, 1), a1 + hstep, voffA);
            PG8_WAIT_L(8); PG8_BAR; PG8_WAIT_L(0); PG8_MMA(0, 0, At, B0); PG8_BAR; PG8_SCHED;
            PG8_LDB(B1, 0, 1); PG8_STAGE(PG8_SB(0, 0), b2, voffB);
            PG8_BAR; PG8_WAIT_L(0); PG8_MMA(0, 1, At, B1); PG8_BAR;
            PG8_LDA(At, 0, 1); PG8_STAGE(PG8_SA(0, 0), a2, voffA);
            PG8_BAR; PG8_WAIT_L(0); PG8_MMA(1, 0, At, B0); PG8_BAR; PG8_SCHED;
            PG8_STAGE(PG8_SB(0, 1), b2 + hstep, voffB);
            PG8_WAIT_V(6); PG8_BAR; PG8_MMA(1, 1, At, B1); PG8_BAR;
            PG8_LDB(B0, 1, 0); PG8_SCHED; PG8_LDA(At, 1, 0); PG8_STAGE(PG8_SA(0, 1), a2 + hstep, voffA);
            PG8_WAIT_L(8); PG8_BAR; PG8_WAIT_L(0); PG8_MMA(0, 0, At, B0); PG8_BAR; PG8_SCHED;
            PG8_LDB(B1, 1, 1); PG8_STAGE(PG8_SB(1, 0), b3, voffB);
            PG8_BAR; PG8_WAIT_L(0); PG8_MMA(0, 1, At, B1); PG8_BAR;
            PG8_LDA(At, 1, 1); PG8_STAGE(PG8_SA(1, 0), a3, voffA);
            PG8_BAR; PG8_WAIT_L(0); PG8_MMA(1, 0, At, B0); PG8_BAR; PG8_SCHED;
            PG8_STAGE(PG8_SB(1, 1), b3 + hstep, voffB);
            PG8_WAIT_V(6); PG8_BAR; PG8_MMA(1, 1, At, B1); PG8_BAR;
            }
        }
        if constexpr (ALIGN_EPI) { if (wr == 0) PG8_BAR; }
        if constexpr (!Epi::AFTER_DRAIN) { E(acc, cur, wr, wc, fr, fq); S.done(cur); }
        if (!has_next) break;
#pragma unroll
        for (int a = 0; a < 2; ++a)
#pragma unroll
            for (int b = 0; b < 2; ++b)
#pragma unroll
                for (int m = 0; m < 4; ++m)
#pragma unroll
                    for (int n = 0; n < 2; ++n) acc[a][b][m][n] = (f32x4){0.f, 0.f, 0.f, 0.f};
        cur = nxt; cA = nA; cB = nB; ++ui;
        if constexpr (ALIGN_EPI) { if (wr == 1) PG8_BAR; }
    }
    PG8_WAIT_V(0);
    if constexpr (!ALIGN_EPI) { if (wr == 0) PG8_BAR; }
    PG8_BAR;
    if constexpr (Epi::AFTER_DRAIN) { E.fused(acc, cur, wr, wc, fr, fq, lds, wid, lane); S.done(cur); }
#undef PG8_SA
#undef PG8_SB
#undef PG8_STAGE
#undef PG8_LDA
#undef PG8_LDB
#undef PG8_MMA
#undef PG8_WAIT_V
#undef PG8_WAIT_L
#undef PG8_BAR
#undef PG8_SCHED
}
}
constexpr int NWAVES = 8;
#ifndef MK_ONE_LAUNCH
#define MK_ONE_LAUNCH 1
#endif

#ifndef MK_GLOBAL_GROUPS
#define MK_GLOBAL_GROUPS 30
#endif
#ifndef MK_CHUNKED
#define MK_CHUNKED 1
#endif
#ifndef MK_SP2
#define MK_SP2 true
#endif
#ifndef MK_ALIGN
#define MK_ALIGN true
#endif
#ifndef MK_CONV_IN_G1
#define MK_CONV_IN_G1 0
#endif
#ifndef MK_X2_NT
#define MK_X2_NT 0
#endif
#ifndef MK_REP
#define MK_REP 0
#endif

constexpr int BATCH = 2, SEQ = 8192, D = 2048, DEPTH = 4, M = BATCH * SEQ;
constexpr int RETW = 1024, RH = 8, RD = 128, RWW = 1024, WH = 16, WD = 64;
constexpr int INW = 11520, DFF = 8192, RWSHIFT = 3328;
constexpr int ZC_Q = 0, ZC_K = 1024, ZC_V = 2048, ZC_GR = 3072, ZC_RW = 4096, ZC_GA = 7424, ZC_GB = 9472;
constexpr int RWC_R = 0, RWC_K = 1024, RWC_V = 2048, RWC_W = 3072, RWC_A = 3136, RWC_G = 3200;
constexpr float NORM_EPS = 1e-6f, RET_GN_EPS = 1e-5f, RWKV_LN_EPS = 64e-5f;

constexpr size_t MiB = 1u << 20;
constexpr size_t WS_CTL = 0, CTL_ZERO_BYTES = 1 * MiB;
constexpr size_t WS_ROPE = 1 * MiB;
constexpr size_t WS_WSET = 16 * MiB, WSET_BYTES = 126 * MiB;
constexpr size_t WO_WIN = 0, WO_WA = 45 * MiB, WO_WB = 49 * MiB, WO_WO = 53 * MiB, WO_WUP = 61 * MiB, WO_WDN = 93 * MiB, WO_LORA = 125 * MiB;
constexpr size_t WS_H = 272 * MiB;
constexpr size_t WS_Z = 336 * MiB;
constexpr size_t WS_UP = WS_Z;
constexpr size_t WS_QR = 696 * MiB, WS_KR = 728 * MiB;
constexpr size_t WS_YRET = 760 * MiB, WS_YRWKV = 792 * MiB;
constexpr size_t WS_MRG = 824 * MiB;
#if MK_CHUNKED
constexpr size_t WS_SR = 888 * MiB, WS_SV = 1208 * MiB;
#else
constexpr size_t WS_SR = 888 * MiB, WS_SW = 952 * MiB, WS_SK = 1016 * MiB, WS_SV = 1080 * MiB, WS_SNKK = 1144 * MiB, WS_SKKA = 1208 * MiB;
#endif
constexpr size_t WS_CU = WS_SR;
constexpr size_t WS_G = 1272 * MiB;
constexpr size_t WS_BONUS = 1336 * MiB;
constexpr size_t WS_SS = 1337 * MiB;
constexpr size_t WS_YRAWR = WS_H, WS_YRAWW = WS_MRG;
constexpr size_t WS_END = 1341 * MiB;
constexpr int CW_BAR = 4096;

constexpr int PPL = 9;
enum { LP_G1 = 0, LP_PREP, LP_SCAN, LP_POST, LP_GA, LP_GB, LP_GO, LP_GUP, LP_GDN };
constexpr int PH_PRO = 0, PH_L0 = 1, PH_FIN = PH_L0 + DEPTH * PPL, NPH = PH_FIN + 1;

constexpr int RING_OFF = 0, RING_BYTES = 131072;
constexpr int LDSCTL_OFF = RING_BYTES, MISC_OFF = LDSCTL_OFF + 320;
constexpr int LDS_BYTES = 147456;
static_assert(MISC_OFF + 128 <= LDS_BYTES, "LDS map");

#define GAS __attribute__((address_space(1)))
#define LAS __attribute__((address_space(3)))
typedef unsigned short bf16;
typedef unsigned v4u __attribute__((ext_vector_type(4)));
typedef unsigned v2u __attribute__((ext_vector_type(2)));
typedef float f32x4 __attribute__((ext_vector_type(4)));
typedef float f32x2 __attribute__((ext_vector_type(2)));
typedef short bf16x8 __attribute__((ext_vector_type(8)));
typedef GAS unsigned gu32;
#define LDS_WAIT() asm volatile("s_waitcnt lgkmcnt(0)" ::: "memory")
#define VM_WAIT() asm volatile("s_waitcnt vmcnt(0)" ::: "memory")
__device__ __forceinline__ unsigned f2bf(float f) { unsigned u = __builtin_bit_cast(unsigned, f); return (u + 0x7fffu + ((u >> 16) & 1u)) >> 16; }
__device__ __forceinline__ unsigned pk2(float lo, float hi) { return f2bf(lo) | (f2bf(hi) << 16); }
__device__ __forceinline__ float bf2f(bf16 v) { return __builtin_bit_cast(float, (unsigned)v << 16); }
__device__ __forceinline__ float rdlane(float v, int l) { return __builtin_bit_cast(float, __builtin_amdgcn_readlane(__builtin_bit_cast(int, v), l)); }
__device__ __forceinline__ float sigm(float x) { return 1.0f / (1.0f + expf(-x)); }

__device__ const double ROPE_REV[64] = {
0.15915494309189535, 0.13782250260398285, 0.11934937021124886, 0.10335229661843406,
0.08949940160889101, 0.07750328875537406, 0.06711508300522726, 0.058119267441876246,
0.050329212104487035, 0.04358330210530733, 0.03774158471741977, 0.032682865872357,
0.0283021958306234, 0.024508691862069852, 0.02122365276477766, 0.018378926105679667,
0.015915494309189534, 0.013782250260398284, 0.011934937021124886, 0.010335229661843406,
0.008949940160889102, 0.0077503288755374055, 0.006711508300522725, 0.005811926744187624,
0.005032921210448704, 0.004358330210530733, 0.003774158471741977, 0.0032682865872356993,
0.00283021958306234, 0.002450869186206985, 0.0021223652764777662, 0.0018378926105679667,
0.0015915494309189536, 0.0013782250260398288, 0.0011934937021124885, 0.0010335229661843405,
0.0008949940160889102, 0.0007750328875537405, 0.0006711508300522726, 0.0005811926744187624,
0.0005032921210448703, 0.0004358330210530733, 0.00037741584717419774, 0.0003268286587235699,
0.00028302195830623395, 0.00024508691862069854, 0.0002122365276477766, 0.00018378926105679666,
0.00015915494309189535, 0.00013782250260398286, 0.00011934937021124886, 0.00010335229661843406,
8.949940160889102e-05, 7.750328875537406e-05, 6.711508300522725e-05, 5.811926744187624e-05,
5.0329212104487035e-05, 4.358330210530732e-05, 3.774158471741978e-05, 3.2682865872357e-05,
2.8302195830623396e-05, 2.4508691862069852e-05, 2.122365276477766e-05, 1.8378926105679668e-05 };

#define XB_TMO      128
#define XB_XCNT(j)  (256  + 64 * (j))
#define XB_XSUB(j)  (1280 + 64 * (j))
#define XB_XGEN(j)  (2304 + 64 * (j))
#define XB_TOP      3328
#define XB_TOPGEN   3392
#define XCD_BAR_WORDS 3456
#define XB_SPIN_CAP (1u << 18)

__device__ __forceinline__ unsigned xb_ld(unsigned* p)              { return __hip_atomic_load(p, __ATOMIC_RELAXED, __HIP_MEMORY_SCOPE_AGENT); }
__device__ __forceinline__ unsigned xb_add(unsigned* p, unsigned v) { return __hip_atomic_fetch_add(p, v, __ATOMIC_RELAXED, __HIP_MEMORY_SCOPE_AGENT); }
__device__ __forceinline__ unsigned xb_xcc_id() { return (unsigned)__builtin_amdgcn_s_getreg((3 << 11) | 20) & 0xFu; }
#define XB_SPIN(cond, bar) do { unsigned _sp = 0; while (cond) { __builtin_amdgcn_s_sleep(1); \
    if ((++_sp & 255u) == 0u) { if (xb_ld(&(bar)[XB_TMO])) break; if (_sp > XB_SPIN_CAP) { atomicAdd(&(bar)[XB_TMO], 1u); break; } } } } while (0)

struct XcdBarrier {
    unsigned* bar; unsigned x;
    volatile LAS unsigned* st;
};

__device__ __forceinline__ XcdBarrier xcd_barrier_post(unsigned* bar, volatile LAS unsigned* st) {
    XcdBarrier b; b.bar = bar; b.x = xb_xcc_id(); b.st = st;
    if (threadIdx.x == 0) (void)xb_add(&bar[XB_XCNT(b.x)], 1u);
    return b;
}
__device__ __forceinline__ void xcd_barrier_complete(unsigned* bar, unsigned x, unsigned& nloc, unsigned& nx) {
    const unsigned G = gridDim.x * gridDim.y * gridDim.z;
    unsigned sum, cnt, mine, sp = 0u;
    for (;;) {
        sum = 0u; cnt = 0u; mine = 0u;
#pragma unroll
        for (unsigned j = 0; j < 16; ++j) { const unsigned c = xb_ld(&bar[XB_XCNT(j)]); sum += c; cnt += (c > 0u) ? 1u : 0u; mine = (j == x) ? c : mine; }
        if (sum == G) break;
        __builtin_amdgcn_s_sleep(1);
        if ((++sp & 255u) == 0u) { if (xb_ld(&bar[XB_TMO])) break; if (sp > XB_SPIN_CAP) { atomicAdd(&bar[XB_TMO], 1u); break; } }
    }
    nloc = mine > 0u ? mine : 1u; nx = cnt > 0u ? cnt : 1u;
}

__device__ __forceinline__ void xcd_barrier(const XcdBarrier& b) {
    asm volatile("s_waitcnt vmcnt(0)" ::: "memory");
    __syncthreads();
    if (threadIdx.x == 0) {
        unsigned* bar = b.bar;
        __builtin_amdgcn_s_waitcnt(0);
        unsigned nloc = b.st[0], nx = b.st[1];
        if (nloc == 0u) { xcd_barrier_complete(bar, b.x, nloc, nx); b.st[0] = nloc; b.st[1] = nx; }
        const unsigned old = xb_add(&bar[XB_XSUB(b.x)], 1u);
        const unsigned gen = old / nloc;
        if (old + 1u == (gen + 1u) * nloc) {
            __builtin_amdgcn_fence(__ATOMIC_RELEASE, "agent");
            asm volatile("s_waitcnt vmcnt(0)" ::: "memory");
            const unsigned og = xb_add(&bar[XB_TOP], 1u);
            const unsigned tg = og / nx;
            if (og + 1u == (tg + 1u) * nx) xb_add(&bar[XB_TOPGEN], 1u);
            else XB_SPIN(xb_ld(&bar[XB_TOPGEN]) == tg, bar);
            __builtin_amdgcn_fence(__ATOMIC_ACQUIRE, "agent");
            xb_add(&bar[XB_XGEN(b.x)], 1u);
            asm volatile("s_waitcnt vmcnt(0)" ::: "memory");
        } else {
            XB_SPIN(xb_ld(&bar[XB_XGEN(b.x)]) == gen, bar);
            __builtin_amdgcn_fence(__ATOMIC_ACQUIRE, "agent");
            asm volatile("s_waitcnt vmcnt(0)" ::: "memory");
        }
    }
    __syncthreads();
}


struct Frame {
    LAS unsigned char* lds;
    volatile LAS unsigned* MISC;
    int tid, lane, wave;
    int vcu, G;
    float* out; unsigned char* ws;
};
struct Args { const float* in[24]; float* out; unsigned char* ws; int ph_lo, ph_hi, li, pad; };
#define WSP(T, off) ((T*)(F.ws + (off)))
#define WSPG(T, off) ((T*)(GAS T*)(unsigned long long)(F.ws + (off)))
#define WSW(l, off) ((bf16*)(F.ws + WS_WSET + (size_t)((l) & 1) * WSET_BYTES + (off)))
#define WSWG(l, off) ((bf16*)(GAS bf16*)(unsigned long long)(F.ws + WS_WSET + (size_t)((l) & 1) * WSET_BYTES + (off)))
#define OUTP ((float*)F.out)
#define OUTPG ((float*)(GAS float*)(unsigned long long)F.out)
#define INP(A, i) ((const float*)((const GAS float*)(A)->in[i]))
#define RETID() do { int t_ = threadIdx.x; asm volatile("" : "+v"(t_)); F.tid = t_; F.lane = t_ & 63; } while (0)
#define CAS __attribute__((address_space(4)))
typedef const CAS Args* ArgP;

__device__ __forceinline__ float fexp(float x) { return __builtin_amdgcn_exp2f(x * 1.4426950408889634f); }
__device__ __forceinline__ float fsig(float x) { return __builtin_amdgcn_rcpf(1.0f + fexp(-x)); }
__device__ __forceinline__ float ftanh(float x) { return 1.0f - 2.0f * __builtin_amdgcn_rcpf(1.0f + fexp(2.0f * x)); }
__device__ __forceinline__ float wave_sum(float v) {
#pragma unroll
    for (int o = 1; o < 64; o <<= 1) v += __shfl_xor(v, o);
    return v;
}
struct TItem { const float* W; bf16* WT; const float* gk; int K, N, item; };
__device__ __forceinline__ void titem_load(const TItem& t, int lane, f32x4 (&v)[8]) {
    const int nblk = t.N / 32, kb = t.item / nblk, nb = t.item % nblk, k0 = 64 * kb, n0 = 32 * nb, nq = lane & 7, kr = lane >> 3;
#pragma unroll
    for (int i = 0; i < 8; ++i) v[i] = *(const GAS f32x4*)(t.W + (size_t)(k0 + kr + 8 * i) * t.N + n0 + 4 * nq);
}
__device__ __forceinline__ void titem_finish(const TItem& t, int lane, const f32x4 (&v)[8], LAS float* scr) {
    const int nblk = t.N / 32, kb = t.item / nblk, nb = t.item % nblk, k0 = 64 * kb, n0 = 32 * nb, nq = lane & 7, kr = lane >> 3;
#pragma unroll
    for (int i = 0; i < 8; ++i)
#pragma unroll
        for (int e = 0; e < 4; ++e) scr[(kr + 8 * i) * 33 + 4 * nq + e] = v[i][e];
    const int c = lane & 7;
    f32x4 g0 = (f32x4){1.f, 1.f, 1.f, 1.f}, g1 = g0;
    if (t.gk) { g0 = *(const GAS f32x4*)(t.gk + k0 + 8 * c); g1 = *(const GAS f32x4*)(t.gk + k0 + 8 * c + 4); }
    LDS_WAIT(); asm volatile("" ::: "memory");
#pragma unroll
    for (int j = 0; j < 4; ++j) { const int n = (lane >> 3) + 8 * j; const LAS float* s = scr + (8 * c) * 33 + n;
        v4u o; o.x = pk2(s[0 * 33] * g0.x, s[1 * 33] * g0.y); o.y = pk2(s[2 * 33] * g0.z, s[3 * 33] * g0.w); o.z = pk2(s[4 * 33] * g1.x, s[5 * 33] * g1.y); o.w = pk2(s[6 * 33] * g1.z, s[7 * 33] * g1.w);
        *(GAS v4u*)(t.WT + (size_t)(n0 + n) * t.K + k0 + 8 * c) = o; }
    LDS_WAIT(); asm volatile("" ::: "memory");
}
__device__ __forceinline__ void rms_row_to_bf16(const float* xrow, const float* g, bf16* orow, int lane) {
    const GAS f32x4* xr = (const GAS f32x4*)xrow + lane;
    f32x4 v[8]; float s = 0.f;
#pragma unroll
    for (int j = 0; j < 8; ++j) { v[j] = xr[64 * j]; s += (v[j].x * v[j].x + v[j].y * v[j].y) + (v[j].z * v[j].z + v[j].w * v[j].w); }
    const float rstd = 1.f / sqrtf(wave_sum(s) * (1.f / D) + NORM_EPS);
    const GAS f32x4* gr = (const GAS f32x4*)g + lane;
    GAS v2u* o8 = (GAS v2u*)orow + lane;
#pragma unroll
    for (int j = 0; j < 8; ++j) { const f32x4 gg = gr[64 * j]; v2u o; o.x = pk2(v[j].x * rstd * gg.x, v[j].y * rstd * gg.y); o.y = pk2(v[j].z * rstd * gg.z, v[j].w * rstd * gg.w); o8[64 * j] = o; }
}

#if (MK_GLOBAL_GROUPS & 1)
#pragma push_macro("WSP")
#pragma push_macro("WSW")
#pragma push_macro("OUTP")
#undef WSP
#undef WSW
#undef OUTP
#define WSP WSPG
#define WSW WSWG
#define OUTP OUTPG
#endif
__device__ __forceinline__ void ph_prologue(Frame& F, ArgP A) {
    const int* pos = (const int*)INP(A, 1); float2* rope = WSP(float2, WS_ROPE);
    {
        const int gw = F.vcu * NWAVES + F.wave, NGW = F.G * NWAVES, lane = F.lane;
        for (int m = gw; m < M; m += NGW) {
            const GAS f32x4* xr = (const GAS f32x4*)(INP(A, 0) + (size_t)m * D) + lane;
            GAS v2u* hb = (GAS v2u*)(WSP(bf16, WS_H) + (size_t)m * D) + lane; float s = 0.f;
#pragma unroll
            for (int j = 0; j < 8; ++j) { const f32x4 v = xr[64 * j]; v2u o; o.x = pk2(v.x, v.y); o.y = pk2(v.z, v.w); hb[64 * j] = o; s += (v.x * v.x + v.y * v.y) + (v.z * v.z + v.w * v.w); }
            s = wave_sum(s);
            if (lane < 32) WSP(float, WS_SS)[(size_t)m * 32 + lane] = lane == 0 ? s : 0.f;
        }
    }
    for (int i = F.vcu * 512 + F.tid; i < M * 64; i += F.G * 512) {
        const int m = i >> 6, j = i & 63;
        const double rev = (double)pos[m] * ROPE_REV[j];
        const float fr = (float)(rev - __builtin_rint(rev));
        rope[i] = make_float2(__builtin_amdgcn_cosf(fr), __builtin_amdgcn_sinf(fr));
    }
}
#if (MK_GLOBAL_GROUPS & 1)
#pragma pop_macro("WSP")
#pragma pop_macro("WSW")
#pragma pop_macro("OUTP")
#endif
#if (MK_GLOBAL_GROUPS & 16)
#pragma push_macro("WSP")
#pragma push_macro("WSW")
#pragma push_macro("OUTP")
#undef WSP
#undef WSW
#undef OUTP
#define WSP WSPG
#define WSW WSWG
#define OUTP OUTPG
#endif
__device__ __forceinline__ TItem conv_item(Frame& F, ArgP A, int l, int it) {
    constexpr int I_IN = (D / 64) * (INW / 32), I_A = (RETW / 64) * (D / 32), I_O = (D / 64) * (D / 32), I_UP = (D / 64) * (DFF / 32), I_DN = (DFF / 64) * (D / 32);
    int r = it; TItem t;
    if (r < I_IN) { t = TItem{INP(A, 3) + (size_t)l * D * INW, WSW(l, WO_WIN), INP(A, 2) + (size_t)l * D, D, INW, r}; return t; } r -= I_IN;
    if (r < I_A) { t = TItem{INP(A, 17) + (size_t)l * RETW * D, WSW(l, WO_WA), nullptr, RETW, D, r}; return t; } r -= I_A;
    if (r < I_A) { t = TItem{INP(A, 18) + (size_t)l * RWW * D, WSW(l, WO_WB), nullptr, RWW, D, r}; return t; } r -= I_A;
    if (r < I_O) { t = TItem{INP(A, 19) + (size_t)l * D * D, WSW(l, WO_WO), nullptr, D, D, r}; return t; } r -= I_O;
    if (r < I_UP) { t = TItem{INP(A, 21) + (size_t)l * D * DFF, WSW(l, WO_WUP), INP(A, 20) + (size_t)l * D, D, DFF, r}; return t; } r -= I_UP;
    if (r < I_DN) { t = TItem{INP(A, 22) + (size_t)l * DFF * D, WSW(l, WO_WDN), nullptr, DFF, D, r}; return t; } r -= I_DN;
    if (r < 32) { t = TItem{INP(A, 8) + (size_t)l * 64 * RWW, WSW(l, WO_LORA), nullptr, 64, RWW, r}; return t; } r -= 32;
    if (r < 32) { t = TItem{INP(A, 10) + (size_t)l * 64 * RWW, WSW(l, WO_LORA) + 1024 * 64, nullptr, 64, RWW, r}; return t; } r -= 32;
    t = TItem{INP(A, 11) + (size_t)l * 128 * RWW, WSW(l, WO_LORA) + 2 * 1024 * 64, nullptr, 128, RWW, r}; return t;
}
__device__ __forceinline__ void ph_convert(Frame& F, ArgP A, int l, int wg, int nwg) {
    LAS float* scr = (LAS float*)(F.lds + RING_OFF + F.wave * 16384);
    const int gw = wg * NWAVES + F.wave, NGW = nwg * NWAVES, lane = F.lane;
    constexpr int I_IN = (D / 64) * (INW / 32), I_A = (RETW / 64) * (D / 32), I_O = (D / 64) * (D / 32), I_UP = (D / 64) * (DFF / 32), I_DN = (DFF / 64) * (D / 32);
    constexpr int NITEMS = I_IN + 2 * I_A + I_O + I_UP + I_DN + 32 + 32 + 64;
    if (gw >= NITEMS) return;
    TItem cur = conv_item(F, A, l, gw); f32x4 va[8], vb[8];
    titem_load(cur, lane, va);
    for (int it = gw; it < NITEMS; it += 2 * NGW) {
        TItem nxt = cur; const bool h1 = it + NGW < NITEMS;
        if (h1) { nxt = conv_item(F, A, l, it + NGW); titem_load(nxt, lane, vb); }
        titem_finish(cur, lane, va, scr);
        if (!h1) break;
        const bool h2 = it + 2 * NGW < NITEMS;
        if (h2) { cur = conv_item(F, A, l, it + 2 * NGW); titem_load(cur, lane, va); }
        titem_finish(nxt, lane, vb, scr);
        if (!h2) break;
    }
}
__device__ __forceinline__ void ph_norm(Frame& F, const float* g) {
    const int gw = F.vcu * NWAVES + F.wave, NGW = F.G * NWAVES;
    for (int m = gw; m < M; m += NGW) rms_row_to_bf16(OUTP + (size_t)m * D, g, WSP(bf16, WS_H) + (size_t)m * D, F.lane);
}
#if (MK_GLOBAL_GROUPS & 16)
#pragma pop_macro("WSP")
#pragma pop_macro("WSW")
#pragma pop_macro("OUTP")
#endif
#if (MK_GLOBAL_GROUPS & 2)
#pragma push_macro("WSP")
#pragma push_macro("WSW")
#pragma push_macro("OUTP")
#undef WSP
#undef WSW
#undef OUTP
#define WSP WSPG
#define WSW WSWG
#define OUTP OUTPG
#endif
__device__ __forceinline__ f32x4 unpk4(const v2u p) { return (f32x4){pg8::bf_lo(p.x), pg8::bf_hi(p.x), pg8::bf_lo(p.y), pg8::bf_hi(p.y)}; }
__device__ __forceinline__ void unpack8(const v4u a, float (&o)[8]) {
    o[0] = pg8::bf_lo(a.x); o[1] = pg8::bf_hi(a.x); o[2] = pg8::bf_lo(a.y); o[3] = pg8::bf_hi(a.y); o[4] = pg8::bf_lo(a.z); o[5] = pg8::bf_hi(a.z); o[6] = pg8::bf_lo(a.w); o[7] = pg8::bf_hi(a.w);
}
__device__ __forceinline__ void mix8(const GAS bf16* zc, bool has_prev, const GAS float* mu, float (&o)[8]) {
    const v4u a = *(const GAS v4u*)zc; v4u p = (v4u){0u, 0u, 0u, 0u}; if (has_prev) p = *(const GAS v4u*)(zc - INW);
    const f32x4 m0 = *(const GAS f32x4*)mu, m1 = *(const GAS f32x4*)(mu + 4);
    float z[8], q[8]; unpack8(a, z); unpack8(p, q);
#pragma unroll
    for (int j = 0; j < 4; ++j) { o[j] = z[j] + m0[j] * (q[j] - z[j]); o[4 + j] = z[4 + j] + m1[j] * (q[4 + j] - z[4 + j]); }
}
__device__ __forceinline__ f32x4 mix4(const GAS bf16* zc, bool has_prev, const GAS float* mu) {
    const v2u a = *(const GAS v2u*)zc; v2u p = (v2u){0u, 0u}; if (has_prev) p = *(const GAS v2u*)(zc - INW);
    const f32x4 m = *(const GAS f32x4*)mu;
    const f32x4 z = (f32x4){pg8::bf_lo(a.x), pg8::bf_hi(a.x), pg8::bf_lo(a.y), pg8::bf_hi(a.y)}, q = (f32x4){pg8::bf_lo(p.x), pg8::bf_hi(p.x), pg8::bf_lo(p.y), pg8::bf_hi(p.y)};
    return z + m * (q - z);
}
__device__ __forceinline__ bf16x8 pack8(const float (&v)[8]) {
    v4u o; o.x = pg8::cvt_pk_bf16(v[0], v[1]); o.y = pg8::cvt_pk_bf16(v[2], v[3]); o.z = pg8::cvt_pk_bf16(v[4], v[5]); o.w = pg8::cvt_pk_bf16(v[6], v[7]);
    return __builtin_bit_cast(bf16x8, o);
}
constexpr int CU_BYTES = 20480, CU_M = 0, CU_OM = 8192, CU_QB = 10240, CU_QSTR = 2560;
constexpr int CK = 16, NCHUNK = SEQ / CK;
constexpr int XL_STR = 144, XL_MAT = 16 * XL_STR;
typedef short s4v __attribute__((ext_vector_type(4)));
__device__ __forceinline__ s4v pk4(const f32x4 v) { v2u o; o.x = pg8::cvt_pk_bf16(v[0], v[1]); o.y = pg8::cvt_pk_bf16(v[2], v[3]); return __builtin_bit_cast(s4v, o); }
__device__ __forceinline__ bf16x8 pk8v(const f32x4 a, const f32x4 b) { v4u o; o.x = pg8::cvt_pk_bf16(a[0], a[1]); o.y = pg8::cvt_pk_bf16(a[2], a[3]); o.z = pg8::cvt_pk_bf16(b[0], b[1]); o.w = pg8::cvt_pk_bf16(b[2], b[3]); return __builtin_bit_cast(bf16x8, o); }
__device__ __forceinline__ f32x4 mma16(const s4v x, const s4v y, const f32x4 c) {
    const bf16x8 x8 = (bf16x8){x.x, x.y, x.z, x.w, 0, 0, 0, 0}, y8 = (bf16x8){y.x, y.y, y.z, y.w, 0, 0, 0, 0};
    return __builtin_amdgcn_mfma_f32_16x16x32_bf16(x8, y8, c, 0, 0, 0); }
__device__ __forceinline__ f32x4 mma32(const bf16x8 x, const bf16x8 y, const f32x4 c) { return __builtin_amdgcn_mfma_f32_16x16x32_bf16(x, y, c, 0, 0, 0); }
template <int N> __device__ __forceinline__ float dpp_shr0(float x) { return __builtin_bit_cast(float, __builtin_amdgcn_update_dpp(0, __builtin_bit_cast(int, x), 0x110 + N, 0xF, 0xF, true)); }
__device__ __forceinline__ float scan16(float x) { x += dpp_shr0<1>(x); x += dpp_shr0<2>(x); x += dpp_shr0<4>(x); x += dpp_shr0<8>(x); return x; }
__device__ __forceinline__ s4v trd(const LAS unsigned char* p) { return __builtin_amdgcn_ds_read_tr16_b64_v4i16((LAS s4v*)p); }
__device__ __forceinline__ void chunk_ops(const f32x4 (&r)[4], const f32x4 (&lw)[4], const f32x4 (&kp)[4], const f32x4 (&v)[4], const f32x4 (&a)[4], const f32x4 (&b)[4],
                                          LAS unsigned char* scr, GAS unsigned char* rec, int lane) {
    const int l15 = lane & 15, g = lane >> 4, tq = l15 >> 2, tp = l15 & 3;
    const f32x4 Z4 = (f32x4){0.f, 0.f, 0.f, 0.f};
    f32x4 Rt[4], pc[4]; bf16x8 Atf[2], Btf[2], Ktf[2], Rtf[2];
    {
        s4v Ah[4], Bq[4], Kq[4], Rq[4];
#pragma unroll
        for (int nt = 0; nt < 4; ++nt) {
            f32x4 cs, tot;
#pragma unroll
            for (int i = 0; i < 4; ++i) { cs[i] = scan16(lw[nt][i]); tot[i] = __shfl(cs[i], lane | 15); }
            f32x4 At, Bt, Kt, Bh, Kh;
#pragma unroll
            for (int i = 0; i < 4; ++i) { const float P = fexp(cs[i]), Pm1 = fexp(cs[i] - lw[nt][i]), iP = fexp(-cs[i]), PCP = fexp(tot[i] - cs[i]);
                pc[nt][i] = fexp(tot[i]); At[i] = a[nt][i] * Pm1; Bt[i] = b[nt][i] * iP; Kt[i] = kp[nt][i] * iP; Rt[nt][i] = r[nt][i] * P; Bh[i] = b[nt][i] * PCP; Kh[i] = kp[nt][i] * PCP; }
            Ah[nt] = pk4(At); Bq[nt] = pk4(Bt); Kq[nt] = pk4(Kt); Rq[nt] = pk4(Rt[nt]);
            LAS unsigned char* w = scr + l15 * XL_STR + (16 * nt + 4 * g) * 2;
            *(LAS s4v*)(w + 0 * XL_MAT) = Ah[nt]; *(LAS s4v*)(w + 1 * XL_MAT) = pk4(v[nt]); *(LAS s4v*)(w + 2 * XL_MAT) = pk4(Bh); *(LAS s4v*)(w + 3 * XL_MAT) = pk4(Kh);
        }
#pragma unroll
        for (int s = 0; s < 2; ++s) {
            Atf[s] = (bf16x8){Ah[2 * s].x, Ah[2 * s].y, Ah[2 * s].z, Ah[2 * s].w, Ah[2 * s + 1].x, Ah[2 * s + 1].y, Ah[2 * s + 1].z, Ah[2 * s + 1].w};
            Btf[s] = (bf16x8){Bq[2 * s].x, Bq[2 * s].y, Bq[2 * s].z, Bq[2 * s].w, Bq[2 * s + 1].x, Bq[2 * s + 1].y, Bq[2 * s + 1].z, Bq[2 * s + 1].w};
            Ktf[s] = (bf16x8){Kq[2 * s].x, Kq[2 * s].y, Kq[2 * s].z, Kq[2 * s].w, Kq[2 * s + 1].x, Kq[2 * s + 1].y, Kq[2 * s + 1].z, Kq[2 * s + 1].w};
            Rtf[s] = (bf16x8){Rq[2 * s].x, Rq[2 * s].y, Rq[2 * s].z, Rq[2 * s].w, Rq[2 * s + 1].x, Rq[2 * s + 1].y, Rq[2 * s + 1].z, Rq[2 * s + 1].w}; }
    }
    f32x4 LabR = Z4, LabT = Z4, LakT = Z4, LrbT = Z4, LrkT = Z4;
#pragma unroll
    for (int s = 0; s < 2; ++s) { LabR = mma32(Atf[s], Btf[s], LabR); LabT = mma32(Btf[s], Atf[s], LabT); LakT = mma32(Ktf[s], Atf[s], LakT); LrbT = mma32(Btf[s], Rtf[s], LrbT); LrkT = mma32(Ktf[s], Rtf[s], LrkT); }
    f32x4 IR;
#pragma unroll
    for (int i = 0; i < 4; ++i) { const int tt = 4 * g + i;
        IR[i] = (tt == l15) ? 1.f : 0.f;
        LabR[i] = (tt > l15) ? LabR[i] : 0.f; LabT[i] = (l15 > tt) ? LabT[i] : 0.f; LakT[i] = (l15 > tt) ? LakT[i] : 0.f;
        LrbT[i] = (l15 >= tt) ? LrbT[i] : 0.f; LrkT[i] = (l15 >= tt) ? LrkT[i] : 0.f; }
    const s4v L1R = pk4(LabR), L1T = pk4(LabT);
    const f32x4 L2R = mma16(L1T, L1R, Z4), L2T = mma16(L1R, L1T, Z4);
    const s4v L2Rp = pk4(L2R), L2Tp = pk4(L2T);
    const f32x4 L4R = mma16(L2Tp, L2Rp, Z4), L4T = mma16(L2Rp, L2Tp, Z4);
    const s4v L4Rp = pk4(L4R), L4Tp = pk4(L4T);
    const f32x4 L8R = mma16(L4Tp, L4Rp, Z4);
    const f32x4 T1T = mma16(pk4(IR + L2R), pk4(IR + LabT), Z4);
    const f32x4 T2T = mma16(pk4(IR + L4R), pk4(T1T), Z4);
    const s4v TmT = pk4(mma16(pk4(IR + L8R), pk4(T2T), Z4));
    const s4v LakTp = pk4(LakT), LrbTp = pk4(LrbT), LrkTp = pk4(LrkT);
    asm volatile("s_waitcnt lgkmcnt(0)" ::: "memory");
    const LAS unsigned char* tb = scr + (4 * g + tq) * XL_STR + (4 * tp) * 2;
    s4v tAt[4], tV[4], tBh[4], tKh[4];
#pragma unroll
    for (int t = 0; t < 4; ++t) { tAt[t] = trd(tb + 0 * XL_MAT + 32 * t); tV[t] = trd(tb + 1 * XL_MAT + 32 * t); tBh[t] = trd(tb + 2 * XL_MAT + 32 * t); tKh[t] = trd(tb + 3 * XL_MAT + 32 * t); }
    s4v Wp[4], U0p[4];
#pragma unroll
    for (int t = 0; t < 4; ++t) { Wp[t] = pk4(mma16(TmT, tAt[t], Z4));
        const f32x4 G = mma16(LakTp, tV[t], Z4);
        const f32x4 U0 = mma16(TmT, pk4(G), Z4); U0p[t] = pk4(U0);
        f32x4 Y0 = mma16(LrbTp, U0p[t], Z4); Y0 = mma16(LrkTp, tV[t], Y0);
        *(GAS s4v*)(rec + CU_QB + t * CU_QSTR + 2048 + lane * 8) = pk4(Y0); }
    {
        f32x4 Om[4];
#pragma unroll
        for (int ct = 0; ct < 4; ++ct) Om[ct] = mma16(Wp[ct], LrbTp, Rt[ct]);
        *(GAS bf16x8*)(rec + CU_OM + 0 * 1024 + lane * 16) = pk8v(Om[0], Om[1]); *(GAS bf16x8*)(rec + CU_OM + 1 * 1024 + lane * 16) = pk8v(Om[2], Om[3]);
    }
#pragma unroll
    for (int tl = 0; tl < 4; ++tl) {
        f32x4 Mt[4];
#pragma unroll
        for (int kt = 0; kt < 4; ++kt) { Mt[kt] = mma16(Wp[kt], tBh[tl], Z4);
            if (kt == tl) {
#pragma unroll
                for (int i = 0; i < 4; ++i) Mt[kt][i] += (4 * g + i == l15) ? pc[kt][i] : 0.f; } }
        *(GAS bf16x8*)(rec + CU_M + (tl * 2 + 0) * 1024 + lane * 16) = pk8v(Mt[0], Mt[1]); *(GAS bf16x8*)(rec + CU_M + (tl * 2 + 1) * 1024 + lane * 16) = pk8v(Mt[2], Mt[3]);
    }
#pragma unroll
    for (int q = 0; q < 4; ++q)
#pragma unroll
        for (int tl = 0; tl < 4; ++tl) { f32x4 Nt = mma16(tBh[tl], U0p[q], Z4); Nt = mma16(tKh[tl], tV[q], Nt);
            *(GAS s4v*)(rec + CU_QB + q * CU_QSTR + tl * 512 + lane * 8) = pk4(Nt); }
}
__device__ __forceinline__ void ph_prep(Frame& F, ArgP A, int l) {
    const int gw = F.vcu * NWAVES + F.wave, NGW = F.G * NWAVES, lane = F.lane, l15 = lane & 15, g = lane >> 4;
    {
        const int h = lane >> 3, i0 = 8 * (lane & 7);
        int nrr_ = (MK_REP & 1024) ? 2 : 1; asm volatile("" : "+s"(nrr_));
#pragma unroll 1
        for (int rr_ = 0; rr_ < nrr_; ++rr_)
        for (int m = gw; m < M; m += NGW) {
            const GAS bf16* zrow = (const GAS bf16*)(WSP(bf16, WS_Z) + (size_t)m * INW);
            const GAS f32x4* rp = (const GAS f32x4*)(WSP(float2, WS_ROPE) + (size_t)m * 64 + i0);
            const f32x4 c01 = rp[0], c23 = rp[1], c45 = rp[2], c67 = rp[3];
            const float cs[8] = {c01.x, c01.z, c23.x, c23.z, c45.x, c45.z, c67.x, c67.z}, sn[8] = {c01.y, c01.w, c23.y, c23.w, c45.y, c45.w, c67.y, c67.w};
            float q1[8], q2[8], k1[8], k2[8], o1[8], o2[8];
            unpack8(*(const GAS v4u*)(zrow + ZC_Q + h * RD + i0), q1); unpack8(*(const GAS v4u*)(zrow + ZC_Q + h * RD + 64 + i0), q2);
            unpack8(*(const GAS v4u*)(zrow + ZC_K + h * RD + i0), k1); unpack8(*(const GAS v4u*)(zrow + ZC_K + h * RD + 64 + i0), k2);
#pragma unroll
            for (int j = 0; j < 8; ++j) { o1[j] = q1[j] * cs[j] - q2[j] * sn[j]; o2[j] = q2[j] * cs[j] + q1[j] * sn[j]; }
            GAS bf16* qo = (GAS bf16*)(WSP(bf16, WS_QR) + (size_t)m * RETW + h * RD + i0);
            *(GAS bf16x8*)qo = pack8(o1); *(GAS bf16x8*)(qo + 64) = pack8(o2);
#pragma unroll
            for (int j = 0; j < 8; ++j) { const float a = k1[j] * 0.08838834764831845f, b = k2[j] * 0.08838834764831845f; o1[j] = a * cs[j] - b * sn[j]; o2[j] = b * cs[j] + a * sn[j]; }
            GAS bf16* ko = (GAS bf16*)(WSP(bf16, WS_KR) + (size_t)m * RETW + h * RD + i0);
            *(GAS bf16x8*)ko = pack8(o1); *(GAS bf16x8*)(ko + 64) = pack8(o2);
        }
    }
    const GAS float* mu = (const GAS float*)(INP(A, 6) + (size_t)l * RWSHIFT);
    const GAS float* w0 = (const GAS float*)(INP(A, 7) + (size_t)l * RWW); const GAS float* a0 = (const GAS float*)(INP(A, 9) + (size_t)l * RWW);
    const GAS float* kkw = (const GAS float*)(INP(A, 12) + (size_t)l * RWW); const GAS float* kaw = (const GAS float*)(INP(A, 13) + (size_t)l * RWW); const GAS float* rkw = (const GAS float*)(INP(A, 14) + (size_t)l * RWW);
    const GAS bf16* WupT = (const GAS bf16*)WSW(l, WO_LORA); const GAS bf16* AupT = WupT + 1024 * 64; const GAS bf16* GupT = AupT + 1024 * 64;
    constexpr int PP_OFF = 8 * 10240;
    LAS float* PP = (LAS float*)(F.lds + RING_OFF + PP_OFF);
    __syncthreads();
    for (int i = F.tid; i < 2048; i += NWAVES * 64) { const int arr = i >> 8, off = (i & 255) * 4;
        const GAS float* src = arr < 3 ? mu + arr * 1024 : (arr == 3 ? w0 : (arr == 4 ? a0 : (arr == 5 ? kkw : (arr == 6 ? kaw : rkw))));
        *(LAS f32x4*)(PP + arr * 1024 + off) = *(const GAS f32x4*)(src + off); }
    __syncthreads();
    int nrw_ = (MK_REP & 2048) ? 2 : 1; asm volatile("" : "+s"(nrw_));
#pragma unroll 1
    for (int rw_ = 0; rw_ < nrw_; ++rw_)
    for (int task = gw; task < M / 8; task += NGW) {
        const int m = (task >> 1) * 16 + l15, hh0 = (task & 1) * (WH / 2);
        const bool has_prev = (m % SEQ) != 0;
        const GAS bf16* zr = (const GAS bf16*)(WSP(bf16, WS_Z) + (size_t)m * INW + ZC_RW);
        bf16x8 fw[2], fa[2], fg[4];
#pragma unroll
        for (int ks = 0; ks < 2; ++ks) { float t[8];
            mix8(zr + RWC_W + 32 * ks + 8 * g, has_prev, mu + RWC_W + 32 * ks + 8 * g, t);
#pragma unroll
            for (int j = 0; j < 8; ++j) t[j] = ftanh(t[j]);
            fw[ks] = pack8(t);
            mix8(zr + RWC_A + 32 * ks + 8 * g, has_prev, mu + RWC_A + 32 * ks + 8 * g, t); fa[ks] = pack8(t); }
#pragma unroll
        for (int ks = 0; ks < 4; ++ks) { float t[8];
            mix8(zr + RWC_G + 32 * ks + 8 * g, has_prev, mu + RWC_G + 32 * ks + 8 * g, t);
#pragma unroll
            for (int j = 0; j < 8; ++j) t[j] = fsig(t[j]);
            fg[ks] = pack8(t); }
        const GAS bf16* zq = has_prev ? zr - INW : zr;
        for (int hh = hh0; hh < hh0 + WH / 2; ++hh) {
            f32x4 kkr[4], av[4], rr[4], lwv[4], kpv[4], vv[4]; float ss = 0.f, bonus = 0.f;
            const int cb = hh * WD + 4 * g;
            {
                v2u zc[3][4], zp[3][4];
#pragma unroll
                for (int a3 = 0; a3 < 3; ++a3)
#pragma unroll
                    for (int nt = 0; nt < 4; ++nt) { zc[a3][nt] = *(const GAS v2u*)(zr + a3 * 1024 + cb + 16 * nt); zp[a3][nt] = *(const GAS v2u*)(zq + a3 * 1024 + cb + 16 * nt); }
#pragma unroll
                for (int nt = 0; nt < 4; ++nt) {
#pragma unroll
                    for (int a3 = 0; a3 < 3; ++a3) { const f32x4 z = unpk4(zc[a3][nt]); f32x4 p = unpk4(zp[a3][nt]); if (!has_prev) p = (f32x4){0.f, 0.f, 0.f, 0.f};
                        const f32x4 mx = z + *(const LAS f32x4*)(PP + a3 * 1024 + cb + 16 * nt) * (p - z);
                        if (a3 == 0) rr[nt] = mx; else if (a3 == 1) kpv[nt] = mx; else vv[nt] = mx; }
                }
            }
            bf16x8 wf[2][2], af[2][2], gf[2][4];
#define PREP_WFRAGS(nt_, k_) do { const int cf_ = hh * WD + (nt_) * 16 + l15; \
            _Pragma("unroll") for (int ks = 0; ks < 2; ++ks) { wf[k_][ks] = *(const GAS bf16x8*)(WupT + (size_t)cf_ * 64 + 32 * ks + 8 * g); af[k_][ks] = *(const GAS bf16x8*)(AupT + (size_t)cf_ * 64 + 32 * ks + 8 * g); } \
            _Pragma("unroll") for (int ks = 0; ks < 4; ++ks) gf[k_][ks] = *(const GAS bf16x8*)(GupT + (size_t)cf_ * 128 + 32 * ks + 8 * g); } while (0)
            PREP_WFRAGS(0, 0);
#pragma unroll
            for (int nt = 0; nt < 4; ++nt) {
                const int c0 = cb + 16 * nt, cs_ = nt & 1;
                if (nt + 1 < 4) PREP_WFRAGS(nt + 1, (cs_ ^ 1));
                f32x4 wl = *(const LAS f32x4*)(PP + 3 * 1024 + c0), al = *(const LAS f32x4*)(PP + 4 * 1024 + c0), gl = (f32x4){0.f, 0.f, 0.f, 0.f};
#pragma unroll
                for (int ks = 0; ks < 2; ++ks) { wl = __builtin_amdgcn_mfma_f32_16x16x32_bf16(wf[cs_][ks], fw[ks], wl, 0, 0, 0); al = __builtin_amdgcn_mfma_f32_16x16x32_bf16(af[cs_][ks], fa[ks], al, 0, 0, 0); }
#pragma unroll
                for (int ks = 0; ks < 4; ++ks) gl = __builtin_amdgcn_mfma_f32_16x16x32_bf16(gf[cs_][ks], fg[ks], gl, 0, 0, 0);
                const f32x4 r = rr[nt], k = kpv[nt], v = vv[nt];
                const f32x4 kk4 = *(const LAS f32x4*)(PP + 5 * 1024 + c0), ka4 = *(const LAS f32x4*)(PP + 6 * 1024 + c0), rk4 = *(const LAS f32x4*)(PP + 7 * 1024 + c0);
                f32x4 lwd, a, kp;
#pragma unroll
                for (int i = 0; i < 4; ++i) {
                    lwd[i] = -0.6065306597126334f * fsig(wl[i]);
                    a[i] = fsig(al[i]);
                    kp[i] = k[i] * (1.0f + (a[i] - 1.0f) * ka4[i]);
                }
                kkr[nt] = k * kk4; av[nt] = a; lwv[nt] = lwd; kpv[nt] = kp;
                ss += (kkr[nt].x * kkr[nt].x + kkr[nt].y * kkr[nt].y) + (kkr[nt].z * kkr[nt].z + kkr[nt].w * kkr[nt].w);
                const f32x4 rb = r * kp * rk4; bonus += (rb.x + rb.y) + (rb.z + rb.w);
                const size_t o = (size_t)m * RWW + c0;
#if MK_CHUNKED
                *(GAS s4v*)(WSP(bf16, WS_SV) + o) = pk4(v); *(GAS s4v*)(WSP(bf16, WS_G) + o) = pk4(gl);
#else
                f32x4 decay;
#pragma unroll
                for (int i = 0; i < 4; ++i) decay[i] = fexp(lwd[i]);
                *(GAS f32x4*)(WSP(float, WS_SR) + o) = r; *(GAS f32x4*)(WSP(float, WS_SW) + o) = decay; *(GAS f32x4*)(WSP(float, WS_SK) + o) = kp;
                *(GAS f32x4*)(WSP(float, WS_SV) + o) = v; *(GAS f32x4*)(WSP(float, WS_G) + o) = gl;
#endif
            }
#undef PREP_WFRAGS
            ss += __shfl_xor(ss, 16); ss += __shfl_xor(ss, 32); bonus += __shfl_xor(bonus, 16); bonus += __shfl_xor(bonus, 32);
            const float inv = 1.0f / fmaxf(sqrtf(ss), 1e-12f);
            if (g == 0) WSP(float, WS_BONUS)[(size_t)m * WH + hh] = bonus;
#if MK_CHUNKED
            f32x4 aa[4], bb[4];
#pragma unroll
            for (int nt = 0; nt < 4; ++nt) { const f32x4 kk = kkr[nt] * inv; aa[nt] = -kk; bb[nt] = kk * av[nt]; }
            const int tile = task >> 1;
            GAS unsigned char* rec = (GAS unsigned char*)WSP(unsigned char, WS_CU) + ((size_t)((tile / NCHUNK) * WH + hh) * NCHUNK + (tile % NCHUNK)) * CU_BYTES;
            chunk_ops(rr, lwv, kpv, vv, aa, bb, F.lds + RING_OFF + F.wave * 10240, rec, lane);
#else
#pragma unroll
            for (int nt = 0; nt < 4; ++nt) { const size_t o = (size_t)m * RWW + hh * WD + nt * 16 + 4 * g; const f32x4 kk = kkr[nt] * inv;
                *(GAS f32x4*)(WSP(float, WS_SNKK) + o) = -kk; *(GAS f32x4*)(WSP(float, WS_SKKA) + o) = kk * av[nt]; }
#endif
        }
    }
}
#if (MK_GLOBAL_GROUPS & 2)
#pragma pop_macro("WSP")
#pragma pop_macro("WSW")
#pragma pop_macro("OUTP")
#endif
#if (MK_GLOBAL_GROUPS & 4)
#pragma push_macro("WSP")
#pragma push_macro("WSW")
#pragma push_macro("OUTP")
#undef WSP
#undef WSW
#undef OUTP
#define WSP WSPG
#define WSW WSWG
#define OUTP OUTPG
#endif
#if !MK_CHUNKED
__device__ __forceinline__ void scan_rwkv_naive(Frame& F, int item) {
    const int lane = F.lane;
    float st[64];
#pragma unroll
    for (int j = 0; j < 64; ++j) st[j] = 0.f;
    const size_t base0 = (size_t)(item >> 4) * SEQ * RWW + (size_t)(item & 15) * WD + lane;
    for (int t = 0; t < SEQ; ++t) {
        const size_t o = base0 + (size_t)t * RWW;
        const float r = WSP(float, WS_SR)[o], w = WSP(float, WS_SW)[o], k = WSP(float, WS_SK)[o], v = WSP(float, WS_SV)[o], nk = WSP(float, WS_SNKK)[o], ka = WSP(float, WS_SKKA)[o];
        float sa = 0.f;
#pragma unroll
        for (int j = 0; j < 64; ++j) sa += st[j] * rdlane(nk, j);
        float y = 0.f;
#pragma unroll
        for (int j = 0; j < 64; ++j) { st[j] = st[j] * rdlane(w, j) + sa * rdlane(ka, j) + v * rdlane(k, j); y += st[j] * rdlane(r, j); }
        WSP(float, WS_YRAWW)[o] = y;
    }
}
#endif
__device__ __forceinline__ void scan_ret_naive(Frame& F, int item) {
    const int lane = F.lane, b = item >> 4, h = (item >> 1) & 7, half = item & 1;
    const float gam = 1.0f - exp2f((float)(-5 - h));
    float R[128];
#pragma unroll
    for (int j = 0; j < 128; ++j) R[j] = 0.f;
    for (int t = 0; t < SEQ; ++t) {
        const size_t m = (size_t)b * SEQ + t;
        const float q1 = bf2f(WSP(bf16, WS_QR)[m * RETW + h * RD + lane]), q2 = bf2f(WSP(bf16, WS_QR)[m * RETW + h * RD + 64 + lane]);
        const float k1 = bf2f(WSP(bf16, WS_KR)[m * RETW + h * RD + lane]), k2 = bf2f(WSP(bf16, WS_KR)[m * RETW + h * RD + 64 + lane]);
        const float v = bf2f(WSP(bf16, WS_Z)[m * INW + ZC_V + h * RD + half * 64 + lane]);
        float y = 0.f;
#pragma unroll
        for (int d = 0; d < 64; ++d) { R[d] = gam * R[d] + rdlane(k1, d) * v; y += rdlane(q1, d) * R[d]; }
#pragma unroll
        for (int d = 0; d < 64; ++d) { R[64 + d] = gam * R[64 + d] + rdlane(k2, d) * v; y += rdlane(q2, d) * R[64 + d]; }
        WSP(float, WS_YRAWR)[m * RETW + h * RD + half * 64 + lane] = y;
    }
}
#if !MK_CHUNKED
constexpr int SCT = 32;
constexpr int SC_ARR = SCT * 64 * 4;
constexpr int SC_BUF = 5 * SC_ARR + SCT * 16 * 4;
static_assert(2 * SC_BUF <= RING_BYTES, "scan LDS");
template <int CTRL> __device__ __forceinline__ float dppf(float x) { return __builtin_bit_cast(float, __builtin_amdgcn_update_dpp(0, __builtin_bit_cast(int, x), CTRL, 0xF, 0xF, true)); }
__device__ __forceinline__ float sum16(float x) {
    x += dppf<0xB1>(x); x += dppf<0x4E>(x); x += dppf<0x141>(x); x += dppf<0x140>(x); return x;
}
__device__ __forceinline__ void scan_rwkv_fast(Frame& F, int w) {
    const int b = w >> 6, hh = (w >> 2) & 15, q = w & 3;
    const int lane = F.lane, wave = F.wave;
    LAS unsigned char* base = F.lds + RING_OFF;
    const size_t g0 = (size_t)b * SEQ * RWW + (size_t)hh * WD;
    constexpr int NBLK = SEQ / SCT;
#define SC_BAR() do { asm volatile("s_waitcnt lgkmcnt(0)" ::: "memory"); __builtin_amdgcn_s_barrier(); asm volatile("" ::: "memory"); } while (0)
    if (wave >= 4) {
        const int lt = F.tid - 256;
        const float* a0 = WSP(float, WS_SR) + g0; const float* a1 = WSP(float, WS_SW) + g0; const float* a2 = WSP(float, WS_SK) + g0;
        const float* a3 = WSP(float, WS_SNKK) + g0; const float* a4 = WSP(float, WS_SKKA) + g0; const float* av = WSP(float, WS_SV) + g0 + 16 * q;
        const int f0 = lt, f1 = lt + 256;
        const size_t o0 = (size_t)(f0 >> 4) * RWW + 4 * (f0 & 15), o1 = (size_t)(f1 >> 4) * RWW + 4 * (f1 & 15), ov = (size_t)(lt >> 2) * RWW + 4 * (lt & 3);
        f32x4 r0[5], r1[5], rv;
#define SC_LOAD(blk) do { const size_t tb = (size_t)(blk) * SCT * RWW; \
        r0[0] = *(const GAS f32x4*)(a0 + tb + o0); r1[0] = *(const GAS f32x4*)(a0 + tb + o1); r0[1] = *(const GAS f32x4*)(a1 + tb + o0); r1[1] = *(const GAS f32x4*)(a1 + tb + o1); \
        r0[2] = *(const GAS f32x4*)(a2 + tb + o0); r1[2] = *(const GAS f32x4*)(a2 + tb + o1); r0[3] = *(const GAS f32x4*)(a3 + tb + o0); r1[3] = *(const GAS f32x4*)(a3 + tb + o1); \
        r0[4] = *(const GAS f32x4*)(a4 + tb + o0); r1[4] = *(const GAS f32x4*)(a4 + tb + o1); if (lt < 128) rv = *(const GAS f32x4*)(av + tb + ov); } while (0)
#define SC_STORE(bi) do { LAS unsigned char* bb = base + (bi) * SC_BUF; \
        _Pragma("unroll") for (int a = 0; a < 5; ++a) { *(LAS f32x4*)(bb + a * SC_ARR + f0 * 16) = r0[a]; *(LAS f32x4*)(bb + a * SC_ARR + f1 * 16) = r1[a]; } \
        if (lt < 128) *(LAS f32x4*)(bb + 5 * SC_ARR + lt * 16) = rv; } while (0)
        SC_LOAD(0); SC_STORE(0);
        if (1 < NBLK) SC_LOAD(1);
        SC_BAR();
        for (int blk = 0; blk < NBLK; ++blk) {
            if (blk + 1 < NBLK) { SC_STORE((blk + 1) & 1); if (blk + 2 < NBLK) SC_LOAD(blk + 2); }
            SC_BAR();
        }
#undef SC_LOAD
#undef SC_STORE
    } else {
        const int l16 = lane & 15, rowl = 4 * wave + (lane >> 4);
        GAS float* Y = (GAS float*)(WSP(float, WS_YRAWW) + g0 + 16 * q + rowl);
        f32x4 st = (f32x4){0.f, 0.f, 0.f, 0.f};
        const int lo = l16 * 16, vo = 5 * SC_ARR + rowl * 4;
#define SC_LD(tt_, R4, W4, K4, N4, A4, V) do { R4 = *(const LAS f32x4*)(bb + 0 * SC_ARR + (tt_) * 256 + lo); W4 = *(const LAS f32x4*)(bb + 1 * SC_ARR + (tt_) * 256 + lo); \
        K4 = *(const LAS f32x4*)(bb + 2 * SC_ARR + (tt_) * 256 + lo); N4 = *(const LAS f32x4*)(bb + 3 * SC_ARR + (tt_) * 256 + lo); A4 = *(const LAS f32x4*)(bb + 4 * SC_ARR + (tt_) * 256 + lo); \
        V = *(const LAS float*)(bb + vo + (tt_) * 64); } while (0)
        SC_BAR();
        for (int blk = 0; blk < NBLK; ++blk) {
            const LAS unsigned char* bb = base + (blk & 1) * SC_BUF;
            GAS float* yb = Y + (size_t)blk * SCT * RWW;
            f32x4 r4[3], w4[3], k4[3], n4[3], a4[3]; float v[3];
            SC_LD(0, r4[0], w4[0], k4[0], n4[0], a4[0], v[0]);
            SC_LD(1, r4[1], w4[1], k4[1], n4[1], a4[1], v[1]);
#pragma unroll
            for (int tt = 0; tt < SCT; ++tt) {
                const int c = tt % 3, p = (tt + 2) % 3;
                if (tt + 2 < SCT) SC_LD(tt + 2, r4[p], w4[p], k4[p], n4[p], a4[p], v[p]);
                f32x2 sp2 = (f32x2){st.x, st.y} * (f32x2){n4[c].x, n4[c].y}; sp2 = (f32x2){st.z, st.w} * (f32x2){n4[c].z, n4[c].w} + sp2;
                const f32x4 t0 = st * w4[c] + k4[c] * v[c];
                const float sa = sum16(sp2.x + sp2.y);
                st = a4[c] * sa + t0;
                f32x2 yp2 = (f32x2){st.x, st.y} * (f32x2){r4[c].x, r4[c].y}; yp2 = (f32x2){st.z, st.w} * (f32x2){r4[c].z, r4[c].w} + yp2;
                const float y = sum16(yp2.x + yp2.y);
                yb[(size_t)tt * RWW] = y;
            }
            SC_BAR();
        }
#undef SC_LD
#undef SC_BAR
    }
}
#endif
constexpr int CB_STEPS = 4, CB_STEP_BYTES = 8192 + 2048 + 2048 + 512, CB_BUF = CB_STEPS * CB_STEP_BYTES, CB_PIECES = CB_BUF / 16, CB_NBLK = NCHUNK / CB_STEPS;
static_assert(2 * CB_BUF <= RING_BYTES, "chunk scan LDS");
#ifndef MK_X2_DIRECT
#define MK_X2_DIRECT 0
#endif
__device__ __forceinline__ void scan_rwkv_chunk(Frame& F, int w) {
    const int bh = w >> 2, q = w & 3, lane = F.lane, wave = F.wave;
#if MK_X2_DIRECT
    if (wave == 0) {
        const int l15 = lane & 15, g = lane >> 4;
        const f32x4 Z4 = (f32x4){0.f, 0.f, 0.f, 0.f};
        f32x4 acc[4] = {Z4, Z4, Z4, Z4};
        const GAS unsigned char* rec = (const GAS unsigned char*)WSP(unsigned char, WS_CU) + (size_t)bh * NCHUNK * CU_BYTES;
        GAS float* Y = (GAS float*)(WSP(float, WS_YRAWW) + (size_t)(bh >> 4) * SEQ * RWW + (size_t)(bh & 15) * WD + 16 * q + l15 + (size_t)(4 * g) * RWW);
        for (int n = 0; n < NCHUNK; ++n, rec += CU_BYTES) {
            const bf16x8 sf0 = pk8v(acc[0], acc[1]), sf1 = pk8v(acc[2], acc[3]);
            f32x4 ya = unpk4(*(const GAS v2u*)(rec + CU_QB + q * CU_QSTR + 2048 + lane * 8));
            ya = mma32(*(const GAS bf16x8*)(rec + CU_OM + lane * 16), sf0, ya); ya = mma32(*(const GAS bf16x8*)(rec + CU_OM + 1024 + lane * 16), sf1, ya);
            GAS float* yp = Y + (size_t)(n * CK) * RWW;
#pragma unroll
            for (int i = 0; i < 4; ++i) yp[(size_t)i * RWW] = ya[i];
#pragma unroll
            for (int tl = 0; tl < 4; ++tl) { f32x4 na = unpk4(*(const GAS v2u*)(rec + CU_QB + q * CU_QSTR + tl * 512 + lane * 8));
                na = mma32(*(const GAS bf16x8*)(rec + CU_M + (tl * 2 + 0) * 1024 + lane * 16), sf0, na); na = mma32(*(const GAS bf16x8*)(rec + CU_M + (tl * 2 + 1) * 1024 + lane * 16), sf1, na);
                acc[tl] = na; }
        }
    }
    return;
#endif
    LAS unsigned char* base = F.lds + RING_OFF;
    const GAS unsigned char* rec0 = (const GAS unsigned char*)WSP(unsigned char, WS_CU) + (size_t)bh * NCHUNK * CU_BYTES;
#define CB_BAR() do { asm volatile("s_waitcnt lgkmcnt(0)" ::: "memory"); __builtin_amdgcn_s_barrier(); asm volatile("" ::: "memory"); } while (0)
    if (wave >= 1) {
        const int lt = F.tid - 64;
#if MK_X2_NT
#define CB_LD(p_) __builtin_nontemporal_load((const GAS v4u*)(p_))
#else
#define CB_LD(p_) (*(const GAS v4u*)(p_))
#endif
        v4u ra[8], rb[8], rc[8], rd[8];
        const int ltc = lt < 400 ? lt : 399;
        int so[8];
#pragma unroll
        for (int j = 0; j < 8; ++j) { const int p = ltc + 400 * j, st = p / 800, off = p % 800; so[j] = st * CU_BYTES + off * 16 + (off >= 640 ? q * CU_QSTR : 0); }
#define CB_LOAD(rg, blk) do { const int bc_ = (blk) < CB_NBLK ? (blk) : CB_NBLK - 1; const GAS unsigned char* bp = rec0 + (size_t)bc_ * CB_STEPS * CU_BYTES; \
            _Pragma("unroll") for (int j = 0; j < 8; ++j) rg[j] = CB_LD(bp + so[j]); } while (0)
#define CB_STORE(rg, bi) do { LAS unsigned char* dp = base + (bi) * CB_BUF + ltc * 16; \
            _Pragma("unroll") for (int j = 0; j < 8; ++j) *(LAS v4u*)(dp + j * 400 * 16) = rg[j]; } while (0)
        static_assert(CB_NBLK % 4 == 0 && CB_NBLK >= 8, "block quads");
        CB_LOAD(ra, 0); CB_STORE(ra, 0); CB_LOAD(rb, 1); CB_LOAD(rc, 2); CB_LOAD(rd, 3);
        CB_BAR();
        for (int blk = 0; blk < CB_NBLK; blk += 4) {
            CB_STORE(rb, 1); CB_LOAD(ra, blk + 4); CB_BAR();
            CB_STORE(rc, 0); CB_LOAD(rb, blk + 5); CB_BAR();
            CB_STORE(rd, 1); CB_LOAD(rc, blk + 6); CB_BAR();
            CB_STORE(ra, 0); CB_LOAD(rd, blk + 7); CB_BAR();
        }
#undef CB_LOAD
#undef CB_STORE
    } else {
        const int l15 = lane & 15, g = lane >> 4;
        const f32x4 Z4 = (f32x4){0.f, 0.f, 0.f, 0.f};
        f32x4 acc[4] = {Z4, Z4, Z4, Z4};
        GAS float* Y = (GAS float*)(WSP(float, WS_YRAWW) + (size_t)(bh >> 4) * SEQ * RWW + (size_t)(bh & 15) * WD + 16 * q + l15 + (size_t)(4 * g) * RWW);
        CB_BAR();
        bf16x8 Mf[2][8], Of[2][2]; v2u Nt[2][4], Yt[2];
#define CB_FRAGS(sb_, k_) do { _Pragma("unroll") for (int j = 0; j < 8; ++j) Mf[k_][j] = *(const LAS bf16x8*)((sb_) + j * 1024 + lane * 16); \
        _Pragma("unroll") for (int j = 0; j < 4; ++j) Nt[k_][j] = *(const LAS v2u*)((sb_) + 10240 + j * 512 + lane * 8); \
        Of[k_][0] = *(const LAS bf16x8*)((sb_) + 8192 + lane * 16); Of[k_][1] = *(const LAS bf16x8*)((sb_) + 9216 + lane * 16); Yt[k_] = *(const LAS v2u*)((sb_) + 12288 + lane * 8); } while (0)
        for (int blk = 0; blk < CB_NBLK; ++blk) {
            const LAS unsigned char* bb = base + (blk & 1) * CB_BUF;
            CB_FRAGS(bb, 0);
#pragma unroll
            for (int st = 0; st < CB_STEPS; ++st) {
                const int c = st & 1;
                if (st + 1 < CB_STEPS) CB_FRAGS(bb + (st + 1) * CB_STEP_BYTES, (c ^ 1));
                const bf16x8 sf0 = pk8v(acc[0], acc[1]), sf1 = pk8v(acc[2], acc[3]);
                f32x4 ya = unpk4(Yt[c]);
                ya = mma32(Of[c][0], sf0, ya); ya = mma32(Of[c][1], sf1, ya);
                GAS float* yp = Y + (size_t)((blk * CB_STEPS + st) * CK) * RWW;
#pragma unroll
                for (int i = 0; i < 4; ++i) yp[(size_t)i * RWW] = ya[i];
                f32x4 na[4];
#pragma unroll
                for (int tl = 0; tl < 4; ++tl) na[tl] = mma32(Mf[c][tl * 2 + 0], sf0, unpk4(Nt[c][tl]));
#pragma unroll
                for (int tl = 0; tl < 4; ++tl) acc[tl] = mma32(Mf[c][tl * 2 + 1], sf1, na[tl]);
            }
            CB_BAR();
        }
#undef CB_FRAGS
    }
#undef CB_BAR
}
constexpr int RT_STR = 288, RT_QS = 0, RT_KS = 128 * RT_STR, RT_VSTR = 80, RT_VS = 2 * 128 * RT_STR, RT_VPS = RT_VS + 128 * RT_VSTR, RT_RT = RT_VPS + 128 * RT_VSTR, RT_RTSZ = 32 * RT_STR;
static_assert(RT_RT + 2 * RT_RTSZ <= RING_BYTES, "retention LDS");
__device__ __forceinline__ bf16x8 tr8(const LAS unsigned char* p0, const LAS unsigned char* p1) {
    const s4v a = __builtin_amdgcn_ds_read_tr16_b64_v4i16((LAS s4v*)p0), b = __builtin_amdgcn_ds_read_tr16_b64_v4i16((LAS s4v*)p1);
    return (bf16x8){a.x, a.y, a.z, a.w, b.x, b.y, b.z, b.w};
}
__device__ __forceinline__ void scan_ret_mfma(Frame& F, int w_) {
    const int b = w_ >> 5, h = (w_ >> 2) & 7, eq = w_ & 3;
    const int tid = F.tid, lane = F.lane, w = F.wave, l15 = lane & 15, g = lane >> 4, tq = l15 >> 2, tp = l15 & 3;
    LAS unsigned char* L = F.lds + RING_OFF;
    const float lg2 = log1pf(-exp2f((float)(-5 - h))) * 1.4426950408889634f;
    const float gC = __builtin_amdgcn_exp2f(lg2 * 128.f);
    for (int i = tid; i < RT_RTSZ / 4; i += NWAVES * 64) ((LAS unsigned*)(L + RT_RT))[i] = 0u;
    const GAS bf16* Qg = (const GAS bf16*)(WSP(bf16, WS_QR) + (size_t)b * SEQ * RETW + h * RD);
    const GAS bf16* Kg = (const GAS bf16*)(WSP(bf16, WS_KR) + (size_t)b * SEQ * RETW + h * RD);
    const GAS bf16* Vg = (const GAS bf16*)(WSP(bf16, WS_Z) + (size_t)b * SEQ * INW + ZC_V + h * RD + 32 * eq);
    GAS float* Yg = (GAS float*)(WSP(float, WS_YRAWR) + (size_t)b * SEQ * RETW + h * RD + 32 * eq);
    v4u rq[4], rk[4], rv;
#define RT_BAR() do { asm volatile("s_waitcnt lgkmcnt(0)" ::: "memory"); __builtin_amdgcn_s_barrier(); asm volatile("" ::: "memory"); } while (0)
#define RT_LOAD(n_) do { _Pragma("unroll") for (int i = 0; i < 4; ++i) { const int f = tid + 512 * i, c = f >> 4, pc = f & 15; \
        rq[i] = *(const GAS v4u*)(Qg + (size_t)((n_) * 128 + c) * RETW + 8 * pc); rk[i] = *(const GAS v4u*)(Kg + (size_t)((n_) * 128 + c) * RETW + 8 * pc); } \
        rv = *(const GAS v4u*)(Vg + (size_t)((n_) * 128 + (tid >> 2)) * INW + 8 * (tid & 3)); } while (0)
    f32x4 accR[2] = {(f32x4){0.f, 0.f, 0.f, 0.f}, (f32x4){0.f, 0.f, 0.f, 0.f}};
    RT_LOAD(0);
    for (int n = 0; n < SEQ / 128; ++n) {
#pragma unroll
        for (int i = 0; i < 4; ++i) { const int f = tid + 512 * i, c = f >> 4, pc = f & 15;
            *(LAS v4u*)(L + RT_QS + c * RT_STR + pc * 16) = rq[i]; *(LAS v4u*)(L + RT_KS + c * RT_STR + pc * 16) = rk[i]; }
        { const int c = tid >> 2, pc = tid & 3; *(LAS v4u*)(L + RT_VS + c * RT_VSTR + pc * 16) = rv;
          const float sc = __builtin_amdgcn_exp2f(lg2 * (float)(127 - c)); v4u o;
          o.x = pg8::cvt_pk_bf16(pg8::bf_lo(rv.x) * sc, pg8::bf_hi(rv.x) * sc); o.y = pg8::cvt_pk_bf16(pg8::bf_lo(rv.y) * sc, pg8::bf_hi(rv.y) * sc);
          o.z = pg8::cvt_pk_bf16(pg8::bf_lo(rv.z) * sc, pg8::bf_hi(rv.z) * sc); o.w = pg8::cvt_pk_bf16(pg8::bf_lo(rv.w) * sc, pg8::bf_hi(rv.w) * sc);
          *(LAS v4u*)(L + RT_VPS + c * RT_VSTR + pc * 16) = o; }
        RT_BAR();
        if (n + 1 < SEQ / 128) RT_LOAD(n + 1);
        bf16x8 qf[4];
#pragma unroll
        for (int ks = 0; ks < 4; ++ks) qf[ks] = *(const LAS bf16x8*)(L + RT_QS + (16 * w + l15) * RT_STR + (32 * ks + 8 * g) * 2);
        bf16x8 pf[4];
        const int cq = 16 * w + l15;
#pragma unroll
        for (int p = 0; p < 4; ++p) {
            bf16x8 kf[8];
#pragma unroll
            for (int ks = 0; ks < 4; ++ks) { kf[ks] = *(const LAS bf16x8*)(L + RT_KS + (32 * p + l15) * RT_STR + (32 * ks + 8 * g) * 2);
                kf[4 + ks] = *(const LAS bf16x8*)(L + RT_KS + (32 * p + 16 + l15) * RT_STR + (32 * ks + 8 * g) * 2); }
            __builtin_amdgcn_sched_barrier(0);
            f32x4 s0 = (f32x4){0.f, 0.f, 0.f, 0.f}, s1 = (f32x4){0.f, 0.f, 0.f, 0.f};
            if (2 * p <= w) {
#pragma unroll
                for (int ks = 0; ks < 4; ++ks) s0 = __builtin_amdgcn_mfma_f32_16x16x32_bf16(kf[ks], qf[ks], s0, 0, 0, 0);
            }
            if (2 * p + 1 <= w) {
#pragma unroll
                for (int ks = 0; ks < 4; ++ks) s1 = __builtin_amdgcn_mfma_f32_16x16x32_bf16(kf[4 + ks], qf[ks], s1, 0, 0, 0);
            }
            float p0[4], p1[4];
#pragma unroll
            for (int i = 0; i < 4; ++i) { const int d0 = cq - (32 * p + 4 * g + i), d1 = d0 - 16;
                p0[i] = d0 >= 0 ? s0[i] * __builtin_amdgcn_exp2f(lg2 * (float)d0) : 0.f; p1[i] = d1 >= 0 ? s1[i] * __builtin_amdgcn_exp2f(lg2 * (float)d1) : 0.f; }
            v4u pk; pk.x = pg8::cvt_pk_bf16(p0[0], p0[1]); pk.y = pg8::cvt_pk_bf16(p0[2], p0[3]); pk.z = pg8::cvt_pk_bf16(p1[0], p1[1]); pk.w = pg8::cvt_pk_bf16(p1[2], p1[3]);
            pf[p] = __builtin_bit_cast(bf16x8, pk);
        }
        const LAS unsigned char* Rcur = L + RT_RT + (n & 1) * RT_RTSZ;
#pragma unroll
        for (int et = 0; et < 2; ++et) {
            bf16x8 rf[4], vf[4];
#pragma unroll
            for (int ks = 0; ks < 4; ++ks) rf[ks] = *(const LAS bf16x8*)(Rcur + (16 * et + l15) * RT_STR + (32 * ks + 8 * g) * 2);
#pragma unroll
            for (int p = 0; p < 4; ++p) { const LAS unsigned char* vb = L + RT_VS + (32 * p + 4 * g + tq) * RT_VSTR + (16 * et + 4 * tp) * 2; vf[p] = tr8(vb, vb + 16 * RT_VSTR); }
            __builtin_amdgcn_sched_barrier(0);
            f32x4 acc = (f32x4){0.f, 0.f, 0.f, 0.f};
#pragma unroll
            for (int ks = 0; ks < 4; ++ks) acc = __builtin_amdgcn_mfma_f32_16x16x32_bf16(qf[ks], rf[ks], acc, 0, 0, 0);
#pragma unroll
            for (int i = 0; i < 4; ++i) acc[i] *= __builtin_amdgcn_exp2f(lg2 * (float)(16 * w + 4 * g + i + 1));
#pragma unroll
            for (int p = 0; p < 4; ++p) if (2 * p <= w) acc = __builtin_amdgcn_mfma_f32_16x16x32_bf16(pf[p], vf[p], acc, 0, 0, 0);
#pragma unroll
            for (int i = 0; i < 4; ++i) Yg[(size_t)(n * 128 + 16 * w + 4 * g + i) * RETW + 16 * et + l15] = acc[i];
        }
        {
            bf16x8 kt[4], vt[4][2];
#pragma unroll
            for (int cs = 0; cs < 4; ++cs) {
                const LAS unsigned char* kb = L + RT_KS + (32 * cs + 8 * g + tq) * RT_STR + (16 * w + 4 * tp) * 2;
                kt[cs] = tr8(kb, kb + 4 * RT_STR);
#pragma unroll
                for (int et = 0; et < 2; ++et) { const LAS unsigned char* vb = L + RT_VPS + (32 * cs + 8 * g + tq) * RT_VSTR + (16 * et + 4 * tp) * 2; vt[cs][et] = tr8(vb, vb + 4 * RT_VSTR); }
            }
            __builtin_amdgcn_sched_barrier(0);
            LAS unsigned char* Rnxt = L + RT_RT + ((n + 1) & 1) * RT_RTSZ;
            accR[0] = accR[0] * gC; accR[1] = accR[1] * gC;
#pragma unroll
            for (int cs = 0; cs < 4; ++cs)
#pragma unroll
                for (int et = 0; et < 2; ++et) accR[et] = __builtin_amdgcn_mfma_f32_16x16x32_bf16(kt[cs], vt[cs][et], accR[et], 0, 0, 0);
#pragma unroll
            for (int et = 0; et < 2; ++et) { v2u o; o.x = pg8::cvt_pk_bf16(accR[et][0], accR[et][1]); o.y = pg8::cvt_pk_bf16(accR[et][2], accR[et][3]);
                *(LAS v2u*)(Rnxt + (16 * et + l15) * RT_STR + (16 * w + 4 * g) * 2) = o; }
        }
        RT_BAR();
    }
#undef RT_LOAD
#undef RT_BAR
}
__device__ __forceinline__ void ph_scan(Frame& F, ArgP A, int l) {
#if MK_CHUNKED
    if (F.G == 256) {
        const int it = F.vcu, r = it & 3, idx = it >> 2;
        if (r == 0 || r == 2) { const int w = idx * 2 + (r >> 1); int n_ = (MK_REP & 32) ? 2 : 1; asm volatile("" : "+s"(n_));
#pragma unroll 1
            for (int k_ = 0; k_ < n_; ++k_) { scan_rwkv_chunk(F, w); __syncthreads(); } }
        else if (r == 1) { int n_ = (MK_REP & 64) ? 2 : 1; asm volatile("" : "+s"(n_));
#pragma unroll 1
            for (int k_ = 0; k_ < n_; ++k_) { scan_ret_mfma(F, idx); __syncthreads(); } }
        else if (l + 1 < DEPTH) { ph_convert(F, A, l + 1, idx, 64); }
        __syncthreads();
    }
#else
    if (F.G >= 256) {
        if (F.vcu >= 192) { if (l + 1 < DEPTH) ph_convert(F, A, l + 1, F.vcu - 192, F.G - 192); return; }
        if (F.vcu < 128) { scan_rwkv_fast(F, F.vcu); if (MK_REP & 32) { __syncthreads(); scan_rwkv_fast(F, F.vcu); } }
        else if (F.vcu < 192) { scan_ret_mfma(F, F.vcu - 128); if (MK_REP & 64) { __syncthreads(); scan_ret_mfma(F, F.vcu - 128); } }
    } else {
        if (l + 1 < DEPTH) ph_convert(F, A, l + 1, F.vcu, F.G);
        const int gw = F.vcu * NWAVES + F.wave, NGW = F.G * NWAVES;
        const int stride = NGW >= 64 ? NGW / 64 : 1;
        if (gw % stride == 0) {
            for (int item = gw / stride; item < 64; item += (NGW + stride - 1) / stride) {
                if (item < 32) scan_rwkv_naive(F, item); else scan_ret_naive(F, item - 32);
            }
        }
    }
#endif
}
#if (MK_GLOBAL_GROUPS & 4)
#pragma pop_macro("WSP")
#pragma pop_macro("WSW")
#pragma pop_macro("OUTP")
#endif
#if (MK_GLOBAL_GROUPS & 8)
#pragma push_macro("WSP")
#pragma push_macro("WSW")
#pragma push_macro("OUTP")
#undef WSP
#undef WSW
#undef OUTP
#define WSP WSPG
#define WSW WSWG
#define OUTP OUTPG
#endif
template <int CTRL> __device__ __forceinline__ float dppx(float x) { return __builtin_bit_cast(float, __builtin_amdgcn_update_dpp(0, __builtin_bit_cast(int, x), CTRL, 0xF, 0xF, true)); }
__device__ __forceinline__ void ph_post(Frame& F, ArgP A, int l) {
    const int gw = F.vcu * NWAVES + F.wave, NGW = F.G * NWAVES, lane = F.lane, c0 = lane * 16;
    f32x4 gg[4], gb[4], lg[4], lb[4];
#pragma unroll
    for (int j = 0; j < 4; ++j) { gg[j] = *(const GAS f32x4*)(INP(A, 4) + (size_t)l * RETW + c0 + 4 * j); gb[j] = *(const GAS f32x4*)(INP(A, 5) + (size_t)l * RETW + c0 + 4 * j);
        lg[j] = *(const GAS f32x4*)(INP(A, 15) + (size_t)l * RWW + c0 + 4 * j); lb[j] = *(const GAS f32x4*)(INP(A, 16) + (size_t)l * RWW + c0 + 4 * j); }
    for (int m = gw; m < M; m += NGW) {
        {
            f32x4 y[4]; float s = 0.f;
#pragma unroll
            for (int j = 0; j < 4; ++j) { y[j] = *(const GAS f32x4*)(WSP(float, WS_YRAWR) + (size_t)m * RETW + c0 + 4 * j); s += (y[j].x + y[j].y) + (y[j].z + y[j].w); }
            const GAS bf16* zg = (const GAS bf16*)(WSP(bf16, WS_Z) + (size_t)m * INW + ZC_GR + c0);
            float g[16]; { float t[8]; unpack8(*(const GAS v4u*)zg, t);
#pragma unroll
                for (int j = 0; j < 8; ++j) g[j] = t[j]; unpack8(*(const GAS v4u*)(zg + 8), t);
#pragma unroll
                for (int j = 0; j < 8; ++j) g[8 + j] = t[j]; }
            s += dppx<0xB1>(s); s += dppx<0x4E>(s); s += dppx<0x141>(s);
            const float mean = s * (1.f / RD); float q = 0.f;
#pragma unroll
            for (int j = 0; j < 4; ++j) { y[j] = y[j] - mean; q += (y[j].x * y[j].x + y[j].y * y[j].y) + (y[j].z * y[j].z + y[j].w * y[j].w); }
            q += dppx<0xB1>(q); q += dppx<0x4E>(q); q += dppx<0x141>(q);
            const float rstd = __builtin_amdgcn_rsqf(q * (1.f / RD) + RET_GN_EPS);
            float o[16];
#pragma unroll
            for (int j = 0; j < 4; ++j)
#pragma unroll
                for (int k = 0; k < 4; ++k) { const float gr = g[4 * j + k]; o[4 * j + k] = (y[j][k] * rstd * gg[j][k] + gb[j][k]) * (gr * fsig(gr)); }
            GAS bf16* yo = (GAS bf16*)(WSP(bf16, WS_YRET) + (size_t)m * RETW + c0);
            { float t[8];
#pragma unroll
              for (int j = 0; j < 8; ++j) t[j] = o[j]; *(GAS bf16x8*)yo = pack8(t);
#pragma unroll
              for (int j = 0; j < 8; ++j) t[j] = o[8 + j]; *(GAS bf16x8*)(yo + 8) = pack8(t); }
        }
        {
            const size_t ob = (size_t)m * RWW + c0;
            f32x4 y[4]; float s = 0.f;
#pragma unroll
            for (int j = 0; j < 4; ++j) { y[j] = *(const GAS f32x4*)(WSP(float, WS_YRAWW) + ob + 4 * j); s += (y[j].x + y[j].y) + (y[j].z + y[j].w); }
            f32x4 vv[4], gt[4];
#pragma unroll
#if MK_CHUNKED
            for (int j = 0; j < 4; ++j) { vv[j] = unpk4(*(const GAS v2u*)(WSP(bf16, WS_SV) + ob + 4 * j)); gt[j] = unpk4(*(const GAS v2u*)(WSP(bf16, WS_G) + ob + 4 * j)); }
#else
            for (int j = 0; j < 4; ++j) { vv[j] = *(const GAS f32x4*)(WSP(float, WS_SV) + ob + 4 * j); gt[j] = *(const GAS f32x4*)(WSP(float, WS_G) + ob + 4 * j); }
#endif
            const float bonus = *(const GAS float*)(WSP(float, WS_BONUS) + (size_t)m * WH + (lane >> 2));
            s += dppx<0xB1>(s); s += dppx<0x4E>(s);
            const float mean = s * (1.f / WD); float q = 0.f;
#pragma unroll
            for (int j = 0; j < 4; ++j) { y[j] = y[j] - mean; q += (y[j].x * y[j].x + y[j].y * y[j].y) + (y[j].z * y[j].z + y[j].w * y[j].w); }
            q += dppx<0xB1>(q); q += dppx<0x4E>(q);
            const float rstd = __builtin_amdgcn_rsqf(q * (1.f / WD) + RWKV_LN_EPS);
            float o[16];
#pragma unroll
            for (int j = 0; j < 4; ++j)
#pragma unroll
                for (int k = 0; k < 4; ++k) o[4 * j + k] = (y[j][k] * rstd * lg[j][k] + lb[j][k] + bonus * vv[j][k]) * gt[j][k];
            GAS bf16* yo = (GAS bf16*)(WSP(bf16, WS_YRWKV) + ob);
            { float t[8];
#pragma unroll
              for (int j = 0; j < 8; ++j) t[j] = o[j]; *(GAS bf16x8*)yo = pack8(t);
#pragma unroll
              for (int j = 0; j < 8; ++j) t[j] = o[8 + j]; *(GAS bf16x8*)(yo + 8) = pack8(t); }
        }
    }
}
__device__ __forceinline__ void ph_final(Frame& F, ArgP A) {
    const int gw = F.vcu * NWAVES + F.wave, NGW = F.G * NWAVES, lane = F.lane;
    const GAS f32x4* gr = (const GAS f32x4*)INP(A, 23) + lane;
    for (int m = gw; m < M; m += NGW) {
        GAS f32x4* xr = (GAS f32x4*)(OUTP + (size_t)m * D) + lane;
        f32x4 v[8]; float s = 0.f;
#pragma unroll
        for (int j = 0; j < 8; ++j) { v[j] = xr[64 * j]; s += (v[j].x * v[j].x + v[j].y * v[j].y) + (v[j].z * v[j].z + v[j].w * v[j].w); }
        const float rstd = 1.f / sqrtf(wave_sum(s) * (1.f / D) + NORM_EPS);
#pragma unroll
        for (int j = 0; j < 8; ++j) xr[64 * j] = v[j] * rstd * gr[64 * j];
    }
}
#if (MK_GLOBAL_GROUPS & 8)
#pragma pop_macro("WSP")
#pragma pop_macro("WSW")
#pragma pop_macro("OUTP")
#endif

__global__ void __launch_bounds__(NWAVES * 64, 2) hybrid_fwd(Args args) {
    extern __shared__ __attribute__((aligned(16))) unsigned char lds[];
    Frame F;
    F.lds = (LAS unsigned char*)lds;
    F.MISC = (volatile LAS unsigned*)(F.lds + MISC_OFF);
    F.tid = threadIdx.x; F.lane = F.tid & 63; F.wave = __builtin_amdgcn_readfirstlane(F.tid >> 6);
    int bx = blockIdx.x; F.G = gridDim.x; { F.vcu = (F.G % 8 == 0) ? (bx % 8) * (F.G / 8) + bx / 8 : bx; }
    F.ws = args.ws; F.out = args.out;
    for (int u = F.tid; u < (LDS_BYTES - LDSCTL_OFF) / 4; u += NWAVES * 64) ((LAS unsigned*)(F.lds + LDSCTL_OFF))[u] = 0u;
    __syncthreads();
    if (F.tid == 0) { volatile LAS unsigned* U = (volatile LAS unsigned*)(F.lds + MISC_OFF) + 16; const unsigned long long pw = (unsigned long long)args.ws, po = (unsigned long long)args.out, pa = (unsigned long long)__builtin_amdgcn_kernarg_segment_ptr();
        U[0] = (unsigned)pw; U[1] = (unsigned)(pw >> 32); U[2] = (unsigned)po; U[3] = (unsigned)(po >> 32); U[4] = (unsigned)pa; U[5] = (unsigned)(pa >> 32); U[6] = (unsigned)F.G; U[7] = (unsigned)F.vcu; U[8] = (unsigned)bx; }
    __syncthreads();
    XcdBarrier bar = xcd_barrier_post((unsigned*)(F.ws + WS_CTL) + CW_BAR, F.MISC + 8);

    ArgP ap = (ArgP)__builtin_amdgcn_kernarg_segment_ptr();
    const int lo = args.ph_lo, hi = args.ph_hi;
#define REPX(bit, body) do { body; if (MK_REP & (bit)) { __syncthreads(); body; } } while (0)
#define IN(k) (lo <= (k) && (k) < hi)
#define SEAM(k) do { if (IN(k) && IN((k) + 1)) xcd_barrier(bar); else __syncthreads(); } while (0)

    if (IN(PH_PRO)) { int np_ = (MK_REP & 8192) ? 2 : 1; asm volatile("" : "+s"(np_));
#pragma unroll 1
        for (int rp_ = 0; rp_ < np_; ++rp_) { ph_prologue(F, ap); ph_convert(F, ap, 0, F.vcu, F.G); __syncthreads(); } }
    SEAM(PH_PRO);
    for (int l = 0; l < DEPTH; ++l) {
        const int p0 = PH_L0 + l * PPL;
        RETID();
        { unsigned ba = MISC_OFF + 64; asm volatile("" : "+v"(ba));
          const volatile LAS v4u* U = (const volatile LAS v4u*)(F.lds + ba);
          const v4u ua = U[0], ub = U[1]; const unsigned uc = *(const volatile LAS unsigned*)(U + 2);
          const unsigned u0 = __builtin_amdgcn_readfirstlane(ua.x), u1 = __builtin_amdgcn_readfirstlane(ua.y), u2 = __builtin_amdgcn_readfirstlane(ua.z), u3 = __builtin_amdgcn_readfirstlane(ua.w);
          const unsigned u4 = __builtin_amdgcn_readfirstlane(ub.x), u5 = __builtin_amdgcn_readfirstlane(ub.y), u6 = __builtin_amdgcn_readfirstlane(ub.z), u7 = __builtin_amdgcn_readfirstlane(ub.w), u8 = __builtin_amdgcn_readfirstlane(uc);
          F.ws = (unsigned char*)(((unsigned long long)u1 << 32) | u0); F.out = (float*)(((unsigned long long)u3 << 32) | u2); ap = (ArgP)(((unsigned long long)u5 << 32) | u4);
          F.G = (int)u6; F.vcu = (int)u7; bx = (int)u8; F.wave = __builtin_amdgcn_readfirstlane(F.tid >> 6); }
        if (IN(p0 + LP_G1)) {
            pg8::Gemm g{WSPG(bf16, WS_H), WSWG(l, WO_WIN), M, INW, D}; pg8::StaticOrder S; S.init(M, INW, F.G, bx);
            pg8::EpiB<0> E{WSPG(bf16, WS_Z), INW, nullptr, 0, WSPG(float, WS_SS)};
            pg8::gemm_phase<pg8::EpiB<0>, pg8::StaticOrder, MK_ALIGN, MK_SP2>(F.lds + RING_OFF, g, S, E);
            if (MK_REP & 512) { __syncthreads(); pg8::gemm_phase<pg8::EpiB<0>, pg8::StaticOrder, MK_ALIGN, MK_SP2>(F.lds + RING_OFF, g, S, E); }
            if (MK_CONV_IN_G1 && F.G == 256 && l + 1 < DEPTH && bx >= 64) { RETID(); ph_convert(F, ap, l + 1, bx - 64, 192); }
        }
        SEAM(p0 + LP_G1);
        if (IN(p0 + LP_PREP)) { int nrep_ = (MK_REP & 4) ? 2 : 1; asm volatile("" : "+s"(nrep_));
#pragma unroll 1
            for (int rep_ = 0; rep_ < nrep_; ++rep_) { RETID(); ph_prep(F, ap, l); __syncthreads(); } }
        SEAM(p0 + LP_PREP);
        if (IN(p0 + LP_SCAN)) { RETID(); REPX(8, ph_scan(F, ap, l)); }
        SEAM(p0 + LP_SCAN);
        if (IN(p0 + LP_POST)) { RETID(); REPX(16, ph_post(F, ap, l)); }
        SEAM(p0 + LP_POST);
        if (IN(p0 + LP_GA)) {
            pg8::Gemm g{WSPG(bf16, WS_YRET), WSWG(l, WO_WA), M, D, RETW}; pg8::StaticOrder S; S.init(M, D, F.G, bx);
            pg8::EpiB<2> E{WSPG(bf16, WS_MRG), D, WSPG(bf16, WS_Z) + ZC_GA, INW, nullptr};
            pg8::gemm_phase<pg8::EpiB<2>, pg8::StaticOrder, MK_ALIGN, MK_SP2>(F.lds + RING_OFF, g, S, E);
        }
        __syncthreads();
        if (IN(p0 + LP_GB)) {
            pg8::Gemm g{WSPG(bf16, WS_YRWKV), WSWG(l, WO_WB), M, D, RWW}; pg8::StaticOrder S; S.init(M, D, F.G, bx);
            pg8::EpiB<3> E{WSPG(bf16, WS_MRG), D, WSPG(bf16, WS_Z) + ZC_GB, INW, nullptr};
            pg8::gemm_phase<pg8::EpiB<3>, pg8::StaticOrder, MK_ALIGN, MK_SP2>(F.lds + RING_OFF, g, S, E);
        }
        SEAM(p0 + LP_GB);
        if (IN(p0 + LP_GO)) {
            pg8::Gemm g{WSPG(bf16, WS_MRG), WSWG(l, WO_WO), M, D, D}; pg8::StaticOrder S; S.init(M, D, F.G, bx);
            pg8::EpiResNorm E{OUTPG, D, WSPG(bf16, WS_H), WSPG(float, WS_SS), l == 0 ? (const float*)(GAS const float*)(unsigned long long)INP(ap, 0) : (const float*)OUTPG};
            pg8::gemm_phase<pg8::EpiResNorm, pg8::StaticOrder, MK_ALIGN, MK_SP2>(F.lds + RING_OFF, g, S, E);
        }
        SEAM(p0 + LP_GO);
        if (IN(p0 + LP_GUP)) {
            pg8::Gemm g{WSPG(bf16, WS_H), WSWG(l, WO_WUP), M, DFF, D}; pg8::StaticOrder S; S.init(M, DFF, F.G, bx);
            pg8::EpiB<1> E{WSPG(bf16, WS_UP), DFF, nullptr, 0, WSPG(float, WS_SS)};
            pg8::gemm_phase<pg8::EpiB<1>, pg8::StaticOrder, MK_ALIGN, MK_SP2>(F.lds + RING_OFF, g, S, E);
        }
        SEAM(p0 + LP_GUP);
        if (IN(p0 + LP_GDN)) {
            pg8::Gemm g{WSPG(bf16, WS_UP), WSWG(l, WO_WDN), M, D, DFF}; pg8::StaticOrder S; S.init(M, D, F.G, bx);
            pg8::EpiResNorm E{OUTPG, D, WSPG(bf16, WS_H), WSPG(float, WS_SS), OUTPG};
            pg8::gemm_phase<pg8::EpiResNorm, pg8::StaticOrder, MK_ALIGN, MK_SP2>(F.lds + RING_OFF, g, S, E);
        }
        SEAM(p0 + LP_GDN);
    }
    if (IN(PH_FIN)) { RETID(); ph_final(F, ap); }
#undef IN
#undef SEAM
}

extern "C" void kernel_launch(void* const* d_in, const int* in_sizes, int n_in, void* d_out, int out_size, void* d_ws, size_t ws_size, hipStream_t stream) {
    static int grid = 0;
    if (grid == 0) {
        if (n_in != 24 || in_sizes[0] != M * D || out_size != M * D || ws_size < WS_END) { fprintf(stderr, "kernel_launch: built for 24 inputs, x and out of %d floats, >= %zu bytes of workspace; got n_in %d, in0 %d, out %d, ws %zu; nothing launched\n", M * D, (size_t)WS_END, n_in, n_in > 0 ? in_sizes[0] : -1, out_size, ws_size); grid = -1; return; }
        int dev = 0, cus = 0, per_cu = 0;
        if (hipGetDevice(&dev) != hipSuccess || hipDeviceGetAttribute(&cus, hipDeviceAttributeMultiprocessorCount, dev) != hipSuccess) { fprintf(stderr, "kernel_launch: hipGetDevice / hipDeviceGetAttribute failed; nothing launched\n"); grid = -1; return; }
        if (hipFuncSetAttribute((const void*)hybrid_fwd, hipFuncAttributeMaxDynamicSharedMemorySize, LDS_BYTES) != hipSuccess) { fprintf(stderr, "kernel_launch: hipFuncSetAttribute failed\n"); grid = -1; return; }
        if (hipOccupancyMaxActiveBlocksPerMultiprocessor(&per_cu, (const void*)hybrid_fwd, NWAVES * 64, LDS_BYTES) != hipSuccess || per_cu < 1)
            fprintf(stderr, "kernel_launch: note: the occupancy query reports %d workgroups per CU\n", per_cu);
        (void)hipGetLastError();
        if (cus < 256) { fprintf(stderr, "kernel_launch: built for a 256-CU device (MI355X); this one reports %d CUs; nothing launched\n", cus); grid = -1; return; }
        grid = 256;
    }
    if (grid < 0) return;
    if (hipMemsetAsync((char*)d_ws + WS_CTL, 0, CTL_ZERO_BYTES, stream) != hipSuccess) { fprintf(stderr, "kernel_launch: hipMemsetAsync failed\n"); return; }
    Args a{};
    for (int i = 0; i < 24; ++i) a.in[i] = (const float*)d_in[i];
    a.out = (float*)d_out; a.ws = (unsigned char*)d_ws; a.li = 0; a.pad = 0;
#if MK_ONE_LAUNCH
    a.ph_lo = 0; a.ph_hi = NPH;
    hipLaunchKernelGGL(hybrid_fwd, dim3(grid), dim3(NWAVES * 64), LDS_BYTES, stream, a);
#else
    for (int p = 0; p < NPH; ++p) {
        a.ph_lo = p; a.ph_hi = p + 1;
        hipLaunchKernelGGL(hybrid_fwd, dim3(grid), dim3(NWAVES * 64), LDS_BYTES, stream, a);
    }
#endif
    const hipError_t le = hipPeekAtLastError();
    if (le != hipSuccess) fprintf(stderr, "kernel_launch: launch failed: %s\n", hipGetErrorName(le));
}
```

```cpp
#include <hip/hip_runtime.h>
#include <cstdio>
#include <cstdint>
#ifndef MK_GLOBAL_GROUPS
#define MK_GLOBAL_GROUPS 30
#endif
#ifndef MK_REP
#define MK_REP 0
#endif
namespace pg8 {
#define PG8_LAS __attribute__((address_space(3)))
typedef unsigned short bf16_t;
typedef short bf16x8 __attribute__((ext_vector_type(8)));
typedef float f32x4 __attribute__((ext_vector_type(4)));
typedef unsigned u32x4 __attribute__((ext_vector_type(4)));
constexpr int BM = 256, BK = 64, HALF = 128, HTB = HALF * BK * 2  , STAGE_BYTES = 8 * HTB, NXCD = 8, WGM = 8;

__host__ __device__ __forceinline__ int lds_byte(int r, int c) { const int st = (r >> 4) * 2 + (c >> 5), rr = r & 15, cc = c & 31, ob = rr * 64 + cc * 2; return st * 1024 + (ob ^ (((ob >> 9) & 1) << 5)); }
__host__ __device__ __forceinline__ void stage_rc(int b, int& R, int& C) { const int st = b / 1024, sb = b % 1024, swz = sb ^ (((sb >> 9) & 1) << 5); R = (st >> 1) * 16 + swz / 64; C = (st & 1) * 32 + (swz % 64) / 2; }
__host__ __device__ __forceinline__ int perm32(int rho) { const int n = rho >> 4, i = rho & 15; return 8 * (i >> 2) + 4 * n + (i & 3); }

struct Unit { int pm, pn; };
struct Gemm { const bf16_t* A; const bf16_t* Bt; int M, N, K; };

struct StaticOrder {
    int nM, nN, nwg, G, c;
    __host__ __device__ void init(int M, int N, int G_, int c_) { nM = M / BM; nN = N / BM; nwg = nM * nN; G = G_; c = c_; }
    __host__ __device__ bool next(int i, Unit& u) const {
        const long L = (long)i * G + c; if (L >= nwg) return false;
        int wgid = (int)L; { const int q = nwg / NXCD, r = nwg % NXCD, xcd = wgid % NXCD, off = wgid / NXCD; wgid = (xcd < r ? xcd * (q + 1) : r * (q + 1) + (xcd - r) * q) + off; }
        const int nig = WGM * nN, gid = wgid / nig, fm = gid * WGM, gsz = (nM - fm) < WGM ? (nM - fm) : WGM;
        u.pm = fm + ((wgid % nig) % gsz); u.pn = (wgid % nig) / gsz; return true;
    }
    __device__ __forceinline__ void a_ready(const Unit&) const {}
    __device__ __forceinline__ void done(const Unit&) const {}
};

typedef float f32x2c __attribute__((ext_vector_type(2))); typedef __bf16 bf16x2c __attribute__((ext_vector_type(2)));
__device__ __forceinline__ unsigned cvt_pk_bf16(float lo, float hi) { const f32x2c v = {lo, hi}; return __builtin_bit_cast(unsigned, __builtin_convertvector(v, bf16x2c)); }
typedef float f32x2 __attribute__((ext_vector_type(2)));
__device__ __forceinline__ float bf_lo(unsigned w) { return __builtin_bit_cast(float, w << 16); }
__device__ __forceinline__ float bf_hi(unsigned w) { return __builtin_bit_cast(float, w & 0xffff0000u); }
__device__ __forceinline__ float sigmoidf_(float x) { return 1.0f / (1.0f + __expf(-x)); }
template <int MODE> struct EpiB {
    static constexpr bool PERM = true, AFTER_DRAIN = false;
    bf16_t* O; int ldc; const bf16_t* gate; int ldg; const float* ss;
    __device__ __forceinline__ void operator()(const f32x4 (&acc)[2][2][4][2], const Unit& u, int wr, int wc, int fr, int fq) const {
        const int row0 = u.pm * BM + wr * 64 + fr, col0 = u.pn * BM + wc * 32 + 8 * fq;
        float rs[2][4];
        for (int rep_ = 0; rep_ < ((MK_REP & 128) ? 2 : 1); ++rep_) { asm volatile("" ::: "memory");
        if (MODE <= 1) {
            typedef __attribute__((address_space(1))) const f32x4 gf4;
            f32x4 q[2][4][2];
#pragma unroll
            for (int ai = 0; ai < 2; ++ai)
#pragma unroll
                for (int m = 0; m < 4; ++m) { gf4* sp = (gf4*)(ss + (size_t)(row0 + ai * HALF + m * 16) * 32) + fq * 2; q[ai][m][0] = sp[0]; q[ai][m][1] = sp[1]; }
#pragma unroll
            for (int ai = 0; ai < 2; ++ai)
#pragma unroll
                for (int m = 0; m < 4; ++m) { const f32x4 a = q[ai][m][0] + q[ai][m][1]; rs[ai][m] = (a[0] + a[1]) + (a[2] + a[3]); }
#pragma unroll
            for (int ai = 0; ai < 2; ++ai)
#pragma unroll
                for (int m = 0; m < 4; ++m) rs[ai][m] += __shfl_xor(rs[ai][m], 16);
#pragma unroll
            for (int ai = 0; ai < 2; ++ai)
#pragma unroll
                for (int m = 0; m < 4; ++m) { rs[ai][m] += __shfl_xor(rs[ai][m], 32); rs[ai][m] = __builtin_amdgcn_rsqf(rs[ai][m] * (1.0f / 2048.0f) + 1e-6f); }
        }
        if (MK_REP & 128) asm volatile("" : "+v"(rs[0][0]), "+v"(rs[1][3]) :: "memory"); }
        int ne_ = ((MK_REP & 16384) && MODE == 1) ? 2 : 1; asm volatile("" : "+s"(ne_));
#pragma unroll 1
        for (int re_ = 0; re_ < ne_; ++re_)
#pragma unroll
        for (int ai = 0; ai < 2; ++ai)
#pragma unroll
            for (int m = 0; m < 4; ++m) { const size_t row = (size_t)(row0 + ai * HALF + m * 16);
#pragma unroll
                for (int bj = 0; bj < 2; ++bj) { f32x4 v0 = acc[ai][bj][m][0], v1 = acc[ai][bj][m][1]; const int c = col0 + bj * HALF;
                    if (MODE <= 1) { v0 = v0 * rs[ai][m]; v1 = v1 * rs[ai][m]; }
                    if (MODE == 1) {
#pragma unroll
                        for (int j = 0; j < 4; ++j) { const float a = fmaxf(v0[j], 0.f), b = fmaxf(v1[j], 0.f); v0[j] = a * a; v1[j] = b * b; } }
                    if (MODE >= 2) { const u32x4 g = *(const u32x4*)(gate + row * ldg + c);
                        v0[0] *= sigmoidf_(bf_lo(g.x)); v0[1] *= sigmoidf_(bf_hi(g.x)); v0[2] *= sigmoidf_(bf_lo(g.y)); v0[3] *= sigmoidf_(bf_hi(g.y));
                        v1[0] *= sigmoidf_(bf_lo(g.z)); v1[1] *= sigmoidf_(bf_hi(g.z)); v1[2] *= sigmoidf_(bf_lo(g.w)); v1[3] *= sigmoidf_(bf_hi(g.w)); }
                    if (MODE == 3) { const u32x4 o = *(const u32x4*)(O + row * ldc + c);
                        v0[0] += bf_lo(o.x); v0[1] += bf_hi(o.x); v0[2] += bf_lo(o.y); v0[3] += bf_hi(o.y);
                        v1[0] += bf_lo(o.z); v1[1] += bf_hi(o.z); v1[2] += bf_lo(o.w); v1[3] += bf_hi(o.w); }
                    u32x4 w; w.x = cvt_pk_bf16(v0[0], v0[1]); w.y = cvt_pk_bf16(v0[2], v0[3]); w.z = cvt_pk_bf16(v1[0], v1[1]); w.w = cvt_pk_bf16(v1[2], v1[3]);
                    *(u32x4*)(O + row * ldc + c) = w; } }
    }
};
struct EpiResNorm {
    static constexpr bool PERM = true, AFTER_DRAIN = false;
    bf16_t* XB; int ldc; float* SS;
    __device__ __forceinline__ void operator()(const f32x4 (&acc)[2][2][4][2], const Unit& u, int wr, int wc, int fr, int fq) const {
        const int row0 = u.pm * BM + wr * 64 + fr, col0 = u.pn * BM + wc * 32 + 8 * fq;
#pragma unroll
        for (int ai = 0; ai < 2; ++ai) {
            u32x4 o[4][2];
#pragma unroll
            for (int m = 0; m < 4; ++m)
#pragma unroll
                for (int bj = 0; bj < 2; ++bj) o[m][bj] = *(const u32x4*)(XB + (size_t)(row0 + ai * HALF + m * 16) * ldc + col0 + bj * HALF);
#pragma unroll
            for (int m = 0; m < 4; ++m) { const size_t row = (size_t)(row0 + ai * HALF + m * 16);
                float s = 0.f;
#pragma unroll
                for (int bj = 0; bj < 2; ++bj) { const int c = col0 + bj * HALF; const u32x4 r = o[m][bj];
                    f32x4 x0 = acc[ai][bj][m][0], x1 = acc[ai][bj][m][1];
                    x0[0] += bf_lo(r.x); x0[1] += bf_hi(r.x); x0[2] += bf_lo(r.y); x0[3] += bf_hi(r.y); x1[0] += bf_lo(r.z); x1[1] += bf_hi(r.z); x1[2] += bf_lo(r.w); x1[3] += bf_hi(r.w);
                    u32x4 w; w.x = cvt_pk_bf16(x0[0], x0[1]); w.y = cvt_pk_bf16(x0[2], x0[3]); w.z = cvt_pk_bf16(x1[0], x1[1]); w.w = cvt_pk_bf16(x1[2], x1[3]);
                    *(u32x4*)(XB + row * ldc + c) = w;
                    s += ((x0[0] * x0[0] + x0[1] * x0[1]) + (x0[2] * x0[2] + x0[3] * x0[3])) + ((x1[0] * x1[0] + x1[1] * x1[1]) + (x1[2] * x1[2] + x1[3] * x1[3])); }
                s += __shfl_xor(s, 16); s += __shfl_xor(s, 32);
                if (fq == 0) SS[row * 32 + u.pn * 4 + wc] = s; } }
    }
};

template <class Epi, class Sched, bool ALIGN_EPI = false, bool SP2 = false>
__device__ __forceinline__ void gemm_phase(PG8_LAS unsigned char* lds, const Gemm g, const Sched& S, const Epi& E) {
    int tid_ = threadIdx.x; asm volatile("" : "+v"(tid_));
    const int tid = tid_, wid = __builtin_amdgcn_readfirstlane(tid >> 6), lane = tid & 63, wr = wid >> 2, wc = wid & 3, fr = lane & 15, fq = lane >> 4;
    const int K = g.K, nt = K / BK;
    unsigned voffA[2], voffB[2];
#pragma unroll
    for (int i = 0; i < 2; ++i) { int R, C; stage_rc(tid * 16 + i * 8192, R, C); const int Rb = Epi::PERM ? ((R & ~31) + perm32(R & 31)) : R;
        voffA[i] = (unsigned)(R * K + C) * 2u; voffB[i] = (unsigned)(Rb * K + C) * 2u; }
    const size_t kstep = (size_t)(BK * 2);
    const size_t hstep = (size_t)HALF * K * 2;
    const size_t tstep = 2 * hstep;
    const unsigned ldsw = (unsigned)wid * 1024u;
    const int aoff = lds_byte(wr * 64 + fr, fq * 8), boff = lds_byte(wc * 32 + fr, fq * 8);
#define PG8_SA(b, h) (((b) * 2 + (h)) * HTB)
#define PG8_SB(b, h) ((4 + (b) * 2 + (h)) * HTB)
#define PG8_STAGE(bufoff, gbase, voff) do { _Pragma("unroll") for (int _i = 0; _i < 2; ++_i) \
        __builtin_amdgcn_global_load_lds((const unsigned*)((const char*)(gbase) + (voff)[_i]), (PG8_LAS unsigned*)(lds + (bufoff) + ldsw + _i * 8192), 16, 0, 0); } while (0)
#define PG8_LDA(dst, b, h) do { _Pragma("unroll") for (int m = 0; m < 4; ++m) _Pragma("unroll") for (int k = 0; k < 2; ++k) dst[m][k] = *(const PG8_LAS bf16x8*)(lds + PG8_SA(b, h) + aoff + m * 2048 + k * 1024); } while (0)
#define PG8_LDB(dst, b, h) do { _Pragma("unroll") for (int n = 0; n < 2; ++n) _Pragma("unroll") for (int k = 0; k < 2; ++k) dst[n][k] = *(const PG8_LAS bf16x8*)(lds + PG8_SB(b, h) + boff + n * 2048 + k * 1024); } while (0)
#define PG8_MMA(ai, bj, At, Bt) do { __builtin_amdgcn_s_setprio(1); _Pragma("unroll") for (int m = 0; m < 4; ++m) _Pragma("unroll") for (int n = 0; n < 2; ++n) _Pragma("unroll") for (int k = 0; k < 2; ++k) \
        acc[ai][bj][m][n] = __builtin_amdgcn_mfma_f32_16x16x32_bf16(Bt[n][k], At[m][k], acc[ai][bj][m][n], 0, 0, 0); __builtin_amdgcn_s_setprio(0); } while (0)
#define PG8_WAIT_V(n) asm volatile("s_waitcnt vmcnt(" #n ")" ::: "memory")
#define PG8_WAIT_L(n) asm volatile("s_waitcnt lgkmcnt(" #n ")" ::: "memory")
#define PG8_BAR __builtin_amdgcn_s_barrier()
#define PG8_SCHED __builtin_amdgcn_sched_barrier(0)
    Unit cur, nxt; int ui = 0;
    if (!S.next(0, cur)) return;
    f32x4 acc[2][2][4][2];
#pragma unroll
    for (int a = 0; a < 2; ++a)
#pragma unroll
        for (int b = 0; b < 2; ++b)
#pragma unroll
            for (int m = 0; m < 4; ++m)
#pragma unroll
                for (int n = 0; n < 2; ++n) acc[a][b][m][n] = (f32x4){0.f, 0.f, 0.f, 0.f};
    bf16x8 At[4][2], B0[2][2], B1[2][2];
    const char* cA = (const char*)g.A + (size_t)cur.pm * tstep; const char* cB = (const char*)g.Bt + (size_t)cur.pn * tstep;
    S.a_ready(cur);
    if constexpr (SP2) {
        PG8_STAGE(PG8_SB(0, 0), cB, voffB); PG8_STAGE(PG8_SB(0, 1), cB + hstep, voffB); PG8_STAGE(PG8_SA(0, 0), cA, voffA); PG8_STAGE(PG8_SA(0, 1), cA + hstep, voffA);
        if (wr == 1) PG8_BAR;
        PG8_WAIT_V(2); PG8_BAR;
        PG8_STAGE(PG8_SB(1, 0), cB + kstep, voffB); PG8_STAGE(PG8_SA(1, 0), cA + kstep, voffA); PG8_STAGE(PG8_SB(1, 1), cB + hstep + kstep, voffB);
        PG8_WAIT_V(6); PG8_BAR;
    } else {
        PG8_STAGE(PG8_SB(0, 0), cB, voffB); PG8_STAGE(PG8_SA(0, 0), cA, voffA); PG8_STAGE(PG8_SB(0, 1), cB + hstep, voffB); PG8_STAGE(PG8_SA(0, 1), cA + hstep, voffA);
        if (wr == 1) PG8_BAR;
        PG8_WAIT_V(4); PG8_BAR;
        PG8_STAGE(PG8_SB(1, 0), cB + kstep, voffB); PG8_STAGE(PG8_SA(1, 0), cA + kstep, voffA); PG8_STAGE(PG8_SB(1, 1), cB + hstep + kstep, voffB);
        PG8_WAIT_V(6); PG8_BAR;
    }
    for (;;) {
        const bool has_next = S.next(ui + 1, nxt);
        const char* nA = has_next ? (const char*)g.A + (size_t)nxt.pm * tstep : cA; const char* nB = has_next ? (const char*)g.Bt + (size_t)nxt.pn * tstep : cB;
        for (int t = 0; t < nt; t += 2) {
            const bool last = (t == nt - 2);
            const char* a1 = cA + (size_t)(t + 1) * kstep;
            const char* a2 = last ? nA : cA + (size_t)(t + 2) * kstep; const char* b2 = last ? nB : cB + (size_t)(t + 2) * kstep;
            const char* a3 = a2 + kstep; const char* b3 = b2 + kstep;
            if (last && has_next) S.a_ready(nxt);
            if constexpr (SP2) {
            PG8_LDB(B0, 0, 0); PG8_LDB(B1, 0, 1); PG8_SCHED; PG8_LDA(At, 0, 0); PG8_STAGE(PG8_SA(1, 1), a1 + hstep, voffA);
            PG8_WAIT_V(8); PG8_WAIT_L(0); PG8_BAR; PG8_MMA(0, 0, At, B0); PG8_MMA(0, 1, At, B1); PG8_BAR; PG8_SCHED;
            PG8_LDA(At, 0, 1); PG8_STAGE(PG8_SB(0, 0), b2, voffB); PG8_STAGE(PG8_SB(0, 1), b2 + hstep, voffB); PG8_STAGE(PG8_SA(0, 0), a2, voffA);
            PG8_WAIT_V(8); PG8_WAIT_L(0); PG8_BAR; PG8_MMA(1, 0, At, B0); PG8_MMA(1, 1, At, B1); PG8_BAR; PG8_SCHED;
            PG8_LDB(B0, 1, 0); PG8_LDB(B1, 1, 1); PG8_SCHED; PG8_LDA(At, 1, 0); PG8_STAGE(PG8_SA(0, 1), a2 + hstep, voffA);
            PG8_WAIT_V(8); PG8_WAIT_L(0); PG8_BAR; PG8_MMA(0, 0, At, B0); PG8_MMA(0, 1, At, B1); PG8_BAR; PG8_SCHED;
            PG8_LDA(At, 1, 1); PG8_STAGE(PG8_SB(1, 0), b3, voffB); PG8_STAGE(PG8_SB(1, 1), b3 + hstep, voffB); PG8_STAGE(PG8_SA(1, 0), a3, voffA);
            PG8_WAIT_V(8); PG8_WAIT_L(0); PG8_BAR; PG8_MMA(1, 0, At, B0); PG8_MMA(1, 1, At, B1); PG8_BAR; PG8_SCHED;
            } else {
            PG8_LDB(B0, 0, 0); PG8_SCHED; PG8_LDA(At, 0, 0); PG8_STAGE(PG8_SA(1, 1), a1 + hstep, voffA);
            PG8_WAIT_L(8); PG8_BAR; PG8_WAIT_L(0); PG8_MMA(0, 0, At, B0); PG8_BAR; PG8_SCHED;
            PG8_LDB(B1, 0, 1); PG8_STAGE(PG8_SB(0, 0), b2, voffB);
            PG8_BAR; PG8_WAIT_L(0); PG8_MMA(0, 1, At, B1); PG8_BAR;
            PG8_LDA(At, 0, 1); PG8_STAGE(PG8_SA(0, 0), a2, voffA);
            PG8_BAR; PG8_WAIT_L(0); PG8_MMA(1, 0, At, B0); PG8_BAR; PG8_SCHED;
            PG8_STAGE(PG8_SB(0, 1), b2 + hstep, voffB);
            PG8_WAIT_V(6); PG8_BAR; PG8_MMA(1, 1, At, B1); PG8_BAR;
            PG8_LDB(B0, 1, 0); PG8_SCHED; PG8_LDA(At, 1, 0); PG8_STAGE(PG8_SA(0, 1), a2 + hstep, voffA);
            PG8_WAIT_L(8); PG8_BAR; PG8_WAIT_L(0); PG8_MMA(0, 0, At, B0); PG8_BAR; PG8_SCHED;
            PG8_LDB(B1, 1, 1); PG8_STAGE(PG8_SB(1, 0), b3, voffB);
            PG8_BAR; PG8_WAIT_L(0); PG8_MMA(0, 1, At, B1); PG8_BAR;
            PG8_LDA(At, 1, 1); PG8_STAGE(PG8_SA(1, 0), a3, voffA);
            PG8_BAR; PG8_WAIT_L(0); PG8_MMA(1, 0, At, B0); PG8_BAR; PG8_SCHED;
            PG8_STAGE(PG8_SB(1, 1), b3 + hstep, voffB);
            PG8_WAIT_V(6); PG8_BAR; PG8_MMA(1, 1, At, B1); PG8_BAR;
            }
        }
        if constexpr (ALIGN_EPI) { if (wr == 0) PG8_BAR; }
        if constexpr (!Epi::AFTER_DRAIN) { E(acc, cur, wr, wc, fr, fq); S.done(cur); }
        if (!has_next) break;
#pragma unroll
        for (int a = 0; a < 2; ++a)
#pragma unroll
            for (int b = 0; b < 2; ++b)
#pragma unroll
                for (int m = 0; m < 4; ++m)
#pragma unroll
                    for (int n = 0; n < 2; ++n) acc[a][b][m][n] = (f32x4){0.f, 0.f, 0.f, 0.f};
        cur = nxt; cA = nA; cB = nB; ++ui;
        if constexpr (ALIGN_EPI) { if (wr == 1) PG8_BAR; }
    }
    PG8_WAIT_V(0);
    if constexpr (!ALIGN_EPI) { if (wr == 0) PG8_BAR; }
    PG8_BAR;
    if constexpr (Epi::AFTER_DRAIN) { E.fused(acc, cur, wr, wc, fr, fq, lds, wid, lane); S.done(cur); }
#undef PG8_SA
#undef PG8_SB
#undef PG8_STAGE
#undef PG8_LDA
#undef PG8_LDB
#undef PG8_MMA
#undef PG8_WAIT_V
#undef PG8_WAIT_L
#undef PG8_BAR
#undef PG8_SCHED
}
}
constexpr int NWAVES = 8;
#ifndef MK_ONE_LAUNCH
#define MK_ONE_LAUNCH 1
#endif

#ifndef MK_GLOBAL_GROUPS
#define MK_GLOBAL_GROUPS 30
#endif
#ifndef MK_CHUNKED
#define MK_CHUNKED 1
#endif
#ifndef MK_SP2
#define MK_SP2 true
#endif
#ifndef MK_ALIGN
#define MK_ALIGN true
#endif
#ifndef MK_CONV_IN_G1
#define MK_CONV_IN_G1 0
#endif
#ifndef MK_X2_NT
#define MK_X2_NT 0
#endif
#ifndef MK_REP
#define MK_REP 0
#endif

constexpr int BATCH = 2, SEQ = 8192, D = 2048, DEPTH = 4, M = BATCH * SEQ;
constexpr int RETW = 1024, RH = 8, RD = 128, RWW = 1024, WH = 16, WD = 64;
constexpr int INW = 11520, DFF = 8192, RWSHIFT = 3328;
constexpr int ZC_Q = 0, ZC_K = 1024, ZC_V = 2048, ZC_GR = 3072, ZC_RW = 4096, ZC_GA = 7424, ZC_GB = 9472;
constexpr int RWC_R = 0, RWC_K = 1024, RWC_V = 2048, RWC_W = 3072, RWC_A = 3136, RWC_G = 3200;
constexpr float NORM_EPS = 1e-6f, RET_GN_EPS = 1e-5f, RWKV_LN_EPS = 64e-5f;

constexpr size_t MiB = 1u << 20;
constexpr size_t WS_CTL = 0, CTL_ZERO_BYTES = 1 * MiB;
constexpr size_t WS_ROPE = 1 * MiB;
constexpr size_t WS_WSET = 16 * MiB, WSET_BYTES = 126 * MiB;
constexpr size_t WO_WIN = 0, WO_WA = 45 * MiB, WO_WB = 49 * MiB, WO_WO = 53 * MiB, WO_WUP = 61 * MiB, WO_WDN = 93 * MiB, WO_LORA = 125 * MiB;
constexpr size_t WS_H = 272 * MiB;
constexpr size_t WS_Z = 336 * MiB;
constexpr size_t WS_UP = WS_Z;
constexpr size_t WS_QR = 696 * MiB, WS_KR = 728 * MiB;
constexpr size_t WS_YRET = 760 * MiB, WS_YRWKV = 792 * MiB;
constexpr size_t WS_MRG = 824 * MiB;
#if MK_CHUNKED
constexpr size_t WS_SR = 888 * MiB, WS_SV = 1208 * MiB;
#else
constexpr size_t WS_SR = 888 * MiB, WS_SW = 952 * MiB, WS_SK = 1016 * MiB, WS_SV = 1080 * MiB, WS_SNKK = 1144 * MiB, WS_SKKA = 1208 * MiB;
#endif
constexpr size_t WS_CU = WS_SR;
constexpr size_t WS_G = 1272 * MiB;
constexpr size_t WS_BONUS = 1336 * MiB;
constexpr size_t WS_SS = 1337 * MiB;
constexpr size_t WS_YRAWW = WS_MRG;
constexpr size_t WS_END = 1341 * MiB;
constexpr int CW_BAR = 4096;

constexpr int PPL = 9;
enum { LP_G1 = 0, LP_PREP, LP_SCAN, LP_POST, LP_GA, LP_GB, LP_GO, LP_GUP, LP_GDN };
constexpr int PH_PRO = 0, PH_L0 = 1, PH_FIN = PH_L0 + DEPTH * PPL, NPH = PH_FIN + 1;

constexpr int RING_OFF = 0, RING_BYTES = 131072;
constexpr int LDSCTL_OFF = RING_BYTES, MISC_OFF = LDSCTL_OFF + 320;
constexpr int LDS_BYTES = 147456;
static_assert(MISC_OFF + 128 <= LDS_BYTES, "LDS map");

#define GAS __attribute__((address_space(1)))
#define LAS __attribute__((address_space(3)))
typedef unsigned short bf16;
typedef unsigned v4u __attribute__((ext_vector_type(4)));
typedef unsigned v2u __attribute__((ext_vector_type(2)));
typedef float f32x4 __attribute__((ext_vector_type(4)));
typedef float f32x2 __attribute__((ext_vector_type(2)));
typedef short bf16x8 __attribute__((ext_vector_type(8)));
typedef GAS unsigned gu32;
#define LDS_WAIT() asm volatile("s_waitcnt lgkmcnt(0)" ::: "memory")
#define VM_WAIT() asm volatile("s_waitcnt vmcnt(0)" ::: "memory")
__device__ __forceinline__ unsigned f2bf(float f) { unsigned u = __builtin_bit_cast(unsigned, f); return (u + 0x7fffu + ((u >> 16) & 1u)) >> 16; }
__device__ __forceinline__ unsigned pk2(float lo, float hi) { return f2bf(lo) | (f2bf(hi) << 16); }
__device__ __forceinline__ float bf2f(bf16 v) { return __builtin_bit_cast(float, (unsigned)v << 16); }
__device__ __forceinline__ float rdlane(float v, int l) { return __builtin_bit_cast(float, __builtin_amdgcn_readlane(__builtin_bit_cast(int, v), l)); }
__device__ __forceinline__ float sigm(float x) { return 1.0f / (1.0f + expf(-x)); }

__device__ const double ROPE_REV[64] = {
0.15915494309189535, 0.13782250260398285, 0.11934937021124886, 0.10335229661843406,
0.08949940160889101, 0.07750328875537406, 0.06711508300522726, 0.058119267441876246,
0.050329212104487035, 0.04358330210530733, 0.03774158471741977, 0.032682865872357,
0.0283021958306234, 0.024508691862069852, 0.02122365276477766, 0.018378926105679667,
0.015915494309189534, 0.013782250260398284, 0.011934937021124886, 0.010335229661843406,
0.008949940160889102, 0.0077503288755374055, 0.006711508300522725, 0.005811926744187624,
0.005032921210448704, 0.004358330210530733, 0.003774158471741977, 0.0032682865872356993,
0.00283021958306234, 0.002450869186206985, 0.0021223652764777662, 0.0018378926105679667,
0.0015915494309189536, 0.0013782250260398288, 0.0011934937021124885, 0.0010335229661843405,
0.0008949940160889102, 0.0007750328875537405, 0.0006711508300522726, 0.0005811926744187624,
0.0005032921210448703, 0.0004358330210530733, 0.00037741584717419774, 0.0003268286587235699,
0.00028302195830623395, 0.00024508691862069854, 0.0002122365276477766, 0.00018378926105679666,
0.00015915494309189535, 0.00013782250260398286, 0.00011934937021124886, 0.00010335229661843406,
8.949940160889102e-05, 7.750328875537406e-05, 6.711508300522725e-05, 5.811926744187624e-05,
5.0329212104487035e-05, 4.358330210530732e-05, 3.774158471741978e-05, 3.2682865872357e-05,
2.8302195830623396e-05, 2.4508691862069852e-05, 2.122365276477766e-05, 1.8378926105679668e-05 };

#define XB_TMO      128
#define XB_XCNT(j)  (256  + 64 * (j))
#define XB_XSUB(j)  (1280 + 64 * (j))
#define XB_XGEN(j)  (2304 + 64 * (j))
#define XB_TOP      3328
#define XB_TOPGEN   3392
#define XCD_BAR_WORDS 3456
#define XB_SPIN_CAP (1u << 18)

__device__ __forceinline__ unsigned xb_ld(unsigned* p)              { return __hip_atomic_load(p, __ATOMIC_RELAXED, __HIP_MEMORY_SCOPE_AGENT); }
__device__ __forceinline__ unsigned xb_add(unsigned* p, unsigned v) { return __hip_atomic_fetch_add(p, v, __ATOMIC_RELAXED, __HIP_MEMORY_SCOPE_AGENT); }
__device__ __forceinline__ unsigned xb_xcc_id() { return (unsigned)__builtin_amdgcn_s_getreg((3 << 11) | 20) & 0xFu; }
#define XB_SPIN(cond, bar) do { unsigned _sp = 0; while (cond) { __builtin_amdgcn_s_sleep(1); \
    if ((++_sp & 255u) == 0u) { if (xb_ld(&(bar)[XB_TMO])) break; if (_sp > XB_SPIN_CAP) { atomicAdd(&(bar)[XB_TMO], 1u); break; } } } } while (0)

struct XcdBarrier {
    unsigned* bar; unsigned x;
    volatile LAS unsigned* st;
};

__device__ __forceinline__ XcdBarrier xcd_barrier_post(unsigned* bar, volatile LAS unsigned* st) {
    XcdBarrier b; b.bar = bar; b.x = xb_xcc_id(); b.st = st;
    if (threadIdx.x == 0) (void)xb_add(&bar[XB_XCNT(b.x)], 1u);
    return b;
}
__device__ __forceinline__ void xcd_barrier_complete(unsigned* bar, unsigned x, unsigned& nloc, unsigned& nx) {
    const unsigned G = gridDim.x * gridDim.y * gridDim.z;
    unsigned sum, cnt, mine, sp = 0u;
    for (;;) {
        sum = 0u; cnt = 0u; mine = 0u;
#pragma unroll
        for (unsigned j = 0; j < 16; ++j) { const unsigned c = xb_ld(&bar[XB_XCNT(j)]); sum += c; cnt += (c > 0u) ? 1u : 0u; mine = (j == x) ? c : mine; }
        if (sum == G) break;
        __builtin_amdgcn_s_sleep(1);
        if ((++sp & 255u) == 0u) { if (xb_ld(&bar[XB_TMO])) break; if (sp > XB_SPIN_CAP) { atomicAdd(&bar[XB_TMO], 1u); break; } }
    }
    nloc = mine > 0u ? mine : 1u; nx = cnt > 0u ? cnt : 1u;
}

__device__ __forceinline__ void xcd_barrier(const XcdBarrier& b) {
    asm volatile("s_waitcnt vmcnt(0)" ::: "memory");
    __syncthreads();
    if (threadIdx.x == 0) {
        unsigned* bar = b.bar;
        __builtin_amdgcn_s_waitcnt(0);
        unsigned nloc = b.st[0], nx = b.st[1];
        if (nloc == 0u) { xcd_barrier_complete(bar, b.x, nloc, nx); b.st[0] = nloc; b.st[1] = nx; }
        const unsigned old = xb_add(&bar[XB_XSUB(b.x)], 1u);
        const unsigned gen = old / nloc;
        if (old + 1u == (gen + 1u) * nloc) {
            __builtin_amdgcn_fence(__ATOMIC_RELEASE, "agent");
            asm volatile("s_waitcnt vmcnt(0)" ::: "memory");
            const unsigned og = xb_add(&bar[XB_TOP], 1u);
            const unsigned tg = og / nx;
            if (og + 1u == (tg + 1u) * nx) xb_add(&bar[XB_TOPGEN], 1u);
            else XB_SPIN(xb_ld(&bar[XB_TOPGEN]) == tg, bar);
            __builtin_amdgcn_fence(__ATOMIC_ACQUIRE, "agent");
            xb_add(&bar[XB_XGEN(b.x)], 1u);
            asm volatile("s_waitcnt vmcnt(0)" ::: "memory");
        } else {
            XB_SPIN(xb_ld(&bar[XB_XGEN(b.x)]) == gen, bar);
            __builtin_amdgcn_fence(__ATOMIC_ACQUIRE, "agent");
            asm volatile("s_waitcnt vmcnt(0)" ::: "memory");
        }
    }
    __syncthreads();
}


struct Frame {
    LAS unsigned char* lds;
    volatile LAS unsigned* MISC;
    int tid, lane, wave;
    int vcu, G;
    float* out; unsigned char* ws;
};
struct Args { const float* in[24]; float* out; unsigned char* ws; int ph_lo, ph_hi, li, pad; };
#define WSP(T, off) ((T*)(F.ws + (off)))
#define WSPG(T, off) ((T*)(GAS T*)(unsigned long long)(F.ws + (off)))
#define WSW(l, off) ((bf16*)(F.ws + WS_WSET + (size_t)((l) & 1) * WSET_BYTES + (off)))
#define WSWG(l, off) ((bf16*)(GAS bf16*)(unsigned long long)(F.ws + WS_WSET + (size_t)((l) & 1) * WSET_BYTES + (off)))
#define OUTP ((float*)F.out)
#define OUTPG ((float*)(GAS float*)(unsigned long long)F.out)
#define INP(A, i) ((const float*)((const GAS float*)(A)->in[i]))
#define RETID() do { int t_ = threadIdx.x; asm volatile("" : "+v"(t_)); F.tid = t_; F.lane = t_ & 63; } while (0)
#define CAS __attribute__((address_space(4)))
typedef const CAS Args* ArgP;

__device__ __forceinline__ float fexp(float x) { return __builtin_amdgcn_exp2f(x * 1.4426950408889634f); }
__device__ __forceinline__ float fsig(float x) { return __builtin_amdgcn_rcpf(1.0f + fexp(-x)); }
__device__ __forceinline__ float ftanh(float x) { return 1.0f - 2.0f * __builtin_amdgcn_rcpf(1.0f + fexp(2.0f * x)); }
__device__ __forceinline__ float wave_sum(float v) {
#pragma unroll
    for (int o = 1; o < 64; o <<= 1) v += __shfl_xor(v, o);
    return v;
}
struct TItem { const float* W; bf16* WT; const float* gk; int K, N, item; };
__device__ __forceinline__ void titem_load(const TItem& t, int lane, f32x4 (&v)[8]) {
    const int nblk = t.N / 32, kb = t.item / nblk, nb = t.item % nblk, k0 = 64 * kb, n0 = 32 * nb, nq = lane & 7, kr = lane >> 3;
#pragma unroll
    for (int i = 0; i < 8; ++i) v[i] = *(const GAS f32x4*)(t.W + (size_t)(k0 + kr + 8 * i) * t.N + n0 + 4 * nq);
}
__device__ __forceinline__ void titem_finish(const TItem& t, int lane, const f32x4 (&v)[8], LAS float* scr) {
    const int nblk = t.N / 32, kb = t.item / nblk, nb = t.item % nblk, k0 = 64 * kb, n0 = 32 * nb, nq = lane & 7, kr = lane >> 3;
#pragma unroll
    for (int i = 0; i < 8; ++i)
#pragma unroll
        for (int e = 0; e < 4; ++e) scr[(kr + 8 * i) * 33 + 4 * nq + e] = v[i][e];
    const int c = lane & 7;
    f32x4 g0 = (f32x4){1.f, 1.f, 1.f, 1.f}, g1 = g0;
    if (t.gk) { g0 = *(const GAS f32x4*)(t.gk + k0 + 8 * c); g1 = *(const GAS f32x4*)(t.gk + k0 + 8 * c + 4); }
    LDS_WAIT(); asm volatile("" ::: "memory");
#pragma unroll
    for (int j = 0; j < 4; ++j) { const int n = (lane >> 3) + 8 * j; const LAS float* s = scr + (8 * c) * 33 + n;
        v4u o; o.x = pk2(s[0 * 33] * g0.x, s[1 * 33] * g0.y); o.y = pk2(s[2 * 33] * g0.z, s[3 * 33] * g0.w); o.z = pk2(s[4 * 33] * g1.x, s[5 * 33] * g1.y); o.w = pk2(s[6 * 33] * g1.z, s[7 * 33] * g1.w);
        *(GAS v4u*)(t.WT + (size_t)(n0 + n) * t.K + k0 + 8 * c) = o; }
    LDS_WAIT(); asm volatile("" ::: "memory");
}
__device__ __forceinline__ void rms_row_to_bf16(const float* xrow, const float* g, bf16* orow, int lane) {
    const GAS f32x4* xr = (const GAS f32x4*)xrow + lane;
    f32x4 v[8]; float s = 0.f;
#pragma unroll
    for (int j = 0; j < 8; ++j) { v[j] = xr[64 * j]; s += (v[j].x * v[j].x + v[j].y * v[j].y) + (v[j].z * v[j].z + v[j].w * v[j].w); }
    const float rstd = 1.f / sqrtf(wave_sum(s) * (1.f / D) + NORM_EPS);
    const GAS f32x4* gr = (const GAS f32x4*)g + lane;
    GAS v2u* o8 = (GAS v2u*)orow + lane;
#pragma unroll
    for (int j = 0; j < 8; ++j) { const f32x4 gg = gr[64 * j]; v2u o; o.x = pk2(v[j].x * rstd * gg.x, v[j].y * rstd * gg.y); o.y = pk2(v[j].z * rstd * gg.z, v[j].w * rstd * gg.w); o8[64 * j] = o; }
}

#if (MK_GLOBAL_GROUPS & 1)
#pragma push_macro("WSP")
#pragma push_macro("WSW")
#pragma push_macro("OUTP")
#undef WSP
#undef WSW
#undef OUTP
#define WSP WSPG
#define WSW WSWG
#define OUTP OUTPG
#endif
__device__ __forceinline__ void ph_prologue(Frame& F, ArgP A) {
    const int* pos = (const int*)INP(A, 1); float2* rope = WSP(float2, WS_ROPE);
    {
        const int gw = F.vcu * NWAVES + F.wave, NGW = F.G * NWAVES, lane = F.lane;
        for (int m = gw; m < M; m += NGW) {
            const GAS f32x4* xr = (const GAS f32x4*)(INP(A, 0) + (size_t)m * D) + lane;
            GAS v2u* hb = (GAS v2u*)(WSP(bf16, WS_H) + (size_t)m * D) + lane; float s = 0.f;
#pragma unroll
            for (int j = 0; j < 8; ++j) { const f32x4 v = xr[64 * j]; v2u o; o.x = pk2(v.x, v.y); o.y = pk2(v.z, v.w); hb[64 * j] = o; s += (v.x * v.x + v.y * v.y) + (v.z * v.z + v.w * v.w); }
            s = wave_sum(s);
            if (lane < 32) WSP(float, WS_SS)[(size_t)m * 32 + lane] = lane == 0 ? s : 0.f;
        }
    }
    for (int i = F.vcu * 512 + F.tid; i < M * 64; i += F.G * 512) {
        const int m = i >> 6, j = i & 63;
        const double rev = (double)pos[m] * ROPE_REV[j];
        const float fr = (float)(rev - __builtin_rint(rev));
        rope[i] = make_float2(__builtin_amdgcn_cosf(fr), __builtin_amdgcn_sinf(fr));
    }
}
#if (MK_GLOBAL_GROUPS & 1)
#pragma pop_macro("WSP")
#pragma pop_macro("WSW")
#pragma pop_macro("OUTP")
#endif
#if (MK_GLOBAL_GROUPS & 16)
#pragma push_macro("WSP")
#pragma push_macro("WSW")
#pragma push_macro("OUTP")
#undef WSP
#undef WSW
#undef OUTP
#define WSP WSPG
#define WSW WSWG
#define OUTP OUTPG
#endif
__device__ __forceinline__ TItem conv_item(Frame& F, ArgP A, int l, int it) {
    constexpr int I_IN = (D / 64) * (INW / 32), I_A = (RETW / 64) * (D / 32), I_O = (D / 64) * (D / 32), I_UP = (D / 64) * (DFF / 32), I_DN = (DFF / 64) * (D / 32);
    int r = it; TItem t;
    if (r < I_IN) { t = TItem{INP(A, 3) + (size_t)l * D * INW, WSW(l, WO_WIN), INP(A, 2) + (size_t)l * D, D, INW, r}; return t; } r -= I_IN;
    if (r < I_A) { t = TItem{INP(A, 17) + (size_t)l * RETW * D, WSW(l, WO_WA), nullptr, RETW, D, r}; return t; } r -= I_A;
    if (r < I_A) { t = TItem{INP(A, 18) + (size_t)l * RWW * D, WSW(l, WO_WB), nullptr, RWW, D, r}; return t; } r -= I_A;
    if (r < I_O) { t = TItem{INP(A, 19) + (size_t)l * D * D, WSW(l, WO_WO), nullptr, D, D, r}; return t; } r -= I_O;
    if (r < I_UP) { t = TItem{INP(A, 21) + (size_t)l * D * DFF, WSW(l, WO_WUP), INP(A, 20) + (size_t)l * D, D, DFF, r}; return t; } r -= I_UP;
    if (r < I_DN) { t = TItem{INP(A, 22) + (size_t)l * DFF * D, WSW(l, WO_WDN), nullptr, DFF, D, r}; return t; } r -= I_DN;
    if (r < 32) { t = TItem{INP(A, 8) + (size_t)l * 64 * RWW, WSW(l, WO_LORA), nullptr, 64, RWW, r}; return t; } r -= 32;
    if (r < 32) { t = TItem{INP(A, 10) + (size_t)l * 64 * RWW, WSW(l, WO_LORA) + 1024 * 64, nullptr, 64, RWW, r}; return t; } r -= 32;
    t = TItem{INP(A, 11) + (size_t)l * 128 * RWW, WSW(l, WO_LORA) + 2 * 1024 * 64, nullptr, 128, RWW, r}; return t;
}
__device__ __forceinline__ void ph_convert(Frame& F, ArgP A, int l, int wg, int nwg) {
    LAS float* scr = (LAS float*)(F.lds + RING_OFF + F.wave * 16384);
    const int gw = wg * NWAVES + F.wave, NGW = nwg * NWAVES, lane = F.lane;
    constexpr int I_IN = (D / 64) * (INW / 32), I_A = (RETW / 64) * (D / 32), I_O = (D / 64) * (D / 32), I_UP = (D / 64) * (DFF / 32), I_DN = (DFF / 64) * (D / 32);
    constexpr int NITEMS = I_IN + 2 * I_A + I_O + I_UP + I_DN + 32 + 32 + 64;
    if (gw >= NITEMS) return;
    TItem cur = conv_item(F, A, l, gw); f32x4 va[8], vb[8];
    titem_load(cur, lane, va);
    for (int it = gw; it < NITEMS; it += 2 * NGW) {
        TItem nxt = cur; const bool h1 = it + NGW < NITEMS;
        if (h1) { nxt = conv_item(F, A, l, it + NGW); titem_load(nxt, lane, vb); }
        titem_finish(cur, lane, va, scr);
        if (!h1) break;
        const bool h2 = it + 2 * NGW < NITEMS;
        if (h2) { cur = conv_item(F, A, l, it + 2 * NGW); titem_load(cur, lane, va); }
        titem_finish(nxt, lane, vb, scr);
        if (!h2) break;
    }
}
#if (MK_GLOBAL_GROUPS & 16)
#pragma pop_macro("WSP")
#pragma pop_macro("WSW")
#pragma pop_macro("OUTP")
#endif
#if (MK_GLOBAL_GROUPS & 2)
#pragma push_macro("WSP")
#pragma push_macro("WSW")
#pragma push_macro("OUTP")
#undef WSP
#undef WSW
#undef OUTP
#define WSP WSPG
#define WSW WSWG
#define OUTP OUTPG
#endif
__device__ __forceinline__ f32x4 unpk4(const v2u p) { return (f32x4){pg8::bf_lo(p.x), pg8::bf_hi(p.x), pg8::bf_lo(p.y), pg8::bf_hi(p.y)}; }
__device__ __forceinline__ void unpack8(const v4u a, float (&o)[8]) {
    o[0] = pg8::bf_lo(a.x); o[1] = pg8::bf_hi(a.x); o[2] = pg8::bf_lo(a.y); o[3] = pg8::bf_hi(a.y); o[4] = pg8::bf_lo(a.z); o[5] = pg8::bf_hi(a.z); o[6] = pg8::bf_lo(a.w); o[7] = pg8::bf_hi(a.w);
}
__device__ __forceinline__ void mix8(const GAS bf16* zc, bool has_prev, const GAS float* mu, float (&o)[8]) {
    const v4u a = *(const GAS v4u*)zc; v4u p = (v4u){0u, 0u, 0u, 0u}; if (has_prev) p = *(const GAS v4u*)(zc - INW);
    const f32x4 m0 = *(const GAS f32x4*)mu, m1 = *(const GAS f32x4*)(mu + 4);
    float z[8], q[8]; unpack8(a, z); unpack8(p, q);
#pragma unroll
    for (int j = 0; j < 4; ++j) { o[j] = z[j] + m0[j] * (q[j] - z[j]); o[4 + j] = z[4 + j] + m1[j] * (q[4 + j] - z[4 + j]); }
}
__device__ __forceinline__ f32x4 mix4(const GAS bf16* zc, bool has_prev, const GAS float* mu) {
    const v2u a = *(const GAS v2u*)zc; v2u p = (v2u){0u, 0u}; if (has_prev) p = *(const GAS v2u*)(zc - INW);
    const f32x4 m = *(const GAS f32x4*)mu;
    const f32x4 z = (f32x4){pg8::bf_lo(a.x), pg8::bf_hi(a.x), pg8::bf_lo(a.y), pg8::bf_hi(a.y)}, q = (f32x4){pg8::bf_lo(p.x), pg8::bf_hi(p.x), pg8::bf_lo(p.y), pg8::bf_hi(p.y)};
    return z + m * (q - z);
}
__device__ __forceinline__ bf16x8 pack8(const float (&v)[8]) {
    v4u o; o.x = pg8::cvt_pk_bf16(v[0], v[1]); o.y = pg8::cvt_pk_bf16(v[2], v[3]); o.z = pg8::cvt_pk_bf16(v[4], v[5]); o.w = pg8::cvt_pk_bf16(v[6], v[7]);
    return __builtin_bit_cast(bf16x8, o);
}
constexpr int CU_BYTES = 20480, CU_M = 0, CU_OM = 8192, CU_QB = 10240, CU_QSTR = 2560;
constexpr int CK = 16, NCHUNK = SEQ / CK;
constexpr int XL_STR = 144, XL_MAT = 16 * XL_STR;
typedef short s4v __attribute__((ext_vector_type(4)));
__device__ __forceinline__ s4v pk4(const f32x4 v) { v2u o; o.x = pg8::cvt_pk_bf16(v[0], v[1]); o.y = pg8::cvt_pk_bf16(v[2], v[3]); return __builtin_bit_cast(s4v, o); }
__device__ __forceinline__ bf16x8 pk8v(const f32x4 a, const f32x4 b) { v4u o; o.x = pg8::cvt_pk_bf16(a[0], a[1]); o.y = pg8::cvt_pk_bf16(a[2], a[3]); o.z = pg8::cvt_pk_bf16(b[0], b[1]); o.w = pg8::cvt_pk_bf16(b[2], b[3]); return __builtin_bit_cast(bf16x8, o); }
__device__ __forceinline__ f32x4 mma16(const s4v x, const s4v y, const f32x4 c) {
    const bf16x8 x8 = (bf16x8){x.x, x.y, x.z, x.w, 0, 0, 0, 0}, y8 = (bf16x8){y.x, y.y, y.z, y.w, 0, 0, 0, 0};
    return __builtin_amdgcn_mfma_f32_16x16x32_bf16(x8, y8, c, 0, 0, 0); }
__device__ __forceinline__ f32x4 mma32(const bf16x8 x, const bf16x8 y, const f32x4 c) { return __builtin_amdgcn_mfma_f32_16x16x32_bf16(x, y, c, 0, 0, 0); }
template <int N> __device__ __forceinline__ float dpp_shr0(float x) { return __builtin_bit_cast(float, __builtin_amdgcn_update_dpp(0, __builtin_bit_cast(int, x), 0x110 + N, 0xF, 0xF, true)); }
__device__ __forceinline__ float scan16(float x) { x += dpp_shr0<1>(x); x += dpp_shr0<2>(x); x += dpp_shr0<4>(x); x += dpp_shr0<8>(x); return x; }
__device__ __forceinline__ s4v trd(const LAS unsigned char* p) { return __builtin_amdgcn_ds_read_tr16_b64_v4i16((LAS s4v*)p); }
__device__ __forceinline__ void chunk_ops(const f32x4 (&r)[4], const f32x4 (&lw)[4], const f32x4 (&kp)[4], const f32x4 (&v)[4], const f32x4 (&a)[4], const f32x4 (&b)[4],
                                          LAS unsigned char* scr, GAS unsigned char* rec, int lane) {
    const int l15 = lane & 15, g = lane >> 4, tq = l15 >> 2, tp = l15 & 3;
    const f32x4 Z4 = (f32x4){0.f, 0.f, 0.f, 0.f};
    f32x4 Rt[4], pc[4]; bf16x8 Atf[2], Btf[2], Ktf[2], Rtf[2];
    {
        s4v Ah[4], Bq[4], Kq[4], Rq[4];
#pragma unroll
        for (int nt = 0; nt < 4; ++nt) {
            f32x4 cs, tot;
#pragma unroll
            for (int i = 0; i < 4; ++i) { cs[i] = scan16(lw[nt][i]); tot[i] = __shfl(cs[i], lane | 15); }
            f32x4 At, Bt, Kt, Bh, Kh;
#pragma unroll
            for (int i = 0; i < 4; ++i) { const float P = fexp(cs[i]), Pm1 = fexp(cs[i] - lw[nt][i]), iP = fexp(-cs[i]), PCP = fexp(tot[i] - cs[i]);
                pc[nt][i] = fexp(tot[i]); At[i] = a[nt][i] * Pm1; Bt[i] = b[nt][i] * iP; Kt[i] = kp[nt][i] * iP; Rt[nt][i] = r[nt][i] * P; Bh[i] = b[nt][i] * PCP; Kh[i] = kp[nt][i] * PCP; }
            Ah[nt] = pk4(At); Bq[nt] = pk4(Bt); Kq[nt] = pk4(Kt); Rq[nt] = pk4(Rt[nt]);
            LAS unsigned char* w = scr + l15 * XL_STR + (16 * nt + 4 * g) * 2;
            *(LAS s4v*)(w + 0 * XL_MAT) = Ah[nt]; *(LAS s4v*)(w + 1 * XL_MAT) = pk4(v[nt]); *(LAS s4v*)(w + 2 * XL_MAT) = pk4(Bh); *(LAS s4v*)(w + 3 * XL_MAT) = pk4(Kh);
        }
#pragma unroll
        for (int s = 0; s < 2; ++s) {
            Atf[s] = (bf16x8){Ah[2 * s].x, Ah[2 * s].y, Ah[2 * s].z, Ah[2 * s].w, Ah[2 * s + 1].x, Ah[2 * s + 1].y, Ah[2 * s + 1].z, Ah[2 * s + 1].w};
            Btf[s] = (bf16x8){Bq[2 * s].x, Bq[2 * s].y, Bq[2 * s].z, Bq[2 * s].w, Bq[2 * s + 1].x, Bq[2 * s + 1].y, Bq[2 * s + 1].z, Bq[2 * s + 1].w};
            Ktf[s] = (bf16x8){Kq[2 * s].x, Kq[2 * s].y, Kq[2 * s].z, Kq[2 * s].w, Kq[2 * s + 1].x, Kq[2 * s + 1].y, Kq[2 * s + 1].z, Kq[2 * s + 1].w};
            Rtf[s] = (bf16x8){Rq[2 * s].x, Rq[2 * s].y, Rq[2 * s].z, Rq[2 * s].w, Rq[2 * s + 1].x, Rq[2 * s + 1].y, Rq[2 * s + 1].z, Rq[2 * s + 1].w}; }
    }
    f32x4 LabR = Z4, LabT = Z4, LakT = Z4, LrbT = Z4, LrkT = Z4;
#pragma unroll
    for (int s = 0; s < 2; ++s) { LabR = mma32(Atf[s], Btf[s], LabR); LabT = mma32(Btf[s], Atf[s], LabT); LakT = mma32(Ktf[s], Atf[s], LakT); LrbT = mma32(Btf[s], Rtf[s], LrbT); LrkT = mma32(Ktf[s], Rtf[s], LrkT); }
    f32x4 IR;
#pragma unroll
    for (int i = 0; i < 4; ++i) { const int tt = 4 * g + i;
        IR[i] = (tt == l15) ? 1.f : 0.f;
        LabR[i] = (tt > l15) ? LabR[i] : 0.f; LabT[i] = (l15 > tt) ? LabT[i] : 0.f; LakT[i] = (l15 > tt) ? LakT[i] : 0.f;
        LrbT[i] = (l15 >= tt) ? LrbT[i] : 0.f; LrkT[i] = (l15 >= tt) ? LrkT[i] : 0.f; }
    const s4v L1R = pk4(LabR), L1T = pk4(LabT);
    const f32x4 L2R = mma16(L1T, L1R, Z4), L2T = mma16(L1R, L1T, Z4);
    const s4v L2Rp = pk4(L2R), L2Tp = pk4(L2T);
    const f32x4 L4R = mma16(L2Tp, L2Rp, Z4), L4T = mma16(L2Rp, L2Tp, Z4);
    const s4v L4Rp = pk4(L4R), L4Tp = pk4(L4T);
    const f32x4 L8R = mma16(L4Tp, L4Rp, Z4);
    const f32x4 T1T = mma16(pk4(IR + L2R), pk4(IR + LabT), Z4);
    const f32x4 T2T = mma16(pk4(IR + L4R), pk4(T1T), Z4);
    const s4v TmT = pk4(mma16(pk4(IR + L8R), pk4(T2T), Z4));
    const s4v LakTp = pk4(LakT), LrbTp = pk4(LrbT), LrkTp = pk4(LrkT);
    asm volatile("s_waitcnt lgkmcnt(0)" ::: "memory");
    const LAS unsigned char* tb = scr + (4 * g + tq) * XL_STR + (4 * tp) * 2;
    s4v tAt[4], tV[4], tBh[4], tKh[4];
#pragma unroll
    for (int t = 0; t < 4; ++t) { tAt[t] = trd(tb + 0 * XL_MAT + 32 * t); tV[t] = trd(tb + 1 * XL_MAT + 32 * t); tBh[t] = trd(tb + 2 * XL_MAT + 32 * t); tKh[t] = trd(tb + 3 * XL_MAT + 32 * t); }
    s4v Wp[4], U0p[4];
#pragma unroll
    for (int t = 0; t < 4; ++t) { Wp[t] = pk4(mma16(TmT, tAt[t], Z4));
        const f32x4 G = mma16(LakTp, tV[t], Z4);
        const f32x4 U0 = mma16(TmT, pk4(G), Z4); U0p[t] = pk4(U0);
        f32x4 Y0 = mma16(LrbTp, U0p[t], Z4); Y0 = mma16(LrkTp, tV[t], Y0);
        *(GAS s4v*)(rec + CU_QB + t * CU_QSTR + 2048 + lane * 8) = pk4(Y0); }
    {
        f32x4 Om[4];
#pragma unroll
        for (int ct = 0; ct < 4; ++ct) Om[ct] = mma16(Wp[ct], LrbTp, Rt[ct]);
        *(GAS bf16x8*)(rec + CU_OM + 0 * 1024 + lane * 16) = pk8v(Om[0], Om[1]); *(GAS bf16x8*)(rec + CU_OM + 1 * 1024 + lane * 16) = pk8v(Om[2], Om[3]);
    }
#pragma unroll
    for (int tl = 0; tl < 4; ++tl) {
        f32x4 Mt[4];
#pragma unroll
        for (int kt = 0; kt < 4; ++kt) { Mt[kt] = mma16(Wp[kt], tBh[tl], Z4);
            if (kt == tl) {
#pragma unroll
                for (int i = 0; i < 4; ++i) Mt[kt][i] += (4 * g + i == l15) ? pc[kt][i] : 0.f; } }
        *(GAS bf16x8*)(rec + CU_M + (tl * 2 + 0) * 1024 + lane * 16) = pk8v(Mt[0], Mt[1]); *(GAS bf16x8*)(rec + CU_M + (tl * 2 + 1) * 1024 + lane * 16) = pk8v(Mt[2], Mt[3]);
    }
#pragma unroll
    for (int q = 0; q < 4; ++q)
#pragma unroll
        for (int tl = 0; tl < 4; ++tl) { f32x4 Nt = mma16(tBh[tl], U0p[q], Z4); Nt = mma16(tKh[tl], tV[q], Nt);
            *(GAS s4v*)(rec + CU_QB + q * CU_QSTR + tl * 512 + lane * 8) = pk4(Nt); }
}
__device__ __forceinline__ void ph_prep(Frame& F, ArgP A, int l) {
    const int gw = F.vcu * NWAVES + F.wave, NGW = F.G * NWAVES, lane = F.lane, l15 = lane & 15, g = lane >> 4;
    {
        const int h = lane >> 3, i0 = 8 * (lane & 7);
        int nrr_ = (MK_REP & 1024) ? 2 : 1; asm volatile("" : "+s"(nrr_));
#pragma unroll 1
        for (int rr_ = 0; rr_ < nrr_; ++rr_)
        for (int m = gw; m < M; m += NGW) {
            const GAS bf16* zrow = (const GAS bf16*)(WSP(bf16, WS_Z) + (size_t)m * INW);
            const GAS f32x4* rp = (const GAS f32x4*)(WSP(float2, WS_ROPE) + (size_t)m * 64 + i0);
            const f32x4 c01 = rp[0], c23 = rp[1], c45 = rp[2], c67 = rp[3];
            const float cs[8] = {c01.x, c01.z, c23.x, c23.z, c45.x, c45.z, c67.x, c67.z}, sn[8] = {c01.y, c01.w, c23.y, c23.w, c45.y, c45.w, c67.y, c67.w};
            float q1[8], q2[8], k1[8], k2[8], o1[8], o2[8];
            unpack8(*(const GAS v4u*)(zrow + ZC_Q + h * RD + i0), q1); unpack8(*(const GAS v4u*)(zrow + ZC_Q + h * RD + 64 + i0), q2);
            unpack8(*(const GAS v4u*)(zrow + ZC_K + h * RD + i0), k1); unpack8(*(const GAS v4u*)(zrow + ZC_K + h * RD + 64 + i0), k2);
#pragma unroll
            for (int j = 0; j < 8; ++j) { o1[j] = q1[j] * cs[j] - q2[j] * sn[j]; o2[j] = q2[j] * cs[j] + q1[j] * sn[j]; }
            GAS bf16* qo = (GAS bf16*)(WSP(bf16, WS_QR) + (size_t)m * RETW + h * RD + i0);
            *(GAS bf16x8*)qo = pack8(o1); *(GAS bf16x8*)(qo + 64) = pack8(o2);
#pragma unroll
            for (int j = 0; j < 8; ++j) { const float a = k1[j] * 0.08838834764831845f, b = k2[j] * 0.08838834764831845f; o1[j] = a * cs[j] - b * sn[j]; o2[j] = b * cs[j] + a * sn[j]; }
            GAS bf16* ko = (GAS bf16*)(WSP(bf16, WS_KR) + (size_t)m * RETW + h * RD + i0);
            *(GAS bf16x8*)ko = pack8(o1); *(GAS bf16x8*)(ko + 64) = pack8(o2);
        }
    }
    const GAS float* mu = (const GAS float*)(INP(A, 6) + (size_t)l * RWSHIFT);
    const GAS float* w0 = (const GAS float*)(INP(A, 7) + (size_t)l * RWW); const GAS float* a0 = (const GAS float*)(INP(A, 9) + (size_t)l * RWW);
    const GAS float* kkw = (const GAS float*)(INP(A, 12) + (size_t)l * RWW); const GAS float* kaw = (const GAS float*)(INP(A, 13) + (size_t)l * RWW); const GAS float* rkw = (const GAS float*)(INP(A, 14) + (size_t)l * RWW);
    const GAS bf16* WupT = (const GAS bf16*)WSW(l, WO_LORA); const GAS bf16* AupT = WupT + 1024 * 64; const GAS bf16* GupT = AupT + 1024 * 64;
    constexpr int PP_OFF = 8 * 10240;
    LAS float* PP = (LAS float*)(F.lds + RING_OFF + PP_OFF);
    __syncthreads();
    for (int i = F.tid; i < 2048; i += NWAVES * 64) { const int arr = i >> 8, off = (i & 255) * 4;
        const GAS float* src = arr < 3 ? mu + arr * 1024 : (arr == 3 ? w0 : (arr == 4 ? a0 : (arr == 5 ? kkw : (arr == 6 ? kaw : rkw))));
        *(LAS f32x4*)(PP + arr * 1024 + off) = *(const GAS f32x4*)(src + off); }
    __syncthreads();
    int nrw_ = (MK_REP & 2048) ? 2 : 1; asm volatile("" : "+s"(nrw_));
#pragma unroll 1
    for (int rw_ = 0; rw_ < nrw_; ++rw_)
    for (int task = gw; task < M / 8; task += NGW) {
        const int m = (task >> 1) * 16 + l15, hh0 = (task & 1) * (WH / 2);
        const bool has_prev = (m % SEQ) != 0;
        const GAS bf16* zr = (const GAS bf16*)(WSP(bf16, WS_Z) + (size_t)m * INW + ZC_RW);
        bf16x8 fw[2], fa[2], fg[4];
#pragma unroll
        for (int ks = 0; ks < 2; ++ks) { float t[8];
            mix8(zr + RWC_W + 32 * ks + 8 * g, has_prev, mu + RWC_W + 32 * ks + 8 * g, t);
#pragma unroll
            for (int j = 0; j < 8; ++j) t[j] = ftanh(t[j]);
            fw[ks] = pack8(t);
            mix8(zr + RWC_A + 32 * ks + 8 * g, has_prev, mu + RWC_A + 32 * ks + 8 * g, t); fa[ks] = pack8(t); }
#pragma unroll
        for (int ks = 0; ks < 4; ++ks) { float t[8];
            mix8(zr + RWC_G + 32 * ks + 8 * g, has_prev, mu + RWC_G + 32 * ks + 8 * g, t);
#pragma unroll
            for (int j = 0; j < 8; ++j) t[j] = fsig(t[j]);
            fg[ks] = pack8(t); }
        const GAS bf16* zq = has_prev ? zr - INW : zr;
        for (int hh = hh0; hh < hh0 + WH / 2; ++hh) {
            f32x4 kkr[4], av[4], rr[4], lwv[4], kpv[4], vv[4]; float ss = 0.f, bonus = 0.f;
            const int cb = hh * WD + 4 * g;
            {
                v2u zc[3][4], zp[3][4];
#pragma unroll
                for (int a3 = 0; a3 < 3; ++a3)
#pragma unroll
                    for (int nt = 0; nt < 4; ++nt) { zc[a3][nt] = *(const GAS v2u*)(zr + a3 * 1024 + cb + 16 * nt); zp[a3][nt] = *(const GAS v2u*)(zq + a3 * 1024 + cb + 16 * nt); }
#pragma unroll
                for (int nt = 0; nt < 4; ++nt) {
#pragma unroll
                    for (int a3 = 0; a3 < 3; ++a3) { const f32x4 z = unpk4(zc[a3][nt]); f32x4 p = unpk4(zp[a3][nt]); if (!has_prev) p = (f32x4){0.f, 0.f, 0.f, 0.f};
                        const f32x4 mx = z + *(const LAS f32x4*)(PP + a3 * 1024 + cb + 16 * nt) * (p - z);
                        if (a3 == 0) rr[nt] = mx; else if (a3 == 1) kpv[nt] = mx; else vv[nt] = mx; }
                }
            }
            bf16x8 wf[2][2], af[2][2], gf[2][4];
#define PREP_WFRAGS(nt_, k_) do { const int cf_ = hh * WD + (nt_) * 16 + l15; \
            _Pragma("unroll") for (int ks = 0; ks < 2; ++ks) { wf[k_][ks] = *(const GAS bf16x8*)(WupT + (size_t)cf_ * 64 + 32 * ks + 8 * g); af[k_][ks] = *(const GAS bf16x8*)(AupT + (size_t)cf_ * 64 + 32 * ks + 8 * g); } \
            _Pragma("unroll") for (int ks = 0; ks < 4; ++ks) gf[k_][ks] = *(const GAS bf16x8*)(GupT + (size_t)cf_ * 128 + 32 * ks + 8 * g); } while (0)
            PREP_WFRAGS(0, 0);
#pragma unroll
            for (int nt = 0; nt < 4; ++nt) {
                const int c0 = cb + 16 * nt, cs_ = nt & 1;
                if (nt + 1 < 4) PREP_WFRAGS(nt + 1, (cs_ ^ 1));
                f32x4 wl = *(const LAS f32x4*)(PP + 3 * 1024 + c0), al = *(const LAS f32x4*)(PP + 4 * 1024 + c0), gl = (f32x4){0.f, 0.f, 0.f, 0.f};
#pragma unroll
                for (int ks = 0; ks < 2; ++ks) { wl = __builtin_amdgcn_mfma_f32_16x16x32_bf16(wf[cs_][ks], fw[ks], wl, 0, 0, 0); al = __builtin_amdgcn_mfma_f32_16x16x32_bf16(af[cs_][ks], fa[ks], al, 0, 0, 0); }
#pragma unroll
                for (int ks = 0; ks < 4; ++ks) gl = __builtin_amdgcn_mfma_f32_16x16x32_bf16(gf[cs_][ks], fg[ks], gl, 0, 0, 0);
                const f32x4 r = rr[nt], k = kpv[nt], v = vv[nt];
                const f32x4 kk4 = *(const LAS f32x4*)(PP + 5 * 1024 + c0), ka4 = *(const LAS f32x4*)(PP + 6 * 1024 + c0), rk4 = *(const LAS f32x4*)(PP + 7 * 1024 + c0);
                f32x4 lwd, a, kp;
#pragma unroll
                for (int i = 0; i < 4; ++i) {
                    lwd[i] = -0.6065306597126334f * fsig(wl[i]);
                    a[i] = fsig(al[i]);
                    kp[i] = k[i] * (1.0f + (a[i] - 1.0f) * ka4[i]);
                }
                kkr[nt] = k * kk4; av[nt] = a; lwv[nt] = lwd; kpv[nt] = kp;
                ss += (kkr[nt].x * kkr[nt].x + kkr[nt].y * kkr[nt].y) + (kkr[nt].z * kkr[nt].z + kkr[nt].w * kkr[nt].w);
                const f32x4 rb = r * kp * rk4; bonus += (rb.x + rb.y) + (rb.z + rb.w);
                const size_t o = (size_t)m * RWW + c0;
#if MK_CHUNKED
                *(GAS s4v*)(WSP(bf16, WS_SV) + o) = pk4(v); *(GAS s4v*)(WSP(bf16, WS_G) + o) = pk4(gl);
#else
                f32x4 decay;
#pragma unroll
                for (int i = 0; i < 4; ++i) decay[i] = fexp(lwd[i]);
                *(GAS f32x4*)(WSP(float, WS_SR) + o) = r; *(GAS f32x4*)(WSP(float, WS_SW) + o) = decay; *(GAS f32x4*)(WSP(float, WS_SK) + o) = kp;
                *(GAS f32x4*)(WSP(float, WS_SV) + o) = v; *(GAS f32x4*)(WSP(float, WS_G) + o) = gl;
#endif
            }
#undef PREP_WFRAGS
            ss += __shfl_xor(ss, 16); ss += __shfl_xor(ss, 32); bonus += __shfl_xor(bonus, 16); bonus += __shfl_xor(bonus, 32);
            const float inv = 1.0f / fmaxf(sqrtf(ss), 1e-12f);
            if (g == 0) WSP(float, WS_BONUS)[(size_t)m * WH + hh] = bonus;
#if MK_CHUNKED
            f32x4 aa[4], bb[4];
#pragma unroll
            for (int nt = 0; nt < 4; ++nt) { const f32x4 kk = kkr[nt] * inv; aa[nt] = -kk; bb[nt] = kk * av[nt]; }
            const int tile = task >> 1;
            GAS unsigned char* rec = (GAS unsigned char*)WSP(unsigned char, WS_CU) + ((size_t)((tile / NCHUNK) * WH + hh) * NCHUNK + (tile % NCHUNK)) * CU_BYTES;
            chunk_ops(rr, lwv, kpv, vv, aa, bb, F.lds + RING_OFF + F.wave * 10240, rec, lane);
#else
#pragma unroll
            for (int nt = 0; nt < 4; ++nt) { const size_t o = (size_t)m * RWW + hh * WD + nt * 16 + 4 * g; const f32x4 kk = kkr[nt] * inv;
                *(GAS f32x4*)(WSP(float, WS_SNKK) + o) = -kk; *(GAS f32x4*)(WSP(float, WS_SKKA) + o) = kk * av[nt]; }
#endif
        }
    }
}
#if (MK_GLOBAL_GROUPS & 2)
#pragma pop_macro("WSP")
#pragma pop_macro("WSW")
#pragma pop_macro("OUTP")
#endif
#if (MK_GLOBAL_GROUPS & 4)
#pragma push_macro("WSP")
#pragma push_macro("WSW")
#pragma push_macro("OUTP")
#undef WSP
#undef WSW
#undef OUTP
#define WSP WSPG
#define WSW WSWG
#define OUTP OUTPG
#endif
#if !MK_CHUNKED
__device__ __forceinline__ void scan_rwkv_naive(Frame& F, int item) {
    const int lane = F.lane;
    float st[64];
#pragma unroll
    for (int j = 0; j < 64; ++j) st[j] = 0.f;
    const size_t base0 = (size_t)(item >> 4) * SEQ * RWW + (size_t)(item & 15) * WD + lane;
    for (int t = 0; t < SEQ; ++t) {
        const size_t o = base0 + (size_t)t * RWW;
        const float r = WSP(float, WS_SR)[o], w = WSP(float, WS_SW)[o], k = WSP(float, WS_SK)[o], v = WSP(float, WS_SV)[o], nk = WSP(float, WS_SNKK)[o], ka = WSP(float, WS_SKKA)[o];
        float sa = 0.f;
#pragma unroll
        for (int j = 0; j < 64; ++j) sa += st[j] * rdlane(nk, j);
        float y = 0.f;
#pragma unroll
        for (int j = 0; j < 64; ++j) { st[j] = st[j] * rdlane(w, j) + sa * rdlane(ka, j) + v * rdlane(k, j); y += st[j] * rdlane(r, j); }
        WSP(float, WS_YRAWW)[o] = y;
    }
}
#endif
__device__ __forceinline__ void scan_ret_naive(Frame& F, int item) {
    const int lane = F.lane, b = item >> 4, h = (item >> 1) & 7, half = item & 1;
    const float gam = 1.0f - exp2f((float)(-5 - h));
    float R[128];
#pragma unroll
    for (int j = 0; j < 128; ++j) R[j] = 0.f;
    for (int t = 0; t < SEQ; ++t) {
        const size_t m = (size_t)b * SEQ + t;
        const float q1 = bf2f(WSP(bf16, WS_QR)[m * RETW + h * RD + lane]), q2 = bf2f(WSP(bf16, WS_QR)[m * RETW + h * RD + 64 + lane]);
        const float k1 = bf2f(WSP(bf16, WS_KR)[m * RETW + h * RD + lane]), k2 = bf2f(WSP(bf16, WS_KR)[m * RETW + h * RD + 64 + lane]);
        const float v = bf2f(WSP(bf16, WS_Z)[m * INW + ZC_V + h * RD + half * 64 + lane]);
        float y = 0.f;
#pragma unroll
        for (int d = 0; d < 64; ++d) { R[d] = gam * R[d] + rdlane(k1, d) * v; y += rdlane(q1, d) * R[d]; }
#pragma unroll
        for (int d = 0; d < 64; ++d) { R[64 + d] = gam * R[64 + d] + rdlane(k2, d) * v; y += rdlane(q2, d) * R[64 + d]; }
        OUTP[m * RETW + h * RD + half * 64 + lane] = y;
    }
}
#if !MK_CHUNKED
constexpr int SCT = 32;
constexpr int SC_ARR = SCT * 64 * 4;
constexpr int SC_BUF = 5 * SC_ARR + SCT * 16 * 4;
static_assert(2 * SC_BUF <= RING_BYTES, "scan LDS");
template <int CTRL> __device__ __forceinline__ float dppf(float x) { return __builtin_bit_cast(float, __builtin_amdgcn_update_dpp(0, __builtin_bit_cast(int, x), CTRL, 0xF, 0xF, true)); }
__device__ __forceinline__ float sum16(float x) {
    x += dppf<0xB1>(x); x += dppf<0x4E>(x); x += dppf<0x141>(x); x += dppf<0x140>(x); return x;
}
__device__ __forceinline__ void scan_rwkv_fast(Frame& F, int w) {
    const int b = w >> 6, hh = (w >> 2) & 15, q = w & 3;
    const int lane = F.lane, wave = F.wave;
    LAS unsigned char* base = F.lds + RING_OFF;
    const size_t g0 = (size_t)b * SEQ * RWW + (size_t)hh * WD;
    constexpr int NBLK = SEQ / SCT;
#define SC_BAR() do { asm volatile("s_waitcnt lgkmcnt(0)" ::: "memory"); __builtin_amdgcn_s_barrier(); asm volatile("" ::: "memory"); } while (0)
    if (wave >= 4) {
        const int lt = F.tid - 256;
        const float* a0 = WSP(float, WS_SR) + g0; const float* a1 = WSP(float, WS_SW) + g0; const float* a2 = WSP(float, WS_SK) + g0;
        const float* a3 = WSP(float, WS_SNKK) + g0; const float* a4 = WSP(float, WS_SKKA) + g0; const float* av = WSP(float, WS_SV) + g0 + 16 * q;
        const int f0 = lt, f1 = lt + 256;
        const size_t o0 = (size_t)(f0 >> 4) * RWW + 4 * (f0 & 15), o1 = (size_t)(f1 >> 4) * RWW + 4 * (f1 & 15), ov = (size_t)(lt >> 2) * RWW + 4 * (lt & 3);
        f32x4 r0[5], r1[5], rv;
#define SC_LOAD(blk) do { const size_t tb = (size_t)(blk) * SCT * RWW; \
        r0[0] = *(const GAS f32x4*)(a0 + tb + o0); r1[0] = *(const GAS f32x4*)(a0 + tb + o1); r0[1] = *(const GAS f32x4*)(a1 + tb + o0); r1[1] = *(const GAS f32x4*)(a1 + tb + o1); \
        r0[2] = *(const GAS f32x4*)(a2 + tb + o0); r1[2] = *(const GAS f32x4*)(a2 + tb + o1); r0[3] = *(const GAS f32x4*)(a3 + tb + o0); r1[3] = *(const GAS f32x4*)(a3 + tb + o1); \
        r0[4] = *(const GAS f32x4*)(a4 + tb + o0); r1[4] = *(const GAS f32x4*)(a4 + tb + o1); if (lt < 128) rv = *(const GAS f32x4*)(av + tb + ov); } while (0)
#define SC_STORE(bi) do { LAS unsigned char* bb = base + (bi) * SC_BUF; \
        _Pragma("unroll") for (int a = 0; a < 5; ++a) { *(LAS f32x4*)(bb + a * SC_ARR + f0 * 16) = r0[a]; *(LAS f32x4*)(bb + a * SC_ARR + f1 * 16) = r1[a]; } \
        if (lt < 128) *(LAS f32x4*)(bb + 5 * SC_ARR + lt * 16) = rv; } while (0)
        SC_LOAD(0); SC_STORE(0);
        if (1 < NBLK) SC_LOAD(1);
        SC_BAR();
        for (int blk = 0; blk < NBLK; ++blk) {
            if (blk + 1 < NBLK) { SC_STORE((blk + 1) & 1); if (blk + 2 < NBLK) SC_LOAD(blk + 2); }
            SC_BAR();
        }
#undef SC_LOAD
#undef SC_STORE
    } else {
        const int l16 = lane & 15, rowl = 4 * wave + (lane >> 4);
        GAS float* Y = (GAS float*)(WSP(float, WS_YRAWW) + g0 + 16 * q + rowl);
        f32x4 st = (f32x4){0.f, 0.f, 0.f, 0.f};
        const int lo = l16 * 16, vo = 5 * SC_ARR + rowl * 4;
#define SC_LD(tt_, R4, W4, K4, N4, A4, V) do { R4 = *(const LAS f32x4*)(bb + 0 * SC_ARR + (tt_) * 256 + lo); W4 = *(const LAS f32x4*)(bb + 1 * SC_ARR + (tt_) * 256 + lo); \
        K4 = *(const LAS f32x4*)(bb + 2 * SC_ARR + (tt_) * 256 + lo); N4 = *(const LAS f32x4*)(bb + 3 * SC_ARR + (tt_) * 256 + lo); A4 = *(const LAS f32x4*)(bb + 4 * SC_ARR + (tt_) * 256 + lo); \
        V = *(const LAS float*)(bb + vo + (tt_) * 64); } while (0)
        SC_BAR();
        for (int blk = 0; blk < NBLK; ++blk) {
            const LAS unsigned char* bb = base + (blk & 1) * SC_BUF;
            GAS float* yb = Y + (size_t)blk * SCT * RWW;
            f32x4 r4[3], w4[3], k4[3], n4[3], a4[3]; float v[3];
            SC_LD(0, r4[0], w4[0], k4[0], n4[0], a4[0], v[0]);
            SC_LD(1, r4[1], w4[1], k4[1], n4[1], a4[1], v[1]);
#pragma unroll
            for (int tt = 0; tt < SCT; ++tt) {
                const int c = tt % 3, p = (tt + 2) % 3;
                if (tt + 2 < SCT) SC_LD(tt + 2, r4[p], w4[p], k4[p], n4[p], a4[p], v[p]);
                f32x2 sp2 = (f32x2){st.x, st.y} * (f32x2){n4[c].x, n4[c].y}; sp2 = (f32x2){st.z, st.w} * (f32x2){n4[c].z, n4[c].w} + sp2;
                const f32x4 t0 = st * w4[c] + k4[c] * v[c];
                const float sa = sum16(sp2.x + sp2.y);
                st = a4[c] * sa + t0;
                f32x2 yp2 = (f32x2){st.x, st.y} * (f32x2){r4[c].x, r4[c].y}; yp2 = (f32x2){st.z, st.w} * (f32x2){r4[c].z, r4[c].w} + yp2;
                const float y = sum16(yp2.x + yp2.y);
                yb[(size_t)tt * RWW] = y;
            }
            SC_BAR();
        }
#undef SC_LD
#undef SC_BAR
    }
}
#endif
constexpr int CB_STEPS = 4, CB_STEP_BYTES = 8192 + 2048 + 2048 + 512, CB_BUF = CB_STEPS * CB_STEP_BYTES, CB_PIECES = CB_BUF / 16, CB_NBLK = NCHUNK / CB_STEPS;
static_assert(2 * CB_BUF <= RING_BYTES, "chunk scan LDS");
#ifndef MK_X2_DIRECT
#define MK_X2_DIRECT 0
#endif
__device__ __forceinline__ void scan_rwkv_chunk(Frame& F, int w) {
    const int bh = w >> 2, q = w & 3, lane = F.lane, wave = F.wave;
#if MK_X2_DIRECT
    if (wave == 0) {
        const int l15 = lane & 15, g = lane >> 4;
        const f32x4 Z4 = (f32x4){0.f, 0.f, 0.f, 0.f};
        f32x4 acc[4] = {Z4, Z4, Z4, Z4};
        const GAS unsigned char* rec = (const GAS unsigned char*)WSP(unsigned char, WS_CU) + (size_t)bh * NCHUNK * CU_BYTES;
        GAS float* Y = (GAS float*)(WSP(float, WS_YRAWW) + (size_t)(bh >> 4) * SEQ * RWW + (size_t)(bh & 15) * WD + 16 * q + l15 + (size_t)(4 * g) * RWW);
        for (int n = 0; n < NCHUNK; ++n, rec += CU_BYTES) {
            const bf16x8 sf0 = pk8v(acc[0], acc[1]), sf1 = pk8v(acc[2], acc[3]);
            f32x4 ya = unpk4(*(const GAS v2u*)(rec + CU_QB + q * CU_QSTR + 2048 + lane * 8));
            ya = mma32(*(const GAS bf16x8*)(rec + CU_OM + lane * 16), sf0, ya); ya = mma32(*(const GAS bf16x8*)(rec + CU_OM + 1024 + lane * 16), sf1, ya);
            GAS float* yp = Y + (size_t)(n * CK) * RWW;
#pragma unroll
            for (int i = 0; i < 4; ++i) yp[(size_t)i * RWW] = ya[i];
#pragma unroll
            for (int tl = 0; tl < 4; ++tl) { f32x4 na = unpk4(*(const GAS v2u*)(rec + CU_QB + q * CU_QSTR + tl * 512 + lane * 8));
                na = mma32(*(const GAS bf16x8*)(rec + CU_M + (tl * 2 + 0) * 1024 + lane * 16), sf0, na); na = mma32(*(const GAS bf16x8*)(rec + CU_M + (tl * 2 + 1) * 1024 + lane * 16), sf1, na);
                acc[tl] = na; }
        }
    }
    return;
#endif
    LAS unsigned char* base = F.lds + RING_OFF;
    const GAS unsigned char* rec0 = (const GAS unsigned char*)WSP(unsigned char, WS_CU) + (size_t)bh * NCHUNK * CU_BYTES;
#define CB_BAR() do { asm volatile("s_waitcnt lgkmcnt(0)" ::: "memory"); __builtin_amdgcn_s_barrier(); asm volatile("" ::: "memory"); } while (0)
    if (wave >= 1) {
        const int lt = F.tid - 64;
#if MK_X2_NT
#define CB_LD(p_) __builtin_nontemporal_load((const GAS v4u*)(p_))
#else
#define CB_LD(p_) (*(const GAS v4u*)(p_))
#endif
        v4u ra[8], rb[8], rc[8], rd[8];
        const int ltc = lt < 400 ? lt : 399;
        int so[8];
#pragma unroll
        for (int j = 0; j < 8; ++j) { const int p = ltc + 400 * j, st = p / 800, off = p % 800; so[j] = st * CU_BYTES + off * 16 + (off >= 640 ? q * CU_QSTR : 0); }
#define CB_LOAD(rg, blk) do { const int bc_ = (blk) < CB_NBLK ? (blk) : CB_NBLK - 1; const GAS unsigned char* bp = rec0 + (size_t)bc_ * CB_STEPS * CU_BYTES; \
            _Pragma("unroll") for (int j = 0; j < 8; ++j) rg[j] = CB_LD(bp + so[j]); } while (0)
#define CB_STORE(rg, bi) do { LAS unsigned char* dp = base + (bi) * CB_BUF + ltc * 16; \
            _Pragma("unroll") for (int j = 0; j < 8; ++j) *(LAS v4u*)(dp + j * 400 * 16) = rg[j]; } while (0)
        static_assert(CB_NBLK % 4 == 0 && CB_NBLK >= 8, "block quads");
        CB_LOAD(ra, 0); CB_STORE(ra, 0); CB_LOAD(rb, 1); CB_LOAD(rc, 2); CB_LOAD(rd, 3);
        CB_BAR();
        for (int blk = 0; blk < CB_NBLK; blk += 4) {
            CB_STORE(rb, 1); CB_LOAD(ra, blk + 4); CB_BAR();
            CB_STORE(rc, 0); CB_LOAD(rb, blk + 5); CB_BAR();
            CB_STORE(rd, 1); CB_LOAD(rc, blk + 6); CB_BAR();
            CB_STORE(ra, 0); CB_LOAD(rd, blk + 7); CB_BAR();
        }
#undef CB_LOAD
#undef CB_STORE
    } else {
        const int l15 = lane & 15, g = lane >> 4;
        const f32x4 Z4 = (f32x4){0.f, 0.f, 0.f, 0.f};
        f32x4 acc[4] = {Z4, Z4, Z4, Z4};
        GAS float* Y = (GAS float*)(WSP(float, WS_YRAWW) + (size_t)(bh >> 4) * SEQ * RWW + (size_t)(bh & 15) * WD + 16 * q + l15 + (size_t)(4 * g) * RWW);
        CB_BAR();
        bf16x8 Mf[2][8], Of[2][2]; v2u Nt[2][4], Yt[2];
#define CB_FRAGS(sb_, k_) do { _Pragma("unroll") for (int j = 0; j < 8; ++j) Mf[k_][j] = *(const LAS bf16x8*)((sb_) + j * 1024 + lane * 16); \
        _Pragma("unroll") for (int j = 0; j < 4; ++j) Nt[k_][j] = *(const LAS v2u*)((sb_) + 10240 + j * 512 + lane * 8); \
        Of[k_][0] = *(const LAS bf16x8*)((sb_) + 8192 + lane * 16); Of[k_][1] = *(const LAS bf16x8*)((sb_) + 9216 + lane * 16); Yt[k_] = *(const LAS v2u*)((sb_) + 12288 + lane * 8); } while (0)
        for (int blk = 0; blk < CB_NBLK; ++blk) {
            const LAS unsigned char* bb = base + (blk & 1) * CB_BUF;
            CB_FRAGS(bb, 0);
#pragma unroll
            for (int st = 0; st < CB_STEPS; ++st) {
                const int c = st & 1;
                if (st + 1 < CB_STEPS) CB_FRAGS(bb + (st + 1) * CB_STEP_BYTES, (c ^ 1));
                const bf16x8 sf0 = pk8v(acc[0], acc[1]), sf1 = pk8v(acc[2], acc[3]);
                f32x4 ya = unpk4(Yt[c]);
                ya = mma32(Of[c][0], sf0, ya); ya = mma32(Of[c][1], sf1, ya);
                GAS float* yp = Y + (size_t)((blk * CB_STEPS + st) * CK) * RWW;
#pragma unroll
                for (int i = 0; i < 4; ++i) yp[(size_t)i * RWW] = ya[i];
                f32x4 na[4];
#pragma unroll
                for (int tl = 0; tl < 4; ++tl) na[tl] = mma32(Mf[c][tl * 2 + 0], sf0, unpk4(Nt[c][tl]));
#pragma unroll
                for (int tl = 0; tl < 4; ++tl) acc[tl] = mma32(Mf[c][tl * 2 + 1], sf1, na[tl]);
            }
            CB_BAR();
        }
#undef CB_FRAGS
    }
#undef CB_BAR
}
constexpr int RT_STR = 288, RT_QS = 0, RT_KS = 128 * RT_STR, RT_VSTR = 80, RT_VS = 2 * 128 * RT_STR, RT_VPS = RT_VS + 128 * RT_VSTR, RT_RT = RT_VPS + 128 * RT_VSTR, RT_RTSZ = 32 * RT_STR;
static_assert(RT_RT + 2 * RT_RTSZ <= RING_BYTES, "retention LDS");
__device__ __forceinline__ bf16x8 tr8(const LAS unsigned char* p0, const LAS unsigned char* p1) {
    const s4v a = __builtin_amdgcn_ds_read_tr16_b64_v4i16((LAS s4v*)p0), b = __builtin_amdgcn_ds_read_tr16_b64_v4i16((LAS s4v*)p1);
    return (bf16x8){a.x, a.y, a.z, a.w, b.x, b.y, b.z, b.w};
}
__device__ __forceinline__ void scan_ret_mfma(Frame& F, int w_) {
    const int b = w_ >> 5, h = (w_ >> 2) & 7, eq = w_ & 3;
    const int tid = F.tid, lane = F.lane, w = F.wave, l15 = lane & 15, g = lane >> 4, tq = l15 >> 2, tp = l15 & 3;
    LAS unsigned char* L = F.lds + RING_OFF;
    const float lg2 = log1pf(-exp2f((float)(-5 - h))) * 1.4426950408889634f;
    const float gC = __builtin_amdgcn_exp2f(lg2 * 128.f);
    for (int i = tid; i < RT_RTSZ / 4; i += NWAVES * 64) ((LAS unsigned*)(L + RT_RT))[i] = 0u;
    const GAS bf16* Qg = (const GAS bf16*)(WSP(bf16, WS_QR) + (size_t)b * SEQ * RETW + h * RD);
    const GAS bf16* Kg = (const GAS bf16*)(WSP(bf16, WS_KR) + (size_t)b * SEQ * RETW + h * RD);
    const GAS bf16* Vg = (const GAS bf16*)(WSP(bf16, WS_Z) + (size_t)b * SEQ * INW + ZC_V + h * RD + 32 * eq);
    GAS float* Yg = (GAS float*)(OUTP + (size_t)b * SEQ * RETW + h * RD + 32 * eq);
    v4u rq[4], rk[4], rv;
#define RT_BAR() do { asm volatile("s_waitcnt lgkmcnt(0)" ::: "memory"); __builtin_amdgcn_s_barrier(); asm volatile("" ::: "memory"); } while (0)
#define RT_LOAD(n_) do { _Pragma("unroll") for (int i = 0; i < 4; ++i) { const int f = tid + 512 * i, c = f >> 4, pc = f & 15; \
        rq[i] = *(const GAS v4u*)(Qg + (size_t)((n_) * 128 + c) * RETW + 8 * pc); rk[i] = *(const GAS v4u*)(Kg + (size_t)((n_) * 128 + c) * RETW + 8 * pc); } \
        rv = *(const GAS v4u*)(Vg + (size_t)((n_) * 128 + (tid >> 2)) * INW + 8 * (tid & 3)); } while (0)
    f32x4 accR[2] = {(f32x4){0.f, 0.f, 0.f, 0.f}, (f32x4){0.f, 0.f, 0.f, 0.f}};
    RT_LOAD(0);
    for (int n = 0; n < SEQ / 128; ++n) {
#pragma unroll
        for (int i = 0; i < 4; ++i) { const int f = tid + 512 * i, c = f >> 4, pc = f & 15;
            *(LAS v4u*)(L + RT_QS + c * RT_STR + pc * 16) = rq[i]; *(LAS v4u*)(L + RT_KS + c * RT_STR + pc * 16) = rk[i]; }
        { const int c = tid >> 2, pc = tid & 3; *(LAS v4u*)(L + RT_VS + c * RT_VSTR + pc * 16) = rv;
          const float sc = __builtin_amdgcn_exp2f(lg2 * (float)(127 - c)); v4u o;
          o.x = pg8::cvt_pk_bf16(pg8::bf_lo(rv.x) * sc, pg8::bf_hi(rv.x) * sc); o.y = pg8::cvt_pk_bf16(pg8::bf_lo(rv.y) * sc, pg8::bf_hi(rv.y) * sc);
          o.z = pg8::cvt_pk_bf16(pg8::bf_lo(rv.z) * sc, pg8::bf_hi(rv.z) * sc); o.w = pg8::cvt_pk_bf16(pg8::bf_lo(rv.w) * sc, pg8::bf_hi(rv.w) * sc);
          *(LAS v4u*)(L + RT_VPS + c * RT_VSTR + pc * 16) = o; }
        RT_BAR();
        if (n + 1 < SEQ / 128) RT_LOAD(n + 1);
        bf16x8 qf[4];
#pragma unroll
        for (int ks = 0; ks < 4; ++ks) qf[ks] = *(const LAS bf16x8*)(L + RT_QS + (16 * w + l15) * RT_STR + (32 * ks + 8 * g) * 2);
        bf16x8 pf[4];
        const int cq = 16 * w + l15;
#pragma unroll
        for (int p = 0; p < 4; ++p) {
            bf16x8 kf[8];
#pragma unroll
            for (int ks = 0; ks < 4; ++ks) { kf[ks] = *(const LAS bf16x8*)(L + RT_KS + (32 * p + l15) * RT_STR + (32 * ks + 8 * g) * 2);
                kf[4 + ks] = *(const LAS bf16x8*)(L + RT_KS + (32 * p + 16 + l15) * RT_STR + (32 * ks + 8 * g) * 2); }
            __builtin_amdgcn_sched_barrier(0);
            f32x4 s0 = (f32x4){0.f, 0.f, 0.f, 0.f}, s1 = (f32x4){0.f, 0.f, 0.f, 0.f};
            if (2 * p <= w) {
#pragma unroll
                for (int ks = 0; ks < 4; ++ks) s0 = __builtin_amdgcn_mfma_f32_16x16x32_bf16(kf[ks], qf[ks], s0, 0, 0, 0);
            }
            if (2 * p + 1 <= w) {
#pragma unroll
                for (int ks = 0; ks < 4; ++ks) s1 = __builtin_amdgcn_mfma_f32_16x16x32_bf16(kf[4 + ks], qf[ks], s1, 0, 0, 0);
            }
            float p0[4], p1[4];
#pragma unroll
            for (int i = 0; i < 4; ++i) { const int d0 = cq - (32 * p + 4 * g + i), d1 = d0 - 16;
                p0[i] = d0 >= 0 ? s0[i] * __builtin_amdgcn_exp2f(lg2 * (float)d0) : 0.f; p1[i] = d1 >= 0 ? s1[i] * __builtin_amdgcn_exp2f(lg2 * (float)d1) : 0.f; }
            v4u pk; pk.x = pg8::cvt_pk_bf16(p0[0], p0[1]); pk.y = pg8::cvt_pk_bf16(p0[2], p0[3]); pk.z = pg8::cvt_pk_bf16(p1[0], p1[1]); pk.w = pg8::cvt_pk_bf16(p1[2], p1[3]);
            pf[p] = __builtin_bit_cast(bf16x8, pk);
        }
        const LAS unsigned char* Rcur = L + RT_RT + (n & 1) * RT_RTSZ;
#pragma unroll
        for (int et = 0; et < 2; ++et) {
            bf16x8 rf[4], vf[4];
#pragma unroll
            for (int ks = 0; ks < 4; ++ks) rf[ks] = *(const LAS bf16x8*)(Rcur + (16 * et + l15) * RT_STR + (32 * ks + 8 * g) * 2);
#pragma unroll
            for (int p = 0; p < 4; ++p) { const LAS unsigned char* vb = L + RT_VS + (32 * p + 4 * g + tq) * RT_VSTR + (16 * et + 4 * tp) * 2; vf[p] = tr8(vb, vb + 16 * RT_VSTR); }
            __builtin_amdgcn_sched_barrier(0);
            f32x4 acc = (f32x4){0.f, 0.f, 0.f, 0.f};
#pragma unroll
            for (int ks = 0; ks < 4; ++ks) acc = __builtin_amdgcn_mfma_f32_16x16x32_bf16(qf[ks], rf[ks], acc, 0, 0, 0);
#pragma unroll
            for (int i = 0; i < 4; ++i) acc[i] *= __builtin_amdgcn_exp2f(lg2 * (float)(16 * w + 4 * g + i + 1));
#pragma unroll
            for (int p = 0; p < 4; ++p) if (2 * p <= w) acc = __builtin_amdgcn_mfma_f32_16x16x32_bf16(pf[p], vf[p], acc, 0, 0, 0);
#pragma unroll
            for (int i = 0; i < 4; ++i) Yg[(size_t)(n * 128 + 16 * w + 4 * g + i) * RETW + 16 * et + l15] = acc[i];
        }
        {
            bf16x8 kt[4], vt[4][2];
#pragma unroll
            for (int cs = 0; cs < 4; ++cs) {
                const LAS unsigned char* kb = L + RT_KS + (32 * cs + 8 * g + tq) * RT_STR + (16 * w + 4 * tp) * 2;
                kt[cs] = tr8(kb, kb + 4 * RT_STR);
#pragma unroll
                for (int et = 0; et < 2; ++et) { const LAS unsigned char* vb = L + RT_VPS + (32 * cs + 8 * g + tq) * RT_VSTR + (16 * et + 4 * tp) * 2; vt[cs][et] = tr8(vb, vb + 4 * RT_VSTR); }
            }
            __builtin_amdgcn_sched_barrier(0);
            LAS unsigned char* Rnxt = L + RT_RT + ((n + 1) & 1) * RT_RTSZ;
            accR[0] = accR[0] * gC; accR[1] = accR[1] * gC;
#pragma unroll
            for (int cs = 0; cs < 4; ++cs)
#pragma unroll
                for (int et = 0; et < 2; ++et) accR[et] = __builtin_amdgcn_mfma_f32_16x16x32_bf16(kt[cs], vt[cs][et], accR[et], 0, 0, 0);
#pragma unroll
            for (int et = 0; et < 2; ++et) { v2u o; o.x = pg8::cvt_pk_bf16(accR[et][0], accR[et][1]); o.y = pg8::cvt_pk_bf16(accR[et][2], accR[et][3]);
                *(LAS v2u*)(Rnxt + (16 * et + l15) * RT_STR + (16 * w + 4 * g) * 2) = o; }
        }
        RT_BAR();
    }
#undef RT_LOAD
#undef RT_BAR
}
__device__ __forceinline__ void ph_scan(Frame& F, ArgP A, int l) {
#if MK_CHUNKED
    if (F.G == 256) {
        const int it = F.vcu, r = it & 3, idx = it >> 2;
        if (r == 0 || r == 2) { const int w = idx * 2 + (r >> 1); int n_ = (MK_REP & 32) ? 2 : 1; asm volatile("" : "+s"(n_));
#pragma unroll 1
            for (int k_ = 0; k_ < n_; ++k_) { scan_rwkv_chunk(F, w); __syncthreads(); } }
        else if (r == 1) { int n_ = (MK_REP & 64) ? 2 : 1; asm volatile("" : "+s"(n_));
#pragma unroll 1
            for (int k_ = 0; k_ < n_; ++k_) { scan_ret_mfma(F, idx); __syncthreads(); } }
        else if (l + 1 < DEPTH) { ph_convert(F, A, l + 1, idx, 64); }
        __syncthreads();
    }
#else
    if (F.G >= 256) {
        if (F.vcu >= 192) { if (l + 1 < DEPTH) ph_convert(F, A, l + 1, F.vcu - 192, F.G - 192); return; }
        if (F.vcu < 128) { scan_rwkv_fast(F, F.vcu); if (MK_REP & 32) { __syncthreads(); scan_rwkv_fast(F, F.vcu); } }
        else if (F.vcu < 192) { scan_ret_mfma(F, F.vcu - 128); if (MK_REP & 64) { __syncthreads(); scan_ret_mfma(F, F.vcu - 128); } }
    } else {
        if (l + 1 < DEPTH) ph_convert(F, A, l + 1, F.vcu, F.G);
        const int gw = F.vcu * NWAVES + F.wave, NGW = F.G * NWAVES;
        const int stride = NGW >= 64 ? NGW / 64 : 1;
        if (gw % stride == 0) {
            for (int item = gw / stride; item < 64; item += (NGW + stride - 1) / stride) {
                if (item < 32) scan_rwkv_naive(F, item); else scan_ret_naive(F, item - 32);
            }
        }
    }
#endif
}
#if (MK_GLOBAL_GROUPS & 4)
#pragma pop_macro("WSP")
#pragma pop_macro("WSW")
#pragma pop_macro("OUTP")
#endif
#if (MK_GLOBAL_GROUPS & 8)
#pragma push_macro("WSP")
#pragma push_macro("WSW")
#pragma push_macro("OUTP")
#undef WSP
#undef WSW
#undef OUTP
#define WSP WSPG
#define WSW WSWG
#define OUTP OUTPG
#endif
template <int CTRL> __device__ __forceinline__ float dppx(float x) { return __builtin_bit_cast(float, __builtin_amdgcn_update_dpp(0, __builtin_bit_cast(int, x), CTRL, 0xF, 0xF, true)); }
__device__ __forceinline__ void ph_post(Frame& F, ArgP A, int l) {
    const int gw = F.vcu * NWAVES + F.wave, NGW = F.G * NWAVES, lane = F.lane, c0 = lane * 16;
    f32x4 gg[4], gb[4], lg[4], lb[4];
#pragma unroll
    for (int j = 0; j < 4; ++j) { gg[j] = *(const GAS f32x4*)(INP(A, 4) + (size_t)l * RETW + c0 + 4 * j); gb[j] = *(const GAS f32x4*)(INP(A, 5) + (size_t)l * RETW + c0 + 4 * j);
        lg[j] = *(const GAS f32x4*)(INP(A, 15) + (size_t)l * RWW + c0 + 4 * j); lb[j] = *(const GAS f32x4*)(INP(A, 16) + (size_t)l * RWW + c0 + 4 * j); }
    for (int m = gw; m < M; m += NGW) {
        {
            f32x4 y[4]; float s = 0.f;
#pragma unroll
            for (int j = 0; j < 4; ++j) { y[j] = *(const GAS f32x4*)(OUTP + (size_t)m * RETW + c0 + 4 * j); s += (y[j].x + y[j].y) + (y[j].z + y[j].w); }
            const GAS bf16* zg = (const GAS bf16*)(WSP(bf16, WS_Z) + (size_t)m * INW + ZC_GR + c0);
            float g[16]; { float t[8]; unpack8(*(const GAS v4u*)zg, t);
#pragma unroll
                for (int j = 0; j < 8; ++j) g[j] = t[j]; unpack8(*(const GAS v4u*)(zg + 8), t);
#pragma unroll
                for (int j = 0; j < 8; ++j) g[8 + j] = t[j]; }
            s += dppx<0xB1>(s); s += dppx<0x4E>(s); s += dppx<0x141>(s);
            const float mean = s * (1.f / RD); float q = 0.f;
#pragma unroll
            for (int j = 0; j < 4; ++j) { y[j] = y[j] - mean; q += (y[j].x * y[j].x + y[j].y * y[j].y) + (y[j].z * y[j].z + y[j].w * y[j].w); }
            q += dppx<0xB1>(q); q += dppx<0x4E>(q); q += dppx<0x141>(q);
            const float rstd = __builtin_amdgcn_rsqf(q * (1.f / RD) + RET_GN_EPS);
            float o[16];
#pragma unroll
            for (int j = 0; j < 4; ++j)
#pragma unroll
                for (int k = 0; k < 4; ++k) { const float gr = g[4 * j + k]; o[4 * j + k] = (y[j][k] * rstd * gg[j][k] + gb[j][k]) * (gr * fsig(gr)); }
            GAS bf16* yo = (GAS bf16*)(WSP(bf16, WS_YRET) + (size_t)m * RETW + c0);
            { float t[8];
#pragma unroll
              for (int j = 0; j < 8; ++j) t[j] = o[j]; *(GAS bf16x8*)yo = pack8(t);
#pragma unroll
              for (int j = 0; j < 8; ++j) t[j] = o[8 + j]; *(GAS bf16x8*)(yo + 8) = pack8(t); }
        }
        {
            const size_t ob = (size_t)m * RWW + c0;
            f32x4 y[4]; float s = 0.f;
#pragma unroll
            for (int j = 0; j < 4; ++j) { y[j] = *(const GAS f32x4*)(WSP(float, WS_YRAWW) + ob + 4 * j); s += (y[j].x + y[j].y) + (y[j].z + y[j].w); }
            f32x4 vv[4], gt[4];
#pragma unroll
#if MK_CHUNKED
            for (int j = 0; j < 4; ++j) { vv[j] = unpk4(*(const GAS v2u*)(WSP(bf16, WS_SV) + ob + 4 * j)); gt[j] = unpk4(*(const GAS v2u*)(WSP(bf16, WS_G) + ob + 4 * j)); }
#else
            for (int j = 0; j < 4; ++j) { vv[j] = *(const GAS f32x4*)(WSP(float, WS_SV) + ob + 4 * j); gt[j] = *(const GAS f32x4*)(WSP(float, WS_G) + ob + 4 * j); }
#endif
            const float bonus = *(const GAS float*)(WSP(float, WS_BONUS) + (size_t)m * WH + (lane >> 2));
            s += dppx<0xB1>(s); s += dppx<0x4E>(s);
            const float mean = s * (1.f / WD); float q = 0.f;
#pragma unroll
            for (int j = 0; j < 4; ++j) { y[j] = y[j] - mean; q += (y[j].x * y[j].x + y[j].y * y[j].y) + (y[j].z * y[j].z + y[j].w * y[j].w); }
            q += dppx<0xB1>(q); q += dppx<0x4E>(q);
            const float rstd = __builtin_amdgcn_rsqf(q * (1.f / WD) + RWKV_LN_EPS);
            float o[16];
#pragma unroll
            for (int j = 0; j < 4; ++j)
#pragma unroll
                for (int k = 0; k < 4; ++k) o[4 * j + k] = (y[j][k] * rstd * lg[j][k] + lb[j][k] + bonus * vv[j][k]) * gt[j][k];
            GAS bf16* yo = (GAS bf16*)(WSP(bf16, WS_YRWKV) + ob);
            { float t[8];
#pragma unroll
              for (int j = 0; j < 8; ++j) t[j] = o[j]; *(GAS bf16x8*)yo = pack8(t);
#pragma unroll
              for (int j = 0; j < 8; ++j) t[j] = o[8 + j]; *(GAS bf16x8*)(yo + 8) = pack8(t); }
        }
    }
}
__device__ __forceinline__ void ph_final(Frame& F, ArgP A) {
    const int gw = F.vcu * NWAVES + F.wave, NGW = F.G * NWAVES, lane = F.lane;
    const GAS f32x4* gr = (const GAS f32x4*)INP(A, 23) + 2 * lane;
    for (int m = gw; m < M; m += NGW) {
        const GAS v4u* hr = (const GAS v4u*)(WSP(bf16, WS_H) + (size_t)m * D) + lane;
        GAS f32x4* xo = (GAS f32x4*)(OUTP + (size_t)m * D) + 2 * lane;
        v4u h[4]; f32x4 v[8]; float s = 0.f;
#pragma unroll
        for (int j = 0; j < 4; ++j) h[j] = hr[64 * j];
#pragma unroll
        for (int j = 0; j < 4; ++j) {
            v[2 * j] = f32x4{__builtin_bit_cast(float, h[j].x << 16), __builtin_bit_cast(float, h[j].x & 0xffff0000u), __builtin_bit_cast(float, h[j].y << 16), __builtin_bit_cast(float, h[j].y & 0xffff0000u)};
            v[2 * j + 1] = f32x4{__builtin_bit_cast(float, h[j].z << 16), __builtin_bit_cast(float, h[j].z & 0xffff0000u), __builtin_bit_cast(float, h[j].w << 16), __builtin_bit_cast(float, h[j].w & 0xffff0000u)};
        }
#pragma unroll
        for (int j = 0; j < 8; ++j) s += (v[j].x * v[j].x + v[j].y * v[j].y) + (v[j].z * v[j].z + v[j].w * v[j].w);
        const float rstd = 1.f / sqrtf(wave_sum(s) * (1.f / D) + NORM_EPS);
#pragma unroll
        for (int j = 0; j < 4; ++j) { xo[128 * j] = v[2 * j] * rstd * gr[128 * j]; xo[128 * j + 1] = v[2 * j + 1] * rstd * gr[128 * j + 1]; }
    }
}
#if (MK_GLOBAL_GROUPS & 8)
#pragma pop_macro("WSP")
#pragma pop_macro("WSW")
#pragma pop_macro("OUTP")
#endif

__global__ void __launch_bounds__(NWAVES * 64, 2) hybrid_fwd(Args args) {
    extern __shared__ __attribute__((aligned(16))) unsigned char lds[];
    Frame F;
    F.lds = (LAS unsigned char*)lds;
    F.MISC = (volatile LAS unsigned*)(F.lds + MISC_OFF);
    F.tid = threadIdx.x; F.lane = F.tid & 63; F.wave = __builtin_amdgcn_readfirstlane(F.tid >> 6);
    int bx = blockIdx.x; F.G = gridDim.x; { F.vcu = (F.G % 8 == 0) ? (bx % 8) * (F.G / 8) + bx / 8 : bx; }
    F.ws = args.ws; F.out = args.out;
    for (int u = F.tid; u < (LDS_BYTES - LDSCTL_OFF) / 4; u += NWAVES * 64) ((LAS unsigned*)(F.lds + LDSCTL_OFF))[u] = 0u;
    __syncthreads();
    if (F.tid == 0) { volatile LAS unsigned* U = (volatile LAS unsigned*)(F.lds + MISC_OFF) + 16; const unsigned long long pw = (unsigned long long)args.ws, po = (unsigned long long)args.out, pa = (unsigned long long)__builtin_amdgcn_kernarg_segment_ptr();
        U[0] = (unsigned)pw; U[1] = (unsigned)(pw >> 32); U[2] = (unsigned)po; U[3] = (unsigned)(po >> 32); U[4] = (unsigned)pa; U[5] = (unsigned)(pa >> 32); U[6] = (unsigned)F.G; U[7] = (unsigned)F.vcu; U[8] = (unsigned)bx; }
    __syncthreads();
    XcdBarrier bar = xcd_barrier_post((unsigned*)(F.ws + WS_CTL) + CW_BAR, F.MISC + 8);

    ArgP ap = (ArgP)__builtin_amdgcn_kernarg_segment_ptr();
    const int lo = args.ph_lo, hi = args.ph_hi;
#define REPX(bit, body) do { body; if (MK_REP & (bit)) { __syncthreads(); body; } } while (0)
#define IN(k) (lo <= (k) && (k) < hi)
#define SEAM(k) do { if (IN(k) && IN((k) + 1)) xcd_barrier(bar); else __syncthreads(); } while (0)

    if (IN(PH_PRO)) { int np_ = (MK_REP & 8192) ? 2 : 1; asm volatile("" : "+s"(np_));
#pragma unroll 1
        for (int rp_ = 0; rp_ < np_; ++rp_) { ph_prologue(F, ap); ph_convert(F, ap, 0, F.vcu, F.G); __syncthreads(); } }
    SEAM(PH_PRO);
    for (int l = 0; l < DEPTH; ++l) {
        const int p0 = PH_L0 + l * PPL;
        RETID();
        { unsigned ba = MISC_OFF + 64; asm volatile("" : "+v"(ba));
          const volatile LAS v4u* U = (const volatile LAS v4u*)(F.lds + ba);
          const v4u ua = U[0], ub = U[1]; const unsigned uc = *(const volatile LAS unsigned*)(U + 2);
          const unsigned u0 = __builtin_amdgcn_readfirstlane(ua.x), u1 = __builtin_amdgcn_readfirstlane(ua.y), u2 = __builtin_amdgcn_readfirstlane(ua.z), u3 = __builtin_amdgcn_readfirstlane(ua.w);
          const unsigned u4 = __builtin_amdgcn_readfirstlane(ub.x), u5 = __builtin_amdgcn_readfirstlane(ub.y), u6 = __builtin_amdgcn_readfirstlane(ub.z), u7 = __builtin_amdgcn_readfirstlane(ub.w), u8 = __builtin_amdgcn_readfirstlane(uc);
          F.ws = (unsigned char*)(((unsigned long long)u1 << 32) | u0); F.out = (float*)(((unsigned long long)u3 << 32) | u2); ap = (ArgP)(((unsigned long long)u5 << 32) | u4);
          F.G = (int)u6; F.vcu = (int)u7; bx = (int)u8; F.wave = __builtin_amdgcn_readfirstlane(F.tid >> 6); }
        if (IN(p0 + LP_G1)) {
            pg8::Gemm g{WSPG(bf16, WS_H), WSWG(l, WO_WIN), M, INW, D}; pg8::StaticOrder S; S.init(M, INW, F.G, bx);
            pg8::EpiB<0> E{WSPG(bf16, WS_Z), INW, nullptr, 0, WSPG(float, WS_SS)};
            pg8::gemm_phase<pg8::EpiB<0>, pg8::StaticOrder, MK_ALIGN, MK_SP2>(F.lds + RING_OFF, g, S, E);
            if (MK_REP & 512) { __syncthreads(); pg8::gemm_phase<pg8::EpiB<0>, pg8::StaticOrder, MK_ALIGN, MK_SP2>(F.lds + RING_OFF, g, S, E); }
            if (MK_CONV_IN_G1 && F.G == 256 && l + 1 < DEPTH && bx >= 64) { RETID(); ph_convert(F, ap, l + 1, bx - 64, 192); }
        }
        SEAM(p0 + LP_G1);
        if (IN(p0 + LP_PREP)) { int nrep_ = (MK_REP & 4) ? 2 : 1; asm volatile("" : "+s"(nrep_));
#pragma unroll 1
            for (int rep_ = 0; rep_ < nrep_; ++rep_) { RETID(); ph_prep(F, ap, l); __syncthreads(); } }
        SEAM(p0 + LP_PREP);
        if (IN(p0 + LP_SCAN)) { RETID(); REPX(8, ph_scan(F, ap, l)); }
        SEAM(p0 + LP_SCAN);
        if (IN(p0 + LP_POST)) { RETID(); REPX(16, ph_post(F, ap, l)); }
        SEAM(p0 + LP_POST);
        if (IN(p0 + LP_GA)) {
            pg8::Gemm g{WSPG(bf16, WS_YRET), WSWG(l, WO_WA), M, D, RETW}; pg8::StaticOrder S; S.init(M, D, F.G, bx);
            pg8::EpiB<2> E{WSPG(bf16, WS_MRG), D, WSPG(bf16, WS_Z) + ZC_GA, INW, nullptr};
            pg8::gemm_phase<pg8::EpiB<2>, pg8::StaticOrder, MK_ALIGN, MK_SP2>(F.lds + RING_OFF, g, S, E);
        }
        __syncthreads();
        if (IN(p0 + LP_GB)) {
            pg8::Gemm g{WSPG(bf16, WS_YRWKV), WSWG(l, WO_WB), M, D, RWW}; pg8::StaticOrder S; S.init(M, D, F.G, bx);
            pg8::EpiB<3> E{WSPG(bf16, WS_MRG), D, WSPG(bf16, WS_Z) + ZC_GB, INW, nullptr};
            pg8::gemm_phase<pg8::EpiB<3>, pg8::StaticOrder, MK_ALIGN, MK_SP2>(F.lds + RING_OFF, g, S, E);
        }
        SEAM(p0 + LP_GB);
        if (IN(p0 + LP_GO)) {
            pg8::Gemm g{WSPG(bf16, WS_MRG), WSWG(l, WO_WO), M, D, D}; pg8::StaticOrder S; S.init(M, D, F.G, bx);
            pg8::EpiResNorm E{WSPG(bf16, WS_H), D, WSPG(float, WS_SS)};
            pg8::gemm_phase<pg8::EpiResNorm, pg8::StaticOrder, MK_ALIGN, MK_SP2>(F.lds + RING_OFF, g, S, E);
        }
        SEAM(p0 + LP_GO);
        if (IN(p0 + LP_GUP)) {
            pg8::Gemm g{WSPG(bf16, WS_H), WSWG(l, WO_WUP), M, DFF, D}; pg8::StaticOrder S; S.init(M, DFF, F.G, bx);
            pg8::EpiB<1> E{WSPG(bf16, WS_UP), DFF, nullptr, 0, WSPG(float, WS_SS)};
            pg8::gemm_phase<pg8::EpiB<1>, pg8::StaticOrder, MK_ALIGN, MK_SP2>(F.lds + RING_OFF, g, S, E);
        }
        SEAM(p0 + LP_GUP);
        if (IN(p0 + LP_GDN)) {
            pg8::Gemm g{WSPG(bf16, WS_UP), WSWG(l, WO_WDN), M, D, DFF}; pg8::StaticOrder S; S.init(M, D, F.G, bx);
            pg8::EpiResNorm E{WSPG(bf16, WS_H), D, WSPG(float, WS_SS)};
            pg8::gemm_phase<pg8::EpiResNorm, pg8::StaticOrder, MK_ALIGN, MK_SP2>(F.lds + RING_OFF, g, S, E);
        }
        SEAM(p0 + LP_GDN);
    }
    if (IN(PH_FIN)) { RETID(); ph_final(F, ap); }
#undef IN
#undef SEAM
}

extern "C" void kernel_launch(void* const* d_in, const int* in_sizes, int n_in, void* d_out, int out_size, void* d_ws, size_t ws_size, hipStream_t stream) {
    static int grid = 0;
    if (grid == 0) {
        if (n_in != 24 || in_sizes[0] != M * D || out_size != M * D || ws_size < WS_END) { fprintf(stderr, "kernel_launch: built for 24 inputs, x and out of %d floats, >= %zu bytes of workspace; got n_in %d, in0 %d, out %d, ws %zu; nothing launched\n", M * D, (size_t)WS_END, n_in, n_in > 0 ? in_sizes[0] : -1, out_size, ws_size); grid = -1; return; }
        int dev = 0, cus = 0, per_cu = 0;
        if (hipGetDevice(&dev) != hipSuccess || hipDeviceGetAttribute(&cus, hipDeviceAttributeMultiprocessorCount, dev) != hipSuccess) { fprintf(stderr, "kernel_launch: hipGetDevice / hipDeviceGetAttribute failed; nothing launched\n"); grid = -1; return; }
        if (hipFuncSetAttribute((const void*)hybrid_fwd, hipFuncAttributeMaxDynamicSharedMemorySize, LDS_BYTES) != hipSuccess) { fprintf(stderr, "kernel_launch: hipFuncSetAttribute failed\n"); grid = -1; return; }
        if (hipOccupancyMaxActiveBlocksPerMultiprocessor(&per_cu, (const void*)hybrid_fwd, NWAVES * 64, LDS_BYTES) != hipSuccess || per_cu < 1)
            fprintf(stderr, "kernel_launch: note: the occupancy query reports %d workgroups per CU\n", per_cu);
        (void)hipGetLastError();
        if (cus < 256) { fprintf(stderr, "kernel_launch: built for a 256-CU device (MI355X); this one reports %d CUs; nothing launched\n", cus); grid = -1; return; }
        grid = 256;
    }
    if (grid < 0) return;
    if (hipMemsetAsync((char*)d_ws + WS_CTL, 0, CTL_ZERO_BYTES, stream) != hipSuccess) { fprintf(stderr, "kernel_launch: hipMemsetAsync failed\n"); return; }
    Args a{};
    for (int i = 0; i < 24; ++i) a.in[i] = (const float*)d_in[i];
    a.out = (float*)d_out; a.ws = (unsigned char*)d_ws; a.li = 0; a.pad = 0;
#if MK_ONE_LAUNCH
    a.ph_lo = 0; a.ph_hi = NPH;
    hipLaunchKernelGGL(hybrid_fwd, dim3(grid), dim3(NWAVES * 64), LDS_BYTES, stream, a);
#else
    for (int p = 0; p < NPH; ++p) {
        a.ph_lo = p; a.ph_hi = p + 1;
        hipLaunchKernelGGL(hybrid_fwd, dim3(grid), dim3(NWAVES * 64), LDS_BYTES, stream, a);
    }
#endif
    const hipError_t le = hipPeekAtLastError();
    if (le != hipSuccess) fprintf(stderr, "kernel_launch: launch failed: %s\n", hipGetErrorName(le));
}
```

```cpp
#include <hip/hip_runtime.h>
#include <cstdio>
#include <cstdint>
#ifndef MK_GLOBAL_GROUPS
#define MK_GLOBAL_GROUPS 30
#endif
#ifndef MK_REP
#define MK_REP 0
#endif
namespace pg8 {
#define PG8_LAS __attribute__((address_space(3)))
typedef unsigned short bf16_t;
typedef short bf16x8 __attribute__((ext_vector_type(8)));
typedef float f32x4 __attribute__((ext_vector_type(4)));
typedef unsigned u32x4 __attribute__((ext_vector_type(4)));
constexpr int BM = 256, BK = 64, HALF = 128, HTB = HALF * BK * 2  , STAGE_BYTES = 8 * HTB, NXCD = 8, WGM = 4;

__host__ __device__ __forceinline__ int lds_byte(int r, int c) { const int st = (r >> 4) * 2 + (c >> 5), rr = r & 15, cc = c & 31, ob = rr * 64 + cc * 2; return st * 1024 + (ob ^ (((ob >> 9) & 1) << 5)); }
__host__ __device__ __forceinline__ void stage_rc(int b, int& R, int& C) { const int st = b / 1024, sb = b % 1024, swz = sb ^ (((sb >> 9) & 1) << 5); R = (st >> 1) * 16 + swz / 64; C = (st & 1) * 32 + (swz % 64) / 2; }
__host__ __device__ __forceinline__ int perm32(int rho) { const int n = rho >> 4, i = rho & 15; return 8 * (i >> 2) + 4 * n + (i & 3); }

struct Unit { int pm, pn; };
struct Gemm { const bf16_t* A; const bf16_t* Bt; int M, N, K; const bf16_t* A2 = nullptr; const bf16_t* Bt2 = nullptr; };

struct StaticOrder {
    int nM, nN, nwg, G, c;
    __host__ __device__ void init(int M, int N, int G_, int c_) { nM = M / BM; nN = N / BM; nwg = nM * nN; G = G_; c = c_; }
    __host__ __device__ bool next(int i, Unit& u) const {
        const long L = (long)i * G + c; if (L >= nwg) return false;
        int wgid = (int)L; { const int q = nwg / NXCD, r = nwg % NXCD, xcd = wgid % NXCD, off = wgid / NXCD; wgid = (xcd < r ? xcd * (q + 1) : r * (q + 1) + (xcd - r) * q) + off; }
        const int nig = WGM * nN, gid = wgid / nig, fm = gid * WGM, gsz = (nM - fm) < WGM ? (nM - fm) : WGM;
        u.pm = fm + ((wgid % nig) % gsz); u.pn = (wgid % nig) / gsz; return true;
    }
    __device__ __forceinline__ void a_ready(const Unit&) const {}
    __device__ __forceinline__ void done(const Unit&) const {}
};

struct OneUnit {
    int pm, pn;
    __host__ __device__ bool next(int i, Unit& u) const { if (i != 0) return false; u.pm = pm; u.pn = pn; return true; }
    __device__ __forceinline__ void a_ready(const Unit&) const {}
    __device__ __forceinline__ void done(const Unit&) const {}
};

typedef float f32x2c __attribute__((ext_vector_type(2))); typedef __bf16 bf16x2c __attribute__((ext_vector_type(2)));
__device__ __forceinline__ unsigned cvt_pk_bf16(float lo, float hi) { const f32x2c v = {lo, hi}; return __builtin_bit_cast(unsigned, __builtin_convertvector(v, bf16x2c)); }
typedef float f32x2 __attribute__((ext_vector_type(2)));
__device__ __forceinline__ float bf_lo(unsigned w) { return __builtin_bit_cast(float, w << 16); }
__device__ __forceinline__ float bf_hi(unsigned w) { return __builtin_bit_cast(float, w & 0xffff0000u); }
__device__ __forceinline__ float sigmoidf_(float x) { return 1.0f / (1.0f + __expf(-x)); }
template <int MODE> struct EpiB {
    static constexpr bool PERM = true, AFTER_DRAIN = false;
    bf16_t* O; int ldc; const bf16_t* gate; int ldg; const PG8_LAS float* rl; int pm0;
    __device__ __forceinline__ void operator()(const f32x4 (&acc)[2][2][4][2], const Unit& u, int wr, int wc, int fr, int fq) const {
        const int row0 = u.pm * BM + wr * 64 + fr, col0 = u.pn * BM + wc * 32 + 8 * fq;
        float rs[2][4];
        if (MODE <= 1) { int fo = wr * 64 + fr; asm volatile("" : "+v"(fo));
            const PG8_LAS float* r = rl + (u.pm - pm0) * BM + fo;
#pragma unroll
            for (int ai = 0; ai < 2; ++ai)
#pragma unroll
                for (int m = 0; m < 4; ++m) rs[ai][m] = r[ai * HALF + m * 16]; }
#pragma unroll
        for (int ai = 0; ai < 2; ++ai)
#pragma unroll
            for (int m = 0; m < 4; ++m) { const size_t row = (size_t)(row0 + ai * HALF + m * 16);
#pragma unroll
                for (int bj = 0; bj < 2; ++bj) { f32x4 v0 = acc[ai][bj][m][0], v1 = acc[ai][bj][m][1]; const int c = col0 + bj * HALF;
                    if (MODE <= 1) { v0 = v0 * rs[ai][m]; v1 = v1 * rs[ai][m]; }
                    if (MODE == 1) {
#pragma unroll
                        for (int j = 0; j < 4; ++j) { const float a = fmaxf(v0[j], 0.f), b = fmaxf(v1[j], 0.f); v0[j] = a * a; v1[j] = b * b; } }
                    if (MODE >= 2) { const u32x4 g = *(const u32x4*)(gate + row * ldg + c);
                        v0[0] *= sigmoidf_(bf_lo(g.x)); v0[1] *= sigmoidf_(bf_hi(g.x)); v0[2] *= sigmoidf_(bf_lo(g.y)); v0[3] *= sigmoidf_(bf_hi(g.y));
                        v1[0] *= sigmoidf_(bf_lo(g.z)); v1[1] *= sigmoidf_(bf_hi(g.z)); v1[2] *= sigmoidf_(bf_lo(g.w)); v1[3] *= sigmoidf_(bf_hi(g.w)); }
                    if (MODE == 3) { const u32x4 o = *(const u32x4*)(O + row * ldc + c);
                        v0[0] += bf_lo(o.x); v0[1] += bf_hi(o.x); v0[2] += bf_lo(o.y); v0[3] += bf_hi(o.y);
                        v1[0] += bf_lo(o.z); v1[1] += bf_hi(o.z); v1[2] += bf_lo(o.w); v1[3] += bf_hi(o.w); }
                    u32x4 w; w.x = cvt_pk_bf16(v0[0], v0[1]); w.y = cvt_pk_bf16(v0[2], v0[3]); w.z = cvt_pk_bf16(v1[0], v1[1]); w.w = cvt_pk_bf16(v1[2], v1[3]);
                    *(u32x4*)(O + row * ldc + c) = w; } }
    }
};
struct EpiResNorm {
    static constexpr bool PERM = true, AFTER_DRAIN = false;
    bf16_t* XB; int ldc; float* SS;
    __device__ __forceinline__ void operator()(const f32x4 (&acc)[2][2][4][2], const Unit& u, int wr, int wc, int fr, int fq) const {
        const int row0 = u.pm * BM + wr * 64 + fr, col0 = u.pn * BM + wc * 32 + 8 * fq;
#pragma unroll
        for (int ai = 0; ai < 2; ++ai) {
            u32x4 o[4][2];
#pragma unroll
            for (int m = 0; m < 4; ++m)
#pragma unroll
                for (int bj = 0; bj < 2; ++bj) o[m][bj] = *(const u32x4*)(XB + (size_t)(row0 + ai * HALF + m * 16) * ldc + col0 + bj * HALF);
#pragma unroll
            for (int m = 0; m < 4; ++m) { const size_t row = (size_t)(row0 + ai * HALF + m * 16);
                float s = 0.f;
#pragma unroll
                for (int bj = 0; bj < 2; ++bj) { const int c = col0 + bj * HALF; const u32x4 r = o[m][bj];
                    f32x4 x0 = acc[ai][bj][m][0], x1 = acc[ai][bj][m][1];
                    x0[0] += bf_lo(r.x); x0[1] += bf_hi(r.x); x0[2] += bf_lo(r.y); x0[3] += bf_hi(r.y); x1[0] += bf_lo(r.z); x1[1] += bf_hi(r.z); x1[2] += bf_lo(r.w); x1[3] += bf_hi(r.w);
                    u32x4 w; w.x = cvt_pk_bf16(x0[0], x0[1]); w.y = cvt_pk_bf16(x0[2], x0[3]); w.z = cvt_pk_bf16(x1[0], x1[1]); w.w = cvt_pk_bf16(x1[2], x1[3]);
                    *(u32x4*)(XB + row * ldc + c) = w;
                    s += ((x0[0] * x0[0] + x0[1] * x0[1]) + (x0[2] * x0[2] + x0[3] * x0[3])) + ((x1[0] * x1[0] + x1[1] * x1[1]) + (x1[2] * x1[2] + x1[3] * x1[3])); }
                s += __shfl_xor(s, 16); s += __shfl_xor(s, 32);
                if (fq == 0) SS[row * 32 + u.pn * 4 + wc] = s; } }
    }
};

struct EpiGate2 {
    static constexpr bool PERM = true, AFTER_DRAIN = false;
    bf16_t* O; int ldc; const bf16_t* ga; const bf16_t* gb; int ldg;
    static __device__ __forceinline__ float en(float g) { return __expf(-fmaxf(g, -60.f)); }
    __device__ __forceinline__ void mid_load(u32x4 (&a)[2][2], u32x4 (&b)[2][2], int q, int row0, int col0) const {
#pragma unroll
        for (int m = 0; m < 2; ++m)
#pragma unroll
            for (int bj = 0; bj < 2; ++bj) { const size_t o = (size_t)(row0 + (q >> 1) * HALF + (2 * (q & 1) + m) * 16) * ldg + col0 + bj * HALF; a[m][bj] = *(const u32x4*)(ga + o); b[m][bj] = *(const u32x4*)(gb + o); }
    }
    __device__ __forceinline__ void mid_apply(f32x4 (&acc)[2][2][4][2], const u32x4 (&a)[2][2], const u32x4 (&b)[2][2], int q) const {
#pragma unroll
        for (int m = 0; m < 2; ++m)
#pragma unroll
            for (int bj = 0; bj < 2; ++bj) { const u32x4 x = a[m][bj], y = b[m][bj]; f32x4& v0 = acc[q >> 1][bj][2 * (q & 1) + m][0]; f32x4& v1 = acc[q >> 1][bj][2 * (q & 1) + m][1];
                v0[0] *= (1.f + en(bf_lo(y.x))) * __builtin_amdgcn_rcpf(1.f + en(bf_lo(x.x))); v0[1] *= (1.f + en(bf_hi(y.x))) * __builtin_amdgcn_rcpf(1.f + en(bf_hi(x.x)));
                v0[2] *= (1.f + en(bf_lo(y.y))) * __builtin_amdgcn_rcpf(1.f + en(bf_lo(x.y))); v0[3] *= (1.f + en(bf_hi(y.y))) * __builtin_amdgcn_rcpf(1.f + en(bf_hi(x.y)));
                v1[0] *= (1.f + en(bf_lo(y.z))) * __builtin_amdgcn_rcpf(1.f + en(bf_lo(x.z))); v1[1] *= (1.f + en(bf_hi(y.z))) * __builtin_amdgcn_rcpf(1.f + en(bf_hi(x.z)));
                v1[2] *= (1.f + en(bf_lo(y.w))) * __builtin_amdgcn_rcpf(1.f + en(bf_lo(x.w))); v1[3] *= (1.f + en(bf_hi(y.w))) * __builtin_amdgcn_rcpf(1.f + en(bf_hi(x.w))); }
        asm volatile("" : "+v"(acc[q >> 1][0][2 * (q & 1)][0]), "+v"(acc[q >> 1][0][2 * (q & 1)][1]), "+v"(acc[q >> 1][1][2 * (q & 1)][0]), "+v"(acc[q >> 1][1][2 * (q & 1)][1]),
                          "+v"(acc[q >> 1][0][2 * (q & 1) + 1][0]), "+v"(acc[q >> 1][0][2 * (q & 1) + 1][1]), "+v"(acc[q >> 1][1][2 * (q & 1) + 1][0]), "+v"(acc[q >> 1][1][2 * (q & 1) + 1][1]));
    }
    __device__ __forceinline__ void mid(f32x4 (&acc)[2][2][4][2], const Unit& u, int wr, int wc, int fr, int fq) const {
        const int row0 = u.pm * BM + wr * 64 + fr, col0 = u.pn * BM + wc * 32 + 8 * fq;
        u32x4 a0[2][2], b0[2][2], a1[2][2], b1[2][2];
        int r = row0;
        mid_load(a0, b0, 0, r, col0); mid_load(a1, b1, 1, r, col0); __builtin_amdgcn_sched_barrier(0);
        mid_apply(acc, a0, b0, 0); __builtin_amdgcn_sched_barrier(0); asm volatile("" : "+v"(r)); mid_load(a0, b0, 2, r, col0); __builtin_amdgcn_sched_barrier(0);
        mid_apply(acc, a1, b1, 1); __builtin_amdgcn_sched_barrier(0); asm volatile("" : "+v"(r)); mid_load(a1, b1, 3, r, col0); __builtin_amdgcn_sched_barrier(0);
        mid_apply(acc, a0, b0, 2); __builtin_amdgcn_sched_barrier(0);
        mid_apply(acc, a1, b1, 3); __builtin_amdgcn_sched_barrier(0);
    }
    __device__ __forceinline__ void operator()(const f32x4 (&acc)[2][2][4][2], const Unit& u, int wr, int wc, int fr, int fq) const {
        const int row0 = u.pm * BM + wr * 64 + fr, col0 = u.pn * BM + wc * 32 + 8 * fq;
#pragma unroll
        for (int ai = 0; ai < 2; ++ai) {
            u32x4 b[4][2];
#pragma unroll
            for (int m = 0; m < 4; ++m)
#pragma unroll
                for (int bj = 0; bj < 2; ++bj) b[m][bj] = *(const u32x4*)(gb + (size_t)(row0 + ai * HALF + m * 16) * ldg + col0 + bj * HALF);
#pragma unroll
            for (int m = 0; m < 4; ++m)
#pragma unroll
                for (int bj = 0; bj < 2; ++bj) { const u32x4 y = b[m][bj]; f32x4 v0 = acc[ai][bj][m][0], v1 = acc[ai][bj][m][1];
                    v0[0] *= __builtin_amdgcn_rcpf(1.f + en(bf_lo(y.x))); v0[1] *= __builtin_amdgcn_rcpf(1.f + en(bf_hi(y.x))); v0[2] *= __builtin_amdgcn_rcpf(1.f + en(bf_lo(y.y))); v0[3] *= __builtin_amdgcn_rcpf(1.f + en(bf_hi(y.y)));
                    v1[0] *= __builtin_amdgcn_rcpf(1.f + en(bf_lo(y.z))); v1[1] *= __builtin_amdgcn_rcpf(1.f + en(bf_hi(y.z))); v1[2] *= __builtin_amdgcn_rcpf(1.f + en(bf_lo(y.w))); v1[3] *= __builtin_amdgcn_rcpf(1.f + en(bf_hi(y.w)));
                    u32x4 w; w.x = cvt_pk_bf16(v0[0], v0[1]); w.y = cvt_pk_bf16(v0[2], v0[3]); w.z = cvt_pk_bf16(v1[0], v1[1]); w.w = cvt_pk_bf16(v1[2], v1[3]);
                    *(u32x4*)(O + (size_t)(row0 + ai * HALF + m * 16) * ldc + col0 + bj * HALF) = w; }
            __builtin_amdgcn_sched_barrier(0);
        }
    }
};

template <class Epi, class Sched, bool ALIGN_EPI = false, bool SP2 = false, bool SEG2 = false>
__device__ __forceinline__ void gemm_phase(PG8_LAS unsigned char* lds, const Gemm g, const Sched& S, const Epi& E) {
    int tid_ = threadIdx.x; asm volatile("" : "+v"(tid_));
    const int tid = tid_, wid = __builtin_amdgcn_readfirstlane(tid >> 6), lane = tid & 63, wr = wid >> 2, wc = wid & 3, fr = lane & 15, fq = lane >> 4;
    const int K = g.K, nt = K / BK;
    unsigned voffA[2], voffB[2];
#pragma unroll
    for (int i = 0; i < 2; ++i) { int R, C; stage_rc(tid * 16 + i * 8192, R, C); const int Rb = Epi::PERM ? ((R & ~31) + perm32(R & 31)) : R;
        voffA[i] = (unsigned)(R * K + C) * 2u; voffB[i] = (unsigned)(Rb * K + C) * 2u; }
    const size_t kstep = (size_t)(BK * 2);
    const size_t hstep = (size_t)HALF * K * 2;
    const size_t tstep = 2 * hstep;
    const unsigned ldsw = (unsigned)wid * 1024u;
    const int aoff = lds_byte(wr * 64 + fr, fq * 8), boff = lds_byte(wc * 32 + fr, fq * 8);
#define PG8_SA(b, h) (((b) * 2 + (h)) * HTB)
#define PG8_SB(b, h) ((4 + (b) * 2 + (h)) * HTB)
#define PG8_STAGE(bufoff, gbase, voff) do { _Pragma("unroll") for (int _i = 0; _i < 2; ++_i) \
        __builtin_amdgcn_global_load_lds((const unsigned*)((const char*)(gbase) + (voff)[_i]), (PG8_LAS unsigned*)(lds + (bufoff) + ldsw + _i * 8192), 16, 0, 0); } while (0)
#define PG8_LDA(dst, b, h) do { _Pragma("unroll") for (int m = 0; m < 4; ++m) _Pragma("unroll") for (int k = 0; k < 2; ++k) dst[m][k] = *(const PG8_LAS bf16x8*)(lds + PG8_SA(b, h) + aoff + m * 2048 + k * 1024); } while (0)
#define PG8_LDB(dst, b, h) do { _Pragma("unroll") for (int n = 0; n < 2; ++n) _Pragma("unroll") for (int k = 0; k < 2; ++k) dst[n][k] = *(const PG8_LAS bf16x8*)(lds + PG8_SB(b, h) + boff + n * 2048 + k * 1024); } while (0)
#define PG8_MMA(ai, bj, At, Bt) do { __builtin_amdgcn_s_setprio(1); _Pragma("unroll") for (int m = 0; m < 4; ++m) _Pragma("unroll") for (int n = 0; n < 2; ++n) _Pragma("unroll") for (int k = 0; k < 2; ++k) \
        acc[ai][bj][m][n] = __builtin_amdgcn_mfma_f32_16x16x32_bf16(Bt[n][k], At[m][k], acc[ai][bj][m][n], 0, 0, 0); __builtin_amdgcn_s_setprio(0); } while (0)
#define PG8_WAIT_V(n) asm volatile("s_waitcnt vmcnt(" #n ")" ::: "memory")
#define PG8_WAIT_L(n) asm volatile("s_waitcnt lgkmcnt(" #n ")" ::: "memory")
#define PG8_BAR __builtin_amdgcn_s_barrier()
#define PG8_SCHED __builtin_amdgcn_sched_barrier(0)
    Unit cur, nxt; int ui = 0;
    if (!S.next(0, cur)) return;
    f32x4 acc[2][2][4][2];
#pragma unroll
    for (int a = 0; a < 2; ++a)
#pragma unroll
        for (int b = 0; b < 2; ++b)
#pragma unroll
            for (int m = 0; m < 4; ++m)
#pragma unroll
                for (int n = 0; n < 2; ++n) acc[a][b][m][n] = (f32x4){0.f, 0.f, 0.f, 0.f};
    bf16x8 At[4][2], B0[2][2], B1[2][2];
    const char* cA = (const char*)g.A + (size_t)cur.pm * tstep; const char* cB = (const char*)g.Bt + (size_t)cur.pn * tstep;
    S.a_ready(cur);
    if constexpr (SP2) {
        PG8_STAGE(PG8_SB(0, 0), cB, voffB); PG8_STAGE(PG8_SB(0, 1), cB + hstep, voffB); PG8_STAGE(PG8_SA(0, 0), cA, voffA); PG8_STAGE(PG8_SA(0, 1), cA + hstep, voffA);
        if (wr == 1) PG8_BAR;
        PG8_WAIT_V(2); PG8_BAR;
        PG8_STAGE(PG8_SB(1, 0), cB + kstep, voffB); PG8_STAGE(PG8_SA(1, 0), cA + kstep, voffA); PG8_STAGE(PG8_SB(1, 1), cB + hstep + kstep, voffB);
        PG8_WAIT_V(6); PG8_BAR;
    } else {
        PG8_STAGE(PG8_SB(0, 0), cB, voffB); PG8_STAGE(PG8_SA(0, 0), cA, voffA); PG8_STAGE(PG8_SB(0, 1), cB + hstep, voffB); PG8_STAGE(PG8_SA(0, 1), cA + hstep, voffA);
        if (wr == 1) PG8_BAR;
        PG8_WAIT_V(4); PG8_BAR;
        PG8_STAGE(PG8_SB(1, 0), cB + kstep, voffB); PG8_STAGE(PG8_SA(1, 0), cA + kstep, voffA); PG8_STAGE(PG8_SB(1, 1), cB + hstep + kstep, voffB);
        PG8_WAIT_V(6); PG8_BAR;
    }
    int seg = 0;
    for (;;) {
        bool has_next; const char* nA; const char* nB;
        if (SEG2 && seg == 0) { has_next = true; nxt = cur; nA = (const char*)g.A2 + (size_t)cur.pm * tstep; nB = (const char*)g.Bt2 + (size_t)cur.pn * tstep; }
        else { has_next = S.next(ui + 1, nxt); nA = has_next ? (const char*)g.A + (size_t)nxt.pm * tstep : cA; nB = has_next ? (const char*)g.Bt + (size_t)nxt.pn * tstep : cB; }
        for (int t = 0; t < nt; t += 2) {
            const bool last = (t == nt - 2);
            const char* a1 = cA + (size_t)(t + 1) * kstep;
            const char* a2 = last ? nA : cA + (size_t)(t + 2) * kstep; const char* b2 = last ? nB : cB + (size_t)(t + 2) * kstep;
            const char* a3 = a2 + kstep; const char* b3 = b2 + kstep;
            if (last && has_next && !(SEG2 && seg == 0)) S.a_ready(nxt);
            if constexpr (SP2) {
            PG8_LDB(B0, 0, 0); PG8_LDB(B1, 0, 1); PG8_SCHED; PG8_LDA(At, 0, 0); PG8_STAGE(PG8_SA(1, 1), a1 + hstep, voffA);
            PG8_WAIT_V(8); PG8_WAIT_L(0); PG8_BAR; PG8_MMA(0, 0, At, B0); PG8_MMA(0, 1, At, B1); PG8_BAR; PG8_SCHED;
            PG8_LDA(At, 0, 1); PG8_STAGE(PG8_SB(0, 0), b2, voffB); PG8_STAGE(PG8_SB(0, 1), b2 + hstep, voffB); PG8_STAGE(PG8_SA(0, 0), a2, voffA);
            PG8_WAIT_V(8); PG8_WAIT_L(0); PG8_BAR; PG8_MMA(1, 0, At, B0); PG8_MMA(1, 1, At, B1); PG8_BAR; PG8_SCHED;
            PG8_LDB(B0, 1, 0); PG8_LDB(B1, 1, 1); PG8_SCHED; PG8_LDA(At, 1, 0); PG8_STAGE(PG8_SA(0, 1), a2 + hstep, voffA);
            PG8_WAIT_V(8); PG8_WAIT_L(0); PG8_BAR; PG8_MMA(0, 0, At, B0); PG8_MMA(0, 1, At, B1); PG8_BAR; PG8_SCHED;
            PG8_LDA(At, 1, 1); PG8_STAGE(PG8_SB(1, 0), b3, voffB); PG8_STAGE(PG8_SB(1, 1), b3 + hstep, voffB); PG8_STAGE(PG8_SA(1, 0), a3, voffA);
            PG8_WAIT_V(8); PG8_WAIT_L(0); PG8_BAR; PG8_MMA(1, 0, At, B0); PG8_MMA(1, 1, At, B1); PG8_BAR; PG8_SCHED;
            } else {
            PG8_LDB(B0, 0, 0); PG8_SCHED; PG8_LDA(At, 0, 0); PG8_STAGE(PG8_SA(1, 1), a1 + hstep, voffA);
            PG8_WAIT_L(8); PG8_BAR; PG8_WAIT_L(0); PG8_MMA(0, 0, At, B0); PG8_BAR; PG8_SCHED;
            PG8_LDB(B1, 0, 1); PG8_STAGE(PG8_SB(0, 0), b2, voffB);
            PG8_BAR; PG8_WAIT_L(0); PG8_MMA(0, 1, At, B1); PG8_BAR;
            PG8_LDA(At, 0, 1); PG8_STAGE(PG8_SA(0, 0), a2, voffA);
            PG8_BAR; PG8_WAIT_L(0); PG8_MMA(1, 0, At, B0); PG8_BAR; PG8_SCHED;
            PG8_STAGE(PG8_SB(0, 1), b2 + hstep, voffB);
            PG8_WAIT_V(6); PG8_BAR; PG8_MMA(1, 1, At, B1); PG8_BAR;
            PG8_LDB(B0, 1, 0); PG8_SCHED; PG8_LDA(At, 1, 0); PG8_STAGE(PG8_SA(0, 1), a2 + hstep, voffA);
            PG8_WAIT_L(8); PG8_BAR; PG8_WAIT_L(0); PG8_MMA(0, 0, At, B0); PG8_BAR; PG8_SCHED;
            PG8_LDB(B1, 1, 1); PG8_STAGE(PG8_SB(1, 0), b3, voffB);
            PG8_BAR; PG8_WAIT_L(0); PG8_MMA(0, 1, At, B1); PG8_BAR;
            PG8_LDA(At, 1, 1); PG8_STAGE(PG8_SA(1, 0), a3, voffA);
            PG8_BAR; PG8_WAIT_L(0); PG8_MMA(1, 0, At, B0); PG8_BAR; PG8_SCHED;
            PG8_STAGE(PG8_SB(1, 1), b3 + hstep, voffB);
            PG8_WAIT_V(6); PG8_BAR; PG8_MMA(1, 1, At, B1); PG8_BAR;
            }
        }
        if constexpr (ALIGN_EPI) { if (wr == 0) PG8_BAR; }
        if constexpr (SEG2) {
            int t2 = tid, pm2 = cur.pm, pn2 = cur.pn; asm volatile("" : "+v"(t2), "+s"(pm2), "+s"(pn2));
            const int l2 = t2 & 63, w2 = __builtin_amdgcn_readfirstlane(t2 >> 6); const Unit u2{pm2, pn2};
            if (seg == 0) { E.mid(acc, u2, w2 >> 2, w2 & 3, l2 & 15, l2 >> 4); seg = 1; cA = nA; cB = nB; if constexpr (ALIGN_EPI) { if (wr == 1) PG8_BAR; } continue; }
            seg = 0; E(acc, u2, w2 >> 2, w2 & 3, l2 & 15, l2 >> 4); S.done(cur);
        } else
        if constexpr (!Epi::AFTER_DRAIN) { E(acc, cur, wr, wc, fr, fq); S.done(cur); }
        if (!has_next) break;
#pragma unroll
        for (int a = 0; a < 2; ++a)
#pragma unroll
            for (int b = 0; b < 2; ++b)
#pragma unroll
                for (int m = 0; m < 4; ++m)
#pragma unroll
                    for (int n = 0; n < 2; ++n) acc[a][b][m][n] = (f32x4){0.f, 0.f, 0.f, 0.f};
        cur = nxt; cA = nA; cB = nB; ++ui;
        if constexpr (ALIGN_EPI) { if (wr == 1) PG8_BAR; }
    }
    PG8_WAIT_V(0);
    if constexpr (!ALIGN_EPI) { if (wr == 0) PG8_BAR; }
    PG8_BAR;
    if constexpr (Epi::AFTER_DRAIN) { E.fused(acc, cur, wr, wc, fr, fq, lds, wid, lane); S.done(cur); }
#undef PG8_SA
#undef PG8_SB
#undef PG8_STAGE
#undef PG8_LDA
#undef PG8_LDB
#undef PG8_MMA
#undef PG8_WAIT_V
#undef PG8_WAIT_L
#undef PG8_BAR
#undef PG8_SCHED
}
}
constexpr int NWAVES = 8;
#ifndef MK_ONE_LAUNCH
#define MK_ONE_LAUNCH 1
#endif

#ifndef MK_GLOBAL_GROUPS
#define MK_GLOBAL_GROUPS 30
#endif
#ifndef MK_CHUNKED
#define MK_CHUNKED 1
#endif
#ifndef MK_SP2
#define MK_SP2 true
#endif
#ifndef MK_ALIGN
#define MK_ALIGN true
#endif
#ifndef MK_CONV_IN_G1
#define MK_CONV_IN_G1 0
#endif
#ifndef MK_X2_NT
#define MK_X2_NT 0
#endif
#ifndef MK_STAGGER_G1
#define MK_STAGGER_G1 0
#endif
#ifndef MK_TAIL_IN_SCAN
#define MK_TAIL_IN_SCAN 1
#endif
#ifndef MK_CONV_X2_PCT
#define MK_CONV_X2_PCT 60
#endif
#ifndef MK_FUSE_GAB
#define MK_FUSE_GAB 1
#endif
#ifndef MK_REP
#define MK_REP 0
#endif

constexpr int BATCH = 2, SEQ = 8192, D = 2048, DEPTH = 4, M = BATCH * SEQ;
constexpr int RETW = 1024, RH = 8, RD = 128, RWW = 1024, WH = 16, WD = 64;
constexpr int INW = 11520, DFF = 8192, RWSHIFT = 3328;
constexpr int ZC_Q = 0, ZC_K = 1024, ZC_V = 2048, ZC_GR = 3072, ZC_RW = 4096, ZC_GA = 7424, ZC_GB = 9472;
constexpr int RWC_R = 0, RWC_K = 1024, RWC_V = 2048, RWC_W = 3072, RWC_A = 3136, RWC_G = 3200;
constexpr float NORM_EPS = 1e-6f, RET_GN_EPS = 1e-5f, RWKV_LN_EPS = 64e-5f;

constexpr size_t MiB = 1u << 20;
constexpr size_t WS_CTL = 0, CTL_ZERO_BYTES = 1 * MiB;
constexpr size_t WS_ROPE = 1 * MiB;
constexpr size_t WS_WSET = 16 * MiB, WSET_BYTES = 126 * MiB;
constexpr size_t WO_WIN = 0, WO_WA = 45 * MiB, WO_WB = 49 * MiB, WO_WO = 53 * MiB, WO_WUP = 61 * MiB, WO_WDN = 93 * MiB, WO_LORA = 125 * MiB;
constexpr size_t WS_H = 272 * MiB;
constexpr size_t WS_Z = 336 * MiB;
constexpr size_t WS_UP = WS_Z;
constexpr size_t WS_QR = 696 * MiB, WS_KR = 728 * MiB;
constexpr size_t WS_YRET = 760 * MiB, WS_YRWKV = 792 * MiB;
constexpr size_t WS_MRG = 824 * MiB;
#if MK_CHUNKED
constexpr size_t WS_SR = 888 * MiB, WS_SV = 1208 * MiB;
#else
constexpr size_t WS_SR = 888 * MiB, WS_SW = 952 * MiB, WS_SK = 1016 * MiB, WS_SV = 1080 * MiB, WS_SNKK = 1144 * MiB, WS_SKKA = 1208 * MiB;
#endif
constexpr size_t WS_CU = WS_SR;
constexpr size_t WS_G = 1272 * MiB;
constexpr size_t WS_BONUS = 1336 * MiB;
constexpr size_t WS_SS = 1337 * MiB;
constexpr size_t WS_YRAWW = WS_MRG;
constexpr size_t WS_END = 1341 * MiB;
constexpr int CW_BAR = 4096;

constexpr int PPL = 9;
enum { LP_G1 = 0, LP_PREP, LP_SCAN, LP_POST, LP_GA, LP_GB, LP_GO, LP_GUP, LP_GDN };
constexpr int PH_PRO = 0, PH_L0 = 1, PH_FIN = PH_L0 + DEPTH * PPL, NPH = PH_FIN + 1;

constexpr int RING_OFF = 0, RING_BYTES = 131072;
constexpr int LDSCTL_OFF = RING_BYTES, MISC_OFF = LDSCTL_OFF + 320;
constexpr int LDS_BYTES = 147456;
constexpr int RSTD_OFF = LDSCTL_OFF + 1024, RSTD_ROWS = 2048;
static_assert(MISC_OFF + 128 <= RSTD_OFF && RSTD_OFF + RSTD_ROWS * 4 <= LDS_BYTES, "LDS map");

#define GAS __attribute__((address_space(1)))
#define LAS __attribute__((address_space(3)))
typedef unsigned short bf16;
typedef unsigned v4u __attribute__((ext_vector_type(4)));
typedef unsigned v2u __attribute__((ext_vector_type(2)));
typedef float f32x4 __attribute__((ext_vector_type(4)));
typedef float f32x2 __attribute__((ext_vector_type(2)));
typedef short bf16x8 __attribute__((ext_vector_type(8)));
typedef GAS unsigned gu32;
#define LDS_WAIT() asm volatile("s_waitcnt lgkmcnt(0)" ::: "memory")
#define VM_WAIT() asm volatile("s_waitcnt vmcnt(0)" ::: "memory")
__device__ __forceinline__ unsigned f2bf(float f) { unsigned u = __builtin_bit_cast(unsigned, f); return (u + 0x7fffu + ((u >> 16) & 1u)) >> 16; }
__device__ __forceinline__ unsigned pk2(float lo, float hi) { return f2bf(lo) | (f2bf(hi) << 16); }
__device__ __forceinline__ float bf2f(bf16 v) { return __builtin_bit_cast(float, (unsigned)v << 16); }
__device__ __forceinline__ float rdlane(float v, int l) { return __builtin_bit_cast(float, __builtin_amdgcn_readlane(__builtin_bit_cast(int, v), l)); }
__device__ __forceinline__ float sigm(float x) { return 1.0f / (1.0f + expf(-x)); }

__device__ const double ROPE_REV[64] = {
0.15915494309189535, 0.13782250260398285, 0.11934937021124886, 0.10335229661843406,
0.08949940160889101, 0.07750328875537406, 0.06711508300522726, 0.058119267441876246,
0.050329212104487035, 0.04358330210530733, 0.03774158471741977, 0.032682865872357,
0.0283021958306234, 0.024508691862069852, 0.02122365276477766, 0.018378926105679667,
0.015915494309189534, 0.013782250260398284, 0.011934937021124886, 0.010335229661843406,
0.008949940160889102, 0.0077503288755374055, 0.006711508300522725, 0.005811926744187624,
0.005032921210448704, 0.004358330210530733, 0.003774158471741977, 0.0032682865872356993,
0.00283021958306234, 0.002450869186206985, 0.0021223652764777662, 0.0018378926105679667,
0.0015915494309189536, 0.0013782250260398288, 0.0011934937021124885, 0.0010335229661843405,
0.0008949940160889102, 0.0007750328875537405, 0.0006711508300522726, 0.0005811926744187624,
0.0005032921210448703, 0.0004358330210530733, 0.00037741584717419774, 0.0003268286587235699,
0.00028302195830623395, 0.00024508691862069854, 0.0002122365276477766, 0.00018378926105679666,
0.00015915494309189535, 0.00013782250260398286, 0.00011934937021124886, 0.00010335229661843406,
8.949940160889102e-05, 7.750328875537406e-05, 6.711508300522725e-05, 5.811926744187624e-05,
5.0329212104487035e-05, 4.358330210530732e-05, 3.774158471741978e-05, 3.2682865872357e-05,
2.8302195830623396e-05, 2.4508691862069852e-05, 2.122365276477766e-05, 1.8378926105679668e-05 };

#define XB_TMO      128
#define XB_XCNT(j)  (256  + 64 * (j))
#define XB_XSUB(j)  (1280 + 64 * (j))
#define XB_XGEN(j)  (2304 + 64 * (j))
#define XB_TOP      3328
#define XB_TOPGEN   3392
#define XCD_BAR_WORDS 3456
#define XB_SPIN_CAP (1u << 18)

__device__ __forceinline__ unsigned xb_ld(unsigned* p)              { return __hip_atomic_load(p, __ATOMIC_RELAXED, __HIP_MEMORY_SCOPE_AGENT); }
__device__ __forceinline__ unsigned xb_add(unsigned* p, unsigned v) { return __hip_atomic_fetch_add(p, v, __ATOMIC_RELAXED, __HIP_MEMORY_SCOPE_AGENT); }
__device__ __forceinline__ unsigned xb_xcc_id() { return (unsigned)__builtin_amdgcn_s_getreg((3 << 11) | 20) & 0xFu; }
#define XB_SPIN(cond, bar) do { unsigned _sp = 0; while (cond) { __builtin_amdgcn_s_sleep(1); \
    if ((++_sp & 255u) == 0u) { if (xb_ld(&(bar)[XB_TMO])) break; if (_sp > XB_SPIN_CAP) { atomicAdd(&(bar)[XB_TMO], 1u); break; } } } } while (0)

struct XcdBarrier {
    unsigned* bar; unsigned x;
    volatile LAS unsigned* st;
};

__device__ __forceinline__ XcdBarrier xcd_barrier_post(unsigned* bar, volatile LAS unsigned* st) {
    XcdBarrier b; b.bar = bar; b.x = xb_xcc_id(); b.st = st;
    if (threadIdx.x == 0) (void)xb_add(&bar[XB_XCNT(b.x)], 1u);
    return b;
}
__device__ __forceinline__ void xcd_barrier_complete(unsigned* bar, unsigned x, unsigned& nloc, unsigned& nx) {
    const unsigned G = gridDim.x * gridDim.y * gridDim.z;
    unsigned sum, cnt, mine, sp = 0u;
    for (;;) {
        sum = 0u; cnt = 0u; mine = 0u;
#pragma unroll
        for (unsigned j = 0; j < 16; ++j) { const unsigned c = xb_ld(&bar[XB_XCNT(j)]); sum += c; cnt += (c > 0u) ? 1u : 0u; mine = (j == x) ? c : mine; }
        if (sum == G) break;
        __builtin_amdgcn_s_sleep(1);
        if ((++sp & 255u) == 0u) { if (xb_ld(&bar[XB_TMO])) break; if (sp > XB_SPIN_CAP) { atomicAdd(&bar[XB_TMO], 1u); break; } }
    }
    nloc = mine > 0u ? mine : 1u; nx = cnt > 0u ? cnt : 1u;
}

__device__ __forceinline__ void xcd_barrier(const XcdBarrier& b) {
    asm volatile("s_waitcnt vmcnt(0)" ::: "memory");
    __syncthreads();
    if (threadIdx.x == 0) {
        unsigned* bar = b.bar;
        __builtin_amdgcn_s_waitcnt(0);
        unsigned nloc = b.st[0], nx = b.st[1];
        if (nloc == 0u) { xcd_barrier_complete(bar, b.x, nloc, nx); b.st[0] = nloc; b.st[1] = nx; }
        const unsigned old = xb_add(&bar[XB_XSUB(b.x)], 1u);
        const unsigned gen = old / nloc;
        if (old + 1u == (gen + 1u) * nloc) {
            __builtin_amdgcn_fence(__ATOMIC_RELEASE, "agent");
            asm volatile("s_waitcnt vmcnt(0)" ::: "memory");
            const unsigned og = xb_add(&bar[XB_TOP], 1u);
            const unsigned tg = og / nx;
            if (og + 1u == (tg + 1u) * nx) xb_add(&bar[XB_TOPGEN], 1u);
            else XB_SPIN(xb_ld(&bar[XB_TOPGEN]) == tg, bar);
            __builtin_amdgcn_fence(__ATOMIC_ACQUIRE, "agent");
            xb_add(&bar[XB_XGEN(b.x)], 1u);
            asm volatile("s_waitcnt vmcnt(0)" ::: "memory");
        } else {
            XB_SPIN(xb_ld(&bar[XB_XGEN(b.x)]) == gen, bar);
            __builtin_amdgcn_fence(__ATOMIC_ACQUIRE, "agent");
            asm volatile("s_waitcnt vmcnt(0)" ::: "memory");
        }
    }
    __syncthreads();
}


struct Frame {
    LAS unsigned char* lds;
    volatile LAS unsigned* MISC;
    int tid, lane, wave;
    int vcu, G;
    float* out; unsigned char* ws;
};
struct Args { const float* in[24]; float* out; unsigned char* ws; int ph_lo, ph_hi, li, pad; };
#define WSP(T, off) ((T*)(F.ws + (off)))
#define WSPG(T, off) ((T*)(GAS T*)(unsigned long long)(F.ws + (off)))
#define WSW(l, off) ((bf16*)(F.ws + WS_WSET + (size_t)((l) & 1) * WSET_BYTES + (off)))
#define WSWG(l, off) ((bf16*)(GAS bf16*)(unsigned long long)(F.ws + WS_WSET + (size_t)((l) & 1) * WSET_BYTES + (off)))
#define OUTP ((float*)F.out)
#define OUTPG ((float*)(GAS float*)(unsigned long long)F.out)
#define INP(A, i) ((const float*)((const GAS float*)(A)->in[i]))
#define RETID() do { int t_ = threadIdx.x; asm volatile("" : "+v"(t_)); F.tid = t_; F.lane = t_ & 63; } while (0)
#define CAS __attribute__((address_space(4)))
typedef const CAS Args* ArgP;

__device__ __forceinline__ float fexp(float x) { return __builtin_amdgcn_exp2f(x * 1.4426950408889634f); }
__device__ __forceinline__ float fsig(float x) { return __builtin_amdgcn_rcpf(1.0f + fexp(-x)); }
__device__ __forceinline__ float ftanh(float x) { return 1.0f - 2.0f * __builtin_amdgcn_rcpf(1.0f + fexp(2.0f * x)); }
__device__ __forceinline__ float wave_sum(float v) {
#pragma unroll
    for (int o = 1; o < 64; o <<= 1) v += __shfl_xor(v, o);
    return v;
}
struct TItem { const float* W; bf16* WT; const float* gk; int K, N, item; };
__device__ __forceinline__ void titem_load(const TItem& t, int lane, f32x4 (&v)[8]) {
    const int nblk = t.N / 32, kb = t.item / nblk, nb = t.item % nblk, k0 = 64 * kb, n0 = 32 * nb, nq = lane & 7, kr = lane >> 3;
#pragma unroll
    for (int i = 0; i < 8; ++i) v[i] = __builtin_nontemporal_load((const GAS f32x4*)(t.W + (size_t)(k0 + kr + 8 * i) * t.N + n0 + 4 * nq));
}
__device__ __forceinline__ void titem_finish(const TItem& t, int lane, const f32x4 (&v)[8], LAS float* scr) {
    const int nblk = t.N / 32, kb = t.item / nblk, nb = t.item % nblk, k0 = 64 * kb, n0 = 32 * nb, nq = lane & 7, kr = lane >> 3;
#pragma unroll
    for (int i = 0; i < 8; ++i)
#pragma unroll
        for (int e = 0; e < 4; ++e) scr[(kr + 8 * i) * 33 + 4 * nq + e] = v[i][e];
    const int c = lane & 7;
    f32x4 g0 = (f32x4){1.f, 1.f, 1.f, 1.f}, g1 = g0;
    if (t.gk) { g0 = *(const GAS f32x4*)(t.gk + k0 + 8 * c); g1 = *(const GAS f32x4*)(t.gk + k0 + 8 * c + 4); }
    LDS_WAIT(); asm volatile("" ::: "memory");
#pragma unroll
    for (int j = 0; j < 4; ++j) { const int n = (lane >> 3) + 8 * j; const LAS float* s = scr + (8 * c) * 33 + n;
        v4u o; o.x = pk2(s[0 * 33] * g0.x, s[1 * 33] * g0.y); o.y = pk2(s[2 * 33] * g0.z, s[3 * 33] * g0.w); o.z = pk2(s[4 * 33] * g1.x, s[5 * 33] * g1.y); o.w = pk2(s[6 * 33] * g1.z, s[7 * 33] * g1.w);
        __builtin_nontemporal_store(o, (GAS v4u*)(t.WT + (size_t)(n0 + n) * t.K + k0 + 8 * c)); }
    LDS_WAIT(); asm volatile("" ::: "memory");
}
__device__ __forceinline__ void rms_row_to_bf16(const float* xrow, const float* g, bf16* orow, int lane) {
    const GAS f32x4* xr = (const GAS f32x4*)xrow + lane;
    f32x4 v[8]; float s = 0.f;
#pragma unroll
    for (int j = 0; j < 8; ++j) { v[j] = xr[64 * j]; s += (v[j].x * v[j].x + v[j].y * v[j].y) + (v[j].z * v[j].z + v[j].w * v[j].w); }
    const float rstd = 1.f / sqrtf(wave_sum(s) * (1.f / D) + NORM_EPS);
    const GAS f32x4* gr = (const GAS f32x4*)g + lane;
    GAS v2u* o8 = (GAS v2u*)orow + lane;
#pragma unroll
    for (int j = 0; j < 8; ++j) { const f32x4 gg = gr[64 * j]; v2u o; o.x = pk2(v[j].x * rstd * gg.x, v[j].y * rstd * gg.y); o.y = pk2(v[j].z * rstd * gg.z, v[j].w * rstd * gg.w); o8[64 * j] = o; }
}

template <int NROWS> __device__ __forceinline__ void fill_rstd(Frame& F, int row0) {
    static_assert(NROWS <= RSTD_ROWS && (NROWS % (NWAVES * 64) == 0 || NROWS < NWAVES * 64), "fill_rstd");
    int t_ = threadIdx.x; asm volatile("" : "+v"(t_));
    LAS float* T = (LAS float*)(F.lds + RSTD_OFF);
    constexpr int RPT = NROWS >= NWAVES * 64 ? NROWS / (NWAVES * 64) : 1;
    if (NROWS >= NWAVES * 64 || t_ < NROWS) {
        f32x4 q[RPT][8];
#pragma unroll
        for (int k = 0; k < RPT; ++k) { const GAS f32x4* sp = (const GAS f32x4*)(WSPG(float, WS_SS) + (size_t)(row0 + t_ + k * NWAVES * 64) * 32);
#pragma unroll
            for (int j = 0; j < 8; ++j) q[k][j] = sp[j]; }
#pragma unroll
        for (int k = 0; k < RPT; ++k) { const f32x4 a = ((q[k][0] + q[k][1]) + (q[k][2] + q[k][3])) + ((q[k][4] + q[k][5]) + (q[k][6] + q[k][7]));
            T[t_ + k * NWAVES * 64] = __builtin_amdgcn_rsqf(((a[0] + a[1]) + (a[2] + a[3])) * (1.0f / D) + NORM_EPS); }
    }
    __syncthreads();
}
#if (MK_GLOBAL_GROUPS & 1)
#pragma push_macro("WSP")
#pragma push_macro("WSW")
#pragma push_macro("OUTP")
#undef WSP
#undef WSW
#undef OUTP
#define WSP WSPG
#define WSW WSWG
#define OUTP OUTPG
#endif
__device__ __forceinline__ void ph_prologue(Frame& F, ArgP A) {
    const int* pos = (const int*)INP(A, 1); float2* rope = WSP(float2, WS_ROPE);
    {
        const int gw = F.vcu * NWAVES + F.wave, NGW = F.G * NWAVES, lane = F.lane;
        auto load_row = [&](f32x4 (&v)[8], int m) { if (m >= M) m = M - 1; const GAS f32x4* xr = (const GAS f32x4*)(INP(A, 0) + (size_t)m * D) + lane;
#pragma unroll
            for (int j = 0; j < 8; ++j) v[j] = xr[64 * j]; };
        auto do_row = [&](const f32x4 (&v)[8], int m) {
            GAS v2u* hb = (GAS v2u*)(WSP(bf16, WS_H) + (size_t)m * D) + lane; float s = 0.f;
#pragma unroll
            for (int j = 0; j < 8; ++j) { v2u o; o.x = pk2(v[j].x, v[j].y); o.y = pk2(v[j].z, v[j].w); hb[64 * j] = o; s += (v[j].x * v[j].x + v[j].y * v[j].y) + (v[j].z * v[j].z + v[j].w * v[j].w); }
            s = wave_sum(s);
            if (lane < 32) WSP(float, WS_SS)[(size_t)m * 32 + lane] = lane == 0 ? s : 0.f; };
        f32x4 va[8], vb[8];
        if (gw < M) load_row(va, gw);
        for (int m = gw; m < M; m += 2 * NGW) {
            load_row(vb, m + NGW); do_row(va, m);
            if (m + NGW >= M) break;
            load_row(va, m + 2 * NGW); do_row(vb, m + NGW);
        }
    }
    for (int i = F.vcu * 512 + F.tid; i < M * 64; i += F.G * 512) {
        const int m = i >> 6, j = i & 63;
        const double rev = (double)pos[m] * ROPE_REV[j];
        const float fr = (float)(rev - __builtin_rint(rev));
        rope[i] = make_float2(__builtin_amdgcn_cosf(fr), __builtin_amdgcn_sinf(fr));
    }
}
#if (MK_GLOBAL_GROUPS & 1)
#pragma pop_macro("WSP")
#pragma pop_macro("WSW")
#pragma pop_macro("OUTP")
#endif
#if (MK_GLOBAL_GROUPS & 16)
#pragma push_macro("WSP")
#pragma push_macro("WSW")
#pragma push_macro("OUTP")
#undef WSP
#undef WSW
#undef OUTP
#define WSP WSPG
#define WSW WSWG
#define OUTP OUTPG
#endif
__device__ __forceinline__ TItem conv_item(Frame& F, ArgP A, int l, int it) {
    constexpr int I_IN = (D / 64) * (INW / 32), I_A = (RETW / 64) * (D / 32), I_O = (D / 64) * (D / 32), I_UP = (D / 64) * (DFF / 32), I_DN = (DFF / 64) * (D / 32);
    int r = it; TItem t;
    if (r < I_IN) { t = TItem{INP(A, 3) + (size_t)l * D * INW, WSW(l, WO_WIN), INP(A, 2) + (size_t)l * D, D, INW, r}; return t; } r -= I_IN;
    if (r < I_A) { t = TItem{INP(A, 17) + (size_t)l * RETW * D, WSW(l, WO_WA), nullptr, RETW, D, r}; return t; } r -= I_A;
    if (r < I_A) { t = TItem{INP(A, 18) + (size_t)l * RWW * D, WSW(l, WO_WB), nullptr, RWW, D, r}; return t; } r -= I_A;
    if (r < I_O) { t = TItem{INP(A, 19) + (size_t)l * D * D, WSW(l, WO_WO), nullptr, D, D, r}; return t; } r -= I_O;
    if (r < I_UP) { t = TItem{INP(A, 21) + (size_t)l * D * DFF, WSW(l, WO_WUP), INP(A, 20) + (size_t)l * D, D, DFF, r}; return t; } r -= I_UP;
    if (r < I_DN) { t = TItem{INP(A, 22) + (size_t)l * DFF * D, WSW(l, WO_WDN), nullptr, DFF, D, r}; return t; } r -= I_DN;
    if (r < 32) { t = TItem{INP(A, 8) + (size_t)l * 64 * RWW, WSW(l, WO_LORA), nullptr, 64, RWW, r}; return t; } r -= 32;
    if (r < 32) { t = TItem{INP(A, 10) + (size_t)l * 64 * RWW, WSW(l, WO_LORA) + 1024 * 64, nullptr, 64, RWW, r}; return t; } r -= 32;
    t = TItem{INP(A, 11) + (size_t)l * 128 * RWW, WSW(l, WO_LORA) + 2 * 1024 * 64, nullptr, 128, RWW, r}; return t;
}
constexpr int CONV_NITEMS = (D / 64) * (INW / 32) + 2 * (RETW / 64) * (D / 32) + (D / 64) * (D / 32) + (D / 64) * (DFF / 32) + (DFF / 64) * (D / 32) + 32 + 32 + 64;
constexpr int CONV_SPLIT = (int)((long)CONV_NITEMS * (100 - MK_CONV_X2_PCT) / 100);
__device__ __forceinline__ void ph_convert(Frame& F, ArgP A, int l, int wg, int nwg, int lo = 0, int hi = CONV_NITEMS) {
    LAS float* scr = (LAS float*)(F.lds + RING_OFF + F.wave * 16384);
    const int gw = lo + wg * NWAVES + F.wave, NGW = nwg * NWAVES, lane = F.lane;
    if (gw >= hi) return;
    TItem cur = conv_item(F, A, l, gw); f32x4 va[8], vb[8];
    titem_load(cur, lane, va);
    for (int it = gw; it < hi; it += 2 * NGW) {
        TItem nxt = cur; const bool h1 = it + NGW < hi;
        if (h1) { nxt = conv_item(F, A, l, it + NGW); titem_load(nxt, lane, vb); }
        titem_finish(cur, lane, va, scr);
        if (!h1) break;
        const bool h2 = it + 2 * NGW < hi;
        if (h2) { cur = conv_item(F, A, l, it + 2 * NGW); titem_load(cur, lane, va); }
        titem_finish(nxt, lane, vb, scr);
        if (!h2) break;
    }
}
#if (MK_GLOBAL_GROUPS & 16)
#pragma pop_macro("WSP")
#pragma pop_macro("WSW")
#pragma pop_macro("OUTP")
#endif
#if (MK_GLOBAL_GROUPS & 2)
#pragma push_macro("WSP")
#pragma push_macro("WSW")
#pragma push_macro("OUTP")
#undef WSP
#undef WSW
#undef OUTP
#define WSP WSPG
#define WSW WSWG
#define OUTP OUTPG
#endif
__device__ __forceinline__ f32x4 unpk4(const v2u p) { return (f32x4){pg8::bf_lo(p.x), pg8::bf_hi(p.x), pg8::bf_lo(p.y), pg8::bf_hi(p.y)}; }
__device__ __forceinline__ void unpack8(const v4u a, float (&o)[8]) {
    o[0] = pg8::bf_lo(a.x); o[1] = pg8::bf_hi(a.x); o[2] = pg8::bf_lo(a.y); o[3] = pg8::bf_hi(a.y); o[4] = pg8::bf_lo(a.z); o[5] = pg8::bf_hi(a.z); o[6] = pg8::bf_lo(a.w); o[7] = pg8::bf_hi(a.w);
}
__device__ __forceinline__ void mix8(const GAS bf16* zc, bool has_prev, const GAS float* mu, float (&o)[8]) {
    const v4u a = *(const GAS v4u*)zc; v4u p = (v4u){0u, 0u, 0u, 0u}; if (has_prev) p = *(const GAS v4u*)(zc - INW);
    const f32x4 m0 = *(const GAS f32x4*)mu, m1 = *(const GAS f32x4*)(mu + 4);
    float z[8], q[8]; unpack8(a, z); unpack8(p, q);
#pragma unroll
    for (int j = 0; j < 4; ++j) { o[j] = z[j] + m0[j] * (q[j] - z[j]); o[4 + j] = z[4 + j] + m1[j] * (q[4 + j] - z[4 + j]); }
}
__device__ __forceinline__ f32x4 mix4(const GAS bf16* zc, bool has_prev, const GAS float* mu) {
    const v2u a = *(const GAS v2u*)zc; v2u p = (v2u){0u, 0u}; if (has_prev) p = *(const GAS v2u*)(zc - INW);
    const f32x4 m = *(const GAS f32x4*)mu;
    const f32x4 z = (f32x4){pg8::bf_lo(a.x), pg8::bf_hi(a.x), pg8::bf_lo(a.y), pg8::bf_hi(a.y)}, q = (f32x4){pg8::bf_lo(p.x), pg8::bf_hi(p.x), pg8::bf_lo(p.y), pg8::bf_hi(p.y)};
    return z + m * (q - z);
}
__device__ __forceinline__ bf16x8 pack8(const float (&v)[8]) {
    v4u o; o.x = pg8::cvt_pk_bf16(v[0], v[1]); o.y = pg8::cvt_pk_bf16(v[2], v[3]); o.z = pg8::cvt_pk_bf16(v[4], v[5]); o.w = pg8::cvt_pk_bf16(v[6], v[7]);
    return __builtin_bit_cast(bf16x8, o);
}
constexpr int CU_W = 0, CU_R = 2048, CU_BK = 4096, CU_LRB = 8192, CU_PC = 8704, CU_QB = 8960, CU_QSTR = 1536, CU_BYTES = CU_QB + 4 * CU_QSTR;
constexpr int CK = 16, NCHUNK = SEQ / CK;
constexpr int XL_STR = 144, XL_MAT = 16 * XL_STR;
typedef short s4v __attribute__((ext_vector_type(4)));
__device__ __forceinline__ s4v pk4(const f32x4 v) { v2u o; o.x = pg8::cvt_pk_bf16(v[0], v[1]); o.y = pg8::cvt_pk_bf16(v[2], v[3]); return __builtin_bit_cast(s4v, o); }
__device__ __forceinline__ bf16x8 pk8v(const f32x4 a, const f32x4 b) { v4u o; o.x = pg8::cvt_pk_bf16(a[0], a[1]); o.y = pg8::cvt_pk_bf16(a[2], a[3]); o.z = pg8::cvt_pk_bf16(b[0], b[1]); o.w = pg8::cvt_pk_bf16(b[2], b[3]); return __builtin_bit_cast(bf16x8, o); }
__device__ __forceinline__ f32x4 mma16(const s4v x, const s4v y, const f32x4 c) {
    const bf16x8 x8 = (bf16x8){x.x, x.y, x.z, x.w, 0, 0, 0, 0}, y8 = (bf16x8){y.x, y.y, y.z, y.w, 0, 0, 0, 0};
    return __builtin_amdgcn_mfma_f32_16x16x32_bf16(x8, y8, c, 0, 0, 0); }
__device__ __forceinline__ f32x4 mma32(const bf16x8 x, const bf16x8 y, const f32x4 c) { return __builtin_amdgcn_mfma_f32_16x16x32_bf16(x, y, c, 0, 0, 0); }
template <int N> __device__ __forceinline__ float dpp_shr0(float x) { return __builtin_bit_cast(float, __builtin_amdgcn_update_dpp(0, __builtin_bit_cast(int, x), 0x110 + N, 0xF, 0xF, true)); }
__device__ __forceinline__ float scan16(float x) { x += dpp_shr0<1>(x); x += dpp_shr0<2>(x); x += dpp_shr0<4>(x); x += dpp_shr0<8>(x); return x; }
__device__ __forceinline__ s4v trd(const LAS unsigned char* p) { return __builtin_amdgcn_ds_read_tr16_b64_v4i16((LAS s4v*)p); }
__device__ __forceinline__ void chunk_ops(const f32x4 (&r)[4], const f32x4 (&lw)[4], const f32x4 (&kp)[4], const f32x4 (&v)[4], const f32x4 (&a)[4], const f32x4 (&b)[4],
                                          LAS unsigned char* scr, GAS unsigned char* rec, int lane) {
    const int l15 = lane & 15, g = lane >> 4, tq = l15 >> 2, tp = l15 & 3;
    const f32x4 Z4 = (f32x4){0.f, 0.f, 0.f, 0.f};
    f32x4 Rt[4], pc[4]; bf16x8 Atf[2], Btf[2], Ktf[2], Rtf[2];
    {
        s4v Ah[4], Bq[4], Kq[4], Rq[4];
#pragma unroll
        for (int nt = 0; nt < 4; ++nt) {
            f32x4 cs, tot;
#pragma unroll
            for (int i = 0; i < 4; ++i) { cs[i] = scan16(lw[nt][i]); tot[i] = __shfl(cs[i], lane | 15); }
            f32x4 At, Bt, Kt, Bh, Kh;
#pragma unroll
            for (int i = 0; i < 4; ++i) { const float P = fexp(cs[i]), Pm1 = fexp(cs[i] - lw[nt][i]), iP = fexp(-cs[i]), PCP = fexp(tot[i] - cs[i]);
                pc[nt][i] = fexp(tot[i]); At[i] = a[nt][i] * Pm1; Bt[i] = b[nt][i] * iP; Kt[i] = kp[nt][i] * iP; Rt[nt][i] = r[nt][i] * P; Bh[i] = b[nt][i] * PCP; Kh[i] = kp[nt][i] * PCP; }
            Ah[nt] = pk4(At); Bq[nt] = pk4(Bt); Kq[nt] = pk4(Kt); Rq[nt] = pk4(Rt[nt]);
            LAS unsigned char* w = scr + l15 * XL_STR + (16 * nt + 4 * g) * 2;
            *(LAS s4v*)(w + 0 * XL_MAT) = Ah[nt]; *(LAS s4v*)(w + 1 * XL_MAT) = pk4(v[nt]); *(LAS s4v*)(w + 2 * XL_MAT) = pk4(Bh); *(LAS s4v*)(w + 3 * XL_MAT) = pk4(Kh);
        }
#pragma unroll
        for (int s = 0; s < 2; ++s) {
            Atf[s] = (bf16x8){Ah[2 * s].x, Ah[2 * s].y, Ah[2 * s].z, Ah[2 * s].w, Ah[2 * s + 1].x, Ah[2 * s + 1].y, Ah[2 * s + 1].z, Ah[2 * s + 1].w};
            Btf[s] = (bf16x8){Bq[2 * s].x, Bq[2 * s].y, Bq[2 * s].z, Bq[2 * s].w, Bq[2 * s + 1].x, Bq[2 * s + 1].y, Bq[2 * s + 1].z, Bq[2 * s + 1].w};
            Ktf[s] = (bf16x8){Kq[2 * s].x, Kq[2 * s].y, Kq[2 * s].z, Kq[2 * s].w, Kq[2 * s + 1].x, Kq[2 * s + 1].y, Kq[2 * s + 1].z, Kq[2 * s + 1].w};
            Rtf[s] = (bf16x8){Rq[2 * s].x, Rq[2 * s].y, Rq[2 * s].z, Rq[2 * s].w, Rq[2 * s + 1].x, Rq[2 * s + 1].y, Rq[2 * s + 1].z, Rq[2 * s + 1].w}; }
    }
    f32x4 LabR = Z4, LabT = Z4, LakT = Z4, LrbT = Z4, LrkT = Z4;
#pragma unroll
    for (int s = 0; s < 2; ++s) { LabR = mma32(Atf[s], Btf[s], LabR); LabT = mma32(Btf[s], Atf[s], LabT); LakT = mma32(Ktf[s], Atf[s], LakT); LrbT = mma32(Btf[s], Rtf[s], LrbT); LrkT = mma32(Ktf[s], Rtf[s], LrkT); }
    f32x4 IR;
#pragma unroll
    for (int i = 0; i < 4; ++i) { const int tt = 4 * g + i;
        IR[i] = (tt == l15) ? 1.f : 0.f;
        LabR[i] = (tt > l15) ? LabR[i] : 0.f; LabT[i] = (l15 > tt) ? LabT[i] : 0.f; LakT[i] = (l15 > tt) ? LakT[i] : 0.f;
        LrbT[i] = (l15 >= tt) ? LrbT[i] : 0.f; LrkT[i] = (l15 >= tt) ? LrkT[i] : 0.f; }
    const s4v L1R = pk4(LabR), L1T = pk4(LabT);
    const f32x4 L2R = mma16(L1T, L1R, Z4), L2T = mma16(L1R, L1T, Z4);
    const s4v L2Rp = pk4(L2R), L2Tp = pk4(L2T);
    const f32x4 L4R = mma16(L2Tp, L2Rp, Z4), L4T = mma16(L2Rp, L2Tp, Z4);
    const s4v L4Rp = pk4(L4R), L4Tp = pk4(L4T);
    const f32x4 L8R = mma16(L4Tp, L4Rp, Z4);
    const f32x4 T1T = mma16(pk4(IR + L2R), pk4(IR + LabT), Z4);
    const f32x4 T2T = mma16(pk4(IR + L4R), pk4(T1T), Z4);
    const s4v TmT = pk4(mma16(pk4(IR + L8R), pk4(T2T), Z4));
    const s4v LakTp = pk4(LakT), LrbTp = pk4(LrbT), LrkTp = pk4(LrkT);
    asm volatile("s_waitcnt lgkmcnt(0)" ::: "memory");
    const LAS unsigned char* tb = scr + (4 * g + tq) * XL_STR + (4 * tp) * 2;
    s4v tAt[4], tV[4], tBh[4], tKh[4];
#pragma unroll
    for (int t = 0; t < 4; ++t) { tAt[t] = trd(tb + 0 * XL_MAT + 32 * t); tV[t] = trd(tb + 1 * XL_MAT + 32 * t); tBh[t] = trd(tb + 2 * XL_MAT + 32 * t); tKh[t] = trd(tb + 3 * XL_MAT + 32 * t); }
#pragma unroll
    for (int t = 0; t < 4; ++t) {
        const f32x4 G = mma16(LakTp, tV[t], Z4);
        const f32x4 U0 = mma16(TmT, pk4(G), Z4);
        const f32x4 YV = mma16(LrkTp, tV[t], Z4);
        GAS unsigned char* rq = rec + CU_QB + t * CU_QSTR + lane * 8;
        *(GAS s4v*)(rq) = pk4(U0); *(GAS s4v*)(rq + 512) = tV[t]; *(GAS s4v*)(rq + 1024) = pk4(YV); }
    {
        f32x4 Wn[4];
#pragma unroll
        for (int ct = 0; ct < 4; ++ct) Wn[ct] = mma16(tAt[ct], TmT, Z4);
        *(GAS bf16x8*)(rec + CU_W + 0 * 1024 + lane * 16) = pk8v(Wn[0], Wn[1]); *(GAS bf16x8*)(rec + CU_W + 1 * 1024 + lane * 16) = pk8v(Wn[2], Wn[3]);
        *(GAS bf16x8*)(rec + CU_R + 0 * 1024 + lane * 16) = pk8v(Rt[0], Rt[1]); *(GAS bf16x8*)(rec + CU_R + 1 * 1024 + lane * 16) = pk8v(Rt[2], Rt[3]);
    }
#pragma unroll
    for (int tl = 0; tl < 4; ++tl)
        *(GAS bf16x8*)(rec + CU_BK + tl * 1024 + lane * 16) = (bf16x8){tBh[tl].x, tBh[tl].y, tBh[tl].z, tBh[tl].w, tKh[tl].x, tKh[tl].y, tKh[tl].z, tKh[tl].w};
    *(GAS s4v*)(rec + CU_LRB + lane * 8) = LrbTp;
    if (l15 == 0) {
#pragma unroll
        for (int nt = 0; nt < 4; ++nt) *(GAS f32x4*)(rec + CU_PC + (16 * nt + 4 * g) * 4) = pc[nt]; }
}
__device__ __forceinline__ void ph_prep(Frame& F, ArgP A, int l) {
    const int gw = F.vcu * NWAVES + F.wave, NGW = F.G * NWAVES, lane = F.lane, l15 = lane & 15, g = lane >> 4;
    {
        const int h = lane >> 3, i0 = 8 * (lane & 7);
        int nrr_ = (MK_REP & 1024) ? 2 : 1; asm volatile("" : "+s"(nrr_));
#pragma unroll 1
        for (int rr_ = 0; rr_ < nrr_; ++rr_)
        for (int m0 = gw; m0 < M; m0 += 2 * NGW) {
            const int m1 = m0 + NGW < M ? m0 + NGW : m0;
            v4u zq[2][2], zk[2][2]; f32x4 rp4[2][4];
#pragma unroll
            for (int u = 0; u < 2; ++u) { const int m = u ? m1 : m0;
                const GAS bf16* zrow = (const GAS bf16*)(WSP(bf16, WS_Z) + (size_t)m * INW);
                const GAS f32x4* rp = (const GAS f32x4*)(WSP(float2, WS_ROPE) + (size_t)m * 64 + i0);
                rp4[u][0] = rp[0]; rp4[u][1] = rp[1]; rp4[u][2] = rp[2]; rp4[u][3] = rp[3];
                zq[u][0] = *(const GAS v4u*)(zrow + ZC_Q + h * RD + i0); zq[u][1] = *(const GAS v4u*)(zrow + ZC_Q + h * RD + 64 + i0);
                zk[u][0] = *(const GAS v4u*)(zrow + ZC_K + h * RD + i0); zk[u][1] = *(const GAS v4u*)(zrow + ZC_K + h * RD + 64 + i0); }
#pragma unroll
            for (int u = 0; u < 2; ++u) { const int m = u ? m1 : m0;
                const f32x4 c01 = rp4[u][0], c23 = rp4[u][1], c45 = rp4[u][2], c67 = rp4[u][3];
                const float cs[8] = {c01.x, c01.z, c23.x, c23.z, c45.x, c45.z, c67.x, c67.z}, sn[8] = {c01.y, c01.w, c23.y, c23.w, c45.y, c45.w, c67.y, c67.w};
                float q1[8], q2[8], k1[8], k2[8], o1[8], o2[8];
                unpack8(zq[u][0], q1); unpack8(zq[u][1], q2); unpack8(zk[u][0], k1); unpack8(zk[u][1], k2);
#pragma unroll
                for (int j = 0; j < 8; ++j) { o1[j] = q1[j] * cs[j] - q2[j] * sn[j]; o2[j] = q2[j] * cs[j] + q1[j] * sn[j]; }
                GAS bf16* qo = (GAS bf16*)(WSP(bf16, WS_QR) + (size_t)m * RETW + h * RD + i0);
                *(GAS bf16x8*)qo = pack8(o1); *(GAS bf16x8*)(qo + 64) = pack8(o2);
#pragma unroll
                for (int j = 0; j < 8; ++j) { const float a = k1[j] * 0.08838834764831845f, b = k2[j] * 0.08838834764831845f; o1[j] = a * cs[j] - b * sn[j]; o2[j] = b * cs[j] + a * sn[j]; }
                GAS bf16* ko = (GAS bf16*)(WSP(bf16, WS_KR) + (size_t)m * RETW + h * RD + i0);
                *(GAS bf16x8*)ko = pack8(o1); *(GAS bf16x8*)(ko + 64) = pack8(o2); }
        }
    }
    const GAS float* mu = (const GAS float*)(INP(A, 6) + (size_t)l * RWSHIFT);
    const GAS float* w0 = (const GAS float*)(INP(A, 7) + (size_t)l * RWW); const GAS float* a0 = (const GAS float*)(INP(A, 9) + (size_t)l * RWW);
    const GAS float* kkw = (const GAS float*)(INP(A, 12) + (size_t)l * RWW); const GAS float* kaw = (const GAS float*)(INP(A, 13) + (size_t)l * RWW); const GAS float* rkw = (const GAS float*)(INP(A, 14) + (size_t)l * RWW);
    const GAS bf16* WupT = (const GAS bf16*)WSW(l, WO_LORA); const GAS bf16* AupT = WupT + 1024 * 64; const GAS bf16* GupT = AupT + 1024 * 64;
    constexpr int PP_OFF = 8 * 10240;
    LAS float* PP = (LAS float*)(F.lds + RING_OFF + PP_OFF);
    __syncthreads();
    for (int i = F.tid; i < 2048; i += NWAVES * 64) { const int arr = i >> 8, off = (i & 255) * 4;
        const GAS float* src = arr < 3 ? mu + arr * 1024 : (arr == 3 ? w0 : (arr == 4 ? a0 : (arr == 5 ? kkw : (arr == 6 ? kaw : rkw))));
        *(LAS f32x4*)(PP + arr * 1024 + off) = *(const GAS f32x4*)(src + off); }
    __syncthreads();
    int nrw_ = (MK_REP & 2048) ? 2 : 1; asm volatile("" : "+s"(nrw_));
#pragma unroll 1
    for (int rw_ = 0; rw_ < nrw_; ++rw_)
    for (int task = gw; task < M / 8; task += NGW) {
        const int wgv = task >> 3, tile = (wgv >> 1) * 8 + (task & 7), half = wgv & 1;
        const int m = tile * 16 + l15, hh0 = half * (WH / 2);
        const bool has_prev = (m % SEQ) != 0;
        const GAS bf16* zr = (const GAS bf16*)(WSP(bf16, WS_Z) + (size_t)m * INW + ZC_RW);
        bf16x8 fw[2], fa[2], fg[4];
#pragma unroll
        for (int ks = 0; ks < 2; ++ks) { float t[8];
            mix8(zr + RWC_W + 32 * ks + 8 * g, has_prev, mu + RWC_W + 32 * ks + 8 * g, t);
#pragma unroll
            for (int j = 0; j < 8; ++j) t[j] = ftanh(t[j]);
            fw[ks] = pack8(t);
            mix8(zr + RWC_A + 32 * ks + 8 * g, has_prev, mu + RWC_A + 32 * ks + 8 * g, t); fa[ks] = pack8(t); }
#pragma unroll
        for (int ks = 0; ks < 4; ++ks) { float t[8];
            mix8(zr + RWC_G + 32 * ks + 8 * g, has_prev, mu + RWC_G + 32 * ks + 8 * g, t);
#pragma unroll
            for (int j = 0; j < 8; ++j) t[j] = fsig(t[j]);
            fg[ks] = pack8(t); }
        const GAS bf16* zq = has_prev ? zr - INW : zr;
        for (int hh = hh0; hh < hh0 + WH / 2; ++hh) {
            f32x4 kkr[4], av[4], rr[4], lwv[4], kpv[4], vv[4]; float ss = 0.f, bonus = 0.f;
            const int cb = hh * WD + 4 * g;
            {
                v2u zc[3][4], zp[3][4];
#pragma unroll
                for (int a3 = 0; a3 < 3; ++a3)
#pragma unroll
                    for (int nt = 0; nt < 4; ++nt) { zc[a3][nt] = *(const GAS v2u*)(zr + a3 * 1024 + cb + 16 * nt); zp[a3][nt] = *(const GAS v2u*)(zq + a3 * 1024 + cb + 16 * nt); }
#pragma unroll
                for (int nt = 0; nt < 4; ++nt) {
#pragma unroll
                    for (int a3 = 0; a3 < 3; ++a3) { const f32x4 z = unpk4(zc[a3][nt]); f32x4 p = unpk4(zp[a3][nt]); if (!has_prev) p = (f32x4){0.f, 0.f, 0.f, 0.f};
                        const f32x4 mx = z + *(const LAS f32x4*)(PP + a3 * 1024 + cb + 16 * nt) * (p - z);
                        if (a3 == 0) rr[nt] = mx; else if (a3 == 1) kpv[nt] = mx; else vv[nt] = mx; }
                }
            }
            bf16x8 wf[2][2], af[2][2], gf[2][4];
#define PREP_WFRAGS(nt_, k_) do { const int cf_ = hh * WD + (nt_) * 16 + l15; \
            _Pragma("unroll") for (int ks = 0; ks < 2; ++ks) { wf[k_][ks] = *(const GAS bf16x8*)(WupT + (size_t)cf_ * 64 + 32 * ks + 8 * g); af[k_][ks] = *(const GAS bf16x8*)(AupT + (size_t)cf_ * 64 + 32 * ks + 8 * g); } \
            _Pragma("unroll") for (int ks = 0; ks < 4; ++ks) gf[k_][ks] = *(const GAS bf16x8*)(GupT + (size_t)cf_ * 128 + 32 * ks + 8 * g); } while (0)
            PREP_WFRAGS(0, 0);
#pragma unroll
            for (int nt = 0; nt < 4; ++nt) {
                const int c0 = cb + 16 * nt, cs_ = nt & 1;
                if (nt + 1 < 4) PREP_WFRAGS(nt + 1, (cs_ ^ 1));
                f32x4 wl = *(const LAS f32x4*)(PP + 3 * 1024 + c0), al = *(const LAS f32x4*)(PP + 4 * 1024 + c0), gl = (f32x4){0.f, 0.f, 0.f, 0.f};
#pragma unroll
                for (int ks = 0; ks < 2; ++ks) { wl = __builtin_amdgcn_mfma_f32_16x16x32_bf16(wf[cs_][ks], fw[ks], wl, 0, 0, 0); al = __builtin_amdgcn_mfma_f32_16x16x32_bf16(af[cs_][ks], fa[ks], al, 0, 0, 0); }
#pragma unroll
                for (int ks = 0; ks < 4; ++ks) gl = __builtin_amdgcn_mfma_f32_16x16x32_bf16(gf[cs_][ks], fg[ks], gl, 0, 0, 0);
                const f32x4 r = rr[nt], k = kpv[nt], v = vv[nt];
                const f32x4 kk4 = *(const LAS f32x4*)(PP + 5 * 1024 + c0), ka4 = *(const LAS f32x4*)(PP + 6 * 1024 + c0), rk4 = *(const LAS f32x4*)(PP + 7 * 1024 + c0);
                f32x4 lwd, a, kp;
#pragma unroll
                for (int i = 0; i < 4; ++i) {
                    lwd[i] = -0.6065306597126334f * fsig(wl[i]);
                    a[i] = fsig(al[i]);
                    kp[i] = k[i] * (1.0f + (a[i] - 1.0f) * ka4[i]);
                }
                kkr[nt] = k * kk4; av[nt] = a; lwv[nt] = lwd; kpv[nt] = kp;
                ss += (kkr[nt].x * kkr[nt].x + kkr[nt].y * kkr[nt].y) + (kkr[nt].z * kkr[nt].z + kkr[nt].w * kkr[nt].w);
                const f32x4 rb = r * kp * rk4; bonus += (rb.x + rb.y) + (rb.z + rb.w);
                const size_t o = (size_t)m * RWW + c0;
#if MK_CHUNKED
                *(GAS s4v*)(WSP(bf16, WS_SV) + o) = pk4(v); *(GAS s4v*)(WSP(bf16, WS_G) + o) = pk4(gl);
#else
                f32x4 decay;
#pragma unroll
                for (int i = 0; i < 4; ++i) decay[i] = fexp(lwd[i]);
                *(GAS f32x4*)(WSP(float, WS_SR) + o) = r; *(GAS f32x4*)(WSP(float, WS_SW) + o) = decay; *(GAS f32x4*)(WSP(float, WS_SK) + o) = kp;
                *(GAS f32x4*)(WSP(float, WS_SV) + o) = v; *(GAS f32x4*)(WSP(float, WS_G) + o) = gl;
#endif
            }
#undef PREP_WFRAGS
            ss += __shfl_xor(ss, 16); ss += __shfl_xor(ss, 32); bonus += __shfl_xor(bonus, 16); bonus += __shfl_xor(bonus, 32);
            const float inv = 1.0f / fmaxf(sqrtf(ss), 1e-12f);
            if (g == 0) WSP(float, WS_BONUS)[(size_t)m * WH + hh] = bonus;
#if MK_CHUNKED
            f32x4 aa[4], bb[4];
#pragma unroll
            for (int nt = 0; nt < 4; ++nt) { const f32x4 kk = kkr[nt] * inv; aa[nt] = -kk; bb[nt] = kk * av[nt]; }
            GAS unsigned char* rec = (GAS unsigned char*)WSP(unsigned char, WS_CU) + ((size_t)((tile / NCHUNK) * WH + hh) * NCHUNK + (tile % NCHUNK)) * CU_BYTES;
            chunk_ops(rr, lwv, kpv, vv, aa, bb, F.lds + RING_OFF + F.wave * 10240, rec, lane);
#else
#pragma unroll
            for (int nt = 0; nt < 4; ++nt) { const size_t o = (size_t)m * RWW + hh * WD + nt * 16 + 4 * g; const f32x4 kk = kkr[nt] * inv;
                *(GAS f32x4*)(WSP(float, WS_SNKK) + o) = -kk; *(GAS f32x4*)(WSP(float, WS_SKKA) + o) = kk * av[nt]; }
#endif
        }
    }
}
#if (MK_GLOBAL_GROUPS & 2)
#pragma pop_macro("WSP")
#pragma pop_macro("WSW")
#pragma pop_macro("OUTP")
#endif
#if (MK_GLOBAL_GROUPS & 4)
#pragma push_macro("WSP")
#pragma push_macro("WSW")
#pragma push_macro("OUTP")
#undef WSP
#undef WSW
#undef OUTP
#define WSP WSPG
#define WSW WSWG
#define OUTP OUTPG
#endif
#if !MK_CHUNKED
__device__ __forceinline__ void scan_rwkv_naive(Frame& F, int item) {
    const int lane = F.lane;
    float st[64];
#pragma unroll
    for (int j = 0; j < 64; ++j) st[j] = 0.f;
    const size_t base0 = (size_t)(item >> 4) * SEQ * RWW + (size_t)(item & 15) * WD + lane;
    for (int t = 0; t < SEQ; ++t) {
        const size_t o = base0 + (size_t)t * RWW;
        const float r = WSP(float, WS_SR)[o], w = WSP(float, WS_SW)[o], k = WSP(float, WS_SK)[o], v = WSP(float, WS_SV)[o], nk = WSP(float, WS_SNKK)[o], ka = WSP(float, WS_SKKA)[o];
        float sa = 0.f;
#pragma unroll
        for (int j = 0; j < 64; ++j) sa += st[j] * rdlane(nk, j);
        float y = 0.f;
#pragma unroll
        for (int j = 0; j < 64; ++j) { st[j] = st[j] * rdlane(w, j) + sa * rdlane(ka, j) + v * rdlane(k, j); y += st[j] * rdlane(r, j); }
        WSP(float, WS_YRAWW)[o] = y;
    }
}
#endif
__device__ __forceinline__ void scan_ret_naive(Frame& F, int item) {
    const int lane = F.lane, b = item >> 4, h = (item >> 1) & 7, half = item & 1;
    const float gam = 1.0f - exp2f((float)(-5 - h));
    float R[128];
#pragma unroll
    for (int j = 0; j < 128; ++j) R[j] = 0.f;
    for (int t = 0; t < SEQ; ++t) {
        const size_t m = (size_t)b * SEQ + t;
        const float q1 = bf2f(WSP(bf16, WS_QR)[m * RETW + h * RD + lane]), q2 = bf2f(WSP(bf16, WS_QR)[m * RETW + h * RD + 64 + lane]);
        const float k1 = bf2f(WSP(bf16, WS_KR)[m * RETW + h * RD + lane]), k2 = bf2f(WSP(bf16, WS_KR)[m * RETW + h * RD + 64 + lane]);
        const float v = bf2f(WSP(bf16, WS_Z)[m * INW + ZC_V + h * RD + half * 64 + lane]);
        float y = 0.f;
#pragma unroll
        for (int d = 0; d < 64; ++d) { R[d] = gam * R[d] + rdlane(k1, d) * v; y += rdlane(q1, d) * R[d]; }
#pragma unroll
        for (int d = 0; d < 64; ++d) { R[64 + d] = gam * R[64 + d] + rdlane(k2, d) * v; y += rdlane(q2, d) * R[64 + d]; }
        OUTP[m * RETW + h * RD + half * 64 + lane] = y;
    }
}
#if !MK_CHUNKED
constexpr int SCT = 32;
constexpr int SC_ARR = SCT * 64 * 4;
constexpr int SC_BUF = 5 * SC_ARR + SCT * 16 * 4;
static_assert(2 * SC_BUF <= RING_BYTES, "scan LDS");
template <int CTRL> __device__ __forceinline__ float dppf(float x) { return __builtin_bit_cast(float, __builtin_amdgcn_update_dpp(0, __builtin_bit_cast(int, x), CTRL, 0xF, 0xF, true)); }
__device__ __forceinline__ float sum16(float x) {
    x += dppf<0xB1>(x); x += dppf<0x4E>(x); x += dppf<0x141>(x); x += dppf<0x140>(x); return x;
}
__device__ __forceinline__ void scan_rwkv_fast(Frame& F, int w) {
    const int b = w >> 6, hh = (w >> 2) & 15, q = w & 3;
    const int lane = F.lane, wave = F.wave;
    LAS unsigned char* base = F.lds + RING_OFF;
    const size_t g0 = (size_t)b * SEQ * RWW + (size_t)hh * WD;
    constexpr int NBLK = SEQ / SCT;
#define SC_BAR() do { asm volatile("s_waitcnt lgkmcnt(0)" ::: "memory"); __builtin_amdgcn_s_barrier(); asm volatile("" ::: "memory"); } while (0)
    if (wave >= 4) {
        const int lt = F.tid - 256;
        const float* a0 = WSP(float, WS_SR) + g0; const float* a1 = WSP(float, WS_SW) + g0; const float* a2 = WSP(float, WS_SK) + g0;
        const float* a3 = WSP(float, WS_SNKK) + g0; const float* a4 = WSP(float, WS_SKKA) + g0; const float* av = WSP(float, WS_SV) + g0 + 16 * q;
        const int f0 = lt, f1 = lt + 256;
        const size_t o0 = (size_t)(f0 >> 4) * RWW + 4 * (f0 & 15), o1 = (size_t)(f1 >> 4) * RWW + 4 * (f1 & 15), ov = (size_t)(lt >> 2) * RWW + 4 * (lt & 3);
        f32x4 r0[5], r1[5], rv;
#define SC_LOAD(blk) do { const size_t tb = (size_t)(blk) * SCT * RWW; \
        r0[0] = *(const GAS f32x4*)(a0 + tb + o0); r1[0] = *(const GAS f32x4*)(a0 + tb + o1); r0[1] = *(const GAS f32x4*)(a1 + tb + o0); r1[1] = *(const GAS f32x4*)(a1 + tb + o1); \
        r0[2] = *(const GAS f32x4*)(a2 + tb + o0); r1[2] = *(const GAS f32x4*)(a2 + tb + o1); r0[3] = *(const GAS f32x4*)(a3 + tb + o0); r1[3] = *(const GAS f32x4*)(a3 + tb + o1); \
        r0[4] = *(const GAS f32x4*)(a4 + tb + o0); r1[4] = *(const GAS f32x4*)(a4 + tb + o1); if (lt < 128) rv = *(const GAS f32x4*)(av + tb + ov); } while (0)
#define SC_STORE(bi) do { LAS unsigned char* bb = base + (bi) * SC_BUF; \
        _Pragma("unroll") for (int a = 0; a < 5; ++a) { *(LAS f32x4*)(bb + a * SC_ARR + f0 * 16) = r0[a]; *(LAS f32x4*)(bb + a * SC_ARR + f1 * 16) = r1[a]; } \
        if (lt < 128) *(LAS f32x4*)(bb + 5 * SC_ARR + lt * 16) = rv; } while (0)
        SC_LOAD(0); SC_STORE(0);
        if (1 < NBLK) SC_LOAD(1);
        SC_BAR();
        for (int blk = 0; blk < NBLK; ++blk) {
            if (blk + 1 < NBLK) { SC_STORE((blk + 1) & 1); if (blk + 2 < NBLK) SC_LOAD(blk + 2); }
            SC_BAR();
        }
#undef SC_LOAD
#undef SC_STORE
    } else {
        const int l16 = lane & 15, rowl = 4 * wave + (lane >> 4);
        GAS float* Y = (GAS float*)(WSP(float, WS_YRAWW) + g0 + 16 * q + rowl);
        f32x4 st = (f32x4){0.f, 0.f, 0.f, 0.f};
        const int lo = l16 * 16, vo = 5 * SC_ARR + rowl * 4;
#define SC_LD(tt_, R4, W4, K4, N4, A4, V) do { R4 = *(const LAS f32x4*)(bb + 0 * SC_ARR + (tt_) * 256 + lo); W4 = *(const LAS f32x4*)(bb + 1 * SC_ARR + (tt_) * 256 + lo); \
        K4 = *(const LAS f32x4*)(bb + 2 * SC_ARR + (tt_) * 256 + lo); N4 = *(const LAS f32x4*)(bb + 3 * SC_ARR + (tt_) * 256 + lo); A4 = *(const LAS f32x4*)(bb + 4 * SC_ARR + (tt_) * 256 + lo); \
        V = *(const LAS float*)(bb + vo + (tt_) * 64); } while (0)
        SC_BAR();
        for (int blk = 0; blk < NBLK; ++blk) {
            const LAS unsigned char* bb = base + (blk & 1) * SC_BUF;
            GAS float* yb = Y + (size_t)blk * SCT * RWW;
            f32x4 r4[3], w4[3], k4[3], n4[3], a4[3]; float v[3];
            SC_LD(0, r4[0], w4[0], k4[0], n4[0], a4[0], v[0]);
            SC_LD(1, r4[1], w4[1], k4[1], n4[1], a4[1], v[1]);
#pragma unroll
            for (int tt = 0; tt < SCT; ++tt) {
                const int c = tt % 3, p = (tt + 2) % 3;
                if (tt + 2 < SCT) SC_LD(tt + 2, r4[p], w4[p], k4[p], n4[p], a4[p], v[p]);
                f32x2 sp2 = (f32x2){st.x, st.y} * (f32x2){n4[c].x, n4[c].y}; sp2 = (f32x2){st.z, st.w} * (f32x2){n4[c].z, n4[c].w} + sp2;
                const f32x4 t0 = st * w4[c] + k4[c] * v[c];
                const float sa = sum16(sp2.x + sp2.y);
                st = a4[c] * sa + t0;
                f32x2 yp2 = (f32x2){st.x, st.y} * (f32x2){r4[c].x, r4[c].y}; yp2 = (f32x2){st.z, st.w} * (f32x2){r4[c].z, r4[c].w} + yp2;
                const float y = sum16(yp2.x + yp2.y);
                yb[(size_t)tt * RWW] = y;
            }
            SC_BAR();
        }
#undef SC_LD
#undef SC_BAR
    }
}
#endif
__device__ __forceinline__ float dpp_x1(float x) { return __builtin_bit_cast(float, __builtin_amdgcn_update_dpp(0, __builtin_bit_cast(int, x), 0xB1, 0xF, 0xF, true)); }
__device__ __forceinline__ void store_y_bf16(GAS bf16* p, size_t ld, const f32x4 ya, int l15) {
    const bool odd = l15 & 1;
    const float s0 = dpp_x1(odd ? ya[0] : ya[2]), s1 = dpp_x1(odd ? ya[1] : ya[3]);
    const unsigned w0 = odd ? pg8::cvt_pk_bf16(s0, ya[2]) : pg8::cvt_pk_bf16(ya[0], s0), w1 = odd ? pg8::cvt_pk_bf16(s1, ya[3]) : pg8::cvt_pk_bf16(ya[1], s1);
    GAS bf16* r = p + (odd ? 2 * ld : 0);
    *(GAS unsigned*)r = w0; *(GAS unsigned*)(r + ld) = w1;
}
constexpr int CB_STEPS = 4, CB_STEP_BYTES = CU_QB + CU_QSTR, CB_SP = CB_STEP_BYTES / 16  , CB_BUF = CB_STEPS * CB_STEP_BYTES, CB_PIECES = CB_BUF / 16, CB_NLD = CB_PIECES / 8  , CB_NBLK = NCHUNK / CB_STEPS;
static_assert(CB_NLD * 8 == CB_PIECES && CB_NLD <= 448, "loader split");
static_assert(2 * CB_BUF <= RING_BYTES, "chunk scan LDS");
#ifndef MK_X2_DIRECT
#define MK_X2_DIRECT 0
#endif
__device__ __forceinline__ void scan_rwkv_chunk(Frame& F, int w) {
    const int bh = w >> 2, q = w & 3, lane = F.lane, wave = F.wave;
    LAS unsigned char* base = F.lds + RING_OFF;
    const GAS unsigned char* rec0 = (const GAS unsigned char*)WSP(unsigned char, WS_CU) + (size_t)bh * NCHUNK * CU_BYTES;
#define CB_BAR() do { asm volatile("s_waitcnt lgkmcnt(0)" ::: "memory"); __builtin_amdgcn_s_barrier(); asm volatile("" ::: "memory"); } while (0)
    if (wave >= 1) {
        const int lt = F.tid - 64;
#if MK_X2_NT
#define CB_LD(p_) __builtin_nontemporal_load((const GAS v4u*)(p_))
#else
#define CB_LD(p_) (*(const GAS v4u*)(p_))
#endif
        v4u ra[8], rb[8], rc[8], rd[8];
        const int ltc = lt < CB_NLD ? lt : CB_NLD - 1;
        int so[8];
#pragma unroll
        for (int j = 0; j < 8; ++j) { const int p = ltc + CB_NLD * j, st = p / CB_SP, off = p % CB_SP; so[j] = st * CU_BYTES + off * 16 + (off >= CU_QB / 16 ? q * CU_QSTR : 0); }
#define CB_LOAD(rg, blk) do { const int bc_ = (blk) < CB_NBLK ? (blk) : CB_NBLK - 1; const GAS unsigned char* bp = rec0 + (size_t)bc_ * CB_STEPS * CU_BYTES; \
            _Pragma("unroll") for (int j = 0; j < 8; ++j) rg[j] = CB_LD(bp + so[j]); } while (0)
#define CB_STORE(rg, bi) do { LAS unsigned char* dp = base + (bi) * CB_BUF + ltc * 16; \
            _Pragma("unroll") for (int j = 0; j < 8; ++j) *(LAS v4u*)(dp + j * CB_NLD * 16) = rg[j]; } while (0)
        static_assert(CB_NBLK % 4 == 0 && CB_NBLK >= 8, "block quads");
        CB_LOAD(ra, 0); CB_STORE(ra, 0); CB_LOAD(rb, 1); CB_LOAD(rc, 2); CB_LOAD(rd, 3);
        CB_BAR();
        for (int blk = 0; blk < CB_NBLK; blk += 4) {
            CB_STORE(rb, 1); CB_LOAD(ra, blk + 4); CB_BAR();
            CB_STORE(rc, 0); CB_LOAD(rb, blk + 5); CB_BAR();
            CB_STORE(rd, 1); CB_LOAD(rc, blk + 6); CB_BAR();
            CB_STORE(ra, 0); CB_LOAD(rd, blk + 7); CB_BAR();
        }
#undef CB_LOAD
#undef CB_STORE
    } else {
        const int l15 = lane & 15, g = lane >> 4;
        const f32x4 Z4 = (f32x4){0.f, 0.f, 0.f, 0.f};
        f32x4 acc[4] = {Z4, Z4, Z4, Z4};
        GAS bf16* Y = (GAS bf16*)(WSP(bf16, WS_YRAWW) + (size_t)(bh >> 4) * SEQ * RWW + (size_t)(bh & 15) * WD + 16 * q + (l15 & ~1) + (size_t)(4 * g) * RWW);
        CB_BAR();
        bf16x8 Wf[2][2], Rf[2][2], BKf[2][4]; f32x4 pcv[2][4]; v2u Lrbf[2], U0t[2], Vt[2], YVt[2];
#define CB_FRAGS(sb_, k_) do { _Pragma("unroll") for (int j = 0; j < 2; ++j) { Wf[k_][j] = *(const LAS bf16x8*)((sb_) + CU_W + j * 1024 + lane * 16); Rf[k_][j] = *(const LAS bf16x8*)((sb_) + CU_R + j * 1024 + lane * 16); } \
        _Pragma("unroll") for (int j = 0; j < 4; ++j) { BKf[k_][j] = *(const LAS bf16x8*)((sb_) + CU_BK + j * 1024 + lane * 16); pcv[k_][j] = *(const LAS f32x4*)((sb_) + CU_PC + (16 * j + 4 * g) * 4); } \
        Lrbf[k_] = *(const LAS v2u*)((sb_) + CU_LRB + lane * 8); U0t[k_] = *(const LAS v2u*)((sb_) + CU_QB + lane * 8); Vt[k_] = *(const LAS v2u*)((sb_) + CU_QB + 512 + lane * 8); YVt[k_] = *(const LAS v2u*)((sb_) + CU_QB + 1024 + lane * 8); } while (0)
        for (int blk = 0; blk < CB_NBLK; ++blk) {
            const LAS unsigned char* bb = base + (blk & 1) * CB_BUF;
            CB_FRAGS(bb, 0);
#pragma unroll
            for (int st = 0; st < CB_STEPS; ++st) {
                const int c = st & 1;
                if (st + 1 < CB_STEPS) CB_FRAGS(bb + (st + 1) * CB_STEP_BYTES, (c ^ 1));
                const bf16x8 sf0 = pk8v(acc[0], acc[1]), sf1 = pk8v(acc[2], acc[3]);
                f32x4 pA = unpk4(U0t[c]);
                pA = mma32(Wf[c][0], sf0, pA); pA = mma32(Wf[c][1], sf1, pA);
                f32x4 ya = unpk4(YVt[c]);
                ya = mma32(Rf[c][0], sf0, ya); ya = mma32(Rf[c][1], sf1, ya);
                const s4v pAp = pk4(pA), vq = __builtin_bit_cast(s4v, Vt[c]);
                ya = mma16(__builtin_bit_cast(s4v, Lrbf[c]), pAp, ya);
                store_y_bf16(Y + (size_t)((blk * CB_STEPS + st) * CK) * RWW, RWW, ya, l15);
                const bf16x8 yB = (bf16x8){pAp.x, pAp.y, pAp.z, pAp.w, vq.x, vq.y, vq.z, vq.w};
#pragma unroll
                for (int tl = 0; tl < 4; ++tl) acc[tl] = mma32(BKf[c][tl], yB, acc[tl] * pcv[c][tl]);
            }
            CB_BAR();
        }
#undef CB_FRAGS
    }
#undef CB_BAR
}
__device__ const float RET_LG2[8] = { -4.580368847e-02f, -2.272007614e-02f, -1.131531317e-02f, -5.646563135e-03f, -2.820519032e-03f, -1.409570221e-03f, -7.046129904e-04f, -3.522634797e-04f };
constexpr int RT_STR = 288, RT_QS = 0, RT_KS = 128 * RT_STR, RT_VSTR = 80, RT_VS = 2 * 128 * RT_STR, RT_VPS = RT_VS + 128 * RT_VSTR, RT_RT = RT_VPS + 128 * RT_VSTR, RT_RTSZ = 32 * RT_STR;
static_assert(RT_RT + 2 * RT_RTSZ <= RING_BYTES, "retention LDS");
__device__ __forceinline__ bf16x8 tr8(const LAS unsigned char* p0, const LAS unsigned char* p1) {
    const s4v a = __builtin_amdgcn_ds_read_tr16_b64_v4i16((LAS s4v*)p0), b = __builtin_amdgcn_ds_read_tr16_b64_v4i16((LAS s4v*)p1);
    return (bf16x8){a.x, a.y, a.z, a.w, b.x, b.y, b.z, b.w};
}
__device__ __forceinline__ void scan_ret_mfma(Frame& F, int w_) {
    const int b = w_ >> 5, h = (w_ >> 2) & 7, eq = w_ & 3;
    const int tid = F.tid, lane = F.lane, w = F.wave < 4 ? F.wave : 11 - F.wave, l15 = lane & 15, g = lane >> 4, tq = l15 >> 2, tp = l15 & 3;
    LAS unsigned char* L = F.lds + RING_OFF;
    const float lg2 = RET_LG2[h];
    const float gC = __builtin_amdgcn_exp2f(lg2 * 128.f);
    for (int i = tid; i < RT_RTSZ / 4; i += NWAVES * 64) ((LAS unsigned*)(L + RT_RT))[i] = 0u;
    const GAS bf16* Qg = (const GAS bf16*)(WSP(bf16, WS_QR) + (size_t)b * SEQ * RETW + h * RD);
    const GAS bf16* Kg = (const GAS bf16*)(WSP(bf16, WS_KR) + (size_t)b * SEQ * RETW + h * RD);
    const GAS bf16* Vg = (const GAS bf16*)(WSP(bf16, WS_Z) + (size_t)b * SEQ * INW + ZC_V + h * RD + 32 * eq);
    GAS bf16* Yg = (GAS bf16*)OUTP + (size_t)b * SEQ * RETW + h * RD + 32 * eq;
    v4u rq[4], rk[4], rv;
#define RT_BAR() do { asm volatile("s_waitcnt lgkmcnt(0)" ::: "memory"); __builtin_amdgcn_s_barrier(); asm volatile("" ::: "memory"); } while (0)
#define RT_LOAD(n_) do { _Pragma("unroll") for (int i = 0; i < 4; ++i) { const int f = tid + 512 * i, c = f >> 4, pc = f & 15; \
        rq[i] = *(const GAS v4u*)(Qg + (size_t)((n_) * 128 + c) * RETW + 8 * pc); rk[i] = *(const GAS v4u*)(Kg + (size_t)((n_) * 128 + c) * RETW + 8 * pc); } \
        rv = *(const GAS v4u*)(Vg + (size_t)((n_) * 128 + (tid >> 2)) * INW + 8 * (tid & 3)); } while (0)
    f32x4 accR[2] = {(f32x4){0.f, 0.f, 0.f, 0.f}, (f32x4){0.f, 0.f, 0.f, 0.f}};
    RT_LOAD(0);
    for (int n = 0; n < SEQ / 128; ++n) {
#pragma unroll
        for (int i = 0; i < 4; ++i) { const int f = tid + 512 * i, c = f >> 4, pc = f & 15;
            *(LAS v4u*)(L + RT_QS + c * RT_STR + pc * 16) = rq[i]; *(LAS v4u*)(L + RT_KS + c * RT_STR + pc * 16) = rk[i]; }
        { const int c = tid >> 2, pc = tid & 3; *(LAS v4u*)(L + RT_VS + c * RT_VSTR + pc * 16) = rv;
          const float sc = __builtin_amdgcn_exp2f(lg2 * (float)(127 - c)); v4u o;
          o.x = pg8::cvt_pk_bf16(pg8::bf_lo(rv.x) * sc, pg8::bf_hi(rv.x) * sc); o.y = pg8::cvt_pk_bf16(pg8::bf_lo(rv.y) * sc, pg8::bf_hi(rv.y) * sc);
          o.z = pg8::cvt_pk_bf16(pg8::bf_lo(rv.z) * sc, pg8::bf_hi(rv.z) * sc); o.w = pg8::cvt_pk_bf16(pg8::bf_lo(rv.w) * sc, pg8::bf_hi(rv.w) * sc);
          *(LAS v4u*)(L + RT_VPS + c * RT_VSTR + pc * 16) = o; }
        RT_BAR();
        if (n + 1 < SEQ / 128) RT_LOAD(n + 1);
        bf16x8 qf[4];
#pragma unroll
        for (int ks = 0; ks < 4; ++ks) qf[ks] = *(const LAS bf16x8*)(L + RT_QS + (16 * w + l15) * RT_STR + (32 * ks + 8 * g) * 2);
        bf16x8 pf[4];
        const int cq = 16 * w + l15;
#pragma unroll
        for (int p = 0; p < 4; ++p) {
            bf16x8 kf[8];
#pragma unroll
            for (int ks = 0; ks < 4; ++ks) { kf[ks] = *(const LAS bf16x8*)(L + RT_KS + (32 * p + l15) * RT_STR + (32 * ks + 8 * g) * 2);
                kf[4 + ks] = *(const LAS bf16x8*)(L + RT_KS + (32 * p + 16 + l15) * RT_STR + (32 * ks + 8 * g) * 2); }
            __builtin_amdgcn_sched_barrier(0);
            f32x4 s0 = (f32x4){0.f, 0.f, 0.f, 0.f}, s1 = (f32x4){0.f, 0.f, 0.f, 0.f};
            if (2 * p <= w) {
#pragma unroll
                for (int ks = 0; ks < 4; ++ks) s0 = __builtin_amdgcn_mfma_f32_16x16x32_bf16(kf[ks], qf[ks], s0, 0, 0, 0);
            }
            if (2 * p + 1 <= w) {
#pragma unroll
                for (int ks = 0; ks < 4; ++ks) s1 = __builtin_amdgcn_mfma_f32_16x16x32_bf16(kf[4 + ks], qf[ks], s1, 0, 0, 0);
            }
            float p0[4], p1[4];
#pragma unroll
            for (int i = 0; i < 4; ++i) { const int d0 = cq - (32 * p + 4 * g + i), d1 = d0 - 16;
                p0[i] = d0 >= 0 ? s0[i] * __builtin_amdgcn_exp2f(lg2 * (float)d0) : 0.f; p1[i] = d1 >= 0 ? s1[i] * __builtin_amdgcn_exp2f(lg2 * (float)d1) : 0.f; }
            v4u pk; pk.x = pg8::cvt_pk_bf16(p0[0], p0[1]); pk.y = pg8::cvt_pk_bf16(p0[2], p0[3]); pk.z = pg8::cvt_pk_bf16(p1[0], p1[1]); pk.w = pg8::cvt_pk_bf16(p1[2], p1[3]);
            pf[p] = __builtin_bit_cast(bf16x8, pk);
        }
        const LAS unsigned char* Rcur = L + RT_RT + (n & 1) * RT_RTSZ;
#pragma unroll
        for (int et = 0; et < 2; ++et) {
            bf16x8 rf[4], vf[4];
#pragma unroll
            for (int ks = 0; ks < 4; ++ks) rf[ks] = *(const LAS bf16x8*)(Rcur + (16 * et + l15) * RT_STR + (32 * ks + 8 * g) * 2);
#pragma unroll
            for (int p = 0; p < 4; ++p) { const LAS unsigned char* vb = L + RT_VS + (32 * p + 4 * g + tq) * RT_VSTR + (16 * et + 4 * tp) * 2; vf[p] = tr8(vb, vb + 16 * RT_VSTR); }
            __builtin_amdgcn_sched_barrier(0);
            f32x4 acc = (f32x4){0.f, 0.f, 0.f, 0.f};
#pragma unroll
            for (int ks = 0; ks < 4; ++ks) acc = __builtin_amdgcn_mfma_f32_16x16x32_bf16(qf[ks], rf[ks], acc, 0, 0, 0);
#pragma unroll
            for (int i = 0; i < 4; ++i) acc[i] *= __builtin_amdgcn_exp2f(lg2 * (float)(16 * w + 4 * g + i + 1));
#pragma unroll
            for (int p = 0; p < 4; ++p) if (2 * p <= w) acc = __builtin_amdgcn_mfma_f32_16x16x32_bf16(pf[p], vf[p], acc, 0, 0, 0);
            store_y_bf16(Yg + (size_t)(n * 128 + 16 * w + 4 * g) * RETW + 16 * et + (l15 & ~1), RETW, acc, l15);
        }
        {
            bf16x8 kt[4], vt[4][2];
#pragma unroll
            for (int cs = 0; cs < 4; ++cs) {
                const LAS unsigned char* kb = L + RT_KS + (32 * cs + 8 * g + tq) * RT_STR + (16 * w + 4 * tp) * 2;
                kt[cs] = tr8(kb, kb + 4 * RT_STR);
#pragma unroll
                for (int et = 0; et < 2; ++et) { const LAS unsigned char* vb = L + RT_VPS + (32 * cs + 8 * g + tq) * RT_VSTR + (16 * et + 4 * tp) * 2; vt[cs][et] = tr8(vb, vb + 4 * RT_VSTR); }
            }
            __builtin_amdgcn_sched_barrier(0);
            LAS unsigned char* Rnxt = L + RT_RT + ((n + 1) & 1) * RT_RTSZ;
            accR[0] = accR[0] * gC; accR[1] = accR[1] * gC;
#pragma unroll
            for (int cs = 0; cs < 4; ++cs)
#pragma unroll
                for (int et = 0; et < 2; ++et) accR[et] = __builtin_amdgcn_mfma_f32_16x16x32_bf16(kt[cs], vt[cs][et], accR[et], 0, 0, 0);
#pragma unroll
            for (int et = 0; et < 2; ++et) { v2u o; o.x = pg8::cvt_pk_bf16(accR[et][0], accR[et][1]); o.y = pg8::cvt_pk_bf16(accR[et][2], accR[et][3]);
                *(LAS v2u*)(Rnxt + (16 * et + l15) * RT_STR + (16 * w + 4 * g) * 2) = o; }
        }
        RT_BAR();
    }
#undef RT_LOAD
#undef RT_BAR
}
__device__ __forceinline__ void ph_scan(Frame& F, ArgP A, int l) {
#if MK_CHUNKED
    if (F.G == 256) {
        const int it = F.vcu, r = it & 3, idx = it >> 2;
        if (r == 0 || r == 2) { const int w = idx * 2 + (r >> 1); int n_ = (MK_REP & 32) ? 2 : 1; asm volatile("" : "+s"(n_));
#pragma unroll 1
            for (int k_ = 0; k_ < n_; ++k_) { scan_rwkv_chunk(F, w); __syncthreads(); }
            if (MK_CONV_X2_PCT && l + 1 < DEPTH) { RETID(); ph_convert(F, A, l + 1, w, 128, CONV_SPLIT, CONV_NITEMS); } }
        else if (r == 1) { int n_ = (MK_REP & 64) ? 2 : 1; asm volatile("" : "+s"(n_));
#pragma unroll 1
            for (int k_ = 0; k_ < n_; ++k_) { scan_ret_mfma(F, idx); __syncthreads(); } }
        else {
            if (MK_TAIL_IN_SCAN) { pg8::Gemm g{WSPG(bf16, WS_H), WSWG(l, WO_WIN), M, INW, D}; pg8::OneUnit S{idx, INW / 256 - 1};
                fill_rstd<256>(F, idx * 256);
                pg8::EpiB<0> E{WSPG(bf16, WS_Z), INW, nullptr, 0, (const LAS float*)(F.lds + RSTD_OFF), idx};
                pg8::gemm_phase<pg8::EpiB<0>, pg8::OneUnit, MK_ALIGN, MK_SP2>(F.lds + RING_OFF, g, S, E);
                __syncthreads(); RETID(); }
            if (l + 1 < DEPTH) ph_convert(F, A, l + 1, idx, 64, 0, CONV_SPLIT); }
        __syncthreads();
    }
#else
    if (F.G >= 256) {
        if (F.vcu >= 192) { if (l + 1 < DEPTH) ph_convert(F, A, l + 1, F.vcu - 192, F.G - 192); return; }
        if (F.vcu < 128) { scan_rwkv_fast(F, F.vcu); if (MK_REP & 32) { __syncthreads(); scan_rwkv_fast(F, F.vcu); } }
        else if (F.vcu < 192) { scan_ret_mfma(F, F.vcu - 128); if (MK_REP & 64) { __syncthreads(); scan_ret_mfma(F, F.vcu - 128); } }
    } else {
        if (l + 1 < DEPTH) ph_convert(F, A, l + 1, F.vcu, F.G);
        const int gw = F.vcu * NWAVES + F.wave, NGW = F.G * NWAVES;
        const int stride = NGW >= 64 ? NGW / 64 : 1;
        if (gw % stride == 0) {
            for (int item = gw / stride; item < 64; item += (NGW + stride - 1) / stride) {
                if (item < 32) scan_rwkv_naive(F, item); else scan_ret_naive(F, item - 32);
            }
        }
    }
#endif
}
#if (MK_GLOBAL_GROUPS & 4)
#pragma pop_macro("WSP")
#pragma pop_macro("WSW")
#pragma pop_macro("OUTP")
#endif
#if (MK_GLOBAL_GROUPS & 8)
#pragma push_macro("WSP")
#pragma push_macro("WSW")
#pragma push_macro("OUTP")
#undef WSP
#undef WSW
#undef OUTP
#define WSP WSPG
#define WSW WSWG
#define OUTP OUTPG
#endif
template <int CTRL> __device__ __forceinline__ float dppx(float x) { return __builtin_bit_cast(float, __builtin_amdgcn_update_dpp(0, __builtin_bit_cast(int, x), CTRL, 0xF, 0xF, true)); }
static_assert(MK_CHUNKED == 1, "ph_post reads the raw scan outputs as bf16, which only the chunked / MFMA scans write");
__device__ __forceinline__ void ph_post(Frame& F, ArgP A, int l) {
    const int gw = F.vcu * NWAVES + F.wave, NGW = F.G * NWAVES, lane = F.lane, c0 = lane * 16;
    f32x4 gg[4], gb[4], lg[4], lb[4];
#pragma unroll
    for (int j = 0; j < 4; ++j) { gg[j] = *(const GAS f32x4*)(INP(A, 4) + (size_t)l * RETW + c0 + 4 * j); gb[j] = *(const GAS f32x4*)(INP(A, 5) + (size_t)l * RETW + c0 + 4 * j);
        lg[j] = *(const GAS f32x4*)(INP(A, 15) + (size_t)l * RWW + c0 + 4 * j); lb[j] = *(const GAS f32x4*)(INP(A, 16) + (size_t)l * RWW + c0 + 4 * j); }
    struct Raw { v2u yr[4]; v4u zg[2]; v2u yw[4], sv[4], gt[4]; float bonus; };
    auto load_row = [&](Raw& R, int m) {
        if (m >= M) m = M - 1;
        const GAS bf16* yrp = (const GAS bf16*)OUTP + (size_t)m * RETW + c0; const GAS bf16* zg = (const GAS bf16*)(WSP(bf16, WS_Z) + (size_t)m * INW + ZC_GR + c0);
        const size_t ob = (size_t)m * RWW + c0;
#pragma unroll
        for (int j = 0; j < 4; ++j) { R.yr[j] = *(const GAS v2u*)(yrp + 4 * j); R.yw[j] = *(const GAS v2u*)(WSP(bf16, WS_YRAWW) + ob + 4 * j);
            R.sv[j] = *(const GAS v2u*)(WSP(bf16, WS_SV) + ob + 4 * j); R.gt[j] = *(const GAS v2u*)(WSP(bf16, WS_G) + ob + 4 * j); }
        R.zg[0] = *(const GAS v4u*)zg; R.zg[1] = *(const GAS v4u*)(zg + 8);
        R.bonus = *(const GAS float*)(WSP(float, WS_BONUS) + (size_t)m * WH + (lane >> 2));
    };
    auto do_row = [&](const Raw& R, int m) {
        {
            f32x4 y[4]; float s = 0.f;
#pragma unroll
            for (int j = 0; j < 4; ++j) { y[j] = unpk4(R.yr[j]); s += (y[j].x + y[j].y) + (y[j].z + y[j].w); }
            float g[16]; { float t[8]; unpack8(R.zg[0], t);
#pragma unroll
                for (int j = 0; j < 8; ++j) g[j] = t[j]; unpack8(R.zg[1], t);
#pragma unroll
                for (int j = 0; j < 8; ++j) g[8 + j] = t[j]; }
            s += dppx<0xB1>(s); s += dppx<0x4E>(s); s += dppx<0x141>(s);
            const float mean = s * (1.f / RD); float q = 0.f;
#pragma unroll
            for (int j = 0; j < 4; ++j) { y[j] = y[j] - mean; q += (y[j].x * y[j].x + y[j].y * y[j].y) + (y[j].z * y[j].z + y[j].w * y[j].w); }
            q += dppx<0xB1>(q); q += dppx<0x4E>(q); q += dppx<0x141>(q);
            const float rstd = __builtin_amdgcn_rsqf(q * (1.f / RD) + RET_GN_EPS);
            float o[16];
#pragma unroll
            for (int j = 0; j < 4; ++j)
#pragma unroll
                for (int k = 0; k < 4; ++k) { const float gr = g[4 * j + k]; o[4 * j + k] = (y[j][k] * rstd * gg[j][k] + gb[j][k]) * (gr * fsig(gr)); }
            GAS bf16* yo = (GAS bf16*)(WSP(bf16, WS_YRET) + (size_t)m * RETW + c0);
            { float t[8];
#pragma unroll
              for (int j = 0; j < 8; ++j) t[j] = o[j]; *(GAS bf16x8*)yo = pack8(t);
#pragma unroll
              for (int j = 0; j < 8; ++j) t[j] = o[8 + j]; *(GAS bf16x8*)(yo + 8) = pack8(t); }
        }
        {
            const size_t ob = (size_t)m * RWW + c0;
            f32x4 y[4]; float s = 0.f;
#pragma unroll
            for (int j = 0; j < 4; ++j) { y[j] = unpk4(R.yw[j]); s += (y[j].x + y[j].y) + (y[j].z + y[j].w); }
            f32x4 vv[4], gt[4];
#pragma unroll
            for (int j = 0; j < 4; ++j) { vv[j] = unpk4(R.sv[j]); gt[j] = unpk4(R.gt[j]); }
            const float bonus = R.bonus;
            s += dppx<0xB1>(s); s += dppx<0x4E>(s);
            const float mean = s * (1.f / WD); float q = 0.f;
#pragma unroll
            for (int j = 0; j < 4; ++j) { y[j] = y[j] - mean; q += (y[j].x * y[j].x + y[j].y * y[j].y) + (y[j].z * y[j].z + y[j].w * y[j].w); }
            q += dppx<0xB1>(q); q += dppx<0x4E>(q);
            const float rstd = __builtin_amdgcn_rsqf(q * (1.f / WD) + RWKV_LN_EPS);
            float o[16];
#pragma unroll
            for (int j = 0; j < 4; ++j)
#pragma unroll
                for (int k = 0; k < 4; ++k) o[4 * j + k] = (y[j][k] * rstd * lg[j][k] + lb[j][k] + bonus * vv[j][k]) * gt[j][k];
            GAS bf16* yo = (GAS bf16*)(WSP(bf16, WS_YRWKV) + ob);
            { float t[8];
#pragma unroll
              for (int j = 0; j < 8; ++j) t[j] = o[j]; *(GAS bf16x8*)yo = pack8(t);
#pragma unroll
              for (int j = 0; j < 8; ++j) t[j] = o[8 + j]; *(GAS bf16x8*)(yo + 8) = pack8(t); }
        }
    };
    Raw ra, rb;
    if (gw < M) load_row(ra, gw);
    for (int m = gw; m < M; m += 2 * NGW) {
        load_row(rb, m + NGW); do_row(ra, m);
        if (m + NGW >= M) break;
        load_row(ra, m + 2 * NGW); do_row(rb, m + NGW);
    }
}
__device__ __forceinline__ void ph_final(Frame& F, ArgP A) {
    const int gw = F.vcu * NWAVES + F.wave, NGW = F.G * NWAVES, lane = F.lane;
    const GAS f32x4* gr = (const GAS f32x4*)INP(A, 23) + 2 * lane;
    f32x4 gn[8];
#pragma unroll
    for (int j = 0; j < 4; ++j) { gn[2 * j] = gr[128 * j]; gn[2 * j + 1] = gr[128 * j + 1]; }
    auto load_row = [&](v4u (&h)[4], int m) { if (m >= M) m = M - 1; const GAS v4u* hr = (const GAS v4u*)(WSP(bf16, WS_H) + (size_t)m * D) + lane;
#pragma unroll
        for (int j = 0; j < 4; ++j) h[j] = hr[64 * j]; };
    auto do_row = [&](const v4u (&h)[4], int m) {
        GAS f32x4* xo = (GAS f32x4*)(OUTP + (size_t)m * D) + 2 * lane;
        f32x4 v[8]; float s = 0.f;
#pragma unroll
        for (int j = 0; j < 4; ++j) {
            v[2 * j] = f32x4{__builtin_bit_cast(float, h[j].x << 16), __builtin_bit_cast(float, h[j].x & 0xffff0000u), __builtin_bit_cast(float, h[j].y << 16), __builtin_bit_cast(float, h[j].y & 0xffff0000u)};
            v[2 * j + 1] = f32x4{__builtin_bit_cast(float, h[j].z << 16), __builtin_bit_cast(float, h[j].z & 0xffff0000u), __builtin_bit_cast(float, h[j].w << 16), __builtin_bit_cast(float, h[j].w & 0xffff0000u)};
        }
#pragma unroll
        for (int j = 0; j < 8; ++j) s += (v[j].x * v[j].x + v[j].y * v[j].y) + (v[j].z * v[j].z + v[j].w * v[j].w);
        const float rstd = 1.f / sqrtf(wave_sum(s) * (1.f / D) + NORM_EPS);
#pragma unroll
        for (int j = 0; j < 4; ++j) { xo[128 * j] = v[2 * j] * rstd * gn[2 * j]; xo[128 * j + 1] = v[2 * j + 1] * rstd * gn[2 * j + 1]; }
    };
    v4u ha[4], hb[4];
    if (gw < M) load_row(ha, gw);
    for (int m = gw; m < M; m += 2 * NGW) {
        load_row(hb, m + NGW); do_row(ha, m);
        if (m + NGW >= M) break;
        load_row(ha, m + 2 * NGW); do_row(hb, m + NGW);
    }
}
#if (MK_GLOBAL_GROUPS & 8)
#pragma pop_macro("WSP")
#pragma pop_macro("WSW")
#pragma pop_macro("OUTP")
#endif

__global__ void __launch_bounds__(NWAVES * 64, 2) hybrid_fwd(Args args) {
    extern __shared__ __attribute__((aligned(16))) unsigned char lds[];
    Frame F;
    F.lds = (LAS unsigned char*)lds;
    F.MISC = (volatile LAS unsigned*)(F.lds + MISC_OFF);
    F.tid = threadIdx.x; F.lane = F.tid & 63; F.wave = __builtin_amdgcn_readfirstlane(F.tid >> 6);
    int bx = blockIdx.x; F.G = gridDim.x; { F.vcu = (F.G % 8 == 0) ? (bx % 8) * (F.G / 8) + bx / 8 : bx; }
    F.ws = args.ws; F.out = args.out;
    for (int u = F.tid; u < (LDS_BYTES - LDSCTL_OFF) / 4; u += NWAVES * 64) ((LAS unsigned*)(F.lds + LDSCTL_OFF))[u] = 0u;
    __syncthreads();
    if (F.tid == 0) { volatile LAS unsigned* U = (volatile LAS unsigned*)(F.lds + MISC_OFF) + 16; const unsigned long long pw = (unsigned long long)args.ws, po = (unsigned long long)args.out, pa = (unsigned long long)__builtin_amdgcn_kernarg_segment_ptr();
        U[0] = (unsigned)pw; U[1] = (unsigned)(pw >> 32); U[2] = (unsigned)po; U[3] = (unsigned)(po >> 32); U[4] = (unsigned)pa; U[5] = (unsigned)(pa >> 32); U[6] = (unsigned)F.G; U[7] = (unsigned)F.vcu; U[8] = (unsigned)bx; }
    __syncthreads();
    XcdBarrier bar = xcd_barrier_post((unsigned*)(F.ws + WS_CTL) + CW_BAR, F.MISC + 8);

    ArgP ap = (ArgP)__builtin_amdgcn_kernarg_segment_ptr();
    const int lo = args.ph_lo, hi = args.ph_hi;
#define REPX(bit, body) do { body; if (MK_REP & (bit)) { __syncthreads(); body; } } while (0)
#define IN(k) (lo <= (k) && (k) < hi)
#define SEAM(k) do { if (IN(k) && IN((k) + 1)) { xcd_barrier(bar); if (MK_REP & 256) { xcd_barrier(bar); xcd_barrier(bar); } } else __syncthreads(); } while (0)

    if (IN(PH_PRO)) { int np_ = (MK_REP & 8192) ? 2 : 1; asm volatile("" : "+s"(np_));
#pragma unroll 1
        for (int rp_ = 0; rp_ < np_; ++rp_) { ph_prologue(F, ap); ph_convert(F, ap, 0, F.vcu, F.G); __syncthreads(); } }
    SEAM(PH_PRO);
    for (int l = 0; l < DEPTH; ++l) {
        const int p0 = PH_L0 + l * PPL;
        RETID();
        { unsigned ba = MISC_OFF + 64; asm volatile("" : "+v"(ba));
          const volatile LAS v4u* U = (const volatile LAS v4u*)(F.lds + ba);
          const v4u ua = U[0], ub = U[1]; const unsigned uc = *(const volatile LAS unsigned*)(U + 2);
          const unsigned u0 = __builtin_amdgcn_readfirstlane(ua.x), u1 = __builtin_amdgcn_readfirstlane(ua.y), u2 = __builtin_amdgcn_readfirstlane(ua.z), u3 = __builtin_amdgcn_readfirstlane(ua.w);
          const unsigned u4 = __builtin_amdgcn_readfirstlane(ub.x), u5 = __builtin_amdgcn_readfirstlane(ub.y), u6 = __builtin_amdgcn_readfirstlane(ub.z), u7 = __builtin_amdgcn_readfirstlane(ub.w), u8 = __builtin_amdgcn_readfirstlane(uc);
          F.ws = (unsigned char*)(((unsigned long long)u1 << 32) | u0); F.out = (float*)(((unsigned long long)u3 << 32) | u2); ap = (ArgP)(((unsigned long long)u5 << 32) | u4);
          F.G = (int)u6; F.vcu = (int)u7; bx = (int)u8; F.wave = __builtin_amdgcn_readfirstlane(F.tid >> 6); }
        if (IN(p0 + LP_G1)) {
            pg8::Gemm g{WSPG(bf16, WS_H), WSWG(l, WO_WIN), M, INW, D}; pg8::StaticOrder S; S.init(M, INW - (MK_TAIL_IN_SCAN ? 256 : 0), F.G, bx);
            fill_rstd<RSTD_ROWS>(F, (bx & 7) * RSTD_ROWS);
            pg8::EpiB<0> E{WSPG(bf16, WS_Z), INW, nullptr, 0, (const LAS float*)(F.lds + RSTD_OFF), (bx & 7) * 8};
            if (MK_STAGGER_G1 && F.G == 256 && bx >= 64) { const unsigned long long t0 = __builtin_amdgcn_s_memrealtime(), ticks = (unsigned long long)(bx - 64) * (MK_STAGGER_G1 * 100) / 192;
                while (__builtin_amdgcn_s_memrealtime() - t0 < ticks) __builtin_amdgcn_s_sleep(16); }
            pg8::gemm_phase<pg8::EpiB<0>, pg8::StaticOrder, MK_ALIGN, MK_SP2>(F.lds + RING_OFF, g, S, E);
            if (MK_REP & 512) { __syncthreads(); pg8::gemm_phase<pg8::EpiB<0>, pg8::StaticOrder, MK_ALIGN, MK_SP2>(F.lds + RING_OFF, g, S, E); }
            if (MK_CONV_IN_G1 && F.G == 256 && l + 1 < DEPTH && bx >= 64) { RETID(); ph_convert(F, ap, l + 1, bx - 64, 192); }
        }
        SEAM(p0 + LP_G1);
        if (IN(p0 + LP_PREP)) { int nrep_ = (MK_REP & 4) ? 2 : 1; asm volatile("" : "+s"(nrep_));
#pragma unroll 1
            for (int rep_ = 0; rep_ < nrep_; ++rep_) { RETID(); ph_prep(F, ap, l); __syncthreads(); } }
        SEAM(p0 + LP_PREP);
        if (IN(p0 + LP_SCAN)) { RETID(); REPX(8, ph_scan(F, ap, l)); }
        SEAM(p0 + LP_SCAN);
        if (IN(p0 + LP_POST)) { RETID(); REPX(16, ph_post(F, ap, l)); }
        SEAM(p0 + LP_POST);
#if MK_FUSE_GAB
        if (IN(p0 + LP_GA)) {
            pg8::Gemm g{WSPG(bf16, WS_YRET), WSWG(l, WO_WA), M, D, RETW, WSPG(bf16, WS_YRWKV), WSWG(l, WO_WB)}; pg8::StaticOrder S; S.init(M, D, F.G, bx);
            pg8::EpiGate2 E{WSPG(bf16, WS_MRG), D, WSPG(bf16, WS_Z) + ZC_GA, WSPG(bf16, WS_Z) + ZC_GB, INW};
            pg8::gemm_phase<pg8::EpiGate2, pg8::StaticOrder, MK_ALIGN, MK_SP2, true>(F.lds + RING_OFF, g, S, E);
        }
        __syncthreads();
#else
        if (IN(p0 + LP_GA)) {
            pg8::Gemm g{WSPG(bf16, WS_YRET), WSWG(l, WO_WA), M, D, RETW}; pg8::StaticOrder S; S.init(M, D, F.G, bx);
            pg8::EpiB<2> E{WSPG(bf16, WS_MRG), D, WSPG(bf16, WS_Z) + ZC_GA, INW, nullptr};
            pg8::gemm_phase<pg8::EpiB<2>, pg8::StaticOrder, MK_ALIGN, MK_SP2>(F.lds + RING_OFF, g, S, E);
        }
        __syncthreads();
        if (IN(p0 + LP_GB)) {
            pg8::Gemm g{WSPG(bf16, WS_YRWKV), WSWG(l, WO_WB), M, D, RWW}; pg8::StaticOrder S; S.init(M, D, F.G, bx);
            pg8::EpiB<3> E{WSPG(bf16, WS_MRG), D, WSPG(bf16, WS_Z) + ZC_GB, INW, nullptr};
            pg8::gemm_phase<pg8::EpiB<3>, pg8::StaticOrder, MK_ALIGN, MK_SP2>(F.lds + RING_OFF, g, S, E);
        }
#endif
        SEAM(p0 + LP_GB);
        if (IN(p0 + LP_GO)) {
            pg8::Gemm g{WSPG(bf16, WS_MRG), WSWG(l, WO_WO), M, D, D}; pg8::StaticOrder S; S.init(M, D, F.G, bx);
            pg8::EpiResNorm E{WSPG(bf16, WS_H), D, WSPG(float, WS_SS)};
            pg8::gemm_phase<pg8::EpiResNorm, pg8::StaticOrder, MK_ALIGN, MK_SP2>(F.lds + RING_OFF, g, S, E);
        }
        SEAM(p0 + LP_GO);
        if (IN(p0 + LP_GUP)) {
            pg8::Gemm g{WSPG(bf16, WS_H), WSWG(l, WO_WUP), M, DFF, D}; pg8::StaticOrder S; S.init(M, DFF, F.G, bx);
            fill_rstd<RSTD_ROWS>(F, (bx & 7) * RSTD_ROWS);
            pg8::EpiB<1> E{WSPG(bf16, WS_UP), DFF, nullptr, 0, (const LAS float*)(F.lds + RSTD_OFF), (bx & 7) * 8};
            pg8::gemm_phase<pg8::EpiB<1>, pg8::StaticOrder, MK_ALIGN, MK_SP2>(F.lds + RING_OFF, g, S, E);
        }
        SEAM(p0 + LP_GUP);
        if (IN(p0 + LP_GDN)) {
            pg8::Gemm g{WSPG(bf16, WS_UP), WSWG(l, WO_WDN), M, D, DFF}; pg8::StaticOrder S; S.init(M, D, F.G, bx);
            pg8::EpiResNorm E{WSPG(bf16, WS_H), D, WSPG(float, WS_SS)};
            pg8::gemm_phase<pg8::EpiResNorm, pg8::StaticOrder, MK_ALIGN, MK_SP2>(F.lds + RING_OFF, g, S, E);
        }
        SEAM(p0 + LP_GDN);
    }
    if (IN(PH_FIN)) { RETID(); ph_final(F, ap); }
#undef IN
#undef SEAM
}

extern "C" void kernel_launch(void* const* d_in, const int* in_sizes, int n_in, void* d_out, int out_size, void* d_ws, size_t ws_size, hipStream_t stream) {
    static int grid = 0;
    if (grid == 0) {
        if (n_in != 24 || in_sizes[0] != M * D || out_size != M * D || ws_size < WS_END) { fprintf(stderr, "kernel_launch: built for 24 inputs, x and out of %d floats, >= %zu bytes of workspace; got n_in %d, in0 %d, out %d, ws %zu; nothing launched\n", M * D, (size_t)WS_END, n_in, n_in > 0 ? in_sizes[0] : -1, out_size, ws_size); grid = -1; return; }
        int dev = 0, cus = 0, per_cu = 0;
        if (hipGetDevice(&dev) != hipSuccess || hipDeviceGetAttribute(&cus, hipDeviceAttributeMultiprocessorCount, dev) != hipSuccess) { fprintf(stderr, "kernel_launch: hipGetDevice / hipDeviceGetAttribute failed; nothing launched\n"); grid = -1; return; }
        if (hipFuncSetAttribute((const void*)hybrid_fwd, hipFuncAttributeMaxDynamicSharedMemorySize, LDS_BYTES) != hipSuccess) { fprintf(stderr, "kernel_launch: hipFuncSetAttribute failed\n"); grid = -1; return; }
        if (hipOccupancyMaxActiveBlocksPerMultiprocessor(&per_cu, (const void*)hybrid_fwd, NWAVES * 64, LDS_BYTES) != hipSuccess || per_cu < 1)
            fprintf(stderr, "kernel_launch: note: the occupancy query reports %d workgroups per CU\n", per_cu);
        (void)hipGetLastError();
        if (cus < 256) { fprintf(stderr, "kernel_launch: built for a 256-CU device (MI355X); this one reports %d CUs; nothing launched\n", cus); grid = -1; return; }
        grid = 256;
    }
    if (grid < 0) return;
    if (hipMemsetAsync((char*)d_ws + WS_CTL, 0, CTL_ZERO_BYTES, stream) != hipSuccess) { fprintf(stderr, "kernel_launch: hipMemsetAsync failed\n"); return; }
    Args a{};
    for (int i = 0; i < 24; ++i) a.in[i] = (const float*)d_in[i];
    a.out = (float*)d_out; a.ws = (unsigned char*)d_ws; a.li = 0; a.pad = 0;
#if MK_ONE_LAUNCH
    a.ph_lo = 0; a.ph_hi = NPH;
    hipLaunchKernelGGL(hybrid_fwd, dim3(grid), dim3(NWAVES * 64), LDS_BYTES, stream, a);
#else
    for (int p = 0; p < NPH; ++p) {
        a.ph_lo = p; a.ph_hi = p + 1;
        hipLaunchKernelGGL(hybrid_fwd, dim3(grid), dim3(NWAVES * 64), LDS_BYTES, stream, a);
    }
#endif
    const hipError_t le = hipPeekAtLastError();
    if (le != hipSuccess) fprintf(stderr, "kernel_launch: launch failed: %s\n", hipGetErrorName(le));
}
```

```cpp
#include <hip/hip_runtime.h>
#include <cstdio>
#include <cstdint>
#ifndef MK_GLOBAL_GROUPS
#define MK_GLOBAL_GROUPS 30
#endif
#ifndef MK_REP
#define MK_REP 0
#endif
namespace pg8 {
#define PG8_LAS __attribute__((address_space(3)))
typedef unsigned short bf16_t;
typedef short bf16x8 __attribute__((ext_vector_type(8)));
typedef float f32x4 __attribute__((ext_vector_type(4)));
typedef unsigned u32x4 __attribute__((ext_vector_type(4)));
constexpr int BM = 256, BK = 64, HALF = 128, HTB = HALF * BK * 2  , STAGE_BYTES = 8 * HTB, NXCD = 8, WGM = 4;

__host__ __device__ __forceinline__ int lds_byte(int r, int c) { const int st = (r >> 4) * 2 + (c >> 5), rr = r & 15, cc = c & 31, ob = rr * 64 + cc * 2; return st * 1024 + (ob ^ (((ob >> 9) & 1) << 5)); }
__host__ __device__ __forceinline__ void stage_rc(int b, int& R, int& C) { const int st = b / 1024, sb = b % 1024, swz = sb ^ (((sb >> 9) & 1) << 5); R = (st >> 1) * 16 + swz / 64; C = (st & 1) * 32 + (swz % 64) / 2; }
__host__ __device__ __forceinline__ int perm32(int rho) { const int n = rho >> 4, i = rho & 15; return 8 * (i >> 2) + 4 * n + (i & 3); }

struct Unit { int pm, pn; };
struct Gemm { const bf16_t* A; const bf16_t* Bt; int M, N, K; const bf16_t* A2 = nullptr; const bf16_t* Bt2 = nullptr; };

struct StaticOrder {
    int nM, nN, nwg, G, c;
    __host__ __device__ void init(int M, int N, int G_, int c_) { nM = M / BM; nN = N / BM; nwg = nM * nN; G = G_; c = c_; }
    __host__ __device__ bool next(int i, Unit& u) const {
        const long L = (long)i * G + c; if (L >= nwg) return false;
        int wgid = (int)L; { const int q = nwg / NXCD, r = nwg % NXCD, xcd = wgid % NXCD, off = wgid / NXCD; wgid = (xcd < r ? xcd * (q + 1) : r * (q + 1) + (xcd - r) * q) + off; }
        const int nig = WGM * nN, gid = wgid / nig, fm = gid * WGM, gsz = (nM - fm) < WGM ? (nM - fm) : WGM;
        u.pm = fm + ((wgid % nig) % gsz); u.pn = (wgid % nig) / gsz; return true;
    }
    __device__ __forceinline__ void a_ready(const Unit&) const {}
    __device__ __forceinline__ void done(const Unit&) const {}
};

struct OneUnit {
    int pm, pn;
    __host__ __device__ bool next(int i, Unit& u) const { if (i != 0) return false; u.pm = pm; u.pn = pn; return true; }
    __device__ __forceinline__ void a_ready(const Unit&) const {}
    __device__ __forceinline__ void done(const Unit&) const {}
};

typedef float f32x2c __attribute__((ext_vector_type(2))); typedef __bf16 bf16x2c __attribute__((ext_vector_type(2)));
__device__ __forceinline__ unsigned cvt_pk_bf16(float lo, float hi) { const f32x2c v = {lo, hi}; return __builtin_bit_cast(unsigned, __builtin_convertvector(v, bf16x2c)); }
typedef float f32x2 __attribute__((ext_vector_type(2)));
__device__ __forceinline__ float bf_lo(unsigned w) { return __builtin_bit_cast(float, w << 16); }
__device__ __forceinline__ float bf_hi(unsigned w) { return __builtin_bit_cast(float, w & 0xffff0000u); }
__device__ __forceinline__ float sigmoidf_(float x) { return 1.0f / (1.0f + __expf(-x)); }
template <int MODE> struct EpiB {
    static constexpr bool PERM = true, AFTER_DRAIN = false;
    bf16_t* O; int ldc; const bf16_t* gate; int ldg; const PG8_LAS float* rl; int pm0;
    __device__ __forceinline__ void operator()(const f32x4 (&acc)[2][2][4][2], const Unit& u, int wr, int wc, int fr, int fq) const {
        const int row0 = u.pm * BM + wr * 64 + fr, col0 = u.pn * BM + wc * 32 + 8 * fq;
        float rs[2][4];
        if (MODE <= 1) { int fo = wr * 64 + fr; asm volatile("" : "+v"(fo));
            const PG8_LAS float* r = rl + (u.pm - pm0) * BM + fo;
#pragma unroll
            for (int ai = 0; ai < 2; ++ai)
#pragma unroll
                for (int m = 0; m < 4; ++m) rs[ai][m] = r[ai * HALF + m * 16]; }
#pragma unroll
        for (int ai = 0; ai < 2; ++ai)
#pragma unroll
            for (int m = 0; m < 4; ++m) { const size_t row = (size_t)(row0 + ai * HALF + m * 16);
#pragma unroll
                for (int bj = 0; bj < 2; ++bj) { f32x4 v0 = acc[ai][bj][m][0], v1 = acc[ai][bj][m][1]; const int c = col0 + bj * HALF;
                    if (MODE <= 1) { v0 = v0 * rs[ai][m]; v1 = v1 * rs[ai][m]; }
                    if (MODE == 1) {
#pragma unroll
                        for (int j = 0; j < 4; ++j) { const float a = fmaxf(v0[j], 0.f), b = fmaxf(v1[j], 0.f); v0[j] = a * a; v1[j] = b * b; } }
                    if (MODE >= 2) { const u32x4 g = *(const u32x4*)(gate + row * ldg + c);
                        v0[0] *= sigmoidf_(bf_lo(g.x)); v0[1] *= sigmoidf_(bf_hi(g.x)); v0[2] *= sigmoidf_(bf_lo(g.y)); v0[3] *= sigmoidf_(bf_hi(g.y));
                        v1[0] *= sigmoidf_(bf_lo(g.z)); v1[1] *= sigmoidf_(bf_hi(g.z)); v1[2] *= sigmoidf_(bf_lo(g.w)); v1[3] *= sigmoidf_(bf_hi(g.w)); }
                    if (MODE == 3) { const u32x4 o = *(const u32x4*)(O + row * ldc + c);
                        v0[0] += bf_lo(o.x); v0[1] += bf_hi(o.x); v0[2] += bf_lo(o.y); v0[3] += bf_hi(o.y);
                        v1[0] += bf_lo(o.z); v1[1] += bf_hi(o.z); v1[2] += bf_lo(o.w); v1[3] += bf_hi(o.w); }
                    u32x4 w; w.x = cvt_pk_bf16(v0[0], v0[1]); w.y = cvt_pk_bf16(v0[2], v0[3]); w.z = cvt_pk_bf16(v1[0], v1[1]); w.w = cvt_pk_bf16(v1[2], v1[3]);
                    *(u32x4*)(O + row * ldc + c) = w; } }
    }
};
struct EpiResNorm {
    static constexpr bool PERM = true, AFTER_DRAIN = false;
    bf16_t* XB; int ldc; float* SS;
    __device__ __forceinline__ void operator()(const f32x4 (&acc)[2][2][4][2], const Unit& u, int wr, int wc, int fr, int fq) const {
        const int row0 = u.pm * BM + wr * 64 + fr, col0 = u.pn * BM + wc * 32 + 8 * fq;
#pragma unroll
        for (int ai = 0; ai < 2; ++ai) {
            u32x4 o[4][2];
#pragma unroll
            for (int m = 0; m < 4; ++m)
#pragma unroll
                for (int bj = 0; bj < 2; ++bj) o[m][bj] = *(const u32x4*)(XB + (size_t)(row0 + ai * HALF + m * 16) * ldc + col0 + bj * HALF);
#pragma unroll
            for (int m = 0; m < 4; ++m) { const size_t row = (size_t)(row0 + ai * HALF + m * 16);
                float s = 0.f;
#pragma unroll
                for (int bj = 0; bj < 2; ++bj) { const int c = col0 + bj * HALF; const u32x4 r = o[m][bj];
                    f32x4 x0 = acc[ai][bj][m][0], x1 = acc[ai][bj][m][1];
                    x0[0] += bf_lo(r.x); x0[1] += bf_hi(r.x); x0[2] += bf_lo(r.y); x0[3] += bf_hi(r.y); x1[0] += bf_lo(r.z); x1[1] += bf_hi(r.z); x1[2] += bf_lo(r.w); x1[3] += bf_hi(r.w);
                    u32x4 w; w.x = cvt_pk_bf16(x0[0], x0[1]); w.y = cvt_pk_bf16(x0[2], x0[3]); w.z = cvt_pk_bf16(x1[0], x1[1]); w.w = cvt_pk_bf16(x1[2], x1[3]);
                    *(u32x4*)(XB + row * ldc + c) = w;
                    s += ((x0[0] * x0[0] + x0[1] * x0[1]) + (x0[2] * x0[2] + x0[3] * x0[3])) + ((x1[0] * x1[0] + x1[1] * x1[1]) + (x1[2] * x1[2] + x1[3] * x1[3])); }
                s += __shfl_xor(s, 16); s += __shfl_xor(s, 32);
                if (fq == 0) SS[row * 32 + u.pn * 4 + wc] = s; } }
    }
};

struct EpiGate2 {
    static constexpr bool PERM = true, AFTER_DRAIN = false;
    bf16_t* O; int ldc; const bf16_t* ga; const bf16_t* gb; int ldg;
    static __device__ __forceinline__ float en(float g) { return __expf(-fmaxf(g, -60.f)); }
    __device__ __forceinline__ void mid(f32x4 (&acc)[2][2][4][2], const Unit& u, int wr, int wc, int fr, int fq) const {
        const int row0 = u.pm * BM + wr * 64 + fr, col0 = u.pn * BM + wc * 32 + 8 * fq;
        int r = row0;
#pragma unroll
        for (int ai = 0; ai < 2; ++ai) {
            asm volatile("" : "+v"(r));
            u32x4 a[4][2], b[4][2];
#pragma unroll
            for (int m = 0; m < 4; ++m)
#pragma unroll
                for (int bj = 0; bj < 2; ++bj) { const size_t o = (size_t)(r + ai * HALF + m * 16) * ldg + col0 + bj * HALF; a[m][bj] = *(const u32x4*)(ga + o); b[m][bj] = *(const u32x4*)(gb + o); }
            __builtin_amdgcn_sched_barrier(0);
#pragma unroll
            for (int m = 0; m < 4; ++m) {
#pragma unroll
                for (int bj = 0; bj < 2; ++bj) { const u32x4 x = a[m][bj], y = b[m][bj]; f32x4& v0 = acc[ai][bj][m][0]; f32x4& v1 = acc[ai][bj][m][1];
                    v0[0] *= (1.f + en(bf_lo(y.x))) * __builtin_amdgcn_rcpf(1.f + en(bf_lo(x.x))); v0[1] *= (1.f + en(bf_hi(y.x))) * __builtin_amdgcn_rcpf(1.f + en(bf_hi(x.x)));
                    v0[2] *= (1.f + en(bf_lo(y.y))) * __builtin_amdgcn_rcpf(1.f + en(bf_lo(x.y))); v0[3] *= (1.f + en(bf_hi(y.y))) * __builtin_amdgcn_rcpf(1.f + en(bf_hi(x.y)));
                    v1[0] *= (1.f + en(bf_lo(y.z))) * __builtin_amdgcn_rcpf(1.f + en(bf_lo(x.z))); v1[1] *= (1.f + en(bf_hi(y.z))) * __builtin_amdgcn_rcpf(1.f + en(bf_hi(x.z)));
                    v1[2] *= (1.f + en(bf_lo(y.w))) * __builtin_amdgcn_rcpf(1.f + en(bf_lo(x.w))); v1[3] *= (1.f + en(bf_hi(y.w))) * __builtin_amdgcn_rcpf(1.f + en(bf_hi(x.w))); }
                asm volatile("" : "+v"(acc[ai][0][m][0]), "+v"(acc[ai][0][m][1]), "+v"(acc[ai][1][m][0]), "+v"(acc[ai][1][m][1]));
            }
            __builtin_amdgcn_sched_barrier(0);
        }
    }
    __device__ __forceinline__ void operator()(const f32x4 (&acc)[2][2][4][2], const Unit& u, int wr, int wc, int fr, int fq) const {
        const int row0 = u.pm * BM + wr * 64 + fr, col0 = u.pn * BM + wc * 32 + 8 * fq;
#pragma unroll
        for (int ai = 0; ai < 2; ++ai) {
            u32x4 b[4][2];
#pragma unroll
            for (int m = 0; m < 4; ++m)
#pragma unroll
                for (int bj = 0; bj < 2; ++bj) b[m][bj] = *(const u32x4*)(gb + (size_t)(row0 + ai * HALF + m * 16) * ldg + col0 + bj * HALF);
#pragma unroll
            for (int m = 0; m < 4; ++m)
#pragma unroll
                for (int bj = 0; bj < 2; ++bj) { const u32x4 y = b[m][bj]; f32x4 v0 = acc[ai][bj][m][0], v1 = acc[ai][bj][m][1];
                    v0[0] *= __builtin_amdgcn_rcpf(1.f + en(bf_lo(y.x))); v0[1] *= __builtin_amdgcn_rcpf(1.f + en(bf_hi(y.x))); v0[2] *= __builtin_amdgcn_rcpf(1.f + en(bf_lo(y.y))); v0[3] *= __builtin_amdgcn_rcpf(1.f + en(bf_hi(y.y)));
                    v1[0] *= __builtin_amdgcn_rcpf(1.f + en(bf_lo(y.z))); v1[1] *= __builtin_amdgcn_rcpf(1.f + en(bf_hi(y.z))); v1[2] *= __builtin_amdgcn_rcpf(1.f + en(bf_lo(y.w))); v1[3] *= __builtin_amdgcn_rcpf(1.f + en(bf_hi(y.w)));
                    u32x4 w; w.x = cvt_pk_bf16(v0[0], v0[1]); w.y = cvt_pk_bf16(v0[2], v0[3]); w.z = cvt_pk_bf16(v1[0], v1[1]); w.w = cvt_pk_bf16(v1[2], v1[3]);
                    *(u32x4*)(O + (size_t)(row0 + ai * HALF + m * 16) * ldc + col0 + bj * HALF) = w; }
            __builtin_amdgcn_sched_barrier(0);
        }
    }
};

template <class Epi, class Sched, bool ALIGN_EPI = false, bool SP2 = false, bool SEG2 = false>
__device__ __forceinline__ void gemm_phase(PG8_LAS unsigned char* lds, const Gemm g, const Sched& S, const Epi& E) {
    int tid_ = threadIdx.x; asm volatile("" : "+v"(tid_));
    const int tid = tid_, wid = __builtin_amdgcn_readfirstlane(tid >> 6), lane = tid & 63, wr = wid >> 2, wc = wid & 3, fr = lane & 15, fq = lane >> 4;
    const int K = g.K, nt = K / BK;
    unsigned voffA[2], voffB[2];
#pragma unroll
    for (int i = 0; i < 2; ++i) { int R, C; stage_rc(tid * 16 + i * 8192, R, C); const int Rb = Epi::PERM ? ((R & ~31) + perm32(R & 31)) : R;
        voffA[i] = (unsigned)(R * K + C) * 2u; voffB[i] = (unsigned)(Rb * K + C) * 2u; }
    const size_t kstep = (size_t)(BK * 2);
    const size_t hstep = (size_t)HALF * K * 2;
    const size_t tstep = 2 * hstep;
    const unsigned ldsw = (unsigned)wid * 1024u;
    const int aoff = lds_byte(wr * 64 + fr, fq * 8), boff = lds_byte(wc * 32 + fr, fq * 8);
#define PG8_SA(b, h) (((b) * 2 + (h)) * HTB)
#define PG8_SB(b, h) ((4 + (b) * 2 + (h)) * HTB)
#define PG8_STAGE(bufoff, gbase, voff) do { _Pragma("unroll") for (int _i = 0; _i < 2; ++_i) \
        __builtin_amdgcn_global_load_lds((const unsigned*)((const char*)(gbase) + (voff)[_i]), (PG8_LAS unsigned*)(lds + (bufoff) + ldsw + _i * 8192), 16, 0, 0); } while (0)
#define PG8_LDA(dst, b, h) do { _Pragma("unroll") for (int m = 0; m < 4; ++m) _Pragma("unroll") for (int k = 0; k < 2; ++k) dst[m][k] = *(const PG8_LAS bf16x8*)(lds + PG8_SA(b, h) + aoff + m * 2048 + k * 1024); } while (0)
#define PG8_LDB(dst, b, h) do { _Pragma("unroll") for (int n = 0; n < 2; ++n) _Pragma("unroll") for (int k = 0; k < 2; ++k) dst[n][k] = *(const PG8_LAS bf16x8*)(lds + PG8_SB(b, h) + boff + n * 2048 + k * 1024); } while (0)
#define PG8_MMA(ai, bj, At, Bt) do { __builtin_amdgcn_s_setprio(1); _Pragma("unroll") for (int m = 0; m < 4; ++m) _Pragma("unroll") for (int n = 0; n < 2; ++n) _Pragma("unroll") for (int k = 0; k < 2; ++k) \
        acc[ai][bj][m][n] = __builtin_amdgcn_mfma_f32_16x16x32_bf16(Bt[n][k], At[m][k], acc[ai][bj][m][n], 0, 0, 0); __builtin_amdgcn_s_setprio(0); } while (0)
#define PG8_WAIT_V(n) asm volatile("s_waitcnt vmcnt(" #n ")" ::: "memory")
#define PG8_WAIT_L(n) asm volatile("s_waitcnt lgkmcnt(" #n ")" ::: "memory")
#define PG8_BAR __builtin_amdgcn_s_barrier()
#define PG8_SCHED __builtin_amdgcn_sched_barrier(0)
    Unit cur, nxt; int ui = 0;
    if (!S.next(0, cur)) return;
    f32x4 acc[2][2][4][2];
#pragma unroll
    for (int a = 0; a < 2; ++a)
#pragma unroll
        for (int b = 0; b < 2; ++b)
#pragma unroll
            for (int m = 0; m < 4; ++m)
#pragma unroll
                for (int n = 0; n < 2; ++n) acc[a][b][m][n] = (f32x4){0.f, 0.f, 0.f, 0.f};
    bf16x8 At[4][2], B0[2][2], B1[2][2];
    const char* cA = (const char*)g.A + (size_t)cur.pm * tstep; const char* cB = (const char*)g.Bt + (size_t)cur.pn * tstep;
    S.a_ready(cur);
    if constexpr (SP2) {
        PG8_STAGE(PG8_SB(0, 0), cB, voffB); PG8_STAGE(PG8_SB(0, 1), cB + hstep, voffB); PG8_STAGE(PG8_SA(0, 0), cA, voffA); PG8_STAGE(PG8_SA(0, 1), cA + hstep, voffA);
        if (wr == 1) PG8_BAR;
        PG8_WAIT_V(2); PG8_BAR;
        PG8_STAGE(PG8_SB(1, 0), cB + kstep, voffB); PG8_STAGE(PG8_SA(1, 0), cA + kstep, voffA); PG8_STAGE(PG8_SB(1, 1), cB + hstep + kstep, voffB);
        PG8_WAIT_V(6); PG8_BAR;
    } else {
        PG8_STAGE(PG8_SB(0, 0), cB, voffB); PG8_STAGE(PG8_SA(0, 0), cA, voffA); PG8_STAGE(PG8_SB(0, 1), cB + hstep, voffB); PG8_STAGE(PG8_SA(0, 1), cA + hstep, voffA);
        if (wr == 1) PG8_BAR;
        PG8_WAIT_V(4); PG8_BAR;
        PG8_STAGE(PG8_SB(1, 0), cB + kstep, voffB); PG8_STAGE(PG8_SA(1, 0), cA + kstep, voffA); PG8_STAGE(PG8_SB(1, 1), cB + hstep + kstep, voffB);
        PG8_WAIT_V(6); PG8_BAR;
    }
    int seg = 0;
    for (;;) {
        bool has_next; const char* nA; const char* nB;
        if (SEG2 && seg == 0) { has_next = true; nxt = cur; nA = (const char*)g.A2 + (size_t)cur.pm * tstep; nB = (const char*)g.Bt2 + (size_t)cur.pn * tstep; }
        else { has_next = S.next(ui + 1, nxt); nA = has_next ? (const char*)g.A + (size_t)nxt.pm * tstep : cA; nB = has_next ? (const char*)g.Bt + (size_t)nxt.pn * tstep : cB; }
        for (int t = 0; t < nt; t += 2) {
            const bool last = (t == nt - 2);
            const char* a1 = cA + (size_t)(t + 1) * kstep;
            const char* a2 = last ? nA : cA + (size_t)(t + 2) * kstep; const char* b2 = last ? nB : cB + (size_t)(t + 2) * kstep;
            const char* a3 = a2 + kstep; const char* b3 = b2 + kstep;
            if (last && has_next && !(SEG2 && seg == 0)) S.a_ready(nxt);
            if constexpr (SP2) {
            PG8_LDB(B0, 0, 0); PG8_LDB(B1, 0, 1); PG8_SCHED; PG8_LDA(At, 0, 0); PG8_STAGE(PG8_SA(1, 1), a1 + hstep, voffA);
            PG8_WAIT_V(8); PG8_WAIT_L(0); PG8_BAR; PG8_MMA(0, 0, At, B0); PG8_MMA(0, 1, At, B1); PG8_BAR; PG8_SCHED;
            PG8_LDA(At, 0, 1); PG8_STAGE(PG8_SB(0, 0), b2, voffB); PG8_STAGE(PG8_SB(0, 1), b2 + hstep, voffB); PG8_STAGE(PG8_SA(0, 0), a2, voffA);
            PG8_WAIT_V(8); PG8_WAIT_L(0); PG8_BAR; PG8_MMA(1, 0, At, B0); PG8_MMA(1, 1, At, B1); PG8_BAR; PG8_SCHED;
            PG8_LDB(B0, 1, 0); PG8_LDB(B1, 1, 1); PG8_SCHED; PG8_LDA(At, 1, 0); PG8_STAGE(PG8_SA(0, 1), a2 + hstep, voffA);
            PG8_WAIT_V(8); PG8_WAIT_L(0); PG8_BAR; PG8_MMA(0, 0, At, B0); PG8_MMA(0, 1, At, B1); PG8_BAR; PG8_SCHED;
            PG8_LDA(At, 1, 1); PG8_STAGE(PG8_SB(1, 0), b3, voffB); PG8_STAGE(PG8_SB(1, 1), b3 + hstep, voffB); PG8_STAGE(PG8_SA(1, 0), a3, voffA);
            PG8_WAIT_V(8); PG8_WAIT_L(0); PG8_BAR; PG8_MMA(1, 0, At, B0); PG8_MMA(1, 1, At, B1); PG8_BAR; PG8_SCHED;
            } else {
            PG8_LDB(B0, 0, 0); PG8_SCHED; PG8_LDA(At, 0, 0); PG8_STAGE(PG8_SA(1, 1), a1 + hstep, voffA);
            PG8_WAIT_L(8); PG8_BAR; PG8_WAIT_L(0); PG8_MMA(0, 0, At, B0); PG8_BAR; PG8_SCHED;
            PG8_LDB(B1, 0, 1); PG8_STAGE(PG8_SB(0, 0), b2, voffB);
            PG8_BAR; PG8_WAIT_L(0); PG8_MMA(0, 1, At, B1); PG8_BAR;
            PG8_LDA(At, 0, 1); PG8_STAGE(PG8_SA(0, 0), a2, voffA);
            PG8_BAR; PG8_WAIT_L(0); PG8_MMA(1, 0, At, B0); PG8_BAR; PG8_SCHED;
            PG8_STAGE(PG8_SB(0, 1), b2 + hstep, voffB);
            PG8_WAIT_V(6); PG8_BAR; PG8_MMA(1, 1, At, B1); PG8_BAR;
            PG8_LDB(B0, 1, 0); PG8_SCHED; PG8_LDA(At, 1, 0); PG8_STAGE(PG8_SA(0, 1), a2 + hstep, voffA);
            PG8_WAIT_L(8); PG8_BAR; PG8_WAIT_L(0); PG8_MMA(0, 0, At, B0); PG8_BAR; PG8_SCHED;
            PG8_LDB(B1, 1, 1); PG8_STAGE(PG8_SB(1, 0), b3, voffB);
            PG8_BAR; PG8_WAIT_L(0); PG8_MMA(0, 1, At, B1); PG8_BAR;
            PG8_LDA(At, 1, 1); PG8_STAGE(PG8_SA(1, 0), a3, voffA);
            PG8_BAR; PG8_WAIT_L(0); PG8_MMA(1, 0, At, B0); PG8_BAR; PG8_SCHED;
            PG8_STAGE(PG8_SB(1, 1), b3 + hstep, voffB);
            PG8_WAIT_V(6); PG8_BAR; PG8_MMA(1, 1, At, B1); PG8_BAR;
            }
        }
        if constexpr (ALIGN_EPI) { if (wr == 0) PG8_BAR; }
        if constexpr (SEG2) {
            int t2 = tid, pm2 = cur.pm, pn2 = cur.pn; asm volatile("" : "+v"(t2), "+s"(pm2), "+s"(pn2));
            const int l2 = t2 & 63, w2 = __builtin_amdgcn_readfirstlane(t2 >> 6); const Unit u2{pm2, pn2};
            if (seg == 0) { E.mid(acc, u2, w2 >> 2, w2 & 3, l2 & 15, l2 >> 4); seg = 1; cA = nA; cB = nB; if constexpr (ALIGN_EPI) { if (wr == 1) PG8_BAR; } continue; }
            seg = 0; E(acc, u2, w2 >> 2, w2 & 3, l2 & 15, l2 >> 4); S.done(cur);
        } else
        if constexpr (!Epi::AFTER_DRAIN) { E(acc, cur, wr, wc, fr, fq); S.done(cur); }
        if (!has_next) break;
#pragma unroll
        for (int a = 0; a < 2; ++a)
#pragma unroll
            for (int b = 0; b < 2; ++b)
#pragma unroll
                for (int m = 0; m < 4; ++m)
#pragma unroll
                    for (int n = 0; n < 2; ++n) acc[a][b][m][n] = (f32x4){0.f, 0.f, 0.f, 0.f};
        cur = nxt; cA = nA; cB = nB; ++ui;
        if constexpr (ALIGN_EPI) { if (wr == 1) PG8_BAR; }
    }
    PG8_WAIT_V(0);
    if constexpr (!ALIGN_EPI) { if (wr == 0) PG8_BAR; }
    PG8_BAR;
    if constexpr (Epi::AFTER_DRAIN) { E.fused(acc, cur, wr, wc, fr, fq, lds, wid, lane); S.done(cur); }
#undef PG8_SA
#undef PG8_SB
#undef PG8_STAGE
#undef PG8_LDA
#undef PG8_LDB
#undef PG8_MMA
#undef PG8_WAIT_V
#undef PG8_WAIT_L
#undef PG8_BAR
#undef PG8_SCHED
}
}
constexpr int NWAVES = 8;
#ifndef MK_ONE_LAUNCH
#define MK_ONE_LAUNCH 1
#endif

#ifndef MK_GLOBAL_GROUPS
#define MK_GLOBAL_GROUPS 30
#endif
#ifndef MK_CHUNKED
#define MK_CHUNKED 1
#endif
#ifndef MK_SP2
#define MK_SP2 true
#endif
#ifndef MK_ALIGN
#define MK_ALIGN true
#endif
#ifndef MK_CONV_IN_G1
#define MK_CONV_IN_G1 0
#endif
#ifndef MK_X2_NT
#define MK_X2_NT 0
#endif
#ifndef MK_STAGGER_G1
#define MK_STAGGER_G1 0
#endif
#ifndef MK_TAIL_IN_SCAN
#define MK_TAIL_IN_SCAN 1
#endif
#ifndef MK_CONV_X2_PCT
#define MK_CONV_X2_PCT 60
#endif
#ifndef MK_FUSE_GAB
#define MK_FUSE_GAB 1
#endif
#ifndef MK_REP
#define MK_REP 0
#endif

constexpr int BATCH = 2, SEQ = 8192, D = 2048, DEPTH = 4, M = BATCH * SEQ;
constexpr int RETW = 1024, RH = 8, RD = 128, RWW = 1024, WH = 16, WD = 64;
constexpr int INW = 11520, DFF = 8192, RWSHIFT = 3328;
constexpr int ZC_Q = 0, ZC_K = 1024, ZC_V = 2048, ZC_GR = 3072, ZC_RW = 4096, ZC_GA = 7424, ZC_GB = 9472;
constexpr int RWC_R = 0, RWC_K = 1024, RWC_V = 2048, RWC_W = 3072, RWC_A = 3136, RWC_G = 3200;
constexpr float NORM_EPS = 1e-6f, RET_GN_EPS = 1e-5f, RWKV_LN_EPS = 64e-5f;

constexpr size_t MiB = 1u << 20;
constexpr size_t WS_CTL = 0, CTL_ZERO_BYTES = 1 * MiB;
constexpr size_t WS_ROPE = 1 * MiB;
constexpr size_t WS_WSET = 16 * MiB, WSET_BYTES = 126 * MiB;
constexpr size_t WO_WIN = 0, WO_WA = 45 * MiB, WO_WB = 49 * MiB, WO_WO = 53 * MiB, WO_WUP = 61 * MiB, WO_WDN = 93 * MiB, WO_LORA = 125 * MiB;
constexpr size_t WS_H = 272 * MiB;
constexpr size_t WS_Z = 336 * MiB;
constexpr size_t WS_UP = WS_Z;
constexpr size_t WS_QR = 696 * MiB, WS_KR = 728 * MiB;
constexpr size_t WS_YRET = 760 * MiB, WS_YRWKV = 792 * MiB;
constexpr size_t WS_MRG = 824 * MiB;
#if MK_CHUNKED
constexpr size_t WS_SR = 888 * MiB, WS_SV = 1208 * MiB;
#else
constexpr size_t WS_SR = 888 * MiB, WS_SW = 952 * MiB, WS_SK = 1016 * MiB, WS_SV = 1080 * MiB, WS_SNKK = 1144 * MiB, WS_SKKA = 1208 * MiB;
#endif
constexpr size_t WS_CU = WS_SR;
constexpr size_t WS_G = 1272 * MiB;
constexpr size_t WS_BONUS = 1336 * MiB;
constexpr size_t WS_SS = 1337 * MiB;
constexpr size_t WS_YRAWW = WS_MRG;
constexpr size_t WS_END = 1341 * MiB;
constexpr int CW_BAR = 4096;

constexpr int PPL = 9;
enum { LP_G1 = 0, LP_PREP, LP_SCAN, LP_POST, LP_GA, LP_GB, LP_GO, LP_GUP, LP_GDN };
constexpr int PH_PRO = 0, PH_L0 = 1, PH_FIN = PH_L0 + DEPTH * PPL, NPH = PH_FIN + 1;

constexpr int RING_OFF = 0, RING_BYTES = 131072;
constexpr int LDSCTL_OFF = RING_BYTES, MISC_OFF = LDSCTL_OFF + 320;
constexpr int LDS_BYTES = 147456;
constexpr int RSTD_OFF = LDSCTL_OFF + 1024, RSTD_ROWS = 2048;
static_assert(MISC_OFF + 128 <= RSTD_OFF && RSTD_OFF + RSTD_ROWS * 4 <= LDS_BYTES, "LDS map");

#define GAS __attribute__((address_space(1)))
#define LAS __attribute__((address_space(3)))
typedef unsigned short bf16;
typedef unsigned v4u __attribute__((ext_vector_type(4)));
typedef unsigned v2u __attribute__((ext_vector_type(2)));
typedef float f32x4 __attribute__((ext_vector_type(4)));
typedef float f32x2 __attribute__((ext_vector_type(2)));
typedef short bf16x8 __attribute__((ext_vector_type(8)));
typedef GAS unsigned gu32;
#define LDS_WAIT() asm volatile("s_waitcnt lgkmcnt(0)" ::: "memory")
#define VM_WAIT() asm volatile("s_waitcnt vmcnt(0)" ::: "memory")
__device__ __forceinline__ unsigned f2bf(float f) { unsigned u = __builtin_bit_cast(unsigned, f); return (u + 0x7fffu + ((u >> 16) & 1u)) >> 16; }
__device__ __forceinline__ unsigned pk2(float lo, float hi) { return f2bf(lo) | (f2bf(hi) << 16); }
__device__ __forceinline__ float bf2f(bf16 v) { return __builtin_bit_cast(float, (unsigned)v << 16); }
__device__ __forceinline__ float rdlane(float v, int l) { return __builtin_bit_cast(float, __builtin_amdgcn_readlane(__builtin_bit_cast(int, v), l)); }
__device__ __forceinline__ float sigm(float x) { return 1.0f / (1.0f + expf(-x)); }

__device__ const double ROPE_REV[64] = {
0.15915494309189535, 0.13782250260398285, 0.11934937021124886, 0.10335229661843406,
0.08949940160889101, 0.07750328875537406, 0.06711508300522726, 0.058119267441876246,
0.050329212104487035, 0.04358330210530733, 0.03774158471741977, 0.032682865872357,
0.0283021958306234, 0.024508691862069852, 0.02122365276477766, 0.018378926105679667,
0.015915494309189534, 0.013782250260398284, 0.011934937021124886, 0.010335229661843406,
0.008949940160889102, 0.0077503288755374055, 0.006711508300522725, 0.005811926744187624,
0.005032921210448704, 0.004358330210530733, 0.003774158471741977, 0.0032682865872356993,
0.00283021958306234, 0.002450869186206985, 0.0021223652764777662, 0.0018378926105679667,
0.0015915494309189536, 0.0013782250260398288, 0.0011934937021124885, 0.0010335229661843405,
0.0008949940160889102, 0.0007750328875537405, 0.0006711508300522726, 0.0005811926744187624,
0.0005032921210448703, 0.0004358330210530733, 0.00037741584717419774, 0.0003268286587235699,
0.00028302195830623395, 0.00024508691862069854, 0.0002122365276477766, 0.00018378926105679666,
0.00015915494309189535, 0.00013782250260398286, 0.00011934937021124886, 0.00010335229661843406,
8.949940160889102e-05, 7.750328875537406e-05, 6.711508300522725e-05, 5.811926744187624e-05,
5.0329212104487035e-05, 4.358330210530732e-05, 3.774158471741978e-05, 3.2682865872357e-05,
2.8302195830623396e-05, 2.4508691862069852e-05, 2.122365276477766e-05, 1.8378926105679668e-05 };

#define XB_TMO      128
#define XB_XCNT(j)  (256  + 64 * (j))
#define XB_XSUB(j)  (1280 + 64 * (j))
#define XB_XGEN(j)  (2304 + 64 * (j))
#define XB_TOP      3328
#define XB_TOPGEN   3392
#define XCD_BAR_WORDS 3456
#define XB_SPIN_CAP (1u << 18)

__device__ __forceinline__ unsigned xb_ld(unsigned* p)              { return __hip_atomic_load(p, __ATOMIC_RELAXED, __HIP_MEMORY_SCOPE_AGENT); }
__device__ __forceinline__ unsigned xb_add(unsigned* p, unsigned v) { return __hip_atomic_fetch_add(p, v, __ATOMIC_RELAXED, __HIP_MEMORY_SCOPE_AGENT); }
__device__ __forceinline__ unsigned xb_xcc_id() { return (unsigned)__builtin_amdgcn_s_getreg((3 << 11) | 20) & 0xFu; }
#define XB_SPIN(cond, bar) do { unsigned _sp = 0; while (cond) { __builtin_amdgcn_s_sleep(1); \
    if ((++_sp & 255u) == 0u) { if (xb_ld(&(bar)[XB_TMO])) break; if (_sp > XB_SPIN_CAP) { atomicAdd(&(bar)[XB_TMO], 1u); break; } } } } while (0)

struct XcdBarrier {
    unsigned* bar; unsigned x;
    volatile LAS unsigned* st;
};

__device__ __forceinline__ XcdBarrier xcd_barrier_post(unsigned* bar, volatile LAS unsigned* st) {
    XcdBarrier b; b.bar = bar; b.x = xb_xcc_id(); b.st = st;
    if (threadIdx.x == 0) (void)xb_add(&bar[XB_XCNT(b.x)], 1u);
    return b;
}
__device__ __forceinline__ void xcd_barrier_complete(unsigned* bar, unsigned x, unsigned& nloc, unsigned& nx) {
    const unsigned G = gridDim.x * gridDim.y * gridDim.z;
    unsigned sum, cnt, mine, sp = 0u;
    for (;;) {
        sum = 0u; cnt = 0u; mine = 0u;
#pragma unroll
        for (unsigned j = 0; j < 16; ++j) { const unsigned c = xb_ld(&bar[XB_XCNT(j)]); sum += c; cnt += (c > 0u) ? 1u : 0u; mine = (j == x) ? c : mine; }
        if (sum == G) break;
        __builtin_amdgcn_s_sleep(1);
        if ((++sp & 255u) == 0u) { if (xb_ld(&bar[XB_TMO])) break; if (sp > XB_SPIN_CAP) { atomicAdd(&bar[XB_TMO], 1u); break; } }
    }
    nloc = mine > 0u ? mine : 1u; nx = cnt > 0u ? cnt : 1u;
}

__device__ __forceinline__ void xcd_barrier(const XcdBarrier& b) {
    asm volatile("s_waitcnt vmcnt(0)" ::: "memory");
    __syncthreads();
    if (threadIdx.x == 0) {
        unsigned* bar = b.bar;
        __builtin_amdgcn_s_waitcnt(0);
        unsigned nloc = b.st[0], nx = b.st[1];
        if (nloc == 0u) { xcd_barrier_complete(bar, b.x, nloc, nx); b.st[0] = nloc; b.st[1] = nx; }
        const unsigned old = xb_add(&bar[XB_XSUB(b.x)], 1u);
        const unsigned gen = old / nloc;
        if (old + 1u == (gen + 1u) * nloc) {
            __builtin_amdgcn_fence(__ATOMIC_RELEASE, "agent");
            asm volatile("s_waitcnt vmcnt(0)" ::: "memory");
            const unsigned og = xb_add(&bar[XB_TOP], 1u);
            const unsigned tg = og / nx;
            if (og + 1u == (tg + 1u) * nx) xb_add(&bar[XB_TOPGEN], 1u);
            else XB_SPIN(xb_ld(&bar[XB_TOPGEN]) == tg, bar);
            __builtin_amdgcn_fence(__ATOMIC_ACQUIRE, "agent");
            xb_add(&bar[XB_XGEN(b.x)], 1u);
            asm volatile("s_waitcnt vmcnt(0)" ::: "memory");
        } else {
            XB_SPIN(xb_ld(&bar[XB_XGEN(b.x)]) == gen, bar);
            __builtin_amdgcn_fence(__ATOMIC_ACQUIRE, "agent");
            asm volatile("s_waitcnt vmcnt(0)" ::: "memory");
        }
    }
    __syncthreads();
}


struct Frame {
    LAS unsigned char* lds;
    volatile LAS unsigned* MISC;
    int tid, lane, wave;
    int vcu, G;
    float* out; unsigned char* ws;
};
struct Args { const float* in[24]; float* out; unsigned char* ws; int ph_lo, ph_hi, li, pad; };
#define WSP(T, off) ((T*)(F.ws + (off)))
#define WSPG(T, off) ((T*)(GAS T*)(unsigned long long)(F.ws + (off)))
#define WSW(l, off) ((bf16*)(F.ws + WS_WSET + (size_t)((l) & 1) * WSET_BYTES + (off)))
#define WSWG(l, off) ((bf16*)(GAS bf16*)(unsigned long long)(F.ws + WS_WSET + (size_t)((l) & 1) * WSET_BYTES + (off)))
#define OUTP ((float*)F.out)
#define OUTPG ((float*)(GAS float*)(unsigned long long)F.out)
#define INP(A, i) ((const float*)((const GAS float*)(A)->in[i]))
#define RETID() do { int t_ = threadIdx.x; asm volatile("" : "+v"(t_)); F.tid = t_; F.lane = t_ & 63; } while (0)
#define CAS __attribute__((address_space(4)))
typedef const CAS Args* ArgP;

__device__ __forceinline__ float fexp(float x) { return __builtin_amdgcn_exp2f(x * 1.4426950408889634f); }
__device__ __forceinline__ float fsig(float x) { return __builtin_amdgcn_rcpf(1.0f + fexp(-x)); }
__device__ __forceinline__ float ftanh(float x) { return 1.0f - 2.0f * __builtin_amdgcn_rcpf(1.0f + fexp(2.0f * x)); }
__device__ __forceinline__ float wave_sum(float v) {
#pragma unroll
    for (int o = 1; o < 64; o <<= 1) v += __shfl_xor(v, o);
    return v;
}
struct TItem { const float* W; bf16* WT; const float* gk; int K, N, item; };
__device__ __forceinline__ void titem_load(const TItem& t, int lane, f32x4 (&v)[8]) {
    const int nblk = t.N / 32, kb = t.item / nblk, nb = t.item % nblk, k0 = 64 * kb, n0 = 32 * nb, nq = lane & 7, kr = lane >> 3;
#pragma unroll
    for (int i = 0; i < 8; ++i) v[i] = __builtin_nontemporal_load((const GAS f32x4*)(t.W + (size_t)(k0 + kr + 8 * i) * t.N + n0 + 4 * nq));
}
__device__ __forceinline__ void titem_finish(const TItem& t, int lane, const f32x4 (&v)[8], LAS float* scr) {
    const int nblk = t.N / 32, kb = t.item / nblk, nb = t.item % nblk, k0 = 64 * kb, n0 = 32 * nb, nq = lane & 7, kr = lane >> 3;
#pragma unroll
    for (int i = 0; i < 8; ++i)
#pragma unroll
        for (int e = 0; e < 4; ++e) scr[(kr + 8 * i) * 33 + 4 * nq + e] = v[i][e];
    const int c = lane & 7;
    f32x4 g0 = (f32x4){1.f, 1.f, 1.f, 1.f}, g1 = g0;
    if (t.gk) { g0 = *(const GAS f32x4*)(t.gk + k0 + 8 * c); g1 = *(const GAS f32x4*)(t.gk + k0 + 8 * c + 4); }
    LDS_WAIT(); asm volatile("" ::: "memory");
#pragma unroll
    for (int j = 0; j < 4; ++j) { const int n = (lane >> 3) + 8 * j; const LAS float* s = scr + (8 * c) * 33 + n;
        v4u o; o.x = pk2(s[0 * 33] * g0.x, s[1 * 33] * g0.y); o.y = pk2(s[2 * 33] * g0.z, s[3 * 33] * g0.w); o.z = pk2(s[4 * 33] * g1.x, s[5 * 33] * g1.y); o.w = pk2(s[6 * 33] * g1.z, s[7 * 33] * g1.w);
        __builtin_nontemporal_store(o, (GAS v4u*)(t.WT + (size_t)(n0 + n) * t.K + k0 + 8 * c)); }
    LDS_WAIT(); asm volatile("" ::: "memory");
}
__device__ __forceinline__ void rms_row_to_bf16(const float* xrow, const float* g, bf16* orow, int lane) {
    const GAS f32x4* xr = (const GAS f32x4*)xrow + lane;
    f32x4 v[8]; float s = 0.f;
#pragma unroll
    for (int j = 0; j < 8; ++j) { v[j] = xr[64 * j]; s += (v[j].x * v[j].x + v[j].y * v[j].y) + (v[j].z * v[j].z + v[j].w * v[j].w); }
    const float rstd = 1.f / sqrtf(wave_sum(s) * (1.f / D) + NORM_EPS);
    const GAS f32x4* gr = (const GAS f32x4*)g + lane;
    GAS v2u* o8 = (GAS v2u*)orow + lane;
#pragma unroll
    for (int j = 0; j < 8; ++j) { const f32x4 gg = gr[64 * j]; v2u o; o.x = pk2(v[j].x * rstd * gg.x, v[j].y * rstd * gg.y); o.y = pk2(v[j].z * rstd * gg.z, v[j].w * rstd * gg.w); o8[64 * j] = o; }
}

__device__ __forceinline__ void fill_rstd(Frame& F, int row0, int nrows) {
    int t_ = threadIdx.x; asm volatile("" : "+v"(t_));
    LAS float* T = (LAS float*)(F.lds + RSTD_OFF);
    for (int r = t_; r < nrows; r += NWAVES * 64) {
        const GAS f32x4* sp = (const GAS f32x4*)(WSPG(float, WS_SS) + (size_t)(row0 + r) * 32);
        f32x4 a = sp[0];
#pragma unroll
        for (int j = 1; j < 8; ++j) a = a + sp[j];
        T[r] = __builtin_amdgcn_rsqf(((a[0] + a[1]) + (a[2] + a[3])) * (1.0f / D) + NORM_EPS);
    }
    __syncthreads();
}
#if (MK_GLOBAL_GROUPS & 1)
#pragma push_macro("WSP")
#pragma push_macro("WSW")
#pragma push_macro("OUTP")
#undef WSP
#undef WSW
#undef OUTP
#define WSP WSPG
#define WSW WSWG
#define OUTP OUTPG
#endif
__device__ __forceinline__ void ph_prologue(Frame& F, ArgP A) {
    const int* pos = (const int*)INP(A, 1); float2* rope = WSP(float2, WS_ROPE);
    {
        const int gw = F.vcu * NWAVES + F.wave, NGW = F.G * NWAVES, lane = F.lane;
        auto load_row = [&](f32x4 (&v)[8], int m) { if (m >= M) m = M - 1; const GAS f32x4* xr = (const GAS f32x4*)(INP(A, 0) + (size_t)m * D) + lane;
#pragma unroll
            for (int j = 0; j < 8; ++j) v[j] = xr[64 * j]; };
        auto do_row = [&](const f32x4 (&v)[8], int m) {
            GAS v2u* hb = (GAS v2u*)(WSP(bf16, WS_H) + (size_t)m * D) + lane; float s = 0.f;
#pragma unroll
            for (int j = 0; j < 8; ++j) { v2u o; o.x = pk2(v[j].x, v[j].y); o.y = pk2(v[j].z, v[j].w); hb[64 * j] = o; s += (v[j].x * v[j].x + v[j].y * v[j].y) + (v[j].z * v[j].z + v[j].w * v[j].w); }
            s = wave_sum(s);
            if (lane < 32) WSP(float, WS_SS)[(size_t)m * 32 + lane] = lane == 0 ? s : 0.f; };
        f32x4 va[8], vb[8];
        if (gw < M) load_row(va, gw);
        for (int m = gw; m < M; m += 2 * NGW) {
            load_row(vb, m + NGW); do_row(va, m);
            if (m + NGW >= M) break;
            load_row(va, m + 2 * NGW); do_row(vb, m + NGW);
        }
    }
    for (int i = F.vcu * 512 + F.tid; i < M * 64; i += F.G * 512) {
        const int m = i >> 6, j = i & 63;
        const double rev = (double)pos[m] * ROPE_REV[j];
        const float fr = (float)(rev - __builtin_rint(rev));
        rope[i] = make_float2(__builtin_amdgcn_cosf(fr), __builtin_amdgcn_sinf(fr));
    }
}
#if (MK_GLOBAL_GROUPS & 1)
#pragma pop_macro("WSP")
#pragma pop_macro("WSW")
#pragma pop_macro("OUTP")
#endif
#if (MK_GLOBAL_GROUPS & 16)
#pragma push_macro("WSP")
#pragma push_macro("WSW")
#pragma push_macro("OUTP")
#undef WSP
#undef WSW
#undef OUTP
#define WSP WSPG
#define WSW WSWG
#define OUTP OUTPG
#endif
__device__ __forceinline__ TItem conv_item(Frame& F, ArgP A, int l, int it) {
    constexpr int I_IN = (D / 64) * (INW / 32), I_A = (RETW / 64) * (D / 32), I_O = (D / 64) * (D / 32), I_UP = (D / 64) * (DFF / 32), I_DN = (DFF / 64) * (D / 32);
    int r = it; TItem t;
    if (r < I_IN) { t = TItem{INP(A, 3) + (size_t)l * D * INW, WSW(l, WO_WIN), INP(A, 2) + (size_t)l * D, D, INW, r}; return t; } r -= I_IN;
    if (r < I_A) { t = TItem{INP(A, 17) + (size_t)l * RETW * D, WSW(l, WO_WA), nullptr, RETW, D, r}; return t; } r -= I_A;
    if (r < I_A) { t = TItem{INP(A, 18) + (size_t)l * RWW * D, WSW(l, WO_WB), nullptr, RWW, D, r}; return t; } r -= I_A;
    if (r < I_O) { t = TItem{INP(A, 19) + (size_t)l * D * D, WSW(l, WO_WO), nullptr, D, D, r}; return t; } r -= I_O;
    if (r < I_UP) { t = TItem{INP(A, 21) + (size_t)l * D * DFF, WSW(l, WO_WUP), INP(A, 20) + (size_t)l * D, D, DFF, r}; return t; } r -= I_UP;
    if (r < I_DN) { t = TItem{INP(A, 22) + (size_t)l * DFF * D, WSW(l, WO_WDN), nullptr, DFF, D, r}; return t; } r -= I_DN;
    if (r < 32) { t = TItem{INP(A, 8) + (size_t)l * 64 * RWW, WSW(l, WO_LORA), nullptr, 64, RWW, r}; return t; } r -= 32;
    if (r < 32) { t = TItem{INP(A, 10) + (size_t)l * 64 * RWW, WSW(l, WO_LORA) + 1024 * 64, nullptr, 64, RWW, r}; return t; } r -= 32;
    t = TItem{INP(A, 11) + (size_t)l * 128 * RWW, WSW(l, WO_LORA) + 2 * 1024 * 64, nullptr, 128, RWW, r}; return t;
}
constexpr int CONV_NITEMS = (D / 64) * (INW / 32) + 2 * (RETW / 64) * (D / 32) + (D / 64) * (D / 32) + (D / 64) * (DFF / 32) + (DFF / 64) * (D / 32) + 32 + 32 + 64;
constexpr int CONV_SPLIT = (int)((long)CONV_NITEMS * (100 - MK_CONV_X2_PCT) / 100);
__device__ __forceinline__ void ph_convert(Frame& F, ArgP A, int l, int wg, int nwg, int lo = 0, int hi = CONV_NITEMS) {
    LAS float* scr = (LAS float*)(F.lds + RING_OFF + F.wave * 16384);
    const int gw = lo + wg * NWAVES + F.wave, NGW = nwg * NWAVES, lane = F.lane;
    if (gw >= hi) return;
    TItem cur = conv_item(F, A, l, gw); f32x4 va[8], vb[8];
    titem_load(cur, lane, va);
    for (int it = gw; it < hi; it += 2 * NGW) {
        TItem nxt = cur; const bool h1 = it + NGW < hi;
        if (h1) { nxt = conv_item(F, A, l, it + NGW); titem_load(nxt, lane, vb); }
        titem_finish(cur, lane, va, scr);
        if (!h1) break;
        const bool h2 = it + 2 * NGW < hi;
        if (h2) { cur = conv_item(F, A, l, it + 2 * NGW); titem_load(cur, lane, va); }
        titem_finish(nxt, lane, vb, scr);
        if (!h2) break;
    }
}
#if (MK_GLOBAL_GROUPS & 16)
#pragma pop_macro("WSP")
#pragma pop_macro("WSW")
#pragma pop_macro("OUTP")
#endif
#if (MK_GLOBAL_GROUPS & 2)
#pragma push_macro("WSP")
#pragma push_macro("WSW")
#pragma push_macro("OUTP")
#undef WSP
#undef WSW
#undef OUTP
#define WSP WSPG
#define WSW WSWG
#define OUTP OUTPG
#endif
__device__ __forceinline__ f32x4 unpk4(const v2u p) { return (f32x4){pg8::bf_lo(p.x), pg8::bf_hi(p.x), pg8::bf_lo(p.y), pg8::bf_hi(p.y)}; }
__device__ __forceinline__ void unpack8(const v4u a, float (&o)[8]) {
    o[0] = pg8::bf_lo(a.x); o[1] = pg8::bf_hi(a.x); o[2] = pg8::bf_lo(a.y); o[3] = pg8::bf_hi(a.y); o[4] = pg8::bf_lo(a.z); o[5] = pg8::bf_hi(a.z); o[6] = pg8::bf_lo(a.w); o[7] = pg8::bf_hi(a.w);
}
__device__ __forceinline__ void mix8(const GAS bf16* zc, bool has_prev, const GAS float* mu, float (&o)[8]) {
    const v4u a = *(const GAS v4u*)zc; v4u p = (v4u){0u, 0u, 0u, 0u}; if (has_prev) p = *(const GAS v4u*)(zc - INW);
    const f32x4 m0 = *(const GAS f32x4*)mu, m1 = *(const GAS f32x4*)(mu + 4);
    float z[8], q[8]; unpack8(a, z); unpack8(p, q);
#pragma unroll
    for (int j = 0; j < 4; ++j) { o[j] = z[j] + m0[j] * (q[j] - z[j]); o[4 + j] = z[4 + j] + m1[j] * (q[4 + j] - z[4 + j]); }
}
__device__ __forceinline__ f32x4 mix4(const GAS bf16* zc, bool has_prev, const GAS float* mu) {
    const v2u a = *(const GAS v2u*)zc; v2u p = (v2u){0u, 0u}; if (has_prev) p = *(const GAS v2u*)(zc - INW);
    const f32x4 m = *(const GAS f32x4*)mu;
    const f32x4 z = (f32x4){pg8::bf_lo(a.x), pg8::bf_hi(a.x), pg8::bf_lo(a.y), pg8::bf_hi(a.y)}, q = (f32x4){pg8::bf_lo(p.x), pg8::bf_hi(p.x), pg8::bf_lo(p.y), pg8::bf_hi(p.y)};
    return z + m * (q - z);
}
__device__ __forceinline__ bf16x8 pack8(const float (&v)[8]) {
    v4u o; o.x = pg8::cvt_pk_bf16(v[0], v[1]); o.y = pg8::cvt_pk_bf16(v[2], v[3]); o.z = pg8::cvt_pk_bf16(v[4], v[5]); o.w = pg8::cvt_pk_bf16(v[6], v[7]);
    return __builtin_bit_cast(bf16x8, o);
}
constexpr int CU_W = 0, CU_R = 2048, CU_BK = 4096, CU_LRB = 8192, CU_PC = 8704, CU_QB = 8960, CU_QSTR = 1536, CU_BYTES = CU_QB + 4 * CU_QSTR;
constexpr int CK = 16, NCHUNK = SEQ / CK;
constexpr int XL_STR = 144, XL_MAT = 16 * XL_STR;
typedef short s4v __attribute__((ext_vector_type(4)));
__device__ __forceinline__ s4v pk4(const f32x4 v) { v2u o; o.x = pg8::cvt_pk_bf16(v[0], v[1]); o.y = pg8::cvt_pk_bf16(v[2], v[3]); return __builtin_bit_cast(s4v, o); }
__device__ __forceinline__ bf16x8 pk8v(const f32x4 a, const f32x4 b) { v4u o; o.x = pg8::cvt_pk_bf16(a[0], a[1]); o.y = pg8::cvt_pk_bf16(a[2], a[3]); o.z = pg8::cvt_pk_bf16(b[0], b[1]); o.w = pg8::cvt_pk_bf16(b[2], b[3]); return __builtin_bit_cast(bf16x8, o); }
__device__ __forceinline__ f32x4 mma16(const s4v x, const s4v y, const f32x4 c) {
    const bf16x8 x8 = (bf16x8){x.x, x.y, x.z, x.w, 0, 0, 0, 0}, y8 = (bf16x8){y.x, y.y, y.z, y.w, 0, 0, 0, 0};
    return __builtin_amdgcn_mfma_f32_16x16x32_bf16(x8, y8, c, 0, 0, 0); }
__device__ __forceinline__ f32x4 mma32(const bf16x8 x, const bf16x8 y, const f32x4 c) { return __builtin_amdgcn_mfma_f32_16x16x32_bf16(x, y, c, 0, 0, 0); }
template <int N> __device__ __forceinline__ float dpp_shr0(float x) { return __builtin_bit_cast(float, __builtin_amdgcn_update_dpp(0, __builtin_bit_cast(int, x), 0x110 + N, 0xF, 0xF, true)); }
__device__ __forceinline__ float scan16(float x) { x += dpp_shr0<1>(x); x += dpp_shr0<2>(x); x += dpp_shr0<4>(x); x += dpp_shr0<8>(x); return x; }
__device__ __forceinline__ s4v trd(const LAS unsigned char* p) { return __builtin_amdgcn_ds_read_tr16_b64_v4i16((LAS s4v*)p); }
__device__ __forceinline__ void chunk_ops(const f32x4 (&r)[4], const f32x4 (&lw)[4], const f32x4 (&kp)[4], const f32x4 (&v)[4], const f32x4 (&a)[4], const f32x4 (&b)[4],
                                          LAS unsigned char* scr, GAS unsigned char* rec, int lane) {
    const int l15 = lane & 15, g = lane >> 4, tq = l15 >> 2, tp = l15 & 3;
    const f32x4 Z4 = (f32x4){0.f, 0.f, 0.f, 0.f};
    f32x4 Rt[4], pc[4]; bf16x8 Atf[2], Btf[2], Ktf[2], Rtf[2];
    {
        s4v Ah[4], Bq[4], Kq[4], Rq[4];
#pragma unroll
        for (int nt = 0; nt < 4; ++nt) {
            f32x4 cs, tot;
#pragma unroll
            for (int i = 0; i < 4; ++i) { cs[i] = scan16(lw[nt][i]); tot[i] = __shfl(cs[i], lane | 15); }
            f32x4 At, Bt, Kt, Bh, Kh;
#pragma unroll
            for (int i = 0; i < 4; ++i) { const float P = fexp(cs[i]), Pm1 = fexp(cs[i] - lw[nt][i]), iP = fexp(-cs[i]), PCP = fexp(tot[i] - cs[i]);
                pc[nt][i] = fexp(tot[i]); At[i] = a[nt][i] * Pm1; Bt[i] = b[nt][i] * iP; Kt[i] = kp[nt][i] * iP; Rt[nt][i] = r[nt][i] * P; Bh[i] = b[nt][i] * PCP; Kh[i] = kp[nt][i] * PCP; }
            Ah[nt] = pk4(At); Bq[nt] = pk4(Bt); Kq[nt] = pk4(Kt); Rq[nt] = pk4(Rt[nt]);
            LAS unsigned char* w = scr + l15 * XL_STR + (16 * nt + 4 * g) * 2;
            *(LAS s4v*)(w + 0 * XL_MAT) = Ah[nt]; *(LAS s4v*)(w + 1 * XL_MAT) = pk4(v[nt]); *(LAS s4v*)(w + 2 * XL_MAT) = pk4(Bh); *(LAS s4v*)(w + 3 * XL_MAT) = pk4(Kh);
        }
#pragma unroll
        for (int s = 0; s < 2; ++s) {
            Atf[s] = (bf16x8){Ah[2 * s].x, Ah[2 * s].y, Ah[2 * s].z, Ah[2 * s].w, Ah[2 * s + 1].x, Ah[2 * s + 1].y, Ah[2 * s + 1].z, Ah[2 * s + 1].w};
            Btf[s] = (bf16x8){Bq[2 * s].x, Bq[2 * s].y, Bq[2 * s].z, Bq[2 * s].w, Bq[2 * s + 1].x, Bq[2 * s + 1].y, Bq[2 * s + 1].z, Bq[2 * s + 1].w};
            Ktf[s] = (bf16x8){Kq[2 * s].x, Kq[2 * s].y, Kq[2 * s].z, Kq[2 * s].w, Kq[2 * s + 1].x, Kq[2 * s + 1].y, Kq[2 * s + 1].z, Kq[2 * s + 1].w};
            Rtf[s] = (bf16x8){Rq[2 * s].x, Rq[2 * s].y, Rq[2 * s].z, Rq[2 * s].w, Rq[2 * s + 1].x, Rq[2 * s + 1].y, Rq[2 * s + 1].z, Rq[2 * s + 1].w}; }
    }
    f32x4 LabR = Z4, LabT = Z4, LakT = Z4, LrbT = Z4, LrkT = Z4;
#pragma unroll
    for (int s = 0; s < 2; ++s) { LabR = mma32(Atf[s], Btf[s], LabR); LabT = mma32(Btf[s], Atf[s], LabT); LakT = mma32(Ktf[s], Atf[s], LakT); LrbT = mma32(Btf[s], Rtf[s], LrbT); LrkT = mma32(Ktf[s], Rtf[s], LrkT); }
    f32x4 IR;
#pragma unroll
    for (int i = 0; i < 4; ++i) { const int tt = 4 * g + i;
        IR[i] = (tt == l15) ? 1.f : 0.f;
        LabR[i] = (tt > l15) ? LabR[i] : 0.f; LabT[i] = (l15 > tt) ? LabT[i] : 0.f; LakT[i] = (l15 > tt) ? LakT[i] : 0.f;
        LrbT[i] = (l15 >= tt) ? LrbT[i] : 0.f; LrkT[i] = (l15 >= tt) ? LrkT[i] : 0.f; }
    const s4v L1R = pk4(LabR), L1T = pk4(LabT);
    const f32x4 L2R = mma16(L1T, L1R, Z4), L2T = mma16(L1R, L1T, Z4);
    const s4v L2Rp = pk4(L2R), L2Tp = pk4(L2T);
    const f32x4 L4R = mma16(L2Tp, L2Rp, Z4), L4T = mma16(L2Rp, L2Tp, Z4);
    const s4v L4Rp = pk4(L4R), L4Tp = pk4(L4T);
    const f32x4 L8R = mma16(L4Tp, L4Rp, Z4);
    const f32x4 T1T = mma16(pk4(IR + L2R), pk4(IR + LabT), Z4);
    const f32x4 T2T = mma16(pk4(IR + L4R), pk4(T1T), Z4);
    const s4v TmT = pk4(mma16(pk4(IR + L8R), pk4(T2T), Z4));
    const s4v LakTp = pk4(LakT), LrbTp = pk4(LrbT), LrkTp = pk4(LrkT);
    asm volatile("s_waitcnt lgkmcnt(0)" ::: "memory");
    const LAS unsigned char* tb = scr + (4 * g + tq) * XL_STR + (4 * tp) * 2;
    s4v tAt[4], tV[4], tBh[4], tKh[4];
#pragma unroll
    for (int t = 0; t < 4; ++t) { tAt[t] = trd(tb + 0 * XL_MAT + 32 * t); tV[t] = trd(tb + 1 * XL_MAT + 32 * t); tBh[t] = trd(tb + 2 * XL_MAT + 32 * t); tKh[t] = trd(tb + 3 * XL_MAT + 32 * t); }
#pragma unroll
    for (int t = 0; t < 4; ++t) {
        const f32x4 G = mma16(LakTp, tV[t], Z4);
        const f32x4 U0 = mma16(TmT, pk4(G), Z4);
        const f32x4 YV = mma16(LrkTp, tV[t], Z4);
        GAS unsigned char* rq = rec + CU_QB + t * CU_QSTR + lane * 8;
        *(GAS s4v*)(rq) = pk4(U0); *(GAS s4v*)(rq + 512) = tV[t]; *(GAS s4v*)(rq + 1024) = pk4(YV); }
    {
        f32x4 Wn[4];
#pragma unroll
        for (int ct = 0; ct < 4; ++ct) Wn[ct] = mma16(tAt[ct], TmT, Z4);
        *(GAS bf16x8*)(rec + CU_W + 0 * 1024 + lane * 16) = pk8v(Wn[0], Wn[1]); *(GAS bf16x8*)(rec + CU_W + 1 * 1024 + lane * 16) = pk8v(Wn[2], Wn[3]);
        *(GAS bf16x8*)(rec + CU_R + 0 * 1024 + lane * 16) = pk8v(Rt[0], Rt[1]); *(GAS bf16x8*)(rec + CU_R + 1 * 1024 + lane * 16) = pk8v(Rt[2], Rt[3]);
    }
#pragma unroll
    for (int tl = 0; tl < 4; ++tl)
        *(GAS bf16x8*)(rec + CU_BK + tl * 1024 + lane * 16) = (bf16x8){tBh[tl].x, tBh[tl].y, tBh[tl].z, tBh[tl].w, tKh[tl].x, tKh[tl].y, tKh[tl].z, tKh[tl].w};
    *(GAS s4v*)(rec + CU_LRB + lane * 8) = LrbTp;
    if (l15 == 0) {
#pragma unroll
        for (int nt = 0; nt < 4; ++nt) *(GAS f32x4*)(rec + CU_PC + (16 * nt + 4 * g) * 4) = pc[nt]; }
}
__device__ __forceinline__ void ph_prep(Frame& F, ArgP A, int l) {
    const int gw = F.vcu * NWAVES + F.wave, NGW = F.G * NWAVES, lane = F.lane, l15 = lane & 15, g = lane >> 4;
    {
        const int h = lane >> 3, i0 = 8 * (lane & 7);
        int nrr_ = (MK_REP & 1024) ? 2 : 1; asm volatile("" : "+s"(nrr_));
#pragma unroll 1
        for (int rr_ = 0; rr_ < nrr_; ++rr_)
        for (int m0 = gw; m0 < M; m0 += 2 * NGW) {
            const int m1 = m0 + NGW < M ? m0 + NGW : m0;
            v4u zq[2][2], zk[2][2]; f32x4 rp4[2][4];
#pragma unroll
            for (int u = 0; u < 2; ++u) { const int m = u ? m1 : m0;
                const GAS bf16* zrow = (const GAS bf16*)(WSP(bf16, WS_Z) + (size_t)m * INW);
                const GAS f32x4* rp = (const GAS f32x4*)(WSP(float2, WS_ROPE) + (size_t)m * 64 + i0);
                rp4[u][0] = rp[0]; rp4[u][1] = rp[1]; rp4[u][2] = rp[2]; rp4[u][3] = rp[3];
                zq[u][0] = *(const GAS v4u*)(zrow + ZC_Q + h * RD + i0); zq[u][1] = *(const GAS v4u*)(zrow + ZC_Q + h * RD + 64 + i0);
                zk[u][0] = *(const GAS v4u*)(zrow + ZC_K + h * RD + i0); zk[u][1] = *(const GAS v4u*)(zrow + ZC_K + h * RD + 64 + i0); }
#pragma unroll
            for (int u = 0; u < 2; ++u) { const int m = u ? m1 : m0;
                const f32x4 c01 = rp4[u][0], c23 = rp4[u][1], c45 = rp4[u][2], c67 = rp4[u][3];
                const float cs[8] = {c01.x, c01.z, c23.x, c23.z, c45.x, c45.z, c67.x, c67.z}, sn[8] = {c01.y, c01.w, c23.y, c23.w, c45.y, c45.w, c67.y, c67.w};
                float q1[8], q2[8], k1[8], k2[8], o1[8], o2[8];
                unpack8(zq[u][0], q1); unpack8(zq[u][1], q2); unpack8(zk[u][0], k1); unpack8(zk[u][1], k2);
#pragma unroll
                for (int j = 0; j < 8; ++j) { o1[j] = q1[j] * cs[j] - q2[j] * sn[j]; o2[j] = q2[j] * cs[j] + q1[j] * sn[j]; }
                GAS bf16* qo = (GAS bf16*)(WSP(bf16, WS_QR) + (size_t)m * RETW + h * RD + i0);
                *(GAS bf16x8*)qo = pack8(o1); *(GAS bf16x8*)(qo + 64) = pack8(o2);
#pragma unroll
                for (int j = 0; j < 8; ++j) { const float a = k1[j] * 0.08838834764831845f, b = k2[j] * 0.08838834764831845f; o1[j] = a * cs[j] - b * sn[j]; o2[j] = b * cs[j] + a * sn[j]; }
                GAS bf16* ko = (GAS bf16*)(WSP(bf16, WS_KR) + (size_t)m * RETW + h * RD + i0);
                *(GAS bf16x8*)ko = pack8(o1); *(GAS bf16x8*)(ko + 64) = pack8(o2); }
        }
    }
    const GAS float* mu = (const GAS float*)(INP(A, 6) + (size_t)l * RWSHIFT);
    const GAS float* w0 = (const GAS float*)(INP(A, 7) + (size_t)l * RWW); const GAS float* a0 = (const GAS float*)(INP(A, 9) + (size_t)l * RWW);
    const GAS float* kkw = (const GAS float*)(INP(A, 12) + (size_t)l * RWW); const GAS float* kaw = (const GAS float*)(INP(A, 13) + (size_t)l * RWW); const GAS float* rkw = (const GAS float*)(INP(A, 14) + (size_t)l * RWW);
    const GAS bf16* WupT = (const GAS bf16*)WSW(l, WO_LORA); const GAS bf16* AupT = WupT + 1024 * 64; const GAS bf16* GupT = AupT + 1024 * 64;
    constexpr int PP_OFF = 8 * 10240;
    LAS float* PP = (LAS float*)(F.lds + RING_OFF + PP_OFF);
    __syncthreads();
    for (int i = F.tid; i < 2048; i += NWAVES * 64) { const int arr = i >> 8, off = (i & 255) * 4;
        const GAS float* src = arr < 3 ? mu + arr * 1024 : (arr == 3 ? w0 : (arr == 4 ? a0 : (arr == 5 ? kkw : (arr == 6 ? kaw : rkw))));
        *(LAS f32x4*)(PP + arr * 1024 + off) = *(const GAS f32x4*)(src + off); }
    __syncthreads();
    int nrw_ = (MK_REP & 2048) ? 2 : 1; asm volatile("" : "+s"(nrw_));
#pragma unroll 1
    for (int rw_ = 0; rw_ < nrw_; ++rw_)
    for (int task = gw; task < M / 8; task += NGW) {
        const int wgv = task >> 3, tile = (wgv >> 1) * 8 + (task & 7), half = wgv & 1;
        const int m = tile * 16 + l15, hh0 = half * (WH / 2);
        const bool has_prev = (m % SEQ) != 0;
        const GAS bf16* zr = (const GAS bf16*)(WSP(bf16, WS_Z) + (size_t)m * INW + ZC_RW);
        bf16x8 fw[2], fa[2], fg[4];
#pragma unroll
        for (int ks = 0; ks < 2; ++ks) { float t[8];
            mix8(zr + RWC_W + 32 * ks + 8 * g, has_prev, mu + RWC_W + 32 * ks + 8 * g, t);
#pragma unroll
            for (int j = 0; j < 8; ++j) t[j] = ftanh(t[j]);
            fw[ks] = pack8(t);
            mix8(zr + RWC_A + 32 * ks + 8 * g, has_prev, mu + RWC_A + 32 * ks + 8 * g, t); fa[ks] = pack8(t); }
#pragma unroll
        for (int ks = 0; ks < 4; ++ks) { float t[8];
            mix8(zr + RWC_G + 32 * ks + 8 * g, has_prev, mu + RWC_G + 32 * ks + 8 * g, t);
#pragma unroll
            for (int j = 0; j < 8; ++j) t[j] = fsig(t[j]);
            fg[ks] = pack8(t); }
        const GAS bf16* zq = has_prev ? zr - INW : zr;
        for (int hh = hh0; hh < hh0 + WH / 2; ++hh) {
            f32x4 kkr[4], av[4], rr[4], lwv[4], kpv[4], vv[4]; float ss = 0.f, bonus = 0.f;
            const int cb = hh * WD + 4 * g;
            {
                v2u zc[3][4], zp[3][4];
#pragma unroll
                for (int a3 = 0; a3 < 3; ++a3)
#pragma unroll
                    for (int nt = 0; nt < 4; ++nt) { zc[a3][nt] = *(const GAS v2u*)(zr + a3 * 1024 + cb + 16 * nt); zp[a3][nt] = *(const GAS v2u*)(zq + a3 * 1024 + cb + 16 * nt); }
#pragma unroll
                for (int nt = 0; nt < 4; ++nt) {
#pragma unroll
                    for (int a3 = 0; a3 < 3; ++a3) { const f32x4 z = unpk4(zc[a3][nt]); f32x4 p = unpk4(zp[a3][nt]); if (!has_prev) p = (f32x4){0.f, 0.f, 0.f, 0.f};
                        const f32x4 mx = z + *(const LAS f32x4*)(PP + a3 * 1024 + cb + 16 * nt) * (p - z);
                        if (a3 == 0) rr[nt] = mx; else if (a3 == 1) kpv[nt] = mx; else vv[nt] = mx; }
                }
            }
            bf16x8 wf[2][2], af[2][2], gf[2][4];
#define PREP_WFRAGS(nt_, k_) do { const int cf_ = hh * WD + (nt_) * 16 + l15; \
            _Pragma("unroll") for (int ks = 0; ks < 2; ++ks) { wf[k_][ks] = *(const GAS bf16x8*)(WupT + (size_t)cf_ * 64 + 32 * ks + 8 * g); af[k_][ks] = *(const GAS bf16x8*)(AupT + (size_t)cf_ * 64 + 32 * ks + 8 * g); } \
            _Pragma("unroll") for (int ks = 0; ks < 4; ++ks) gf[k_][ks] = *(const GAS bf16x8*)(GupT + (size_t)cf_ * 128 + 32 * ks + 8 * g); } while (0)
            PREP_WFRAGS(0, 0);
#pragma unroll
            for (int nt = 0; nt < 4; ++nt) {
                const int c0 = cb + 16 * nt, cs_ = nt & 1;
                if (nt + 1 < 4) PREP_WFRAGS(nt + 1, (cs_ ^ 1));
                f32x4 wl = *(const LAS f32x4*)(PP + 3 * 1024 + c0), al = *(const LAS f32x4*)(PP + 4 * 1024 + c0), gl = (f32x4){0.f, 0.f, 0.f, 0.f};
#pragma unroll
                for (int ks = 0; ks < 2; ++ks) { wl = __builtin_amdgcn_mfma_f32_16x16x32_bf16(wf[cs_][ks], fw[ks], wl, 0, 0, 0); al = __builtin_amdgcn_mfma_f32_16x16x32_bf16(af[cs_][ks], fa[ks], al, 0, 0, 0); }
#pragma unroll
                for (int ks = 0; ks < 4; ++ks) gl = __builtin_amdgcn_mfma_f32_16x16x32_bf16(gf[cs_][ks], fg[ks], gl, 0, 0, 0);
                const f32x4 r = rr[nt], k = kpv[nt], v = vv[nt];
                const f32x4 kk4 = *(const LAS f32x4*)(PP + 5 * 1024 + c0), ka4 = *(const LAS f32x4*)(PP + 6 * 1024 + c0), rk4 = *(const LAS f32x4*)(PP + 7 * 1024 + c0);
                f32x4 lwd, a, kp;
#pragma unroll
                for (int i = 0; i < 4; ++i) {
                    lwd[i] = -0.6065306597126334f * fsig(wl[i]);
                    a[i] = fsig(al[i]);
                    kp[i] = k[i] * (1.0f + (a[i] - 1.0f) * ka4[i]);
                }
                kkr[nt] = k * kk4; av[nt] = a; lwv[nt] = lwd; kpv[nt] = kp;
                ss += (kkr[nt].x * kkr[nt].x + kkr[nt].y * kkr[nt].y) + (kkr[nt].z * kkr[nt].z + kkr[nt].w * kkr[nt].w);
                const f32x4 rb = r * kp * rk4; bonus += (rb.x + rb.y) + (rb.z + rb.w);
                const size_t o = (size_t)m * RWW + c0;
#if MK_CHUNKED
                *(GAS s4v*)(WSP(bf16, WS_SV) + o) = pk4(v); *(GAS s4v*)(WSP(bf16, WS_G) + o) = pk4(gl);
#else
                f32x4 decay;
#pragma unroll
                for (int i = 0; i < 4; ++i) decay[i] = fexp(lwd[i]);
                *(GAS f32x4*)(WSP(float, WS_SR) + o) = r; *(GAS f32x4*)(WSP(float, WS_SW) + o) = decay; *(GAS f32x4*)(WSP(float, WS_SK) + o) = kp;
                *(GAS f32x4*)(WSP(float, WS_SV) + o) = v; *(GAS f32x4*)(WSP(float, WS_G) + o) = gl;
#endif
            }
#undef PREP_WFRAGS
            ss += __shfl_xor(ss, 16); ss += __shfl_xor(ss, 32); bonus += __shfl_xor(bonus, 16); bonus += __shfl_xor(bonus, 32);
            const float inv = 1.0f / fmaxf(sqrtf(ss), 1e-12f);
            if (g == 0) WSP(float, WS_BONUS)[(size_t)m * WH + hh] = bonus;
#if MK_CHUNKED
            f32x4 aa[4], bb[4];
#pragma unroll
            for (int nt = 0; nt < 4; ++nt) { const f32x4 kk = kkr[nt] * inv; aa[nt] = -kk; bb[nt] = kk * av[nt]; }
            GAS unsigned char* rec = (GAS unsigned char*)WSP(unsigned char, WS_CU) + ((size_t)((tile / NCHUNK) * WH + hh) * NCHUNK + (tile % NCHUNK)) * CU_BYTES;
            chunk_ops(rr, lwv, kpv, vv, aa, bb, F.lds + RING_OFF + F.wave * 10240, rec, lane);
#else
#pragma unroll
            for (int nt = 0; nt < 4; ++nt) { const size_t o = (size_t)m * RWW + hh * WD + nt * 16 + 4 * g; const f32x4 kk = kkr[nt] * inv;
                *(GAS f32x4*)(WSP(float, WS_SNKK) + o) = -kk; *(GAS f32x4*)(WSP(float, WS_SKKA) + o) = kk * av[nt]; }
#endif
        }
    }
}
#if (MK_GLOBAL_GROUPS & 2)
#pragma pop_macro("WSP")
#pragma pop_macro("WSW")
#pragma pop_macro("OUTP")
#endif
#if (MK_GLOBAL_GROUPS & 4)
#pragma push_macro("WSP")
#pragma push_macro("WSW")
#pragma push_macro("OUTP")
#undef WSP
#undef WSW
#undef OUTP
#define WSP WSPG
#define WSW WSWG
#define OUTP OUTPG
#endif
#if !MK_CHUNKED
__device__ __forceinline__ void scan_rwkv_naive(Frame& F, int item) {
    const int lane = F.lane;
    float st[64];
#pragma unroll
    for (int j = 0; j < 64; ++j) st[j] = 0.f;
    const size_t base0 = (size_t)(item >> 4) * SEQ * RWW + (size_t)(item & 15) * WD + lane;
    for (int t = 0; t < SEQ; ++t) {
        const size_t o = base0 + (size_t)t * RWW;
        const float r = WSP(float, WS_SR)[o], w = WSP(float, WS_SW)[o], k = WSP(float, WS_SK)[o], v = WSP(float, WS_SV)[o], nk = WSP(float, WS_SNKK)[o], ka = WSP(float, WS_SKKA)[o];
        float sa = 0.f;
#pragma unroll
        for (int j = 0; j < 64; ++j) sa += st[j] * rdlane(nk, j);
        float y = 0.f;
#pragma unroll
        for (int j = 0; j < 64; ++j) { st[j] = st[j] * rdlane(w, j) + sa * rdlane(ka, j) + v * rdlane(k, j); y += st[j] * rdlane(r, j); }
        WSP(float, WS_YRAWW)[o] = y;
    }
}
#endif
__device__ __forceinline__ void scan_ret_naive(Frame& F, int item) {
    const int lane = F.lane, b = item >> 4, h = (item >> 1) & 7, half = item & 1;
    const float gam = 1.0f - exp2f((float)(-5 - h));
    float R[128];
#pragma unroll
    for (int j = 0; j < 128; ++j) R[j] = 0.f;
    for (int t = 0; t < SEQ; ++t) {
        const size_t m = (size_t)b * SEQ + t;
        const float q1 = bf2f(WSP(bf16, WS_QR)[m * RETW + h * RD + lane]), q2 = bf2f(WSP(bf16, WS_QR)[m * RETW + h * RD + 64 + lane]);
        const float k1 = bf2f(WSP(bf16, WS_KR)[m * RETW + h * RD + lane]), k2 = bf2f(WSP(bf16, WS_KR)[m * RETW + h * RD + 64 + lane]);
        const float v = bf2f(WSP(bf16, WS_Z)[m * INW + ZC_V + h * RD + half * 64 + lane]);
        float y = 0.f;
#pragma unroll
        for (int d = 0; d < 64; ++d) { R[d] = gam * R[d] + rdlane(k1, d) * v; y += rdlane(q1, d) * R[d]; }
#pragma unroll
        for (int d = 0; d < 64; ++d) { R[64 + d] = gam * R[64 + d] + rdlane(k2, d) * v; y += rdlane(q2, d) * R[64 + d]; }
        OUTP[m * RETW + h * RD + half * 64 + lane] = y;
    }
}
#if !MK_CHUNKED
constexpr int SCT = 32;
constexpr int SC_ARR = SCT * 64 * 4;
constexpr int SC_BUF = 5 * SC_ARR + SCT * 16 * 4;
static_assert(2 * SC_BUF <= RING_BYTES, "scan LDS");
template <int CTRL> __device__ __forceinline__ float dppf(float x) { return __builtin_bit_cast(float, __builtin_amdgcn_update_dpp(0, __builtin_bit_cast(int, x), CTRL, 0xF, 0xF, true)); }
__device__ __forceinline__ float sum16(float x) {
    x += dppf<0xB1>(x); x += dppf<0x4E>(x); x += dppf<0x141>(x); x += dppf<0x140>(x); return x;
}
__device__ __forceinline__ void scan_rwkv_fast(Frame& F, int w) {
    const int b = w >> 6, hh = (w >> 2) & 15, q = w & 3;
    const int lane = F.lane, wave = F.wave;
    LAS unsigned char* base = F.lds + RING_OFF;
    const size_t g0 = (size_t)b * SEQ * RWW + (size_t)hh * WD;
    constexpr int NBLK = SEQ / SCT;
#define SC_BAR() do { asm volatile("s_waitcnt lgkmcnt(0)" ::: "memory"); __builtin_amdgcn_s_barrier(); asm volatile("" ::: "memory"); } while (0)
    if (wave >= 4) {
        const int lt = F.tid - 256;
        const float* a0 = WSP(float, WS_SR) + g0; const float* a1 = WSP(float, WS_SW) + g0; const float* a2 = WSP(float, WS_SK) + g0;
        const float* a3 = WSP(float, WS_SNKK) + g0; const float* a4 = WSP(float, WS_SKKA) + g0; const float* av = WSP(float, WS_SV) + g0 + 16 * q;
        const int f0 = lt, f1 = lt + 256;
        const size_t o0 = (size_t)(f0 >> 4) * RWW + 4 * (f0 & 15), o1 = (size_t)(f1 >> 4) * RWW + 4 * (f1 & 15), ov = (size_t)(lt >> 2) * RWW + 4 * (lt & 3);
        f32x4 r0[5], r1[5], rv;
#define SC_LOAD(blk) do { const size_t tb = (size_t)(blk) * SCT * RWW; \
        r0[0] = *(const GAS f32x4*)(a0 + tb + o0); r1[0] = *(const GAS f32x4*)(a0 + tb + o1); r0[1] = *(const GAS f32x4*)(a1 + tb + o0); r1[1] = *(const GAS f32x4*)(a1 + tb + o1); \
        r0[2] = *(const GAS f32x4*)(a2 + tb + o0); r1[2] = *(const GAS f32x4*)(a2 + tb + o1); r0[3] = *(const GAS f32x4*)(a3 + tb + o0); r1[3] = *(const GAS f32x4*)(a3 + tb + o1); \
        r0[4] = *(const GAS f32x4*)(a4 + tb + o0); r1[4] = *(const GAS f32x4*)(a4 + tb + o1); if (lt < 128) rv = *(const GAS f32x4*)(av + tb + ov); } while (0)
#define SC_STORE(bi) do { LAS unsigned char* bb = base + (bi) * SC_BUF; \
        _Pragma("unroll") for (int a = 0; a < 5; ++a) { *(LAS f32x4*)(bb + a * SC_ARR + f0 * 16) = r0[a]; *(LAS f32x4*)(bb + a * SC_ARR + f1 * 16) = r1[a]; } \
        if (lt < 128) *(LAS f32x4*)(bb + 5 * SC_ARR + lt * 16) = rv; } while (0)
        SC_LOAD(0); SC_STORE(0);
        if (1 < NBLK) SC_LOAD(1);
        SC_BAR();
        for (int blk = 0; blk < NBLK; ++blk) {
            if (blk + 1 < NBLK) { SC_STORE((blk + 1) & 1); if (blk + 2 < NBLK) SC_LOAD(blk + 2); }
            SC_BAR();
        }
#undef SC_LOAD
#undef SC_STORE
    } else {
        const int l16 = lane & 15, rowl = 4 * wave + (lane >> 4);
        GAS float* Y = (GAS float*)(WSP(float, WS_YRAWW) + g0 + 16 * q + rowl);
        f32x4 st = (f32x4){0.f, 0.f, 0.f, 0.f};
        const int lo = l16 * 16, vo = 5 * SC_ARR + rowl * 4;
#define SC_LD(tt_, R4, W4, K4, N4, A4, V) do { R4 = *(const LAS f32x4*)(bb + 0 * SC_ARR + (tt_) * 256 + lo); W4 = *(const LAS f32x4*)(bb + 1 * SC_ARR + (tt_) * 256 + lo); \
        K4 = *(const LAS f32x4*)(bb + 2 * SC_ARR + (tt_) * 256 + lo); N4 = *(const LAS f32x4*)(bb + 3 * SC_ARR + (tt_) * 256 + lo); A4 = *(const LAS f32x4*)(bb + 4 * SC_ARR + (tt_) * 256 + lo); \
        V = *(const LAS float*)(bb + vo + (tt_) * 64); } while (0)
        SC_BAR();
        for (int blk = 0; blk < NBLK; ++blk) {
            const LAS unsigned char* bb = base + (blk & 1) * SC_BUF;
            GAS float* yb = Y + (size_t)blk * SCT * RWW;
            f32x4 r4[3], w4[3], k4[3], n4[3], a4[3]; float v[3];
            SC_LD(0, r4[0], w4[0], k4[0], n4[0], a4[0], v[0]);
            SC_LD(1, r4[1], w4[1], k4[1], n4[1], a4[1], v[1]);
#pragma unroll
            for (int tt = 0; tt < SCT; ++tt) {
                const int c = tt % 3, p = (tt + 2) % 3;
                if (tt + 2 < SCT) SC_LD(tt + 2, r4[p], w4[p], k4[p], n4[p], a4[p], v[p]);
                f32x2 sp2 = (f32x2){st.x, st.y} * (f32x2){n4[c].x, n4[c].y}; sp2 = (f32x2){st.z, st.w} * (f32x2){n4[c].z, n4[c].w} + sp2;
                const f32x4 t0 = st * w4[c] + k4[c] * v[c];
                const float sa = sum16(sp2.x + sp2.y);
                st = a4[c] * sa + t0;
                f32x2 yp2 = (f32x2){st.x, st.y} * (f32x2){r4[c].x, r4[c].y}; yp2 = (f32x2){st.z, st.w} * (f32x2){r4[c].z, r4[c].w} + yp2;
                const float y = sum16(yp2.x + yp2.y);
                yb[(size_t)tt * RWW] = y;
            }
            SC_BAR();
        }
#undef SC_LD
#undef SC_BAR
    }
}
#endif
__device__ __forceinline__ float dpp_x1(float x) { return __builtin_bit_cast(float, __builtin_amdgcn_update_dpp(0, __builtin_bit_cast(int, x), 0xB1, 0xF, 0xF, true)); }
__device__ __forceinline__ void store_y_bf16(GAS bf16* p, size_t ld, const f32x4 ya, int l15) {
    const bool odd = l15 & 1;
    const float s0 = dpp_x1(odd ? ya[0] : ya[2]), s1 = dpp_x1(odd ? ya[1] : ya[3]);
    const unsigned w0 = odd ? pg8::cvt_pk_bf16(s0, ya[2]) : pg8::cvt_pk_bf16(ya[0], s0), w1 = odd ? pg8::cvt_pk_bf16(s1, ya[3]) : pg8::cvt_pk_bf16(ya[1], s1);
    GAS bf16* r = p + (odd ? 2 * ld : 0);
    *(GAS unsigned*)r = w0; *(GAS unsigned*)(r + ld) = w1;
}
constexpr int CB_STEPS = 4, CB_STEP_BYTES = CU_QB + CU_QSTR, CB_SP = CB_STEP_BYTES / 16  , CB_BUF = CB_STEPS * CB_STEP_BYTES, CB_PIECES = CB_BUF / 16, CB_NLD = CB_PIECES / 8  , CB_NBLK = NCHUNK / CB_STEPS;
static_assert(CB_NLD * 8 == CB_PIECES && CB_NLD <= 448, "loader split");
static_assert(2 * CB_BUF <= RING_BYTES, "chunk scan LDS");
#ifndef MK_X2_DIRECT
#define MK_X2_DIRECT 0
#endif
__device__ __forceinline__ void scan_rwkv_chunk(Frame& F, int w) {
    const int bh = w >> 2, q = w & 3, lane = F.lane, wave = F.wave;
    LAS unsigned char* base = F.lds + RING_OFF;
    const GAS unsigned char* rec0 = (const GAS unsigned char*)WSP(unsigned char, WS_CU) + (size_t)bh * NCHUNK * CU_BYTES;
#define CB_BAR() do { asm volatile("s_waitcnt lgkmcnt(0)" ::: "memory"); __builtin_amdgcn_s_barrier(); asm volatile("" ::: "memory"); } while (0)
    if (wave >= 1) {
        const int lt = F.tid - 64;
#if MK_X2_NT
#define CB_LD(p_) __builtin_nontemporal_load((const GAS v4u*)(p_))
#else
#define CB_LD(p_) (*(const GAS v4u*)(p_))
#endif
        v4u ra[8], rb[8], rc[8], rd[8];
        const int ltc = lt < CB_NLD ? lt : CB_NLD - 1;
        int so[8];
#pragma unroll
        for (int j = 0; j < 8; ++j) { const int p = ltc + CB_NLD * j, st = p / CB_SP, off = p % CB_SP; so[j] = st * CU_BYTES + off * 16 + (off >= CU_QB / 16 ? q * CU_QSTR : 0); }
#define CB_LOAD(rg, blk) do { const int bc_ = (blk) < CB_NBLK ? (blk) : CB_NBLK - 1; const GAS unsigned char* bp = rec0 + (size_t)bc_ * CB_STEPS * CU_BYTES; \
            _Pragma("unroll") for (int j = 0; j < 8; ++j) rg[j] = CB_LD(bp + so[j]); } while (0)
#define CB_STORE(rg, bi) do { LAS unsigned char* dp = base + (bi) * CB_BUF + ltc * 16; \
            _Pragma("unroll") for (int j = 0; j < 8; ++j) *(LAS v4u*)(dp + j * CB_NLD * 16) = rg[j]; } while (0)
        static_assert(CB_NBLK % 4 == 0 && CB_NBLK >= 8, "block quads");
        CB_LOAD(ra, 0); CB_STORE(ra, 0); CB_LOAD(rb, 1); CB_LOAD(rc, 2); CB_LOAD(rd, 3);
        CB_BAR();
        for (int blk = 0; blk < CB_NBLK; blk += 4) {
            CB_STORE(rb, 1); CB_LOAD(ra, blk + 4); CB_BAR();
            CB_STORE(rc, 0); CB_LOAD(rb, blk + 5); CB_BAR();
            CB_STORE(rd, 1); CB_LOAD(rc, blk + 6); CB_BAR();
            CB_STORE(ra, 0); CB_LOAD(rd, blk + 7); CB_BAR();
        }
#undef CB_LOAD
#undef CB_STORE
    } else {
        const int l15 = lane & 15, g = lane >> 4;
        const f32x4 Z4 = (f32x4){0.f, 0.f, 0.f, 0.f};
        f32x4 acc[4] = {Z4, Z4, Z4, Z4};
        GAS bf16* Y = (GAS bf16*)(WSP(bf16, WS_YRAWW) + (size_t)(bh >> 4) * SEQ * RWW + (size_t)(bh & 15) * WD + 16 * q + (l15 & ~1) + (size_t)(4 * g) * RWW);
        CB_BAR();
        bf16x8 Wf[2][2], Rf[2][2], BKf[2][4]; f32x4 pcv[2][4]; v2u Lrbf[2], U0t[2], Vt[2], YVt[2];
#define CB_FRAGS(sb_, k_) do { _Pragma("unroll") for (int j = 0; j < 2; ++j) { Wf[k_][j] = *(const LAS bf16x8*)((sb_) + CU_W + j * 1024 + lane * 16); Rf[k_][j] = *(const LAS bf16x8*)((sb_) + CU_R + j * 1024 + lane * 16); } \
        _Pragma("unroll") for (int j = 0; j < 4; ++j) { BKf[k_][j] = *(const LAS bf16x8*)((sb_) + CU_BK + j * 1024 + lane * 16); pcv[k_][j] = *(const LAS f32x4*)((sb_) + CU_PC + (16 * j + 4 * g) * 4); } \
        Lrbf[k_] = *(const LAS v2u*)((sb_) + CU_LRB + lane * 8); U0t[k_] = *(const LAS v2u*)((sb_) + CU_QB + lane * 8); Vt[k_] = *(const LAS v2u*)((sb_) + CU_QB + 512 + lane * 8); YVt[k_] = *(const LAS v2u*)((sb_) + CU_QB + 1024 + lane * 8); } while (0)
        for (int blk = 0; blk < CB_NBLK; ++blk) {
            const LAS unsigned char* bb = base + (blk & 1) * CB_BUF;
            CB_FRAGS(bb, 0);
#pragma unroll
            for (int st = 0; st < CB_STEPS; ++st) {
                const int c = st & 1;
                if (st + 1 < CB_STEPS) CB_FRAGS(bb + (st + 1) * CB_STEP_BYTES, (c ^ 1));
                const bf16x8 sf0 = pk8v(acc[0], acc[1]), sf1 = pk8v(acc[2], acc[3]);
                f32x4 pA = unpk4(U0t[c]);
                pA = mma32(Wf[c][0], sf0, pA); pA = mma32(Wf[c][1], sf1, pA);
                f32x4 ya = unpk4(YVt[c]);
                ya = mma32(Rf[c][0], sf0, ya); ya = mma32(Rf[c][1], sf1, ya);
                const s4v pAp = pk4(pA), vq = __builtin_bit_cast(s4v, Vt[c]);
                ya = mma16(__builtin_bit_cast(s4v, Lrbf[c]), pAp, ya);
                store_y_bf16(Y + (size_t)((blk * CB_STEPS + st) * CK) * RWW, RWW, ya, l15);
                const bf16x8 yB = (bf16x8){pAp.x, pAp.y, pAp.z, pAp.w, vq.x, vq.y, vq.z, vq.w};
#pragma unroll
                for (int tl = 0; tl < 4; ++tl) acc[tl] = mma32(BKf[c][tl], yB, acc[tl] * pcv[c][tl]);
            }
            CB_BAR();
        }
#undef CB_FRAGS
    }
#undef CB_BAR
}
__device__ const float RET_LG2[8] = { -4.580368847e-02f, -2.272007614e-02f, -1.131531317e-02f, -5.646563135e-03f, -2.820519032e-03f, -1.409570221e-03f, -7.046129904e-04f, -3.522634797e-04f };
constexpr int RT_STR = 288, RT_QS = 0, RT_KS = 128 * RT_STR, RT_VSTR = 80, RT_VS = 2 * 128 * RT_STR, RT_VPS = RT_VS + 128 * RT_VSTR, RT_RT = RT_VPS + 128 * RT_VSTR, RT_RTSZ = 32 * RT_STR;
static_assert(RT_RT + 2 * RT_RTSZ <= RING_BYTES, "retention LDS");
__device__ __forceinline__ bf16x8 tr8(const LAS unsigned char* p0, const LAS unsigned char* p1) {
    const s4v a = __builtin_amdgcn_ds_read_tr16_b64_v4i16((LAS s4v*)p0), b = __builtin_amdgcn_ds_read_tr16_b64_v4i16((LAS s4v*)p1);
    return (bf16x8){a.x, a.y, a.z, a.w, b.x, b.y, b.z, b.w};
}
__device__ __forceinline__ void scan_ret_mfma(Frame& F, int w_) {
    const int b = w_ >> 5, h = (w_ >> 2) & 7, eq = w_ & 3;
    const int tid = F.tid, lane = F.lane, w = F.wave < 4 ? F.wave : 11 - F.wave, l15 = lane & 15, g = lane >> 4, tq = l15 >> 2, tp = l15 & 3;
    LAS unsigned char* L = F.lds + RING_OFF;
    const float lg2 = RET_LG2[h];
    const float gC = __builtin_amdgcn_exp2f(lg2 * 128.f);
    for (int i = tid; i < RT_RTSZ / 4; i += NWAVES * 64) ((LAS unsigned*)(L + RT_RT))[i] = 0u;
    const GAS bf16* Qg = (const GAS bf16*)(WSP(bf16, WS_QR) + (size_t)b * SEQ * RETW + h * RD);
    const GAS bf16* Kg = (const GAS bf16*)(WSP(bf16, WS_KR) + (size_t)b * SEQ * RETW + h * RD);
    const GAS bf16* Vg = (const GAS bf16*)(WSP(bf16, WS_Z) + (size_t)b * SEQ * INW + ZC_V + h * RD + 32 * eq);
    GAS bf16* Yg = (GAS bf16*)OUTP + (size_t)b * SEQ * RETW + h * RD + 32 * eq;
    v4u rq[4], rk[4], rv;
#define RT_BAR() do { asm volatile("s_waitcnt lgkmcnt(0)" ::: "memory"); __builtin_amdgcn_s_barrier(); asm volatile("" ::: "memory"); } while (0)
#define RT_LOAD(n_) do { _Pragma("unroll") for (int i = 0; i < 4; ++i) { const int f = tid + 512 * i, c = f >> 4, pc = f & 15; \
        rq[i] = *(const GAS v4u*)(Qg + (size_t)((n_) * 128 + c) * RETW + 8 * pc); rk[i] = *(const GAS v4u*)(Kg + (size_t)((n_) * 128 + c) * RETW + 8 * pc); } \
        rv = *(const GAS v4u*)(Vg + (size_t)((n_) * 128 + (tid >> 2)) * INW + 8 * (tid & 3)); } while (0)
    f32x4 accR[2] = {(f32x4){0.f, 0.f, 0.f, 0.f}, (f32x4){0.f, 0.f, 0.f, 0.f}};
    RT_LOAD(0);
    for (int n = 0; n < SEQ / 128; ++n) {
#pragma unroll
        for (int i = 0; i < 4; ++i) { const int f = tid + 512 * i, c = f >> 4, pc = f & 15;
            *(LAS v4u*)(L + RT_QS + c * RT_STR + pc * 16) = rq[i]; *(LAS v4u*)(L + RT_KS + c * RT_STR + pc * 16) = rk[i]; }
        { const int c = tid >> 2, pc = tid & 3; *(LAS v4u*)(L + RT_VS + c * RT_VSTR + pc * 16) = rv;
          const float sc = __builtin_amdgcn_exp2f(lg2 * (float)(127 - c)); v4u o;
          o.x = pg8::cvt_pk_bf16(pg8::bf_lo(rv.x) * sc, pg8::bf_hi(rv.x) * sc); o.y = pg8::cvt_pk_bf16(pg8::bf_lo(rv.y) * sc, pg8::bf_hi(rv.y) * sc);
          o.z = pg8::cvt_pk_bf16(pg8::bf_lo(rv.z) * sc, pg8::bf_hi(rv.z) * sc); o.w = pg8::cvt_pk_bf16(pg8::bf_lo(rv.w) * sc, pg8::bf_hi(rv.w) * sc);
          *(LAS v4u*)(L + RT_VPS + c * RT_VSTR + pc * 16) = o; }
        RT_BAR();
        if (n + 1 < SEQ / 128) RT_LOAD(n + 1);
        bf16x8 qf[4];
#pragma unroll
        for (int ks = 0; ks < 4; ++ks) qf[ks] = *(const LAS bf16x8*)(L + RT_QS + (16 * w + l15) * RT_STR + (32 * ks + 8 * g) * 2);
        bf16x8 pf[4];
        const int cq = 16 * w + l15;
#pragma unroll
        for (int p = 0; p < 4; ++p) {
            bf16x8 kf[8];
#pragma unroll
            for (int ks = 0; ks < 4; ++ks) { kf[ks] = *(const LAS bf16x8*)(L + RT_KS + (32 * p + l15) * RT_STR + (32 * ks + 8 * g) * 2);
                kf[4 + ks] = *(const LAS bf16x8*)(L + RT_KS + (32 * p + 16 + l15) * RT_STR + (32 * ks + 8 * g) * 2); }
            __builtin_amdgcn_sched_barrier(0);
            f32x4 s0 = (f32x4){0.f, 0.f, 0.f, 0.f}, s1 = (f32x4){0.f, 0.f, 0.f, 0.f};
            if (2 * p <= w) {
#pragma unroll
                for (int ks = 0; ks < 4; ++ks) s0 = __builtin_amdgcn_mfma_f32_16x16x32_bf16(kf[ks], qf[ks], s0, 0, 0, 0);
            }
            if (2 * p + 1 <= w) {
#pragma unroll
                for (int ks = 0; ks < 4; ++ks) s1 = __builtin_amdgcn_mfma_f32_16x16x32_bf16(kf[4 + ks], qf[ks], s1, 0, 0, 0);
            }
            float p0[4], p1[4];
#pragma unroll
            for (int i = 0; i < 4; ++i) { const int d0 = cq - (32 * p + 4 * g + i), d1 = d0 - 16;
                p0[i] = d0 >= 0 ? s0[i] * __builtin_amdgcn_exp2f(lg2 * (float)d0) : 0.f; p1[i] = d1 >= 0 ? s1[i] * __builtin_amdgcn_exp2f(lg2 * (float)d1) : 0.f; }
            v4u pk; pk.x = pg8::cvt_pk_bf16(p0[0], p0[1]); pk.y = pg8::cvt_pk_bf16(p0[2], p0[3]); pk.z = pg8::cvt_pk_bf16(p1[0], p1[1]); pk.w = pg8::cvt_pk_bf16(p1[2], p1[3]);
            pf[p] = __builtin_bit_cast(bf16x8, pk);
        }
        const LAS unsigned char* Rcur = L + RT_RT + (n & 1) * RT_RTSZ;
#pragma unroll
        for (int et = 0; et < 2; ++et) {
            bf16x8 rf[4], vf[4];
#pragma unroll
            for (int ks = 0; ks < 4; ++ks) rf[ks] = *(const LAS bf16x8*)(Rcur + (16 * et + l15) * RT_STR + (32 * ks + 8 * g) * 2);
#pragma unroll
            for (int p = 0; p < 4; ++p) { const LAS unsigned char* vb = L + RT_VS + (32 * p + 4 * g + tq) * RT_VSTR + (16 * et + 4 * tp) * 2; vf[p] = tr8(vb, vb + 16 * RT_VSTR); }
            __builtin_amdgcn_sched_barrier(0);
            f32x4 acc = (f32x4){0.f, 0.f, 0.f, 0.f};
#pragma unroll
            for (int ks = 0; ks < 4; ++ks) acc = __builtin_amdgcn_mfma_f32_16x16x32_bf16(qf[ks], rf[ks], acc, 0, 0, 0);
#pragma unroll
            for (int i = 0; i < 4; ++i) acc[i] *= __builtin_amdgcn_exp2f(lg2 * (float)(16 * w + 4 * g + i + 1));
#pragma unroll
            for (int p = 0; p < 4; ++p) if (2 * p <= w) acc = __builtin_amdgcn_mfma_f32_16x16x32_bf16(pf[p], vf[p], acc, 0, 0, 0);
            store_y_bf16(Yg + (size_t)(n * 128 + 16 * w + 4 * g) * RETW + 16 * et + (l15 & ~1), RETW, acc, l15);
        }
        {
            bf16x8 kt[4], vt[4][2];
#pragma unroll
            for (int cs = 0; cs < 4; ++cs) {
                const LAS unsigned char* kb = L + RT_KS + (32 * cs + 8 * g + tq) * RT_STR + (16 * w + 4 * tp) * 2;
                kt[cs] = tr8(kb, kb + 4 * RT_STR);
#pragma unroll
                for (int et = 0; et < 2; ++et) { const LAS unsigned char* vb = L + RT_VPS + (32 * cs + 8 * g + tq) * RT_VSTR + (16 * et + 4 * tp) * 2; vt[cs][et] = tr8(vb, vb + 4 * RT_VSTR); }
            }
            __builtin_amdgcn_sched_barrier(0);
            LAS unsigned char* Rnxt = L + RT_RT + ((n + 1) & 1) * RT_RTSZ;
            accR[0] = accR[0] * gC; accR[1] = accR[1] * gC;
#pragma unroll
            for (int cs = 0; cs < 4; ++cs)
#pragma unroll
                for (int et = 0; et < 2; ++et) accR[et] = __builtin_amdgcn_mfma_f32_16x16x32_bf16(kt[cs], vt[cs][et], accR[et], 0, 0, 0);
#pragma unroll
            for (int et = 0; et < 2; ++et) { v2u o; o.x = pg8::cvt_pk_bf16(accR[et][0], accR[et][1]); o.y = pg8::cvt_pk_bf16(accR[et][2], accR[et][3]);
                *(LAS v2u*)(Rnxt + (16 * et + l15) * RT_STR + (16 * w + 4 * g) * 2) = o; }
        }
        RT_BAR();
    }
#undef RT_LOAD
#undef RT_BAR
}
__device__ __forceinline__ void ph_scan(Frame& F, ArgP A, int l) {
#if MK_CHUNKED
    if (F.G == 256) {
        const int it = F.vcu, r = it & 3, idx = it >> 2;
        if (r == 0 || r == 2) { const int w = idx * 2 + (r >> 1); int n_ = (MK_REP & 32) ? 2 : 1; asm volatile("" : "+s"(n_));
#pragma unroll 1
            for (int k_ = 0; k_ < n_; ++k_) { scan_rwkv_chunk(F, w); __syncthreads(); }
            if (MK_CONV_X2_PCT && l + 1 < DEPTH) { RETID(); ph_convert(F, A, l + 1, w, 128, CONV_SPLIT, CONV_NITEMS); } }
        else if (r == 1) { int n_ = (MK_REP & 64) ? 2 : 1; asm volatile("" : "+s"(n_));
#pragma unroll 1
            for (int k_ = 0; k_ < n_; ++k_) { scan_ret_mfma(F, idx); __syncthreads(); } }
        else {
            if (MK_TAIL_IN_SCAN) { pg8::Gemm g{WSPG(bf16, WS_H), WSWG(l, WO_WIN), M, INW, D}; pg8::OneUnit S{idx, INW / 256 - 1};
                fill_rstd(F, idx * 256, 256);
                pg8::EpiB<0> E{WSPG(bf16, WS_Z), INW, nullptr, 0, (const LAS float*)(F.lds + RSTD_OFF), idx};
                pg8::gemm_phase<pg8::EpiB<0>, pg8::OneUnit, MK_ALIGN, MK_SP2>(F.lds + RING_OFF, g, S, E);
                __syncthreads(); RETID(); }
            if (l + 1 < DEPTH) ph_convert(F, A, l + 1, idx, 64, 0, CONV_SPLIT); }
        __syncthreads();
    }
#else
    if (F.G >= 256) {
        if (F.vcu >= 192) { if (l + 1 < DEPTH) ph_convert(F, A, l + 1, F.vcu - 192, F.G - 192); return; }
        if (F.vcu < 128) { scan_rwkv_fast(F, F.vcu); if (MK_REP & 32) { __syncthreads(); scan_rwkv_fast(F, F.vcu); } }
        else if (F.vcu < 192) { scan_ret_mfma(F, F.vcu - 128); if (MK_REP & 64) { __syncthreads(); scan_ret_mfma(F, F.vcu - 128); } }
    } else {
        if (l + 1 < DEPTH) ph_convert(F, A, l + 1, F.vcu, F.G);
        const int gw = F.vcu * NWAVES + F.wave, NGW = F.G * NWAVES;
        const int stride = NGW >= 64 ? NGW / 64 : 1;
        if (gw % stride == 0) {
            for (int item = gw / stride; item < 64; item += (NGW + stride - 1) / stride) {
                if (item < 32) scan_rwkv_naive(F, item); else scan_ret_naive(F, item - 32);
            }
        }
    }
#endif
}
#if (MK_GLOBAL_GROUPS & 4)
#pragma pop_macro("WSP")
#pragma pop_macro("WSW")
#pragma pop_macro("OUTP")
#endif
#if (MK_GLOBAL_GROUPS & 8)
#pragma push_macro("WSP")
#pragma push_macro("WSW")
#pragma push_macro("OUTP")
#undef WSP
#undef WSW
#undef OUTP
#define WSP WSPG
#define WSW WSWG
#define OUTP OUTPG
#endif
template <int CTRL> __device__ __forceinline__ float dppx(float x) { return __builtin_bit_cast(float, __builtin_amdgcn_update_dpp(0, __builtin_bit_cast(int, x), CTRL, 0xF, 0xF, true)); }
static_assert(MK_CHUNKED == 1, "ph_post reads the raw scan outputs as bf16, which only the chunked / MFMA scans write");
__device__ __forceinline__ void ph_post(Frame& F, ArgP A, int l) {
    const int gw = F.vcu * NWAVES + F.wave, NGW = F.G * NWAVES, lane = F.lane, c0 = lane * 16;
    f32x4 gg[4], gb[4], lg[4], lb[4];
#pragma unroll
    for (int j = 0; j < 4; ++j) { gg[j] = *(const GAS f32x4*)(INP(A, 4) + (size_t)l * RETW + c0 + 4 * j); gb[j] = *(const GAS f32x4*)(INP(A, 5) + (size_t)l * RETW + c0 + 4 * j);
        lg[j] = *(const GAS f32x4*)(INP(A, 15) + (size_t)l * RWW + c0 + 4 * j); lb[j] = *(const GAS f32x4*)(INP(A, 16) + (size_t)l * RWW + c0 + 4 * j); }
    struct Raw { v2u yr[4]; v4u zg[2]; v2u yw[4], sv[4], gt[4]; float bonus; };
    auto load_row = [&](Raw& R, int m) {
        if (m >= M) m = M - 1;
        const GAS bf16* yrp = (const GAS bf16*)OUTP + (size_t)m * RETW + c0; const GAS bf16* zg = (const GAS bf16*)(WSP(bf16, WS_Z) + (size_t)m * INW + ZC_GR + c0);
        const size_t ob = (size_t)m * RWW + c0;
#pragma unroll
        for (int j = 0; j < 4; ++j) { R.yr[j] = *(const GAS v2u*)(yrp + 4 * j); R.yw[j] = *(const GAS v2u*)(WSP(bf16, WS_YRAWW) + ob + 4 * j);
            R.sv[j] = *(const GAS v2u*)(WSP(bf16, WS_SV) + ob + 4 * j); R.gt[j] = *(const GAS v2u*)(WSP(bf16, WS_G) + ob + 4 * j); }
        R.zg[0] = *(const GAS v4u*)zg; R.zg[1] = *(const GAS v4u*)(zg + 8);
        R.bonus = *(const GAS float*)(WSP(float, WS_BONUS) + (size_t)m * WH + (lane >> 2));
    };
    auto do_row = [&](const Raw& R, int m) {
        {
            f32x4 y[4]; float s = 0.f;
#pragma unroll
            for (int j = 0; j < 4; ++j) { y[j] = unpk4(R.yr[j]); s += (y[j].x + y[j].y) + (y[j].z + y[j].w); }
            float g[16]; { float t[8]; unpack8(R.zg[0], t);
#pragma unroll
                for (int j = 0; j < 8; ++j) g[j] = t[j]; unpack8(R.zg[1], t);
#pragma unroll
                for (int j = 0; j < 8; ++j) g[8 + j] = t[j]; }
            s += dppx<0xB1>(s); s += dppx<0x4E>(s); s += dppx<0x141>(s);
            const float mean = s * (1.f / RD); float q = 0.f;
#pragma unroll
            for (int j = 0; j < 4; ++j) { y[j] = y[j] - mean; q += (y[j].x * y[j].x + y[j].y * y[j].y) + (y[j].z * y[j].z + y[j].w * y[j].w); }
            q += dppx<0xB1>(q); q += dppx<0x4E>(q); q += dppx<0x141>(q);
            const float rstd = __builtin_amdgcn_rsqf(q * (1.f / RD) + RET_GN_EPS);
            float o[16];
#pragma unroll
            for (int j = 0; j < 4; ++j)
#pragma unroll
                for (int k = 0; k < 4; ++k) { const float gr = g[4 * j + k]; o[4 * j + k] = (y[j][k] * rstd * gg[j][k] + gb[j][k]) * (gr * fsig(gr)); }
            GAS bf16* yo = (GAS bf16*)(WSP(bf16, WS_YRET) + (size_t)m * RETW + c0);
            { float t[8];
#pragma unroll
              for (int j = 0; j < 8; ++j) t[j] = o[j]; *(GAS bf16x8*)yo = pack8(t);
#pragma unroll
              for (int j = 0; j < 8; ++j) t[j] = o[8 + j]; *(GAS bf16x8*)(yo + 8) = pack8(t); }
        }
        {
            const size_t ob = (size_t)m * RWW + c0;
            f32x4 y[4]; float s = 0.f;
#pragma unroll
            for (int j = 0; j < 4; ++j) { y[j] = unpk4(R.yw[j]); s += (y[j].x + y[j].y) + (y[j].z + y[j].w); }
            f32x4 vv[4], gt[4];
#pragma unroll
            for (int j = 0; j < 4; ++j) { vv[j] = unpk4(R.sv[j]); gt[j] = unpk4(R.gt[j]); }
            const float bonus = R.bonus;
            s += dppx<0xB1>(s); s += dppx<0x4E>(s);
            const float mean = s * (1.f / WD); float q = 0.f;
#pragma unroll
            for (int j = 0; j < 4; ++j) { y[j] = y[j] - mean; q += (y[j].x * y[j].x + y[j].y * y[j].y) + (y[j].z * y[j].z + y[j].w * y[j].w); }
            q += dppx<0xB1>(q); q += dppx<0x4E>(q);
            const float rstd = __builtin_amdgcn_rsqf(q * (1.f / WD) + RWKV_LN_EPS);
            float o[16];
#pragma unroll
            for (int j = 0; j < 4; ++j)
#pragma unroll
                for (int k = 0; k < 4; ++k) o[4 * j + k] = (y[j][k] * rstd * lg[j][k] + lb[j][k] + bonus * vv[j][k]) * gt[j][k];
            GAS bf16* yo = (GAS bf16*)(WSP(bf16, WS_YRWKV) + ob);
            { float t[8];
#pragma unroll
              for (int j = 0; j < 8; ++j) t[j] = o[j]; *(GAS bf16x8*)yo = pack8(t);
#pragma unroll
              for (int j = 0; j < 8; ++j) t[j] = o[8 + j]; *(GAS bf16x8*)(yo + 8) = pack8(t); }
        }
    };
    Raw ra, rb;
    if (gw < M) load_row(ra, gw);
    for (int m = gw; m < M; m += 2 * NGW) {
        load_row(rb, m + NGW); do_row(ra, m);
        if (m + NGW >= M) break;
        load_row(ra, m + 2 * NGW); do_row(rb, m + NGW);
    }
}
__device__ __forceinline__ void ph_final(Frame& F, ArgP A) {
    const int gw = F.vcu * NWAVES + F.wave, NGW = F.G * NWAVES, lane = F.lane;
    const GAS f32x4* gr = (const GAS f32x4*)INP(A, 23) + 2 * lane;
    f32x4 gn[8];
#pragma unroll
    for (int j = 0; j < 4; ++j) { gn[2 * j] = gr[128 * j]; gn[2 * j + 1] = gr[128 * j + 1]; }
    auto load_row = [&](v4u (&h)[4], int m) { if (m >= M) m = M - 1; const GAS v4u* hr = (const GAS v4u*)(WSP(bf16, WS_H) + (size_t)m * D) + lane;
#pragma unroll
        for (int j = 0; j < 4; ++j) h[j] = hr[64 * j]; };
    auto do_row = [&](const v4u (&h)[4], int m) {
        GAS f32x4* xo = (GAS f32x4*)(OUTP + (size_t)m * D) + 2 * lane;
        f32x4 v[8]; float s = 0.f;
#pragma unroll
        for (int j = 0; j < 4; ++j) {
            v[2 * j] = f32x4{__builtin_bit_cast(float, h[j].x << 16), __builtin_bit_cast(float, h[j].x & 0xffff0000u), __builtin_bit_cast(float, h[j].y << 16), __builtin_bit_cast(float, h[j].y & 0xffff0000u)};
            v[2 * j + 1] = f32x4{__builtin_bit_cast(float, h[j].z << 16), __builtin_bit_cast(float, h[j].z & 0xffff0000u), __builtin_bit_cast(float, h[j].w << 16), __builtin_bit_cast(float, h[j].w & 0xffff0000u)};
        }
#pragma unroll
        for (int j = 0; j < 8; ++j) s += (v[j].x * v[j].x + v[j].y * v[j].y) + (v[j].z * v[j].z + v[j].w * v[j].w);
        const float rstd = 1.f / sqrtf(wave_sum(s) * (1.f / D) + NORM_EPS);
#pragma unroll
        for (int j = 0; j < 4; ++j) { xo[128 * j] = v[2 * j] * rstd * gn[2 * j]; xo[128 * j + 1] = v[2 * j + 1] * rstd * gn[2 * j + 1]; }
    };
    v4u ha[4], hb[4];
    if (gw < M) load_row(ha, gw);
    for (int m = gw; m < M; m += 2 * NGW) {
        load_row(hb, m + NGW); do_row(ha, m);
        if (m + NGW >= M) break;
        load_row(ha, m + 2 * NGW); do_row(hb, m + NGW);
    }
}
#if (MK_GLOBAL_GROUPS & 8)
#pragma pop_macro("WSP")
#pragma pop_macro("WSW")
#pragma pop_macro("OUTP")
#endif

__global__ void __launch_bounds__(NWAVES * 64, 2) hybrid_fwd(Args args) {
    extern __shared__ __attribute__((aligned(16))) unsigned char lds[];
    Frame F;
    F.lds = (LAS unsigned char*)lds;
    F.MISC = (volatile LAS unsigned*)(F.lds + MISC_OFF);
    F.tid = threadIdx.x; F.lane = F.tid & 63; F.wave = __builtin_amdgcn_readfirstlane(F.tid >> 6);
    int bx = blockIdx.x; F.G = gridDim.x; { F.vcu = (F.G % 8 == 0) ? (bx % 8) * (F.G / 8) + bx / 8 : bx; }
    F.ws = args.ws; F.out = args.out;
    for (int u = F.tid; u < (LDS_BYTES - LDSCTL_OFF) / 4; u += NWAVES * 64) ((LAS unsigned*)(F.lds + LDSCTL_OFF))[u] = 0u;
    __syncthreads();
    if (F.tid == 0) { volatile LAS unsigned* U = (volatile LAS unsigned*)(F.lds + MISC_OFF) + 16; const unsigned long long pw = (unsigned long long)args.ws, po = (unsigned long long)args.out, pa = (unsigned long long)__builtin_amdgcn_kernarg_segment_ptr();
        U[0] = (unsigned)pw; U[1] = (unsigned)(pw >> 32); U[2] = (unsigned)po; U[3] = (unsigned)(po >> 32); U[4] = (unsigned)pa; U[5] = (unsigned)(pa >> 32); U[6] = (unsigned)F.G; U[7] = (unsigned)F.vcu; U[8] = (unsigned)bx; }
    __syncthreads();
    XcdBarrier bar = xcd_barrier_post((unsigned*)(F.ws + WS_CTL) + CW_BAR, F.MISC + 8);

    ArgP ap = (ArgP)__builtin_amdgcn_kernarg_segment_ptr();
    const int lo = args.ph_lo, hi = args.ph_hi;
#define REPX(bit, body) do { body; if (MK_REP & (bit)) { __syncthreads(); body; } } while (0)
#define IN(k) (lo <= (k) && (k) < hi)
#define SEAM(k) do { if (IN(k) && IN((k) + 1)) { xcd_barrier(bar); if (MK_REP & 256) { xcd_barrier(bar); xcd_barrier(bar); } } else __syncthreads(); } while (0)

    if (IN(PH_PRO)) { int np_ = (MK_REP & 8192) ? 2 : 1; asm volatile("" : "+s"(np_));
#pragma unroll 1
        for (int rp_ = 0; rp_ < np_; ++rp_) { ph_prologue(F, ap); ph_convert(F, ap, 0, F.vcu, F.G); __syncthreads(); } }
    SEAM(PH_PRO);
    for (int l = 0; l < DEPTH; ++l) {
        const int p0 = PH_L0 + l * PPL;
        RETID();
        { unsigned ba = MISC_OFF + 64; asm volatile("" : "+v"(ba));
          const volatile LAS v4u* U = (const volatile LAS v4u*)(F.lds + ba);
          const v4u ua = U[0], ub = U[1]; const unsigned uc = *(const volatile LAS unsigned*)(U + 2);
          const unsigned u0 = __builtin_amdgcn_readfirstlane(ua.x), u1 = __builtin_amdgcn_readfirstlane(ua.y), u2 = __builtin_amdgcn_readfirstlane(ua.z), u3 = __builtin_amdgcn_readfirstlane(ua.w);
          const unsigned u4 = __builtin_amdgcn_readfirstlane(ub.x), u5 = __builtin_amdgcn_readfirstlane(ub.y), u6 = __builtin_amdgcn_readfirstlane(ub.z), u7 = __builtin_amdgcn_readfirstlane(ub.w), u8 = __builtin_amdgcn_readfirstlane(uc);
          F.ws = (unsigned char*)(((unsigned long long)u1 << 32) | u0); F.out = (float*)(((unsigned long long)u3 << 32) | u2); ap = (ArgP)(((unsigned long long)u5 << 32) | u4);
          F.G = (int)u6; F.vcu = (int)u7; bx = (int)u8; F.wave = __builtin_amdgcn_readfirstlane(F.tid >> 6); }
        if (IN(p0 + LP_G1)) {
            pg8::Gemm g{WSPG(bf16, WS_H), WSWG(l, WO_WIN), M, INW, D}; pg8::StaticOrder S; S.init(M, INW - (MK_TAIL_IN_SCAN ? 256 : 0), F.G, bx);
            fill_rstd(F, (bx & 7) * RSTD_ROWS, RSTD_ROWS);
            pg8::EpiB<0> E{WSPG(bf16, WS_Z), INW, nullptr, 0, (const LAS float*)(F.lds + RSTD_OFF), (bx & 7) * 8};
            if (MK_STAGGER_G1 && F.G == 256 && bx >= 64) { const unsigned long long t0 = __builtin_amdgcn_s_memrealtime(), ticks = (unsigned long long)(bx - 64) * (MK_STAGGER_G1 * 100) / 192;
                while (__builtin_amdgcn_s_memrealtime() - t0 < ticks) __builtin_amdgcn_s_sleep(16); }
            pg8::gemm_phase<pg8::EpiB<0>, pg8::StaticOrder, MK_ALIGN, MK_SP2>(F.lds + RING_OFF, g, S, E);
            if (MK_REP & 512) { __syncthreads(); pg8::gemm_phase<pg8::EpiB<0>, pg8::StaticOrder, MK_ALIGN, MK_SP2>(F.lds + RING_OFF, g, S, E); }
            if (MK_CONV_IN_G1 && F.G == 256 && l + 1 < DEPTH && bx >= 64) { RETID(); ph_convert(F, ap, l + 1, bx - 64, 192); }
        }
        SEAM(p0 + LP_G1);
        if (IN(p0 + LP_PREP)) { int nrep_ = (MK_REP & 4) ? 2 : 1; asm volatile("" : "+s"(nrep_));
#pragma unroll 1
            for (int rep_ = 0; rep_ < nrep_; ++rep_) { RETID(); ph_prep(F, ap, l); __syncthreads(); } }
        SEAM(p0 + LP_PREP);
        if (IN(p0 + LP_SCAN)) { RETID(); REPX(8, ph_scan(F, ap, l)); }
        SEAM(p0 + LP_SCAN);
        if (IN(p0 + LP_POST)) { RETID(); REPX(16, ph_post(F, ap, l)); }
        SEAM(p0 + LP_POST);
#if MK_FUSE_GAB
        if (IN(p0 + LP_GA)) {
            pg8::Gemm g{WSPG(bf16, WS_YRET), WSWG(l, WO_WA), M, D, RETW, WSPG(bf16, WS_YRWKV), WSWG(l, WO_WB)}; pg8::StaticOrder S; S.init(M, D, F.G, bx);
            pg8::EpiGate2 E{WSPG(bf16, WS_MRG), D, WSPG(bf16, WS_Z) + ZC_GA, WSPG(bf16, WS_Z) + ZC_GB, INW};
            pg8::gemm_phase<pg8::EpiGate2, pg8::StaticOrder, MK_ALIGN, MK_SP2, true>(F.lds + RING_OFF, g, S, E);
        }
        __syncthreads();
#else
        if (IN(p0 + LP_GA)) {
            pg8::Gemm g{WSPG(bf16, WS_YRET), WSWG(l, WO_WA), M, D, RETW}; pg8::StaticOrder S; S.init(M, D, F.G, bx);
            pg8::EpiB<2> E{WSPG(bf16, WS_MRG), D, WSPG(bf16, WS_Z) + ZC_GA, INW, nullptr};
            pg8::gemm_phase<pg8::EpiB<2>, pg8::StaticOrder, MK_ALIGN, MK_SP2>(F.lds + RING_OFF, g, S, E);
        }
        __syncthreads();
        if (IN(p0 + LP_GB)) {
            pg8::Gemm g{WSPG(bf16, WS_YRWKV), WSWG(l, WO_WB), M, D, RWW}; pg8::StaticOrder S; S.init(M, D, F.G, bx);
            pg8::EpiB<3> E{WSPG(bf16, WS_MRG), D, WSPG(bf16, WS_Z) + ZC_GB, INW, nullptr};
            pg8::gemm_phase<pg8::EpiB<3>, pg8::StaticOrder, MK_ALIGN, MK_SP2>(F.lds + RING_OFF, g, S, E);
        }
#endif
        SEAM(p0 + LP_GB);
        if (IN(p0 + LP_GO)) {
            pg8::Gemm g{WSPG(bf16, WS_MRG), WSWG(l, WO_WO), M, D, D}; pg8::StaticOrder S; S.init(M, D, F.G, bx);
            pg8::EpiResNorm E{WSPG(bf16, WS_H), D, WSPG(float, WS_SS)};
            pg8::gemm_phase<pg8::EpiResNorm, pg8::StaticOrder, MK_ALIGN, MK_SP2>(F.lds + RING_OFF, g, S, E);
        }
        SEAM(p0 + LP_GO);
        if (IN(p0 + LP_GUP)) {
            pg8::Gemm g{WSPG(bf16, WS_H), WSWG(l, WO_WUP), M, DFF, D}; pg8::StaticOrder S; S.init(M, DFF, F.G, bx);
            fill_rstd(F, (bx & 7) * RSTD_ROWS, RSTD_ROWS);
            pg8::EpiB<1> E{WSPG(bf16, WS_UP), DFF, nullptr, 0, (const LAS float*)(F.lds + RSTD_OFF), (bx & 7) * 8};
            pg8::gemm_phase<pg8::EpiB<1>, pg8::StaticOrder, MK_ALIGN, MK_SP2>(F.lds + RING_OFF, g, S, E);
        }
        SEAM(p0 + LP_GUP);
        if (IN(p0 + LP_GDN)) {
            pg8::Gemm g{WSPG(bf16, WS_UP), WSWG(l, WO_WDN), M, D, DFF}; pg8::StaticOrder S; S.init(M, D, F.G, bx);
            pg8::EpiResNorm E{WSPG(bf16, WS_H), D, WSPG(float, WS_SS)};
            pg8::gemm_phase<pg8::EpiResNorm, pg8::StaticOrder, MK_ALIGN, MK_SP2>(F.lds + RING_OFF, g, S, E);
        }
        SEAM(p0 + LP_GDN);
    }
    if (IN(PH_FIN)) { RETID(); ph_final(F, ap); }
#undef IN
#undef SEAM
}

extern "C" void kernel_launch(void* const* d_in, const int* in_sizes, int n_in, void* d_out, int out_size, void* d_ws, size_t ws_size, hipStream_t stream) {
    static int grid = 0;
    if (grid == 0) {
        if (n_in != 24 || in_sizes[0] != M * D || out_size != M * D || ws_size < WS_END) { fprintf(stderr, "kernel_launch: built for 24 inputs, x and out of %d floats, >= %zu bytes of workspace; got n_in %d, in0 %d, out %d, ws %zu; nothing launched\n", M * D, (size_t)WS_END, n_in, n_in > 0 ? in_sizes[0] : -1, out_size, ws_size); grid = -1; return; }
        int dev = 0, cus = 0, per_cu = 0;
        if (hipGetDevice(&dev) != hipSuccess || hipDeviceGetAttribute(&cus, hipDeviceAttributeMultiprocessorCount, dev) != hipSuccess) { fprintf(stderr, "kernel_launch: hipGetDevice / hipDeviceGetAttribute failed; nothing launched\n"); grid = -1; return; }
        if (hipFuncSetAttribute((const void*)hybrid_fwd, hipFuncAttributeMaxDynamicSharedMemorySize, LDS_BYTES) != hipSuccess) { fprintf(stderr, "kernel_launch: hipFuncSetAttribute failed\n"); grid = -1; return; }
        if (hipOccupancyMaxActiveBlocksPerMultiprocessor(&per_cu, (const void*)hybrid_fwd, NWAVES * 64, LDS_BYTES) != hipSuccess || per_cu < 1)
            fprintf(stderr, "kernel_launch: note: the occupancy query reports %d workgroups per CU\n", per_cu);
        (void)hipGetLastError();
        if (cus < 256) { fprintf(stderr, "kernel_launch: built for a 256-CU device (MI355X); this one reports %d CUs; nothing launched\n", cus); grid = -1; return; }
        grid = 256;
    }
    if (grid < 0) return;
    if (hipMemsetAsync((char*)d_ws + WS_CTL, 0, CTL_ZERO_BYTES, stream) != hipSuccess) { fprintf(stderr, "kernel_launch: hipMemsetAsync failed\n"); return; }
    Args a{};
    for (int i = 0; i < 24; ++i) a.in[i] = (const float*)d_in[i];
    a.out = (float*)d_out; a.ws = (unsigned char*)d_ws; a.li = 0; a.pad = 0;
#if MK_ONE_LAUNCH
    a.ph_lo = 0; a.ph_hi = NPH;
    hipLaunchKernelGGL(hybrid_fwd, dim3(grid), dim3(NWAVES * 64), LDS_BYTES, stream, a);
#else
    for (int p = 0; p < NPH; ++p) {
        a.ph_lo = p; a.ph_hi = p + 1;
        hipLaunchKernelGGL(hybrid_fwd, dim3(grid), dim3(NWAVES * 64), LDS_BYTES, stream, a);
    }
#endif
    const hipError_t le = hipPeekAtLastError();
    if (le != hipSuccess) fprintf(stderr, "kernel_launch: launch failed: %s\n", hipGetErrorName(le));
}
```

```cpp
#include <hip/hip_runtime.h>
#include <cstdio>
#include <cstdint>
#ifndef MK_GLOBAL_GROUPS
#define MK_GLOBAL_GROUPS 30
#endif
#ifndef MK_REP
#define MK_REP 0
#endif
namespace pg8 {
#define PG8_LAS __attribute__((address_space(3)))
typedef unsigned short bf16_t;
typedef short bf16x8 __attribute__((ext_vector_type(8)));
typedef float f32x4 __attribute__((ext_vector_type(4)));
typedef unsigned u32x4 __attribute__((ext_vector_type(4)));
constexpr int BM = 256, BK = 64, HALF = 128, HTB = HALF * BK * 2  , STAGE_BYTES = 8 * HTB, NXCD = 8, WGM = 4;

__host__ __device__ __forceinline__ int lds_byte(int r, int c) { const int st = (r >> 4) * 2 + (c >> 5), rr = r & 15, cc = c & 31, ob = rr * 64 + cc * 2; return st * 1024 + (ob ^ (((ob >> 9) & 1) << 5)); }
__host__ __device__ __forceinline__ void stage_rc(int b, int& R, int& C) { const int st = b / 1024, sb = b % 1024, swz = sb ^ (((sb >> 9) & 1) << 5); R = (st >> 1) * 16 + swz / 64; C = (st & 1) * 32 + (swz % 64) / 2; }
__host__ __device__ __forceinline__ int perm32(int rho) { const int n = rho >> 4, i = rho & 15; return 8 * (i >> 2) + 4 * n + (i & 3); }

struct Unit { int pm, pn; };
struct Gemm { const bf16_t* A; const bf16_t* Bt; int M, N, K; const bf16_t* A2 = nullptr; const bf16_t* Bt2 = nullptr; };

struct StaticOrder {
    int nM, nN, nwg, G, c;
    __host__ __device__ void init(int M, int N, int G_, int c_) { nM = M / BM; nN = N / BM; nwg = nM * nN; G = G_; c = c_; }
    __host__ __device__ bool next(int i, Unit& u) const {
        const long L = (long)i * G + c; if (L >= nwg) return false;
        int wgid = (int)L; { const int q = nwg / NXCD, r = nwg % NXCD, xcd = wgid % NXCD, off = wgid / NXCD; wgid = (xcd < r ? xcd * (q + 1) : r * (q + 1) + (xcd - r) * q) + off; }
        const int nig = WGM * nN, gid = wgid / nig, fm = gid * WGM, gsz = (nM - fm) < WGM ? (nM - fm) : WGM;
        u.pm = fm + ((wgid % nig) % gsz); u.pn = (wgid % nig) / gsz; return true;
    }
    __device__ __forceinline__ void a_ready(const Unit&) const {}
    __device__ __forceinline__ void done(const Unit&) const {}
};

struct OneUnit {
    int pm, pn;
    __host__ __device__ bool next(int i, Unit& u) const { if (i != 0) return false; u.pm = pm; u.pn = pn; return true; }
    __device__ __forceinline__ void a_ready(const Unit&) const {}
    __device__ __forceinline__ void done(const Unit&) const {}
};

typedef float f32x2c __attribute__((ext_vector_type(2))); typedef __bf16 bf16x2c __attribute__((ext_vector_type(2)));
__device__ __forceinline__ unsigned cvt_pk_bf16(float lo, float hi) { const f32x2c v = {lo, hi}; return __builtin_bit_cast(unsigned, __builtin_convertvector(v, bf16x2c)); }
typedef float f32x2 __attribute__((ext_vector_type(2)));
__device__ __forceinline__ float bf_lo(unsigned w) { return __builtin_bit_cast(float, w << 16); }
__device__ __forceinline__ float bf_hi(unsigned w) { return __builtin_bit_cast(float, w & 0xffff0000u); }
__device__ __forceinline__ float sigmoidf_(float x) { return 1.0f / (1.0f + __expf(-x)); }
template <int MODE> struct EpiB {
    static constexpr bool PERM = true, AFTER_DRAIN = false;
    bf16_t* O; int ldc; const bf16_t* gate; int ldg; const PG8_LAS float* rl; int pm0;
    __device__ __forceinline__ void operator()(const f32x4 (&acc)[2][2][4][2], const Unit& u, int wr, int wc, int fr, int fq) const {
        const int row0 = u.pm * BM + wr * 64 + fr, col0 = u.pn * BM + wc * 32 + 8 * fq;
        float rs[2][4];
        if (MODE <= 1) { int fo = wr * 64 + fr; asm volatile("" : "+v"(fo));
            const PG8_LAS float* r = rl + (u.pm - pm0) * BM + fo;
#pragma unroll
            for (int ai = 0; ai < 2; ++ai)
#pragma unroll
                for (int m = 0; m < 4; ++m) rs[ai][m] = r[ai * HALF + m * 16]; }
#pragma unroll
        for (int ai = 0; ai < 2; ++ai)
#pragma unroll
            for (int m = 0; m < 4; ++m) { const size_t row = (size_t)(row0 + ai * HALF + m * 16);
#pragma unroll
                for (int bj = 0; bj < 2; ++bj) { f32x4 v0 = acc[ai][bj][m][0], v1 = acc[ai][bj][m][1]; const int c = col0 + bj * HALF;
                    if (MODE <= 1) { v0 = v0 * rs[ai][m]; v1 = v1 * rs[ai][m]; }
                    if (MODE == 1) {
#pragma unroll
                        for (int j = 0; j < 4; ++j) { const float a = fmaxf(v0[j], 0.f), b = fmaxf(v1[j], 0.f); v0[j] = a * a; v1[j] = b * b; } }
                    if (MODE >= 2) { const u32x4 g = *(const u32x4*)(gate + row * ldg + c);
                        v0[0] *= sigmoidf_(bf_lo(g.x)); v0[1] *= sigmoidf_(bf_hi(g.x)); v0[2] *= sigmoidf_(bf_lo(g.y)); v0[3] *= sigmoidf_(bf_hi(g.y));
                        v1[0] *= sigmoidf_(bf_lo(g.z)); v1[1] *= sigmoidf_(bf_hi(g.z)); v1[2] *= sigmoidf_(bf_lo(g.w)); v1[3] *= sigmoidf_(bf_hi(g.w)); }
                    if (MODE == 3) { const u32x4 o = *(const u32x4*)(O + row * ldc + c);
                        v0[0] += bf_lo(o.x); v0[1] += bf_hi(o.x); v0[2] += bf_lo(o.y); v0[3] += bf_hi(o.y);
                        v1[0] += bf_lo(o.z); v1[1] += bf_hi(o.z); v1[2] += bf_lo(o.w); v1[3] += bf_hi(o.w); }
                    u32x4 w; w.x = cvt_pk_bf16(v0[0], v0[1]); w.y = cvt_pk_bf16(v0[2], v0[3]); w.z = cvt_pk_bf16(v1[0], v1[1]); w.w = cvt_pk_bf16(v1[2], v1[3]);
                    *(u32x4*)(O + row * ldc + c) = w; } }
    }
};
struct EpiResNorm {
    static constexpr bool PERM = true, AFTER_DRAIN = false;
    bf16_t* XB; int ldc; float* SS;
    __device__ __forceinline__ void operator()(const f32x4 (&acc)[2][2][4][2], const Unit& u, int wr, int wc, int fr, int fq) const {
        const int row0 = u.pm * BM + wr * 64 + fr, col0 = u.pn * BM + wc * 32 + 8 * fq;
#pragma unroll
        for (int ai = 0; ai < 2; ++ai) {
            u32x4 o[4][2];
#pragma unroll
            for (int m = 0; m < 4; ++m)
#pragma unroll
                for (int bj = 0; bj < 2; ++bj) o[m][bj] = *(const u32x4*)(XB + (size_t)(row0 + ai * HALF + m * 16) * ldc + col0 + bj * HALF);
#pragma unroll
            for (int m = 0; m < 4; ++m) { const size_t row = (size_t)(row0 + ai * HALF + m * 16);
                float s = 0.f;
#pragma unroll
                for (int bj = 0; bj < 2; ++bj) { const int c = col0 + bj * HALF; const u32x4 r = o[m][bj];
                    f32x4 x0 = acc[ai][bj][m][0], x1 = acc[ai][bj][m][1];
                    x0[0] += bf_lo(r.x); x0[1] += bf_hi(r.x); x0[2] += bf_lo(r.y); x0[3] += bf_hi(r.y); x1[0] += bf_lo(r.z); x1[1] += bf_hi(r.z); x1[2] += bf_lo(r.w); x1[3] += bf_hi(r.w);
                    u32x4 w; w.x = cvt_pk_bf16(x0[0], x0[1]); w.y = cvt_pk_bf16(x0[2], x0[3]); w.z = cvt_pk_bf16(x1[0], x1[1]); w.w = cvt_pk_bf16(x1[2], x1[3]);
                    *(u32x4*)(XB + row * ldc + c) = w;
                    s += ((x0[0] * x0[0] + x0[1] * x0[1]) + (x0[2] * x0[2] + x0[3] * x0[3])) + ((x1[0] * x1[0] + x1[1] * x1[1]) + (x1[2] * x1[2] + x1[3] * x1[3])); }
                s += __shfl_xor(s, 16); s += __shfl_xor(s, 32);
                if (fq == 0) SS[row * 32 + u.pn * 4 + wc] = s; } }
    }
};

struct EpiGate2 {
    static constexpr bool PERM = true, AFTER_DRAIN = false;
    bf16_t* O; int ldc; const bf16_t* ga; const bf16_t* gb; int ldg;
    static __device__ __forceinline__ float en(float g) { return __expf(-fmaxf(g, -60.f)); }
    __device__ __forceinline__ void mid(f32x4 (&acc)[2][2][4][2], const Unit& u, int wr, int wc, int fr, int fq) const {
        const int row0 = u.pm * BM + wr * 64 + fr, col0 = u.pn * BM + wc * 32 + 8 * fq;
        int r = row0;
#pragma unroll
        for (int ai = 0; ai < 2; ++ai) {
            asm volatile("" : "+v"(r));
            u32x4 a[4][2], b[4][2];
#pragma unroll
            for (int m = 0; m < 4; ++m)
#pragma unroll
                for (int bj = 0; bj < 2; ++bj) { const size_t o = (size_t)(r + ai * HALF + m * 16) * ldg + col0 + bj * HALF; a[m][bj] = *(const u32x4*)(ga + o); b[m][bj] = *(const u32x4*)(gb + o); }
            __builtin_amdgcn_sched_barrier(0);
#pragma unroll
            for (int m = 0; m < 4; ++m) {
#pragma unroll
                for (int bj = 0; bj < 2; ++bj) { const u32x4 x = a[m][bj], y = b[m][bj]; f32x4& v0 = acc[ai][bj][m][0]; f32x4& v1 = acc[ai][bj][m][1];
                    v0[0] *= (1.f + en(bf_lo(y.x))) * __builtin_amdgcn_rcpf(1.f + en(bf_lo(x.x))); v0[1] *= (1.f + en(bf_hi(y.x))) * __builtin_amdgcn_rcpf(1.f + en(bf_hi(x.x)));
                    v0[2] *= (1.f + en(bf_lo(y.y))) * __builtin_amdgcn_rcpf(1.f + en(bf_lo(x.y))); v0[3] *= (1.f + en(bf_hi(y.y))) * __builtin_amdgcn_rcpf(1.f + en(bf_hi(x.y)));
                    v1[0] *= (1.f + en(bf_lo(y.z))) * __builtin_amdgcn_rcpf(1.f + en(bf_lo(x.z))); v1[1] *= (1.f + en(bf_hi(y.z))) * __builtin_amdgcn_rcpf(1.f + en(bf_hi(x.z)));
                    v1[2] *= (1.f + en(bf_lo(y.w))) * __builtin_amdgcn_rcpf(1.f + en(bf_lo(x.w))); v1[3] *= (1.f + en(bf_hi(y.w))) * __builtin_amdgcn_rcpf(1.f + en(bf_hi(x.w))); }
                asm volatile("" : "+v"(acc[ai][0][m][0]), "+v"(acc[ai][0][m][1]), "+v"(acc[ai][1][m][0]), "+v"(acc[ai][1][m][1]));
            }
            __builtin_amdgcn_sched_barrier(0);
        }
    }
    __device__ __forceinline__ void operator()(const f32x4 (&acc)[2][2][4][2], const Unit& u, int wr, int wc, int fr, int fq) const {
        const int row0 = u.pm * BM + wr * 64 + fr, col0 = u.pn * BM + wc * 32 + 8 * fq;
#pragma unroll
        for (int ai = 0; ai < 2; ++ai) {
            u32x4 b[4][2];
#pragma unroll
            for (int m = 0; m < 4; ++m)
#pragma unroll
                for (int bj = 0; bj < 2; ++bj) b[m][bj] = *(const u32x4*)(gb + (size_t)(row0 + ai * HALF + m * 16) * ldg + col0 + bj * HALF);
#pragma unroll
            for (int m = 0; m < 4; ++m)
#pragma unroll
                for (int bj = 0; bj < 2; ++bj) { const u32x4 y = b[m][bj]; f32x4 v0 = acc[ai][bj][m][0], v1 = acc[ai][bj][m][1];
                    v0[0] *= __builtin_amdgcn_rcpf(1.f + en(bf_lo(y.x))); v0[1] *= __builtin_amdgcn_rcpf(1.f + en(bf_hi(y.x))); v0[2] *= __builtin_amdgcn_rcpf(1.f + en(bf_lo(y.y))); v0[3] *= __builtin_amdgcn_rcpf(1.f + en(bf_hi(y.y)));
                    v1[0] *= __builtin_amdgcn_rcpf(1.f + en(bf_lo(y.z))); v1[1] *= __builtin_amdgcn_rcpf(1.f + en(bf_hi(y.z))); v1[2] *= __builtin_amdgcn_rcpf(1.f + en(bf_lo(y.w))); v1[3] *= __builtin_amdgcn_rcpf(1.f + en(bf_hi(y.w)));
                    u32x4 w; w.x = cvt_pk_bf16(v0[0], v0[1]); w.y = cvt_pk_bf16(v0[2], v0[3]); w.z = cvt_pk_bf16(v1[0], v1[1]); w.w = cvt_pk_bf16(v1[2], v1[3]);
                    *(u32x4*)(O + (size_t)(row0 + ai * HALF + m * 16) * ldc + col0 + bj * HALF) = w; }
            __builtin_amdgcn_sched_barrier(0);
        }
    }
};

template <class Epi, class Sched, bool ALIGN_EPI = false, bool SP2 = false, bool SEG2 = false>
__device__ __forceinline__ void gemm_phase(PG8_LAS unsigned char* lds, const Gemm g, const Sched& S, const Epi& E) {
    int tid_ = threadIdx.x; asm volatile("" : "+v"(tid_));
    const int tid = tid_, wid = __builtin_amdgcn_readfirstlane(tid >> 6), lane = tid & 63, wr = wid >> 2, wc = wid & 3, fr = lane & 15, fq = lane >> 4;
    const int K = g.K, nt = K / BK;
    unsigned voffA[2], voffB[2];
#pragma unroll
    for (int i = 0; i < 2; ++i) { int R, C; stage_rc(tid * 16 + i * 8192, R, C); const int Rb = Epi::PERM ? ((R & ~31) + perm32(R & 31)) : R;
        voffA[i] = (unsigned)(R * K + C) * 2u; voffB[i] = (unsigned)(Rb * K + C) * 2u; }
    const size_t kstep = (size_t)(BK * 2);
    const size_t hstep = (size_t)HALF * K * 2;
    const size_t tstep = 2 * hstep;
    const unsigned ldsw = (unsigned)wid * 1024u;
    const int aoff = lds_byte(wr * 64 + fr, fq * 8), boff = lds_byte(wc * 32 + fr, fq * 8);
#define PG8_SA(b, h) (((b) * 2 + (h)) * HTB)
#define PG8_SB(b, h) ((4 + (b) * 2 + (h)) * HTB)
#define PG8_STAGE(bufoff, gbase, voff) do { _Pragma("unroll") for (int _i = 0; _i < 2; ++_i) \
        __builtin_amdgcn_global_load_lds((const unsigned*)((const char*)(gbase) + (voff)[_i]), (PG8_LAS unsigned*)(lds + (bufoff) + ldsw + _i * 8192), 16, 0, 0); } while (0)
#define PG8_LDA(dst, b, h) do { _Pragma("unroll") for (int m = 0; m < 4; ++m) _Pragma("unroll") for (int k = 0; k < 2; ++k) dst[m][k] = *(const PG8_LAS bf16x8*)(lds + PG8_SA(b, h) + aoff + m * 2048 + k * 1024); } while (0)
#define PG8_LDB(dst, b, h) do { _Pragma("unroll") for (int n = 0; n < 2; ++n) _Pragma("unroll") for (int k = 0; k < 2; ++k) dst[n][k] = *(const PG8_LAS bf16x8*)(lds + PG8_SB(b, h) + boff + n * 2048 + k * 1024); } while (0)
#define PG8_MMA(ai, bj, At, Bt) do { __builtin_amdgcn_s_setprio(1); _Pragma("unroll") for (int m = 0; m < 4; ++m) _Pragma("unroll") for (int n = 0; n < 2; ++n) _Pragma("unroll") for (int k = 0; k < 2; ++k) \
        acc[ai][bj][m][n] = __builtin_amdgcn_mfma_f32_16x16x32_bf16(Bt[n][k], At[m][k], acc[ai][bj][m][n], 0, 0, 0); __builtin_amdgcn_s_setprio(0); } while (0)
#define PG8_WAIT_V(n) asm volatile("s_waitcnt vmcnt(" #n ")" ::: "memory")
#define PG8_WAIT_L(n) asm volatile("s_waitcnt lgkmcnt(" #n ")" ::: "memory")
#define PG8_BAR __builtin_amdgcn_s_barrier()
#define PG8_SCHED __builtin_amdgcn_sched_barrier(0)
    Unit cur, nxt; int ui = 0;
    if (!S.next(0, cur)) return;
    f32x4 acc[2][2][4][2];
#pragma unroll
    for (int a = 0; a < 2; ++a)
#pragma unroll
        for (int b = 0; b < 2; ++b)
#pragma unroll
            for (int m = 0; m < 4; ++m)
#pragma unroll
                for (int n = 0; n < 2; ++n) acc[a][b][m][n] = (f32x4){0.f, 0.f, 0.f, 0.f};
    bf16x8 At[4][2], B0[2][2], B1[2][2];
    const char* cA = (const char*)g.A + (size_t)cur.pm * tstep; const char* cB = (const char*)g.Bt + (size_t)cur.pn * tstep;
    S.a_ready(cur);
    if constexpr (SP2) {
        PG8_STAGE(PG8_SB(0, 0), cB, voffB); PG8_STAGE(PG8_SB(0, 1), cB + hstep, voffB); PG8_STAGE(PG8_SA(0, 0), cA, voffA); PG8_STAGE(PG8_SA(0, 1), cA + hstep, voffA);
        if (wr == 1) PG8_BAR;
        PG8_WAIT_V(2); PG8_BAR;
        PG8_STAGE(PG8_SB(1, 0), cB + kstep, voffB); PG8_STAGE(PG8_SA(1, 0), cA + kstep, voffA); PG8_STAGE(PG8_SB(1, 1), cB + hstep + kstep, voffB);
        PG8_WAIT_V(6); PG8_BAR;
    } else {
        PG8_STAGE(PG8_SB(0, 0), cB, voffB); PG8_STAGE(PG8_SA(0, 0), cA, voffA); PG8_STAGE(PG8_SB(0, 1), cB + hstep, voffB); PG8_STAGE(PG8_SA(0, 1), cA + hstep, voffA);
        if (wr == 1) PG8_BAR;
        PG8_WAIT_V(4); PG8_BAR;
        PG8_STAGE(PG8_SB(1, 0), cB + kstep, voffB); PG8_STAGE(PG8_SA(1, 0), cA + kstep, voffA); PG8_STAGE(PG8_SB(1, 1), cB + hstep + kstep, voffB);
        PG8_WAIT_V(6); PG8_BAR;
    }
    int seg = 0;
    for (;;) {
        bool has_next; const char* nA; const char* nB;
        if (SEG2 && seg == 0) { has_next = true; nxt = cur; nA = (const char*)g.A2 + (size_t)cur.pm * tstep; nB = (const char*)g.Bt2 + (size_t)cur.pn * tstep; }
        else { has_next = S.next(ui + 1, nxt); nA = has_next ? (const char*)g.A + (size_t)nxt.pm * tstep : cA; nB = has_next ? (const char*)g.Bt + (size_t)nxt.pn * tstep : cB; }
        for (int t = 0; t < nt; t += 2) {
            const bool last = (t == nt - 2);
            const char* a1 = cA + (size_t)(t + 1) * kstep;
            const char* a2 = last ? nA : cA + (size_t)(t + 2) * kstep; const char* b2 = last ? nB : cB + (size_t)(t + 2) * kstep;
            const char* a3 = a2 + kstep; const char* b3 = b2 + kstep;
            if (last && has_next && !(SEG2 && seg == 0)) S.a_ready(nxt);
            if constexpr (SP2) {
            PG8_LDB(B0, 0, 0); PG8_LDB(B1, 0, 1); PG8_SCHED; PG8_LDA(At, 0, 0); PG8_STAGE(PG8_SA(1, 1), a1 + hstep, voffA);
            PG8_WAIT_V(8); PG8_WAIT_L(0); PG8_BAR; PG8_MMA(0, 0, At, B0); PG8_MMA(0, 1, At, B1); PG8_BAR; PG8_SCHED;
            PG8_LDA(At, 0, 1); PG8_STAGE(PG8_SB(0, 0), b2, voffB); PG8_STAGE(PG8_SB(0, 1), b2 + hstep, voffB); PG8_STAGE(PG8_SA(0, 0), a2, voffA);
            PG8_WAIT_V(8); PG8_WAIT_L(0); PG8_BAR; PG8_MMA(1, 0, At, B0); PG8_MMA(1, 1, At, B1); PG8_BAR; PG8_SCHED;
            PG8_LDB(B0, 1, 0); PG8_LDB(B1, 1, 1); PG8_SCHED; PG8_LDA(At, 1, 0); PG8_STAGE(PG8_SA(0, 1), a2 + hstep, voffA);
            PG8_WAIT_V(8); PG8_WAIT_L(0); PG8_BAR; PG8_MMA(0, 0, At, B0); PG8_MMA(0, 1, At, B1); PG8_BAR; PG8_SCHED;
            PG8_LDA(At, 1, 1); PG8_STAGE(PG8_SB(1, 0), b3, voffB); PG8_STAGE(PG8_SB(1, 1), b3 + hstep, voffB); PG8_STAGE(PG8_SA(1, 0), a3, voffA);
            PG8_WAIT_V(8); PG8_WAIT_L(0); PG8_BAR; PG8_MMA(1, 0, At, B0); PG8_MMA(1, 1, At, B1); PG8_BAR; PG8_SCHED;
            } else {
            PG8_LDB(B0, 0, 0); PG8_SCHED; PG8_LDA(At, 0, 0); PG8_STAGE(PG8_SA(1, 1), a1 + hstep, voffA);
            PG8_WAIT_L(8); PG8_BAR; PG8_WAIT_L(0); PG8_MMA(0, 0, At, B0); PG8_BAR; PG8_SCHED;
            PG8_LDB(B1, 0, 1); PG8_STAGE(PG8_SB(0, 0), b2, voffB);
            PG8_BAR; PG8_WAIT_L(0); PG8_MMA(0, 1, At, B1); PG8_BAR;
            PG8_LDA(At, 0, 1); PG8_STAGE(PG8_SA(0, 0), a2, voffA);
            PG8_BAR; PG8_WAIT_L(0); PG8_MMA(1, 0, At, B0); PG8_BAR; PG8_SCHED;
            PG8_STAGE(PG8_SB(0, 1), b2 + hstep, voffB);
            PG8_WAIT_V(6); PG8_BAR; PG8_MMA(1, 1, At, B1); PG8_BAR;
            PG8_LDB(B0, 1, 0); PG8_SCHED; PG8_LDA(At, 1, 0); PG8_STAGE(PG8_SA(0, 1), a2 + hstep, voffA);
            PG8_WAIT_L(8); PG8_BAR; PG8_WAIT_L(0); PG8_MMA(0, 0, At, B0); PG8_BAR; PG8_SCHED;
            PG8_LDB(B1, 1, 1); PG8_STAGE(PG8_SB(1, 0), b3, voffB);
            PG8_BAR; PG8_WAIT_L(0); PG8_MMA(0, 1, At, B1); PG8_BAR;
            PG8_LDA(At, 1, 1); PG8_STAGE(PG8_SA(1, 0), a3, voffA);
            PG8_BAR; PG8_WAIT_L(0); PG8_MMA(1, 0, At, B0); PG8_BAR; PG8_SCHED;
            PG8_STAGE(PG8_SB(1, 1), b3 + hstep, voffB);
            PG8_WAIT_V(6); PG8_BAR; PG8_MMA(1, 1, At, B1); PG8_BAR;
            }
        }
        if constexpr (ALIGN_EPI) { if (wr == 0) PG8_BAR; }
        if constexpr (SEG2) {
            int t2 = tid, pm2 = cur.pm, pn2 = cur.pn; asm volatile("" : "+v"(t2), "+s"(pm2), "+s"(pn2));
            const int l2 = t2 & 63, w2 = __builtin_amdgcn_readfirstlane(t2 >> 6); const Unit u2{pm2, pn2};
            if (seg == 0) { E.mid(acc, u2, w2 >> 2, w2 & 3, l2 & 15, l2 >> 4); seg = 1; cA = nA; cB = nB; if constexpr (ALIGN_EPI) { if (wr == 1) PG8_BAR; } continue; }
            seg = 0; E(acc, u2, w2 >> 2, w2 & 3, l2 & 15, l2 >> 4); S.done(cur);
        } else
        if constexpr (!Epi::AFTER_DRAIN) { E(acc, cur, wr, wc, fr, fq); S.done(cur); }
        if (!has_next) break;
#pragma unroll
        for (int a = 0; a < 2; ++a)
#pragma unroll
            for (int b = 0; b < 2; ++b)
#pragma unroll
                for (int m = 0; m < 4; ++m)
#pragma unroll
                    for (int n = 0; n < 2; ++n) acc[a][b][m][n] = (f32x4){0.f, 0.f, 0.f, 0.f};
        cur = nxt; cA = nA; cB = nB; ++ui;
        if constexpr (ALIGN_EPI) { if (wr == 1) PG8_BAR; }
    }
    PG8_WAIT_V(0);
    if constexpr (!ALIGN_EPI) { if (wr == 0) PG8_BAR; }
    PG8_BAR;
    if constexpr (Epi::AFTER_DRAIN) { E.fused(acc, cur, wr, wc, fr, fq, lds, wid, lane); S.done(cur); }
#undef PG8_SA
#undef PG8_SB
#undef PG8_STAGE
#undef PG8_LDA
#undef PG8_LDB
#undef PG8_MMA
#undef PG8_WAIT_V
#undef PG8_WAIT_L
#undef PG8_BAR
#undef PG8_SCHED
}
}
constexpr int NWAVES = 8;
#ifndef MK_ONE_LAUNCH
#define MK_ONE_LAUNCH 1
#endif

#ifndef MK_GLOBAL_GROUPS
#define MK_GLOBAL_GROUPS 30
#endif
#ifndef MK_CHUNKED
#define MK_CHUNKED 1
#endif
#ifndef MK_SP2
#define MK_SP2 true
#endif
#ifndef MK_ALIGN
#define MK_ALIGN true
#endif
#ifndef MK_CONV_IN_G1
#define MK_CONV_IN_G1 0
#endif
#ifndef MK_X2_NT
#define MK_X2_NT 0
#endif
#ifndef MK_STAGGER_G1
#define MK_STAGGER_G1 0
#endif
#ifndef MK_TAIL_IN_SCAN
#define MK_TAIL_IN_SCAN 1
#endif
#ifndef MK_CONV_X2_PCT
#define MK_CONV_X2_PCT 60
#endif
#ifndef MK_FUSE_GAB
#define MK_FUSE_GAB 1
#endif
#ifndef MK_REP
#define MK_REP 0
#endif

constexpr int BATCH = 2, SEQ = 8192, D = 2048, DEPTH = 4, M = BATCH * SEQ;
constexpr int RETW = 1024, RH = 8, RD = 128, RWW = 1024, WH = 16, WD = 64;
constexpr int INW = 11520, DFF = 8192, RWSHIFT = 3328;
constexpr int ZC_Q = 0, ZC_K = 1024, ZC_V = 2048, ZC_GR = 3072, ZC_RW = 4096, ZC_GA = 7424, ZC_GB = 9472;
constexpr int RWC_R = 0, RWC_K = 1024, RWC_V = 2048, RWC_W = 3072, RWC_A = 3136, RWC_G = 3200;
constexpr float NORM_EPS = 1e-6f, RET_GN_EPS = 1e-5f, RWKV_LN_EPS = 64e-5f;

constexpr size_t MiB = 1u << 20;
constexpr size_t WS_CTL = 0, CTL_ZERO_BYTES = 1 * MiB;
constexpr size_t WS_ROPE = 1 * MiB;
constexpr size_t WS_WSET = 16 * MiB, WSET_BYTES = 126 * MiB;
constexpr size_t WO_WIN = 0, WO_WA = 45 * MiB, WO_WB = 49 * MiB, WO_WO = 53 * MiB, WO_WUP = 61 * MiB, WO_WDN = 93 * MiB, WO_LORA = 125 * MiB;
constexpr size_t WS_H = 272 * MiB;
constexpr size_t WS_Z = 336 * MiB;
constexpr size_t WS_UP = WS_Z;
constexpr size_t WS_QR = 696 * MiB, WS_KR = 728 * MiB;
constexpr size_t WS_YRET = 760 * MiB, WS_YRWKV = 792 * MiB;
constexpr size_t WS_MRG = 824 * MiB;
#if MK_CHUNKED
constexpr size_t WS_SR = 888 * MiB, WS_SV = 1208 * MiB;
#else
constexpr size_t WS_SR = 888 * MiB, WS_SW = 952 * MiB, WS_SK = 1016 * MiB, WS_SV = 1080 * MiB, WS_SNKK = 1144 * MiB, WS_SKKA = 1208 * MiB;
#endif
constexpr size_t WS_CU = WS_SR;
constexpr size_t WS_G = 1272 * MiB;
constexpr size_t WS_BONUS = 1336 * MiB;
constexpr size_t WS_SS = 1337 * MiB;
constexpr size_t WS_YRAWW = WS_MRG;
constexpr size_t WS_END = 1341 * MiB;
constexpr int CW_BAR = 4096;

constexpr int PPL = 9;
enum { LP_G1 = 0, LP_PREP, LP_SCAN, LP_POST, LP_GA, LP_GB, LP_GO, LP_GUP, LP_GDN };
constexpr int PH_PRO = 0, PH_L0 = 1, PH_FIN = PH_L0 + DEPTH * PPL, NPH = PH_FIN + 1;

constexpr int RING_OFF = 0, RING_BYTES = 131072;
constexpr int LDSCTL_OFF = RING_BYTES, MISC_OFF = LDSCTL_OFF + 320;
constexpr int LDS_BYTES = 147456;
constexpr int RSTD_OFF = LDSCTL_OFF + 1024, RSTD_ROWS = 2048;
static_assert(MISC_OFF + 128 <= RSTD_OFF && RSTD_OFF + RSTD_ROWS * 4 <= LDS_BYTES, "LDS map");

#define GAS __attribute__((address_space(1)))
#define LAS __attribute__((address_space(3)))
typedef unsigned short bf16;
typedef unsigned v4u __attribute__((ext_vector_type(4)));
typedef unsigned v2u __attribute__((ext_vector_type(2)));
typedef float f32x4 __attribute__((ext_vector_type(4)));
typedef float f32x2 __attribute__((ext_vector_type(2)));
typedef short bf16x8 __attribute__((ext_vector_type(8)));
typedef GAS unsigned gu32;
#define LDS_WAIT() asm volatile("s_waitcnt lgkmcnt(0)" ::: "memory")
#define VM_WAIT() asm volatile("s_waitcnt vmcnt(0)" ::: "memory")
__device__ __forceinline__ unsigned f2bf(float f) { unsigned u = __builtin_bit_cast(unsigned, f); return (u + 0x7fffu + ((u >> 16) & 1u)) >> 16; }
__device__ __forceinline__ unsigned pk2(float lo, float hi) { return f2bf(lo) | (f2bf(hi) << 16); }
__device__ __forceinline__ float bf2f(bf16 v) { return __builtin_bit_cast(float, (unsigned)v << 16); }
__device__ __forceinline__ float rdlane(float v, int l) { return __builtin_bit_cast(float, __builtin_amdgcn_readlane(__builtin_bit_cast(int, v), l)); }
__device__ __forceinline__ float sigm(float x) { return 1.0f / (1.0f + expf(-x)); }

__device__ const double ROPE_REV[64] = {
0.15915494309189535, 0.13782250260398285, 0.11934937021124886, 0.10335229661843406,
0.08949940160889101, 0.07750328875537406, 0.06711508300522726, 0.058119267441876246,
0.050329212104487035, 0.04358330210530733, 0.03774158471741977, 0.032682865872357,
0.0283021958306234, 0.024508691862069852, 0.02122365276477766, 0.018378926105679667,
0.015915494309189534, 0.013782250260398284, 0.011934937021124886, 0.010335229661843406,
0.008949940160889102, 0.0077503288755374055, 0.006711508300522725, 0.005811926744187624,
0.005032921210448704, 0.004358330210530733, 0.003774158471741977, 0.0032682865872356993,
0.00283021958306234, 0.002450869186206985, 0.0021223652764777662, 0.0018378926105679667,
0.0015915494309189536, 0.0013782250260398288, 0.0011934937021124885, 0.0010335229661843405,
0.0008949940160889102, 0.0007750328875537405, 0.0006711508300522726, 0.0005811926744187624,
0.0005032921210448703, 0.0004358330210530733, 0.00037741584717419774, 0.0003268286587235699,
0.00028302195830623395, 0.00024508691862069854, 0.0002122365276477766, 0.00018378926105679666,
0.00015915494309189535, 0.00013782250260398286, 0.00011934937021124886, 0.00010335229661843406,
8.949940160889102e-05, 7.750328875537406e-05, 6.711508300522725e-05, 5.811926744187624e-05,
5.0329212104487035e-05, 4.358330210530732e-05, 3.774158471741978e-05, 3.2682865872357e-05,
2.8302195830623396e-05, 2.4508691862069852e-05, 2.122365276477766e-05, 1.8378926105679668e-05 };

#define XB_TMO      128
#define XB_XCNT(j)  (256  + 64 * (j))
#define XB_XSUB(j)  (1280 + 64 * (j))
#define XB_XGEN(j)  (2304 + 64 * (j))
#define XB_TOP      3328
#define XB_TOPGEN   3392
#define XCD_BAR_WORDS 3456
#define XB_SPIN_CAP (1u << 18)

__device__ __forceinline__ unsigned xb_ld(unsigned* p)              { return __hip_atomic_load(p, __ATOMIC_RELAXED, __HIP_MEMORY_SCOPE_AGENT); }
__device__ __forceinline__ unsigned xb_add(unsigned* p, unsigned v) { return __hip_atomic_fetch_add(p, v, __ATOMIC_RELAXED, __HIP_MEMORY_SCOPE_AGENT); }
__device__ __forceinline__ unsigned xb_xcc_id() { return (unsigned)__builtin_amdgcn_s_getreg((3 << 11) | 20) & 0xFu; }
#define XB_SPIN(cond, bar) do { unsigned _sp = 0; while (cond) { __builtin_amdgcn_s_sleep(1); \
    if ((++_sp & 255u) == 0u) { if (xb_ld(&(bar)[XB_TMO])) break; if (_sp > XB_SPIN_CAP) { atomicAdd(&(bar)[XB_TMO], 1u); break; } } } } while (0)

struct XcdBarrier {
    unsigned* bar; unsigned x;
    volatile LAS unsigned* st;
};

__device__ __forceinline__ XcdBarrier xcd_barrier_post(unsigned* bar, volatile LAS unsigned* st) {
    XcdBarrier b; b.bar = bar; b.x = xb_xcc_id(); b.st = st;
    if (threadIdx.x == 0) (void)xb_add(&bar[XB_XCNT(b.x)], 1u);
    return b;
}
__device__ __forceinline__ void xcd_barrier_complete(unsigned* bar, unsigned x, unsigned& nloc, unsigned& nx) {
    const unsigned G = gridDim.x * gridDim.y * gridDim.z;
    unsigned sum, cnt, mine, sp = 0u;
    for (;;) {
        sum = 0u; cnt = 0u; mine = 0u;
#pragma unroll
        for (unsigned j = 0; j < 16; ++j) { const unsigned c = xb_ld(&bar[XB_XCNT(j)]); sum += c; cnt += (c > 0u) ? 1u : 0u; mine = (j == x) ? c : mine; }
        if (sum == G) break;
        __builtin_amdgcn_s_sleep(1);
        if ((++sp & 255u) == 0u) { if (xb_ld(&bar[XB_TMO])) break; if (sp > XB_SPIN_CAP) { atomicAdd(&bar[XB_TMO], 1u); break; } }
    }
    nloc = mine > 0u ? mine : 1u; nx = cnt > 0u ? cnt : 1u;
}

__device__ __forceinline__ void xcd_barrier(const XcdBarrier& b) {
    asm volatile("s_waitcnt vmcnt(0)" ::: "memory");
    __syncthreads();
    if (threadIdx.x == 0) {
        unsigned* bar = b.bar;
        __builtin_amdgcn_s_waitcnt(0);
        unsigned nloc = b.st[0], nx = b.st[1];
        if (nloc == 0u) { xcd_barrier_complete(bar, b.x, nloc, nx); b.st[0] = nloc; b.st[1] = nx; }
        const unsigned old = xb_add(&bar[XB_XSUB(b.x)], 1u);
        const unsigned gen = old / nloc;
        if (old + 1u == (gen + 1u) * nloc) {
            __builtin_amdgcn_fence(__ATOMIC_RELEASE, "agent");
            asm volatile("s_waitcnt vmcnt(0)" ::: "memory");
            const unsigned og = xb_add(&bar[XB_TOP], 1u);
            const unsigned tg = og / nx;
            if (og + 1u == (tg + 1u) * nx) xb_add(&bar[XB_TOPGEN], 1u);
            else XB_SPIN(xb_ld(&bar[XB_TOPGEN]) == tg, bar);
            __builtin_amdgcn_fence(__ATOMIC_ACQUIRE, "agent");
            xb_add(&bar[XB_XGEN(b.x)], 1u);
            asm volatile("s_waitcnt vmcnt(0)" ::: "memory");
        } else {
            XB_SPIN(xb_ld(&bar[XB_XGEN(b.x)]) == gen, bar);
            __builtin_amdgcn_fence(__ATOMIC_ACQUIRE, "agent");
            asm volatile("s_waitcnt vmcnt(0)" ::: "memory");
        }
    }
    __syncthreads();
}


struct Frame {
    LAS unsigned char* lds;
    volatile LAS unsigned* MISC;
    int tid, lane, wave;
    int vcu, G;
    float* out; unsigned char* ws;
};
struct Args { const float* in[24]; float* out; unsigned char* ws; int ph_lo, ph_hi, li, pad; };
#define WSP(T, off) ((T*)(F.ws + (off)))
#define WSPG(T, off) ((T*)(GAS T*)(unsigned long long)(F.ws + (off)))
#define WSW(l, off) ((bf16*)(F.ws + WS_WSET + (size_t)((l) & 1) * WSET_BYTES + (off)))
#define WSWG(l, off) ((bf16*)(GAS bf16*)(unsigned long long)(F.ws + WS_WSET + (size_t)((l) & 1) * WSET_BYTES + (off)))
#define OUTP ((float*)F.out)
#define OUTPG ((float*)(GAS float*)(unsigned long long)F.out)
#define INP(A, i) ((const float*)((const GAS float*)(A)->in[i]))
#define RETID() do { int t_ = threadIdx.x; asm volatile("" : "+v"(t_)); F.tid = t_; F.lane = t_ & 63; } while (0)
#define CAS __attribute__((address_space(4)))
typedef const CAS Args* ArgP;

__device__ __forceinline__ float fexp(float x) { return __builtin_amdgcn_exp2f(x * 1.4426950408889634f); }
__device__ __forceinline__ float fsig(float x) { return __builtin_amdgcn_rcpf(1.0f + fexp(-x)); }
__device__ __forceinline__ float ftanh(float x) { return 1.0f - 2.0f * __builtin_amdgcn_rcpf(1.0f + fexp(2.0f * x)); }
__device__ __forceinline__ float wave_sum(float v) {
#pragma unroll
    for (int o = 1; o < 64; o <<= 1) v += __shfl_xor(v, o);
    return v;
}
struct TItem { const float* W; bf16* WT; const float* gk; int K, N, item; };
__device__ __forceinline__ void titem_load(const TItem& t, int lane, f32x4 (&v)[8]) {
    const int nblk = t.N / 32, kb = t.item / nblk, nb = t.item % nblk, k0 = 64 * kb, n0 = 32 * nb, nq = lane & 7, kr = lane >> 3;
#pragma unroll
    for (int i = 0; i < 8; ++i) v[i] = __builtin_nontemporal_load((const GAS f32x4*)(t.W + (size_t)(k0 + kr + 8 * i) * t.N + n0 + 4 * nq));
}
__device__ __forceinline__ void titem_finish(const TItem& t, int lane, const f32x4 (&v)[8], LAS float* scr) {
    const int nblk = t.N / 32, kb = t.item / nblk, nb = t.item % nblk, k0 = 64 * kb, n0 = 32 * nb, nq = lane & 7, kr = lane >> 3;
#pragma unroll
    for (int i = 0; i < 8; ++i)
#pragma unroll
        for (int e = 0; e < 4; ++e) scr[(kr + 8 * i) * 33 + 4 * nq + e] = v[i][e];
    const int c = lane & 7;
    f32x4 g0 = (f32x4){1.f, 1.f, 1.f, 1.f}, g1 = g0;
    if (t.gk) { g0 = *(const GAS f32x4*)(t.gk + k0 + 8 * c); g1 = *(const GAS f32x4*)(t.gk + k0 + 8 * c + 4); }
    LDS_WAIT(); asm volatile("" ::: "memory");
#pragma unroll
    for (int j = 0; j < 4; ++j) { const int n = (lane >> 3) + 8 * j; const LAS float* s = scr + (8 * c) * 33 + n;
        v4u o; o.x = pk2(s[0 * 33] * g0.x, s[1 * 33] * g0.y); o.y = pk2(s[2 * 33] * g0.z, s[3 * 33] * g0.w); o.z = pk2(s[4 * 33] * g1.x, s[5 * 33] * g1.y); o.w = pk2(s[6 * 33] * g1.z, s[7 * 33] * g1.w);
        __builtin_nontemporal_store(o, (GAS v4u*)(t.WT + (size_t)(n0 + n) * t.K + k0 + 8 * c)); }
    LDS_WAIT(); asm volatile("" ::: "memory");
}
__device__ __forceinline__ void rms_row_to_bf16(const float* xrow, const float* g, bf16* orow, int lane) {
    const GAS f32x4* xr = (const GAS f32x4*)xrow + lane;
    f32x4 v[8]; float s = 0.f;
#pragma unroll
    for (int j = 0; j < 8; ++j) { v[j] = xr[64 * j]; s += (v[j].x * v[j].x + v[j].y * v[j].y) + (v[j].z * v[j].z + v[j].w * v[j].w); }
    const float rstd = 1.f / sqrtf(wave_sum(s) * (1.f / D) + NORM_EPS);
    const GAS f32x4* gr = (const GAS f32x4*)g + lane;
    GAS v2u* o8 = (GAS v2u*)orow + lane;
#pragma unroll
    for (int j = 0; j < 8; ++j) { const f32x4 gg = gr[64 * j]; v2u o; o.x = pk2(v[j].x * rstd * gg.x, v[j].y * rstd * gg.y); o.y = pk2(v[j].z * rstd * gg.z, v[j].w * rstd * gg.w); o8[64 * j] = o; }
}

__device__ __forceinline__ void fill_rstd(Frame& F, int row0, int nrows) {
    int t_ = threadIdx.x; asm volatile("" : "+v"(t_));
    LAS float* T = (LAS float*)(F.lds + RSTD_OFF);
    for (int r = t_; r < nrows; r += NWAVES * 64) {
        const GAS f32x4* sp = (const GAS f32x4*)(WSPG(float, WS_SS) + (size_t)(row0 + r) * 32);
        f32x4 a = sp[0];
#pragma unroll
        for (int j = 1; j < 8; ++j) a = a + sp[j];
        T[r] = __builtin_amdgcn_rsqf(((a[0] + a[1]) + (a[2] + a[3])) * (1.0f / D) + NORM_EPS);
    }
    __syncthreads();
}
#if (MK_GLOBAL_GROUPS & 1)
#pragma push_macro("WSP")
#pragma push_macro("WSW")
#pragma push_macro("OUTP")
#undef WSP
#undef WSW
#undef OUTP
#define WSP WSPG
#define WSW WSWG
#define OUTP OUTPG
#endif
__device__ __forceinline__ void ph_prologue(Frame& F, ArgP A) {
    const int* pos = (const int*)INP(A, 1); float2* rope = WSP(float2, WS_ROPE);
    {
        const int gw = F.vcu * NWAVES + F.wave, NGW = F.G * NWAVES, lane = F.lane;
        auto load_row = [&](f32x4 (&v)[8], int m) { if (m >= M) m = M - 1; const GAS f32x4* xr = (const GAS f32x4*)(INP(A, 0) + (size_t)m * D) + lane;
#pragma unroll
            for (int j = 0; j < 8; ++j) v[j] = xr[64 * j]; };
        auto do_row = [&](const f32x4 (&v)[8], int m) {
            GAS v2u* hb = (GAS v2u*)(WSP(bf16, WS_H) + (size_t)m * D) + lane; float s = 0.f;
#pragma unroll
            for (int j = 0; j < 8; ++j) { v2u o; o.x = pk2(v[j].x, v[j].y); o.y = pk2(v[j].z, v[j].w); hb[64 * j] = o; s += (v[j].x * v[j].x + v[j].y * v[j].y) + (v[j].z * v[j].z + v[j].w * v[j].w); }
            s = wave_sum(s);
            if (lane < 32) WSP(float, WS_SS)[(size_t)m * 32 + lane] = lane == 0 ? s : 0.f; };
        f32x4 va[8], vb[8];
        if (gw < M) load_row(va, gw);
        for (int m = gw; m < M; m += 2 * NGW) {
            load_row(vb, m + NGW); do_row(va, m);
            if (m + NGW >= M) break;
            load_row(va, m + 2 * NGW); do_row(vb, m + NGW);
        }
    }
    for (int i = F.vcu * 512 + F.tid; i < M * 64; i += F.G * 512) {
        const int m = i >> 6, j = i & 63;
        const double rev = (double)pos[m] * ROPE_REV[j];
        const float fr = (float)(rev - __builtin_rint(rev));
        rope[i] = make_float2(__builtin_amdgcn_cosf(fr), __builtin_amdgcn_sinf(fr));
    }
}
#if (MK_GLOBAL_GROUPS & 1)
#pragma pop_macro("WSP")
#pragma pop_macro("WSW")
#pragma pop_macro("OUTP")
#endif
#if (MK_GLOBAL_GROUPS & 16)
#pragma push_macro("WSP")
#pragma push_macro("WSW")
#pragma push_macro("OUTP")
#undef WSP
#undef WSW
#undef OUTP
#define WSP WSPG
#define WSW WSWG
#define OUTP OUTPG
#endif
__device__ __forceinline__ TItem conv_item(Frame& F, ArgP A, int l, int it) {
    constexpr int I_IN = (D / 64) * (INW / 32), I_A = (RETW / 64) * (D / 32), I_O = (D / 64) * (D / 32), I_UP = (D / 64) * (DFF / 32), I_DN = (DFF / 64) * (D / 32);
    int r = it; TItem t;
    if (r < I_IN) { t = TItem{INP(A, 3) + (size_t)l * D * INW, WSW(l, WO_WIN), INP(A, 2) + (size_t)l * D, D, INW, r}; return t; } r -= I_IN;
    if (r < I_A) { t = TItem{INP(A, 17) + (size_t)l * RETW * D, WSW(l, WO_WA), nullptr, RETW, D, r}; return t; } r -= I_A;
    if (r < I_A) { t = TItem{INP(A, 18) + (size_t)l * RWW * D, WSW(l, WO_WB), nullptr, RWW, D, r}; return t; } r -= I_A;
    if (r < I_O) { t = TItem{INP(A, 19) + (size_t)l * D * D, WSW(l, WO_WO), nullptr, D, D, r}; return t; } r -= I_O;
    if (r < I_UP) { t = TItem{INP(A, 21) + (size_t)l * D * DFF, WSW(l, WO_WUP), INP(A, 20) + (size_t)l * D, D, DFF, r}; return t; } r -= I_UP;
    if (r < I_DN) { t = TItem{INP(A, 22) + (size_t)l * DFF * D, WSW(l, WO_WDN), nullptr, DFF, D, r}; return t; } r -= I_DN;
    if (r < 32) { t = TItem{INP(A, 8) + (size_t)l * 64 * RWW, WSW(l, WO_LORA), nullptr, 64, RWW, r}; return t; } r -= 32;
    if (r < 32) { t = TItem{INP(A, 10) + (size_t)l * 64 * RWW, WSW(l, WO_LORA) + 1024 * 64, nullptr, 64, RWW, r}; return t; } r -= 32;
    t = TItem{INP(A, 11) + (size_t)l * 128 * RWW, WSW(l, WO_LORA) + 2 * 1024 * 64, nullptr, 128, RWW, r}; return t;
}
constexpr int CONV_NITEMS = (D / 64) * (INW / 32) + 2 * (RETW / 64) * (D / 32) + (D / 64) * (D / 32) + (D / 64) * (DFF / 32) + (DFF / 64) * (D / 32) + 32 + 32 + 64;
constexpr int CONV_SPLIT = (int)((long)CONV_NITEMS * (100 - MK_CONV_X2_PCT) / 100);
__device__ __forceinline__ void ph_convert(Frame& F, ArgP A, int l, int wg, int nwg, int lo = 0, int hi = CONV_NITEMS) {
    LAS float* scr = (LAS float*)(F.lds + RING_OFF + F.wave * 16384);
    const int gw = lo + wg * NWAVES + F.wave, NGW = nwg * NWAVES, lane = F.lane;
    if (gw >= hi) return;
    TItem cur = conv_item(F, A, l, gw); f32x4 va[8], vb[8];
    titem_load(cur, lane, va);
    for (int it = gw; it < hi; it += 2 * NGW) {
        TItem nxt = cur; const bool h1 = it + NGW < hi;
        if (h1) { nxt = conv_item(F, A, l, it + NGW); titem_load(nxt, lane, vb); }
        titem_finish(cur, lane, va, scr);
        if (!h1) break;
        const bool h2 = it + 2 * NGW < hi;
        if (h2) { cur = conv_item(F, A, l, it + 2 * NGW); titem_load(cur, lane, va); }
        titem_finish(nxt, lane, vb, scr);
        if (!h2) break;
    }
}
#if (MK_GLOBAL_GROUPS & 16)
#pragma pop_macro("WSP")
#pragma pop_macro("WSW")
#pragma pop_macro("OUTP")
#endif
#if (MK_GLOBAL_GROUPS & 2)
#pragma push_macro("WSP")
#pragma push_macro("WSW")
#pragma push_macro("OUTP")
#undef WSP
#undef WSW
#undef OUTP
#define WSP WSPG
#define WSW WSWG
#define OUTP OUTPG
#endif
__device__ __forceinline__ f32x4 unpk4(const v2u p) { return (f32x4){pg8::bf_lo(p.x), pg8::bf_hi(p.x), pg8::bf_lo(p.y), pg8::bf_hi(p.y)}; }
__device__ __forceinline__ void unpack8(const v4u a, float (&o)[8]) {
    o[0] = pg8::bf_lo(a.x); o[1] = pg8::bf_hi(a.x); o[2] = pg8::bf_lo(a.y); o[3] = pg8::bf_hi(a.y); o[4] = pg8::bf_lo(a.z); o[5] = pg8::bf_hi(a.z); o[6] = pg8::bf_lo(a.w); o[7] = pg8::bf_hi(a.w);
}
__device__ __forceinline__ void mix8(const GAS bf16* zc, bool has_prev, const GAS float* mu, float (&o)[8]) {
    const v4u a = *(const GAS v4u*)zc; v4u p = (v4u){0u, 0u, 0u, 0u}; if (has_prev) p = *(const GAS v4u*)(zc - INW);
    const f32x4 m0 = *(const GAS f32x4*)mu, m1 = *(const GAS f32x4*)(mu + 4);
    float z[8], q[8]; unpack8(a, z); unpack8(p, q);
#pragma unroll
    for (int j = 0; j < 4; ++j) { o[j] = z[j] + m0[j] * (q[j] - z[j]); o[4 + j] = z[4 + j] + m1[j] * (q[4 + j] - z[4 + j]); }
}
__device__ __forceinline__ f32x4 mix4(const GAS bf16* zc, bool has_prev, const GAS float* mu) {
    const v2u a = *(const GAS v2u*)zc; v2u p = (v2u){0u, 0u}; if (has_prev) p = *(const GAS v2u*)(zc - INW);
    const f32x4 m = *(const GAS f32x4*)mu;
    const f32x4 z = (f32x4){pg8::bf_lo(a.x), pg8::bf_hi(a.x), pg8::bf_lo(a.y), pg8::bf_hi(a.y)}, q = (f32x4){pg8::bf_lo(p.x), pg8::bf_hi(p.x), pg8::bf_lo(p.y), pg8::bf_hi(p.y)};
    return z + m * (q - z);
}
__device__ __forceinline__ bf16x8 pack8(const float (&v)[8]) {
    v4u o; o.x = pg8::cvt_pk_bf16(v[0], v[1]); o.y = pg8::cvt_pk_bf16(v[2], v[3]); o.z = pg8::cvt_pk_bf16(v[4], v[5]); o.w = pg8::cvt_pk_bf16(v[6], v[7]);
    return __builtin_bit_cast(bf16x8, o);
}
constexpr int CU_W = 0, CU_R = 2048, CU_BK = 4096, CU_LRB = 8192, CU_PC = 8704, CU_QB = 8960, CU_QSTR = 1536, CU_BYTES = CU_QB + 4 * CU_QSTR;
constexpr int CK = 16, NCHUNK = SEQ / CK;
constexpr int XL_STR = 144, XL_MAT = 16 * XL_STR;
typedef short s4v __attribute__((ext_vector_type(4)));
__device__ __forceinline__ s4v pk4(const f32x4 v) { v2u o; o.x = pg8::cvt_pk_bf16(v[0], v[1]); o.y = pg8::cvt_pk_bf16(v[2], v[3]); return __builtin_bit_cast(s4v, o); }
__device__ __forceinline__ bf16x8 pk8v(const f32x4 a, const f32x4 b) { v4u o; o.x = pg8::cvt_pk_bf16(a[0], a[1]); o.y = pg8::cvt_pk_bf16(a[2], a[3]); o.z = pg8::cvt_pk_bf16(b[0], b[1]); o.w = pg8::cvt_pk_bf16(b[2], b[3]); return __builtin_bit_cast(bf16x8, o); }
__device__ __forceinline__ f32x4 mma16(const s4v x, const s4v y, const f32x4 c) {
    const bf16x8 x8 = (bf16x8){x.x, x.y, x.z, x.w, 0, 0, 0, 0}, y8 = (bf16x8){y.x, y.y, y.z, y.w, 0, 0, 0, 0};
    return __builtin_amdgcn_mfma_f32_16x16x32_bf16(x8, y8, c, 0, 0, 0); }
__device__ __forceinline__ f32x4 mma32(const bf16x8 x, const bf16x8 y, const f32x4 c) { return __builtin_amdgcn_mfma_f32_16x16x32_bf16(x, y, c, 0, 0, 0); }
template <int N> __device__ __forceinline__ float dpp_shr0(float x) { return __builtin_bit_cast(float, __builtin_amdgcn_update_dpp(0, __builtin_bit_cast(int, x), 0x110 + N, 0xF, 0xF, true)); }
__device__ __forceinline__ float dpp_bcast15(float x) { return __builtin_bit_cast(float, __builtin_amdgcn_update_dpp(0, __builtin_bit_cast(int, x), 0x15F, 0xF, 0xF, false)); }
__device__ __forceinline__ float scan16(float x) { x += dpp_shr0<1>(x); x += dpp_shr0<2>(x); x += dpp_shr0<4>(x); x += dpp_shr0<8>(x); return x; }
__device__ __forceinline__ s4v trd(const LAS unsigned char* p) { return __builtin_amdgcn_ds_read_tr16_b64_v4i16((LAS s4v*)p); }
__device__ __forceinline__ void chunk_ops(const f32x4 (&r)[4], const f32x4 (&lw)[4], const f32x4 (&kp)[4], const f32x4 (&v)[4], const f32x4 (&a)[4], const f32x4 (&b)[4],
                                          LAS unsigned char* scr, GAS unsigned char* rec, int lane) {
    const int l15 = lane & 15, g = lane >> 4, tq = l15 >> 2, tp = l15 & 3;
    const f32x4 Z4 = (f32x4){0.f, 0.f, 0.f, 0.f};
    const float first = l15 == 0 ? 1.0f : 0.0f;
    f32x4 Rt[4], pc[4]; bf16x8 Atf[2], Btf[2], Ktf[2], Rtf[2];
    {
        s4v Ah[4], Bq[4], Kq[4], Rq[4];
#pragma unroll
        for (int nt = 0; nt < 4; ++nt) {
            f32x4 cs, tot;
#pragma unroll
            for (int i = 0; i < 4; ++i) { cs[i] = scan16(lw[nt][i]); tot[i] = dpp_bcast15(cs[i]); }
            f32x4 At, Bt, Kt, Bh, Kh;
#pragma unroll
            for (int i = 0; i < 4; ++i) { const float P = fexp(cs[i]), iP = fexp(-cs[i]), pcv = fexp(tot[i]);
                const float Pm1 = dpp_shr0<1>(P) + first, PCP = pcv * iP;
                pc[nt][i] = pcv; At[i] = a[nt][i] * Pm1; Bt[i] = b[nt][i] * iP; Kt[i] = kp[nt][i] * iP; Rt[nt][i] = r[nt][i] * P; Bh[i] = b[nt][i] * PCP; Kh[i] = kp[nt][i] * PCP; }
            Ah[nt] = pk4(At); Bq[nt] = pk4(Bt); Kq[nt] = pk4(Kt); Rq[nt] = pk4(Rt[nt]);
            LAS unsigned char* w = scr + l15 * XL_STR + (16 * nt + 4 * g) * 2;
            *(LAS s4v*)(w + 0 * XL_MAT) = Ah[nt]; *(LAS s4v*)(w + 1 * XL_MAT) = pk4(v[nt]); *(LAS s4v*)(w + 2 * XL_MAT) = pk4(Bh); *(LAS s4v*)(w + 3 * XL_MAT) = pk4(Kh);
        }
#pragma unroll
        for (int s = 0; s < 2; ++s) {
            Atf[s] = (bf16x8){Ah[2 * s].x, Ah[2 * s].y, Ah[2 * s].z, Ah[2 * s].w, Ah[2 * s + 1].x, Ah[2 * s + 1].y, Ah[2 * s + 1].z, Ah[2 * s + 1].w};
            Btf[s] = (bf16x8){Bq[2 * s].x, Bq[2 * s].y, Bq[2 * s].z, Bq[2 * s].w, Bq[2 * s + 1].x, Bq[2 * s + 1].y, Bq[2 * s + 1].z, Bq[2 * s + 1].w};
            Ktf[s] = (bf16x8){Kq[2 * s].x, Kq[2 * s].y, Kq[2 * s].z, Kq[2 * s].w, Kq[2 * s + 1].x, Kq[2 * s + 1].y, Kq[2 * s + 1].z, Kq[2 * s + 1].w};
            Rtf[s] = (bf16x8){Rq[2 * s].x, Rq[2 * s].y, Rq[2 * s].z, Rq[2 * s].w, Rq[2 * s + 1].x, Rq[2 * s + 1].y, Rq[2 * s + 1].z, Rq[2 * s + 1].w}; }
    }
    f32x4 LabR = Z4, LabT = Z4, LakT = Z4, LrbT = Z4, LrkT = Z4;
#pragma unroll
    for (int s = 0; s < 2; ++s) { LabR = mma32(Atf[s], Btf[s], LabR); LabT = mma32(Btf[s], Atf[s], LabT); LakT = mma32(Ktf[s], Atf[s], LakT); LrbT = mma32(Btf[s], Rtf[s], LrbT); LrkT = mma32(Ktf[s], Rtf[s], LrkT); }
    f32x4 IR;
#pragma unroll
    for (int i = 0; i < 4; ++i) { const int tt = 4 * g + i;
        IR[i] = (tt == l15) ? 1.f : 0.f;
        LabR[i] = (tt > l15) ? LabR[i] : 0.f; LabT[i] = (l15 > tt) ? LabT[i] : 0.f; LakT[i] = (l15 > tt) ? LakT[i] : 0.f;
        LrbT[i] = (l15 >= tt) ? LrbT[i] : 0.f; LrkT[i] = (l15 >= tt) ? LrkT[i] : 0.f; }
    const s4v L1R = pk4(LabR), L1T = pk4(LabT);
    const f32x4 L2R = mma16(L1T, L1R, Z4), L2T = mma16(L1R, L1T, Z4);
    const s4v L2Rp = pk4(L2R), L2Tp = pk4(L2T);
    const f32x4 L4R = mma16(L2Tp, L2Rp, Z4), L4T = mma16(L2Rp, L2Tp, Z4);
    const s4v L4Rp = pk4(L4R), L4Tp = pk4(L4T);
    const f32x4 L8R = mma16(L4Tp, L4Rp, Z4);
    const f32x4 T1T = mma16(pk4(IR + L2R), pk4(IR + LabT), Z4);
    const f32x4 T2T = mma16(pk4(IR + L4R), pk4(T1T), Z4);
    const s4v TmT = pk4(mma16(pk4(IR + L8R), pk4(T2T), Z4));
    const s4v LakTp = pk4(LakT), LrbTp = pk4(LrbT), LrkTp = pk4(LrkT);
    asm volatile("s_waitcnt lgkmcnt(0)" ::: "memory");
    const LAS unsigned char* tb = scr + (4 * g + tq) * XL_STR + (4 * tp) * 2;
    s4v tAt[4], tV[4], tBh[4], tKh[4];
#pragma unroll
    for (int t = 0; t < 4; ++t) { tAt[t] = trd(tb + 0 * XL_MAT + 32 * t); tV[t] = trd(tb + 1 * XL_MAT + 32 * t); tBh[t] = trd(tb + 2 * XL_MAT + 32 * t); tKh[t] = trd(tb + 3 * XL_MAT + 32 * t); }
#pragma unroll
    for (int t = 0; t < 4; ++t) {
        const f32x4 G = mma16(LakTp, tV[t], Z4);
        const f32x4 U0 = mma16(TmT, pk4(G), Z4);
        const f32x4 YV = mma16(LrkTp, tV[t], Z4);
        GAS unsigned char* rq = rec + CU_QB + t * CU_QSTR + lane * 8;
        *(GAS s4v*)(rq) = pk4(U0); *(GAS s4v*)(rq + 512) = tV[t]; *(GAS s4v*)(rq + 1024) = pk4(YV); }
    {
        f32x4 Wn[4];
#pragma unroll
        for (int ct = 0; ct < 4; ++ct) Wn[ct] = mma16(tAt[ct], TmT, Z4);
        *(GAS bf16x8*)(rec + CU_W + 0 * 1024 + lane * 16) = pk8v(Wn[0], Wn[1]); *(GAS bf16x8*)(rec + CU_W + 1 * 1024 + lane * 16) = pk8v(Wn[2], Wn[3]);
        *(GAS bf16x8*)(rec + CU_R + 0 * 1024 + lane * 16) = pk8v(Rt[0], Rt[1]); *(GAS bf16x8*)(rec + CU_R + 1 * 1024 + lane * 16) = pk8v(Rt[2], Rt[3]);
    }
#pragma unroll
    for (int tl = 0; tl < 4; ++tl)
        *(GAS bf16x8*)(rec + CU_BK + tl * 1024 + lane * 16) = (bf16x8){tBh[tl].x, tBh[tl].y, tBh[tl].z, tBh[tl].w, tKh[tl].x, tKh[tl].y, tKh[tl].z, tKh[tl].w};
    *(GAS s4v*)(rec + CU_LRB + lane * 8) = LrbTp;
    if (l15 == 0) {
#pragma unroll
        for (int nt = 0; nt < 4; ++nt) *(GAS f32x4*)(rec + CU_PC + (16 * nt + 4 * g) * 4) = pc[nt]; }
}
__device__ __forceinline__ void ph_prep(Frame& F, ArgP A, int l) {
    const int gw = F.vcu * NWAVES + F.wave, NGW = F.G * NWAVES, lane = F.lane, l15 = lane & 15, g = lane >> 4;
    {
        const int h = lane >> 3, i0 = 8 * (lane & 7);
        int nrr_ = (MK_REP & 1024) ? 2 : 1; asm volatile("" : "+s"(nrr_));
#pragma unroll 1
        for (int rr_ = 0; rr_ < nrr_; ++rr_)
        for (int m0 = gw; m0 < M; m0 += 2 * NGW) {
            const int m1 = m0 + NGW < M ? m0 + NGW : m0;
            v4u zq[2][2], zk[2][2]; f32x4 rp4[2][4];
#pragma unroll
            for (int u = 0; u < 2; ++u) { const int m = u ? m1 : m0;
                const GAS bf16* zrow = (const GAS bf16*)(WSP(bf16, WS_Z) + (size_t)m * INW);
                const GAS f32x4* rp = (const GAS f32x4*)(WSP(float2, WS_ROPE) + (size_t)m * 64 + i0);
                rp4[u][0] = rp[0]; rp4[u][1] = rp[1]; rp4[u][2] = rp[2]; rp4[u][3] = rp[3];
                zq[u][0] = *(const GAS v4u*)(zrow + ZC_Q + h * RD + i0); zq[u][1] = *(const GAS v4u*)(zrow + ZC_Q + h * RD + 64 + i0);
                zk[u][0] = *(const GAS v4u*)(zrow + ZC_K + h * RD + i0); zk[u][1] = *(const GAS v4u*)(zrow + ZC_K + h * RD + 64 + i0); }
#pragma unroll
            for (int u = 0; u < 2; ++u) { const int m = u ? m1 : m0;
                const f32x4 c01 = rp4[u][0], c23 = rp4[u][1], c45 = rp4[u][2], c67 = rp4[u][3];
                const float cs[8] = {c01.x, c01.z, c23.x, c23.z, c45.x, c45.z, c67.x, c67.z}, sn[8] = {c01.y, c01.w, c23.y, c23.w, c45.y, c45.w, c67.y, c67.w};
                float q1[8], q2[8], k1[8], k2[8], o1[8], o2[8];
                unpack8(zq[u][0], q1); unpack8(zq[u][1], q2); unpack8(zk[u][0], k1); unpack8(zk[u][1], k2);
#pragma unroll
                for (int j = 0; j < 8; ++j) { o1[j] = q1[j] * cs[j] - q2[j] * sn[j]; o2[j] = q2[j] * cs[j] + q1[j] * sn[j]; }
                GAS bf16* qo = (GAS bf16*)(WSP(bf16, WS_QR) + (size_t)m * RETW + h * RD + i0);
                *(GAS bf16x8*)qo = pack8(o1); *(GAS bf16x8*)(qo + 64) = pack8(o2);
#pragma unroll
                for (int j = 0; j < 8; ++j) { const float a = k1[j] * 0.08838834764831845f, b = k2[j] * 0.08838834764831845f; o1[j] = a * cs[j] - b * sn[j]; o2[j] = b * cs[j] + a * sn[j]; }
                GAS bf16* ko = (GAS bf16*)(WSP(bf16, WS_KR) + (size_t)m * RETW + h * RD + i0);
                *(GAS bf16x8*)ko = pack8(o1); *(GAS bf16x8*)(ko + 64) = pack8(o2); }
        }
    }
    const GAS float* mu = (const GAS float*)(INP(A, 6) + (size_t)l * RWSHIFT);
    const GAS float* w0 = (const GAS float*)(INP(A, 7) + (size_t)l * RWW); const GAS float* a0 = (const GAS float*)(INP(A, 9) + (size_t)l * RWW);
    const GAS float* kkw = (const GAS float*)(INP(A, 12) + (size_t)l * RWW); const GAS float* kaw = (const GAS float*)(INP(A, 13) + (size_t)l * RWW); const GAS float* rkw = (const GAS float*)(INP(A, 14) + (size_t)l * RWW);
    const GAS bf16* WupT = (const GAS bf16*)WSW(l, WO_LORA); const GAS bf16* AupT = WupT + 1024 * 64; const GAS bf16* GupT = AupT + 1024 * 64;
    constexpr int PP_OFF = 8 * 10240;
    LAS float* PP = (LAS float*)(F.lds + RING_OFF + PP_OFF);
    __syncthreads();
    for (int i = F.tid; i < 2048; i += NWAVES * 64) { const int arr = i >> 8, off = (i & 255) * 4;
        const GAS float* src = arr < 3 ? mu + arr * 1024 : (arr == 3 ? w0 : (arr == 4 ? a0 : (arr == 5 ? kkw : (arr == 6 ? kaw : rkw))));
        *(LAS f32x4*)(PP + arr * 1024 + off) = *(const GAS f32x4*)(src + off); }
    __syncthreads();
    int nrw_ = (MK_REP & 2048) ? 2 : 1; asm volatile("" : "+s"(nrw_));
#pragma unroll 1
    for (int rw_ = 0; rw_ < nrw_; ++rw_)
    for (int task = gw; task < M / 8; task += NGW) {
        const int wgv = task >> 3, tile = (wgv >> 1) * 8 + (task & 7), half = wgv & 1;
        const int m = tile * 16 + l15, hh0 = half * (WH / 2);
        const bool has_prev = (m % SEQ) != 0;
        const GAS bf16* zr = (const GAS bf16*)(WSP(bf16, WS_Z) + (size_t)m * INW + ZC_RW);
        bf16x8 fw[2], fa[2], fg[4];
#pragma unroll
        for (int ks = 0; ks < 2; ++ks) { float t[8];
            mix8(zr + RWC_W + 32 * ks + 8 * g, has_prev, mu + RWC_W + 32 * ks + 8 * g, t);
#pragma unroll
            for (int j = 0; j < 8; ++j) t[j] = ftanh(t[j]);
            fw[ks] = pack8(t);
            mix8(zr + RWC_A + 32 * ks + 8 * g, has_prev, mu + RWC_A + 32 * ks + 8 * g, t); fa[ks] = pack8(t); }
#pragma unroll
        for (int ks = 0; ks < 4; ++ks) { float t[8];
            mix8(zr + RWC_G + 32 * ks + 8 * g, has_prev, mu + RWC_G + 32 * ks + 8 * g, t);
#pragma unroll
            for (int j = 0; j < 8; ++j) t[j] = fsig(t[j]);
            fg[ks] = pack8(t); }
        const GAS bf16* zq = has_prev ? zr - INW : zr;
        for (int hh = hh0; hh < hh0 + WH / 2; ++hh) {
            f32x4 kkr[4], av[4], rr[4], lwv[4], kpv[4], vv[4]; float ss = 0.f, bonus = 0.f;
            const int cb = hh * WD + 4 * g;
            {
                v2u zc[3][4], zp[3][4];
#pragma unroll
                for (int a3 = 0; a3 < 3; ++a3)
#pragma unroll
                    for (int nt = 0; nt < 4; ++nt) { zc[a3][nt] = *(const GAS v2u*)(zr + a3 * 1024 + cb + 16 * nt); zp[a3][nt] = *(const GAS v2u*)(zq + a3 * 1024 + cb + 16 * nt); }
#pragma unroll
                for (int nt = 0; nt < 4; ++nt) {
#pragma unroll
                    for (int a3 = 0; a3 < 3; ++a3) { const f32x4 z = unpk4(zc[a3][nt]); f32x4 p = unpk4(zp[a3][nt]); if (!has_prev) p = (f32x4){0.f, 0.f, 0.f, 0.f};
                        const f32x4 mx = z + *(const LAS f32x4*)(PP + a3 * 1024 + cb + 16 * nt) * (p - z);
                        if (a3 == 0) rr[nt] = mx; else if (a3 == 1) kpv[nt] = mx; else vv[nt] = mx; }
                }
            }
            bf16x8 wf[2][2], af[2][2], gf[2][4];
#define PREP_WFRAGS(nt_, k_) do { const int cf_ = hh * WD + (nt_) * 16 + l15; \
            _Pragma("unroll") for (int ks = 0; ks < 2; ++ks) { wf[k_][ks] = *(const GAS bf16x8*)(WupT + (size_t)cf_ * 64 + 32 * ks + 8 * g); af[k_][ks] = *(const GAS bf16x8*)(AupT + (size_t)cf_ * 64 + 32 * ks + 8 * g); } \
            _Pragma("unroll") for (int ks = 0; ks < 4; ++ks) gf[k_][ks] = *(const GAS bf16x8*)(GupT + (size_t)cf_ * 128 + 32 * ks + 8 * g); } while (0)
            PREP_WFRAGS(0, 0);
#pragma unroll
            for (int nt = 0; nt < 4; ++nt) {
                const int c0 = cb + 16 * nt, cs_ = nt & 1;
                if (nt + 1 < 4) PREP_WFRAGS(nt + 1, (cs_ ^ 1));
                f32x4 wl = *(const LAS f32x4*)(PP + 3 * 1024 + c0), al = *(const LAS f32x4*)(PP + 4 * 1024 + c0), gl = (f32x4){0.f, 0.f, 0.f, 0.f};
#pragma unroll
                for (int ks = 0; ks < 2; ++ks) { wl = __builtin_amdgcn_mfma_f32_16x16x32_bf16(wf[cs_][ks], fw[ks], wl, 0, 0, 0); al = __builtin_amdgcn_mfma_f32_16x16x32_bf16(af[cs_][ks], fa[ks], al, 0, 0, 0); }
#pragma unroll
                for (int ks = 0; ks < 4; ++ks) gl = __builtin_amdgcn_mfma_f32_16x16x32_bf16(gf[cs_][ks], fg[ks], gl, 0, 0, 0);
                const f32x4 r = rr[nt], k = kpv[nt], v = vv[nt];
                const f32x4 kk4 = *(const LAS f32x4*)(PP + 5 * 1024 + c0), ka4 = *(const LAS f32x4*)(PP + 6 * 1024 + c0), rk4 = *(const LAS f32x4*)(PP + 7 * 1024 + c0);
                f32x4 lwd, a, kp;
#pragma unroll
                for (int i = 0; i < 4; ++i) {
                    lwd[i] = -0.6065306597126334f * fsig(wl[i]);
                    a[i] = fsig(al[i]);
                    kp[i] = k[i] * (1.0f + (a[i] - 1.0f) * ka4[i]);
                }
                kkr[nt] = k * kk4; av[nt] = a; lwv[nt] = lwd; kpv[nt] = kp;
                ss += (kkr[nt].x * kkr[nt].x + kkr[nt].y * kkr[nt].y) + (kkr[nt].z * kkr[nt].z + kkr[nt].w * kkr[nt].w);
                const f32x4 rb = r * kp * rk4; bonus += (rb.x + rb.y) + (rb.z + rb.w);
                const size_t o = (size_t)m * RWW + c0;
#if MK_CHUNKED
                *(GAS s4v*)(WSP(bf16, WS_SV) + o) = pk4(v); *(GAS s4v*)(WSP(bf16, WS_G) + o) = pk4(gl);
#else
                f32x4 decay;
#pragma unroll
                for (int i = 0; i < 4; ++i) decay[i] = fexp(lwd[i]);
                *(GAS f32x4*)(WSP(float, WS_SR) + o) = r; *(GAS f32x4*)(WSP(float, WS_SW) + o) = decay; *(GAS f32x4*)(WSP(float, WS_SK) + o) = kp;
                *(GAS f32x4*)(WSP(float, WS_SV) + o) = v; *(GAS f32x4*)(WSP(float, WS_G) + o) = gl;
#endif
            }
#undef PREP_WFRAGS
            ss += __shfl_xor(ss, 16); ss += __shfl_xor(ss, 32); bonus += __shfl_xor(bonus, 16); bonus += __shfl_xor(bonus, 32);
            const float inv = 1.0f / fmaxf(sqrtf(ss), 1e-12f);
            if (g == 0) WSP(float, WS_BONUS)[(size_t)m * WH + hh] = bonus;
#if MK_CHUNKED
            f32x4 aa[4], bb[4];
#pragma unroll
            for (int nt = 0; nt < 4; ++nt) { const f32x4 kk = kkr[nt] * inv; aa[nt] = -kk; bb[nt] = kk * av[nt]; }
            GAS unsigned char* rec = (GAS unsigned char*)WSP(unsigned char, WS_CU) + ((size_t)((tile / NCHUNK) * WH + hh) * NCHUNK + (tile % NCHUNK)) * CU_BYTES;
            chunk_ops(rr, lwv, kpv, vv, aa, bb, F.lds + RING_OFF + F.wave * 10240, rec, lane);
#else
#pragma unroll
            for (int nt = 0; nt < 4; ++nt) { const size_t o = (size_t)m * RWW + hh * WD + nt * 16 + 4 * g; const f32x4 kk = kkr[nt] * inv;
                *(GAS f32x4*)(WSP(float, WS_SNKK) + o) = -kk; *(GAS f32x4*)(WSP(float, WS_SKKA) + o) = kk * av[nt]; }
#endif
        }
    }
}
#if (MK_GLOBAL_GROUPS & 2)
#pragma pop_macro("WSP")
#pragma pop_macro("WSW")
#pragma pop_macro("OUTP")
#endif
#if (MK_GLOBAL_GROUPS & 4)
#pragma push_macro("WSP")
#pragma push_macro("WSW")
#pragma push_macro("OUTP")
#undef WSP
#undef WSW
#undef OUTP
#define WSP WSPG
#define WSW WSWG
#define OUTP OUTPG
#endif
#if !MK_CHUNKED
__device__ __forceinline__ void scan_rwkv_naive(Frame& F, int item) {
    const int lane = F.lane;
    float st[64];
#pragma unroll
    for (int j = 0; j < 64; ++j) st[j] = 0.f;
    const size_t base0 = (size_t)(item >> 4) * SEQ * RWW + (size_t)(item & 15) * WD + lane;
    for (int t = 0; t < SEQ; ++t) {
        const size_t o = base0 + (size_t)t * RWW;
        const float r = WSP(float, WS_SR)[o], w = WSP(float, WS_SW)[o], k = WSP(float, WS_SK)[o], v = WSP(float, WS_SV)[o], nk = WSP(float, WS_SNKK)[o], ka = WSP(float, WS_SKKA)[o];
        float sa = 0.f;
#pragma unroll
        for (int j = 0; j < 64; ++j) sa += st[j] * rdlane(nk, j);
        float y = 0.f;
#pragma unroll
        for (int j = 0; j < 64; ++j) { st[j] = st[j] * rdlane(w, j) + sa * rdlane(ka, j) + v * rdlane(k, j); y += st[j] * rdlane(r, j); }
        WSP(float, WS_YRAWW)[o] = y;
    }
}
#endif
__device__ __forceinline__ void scan_ret_naive(Frame& F, int item) {
    const int lane = F.lane, b = item >> 4, h = (item >> 1) & 7, half = item & 1;
    const float gam = 1.0f - exp2f((float)(-5 - h));
    float R[128];
#pragma unroll
    for (int j = 0; j < 128; ++j) R[j] = 0.f;
    for (int t = 0; t < SEQ; ++t) {
        const size_t m = (size_t)b * SEQ + t;
        const float q1 = bf2f(WSP(bf16, WS_QR)[m * RETW + h * RD + lane]), q2 = bf2f(WSP(bf16, WS_QR)[m * RETW + h * RD + 64 + lane]);
        const float k1 = bf2f(WSP(bf16, WS_KR)[m * RETW + h * RD + lane]), k2 = bf2f(WSP(bf16, WS_KR)[m * RETW + h * RD + 64 + lane]);
        const float v = bf2f(WSP(bf16, WS_Z)[m * INW + ZC_V + h * RD + half * 64 + lane]);
        float y = 0.f;
#pragma unroll
        for (int d = 0; d < 64; ++d) { R[d] = gam * R[d] + rdlane(k1, d) * v; y += rdlane(q1, d) * R[d]; }
#pragma unroll
        for (int d = 0; d < 64; ++d) { R[64 + d] = gam * R[64 + d] + rdlane(k2, d) * v; y += rdlane(q2, d) * R[64 + d]; }
        OUTP[m * RETW + h * RD + half * 64 + lane] = y;
    }
}
#if !MK_CHUNKED
constexpr int SCT = 32;
constexpr int SC_ARR = SCT * 64 * 4;
constexpr int SC_BUF = 5 * SC_ARR + SCT * 16 * 4;
static_assert(2 * SC_BUF <= RING_BYTES, "scan LDS");
template <int CTRL> __device__ __forceinline__ float dppf(float x) { return __builtin_bit_cast(float, __builtin_amdgcn_update_dpp(0, __builtin_bit_cast(int, x), CTRL, 0xF, 0xF, true)); }
__device__ __forceinline__ float sum16(float x) {
    x += dppf<0xB1>(x); x += dppf<0x4E>(x); x += dppf<0x141>(x); x += dppf<0x140>(x); return x;
}
__device__ __forceinline__ void scan_rwkv_fast(Frame& F, int w) {
    const int b = w >> 6, hh = (w >> 2) & 15, q = w & 3;
    const int lane = F.lane, wave = F.wave;
    LAS unsigned char* base = F.lds + RING_OFF;
    const size_t g0 = (size_t)b * SEQ * RWW + (size_t)hh * WD;
    constexpr int NBLK = SEQ / SCT;
#define SC_BAR() do { asm volatile("s_waitcnt lgkmcnt(0)" ::: "memory"); __builtin_amdgcn_s_barrier(); asm volatile("" ::: "memory"); } while (0)
    if (wave >= 4) {
        const int lt = F.tid - 256;
        const float* a0 = WSP(float, WS_SR) + g0; const float* a1 = WSP(float, WS_SW) + g0; const float* a2 = WSP(float, WS_SK) + g0;
        const float* a3 = WSP(float, WS_SNKK) + g0; const float* a4 = WSP(float, WS_SKKA) + g0; const float* av = WSP(float, WS_SV) + g0 + 16 * q;
        const int f0 = lt, f1 = lt + 256;
        const size_t o0 = (size_t)(f0 >> 4) * RWW + 4 * (f0 & 15), o1 = (size_t)(f1 >> 4) * RWW + 4 * (f1 & 15), ov = (size_t)(lt >> 2) * RWW + 4 * (lt & 3);
        f32x4 r0[5], r1[5], rv;
#define SC_LOAD(blk) do { const size_t tb = (size_t)(blk) * SCT * RWW; \
        r0[0] = *(const GAS f32x4*)(a0 + tb + o0); r1[0] = *(const GAS f32x4*)(a0 + tb + o1); r0[1] = *(const GAS f32x4*)(a1 + tb + o0); r1[1] = *(const GAS f32x4*)(a1 + tb + o1); \
        r0[2] = *(const GAS f32x4*)(a2 + tb + o0); r1[2] = *(const GAS f32x4*)(a2 + tb + o1); r0[3] = *(const GAS f32x4*)(a3 + tb + o0); r1[3] = *(const GAS f32x4*)(a3 + tb + o1); \
        r0[4] = *(const GAS f32x4*)(a4 + tb + o0); r1[4] = *(const GAS f32x4*)(a4 + tb + o1); if (lt < 128) rv = *(const GAS f32x4*)(av + tb + ov); } while (0)
#define SC_STORE(bi) do { LAS unsigned char* bb = base + (bi) * SC_BUF; \
        _Pragma("unroll") for (int a = 0; a < 5; ++a) { *(LAS f32x4*)(bb + a * SC_ARR + f0 * 16) = r0[a]; *(LAS f32x4*)(bb + a * SC_ARR + f1 * 16) = r1[a]; } \
        if (lt < 128) *(LAS f32x4*)(bb + 5 * SC_ARR + lt * 16) = rv; } while (0)
        SC_LOAD(0); SC_STORE(0);
        if (1 < NBLK) SC_LOAD(1);
        SC_BAR();
        for (int blk = 0; blk < NBLK; ++blk) {
            if (blk + 1 < NBLK) { SC_STORE((blk + 1) & 1); if (blk + 2 < NBLK) SC_LOAD(blk + 2); }
            SC_BAR();
        }
#undef SC_LOAD
#undef SC_STORE
    } else {
        const int l16 = lane & 15, rowl = 4 * wave + (lane >> 4);
        GAS float* Y = (GAS float*)(WSP(float, WS_YRAWW) + g0 + 16 * q + rowl);
        f32x4 st = (f32x4){0.f, 0.f, 0.f, 0.f};
        const int lo = l16 * 16, vo = 5 * SC_ARR + rowl * 4;
#define SC_LD(tt_, R4, W4, K4, N4, A4, V) do { R4 = *(const LAS f32x4*)(bb + 0 * SC_ARR + (tt_) * 256 + lo); W4 = *(const LAS f32x4*)(bb + 1 * SC_ARR + (tt_) * 256 + lo); \
        K4 = *(const LAS f32x4*)(bb + 2 * SC_ARR + (tt_) * 256 + lo); N4 = *(const LAS f32x4*)(bb + 3 * SC_ARR + (tt_) * 256 + lo); A4 = *(const LAS f32x4*)(bb + 4 * SC_ARR + (tt_) * 256 + lo); \
        V = *(const LAS float*)(bb + vo + (tt_) * 64); } while (0)
        SC_BAR();
        for (int blk = 0; blk < NBLK; ++blk) {
            const LAS unsigned char* bb = base + (blk & 1) * SC_BUF;
            GAS float* yb = Y + (size_t)blk * SCT * RWW;
            f32x4 r4[3], w4[3], k4[3], n4[3], a4[3]; float v[3];
            SC_LD(0, r4[0], w4[0], k4[0], n4[0], a4[0], v[0]);
            SC_LD(1, r4[1], w4[1], k4[1], n4[1], a4[1], v[1]);
#pragma unroll
            for (int tt = 0; tt < SCT; ++tt) {
                const int c = tt % 3, p = (tt + 2) % 3;
                if (tt + 2 < SCT) SC_LD(tt + 2, r4[p], w4[p], k4[p], n4[p], a4[p], v[p]);
                f32x2 sp2 = (f32x2){st.x, st.y} * (f32x2){n4[c].x, n4[c].y}; sp2 = (f32x2){st.z, st.w} * (f32x2){n4[c].z, n4[c].w} + sp2;
                const f32x4 t0 = st * w4[c] + k4[c] * v[c];
                const float sa = sum16(sp2.x + sp2.y);
                st = a4[c] * sa + t0;
                f32x2 yp2 = (f32x2){st.x, st.y} * (f32x2){r4[c].x, r4[c].y}; yp2 = (f32x2){st.z, st.w} * (f32x2){r4[c].z, r4[c].w} + yp2;
                const float y = sum16(yp2.x + yp2.y);
                yb[(size_t)tt * RWW] = y;
            }
            SC_BAR();
        }
#undef SC_LD
#undef SC_BAR
    }
}
#endif
__device__ __forceinline__ float dpp_x1(float x) { return __builtin_bit_cast(float, __builtin_amdgcn_update_dpp(0, __builtin_bit_cast(int, x), 0xB1, 0xF, 0xF, true)); }
__device__ __forceinline__ void store_y_bf16(GAS bf16* p, size_t ld, const f32x4 ya, int l15) {
    const bool odd = l15 & 1;
    const float s0 = dpp_x1(odd ? ya[0] : ya[2]), s1 = dpp_x1(odd ? ya[1] : ya[3]);
    const unsigned w0 = odd ? pg8::cvt_pk_bf16(s0, ya[2]) : pg8::cvt_pk_bf16(ya[0], s0), w1 = odd ? pg8::cvt_pk_bf16(s1, ya[3]) : pg8::cvt_pk_bf16(ya[1], s1);
    GAS bf16* r = p + (odd ? 2 * ld : 0);
    *(GAS unsigned*)r = w0; *(GAS unsigned*)(r + ld) = w1;
}
constexpr int CB_STEPS = 4, CB_STEP_BYTES = CU_QB + CU_QSTR, CB_SP = CB_STEP_BYTES / 16  , CB_BUF = CB_STEPS * CB_STEP_BYTES, CB_PIECES = CB_BUF / 16, CB_NLD = CB_PIECES / 8  , CB_NBLK = NCHUNK / CB_STEPS;
static_assert(CB_NLD * 8 == CB_PIECES && CB_NLD <= 448, "loader split");
static_assert(2 * CB_BUF <= RING_BYTES, "chunk scan LDS");
#ifndef MK_X2_DIRECT
#define MK_X2_DIRECT 0
#endif
__device__ __forceinline__ void scan_rwkv_chunk(Frame& F, int w) {
    const int bh = w >> 2, q = w & 3, lane = F.lane, wave = F.wave;
    LAS unsigned char* base = F.lds + RING_OFF;
    const GAS unsigned char* rec0 = (const GAS unsigned char*)WSP(unsigned char, WS_CU) + (size_t)bh * NCHUNK * CU_BYTES;
#define CB_BAR() do { asm volatile("s_waitcnt lgkmcnt(0)" ::: "memory"); __builtin_amdgcn_s_barrier(); asm volatile("" ::: "memory"); } while (0)
    if (wave >= 1) {
        const int lt = F.tid - 64;
#if MK_X2_NT
#define CB_LD(p_) __builtin_nontemporal_load((const GAS v4u*)(p_))
#else
#define CB_LD(p_) (*(const GAS v4u*)(p_))
#endif
        v4u ra[8], rb[8], rc[8], rd[8];
        const int ltc = lt < CB_NLD ? lt : CB_NLD - 1;
        int so[8];
#pragma unroll
        for (int j = 0; j < 8; ++j) { const int p = ltc + CB_NLD * j, st = p / CB_SP, off = p % CB_SP; so[j] = st * CU_BYTES + off * 16 + (off >= CU_QB / 16 ? q * CU_QSTR : 0); }
#define CB_LOAD(rg, blk) do { const int bc_ = (blk) < CB_NBLK ? (blk) : CB_NBLK - 1; const GAS unsigned char* bp = rec0 + (size_t)bc_ * CB_STEPS * CU_BYTES; \
            _Pragma("unroll") for (int j = 0; j < 8; ++j) rg[j] = CB_LD(bp + so[j]); } while (0)
#define CB_STORE(rg, bi) do { LAS unsigned char* dp = base + (bi) * CB_BUF + ltc * 16; \
            _Pragma("unroll") for (int j = 0; j < 8; ++j) *(LAS v4u*)(dp + j * CB_NLD * 16) = rg[j]; } while (0)
        static_assert(CB_NBLK % 4 == 0 && CB_NBLK >= 8, "block quads");
        CB_LOAD(ra, 0); CB_STORE(ra, 0); CB_LOAD(rb, 1); CB_LOAD(rc, 2); CB_LOAD(rd, 3);
        CB_BAR();
        for (int blk = 0; blk < CB_NBLK; blk += 4) {
            CB_STORE(rb, 1); CB_LOAD(ra, blk + 4); CB_BAR();
            CB_STORE(rc, 0); CB_LOAD(rb, blk + 5); CB_BAR();
            CB_STORE(rd, 1); CB_LOAD(rc, blk + 6); CB_BAR();
            CB_STORE(ra, 0); CB_LOAD(rd, blk + 7); CB_BAR();
        }
#undef CB_LOAD
#undef CB_STORE
    } else {
        const int l15 = lane & 15, g = lane >> 4;
        const f32x4 Z4 = (f32x4){0.f, 0.f, 0.f, 0.f};
        f32x4 acc[4] = {Z4, Z4, Z4, Z4};
        GAS bf16* Y = (GAS bf16*)(WSP(bf16, WS_YRAWW) + (size_t)(bh >> 4) * SEQ * RWW + (size_t)(bh & 15) * WD + 16 * q + (l15 & ~1) + (size_t)(4 * g) * RWW);
        CB_BAR();
        bf16x8 Wf[2][2], Rf[2][2], BKf[2][4]; f32x4 pcv[2][4]; v2u Lrbf[2], U0t[2], Vt[2], YVt[2];
#define CB_FRAGS(sb_, k_) do { _Pragma("unroll") for (int j = 0; j < 2; ++j) { Wf[k_][j] = *(const LAS bf16x8*)((sb_) + CU_W + j * 1024 + lane * 16); Rf[k_][j] = *(const LAS bf16x8*)((sb_) + CU_R + j * 1024 + lane * 16); } \
        _Pragma("unroll") for (int j = 0; j < 4; ++j) { BKf[k_][j] = *(const LAS bf16x8*)((sb_) + CU_BK + j * 1024 + lane * 16); pcv[k_][j] = *(const LAS f32x4*)((sb_) + CU_PC + (16 * j + 4 * g) * 4); } \
        Lrbf[k_] = *(const LAS v2u*)((sb_) + CU_LRB + lane * 8); U0t[k_] = *(const LAS v2u*)((sb_) + CU_QB + lane * 8); Vt[k_] = *(const LAS v2u*)((sb_) + CU_QB + 512 + lane * 8); YVt[k_] = *(const LAS v2u*)((sb_) + CU_QB + 1024 + lane * 8); } while (0)
        for (int blk = 0; blk < CB_NBLK; ++blk) {
            const LAS unsigned char* bb = base + (blk & 1) * CB_BUF;
            CB_FRAGS(bb, 0);
#pragma unroll
            for (int st = 0; st < CB_STEPS; ++st) {
                const int c = st & 1;
                if (st + 1 < CB_STEPS) CB_FRAGS(bb + (st + 1) * CB_STEP_BYTES, (c ^ 1));
                const bf16x8 sf0 = pk8v(acc[0], acc[1]), sf1 = pk8v(acc[2], acc[3]);
                f32x4 pA = unpk4(U0t[c]);
                pA = mma32(Wf[c][0], sf0, pA); pA = mma32(Wf[c][1], sf1, pA);
                f32x4 ya = unpk4(YVt[c]);
                ya = mma32(Rf[c][0], sf0, ya); ya = mma32(Rf[c][1], sf1, ya);
                const s4v pAp = pk4(pA), vq = __builtin_bit_cast(s4v, Vt[c]);
                ya = mma16(__builtin_bit_cast(s4v, Lrbf[c]), pAp, ya);
                store_y_bf16(Y + (size_t)((blk * CB_STEPS + st) * CK) * RWW, RWW, ya, l15);
                const bf16x8 yB = (bf16x8){pAp.x, pAp.y, pAp.z, pAp.w, vq.x, vq.y, vq.z, vq.w};
#pragma unroll
                for (int tl = 0; tl < 4; ++tl) acc[tl] = mma32(BKf[c][tl], yB, acc[tl] * pcv[c][tl]);
            }
            CB_BAR();
        }
#undef CB_FRAGS
    }
#undef CB_BAR
}
__device__ const float RET_LG2[8] = { -4.580368847e-02f, -2.272007614e-02f, -1.131531317e-02f, -5.646563135e-03f, -2.820519032e-03f, -1.409570221e-03f, -7.046129904e-04f, -3.522634797e-04f };
constexpr int RT_STR = 288, RT_QS = 0, RT_KS = 128 * RT_STR, RT_VSTR = 80, RT_VS = 2 * 128 * RT_STR, RT_VPS = RT_VS + 128 * RT_VSTR, RT_RT = RT_VPS + 128 * RT_VSTR, RT_RTSZ = 32 * RT_STR;
static_assert(RT_RT + 2 * RT_RTSZ <= RING_BYTES, "retention LDS");
__device__ __forceinline__ bf16x8 tr8(const LAS unsigned char* p0, const LAS unsigned char* p1) {
    const s4v a = __builtin_amdgcn_ds_read_tr16_b64_v4i16((LAS s4v*)p0), b = __builtin_amdgcn_ds_read_tr16_b64_v4i16((LAS s4v*)p1);
    return (bf16x8){a.x, a.y, a.z, a.w, b.x, b.y, b.z, b.w};
}
__device__ __forceinline__ void scan_ret_mfma(Frame& F, int w_) {
    const int b = w_ >> 5, h = (w_ >> 2) & 7, eq = w_ & 3;
    const int tid = F.tid, lane = F.lane, w = F.wave < 4 ? F.wave : 11 - F.wave, l15 = lane & 15, g = lane >> 4, tq = l15 >> 2, tp = l15 & 3;
    LAS unsigned char* L = F.lds + RING_OFF;
    const float lg2 = RET_LG2[h];
    const float gC = __builtin_amdgcn_exp2f(lg2 * 128.f);
    for (int i = tid; i < RT_RTSZ / 4; i += NWAVES * 64) ((LAS unsigned*)(L + RT_RT))[i] = 0u;
    const GAS bf16* Qg = (const GAS bf16*)(WSP(bf16, WS_QR) + (size_t)b * SEQ * RETW + h * RD);
    const GAS bf16* Kg = (const GAS bf16*)(WSP(bf16, WS_KR) + (size_t)b * SEQ * RETW + h * RD);
    const GAS bf16* Vg = (const GAS bf16*)(WSP(bf16, WS_Z) + (size_t)b * SEQ * INW + ZC_V + h * RD + 32 * eq);
    GAS bf16* Yg = (GAS bf16*)OUTP + (size_t)b * SEQ * RETW + h * RD + 32 * eq;
    v4u rq[4], rk[4], rv;
#define RT_BAR() do { asm volatile("s_waitcnt lgkmcnt(0)" ::: "memory"); __builtin_amdgcn_s_barrier(); asm volatile("" ::: "memory"); } while (0)
#define RT_LOAD(n_) do { _Pragma("unroll") for (int i = 0; i < 4; ++i) { const int f = tid + 512 * i, c = f >> 4, pc = f & 15; \
        rq[i] = *(const GAS v4u*)(Qg + (size_t)((n_) * 128 + c) * RETW + 8 * pc); rk[i] = *(const GAS v4u*)(Kg + (size_t)((n_) * 128 + c) * RETW + 8 * pc); } \
        rv = *(const GAS v4u*)(Vg + (size_t)((n_) * 128 + (tid >> 2)) * INW + 8 * (tid & 3)); } while (0)
    f32x4 accR[2] = {(f32x4){0.f, 0.f, 0.f, 0.f}, (f32x4){0.f, 0.f, 0.f, 0.f}};
    float dm0[4][4], dm1[4][4];
#pragma unroll
    for (int p = 0; p < 4; ++p)
#pragma unroll
        for (int i = 0; i < 4; ++i) { const int d0 = 16 * w + l15 - (32 * p + 4 * g + i), d1 = d0 - 16;
            dm0[p][i] = d0 >= 0 ? __builtin_amdgcn_exp2f(lg2 * (float)d0) : 0.f; dm1[p][i] = d1 >= 0 ? __builtin_amdgcn_exp2f(lg2 * (float)d1) : 0.f; }
    RT_LOAD(0);
    for (int n = 0; n < SEQ / 128; ++n) {
#pragma unroll
        for (int i = 0; i < 4; ++i) { const int f = tid + 512 * i, c = f >> 4, pc = f & 15;
            *(LAS v4u*)(L + RT_QS + c * RT_STR + pc * 16) = rq[i]; *(LAS v4u*)(L + RT_KS + c * RT_STR + pc * 16) = rk[i]; }
        { const int c = tid >> 2, pc = tid & 3; *(LAS v4u*)(L + RT_VS + c * RT_VSTR + pc * 16) = rv;
          const float sc = __builtin_amdgcn_exp2f(lg2 * (float)(127 - c)); v4u o;
          o.x = pg8::cvt_pk_bf16(pg8::bf_lo(rv.x) * sc, pg8::bf_hi(rv.x) * sc); o.y = pg8::cvt_pk_bf16(pg8::bf_lo(rv.y) * sc, pg8::bf_hi(rv.y) * sc);
          o.z = pg8::cvt_pk_bf16(pg8::bf_lo(rv.z) * sc, pg8::bf_hi(rv.z) * sc); o.w = pg8::cvt_pk_bf16(pg8::bf_lo(rv.w) * sc, pg8::bf_hi(rv.w) * sc);
          *(LAS v4u*)(L + RT_VPS + c * RT_VSTR + pc * 16) = o; }
        RT_BAR();
        if (n + 1 < SEQ / 128) RT_LOAD(n + 1);
        bf16x8 qf[4];
#pragma unroll
        for (int ks = 0; ks < 4; ++ks) qf[ks] = *(const LAS bf16x8*)(L + RT_QS + (16 * w + l15) * RT_STR + (32 * ks + 8 * g) * 2);
        bf16x8 pf[4];
        const int cq = 16 * w + l15;
#pragma unroll
        for (int p = 0; p < 4; ++p) {
            bf16x8 kf[8];
#pragma unroll
            for (int ks = 0; ks < 4; ++ks) { kf[ks] = *(const LAS bf16x8*)(L + RT_KS + (32 * p + l15) * RT_STR + (32 * ks + 8 * g) * 2);
                kf[4 + ks] = *(const LAS bf16x8*)(L + RT_KS + (32 * p + 16 + l15) * RT_STR + (32 * ks + 8 * g) * 2); }
            __builtin_amdgcn_sched_barrier(0);
            f32x4 s0 = (f32x4){0.f, 0.f, 0.f, 0.f}, s1 = (f32x4){0.f, 0.f, 0.f, 0.f};
            if (2 * p <= w) {
#pragma unroll
                for (int ks = 0; ks < 4; ++ks) s0 = __builtin_amdgcn_mfma_f32_16x16x32_bf16(kf[ks], qf[ks], s0, 0, 0, 0);
            }
            if (2 * p + 1 <= w) {
#pragma unroll
                for (int ks = 0; ks < 4; ++ks) s1 = __builtin_amdgcn_mfma_f32_16x16x32_bf16(kf[4 + ks], qf[ks], s1, 0, 0, 0);
            }
            float p0[4], p1[4];
#pragma unroll
            for (int i = 0; i < 4; ++i) { p0[i] = s0[i] * dm0[p][i]; p1[i] = s1[i] * dm1[p][i]; }
            v4u pk; pk.x = pg8::cvt_pk_bf16(p0[0], p0[1]); pk.y = pg8::cvt_pk_bf16(p0[2], p0[3]); pk.z = pg8::cvt_pk_bf16(p1[0], p1[1]); pk.w = pg8::cvt_pk_bf16(p1[2], p1[3]);
            pf[p] = __builtin_bit_cast(bf16x8, pk);
        }
        const LAS unsigned char* Rcur = L + RT_RT + (n & 1) * RT_RTSZ;
#pragma unroll
        for (int et = 0; et < 2; ++et) {
            bf16x8 rf[4], vf[4];
#pragma unroll
            for (int ks = 0; ks < 4; ++ks) rf[ks] = *(const LAS bf16x8*)(Rcur + (16 * et + l15) * RT_STR + (32 * ks + 8 * g) * 2);
#pragma unroll
            for (int p = 0; p < 4; ++p) { const LAS unsigned char* vb = L + RT_VS + (32 * p + 4 * g + tq) * RT_VSTR + (16 * et + 4 * tp) * 2; vf[p] = tr8(vb, vb + 16 * RT_VSTR); }
            __builtin_amdgcn_sched_barrier(0);
            f32x4 acc = (f32x4){0.f, 0.f, 0.f, 0.f};
#pragma unroll
            for (int ks = 0; ks < 4; ++ks) acc = __builtin_amdgcn_mfma_f32_16x16x32_bf16(qf[ks], rf[ks], acc, 0, 0, 0);
#pragma unroll
            for (int i = 0; i < 4; ++i) acc[i] *= __builtin_amdgcn_exp2f(lg2 * (float)(16 * w + 4 * g + i + 1));
#pragma unroll
            for (int p = 0; p < 4; ++p) if (2 * p <= w) acc = __builtin_amdgcn_mfma_f32_16x16x32_bf16(pf[p], vf[p], acc, 0, 0, 0);
            store_y_bf16(Yg + (size_t)(n * 128 + 16 * w + 4 * g) * RETW + 16 * et + (l15 & ~1), RETW, acc, l15);
        }
        {
            bf16x8 kt[4], vt[4][2];
#pragma unroll
            for (int cs = 0; cs < 4; ++cs) {
                const LAS unsigned char* kb = L + RT_KS + (32 * cs + 8 * g + tq) * RT_STR + (16 * w + 4 * tp) * 2;
                kt[cs] = tr8(kb, kb + 4 * RT_STR);
#pragma unroll
                for (int et = 0; et < 2; ++et) { const LAS unsigned char* vb = L + RT_VPS + (32 * cs + 8 * g + tq) * RT_VSTR + (16 * et + 4 * tp) * 2; vt[cs][et] = tr8(vb, vb + 4 * RT_VSTR); }
            }
            __builtin_amdgcn_sched_barrier(0);
            LAS unsigned char* Rnxt = L + RT_RT + ((n + 1) & 1) * RT_RTSZ;
            accR[0] = accR[0] * gC; accR[1] = accR[1] * gC;
#pragma unroll
            for (int cs = 0; cs < 4; ++cs)
#pragma unroll
                for (int et = 0; et < 2; ++et) accR[et] = __builtin_amdgcn_mfma_f32_16x16x32_bf16(kt[cs], vt[cs][et], accR[et], 0, 0, 0);
#pragma unroll
            for (int et = 0; et < 2; ++et) { v2u o; o.x = pg8::cvt_pk_bf16(accR[et][0], accR[et][1]); o.y = pg8::cvt_pk_bf16(accR[et][2], accR[et][3]);
                *(LAS v2u*)(Rnxt + (16 * et + l15) * RT_STR + (16 * w + 4 * g) * 2) = o; }
        }
        RT_BAR();
    }
#undef RT_LOAD
#undef RT_BAR
}
__device__ __forceinline__ void ph_scan(Frame& F, ArgP A, int l) {
#if MK_CHUNKED
    if (F.G == 256) {
        const int it = F.vcu, r = it & 3, idx = it >> 2;
        if (r == 0 || r == 2) { const int w = idx * 2 + (r >> 1); int n_ = (MK_REP & 32) ? 2 : 1; asm volatile("" : "+s"(n_));
#pragma unroll 1
            for (int k_ = 0; k_ < n_; ++k_) { scan_rwkv_chunk(F, w); __syncthreads(); }
            if (MK_CONV_X2_PCT && l + 1 < DEPTH) { RETID(); ph_convert(F, A, l + 1, w, 128, CONV_SPLIT, CONV_NITEMS); } }
        else if (r == 1) { int n_ = (MK_REP & 64) ? 2 : 1; asm volatile("" : "+s"(n_));
#pragma unroll 1
            for (int k_ = 0; k_ < n_; ++k_) { scan_ret_mfma(F, idx); __syncthreads(); } }
        else {
            if (MK_TAIL_IN_SCAN) { pg8::Gemm g{WSPG(bf16, WS_H), WSWG(l, WO_WIN), M, INW, D}; pg8::OneUnit S{idx, INW / 256 - 1};
                fill_rstd(F, idx * 256, 256);
                pg8::EpiB<0> E{WSPG(bf16, WS_Z), INW, nullptr, 0, (const LAS float*)(F.lds + RSTD_OFF), idx};
                pg8::gemm_phase<pg8::EpiB<0>, pg8::OneUnit, MK_ALIGN, MK_SP2>(F.lds + RING_OFF, g, S, E);
                __syncthreads(); RETID(); }
            if (l + 1 < DEPTH) ph_convert(F, A, l + 1, idx, 64, 0, CONV_SPLIT); }
        __syncthreads();
    }
#else
    if (F.G >= 256) {
        if (F.vcu >= 192) { if (l + 1 < DEPTH) ph_convert(F, A, l + 1, F.vcu - 192, F.G - 192); return; }
        if (F.vcu < 128) { scan_rwkv_fast(F, F.vcu); if (MK_REP & 32) { __syncthreads(); scan_rwkv_fast(F, F.vcu); } }
        else if (F.vcu < 192) { scan_ret_mfma(F, F.vcu - 128); if (MK_REP & 64) { __syncthreads(); scan_ret_mfma(F, F.vcu - 128); } }
    } else {
        if (l + 1 < DEPTH) ph_convert(F, A, l + 1, F.vcu, F.G);
        const int gw = F.vcu * NWAVES + F.wave, NGW = F.G * NWAVES;
        const int stride = NGW >= 64 ? NGW / 64 : 1;
        if (gw % stride == 0) {
            for (int item = gw / stride; item < 64; item += (NGW + stride - 1) / stride) {
                if (item < 32) scan_rwkv_naive(F, item); else scan_ret_naive(F, item - 32);
            }
        }
    }
#endif
}
#if (MK_GLOBAL_GROUPS & 4)
#pragma pop_macro("WSP")
#pragma pop_macro("WSW")
#pragma pop_macro("OUTP")
#endif
#if (MK_GLOBAL_GROUPS & 8)
#pragma push_macro("WSP")
#pragma push_macro("WSW")
#pragma push_macro("OUTP")
#undef WSP
#undef WSW
#undef OUTP
#define WSP WSPG
#define WSW WSWG
#define OUTP OUTPG
#endif
template <int CTRL> __device__ __forceinline__ float dppx(float x) { return __builtin_bit_cast(float, __builtin_amdgcn_update_dpp(0, __builtin_bit_cast(int, x), CTRL, 0xF, 0xF, true)); }
static_assert(MK_CHUNKED == 1, "ph_post reads the raw scan outputs as bf16, which only the chunked / MFMA scans write");
__device__ __forceinline__ void ph_post(Frame& F, ArgP A, int l) {
    const int gw = F.vcu * NWAVES + F.wave, NGW = F.G * NWAVES, lane = F.lane, c0 = lane * 16;
    f32x4 gg[4], gb[4], lg[4], lb[4];
#pragma unroll
    for (int j = 0; j < 4; ++j) { gg[j] = *(const GAS f32x4*)(INP(A, 4) + (size_t)l * RETW + c0 + 4 * j); gb[j] = *(const GAS f32x4*)(INP(A, 5) + (size_t)l * RETW + c0 + 4 * j);
        lg[j] = *(const GAS f32x4*)(INP(A, 15) + (size_t)l * RWW + c0 + 4 * j); lb[j] = *(const GAS f32x4*)(INP(A, 16) + (size_t)l * RWW + c0 + 4 * j); }
    struct Raw { v2u yr[4]; v4u zg[2]; v2u yw[4], sv[4], gt[4]; float bonus; };
    auto load_row = [&](Raw& R, int m) {
        if (m >= M) m = M - 1;
        const GAS bf16* yrp = (const GAS bf16*)OUTP + (size_t)m * RETW + c0; const GAS bf16* zg = (const GAS bf16*)(WSP(bf16, WS_Z) + (size_t)m * INW + ZC_GR + c0);
        const size_t ob = (size_t)m * RWW + c0;
#pragma unroll
        for (int j = 0; j < 4; ++j) { R.yr[j] = *(const GAS v2u*)(yrp + 4 * j); R.yw[j] = *(const GAS v2u*)(WSP(bf16, WS_YRAWW) + ob + 4 * j);
            R.sv[j] = *(const GAS v2u*)(WSP(bf16, WS_SV) + ob + 4 * j); R.gt[j] = *(const GAS v2u*)(WSP(bf16, WS_G) + ob + 4 * j); }
        R.zg[0] = *(const GAS v4u*)zg; R.zg[1] = *(const GAS v4u*)(zg + 8);
        R.bonus = *(const GAS float*)(WSP(float, WS_BONUS) + (size_t)m * WH + (lane >> 2));
    };
    auto do_row = [&](const Raw& R, int m) {
        {
            f32x4 y[4]; float s = 0.f;
#pragma unroll
            for (int j = 0; j < 4; ++j) { y[j] = unpk4(R.yr[j]); s += (y[j].x + y[j].y) + (y[j].z + y[j].w); }
            float g[16]; { float t[8]; unpack8(R.zg[0], t);
#pragma unroll
                for (int j = 0; j < 8; ++j) g[j] = t[j]; unpack8(R.zg[1], t);
#pragma unroll
                for (int j = 0; j < 8; ++j) g[8 + j] = t[j]; }
            s += dppx<0xB1>(s); s += dppx<0x4E>(s); s += dppx<0x141>(s);
            const float mean = s * (1.f / RD); float q = 0.f;
#pragma unroll
            for (int j = 0; j < 4; ++j) { y[j] = y[j] - mean; q += (y[j].x * y[j].x + y[j].y * y[j].y) + (y[j].z * y[j].z + y[j].w * y[j].w); }
            q += dppx<0xB1>(q); q += dppx<0x4E>(q); q += dppx<0x141>(q);
            const float rstd = __builtin_amdgcn_rsqf(q * (1.f / RD) + RET_GN_EPS);
            float o[16];
#pragma unroll
            for (int j = 0; j < 4; ++j)
#pragma unroll
                for (int k = 0; k < 4; ++k) { const float gr = g[4 * j + k]; o[4 * j + k] = (y[j][k] * rstd * gg[j][k] + gb[j][k]) * (gr * fsig(gr)); }
            GAS bf16* yo = (GAS bf16*)(WSP(bf16, WS_YRET) + (size_t)m * RETW + c0);
            { float t[8];
#pragma unroll
              for (int j = 0; j < 8; ++j) t[j] = o[j]; *(GAS bf16x8*)yo = pack8(t);
#pragma unroll
              for (int j = 0; j < 8; ++j) t[j] = o[8 + j]; *(GAS bf16x8*)(yo + 8) = pack8(t); }
        }
        {
            const size_t ob = (size_t)m * RWW + c0;
            f32x4 y[4]; float s = 0.f;
#pragma unroll
            for (int j = 0; j < 4; ++j) { y[j] = unpk4(R.yw[j]); s += (y[j].x + y[j].y) + (y[j].z + y[j].w); }
            f32x4 vv[4], gt[4];
#pragma unroll
            for (int j = 0; j < 4; ++j) { vv[j] = unpk4(R.sv[j]); gt[j] = unpk4(R.gt[j]); }
            const float bonus = R.bonus;
            s += dppx<0xB1>(s); s += dppx<0x4E>(s);
            const float mean = s * (1.f / WD); float q = 0.f;
#pragma unroll
            for (int j = 0; j < 4; ++j) { y[j] = y[j] - mean; q += (y[j].x * y[j].x + y[j].y * y[j].y) + (y[j].z * y[j].z + y[j].w * y[j].w); }
            q += dppx<0xB1>(q); q += dppx<0x4E>(q);
            const float rstd = __builtin_amdgcn_rsqf(q * (1.f / WD) + RWKV_LN_EPS);
            float o[16];
#pragma unroll
            for (int j = 0; j < 4; ++j)
#pragma unroll
                for (int k = 0; k < 4; ++k) o[4 * j + k] = (y[j][k] * rstd * lg[j][k] + lb[j][k] + bonus * vv[j][k]) * gt[j][k];
            GAS bf16* yo = (GAS bf16*)(WSP(bf16, WS_YRWKV) + ob);
            { float t[8];
#pragma unroll
              for (int j = 0; j < 8; ++j) t[j] = o[j]; *(GAS bf16x8*)yo = pack8(t);
#pragma unroll
              for (int j = 0; j < 8; ++j) t[j] = o[8 + j]; *(GAS bf16x8*)(yo + 8) = pack8(t); }
        }
    };
    Raw ra, rb;
    if (gw < M) load_row(ra, gw);
    for (int m = gw; m < M; m += 2 * NGW) {
        load_row(rb, m + NGW); do_row(ra, m);
        if (m + NGW >= M) break;
        load_row(ra, m + 2 * NGW); do_row(rb, m + NGW);
    }
}
__device__ __forceinline__ void ph_final(Frame& F, ArgP A) {
    const int gw = F.vcu * NWAVES + F.wave, NGW = F.G * NWAVES, lane = F.lane;
    const GAS f32x4* gr = (const GAS f32x4*)INP(A, 23) + 2 * lane;
    f32x4 gn[8];
#pragma unroll
    for (int j = 0; j < 4; ++j) { gn[2 * j] = gr[128 * j]; gn[2 * j + 1] = gr[128 * j + 1]; }
    auto load_row = [&](v4u (&h)[4], int m) { if (m >= M) m = M - 1; const GAS v4u* hr = (const GAS v4u*)(WSP(bf16, WS_H) + (size_t)m * D) + lane;
#pragma unroll
        for (int j = 0; j < 4; ++j) h[j] = hr[64 * j]; };
    auto do_row = [&](const v4u (&h)[4], int m) {
        GAS f32x4* xo = (GAS f32x4*)(OUTP + (size_t)m * D) + 2 * lane;
        f32x4 v[8]; float s = 0.f;
#pragma unroll
        for (int j = 0; j < 4; ++j) {
            v[2 * j] = f32x4{__builtin_bit_cast(float, h[j].x << 16), __builtin_bit_cast(float, h[j].x & 0xffff0000u), __builtin_bit_cast(float, h[j].y << 16), __builtin_bit_cast(float, h[j].y & 0xffff0000u)};
            v[2 * j + 1] = f32x4{__builtin_bit_cast(float, h[j].z << 16), __builtin_bit_cast(float, h[j].z & 0xffff0000u), __builtin_bit_cast(float, h[j].w << 16), __builtin_bit_cast(float, h[j].w & 0xffff0000u)};
        }
#pragma unroll
        for (int j = 0; j < 8; ++j) s += (v[j].x * v[j].x + v[j].y * v[j].y) + (v[j].z * v[j].z + v[j].w * v[j].w);
        const float rstd = 1.f / sqrtf(wave_sum(s) * (1.f / D) + NORM_EPS);
#pragma unroll
        for (int j = 0; j < 4; ++j) { xo[128 * j] = v[2 * j] * rstd * gn[2 * j]; xo[128 * j + 1] = v[2 * j + 1] * rstd * gn[2 * j + 1]; }
    };
    v4u ha[4], hb[4];
    if (gw < M) load_row(ha, gw);
    for (int m = gw; m < M; m += 2 * NGW) {
        load_row(hb, m + NGW); do_row(ha, m);
        if (m + NGW >= M) break;
        load_row(ha, m + 2 * NGW); do_row(hb, m + NGW);
    }
}
#if (MK_GLOBAL_GROUPS & 8)
#pragma pop_macro("WSP")
#pragma pop_macro("WSW")
#pragma pop_macro("OUTP")
#endif

__global__ void __launch_bounds__(NWAVES * 64, 2) hybrid_fwd(Args args) {
    extern __shared__ __attribute__((aligned(16))) unsigned char lds[];
    Frame F;
    F.lds = (LAS unsigned char*)lds;
    F.MISC = (volatile LAS unsigned*)(F.lds + MISC_OFF);
    F.tid = threadIdx.x; F.lane = F.tid & 63; F.wave = __builtin_amdgcn_readfirstlane(F.tid >> 6);
    int bx = blockIdx.x; F.G = gridDim.x; { F.vcu = (F.G % 8 == 0) ? (bx % 8) * (F.G / 8) + bx / 8 : bx; }
    F.ws = args.ws; F.out = args.out;
    for (int u = F.tid; u < (LDS_BYTES - LDSCTL_OFF) / 4; u += NWAVES * 64) ((LAS unsigned*)(F.lds + LDSCTL_OFF))[u] = 0u;
    __syncthreads();
    if (F.tid == 0) { volatile LAS unsigned* U = (volatile LAS unsigned*)(F.lds + MISC_OFF) + 16; const unsigned long long pw = (unsigned long long)args.ws, po = (unsigned long long)args.out, pa = (unsigned long long)__builtin_amdgcn_kernarg_segment_ptr();
        U[0] = (unsigned)pw; U[1] = (unsigned)(pw >> 32); U[2] = (unsigned)po; U[3] = (unsigned)(po >> 32); U[4] = (unsigned)pa; U[5] = (unsigned)(pa >> 32); U[6] = (unsigned)F.G; U[7] = (unsigned)F.vcu; U[8] = (unsigned)bx; }
    __syncthreads();
    XcdBarrier bar = xcd_barrier_post((unsigned*)(F.ws + WS_CTL) + CW_BAR, F.MISC + 8);

    ArgP ap = (ArgP)__builtin_amdgcn_kernarg_segment_ptr();
    const int lo = args.ph_lo, hi = args.ph_hi;
#define REPX(bit, body) do { body; if (MK_REP & (bit)) { __syncthreads(); body; } } while (0)
#define IN(k) (lo <= (k) && (k) < hi)
#define SEAM(k) do { if (IN(k) && IN((k) + 1)) { xcd_barrier(bar); if (MK_REP & 256) { xcd_barrier(bar); xcd_barrier(bar); } } else __syncthreads(); } while (0)

    if (IN(PH_PRO)) { int np_ = (MK_REP & 8192) ? 2 : 1; asm volatile("" : "+s"(np_));
#pragma unroll 1
        for (int rp_ = 0; rp_ < np_; ++rp_) { ph_prologue(F, ap); ph_convert(F, ap, 0, F.vcu, F.G); __syncthreads(); } }
    SEAM(PH_PRO);
    for (int l = 0; l < DEPTH; ++l) {
        const int p0 = PH_L0 + l * PPL;
        RETID();
        { unsigned ba = MISC_OFF + 64; asm volatile("" : "+v"(ba));
          const volatile LAS v4u* U = (const volatile LAS v4u*)(F.lds + ba);
          const v4u ua = U[0], ub = U[1]; const unsigned uc = *(const volatile LAS unsigned*)(U + 2);
          const unsigned u0 = __builtin_amdgcn_readfirstlane(ua.x), u1 = __builtin_amdgcn_readfirstlane(ua.y), u2 = __builtin_amdgcn_readfirstlane(ua.z), u3 = __builtin_amdgcn_readfirstlane(ua.w);
          const unsigned u4 = __builtin_amdgcn_readfirstlane(ub.x), u5 = __builtin_amdgcn_readfirstlane(ub.y), u6 = __builtin_amdgcn_readfirstlane(ub.z), u7 = __builtin_amdgcn_readfirstlane(ub.w), u8 = __builtin_amdgcn_readfirstlane(uc);
          F.ws = (unsigned char*)(((unsigned long long)u1 << 32) | u0); F.out = (float*)(((unsigned long long)u3 << 32) | u2); ap = (ArgP)(((unsigned long long)u5 << 32) | u4);
          F.G = (int)u6; F.vcu = (int)u7; bx = (int)u8; F.wave = __builtin_amdgcn_readfirstlane(F.tid >> 6); }
        if (IN(p0 + LP_G1)) {
            pg8::Gemm g{WSPG(bf16, WS_H), WSWG(l, WO_WIN), M, INW, D}; pg8::StaticOrder S; S.init(M, INW - (MK_TAIL_IN_SCAN ? 256 : 0), F.G, bx);
            fill_rstd(F, (bx & 7) * RSTD_ROWS, RSTD_ROWS);
            pg8::EpiB<0> E{WSPG(bf16, WS_Z), INW, nullptr, 0, (const LAS float*)(F.lds + RSTD_OFF), (bx & 7) * 8};
            if (MK_STAGGER_G1 && F.G == 256 && bx >= 64) { const unsigned long long t0 = __builtin_amdgcn_s_memrealtime(), ticks = (unsigned long long)(bx - 64) * (MK_STAGGER_G1 * 100) / 192;
                while (__builtin_amdgcn_s_memrealtime() - t0 < ticks) __builtin_amdgcn_s_sleep(16); }
            pg8::gemm_phase<pg8::EpiB<0>, pg8::StaticOrder, MK_ALIGN, MK_SP2>(F.lds + RING_OFF, g, S, E);
            if (MK_REP & 512) { __syncthreads(); pg8::gemm_phase<pg8::EpiB<0>, pg8::StaticOrder, MK_ALIGN, MK_SP2>(F.lds + RING_OFF, g, S, E); }
            if (MK_CONV_IN_G1 && F.G == 256 && l + 1 < DEPTH && bx >= 64) { RETID(); ph_convert(F, ap, l + 1, bx - 64, 192); }
        }
        SEAM(p0 + LP_G1);
        if (IN(p0 + LP_PREP)) { int nrep_ = (MK_REP & 4) ? 2 : 1; asm volatile("" : "+s"(nrep_));
#pragma unroll 1
            for (int rep_ = 0; rep_ < nrep_; ++rep_) { RETID(); ph_prep(F, ap, l); __syncthreads(); } }
        SEAM(p0 + LP_PREP);
        if (IN(p0 + LP_SCAN)) { RETID(); REPX(8, ph_scan(F, ap, l)); }
        SEAM(p0 + LP_SCAN);
        if (IN(p0 + LP_POST)) { RETID(); REPX(16, ph_post(F, ap, l)); }
        SEAM(p0 + LP_POST);
#if MK_FUSE_GAB
        if (IN(p0 + LP_GA)) {
            pg8::Gemm g{WSPG(bf16, WS_YRET), WSWG(l, WO_WA), M, D, RETW, WSPG(bf16, WS_YRWKV), WSWG(l, WO_WB)}; pg8::StaticOrder S; S.init(M, D, F.G, bx);
            pg8::EpiGate2 E{WSPG(bf16, WS_MRG), D, WSPG(bf16, WS_Z) + ZC_GA, WSPG(bf16, WS_Z) + ZC_GB, INW};
            pg8::gemm_phase<pg8::EpiGate2, pg8::StaticOrder, MK_ALIGN, MK_SP2, true>(F.lds + RING_OFF, g, S, E);
        }
        __syncthreads();
#else
        if (IN(p0 + LP_GA)) {
            pg8::Gemm g{WSPG(bf16, WS_YRET), WSWG(l, WO_WA), M, D, RETW}; pg8::StaticOrder S; S.init(M, D, F.G, bx);
            pg8::EpiB<2> E{WSPG(bf16, WS_MRG), D, WSPG(bf16, WS_Z) + ZC_GA, INW, nullptr};
            pg8::gemm_phase<pg8::EpiB<2>, pg8::StaticOrder, MK_ALIGN, MK_SP2>(F.lds + RING_OFF, g, S, E);
        }
        __syncthreads();
        if (IN(p0 + LP_GB)) {
            pg8::Gemm g{WSPG(bf16, WS_YRWKV), WSWG(l, WO_WB), M, D, RWW}; pg8::StaticOrder S; S.init(M, D, F.G, bx);
            pg8::EpiB<3> E{WSPG(bf16, WS_MRG), D, WSPG(bf16, WS_Z) + ZC_GB, INW, nullptr};
            pg8::gemm_phase<pg8::EpiB<3>, pg8::StaticOrder, MK_ALIGN, MK_SP2>(F.lds + RING_OFF, g, S, E);
        }
#endif
        SEAM(p0 + LP_GB);
        if (IN(p0 + LP_GO)) {
            pg8::Gemm g{WSPG(bf16, WS_MRG), WSWG(l, WO_WO), M, D, D}; pg8::StaticOrder S; S.init(M, D, F.G, bx);
            pg8::EpiResNorm E{WSPG(bf16, WS_H), D, WSPG(float, WS_SS)};
            pg8::gemm_phase<pg8::EpiResNorm, pg8::StaticOrder, MK_ALIGN, MK_SP2>(F.lds + RING_OFF, g, S, E);
        }
        SEAM(p0 + LP_GO);
        if (IN(p0 + LP_GUP)) {
            pg8::Gemm g{WSPG(bf16, WS_H), WSWG(l, WO_WUP), M, DFF, D}; pg8::StaticOrder S; S.init(M, DFF, F.G, bx);
            fill_rstd(F, (bx & 7) * RSTD_ROWS, RSTD_ROWS);
            pg8::EpiB<1> E{WSPG(bf16, WS_UP), DFF, nullptr, 0, (const LAS float*)(F.lds + RSTD_OFF), (bx & 7) * 8};
            pg8::gemm_phase<pg8::EpiB<1>, pg8::StaticOrder, MK_ALIGN, MK_SP2>(F.lds + RING_OFF, g, S, E);
        }
        SEAM(p0 + LP_GUP);
        if (IN(p0 + LP_GDN)) {
            pg8::Gemm g{WSPG(bf16, WS_UP), WSWG(l, WO_WDN), M, D, DFF}; pg8::StaticOrder S; S.init(M, D, F.G, bx);
            pg8::EpiResNorm E{WSPG(bf16, WS_H), D, WSPG(float, WS_SS)};
            pg8::gemm_phase<pg8::EpiResNorm, pg8::StaticOrder, MK_ALIGN, MK_SP2>(F.lds + RING_OFF, g, S, E);
        }
        SEAM(p0 + LP_GDN);
    }
    if (IN(PH_FIN)) { RETID(); ph_final(F, ap); }
#undef IN
#undef SEAM
}

extern "C" void kernel_launch(void* const* d_in, const int* in_sizes, int n_in, void* d_out, int out_size, void* d_ws, size_t ws_size, hipStream_t stream) {
    static int grid = 0;
    if (grid == 0) {
        if (n_in != 24 || in_sizes[0] != M * D || out_size != M * D || ws_size < WS_END) { fprintf(stderr, "kernel_launch: built for 24 inputs, x and out of %d floats, >= %zu bytes of workspace; got n_in %d, in0 %d, out %d, ws %zu; nothing launched\n", M * D, (size_t)WS_END, n_in, n_in > 0 ? in_sizes[0] : -1, out_size, ws_size); grid = -1; return; }
        int dev = 0, cus = 0, per_cu = 0;
        if (hipGetDevice(&dev) != hipSuccess || hipDeviceGetAttribute(&cus, hipDeviceAttributeMultiprocessorCount, dev) != hipSuccess) { fprintf(stderr, "kernel_launch: hipGetDevice / hipDeviceGetAttribute failed; nothing launched\n"); grid = -1; return; }
        if (hipFuncSetAttribute((const void*)hybrid_fwd, hipFuncAttributeMaxDynamicSharedMemorySize, LDS_BYTES) != hipSuccess) { fprintf(stderr, "kernel_launch: hipFuncSetAttribute failed\n"); grid = -1; return; }
        if (hipOccupancyMaxActiveBlocksPerMultiprocessor(&per_cu, (const void*)hybrid_fwd, NWAVES * 64, LDS_BYTES) != hipSuccess || per_cu < 1)
            fprintf(stderr, "kernel_launch: note: the occupancy query reports %d workgroups per CU\n", per_cu);
        (void)hipGetLastError();
        if (cus < 256) { fprintf(stderr, "kernel_launch: built for a 256-CU device (MI355X); this one reports %d CUs; nothing launched\n", cus); grid = -1; return; }
        grid = 256;
    }
    if (grid < 0) return;
    if (hipMemsetAsync((char*)d_ws + WS_CTL, 0, CTL_ZERO_BYTES, stream) != hipSuccess) { fprintf(stderr, "kernel_launch: hipMemsetAsync failed\n"); return; }
    Args a{};
    for (int i = 0; i < 24; ++i) a.in[i] = (const float*)d_in[i];
    a.out = (float*)d_out; a.ws = (unsigned char*)d_ws; a.li = 0; a.pad = 0;
#if MK_ONE_LAUNCH
    a.ph_lo = 0; a.ph_hi = NPH;
    hipLaunchKernelGGL(hybrid_fwd, dim3(grid), dim3(NWAVES * 64), LDS_BYTES, stream, a);
#else
    for (int p = 0; p < NPH; ++p) {
        a.ph_lo = p; a.ph_hi = p + 1;
        hipLaunchKernelGGL(hybrid_fwd, dim3(grid), dim3(NWAVES * 64), LDS_BYTES, stream, a);
    }
#endif
    const hipError_t le = hipPeekAtLastError();
    if (le != hipSuccess) fprintf(stderr, "kernel_launch: launch failed: %s\n", hipGetErrorName(le));
}
```
